# Optimizing an MI355X kernel written in HIP

```python
import math
import jax, jax.numpy as jnp
from jax import lax
import numpy as np

D_MODEL = 1024
BATCH = 4
SEQ = 4096
DEPTH = 4

N_MIXERS = 2
CONV_EXPAND = 2
CONV_WIDTH = D_MODEL * CONV_EXPAND
CONV_K = 3
HEAD_DIM = 64
HEADS_PER_GROUP = D_MODEL // HEAD_DIM
DILATED_GROUPS = ((128, 1), (512, 4), (2048, 16))
N_GROUPS = len(DILATED_GROUPS)
ATTN_WIDTH = HEADS_PER_GROUP * HEAD_DIM
QKV_COLS = N_GROUPS * 3 * ATTN_WIDTH
BLOCK = 128
N_BUCKETS = 32
MAX_DISTANCE = 2048
EPS = 1e-6
N_CONV_LAYERS = (DEPTH + 1) // 2
N_ATTN_LAYERS = DEPTH // 2

kernel_name = "hybrid_shortconv_dilated_attn_trunk"


def rms_norm(x, g):
    xf = x.astype(jnp.float32)
    y = xf * lax.rsqrt(jnp.mean(xf * xf, axis=-1, keepdims=True) + EPS)
    return (y * g.astype(jnp.float32)).astype(x.dtype)


def t5_bucket(dist):
    max_exact = N_BUCKETS // 2
    d = jnp.maximum(dist, 1).astype(jnp.float32)
    large = max_exact + (jnp.log(d / max_exact) / math.log(MAX_DISTANCE / max_exact)
                         * (N_BUCKETS - max_exact)).astype(jnp.int32)
    large = jnp.minimum(large, N_BUCKETS - 1)
    return jnp.where(dist < max_exact, dist, large)


def short_conv_mixer(h, w_in, w_conv, w_out):
    S = h.shape[1]
    proj = h @ w_in
    b_gate, c_gate, u, z = jnp.split(proj, 4, axis=-1)
    v = c_gate * u
    vp = jnp.pad(v, ((0, 0), (CONV_K - 1, 0), (0, 0)))
    conv = sum(w_conv[k] * vp[:, k:k + S] for k in range(CONV_K))
    y = b_gate * conv * jax.nn.silu(z)
    return y @ w_out


def dilated_group_attention(q, k, v, bias_tab, window, dilation):
    B, S, H, Dh = q.shape
    L = S // dilation
    nb = -(-L // BLOCK)
    Lp = nb * BLOCK
    span = window // dilation

    def to_sub(t):
        t = t.reshape(B, L, dilation, H, Dh).transpose(0, 2, 3, 1, 4)
        t = jnp.pad(t, ((0, 0), (0, 0), (0, 0), (0, Lp - L), (0, 0)))
        return t.reshape(B, dilation, H, nb, BLOCK, Dh)

    def band(t):
        prev = jnp.pad(t, ((0, 0), (0, 0), (0, 0), (1, 0), (0, 0), (0, 0)))[:, :, :, :-1]
        return jnp.concatenate([prev, t], axis=4)

    qs = to_sub(q)
    kb = band(to_sub(k))
    vb = band(to_sub(v))
    logits = jnp.einsum('brhnqd,brhnkd->brhnqk', qs, kb).astype(jnp.float32) * (HEAD_DIM ** -0.5)

    a = jnp.arange(BLOCK)[:, None]
    kk = jnp.arange(2 * BLOCK)[None, :]
    step = BLOCK + a - kk
    blk = jnp.arange(nb)[:, None, None]
    key_pos = (blk - 1) * BLOCK + kk[None]
    valid = (step >= 0) & (step <= span) & (key_pos >= 0)
    bucket = t5_bucket(jnp.clip(step, 0, span) * dilation)
    bias = bias_tab.astype(jnp.float32)[bucket].transpose(2, 0, 1)[:, None]

    logits = jnp.where(valid, logits + bias, -jnp.inf)
    lse = jax.nn.logsumexp(logits, axis=-1)
    probs = jnp.exp(logits - lse[..., None])
    out = jnp.einsum('brhnqk,brhnkd->brhnqd', probs.astype(v.dtype), vb)

    out = out.reshape(B, dilation, H, Lp, Dh)[:, :, :, :L]
    out = out.transpose(0, 3, 1, 2, 4).reshape(B, S, H, Dh)
    lse = lse.reshape(B, dilation, H, Lp)[:, :, :, :L]
    lse = lse.transpose(0, 3, 1, 2).reshape(B, S, H)
    return out, lse


def dilated_attention_mixer(h, w_in, q_gain, k_gain, w_out, rel_bias):
    B, S, _ = h.shape
    proj = h @ w_in
    qkv = proj[..., :QKV_COLS].reshape(B, S, N_GROUPS, 3, HEADS_PER_GROUP, HEAD_DIM)
    z = proj[..., QKV_COLS:]
    outs, lses = [], []
    for g, (window, dilation) in enumerate(DILATED_GROUPS):
        q = rms_norm(qkv[:, :, g, 0], q_gain[g])
        k = rms_norm(qkv[:, :, g, 1], k_gain[g])
        bias_g = rel_bias[:, g * HEADS_PER_GROUP:(g + 1) * HEADS_PER_GROUP]
        o, l = dilated_group_attention(q, k, qkv[:, :, g, 2], bias_g, window, dilation)
        outs.append(o)
        lses.append(l)
    alpha = jax.nn.softmax(jnp.stack(lses, axis=0), axis=0)
    o = jnp.sum(alpha[..., None] * jnp.stack(outs, axis=0).astype(jnp.float32), axis=0)
    y = o.reshape(B, S, ATTN_WIDTH).astype(h.dtype) * jax.nn.silu(z)
    return y @ w_out


def setup_inputs(seed: int = 0) -> dict:
    key = jax.random.key(seed)
    ks = jax.random.split(key, 12)
    f32 = jnp.float32
    nc, na = N_CONV_LAYERS, N_ATTN_LAYERS
    x = jax.random.normal(ks[0], (BATCH, SEQ, D_MODEL), f32)
    conv_norm = 1.0 + 0.1 * jax.random.normal(ks[1], (nc, D_MODEL), f32)
    conv_w_in = jax.random.normal(ks[2], (nc, D_MODEL, 4 * CONV_WIDTH), f32) * D_MODEL ** -0.5
    conv_w = jax.random.normal(ks[3], (nc, CONV_K, CONV_WIDTH), f32) * CONV_K ** -0.5
    conv_w_out = jax.random.normal(ks[4], (nc, CONV_WIDTH, D_MODEL), f32) * CONV_WIDTH ** -0.5
    attn_norm = 1.0 + 0.1 * jax.random.normal(ks[5], (na, D_MODEL), f32)
    attn_w_in = jax.random.normal(ks[6], (na, D_MODEL, QKV_COLS + ATTN_WIDTH), f32) * D_MODEL ** -0.5
    attn_q_gain = 1.0 + 0.1 * jax.random.normal(ks[7], (na, N_GROUPS, HEAD_DIM), f32)
    attn_k_gain = 1.0 + 0.1 * jax.random.normal(ks[8], (na, N_GROUPS, HEAD_DIM), f32)
    attn_w_out = jax.random.normal(ks[9], (na, ATTN_WIDTH, D_MODEL), f32) * ATTN_WIDTH ** -0.5
    rel_bias = 0.5 * jax.random.normal(ks[10], (N_BUCKETS, N_GROUPS * HEADS_PER_GROUP), f32)
    return {"x": x, "conv_norm": conv_norm, "conv_w_in": conv_w_in, "conv_w": conv_w,
            "conv_w_out": conv_w_out, "attn_norm": attn_norm, "attn_w_in": attn_w_in,
            "attn_q_gain": attn_q_gain, "attn_k_gain": attn_k_gain, "attn_w_out": attn_w_out,
            "rel_bias": rel_bias}


def reference(x, conv_norm, conv_w_in, conv_w, conv_w_out, attn_norm, attn_w_in,
              attn_q_gain, attn_k_gain, attn_w_out, rel_bias):
    for i in range(DEPTH):
        j = i // N_MIXERS
        if i % N_MIXERS == 0:
            h = rms_norm(x, conv_norm[j])
            x = x + short_conv_mixer(h, conv_w_in[j], conv_w[j], conv_w_out[j])
        else:
            h = rms_norm(x, attn_norm[j])
            x = x + dilated_attention_mixer(h, attn_w_in[j], attn_q_gain[j], attn_k_gain[j],
                                            attn_w_out[j], rel_bias)
    return x
```

```cpp
#include <hip/hip_runtime.h>
#include <cstdio>
#include <cstdint>
#include <cmath>
#define MK_PER_PHASE 1
namespace pg8 {
#define PG8_LAS __attribute__((address_space(3)))
typedef unsigned short bf16_t;
typedef short bf16x8 __attribute__((ext_vector_type(8)));
typedef float f32x4 __attribute__((ext_vector_type(4)));
typedef unsigned u32x4 __attribute__((ext_vector_type(4)));
constexpr int BM = 256, BK = 64, HALF = 128, HTB = HALF * BK * 2  , STAGE_BYTES = 8 * HTB, NXCD = 8, WGM = 8;

__host__ __device__ __forceinline__ int lds_byte(int r, int c) { const int st = (r >> 4) * 2 + (c >> 5), rr = r & 15, cc = c & 31, ob = rr * 64 + cc * 2; return st * 1024 + (ob ^ (((ob >> 9) & 1) << 5)); }
__host__ __device__ __forceinline__ void stage_rc(int b, int& R, int& C) { const int st = b / 1024, sb = b % 1024, swz = sb ^ (((sb >> 9) & 1) << 5); R = (st >> 1) * 16 + swz / 64; C = (st & 1) * 32 + (swz % 64) / 2; }
__host__ __device__ __forceinline__ int perm32(int rho) { const int n = rho >> 4, i = rho & 15; return 8 * (i >> 2) + 4 * n + (i & 3); }

struct Unit { int pm, pn; };
struct Gemm { const bf16_t* A; const bf16_t* Bt; int M, N, K; };

struct StaticOrder {
    int nM, nN, nwg, G, c;
    __host__ __device__ void init(int M, int N, int G_, int c_) { nM = M / BM; nN = N / BM; nwg = nM * nN; G = G_; c = c_; }
    __host__ __device__ bool next(int i, Unit& u) const {
        const long L = (long)i * G + c; if (L >= nwg) return false;
        int wgid = (int)L; { const int q = nwg / NXCD, r = nwg % NXCD, xcd = wgid % NXCD, off = wgid / NXCD; wgid = (xcd < r ? xcd * (q + 1) : r * (q + 1) + (xcd - r) * q) + off; }
        const int nig = WGM * nN, gid = wgid / nig, fm = gid * WGM, gsz = (nM - fm) < WGM ? (nM - fm) : WGM;
        u.pm = fm + ((wgid % nig) % gsz); u.pn = (wgid % nig) / gsz; return true;
    }
    __device__ __forceinline__ void a_ready(const Unit&) const {}
    __device__ __forceinline__ void done(const Unit&) const {}
};

__device__ __forceinline__ unsigned cvt_pk_bf16(float lo, float hi) { unsigned r; asm volatile("v_cvt_pk_bf16_f32 %0, %1, %2" : "=v"(r) : "v"(lo), "v"(hi)); return r; }
typedef float f32x2 __attribute__((ext_vector_type(2)));

template <class Epi, class Sched, bool ALIGN_EPI = false, bool SP2 = false>
__device__ __forceinline__ void gemm_phase(PG8_LAS unsigned char* lds, const Gemm g, const Sched& S, const Epi& E) {
    const int tid = threadIdx.x, wid = __builtin_amdgcn_readfirstlane(tid >> 6), lane = tid & 63, wr = wid >> 2, wc = wid & 3, fr = lane & 15, fq = lane >> 4;
    const int K = g.K, nt = K / BK;
    unsigned voffA[2], voffB[2];
#pragma unroll
    for (int i = 0; i < 2; ++i) { int R, C; stage_rc(tid * 16 + i * 8192, R, C); const int Rb = Epi::PERM ? ((R & ~31) + perm32(R & 31)) : R;
        voffA[i] = (unsigned)(R * K + C) * 2u; voffB[i] = (unsigned)(Rb * K + C) * 2u; }
    const size_t kstep = (size_t)(BK * 2);
    const size_t hstep = (size_t)HALF * K * 2;
    const size_t tstep = 2 * hstep;
    const unsigned ldsw = (unsigned)wid * 1024u;
    const int aoff = lds_byte(wr * 64 + fr, fq * 8), boff = lds_byte(wc * 32 + fr, fq * 8);
#define PG8_SA(b, h) (((b) * 2 + (h)) * HTB)
#define PG8_SB(b, h) ((4 + (b) * 2 + (h)) * HTB)
#define PG8_STAGE(bufoff, gbase, voff) do { _Pragma("unroll") for (int _i = 0; _i < 2; ++_i) \
        __builtin_amdgcn_global_load_lds((const unsigned*)((const char*)(gbase) + (voff)[_i]), (PG8_LAS unsigned*)(lds + (bufoff) + ldsw + _i * 8192), 16, 0, 0); } while (0)
#define PG8_LDA(dst, b, h) do { _Pragma("unroll") for (int m = 0; m < 4; ++m) _Pragma("unroll") for (int k = 0; k < 2; ++k) dst[m][k] = *(const PG8_LAS bf16x8*)(lds + PG8_SA(b, h) + aoff + m * 2048 + k * 1024); } while (0)
#define PG8_LDB(dst, b, h) do { _Pragma("unroll") for (int n = 0; n < 2; ++n) _Pragma("unroll") for (int k = 0; k < 2; ++k) dst[n][k] = *(const PG8_LAS bf16x8*)(lds + PG8_SB(b, h) + boff + n * 2048 + k * 1024); } while (0)
#define PG8_MMA(ai, bj, At, Bt) do { __builtin_amdgcn_s_setprio(1); _Pragma("unroll") for (int m = 0; m < 4; ++m) _Pragma("unroll") for (int n = 0; n < 2; ++n) _Pragma("unroll") for (int k = 0; k < 2; ++k) \
        acc[ai][bj][m][n] = __builtin_amdgcn_mfma_f32_16x16x32_bf16(Bt[n][k], At[m][k], acc[ai][bj][m][n], 0, 0, 0); __builtin_amdgcn_s_setprio(0); } while (0)
#define PG8_WAIT_V(n) asm volatile("s_waitcnt vmcnt(" #n ")" ::: "memory")
#define PG8_WAIT_L(n) asm volatile("s_waitcnt lgkmcnt(" #n ")" ::: "memory")
#define PG8_BAR __builtin_amdgcn_s_barrier()
#define PG8_SCHED __builtin_amdgcn_sched_barrier(0)
    Unit cur, nxt; int ui = 0;
    if (!S.next(0, cur)) return;
    f32x4 acc[2][2][4][2];
#pragma unroll
    for (int a = 0; a < 2; ++a)
#pragma unroll
        for (int b = 0; b < 2; ++b)
#pragma unroll
            for (int m = 0; m < 4; ++m)
#pragma unroll
                for (int n = 0; n < 2; ++n) acc[a][b][m][n] = (f32x4){0.f, 0.f, 0.f, 0.f};
    bf16x8 At[4][2], B0[2][2], B1[2][2];
    const char* cA = (const char*)g.A + (size_t)cur.pm * tstep; const char* cB = (const char*)g.Bt + (size_t)cur.pn * tstep;
    S.a_ready(cur);
    if constexpr (SP2) {
        PG8_STAGE(PG8_SB(0, 0), cB, voffB); PG8_STAGE(PG8_SB(0, 1), cB + hstep, voffB); PG8_STAGE(PG8_SA(0, 0), cA, voffA); PG8_STAGE(PG8_SA(0, 1), cA + hstep, voffA);
        if (wr == 1) PG8_BAR;
        PG8_WAIT_V(2); PG8_BAR;
        PG8_STAGE(PG8_SB(1, 0), cB + kstep, voffB); PG8_STAGE(PG8_SA(1, 0), cA + kstep, voffA); PG8_STAGE(PG8_SB(1, 1), cB + hstep + kstep, voffB);
        PG8_WAIT_V(6); PG8_BAR;
    } else {
        PG8_STAGE(PG8_SB(0, 0), cB, voffB); PG8_STAGE(PG8_SA(0, 0), cA, voffA); PG8_STAGE(PG8_SB(0, 1), cB + hstep, voffB); PG8_STAGE(PG8_SA(0, 1), cA + hstep, voffA);
        if (wr == 1) PG8_BAR;
        PG8_WAIT_V(4); PG8_BAR;
        PG8_STAGE(PG8_SB(1, 0), cB + kstep, voffB); PG8_STAGE(PG8_SA(1, 0), cA + kstep, voffA); PG8_STAGE(PG8_SB(1, 1), cB + hstep + kstep, voffB);
        PG8_WAIT_V(6); PG8_BAR;
    }
    for (;;) {
        const bool has_next = S.next(ui + 1, nxt);
        const char* nA = has_next ? (const char*)g.A + (size_t)nxt.pm * tstep : cA; const char* nB = has_next ? (const char*)g.Bt + (size_t)nxt.pn * tstep : cB;
        for (int t = 0; t < nt; t += 2) {
            const bool last = (t == nt - 2);
            const char* a1 = cA + (size_t)(t + 1) * kstep;
            const char* a2 = last ? nA : cA + (size_t)(t + 2) * kstep; const char* b2 = last ? nB : cB + (size_t)(t + 2) * kstep;
            const char* a3 = a2 + kstep; const char* b3 = b2 + kstep;
            if (last && has_next) S.a_ready(nxt);
            if constexpr (SP2) {
            PG8_LDB(B0, 0, 0); PG8_LDB(B1, 0, 1); PG8_SCHED; PG8_LDA(At, 0, 0); PG8_STAGE(PG8_SA(1, 1), a1 + hstep, voffA);
            PG8_WAIT_V(8); PG8_WAIT_L(0); PG8_BAR; PG8_MMA(0, 0, At, B0); PG8_MMA(0, 1, At, B1); PG8_BAR; PG8_SCHED;
            PG8_LDA(At, 0, 1); PG8_STAGE(PG8_SB(0, 0), b2, voffB); PG8_STAGE(PG8_SB(0, 1), b2 + hstep, voffB); PG8_STAGE(PG8_SA(0, 0), a2, voffA);
            PG8_WAIT_V(8); PG8_WAIT_L(0); PG8_BAR; PG8_MMA(1, 0, At, B0); PG8_MMA(1, 1, At, B1); PG8_BAR; PG8_SCHED;
            PG8_LDB(B0, 1, 0); PG8_LDB(B1, 1, 1); PG8_SCHED; PG8_LDA(At, 1, 0); PG8_STAGE(PG8_SA(0, 1), a2 + hstep, voffA);
            PG8_WAIT_V(8); PG8_WAIT_L(0); PG8_BAR; PG8_MMA(0, 0, At, B0); PG8_MMA(0, 1, At, B1); PG8_BAR; PG8_SCHED;
            PG8_LDA(At, 1, 1); PG8_STAGE(PG8_SB(1, 0), b3, voffB); PG8_STAGE(PG8_SB(1, 1), b3 + hstep, voffB); PG8_STAGE(PG8_SA(1, 0), a3, voffA);
            PG8_WAIT_V(8); PG8_WAIT_L(0); PG8_BAR; PG8_MMA(1, 0, At, B0); PG8_MMA(1, 1, At, B1); PG8_BAR; PG8_SCHED;
            } else {
            PG8_LDB(B0, 0, 0); PG8_SCHED; PG8_LDA(At, 0, 0); PG8_STAGE(PG8_SA(1, 1), a1 + hstep, voffA);
            PG8_WAIT_L(8); PG8_BAR; PG8_WAIT_L(0); PG8_MMA(0, 0, At, B0); PG8_BAR; PG8_SCHED;
            PG8_LDB(B1, 0, 1); PG8_STAGE(PG8_SB(0, 0), b2, voffB);
            PG8_BAR; PG8_WAIT_L(0); PG8_MMA(0, 1, At, B1); PG8_BAR;
            PG8_LDA(At, 0, 1); PG8_STAGE(PG8_SA(0, 0), a2, voffA);
            PG8_BAR; PG8_WAIT_L(0); PG8_MMA(1, 0, At, B0); PG8_BAR; PG8_SCHED;
            PG8_STAGE(PG8_SB(0, 1), b2 + hstep, voffB);
            PG8_WAIT_V(6); PG8_BAR; PG8_MMA(1, 1, At, B1); PG8_BAR;
            PG8_LDB(B0, 1, 0); PG8_SCHED; PG8_LDA(At, 1, 0); PG8_STAGE(PG8_SA(0, 1), a2 + hstep, voffA);
            PG8_WAIT_L(8); PG8_BAR; PG8_WAIT_L(0); PG8_MMA(0, 0, At, B0); PG8_BAR; PG8_SCHED;
            PG8_LDB(B1, 1, 1); PG8_STAGE(PG8_SB(1, 0), b3, voffB);
            PG8_BAR; PG8_WAIT_L(0); PG8_MMA(0, 1, At, B1); PG8_BAR;
            PG8_LDA(At, 1, 1); PG8_STAGE(PG8_SA(1, 0), a3, voffA);
            PG8_BAR; PG8_WAIT_L(0); PG8_MMA(1, 0, At, B0); PG8_BAR; PG8_SCHED;
            PG8_STAGE(PG8_SB(1, 1), b3 + hstep, voffB);
            PG8_WAIT_V(6); PG8_BAR; PG8_MMA(1, 1, At, B1); PG8_BAR;
            }
        }
        if constexpr (ALIGN_EPI) { if (wr == 0) PG8_BAR; }
        if constexpr (!Epi::AFTER_DRAIN) { E(acc, cur, wr, wc, fr, fq); S.done(cur); }
        if (!has_next) break;
#pragma unroll
        for (int a = 0; a < 2; ++a)
#pragma unroll
            for (int b = 0; b < 2; ++b)
#pragma unroll
                for (int m = 0; m < 4; ++m)
#pragma unroll
                    for (int n = 0; n < 2; ++n) acc[a][b][m][n] = (f32x4){0.f, 0.f, 0.f, 0.f};
        cur = nxt; cA = nA; cB = nB; ++ui;
        if constexpr (ALIGN_EPI) { if (wr == 1) PG8_BAR; }
    }
    PG8_WAIT_V(0);
    if constexpr (!ALIGN_EPI) { if (wr == 0) PG8_BAR; }
    PG8_BAR;
    if constexpr (Epi::AFTER_DRAIN) { E.fused(acc, cur, wr, wc, fr, fq, lds, wid, lane); S.done(cur); }
#undef PG8_SA
#undef PG8_SB
#undef PG8_STAGE
#undef PG8_LDA
#undef PG8_LDB
#undef PG8_MMA
#undef PG8_WAIT_V
#undef PG8_WAIT_L
#undef PG8_BAR
#undef PG8_SCHED
}
}

constexpr int BATCH = 4, SEQ = 4096, DM = 1024, MROWS = BATCH * SEQ;
constexpr int CE = 2048, CN = 4 * CE;
constexpr int NH = 16, HD = 64, NG = 3, QKVC = 9216, AN = 10240;
constexpr float EPS = 1e-6f, LOG2E = 1.4426950408889634f, QSCALE = 0.125f * LOG2E;
constexpr int NPHASE = 23;

constexpr size_t MiB = 1u << 20;
constexpr size_t WS_CTL = 0, CTL_ZERO_BYTES = 1 * MiB;
constexpr size_t WS_SSQ = 1 * MiB;
constexpr size_t WS_W1 = 2 * MiB, WS_W2 = 34 * MiB, WS_W3 = 42 * MiB, WS_W4 = 82 * MiB;
constexpr size_t WS_LSE = 86 * MiB;
constexpr size_t WS_BIAS = 89 * MiB;
constexpr size_t WS_XB = 90 * MiB;
constexpr size_t WS_CV = 122 * MiB, WS_CG = 186 * MiB;
constexpr size_t WS_QO = 122 * MiB;
constexpr size_t WS_K = 218 * MiB, WS_V = 250 * MiB, WS_Y = WS_K;
constexpr size_t WS_END = 282 * MiB;
constexpr int CW_TMO = 0, CW_BAR = 4096;

#define GAS __attribute__((address_space(1)))
#define LAS __attribute__((address_space(3)))
typedef unsigned short bf16;
typedef unsigned v4u __attribute__((ext_vector_type(4)));
typedef unsigned v2u __attribute__((ext_vector_type(2)));
typedef float f32x4 __attribute__((ext_vector_type(4)));
typedef short bf16x8 __attribute__((ext_vector_type(8)));
typedef GAS unsigned gu32;
#define RLX_AGENT __ATOMIC_RELAXED, __HIP_MEMORY_SCOPE_AGENT
#define LDS_WAIT() asm volatile("s_waitcnt lgkmcnt(0)" ::: "memory")
#define VM_WAIT() asm volatile("s_waitcnt vmcnt(0)" ::: "memory")
__device__ __forceinline__ unsigned f2bf(float f) { unsigned u = __builtin_bit_cast(unsigned, f); return (u + 0x7fffu + ((u >> 16) & 1u)) >> 16; }
__device__ __forceinline__ unsigned pk2(float lo, float hi) { return f2bf(lo) | (f2bf(hi) << 16); }
__device__ __forceinline__ float bf2f(unsigned h) { return __builtin_bit_cast(float, h << 16); }
__device__ __forceinline__ float bflo(unsigned w) { return __builtin_bit_cast(float, w << 16); }
__device__ __forceinline__ float bfhi(unsigned w) { return __builtin_bit_cast(float, w & 0xffff0000u); }
__device__ __forceinline__ float sigmoidf_(float z) { return 1.0f / (1.0f + __builtin_amdgcn_exp2f(-z * LOG2E)); }
__device__ __forceinline__ float row_rs(const float* ssq, int row) {
    const f32x4* p = (const f32x4*)(ssq + (size_t)row * 16);
    const f32x4 s = (p[0] + p[1]) + (p[2] + p[3]);
    return 1.0f / sqrtf(((s.x + s.y) + (s.z + s.w)) * (1.0f / DM) + EPS);
}
__device__ __forceinline__ float wave_sum(float v) {
#pragma unroll
    for (int o = 1; o < 64; o <<= 1) v += __shfl_xor(v, o);
    return v;
}
__device__ __forceinline__ int t5_bucket(int d) {
    if (d < 16) return d;
    int b = 15;
    b += (d >= 16); b += (d >= 22); b += (d >= 30); b += (d >= 40); b += (d >= 54); b += (d >= 73); b += (d >= 99); b += (d >= 134);
    b += (d >= 182); b += (d >= 246); b += (d >= 332); b += (d >= 450); b += (d >= 609); b += (d >= 825); b += (d >= 1117); b += (d >= 1513);
    return b;
}

#define XB_TMO      128
#define XB_XCNT(j)  (256  + 64 * (j))
#define XB_XSUB(j)  (1280 + 64 * (j))
#define XB_XGEN(j)  (2304 + 64 * (j))
#define XB_TOP      3328
#define XB_TOPGEN   3392
#define XCD_BAR_WORDS 3456
#define XB_SPIN_CAP (1u << 18)

__device__ __forceinline__ unsigned xb_ld(unsigned* p)              { return __hip_atomic_load(p, __ATOMIC_RELAXED, __HIP_MEMORY_SCOPE_AGENT); }
__device__ __forceinline__ unsigned xb_add(unsigned* p, unsigned v) { return __hip_atomic_fetch_add(p, v, __ATOMIC_RELAXED, __HIP_MEMORY_SCOPE_AGENT); }
__device__ __forceinline__ unsigned xb_xcc_id() { return (unsigned)__builtin_amdgcn_s_getreg((3 << 11) | 20) & 0xFu; }
#define XB_SPIN(cond, bar) do { unsigned _sp = 0; while (cond) { __builtin_amdgcn_s_sleep(1); \
    if ((++_sp & 255u) == 0u) { if (xb_ld(&(bar)[XB_TMO])) break; if (_sp > XB_SPIN_CAP) { atomicAdd(&(bar)[XB_TMO], 1u); break; } } } } while (0)

struct XcdBarrier {
    unsigned* bar; unsigned x;
    volatile LAS unsigned* st;
};

__device__ __forceinline__ XcdBarrier xcd_barrier_post(unsigned* bar, volatile LAS unsigned* st) {
    XcdBarrier b; b.bar = bar; b.x = xb_xcc_id(); b.st = st;
    if (threadIdx.x == 0) (void)xb_add(&bar[XB_XCNT(b.x)], 1u);
    return b;
}
__device__ __forceinline__ void xcd_barrier_complete(unsigned* bar, unsigned x, unsigned& nloc, unsigned& nx) {
    const unsigned G = gridDim.x * gridDim.y * gridDim.z;
    unsigned sum, cnt, mine, sp = 0u;
    for (;;) {
        sum = 0u; cnt = 0u; mine = 0u;
#pragma unroll
        for (unsigned j = 0; j < 16; ++j) { const unsigned c = xb_ld(&bar[XB_XCNT(j)]); sum += c; cnt += (c > 0u) ? 1u : 0u; mine = (j == x) ? c : mine; }
        if (sum == G) break;
        __builtin_amdgcn_s_sleep(1);
        if ((++sp & 255u) == 0u) { if (xb_ld(&bar[XB_TMO])) break; if (sp > XB_SPIN_CAP) { atomicAdd(&bar[XB_TMO], 1u); break; } }
    }
    nloc = mine > 0u ? mine : 1u; nx = cnt > 0u ? cnt : 1u;
}

__device__ __forceinline__ void xcd_barrier(const XcdBarrier& b) {
    asm volatile("s_waitcnt vmcnt(0)" ::: "memory");
    __syncthreads();
    if (threadIdx.x == 0) {
        unsigned* bar = b.bar;
        __builtin_amdgcn_s_waitcnt(0);
        unsigned nloc = b.st[0], nx = b.st[1];
        if (nloc == 0u) { xcd_barrier_complete(bar, b.x, nloc, nx); b.st[0] = nloc; b.st[1] = nx; }
        const unsigned old = xb_add(&bar[XB_XSUB(b.x)], 1u);
        const unsigned gen = old / nloc;
        if (old + 1u == (gen + 1u) * nloc) {
            __builtin_amdgcn_fence(__ATOMIC_RELEASE, "agent");
            asm volatile("s_waitcnt vmcnt(0)" ::: "memory");
            const unsigned og = xb_add(&bar[XB_TOP], 1u);
            const unsigned tg = og / nx;
            if (og + 1u == (tg + 1u) * nx) xb_add(&bar[XB_TOPGEN], 1u);
            else XB_SPIN(xb_ld(&bar[XB_TOPGEN]) == tg, bar);
            __builtin_amdgcn_fence(__ATOMIC_ACQUIRE, "agent");
            xb_add(&bar[XB_XGEN(b.x)], 1u);
            asm volatile("s_waitcnt vmcnt(0)" ::: "memory");
        } else {
            XB_SPIN(xb_ld(&bar[XB_XGEN(b.x)]) == gen, bar);
            __builtin_amdgcn_fence(__ATOMIC_ACQUIRE, "agent");
            asm volatile("s_waitcnt vmcnt(0)" ::: "memory");
        }
    }
    __syncthreads();
}

namespace epi {
using pg8::Unit; using pg8::bf16_t;
struct ConvIn {
    static constexpr bool PERM = false, AFTER_DRAIN = false;
    const float* ssq; bf16_t* V; bf16_t* G;
    __device__ __forceinline__ void operator()(const f32x4 (&acc)[2][2][4][2], const Unit& u, int wr, int wc, int fr, int fq) const {
        const int ch0 = u.pn * 64 + wc * 16 + 4 * fq;
#pragma unroll
        for (int ai = 0; ai < 2; ++ai)
#pragma unroll
            for (int m = 0; m < 4; ++m) {
                const int row = u.pm * 256 + ai * 128 + wr * 64 + m * 16 + fr;
                const float rs = row_rs(ssq, row);
                const f32x4 b = acc[ai][0][m][0] * rs, c = acc[ai][0][m][1] * rs, uu = acc[ai][1][m][0] * rs, z = acc[ai][1][m][1] * rs;
                const f32x4 v = c * uu;
                f32x4 g;
#pragma unroll
                for (int i = 0; i < 4; ++i) g[i] = b[i] * z[i] * sigmoidf_(z[i]);
                v2u wv, wg; wv.x = pk2(v[0], v[1]); wv.y = pk2(v[2], v[3]); wg.x = pk2(g[0], g[1]); wg.y = pk2(g[2], g[3]);
                *(v2u*)(V + (size_t)row * CE + ch0) = wv;
                *(v2u*)(G + (size_t)row * CE + ch0) = wg;
            }
    }
};
struct Resid {
    static constexpr bool PERM = false, AFTER_DRAIN = false;
    const float* xin; float* xout; bf16_t* xb; float* ssq;
    __device__ __forceinline__ void operator()(const f32x4 (&acc)[2][2][4][2], const Unit& u, int wr, int wc, int fr, int fq) const {
        const int col0 = u.pn * 256 + wc * 32 + 4 * fq;
#pragma unroll
        for (int ai = 0; ai < 2; ++ai)
#pragma unroll
            for (int m = 0; m < 4; ++m) {
                const int row = u.pm * 256 + ai * 128 + wr * 64 + m * 16 + fr;
                const size_t off = (size_t)row * DM + col0;
                float ss = 0.f;
#pragma unroll
                for (int bj = 0; bj < 2; ++bj)
#pragma unroll
                    for (int n = 0; n < 2; ++n) {
                        const f32x4 xo = *(const f32x4*)(xin + off + bj * 128 + n * 16);
                        const f32x4 xn = xo + acc[ai][bj][m][n];
                        *(f32x4*)(xout + off + bj * 128 + n * 16) = xn;
                        v2u w; w.x = pk2(xn[0], xn[1]); w.y = pk2(xn[2], xn[3]);
                        *(v2u*)(xb + off + bj * 128 + n * 16) = w;
                        ss += (xn[0] * xn[0] + xn[1] * xn[1]) + (xn[2] * xn[2] + xn[3] * xn[3]);
                    }
                ss += __shfl_xor(ss, 16); ss += __shfl_xor(ss, 32);
                if (fq == 0) ssq[(size_t)row * 16 + u.pn * 4 + wc] = ss;
            }
    }
};
struct QKV {
    static constexpr bool PERM = true, AFTER_DRAIN = false;
    const float* ssq; bf16_t* Q; bf16_t* K; bf16_t* Vv; const float* qg; const float* kg;
    __device__ __forceinline__ void operator()(const f32x4 (&acc)[2][2][4][2], const Unit& u, int wr, int wc, int fr, int fq) const {
        const int which = u.pn >> 2, h = (u.pn & 3) * 4 + wc;
        bf16_t* base = which == 0 ? Q : (which == 1 ? K : Vv);
        f32x4 gv[2][2];
#pragma unroll
        for (int bj = 0; bj < 2; ++bj)
#pragma unroll
            for (int n = 0; n < 2; ++n) {
                if (which < 2) { gv[bj][n] = *(const f32x4*)((which == 0 ? qg : kg) + 32 * bj + 8 * fq + 4 * n); if (which == 0) gv[bj][n] = gv[bj][n] * QSCALE; }
                else gv[bj][n] = (f32x4){1.f, 1.f, 1.f, 1.f};
            }
#pragma unroll
        for (int ai = 0; ai < 2; ++ai)
#pragma unroll
            for (int m = 0; m < 4; ++m) {
                const int row = u.pm * 256 + ai * 128 + wr * 64 + m * 16 + fr;
                const float rs = row_rs(ssq, row);
                f32x4 v[2][2]; float ss = 0.f;
#pragma unroll
                for (int bj = 0; bj < 2; ++bj)
#pragma unroll
                    for (int n = 0; n < 2; ++n) { v[bj][n] = acc[ai][bj][m][n] * rs; const f32x4 t = v[bj][n]; ss += (t[0] * t[0] + t[1] * t[1]) + (t[2] * t[2] + t[3] * t[3]); }
                ss += __shfl_xor(ss, 16); ss += __shfl_xor(ss, 32);
                const float rn = which < 2 ? 1.0f / sqrtf(ss * (1.0f / HD) + EPS) : 1.0f;
#pragma unroll
                for (int bj = 0; bj < 2; ++bj) {
                    const f32x4 a = v[bj][0] * gv[bj][0] * rn, b = v[bj][1] * gv[bj][1] * rn;
                    v4u w; w.x = pk2(a[0], a[1]); w.y = pk2(a[2], a[3]); w.z = pk2(b[0], b[1]); w.w = pk2(b[2], b[3]);
                    *(v4u*)(base + (size_t)row * DM + h * HD + 32 * bj + 8 * fq) = w;
                }
            }
    }
};
struct ZMerge {
    static constexpr bool PERM = true, AFTER_DRAIN = false;
    const float* ssq; const bf16_t* O0; const bf16_t* O1; const bf16_t* O2; const float* lse; bf16_t* Y;
    __device__ __forceinline__ void operator()(const f32x4 (&acc)[2][2][4][2], const Unit& u, int wr, int wc, int fr, int fq) const {
        const int h = u.pn * 4 + wc;
#pragma unroll
        for (int ai = 0; ai < 2; ++ai)
#pragma unroll
            for (int m = 0; m < 4; ++m) {
                const int row = u.pm * 256 + ai * 128 + wr * 64 + m * 16 + fr;
                const float rs = row_rs(ssq, row);
                const float l0 = lse[((size_t)0 * MROWS + row) * 16 + h], l1 = lse[((size_t)1 * MROWS + row) * 16 + h], l2 = lse[((size_t)2 * MROWS + row) * 16 + h];
                const float mx = fmaxf(l0, fmaxf(l1, l2));
                float w0 = __builtin_amdgcn_exp2f(l0 - mx), w1 = __builtin_amdgcn_exp2f(l1 - mx), w2 = __builtin_amdgcn_exp2f(l2 - mx);
                const float inv = 1.0f / (w0 + w1 + w2); w0 *= inv; w1 *= inv; w2 *= inv;
#pragma unroll
                for (int bj = 0; bj < 2; ++bj) {
                    const size_t off = (size_t)row * DM + h * HD + 32 * bj + 8 * fq;
                    const v4u a = *(const v4u*)(O0 + off), b = *(const v4u*)(O1 + off), c = *(const v4u*)(O2 + off);
                    float o[8];
#pragma unroll
                    for (int i = 0; i < 4; ++i) { o[2 * i] = w0 * bflo(a[i]) + w1 * bflo(b[i]) + w2 * bflo(c[i]); o[2 * i + 1] = w0 * bfhi(a[i]) + w1 * bfhi(b[i]) + w2 * bfhi(c[i]); }
                    const f32x4 z0 = acc[ai][bj][m][0] * rs, z1 = acc[ai][bj][m][1] * rs;
                    float y[8];
#pragma unroll
                    for (int i = 0; i < 4; ++i) { y[i] = o[i] * z0[i] * sigmoidf_(z0[i]); y[4 + i] = o[4 + i] * z1[i] * sigmoidf_(z1[i]); }
                    v4u w; w.x = pk2(y[0], y[1]); w.y = pk2(y[2], y[3]); w.z = pk2(y[4], y[5]); w.w = pk2(y[6], y[7]);
                    *(v4u*)(Y + off) = w;
                }
            }
    }
};
}

namespace naive {
template <class AL, class BL, class EP>
__device__ __forceinline__ void gemm_tile(LAS float* sm, int K, int row0, const AL& al, const BL& bl, const EP& ep) {
    const int tid = threadIdx.x, tx = tid & 15, ty = tid >> 4;
    LAS float* sA = sm; LAS float* sB = sm + 16 * 132;
    float acc[4][4];
#pragma unroll
    for (int i = 0; i < 4; ++i)
#pragma unroll
        for (int j = 0; j < 4; ++j) acc[i][j] = 0.f;
    for (int k0 = 0; k0 < K; k0 += 16) {
#pragma unroll
        for (int i = 0; i < 4; ++i) { const int idx = tid + 512 * i, r = idx >> 4, kk = idx & 15; sA[kk * 132 + r] = al(row0 + r, k0 + kk); }
#pragma unroll
        for (int i = 0; i < 2; ++i) { const int idx = tid + 512 * i, kk = idx >> 6, c = idx & 63; sB[kk * 68 + c] = bl(k0 + kk, c); }
        __syncthreads();
#pragma unroll
        for (int kk = 0; kk < 16; ++kk) {
            float a[4], b[4];
#pragma unroll
            for (int i = 0; i < 4; ++i) a[i] = sA[kk * 132 + ty * 4 + i];
#pragma unroll
            for (int j = 0; j < 4; ++j) b[j] = sB[kk * 68 + tx + 16 * j];
#pragma unroll
            for (int i = 0; i < 4; ++i)
#pragma unroll
                for (int j = 0; j < 4; ++j) acc[i][j] = fmaf(a[i], b[j], acc[i][j]);
        }
        __syncthreads();
    }
#pragma unroll
    for (int i = 0; i < 4; ++i) ep(row0 + ty * 4 + i, tx, acc[i][0], acc[i][1], acc[i][2], acc[i][3]);
}
struct ALbf { const bf16* A; int ld; __device__ __forceinline__ float operator()(int r, int k) const { return bf2f(A[(size_t)r * ld + k]); } };
__device__ __forceinline__ float red16(float v) { v += __shfl_xor(v, 1); v += __shfl_xor(v, 2); v += __shfl_xor(v, 4); v += __shfl_xor(v, 8); return v; }

struct BLc1 { const float* w; const float* nrm; int ct; __device__ __forceinline__ float operator()(int k, int c) const { return w[(size_t)k * CN + (c >> 4) * CE + ct * 16 + (c & 15)] * nrm[k]; } };
struct EPc1 { const float* ssq; bf16* V; bf16* G; int ct;
    __device__ __forceinline__ void operator()(int row, int tx, float a0, float a1, float a2, float a3) const {
        const float rs = row_rs(ssq, row); const float b = a0 * rs, c = a1 * rs, u = a2 * rs, z = a3 * rs;
        const int e = ct * 16 + tx; V[(size_t)row * CE + e] = (bf16)f2bf(c * u); G[(size_t)row * CE + e] = (bf16)f2bf(b * z * sigmoidf_(z)); } };
__device__ __forceinline__ void c1(LAS float* sm, const bf16* xb, const float* ssq, const float* w, const float* nrm, bf16* V, bf16* G, int bid, int nb) {
    const int nct = CE / 16, ntile = (MROWS / 128) * nct;
    for (int t = bid; t < ntile; t += nb) { const int rt = t / nct, ct = t % nct; gemm_tile(sm, DM, rt * 128, ALbf{xb, DM}, BLc1{w, nrm, ct}, EPc1{ssq, V, G, ct}); }
}
struct BLres { const float* w; int ct; __device__ __forceinline__ float operator()(int k, int c) const { return w[(size_t)k * DM + ct * 64 + c]; } };
struct EPres { const float* xin; float* xout; bf16* xb; float* ssq; int ct;
    __device__ __forceinline__ void operator()(int row, int tx, float a0, float a1, float a2, float a3) const {
        const size_t o = (size_t)row * DM + ct * 64 + tx;
        const float x0 = xin[o] + a0, x1 = xin[o + 16] + a1, x2 = xin[o + 32] + a2, x3 = xin[o + 48] + a3;
        xout[o] = x0; xout[o + 16] = x1; xout[o + 32] = x2; xout[o + 48] = x3;
        xb[o] = (bf16)f2bf(x0); xb[o + 16] = (bf16)f2bf(x1); xb[o + 32] = (bf16)f2bf(x2); xb[o + 48] = (bf16)f2bf(x3);
        const float ss = red16((x0 * x0 + x1 * x1) + (x2 * x2 + x3 * x3));
        if (tx == 0) ssq[(size_t)row * 16 + ct] = ss; } };
__device__ __forceinline__ void resid(LAS float* sm, const bf16* A, int K, const float* w, const float* xin, float* xout, bf16* xb, float* ssq, int bid, int nb) {
    const int ntile = (MROWS / 128) * 16;
    for (int t = bid; t < ntile; t += nb) { const int rt = t / 16, ct = t % 16; gemm_tile(sm, K, rt * 128, ALbf{A, K}, BLres{w, ct}, EPres{xin, xout, xb, ssq, ct}); }
}
struct BLa1 { const float* w; const float* nrm; int col0; __device__ __forceinline__ float operator()(int k, int c) const { return w[(size_t)k * AN + col0 + c] * nrm[k]; } };
struct EPa1 { const float* ssq; bf16* dst; const float* gain; float sc; int h;
    __device__ __forceinline__ void operator()(int row, int tx, float a0, float a1, float a2, float a3) const {
        const float rs = row_rs(ssq, row); float v0 = a0 * rs, v1 = a1 * rs, v2 = a2 * rs, v3 = a3 * rs;
        const float ss = red16((v0 * v0 + v1 * v1) + (v2 * v2 + v3 * v3));
        if (gain) { const float rn = sc / sqrtf(ss * (1.0f / HD) + EPS); v0 *= rn * gain[tx]; v1 *= rn * gain[tx + 16]; v2 *= rn * gain[tx + 32]; v3 *= rn * gain[tx + 48]; }
        const size_t o = (size_t)row * DM + h * HD + tx;
        dst[o] = (bf16)f2bf(v0); dst[o + 16] = (bf16)f2bf(v1); dst[o + 32] = (bf16)f2bf(v2); dst[o + 48] = (bf16)f2bf(v3); } };
__device__ __forceinline__ void a1(LAS float* sm, const bf16* xb, const float* ssq, const float* w, const float* nrm, int g, const float* qg, const float* kg, bf16* Q, bf16* K, bf16* V, int bid, int nb) {
    const int ntile = (MROWS / 128) * 48;
    for (int t = bid; t < ntile; t += nb) { const int rt = t / 48, ct = t % 48, which = ct / 16, h = ct % 16;
        gemm_tile(sm, DM, rt * 128, ALbf{xb, DM}, BLa1{w, nrm, g * 3072 + which * 1024 + h * 64},
                  EPa1{ssq, which == 0 ? Q : (which == 1 ? K : V), which == 0 ? qg : (which == 1 ? kg : nullptr), which == 0 ? QSCALE : 1.0f, h}); }
}
struct EPa3 { const float* ssq; const bf16* O0; const bf16* O1; const bf16* O2; const float* lse; bf16* Y; int h;
    __device__ __forceinline__ void operator()(int row, int tx, float a0, float a1, float a2, float a3) const {
        const float rs = row_rs(ssq, row);
        const float l0 = lse[((size_t)0 * MROWS + row) * 16 + h], l1 = lse[((size_t)1 * MROWS + row) * 16 + h], l2 = lse[((size_t)2 * MROWS + row) * 16 + h];
        const float mx = fmaxf(l0, fmaxf(l1, l2)); float w0 = exp2f(l0 - mx), w1 = exp2f(l1 - mx), w2 = exp2f(l2 - mx); const float inv = 1.0f / (w0 + w1 + w2); w0 *= inv; w1 *= inv; w2 *= inv;
        const float zz[4] = {a0 * rs, a1 * rs, a2 * rs, a3 * rs};
#pragma unroll
        for (int j = 0; j < 4; ++j) { const size_t o = (size_t)row * DM + h * HD + tx + 16 * j;
            const float ov = w0 * bf2f(O0[o]) + w1 * bf2f(O1[o]) + w2 * bf2f(O2[o]); Y[o] = (bf16)f2bf(ov * zz[j] * sigmoidf_(zz[j])); } } };
__device__ __forceinline__ void a3(LAS float* sm, const bf16* xb, const float* ssq, const float* w, const float* nrm, const bf16* O0, const bf16* O1, const bf16* O2, const float* lse, bf16* Y, int bid, int nb) {
    const int ntile = (MROWS / 128) * 16;
    for (int t = bid; t < ntile; t += nb) { const int rt = t / 16, h = t % 16; gemm_tile(sm, DM, rt * 128, ALbf{xb, DM}, BLa1{w, nrm, QKVC + h * 64}, EPa3{ssq, O0, O1, O2, lse, Y, h}); }
}
__device__ __forceinline__ void a2(bf16* QO, const bf16* K, const bf16* V, const float* biasT  , float* lse  , int dil, int gtid, int gthreads) {
    for (int idx = gtid; idx < MROWS * NH; idx += gthreads) {
        const int row = idx >> 4, h = idx & 15, t = row & (SEQ - 1);
        bf16* qp = QO + (size_t)row * DM + h * HD;
        float q[64], o[64];
#pragma unroll
        for (int c = 0; c < 8; ++c) { const v4u w = *(const v4u*)(qp + 8 * c);
#pragma unroll
            for (int i = 0; i < 4; ++i) { q[8 * c + 2 * i] = bflo(w[i]); q[8 * c + 2 * i + 1] = bfhi(w[i]); } }
#pragma unroll
        for (int d = 0; d < 64; ++d) o[d] = 0.f;
        float m = -INFINITY, l = 0.f;
        for (int j = 0; j <= 128; ++j) {
            const int tk = t - dil * j; if (tk < 0) break;
            const size_t ko = (size_t)(row - dil * j) * DM + h * HD;
            float s = 0.f;
#pragma unroll
            for (int c = 0; c < 8; ++c) { const v4u w = *(const v4u*)(K + ko + 8 * c);
#pragma unroll
                for (int i = 0; i < 4; ++i) { s = fmaf(q[8 * c + 2 * i], bflo(w[i]), s); s = fmaf(q[8 * c + 2 * i + 1], bfhi(w[i]), s); } }
            s += biasT[h * 132 + j];
            const float mn = fmaxf(m, s), f = exp2f(m - mn), p = exp2f(s - mn);
            l = l * f + p; m = mn;
#pragma unroll
            for (int c = 0; c < 8; ++c) { const v4u w = *(const v4u*)(V + ko + 8 * c);
#pragma unroll
                for (int i = 0; i < 4; ++i) { o[8 * c + 2 * i] = o[8 * c + 2 * i] * f + p * bflo(w[i]); o[8 * c + 2 * i + 1] = o[8 * c + 2 * i + 1] * f + p * bfhi(w[i]); } }
        }
        const float il = 1.0f / l;
#pragma unroll
        for (int c = 0; c < 8; ++c) { v4u w;
#pragma unroll
            for (int i = 0; i < 4; ++i) w[i] = pk2(o[8 * c + 2 * i] * il, o[8 * c + 2 * i + 1] * il);
            *(v4u*)(qp + 8 * c) = w; }
        lse[(size_t)row * 16 + h] = m + log2f(l);
    }
}
}

template <int MODE> __device__ __forceinline__ int wt_dest_row(int n) {
    if (MODE == 1) { const int type = n >> 11, e = n & 2047, pn = e >> 6, el = e & 63; return 256 * pn + 128 * (type >> 1) + 32 * (el >> 4) + 16 * (type & 1) + (el & 15); }
    if (MODE == 3) { const int blk = n >> 10, r = n & 1023, h = r >> 6, d = r & 63; return blk * 1024 + 256 * (h >> 2) + 128 * (d >> 5) + 32 * (h & 3) + (d & 31); }
    return n;
}
template <int MODE> __device__ __forceinline__ void p0_transpose_item(const float* W, int K, int N, const float* scale, bf16* WT, LAS float* scr, int item, int lane) {
    const int nblk = N / 32, kb = item / nblk, nb = item % nblk, k0 = 64 * kb, n0 = 32 * nb;
#pragma unroll 8
    for (int i = 0; i < 32; ++i) { const int kk = 2 * i + (lane >> 5); const float s = scale ? scale[k0 + kk] : 1.0f; scr[kk * 33 + (lane & 31)] = W[(size_t)(k0 + kk) * N + n0 + (lane & 31)] * s; }
    LDS_WAIT(); asm volatile("" ::: "memory");
    const int c = lane & 7;
#pragma unroll
    for (int j = 0; j < 4; ++j) { const int n = (lane >> 3) + 8 * j; const LAS float* s = scr + (8 * c) * 33 + n;
        v4u o; o.x = pk2(s[0 * 33], s[1 * 33]); o.y = pk2(s[2 * 33], s[3 * 33]); o.z = pk2(s[4 * 33], s[5 * 33]); o.w = pk2(s[6 * 33], s[7 * 33]);
        *(GAS v4u*)(WT + (size_t)wt_dest_row<MODE>(n0 + n) * K + k0 + 8 * c) = o; }
    LDS_WAIT(); asm volatile("" ::: "memory");
}
struct Ptrs {
    const float *x, *conv_norm, *conv_w_in, *conv_w, *conv_w_out, *attn_norm, *attn_w_in, *q_gain, *k_gain, *attn_w_out, *rel_bias;
    float* out; unsigned char* ws;
};
__device__ __forceinline__ void p0_prologue(const Ptrs& P, LAS unsigned char* lds, int vcu, int G, int wave, int lane, int tid) {
    LAS float* scr = (LAS float*)(lds + wave * 16384);
    const int gw = vcu * 8 + wave, NGW = G * 8;
    bf16* W1 = (bf16*)(P.ws + WS_W1); bf16* W2 = (bf16*)(P.ws + WS_W2); bf16* W3 = (bf16*)(P.ws + WS_W3); bf16* W4 = (bf16*)(P.ws + WS_W4);
    constexpr int I1 = (DM / 64) * (CN / 32), I2 = (CE / 64) * (DM / 32), I3 = (DM / 64) * (AN / 32), I4 = (DM / 64) * (DM / 32), IL = I1 + I2 + I3 + I4;
    for (int it = gw; it < 2 * IL; it += NGW) {
        const int j = it / IL; int r = it % IL;
        if (r < I1) { p0_transpose_item<1>(P.conv_w_in + (size_t)j * DM * CN, DM, CN, P.conv_norm + j * DM, W1 + (size_t)j * CN * DM, scr, r, lane); continue; } r -= I1;
        if (r < I2) { p0_transpose_item<0>(P.conv_w_out + (size_t)j * CE * DM, CE, DM, nullptr, W2 + (size_t)j * DM * CE, scr, r, lane); continue; } r -= I2;
        if (r < I3) { p0_transpose_item<3>(P.attn_w_in + (size_t)j * DM * AN, DM, AN, P.attn_norm + j * DM, W3 + (size_t)j * AN * DM, scr, r, lane); continue; } r -= I3;
        p0_transpose_item<0>(P.attn_w_out + (size_t)j * DM * DM, DM, DM, nullptr, W4 + (size_t)j * DM * DM, scr, r, lane);
    }
    bf16* XB = (bf16*)(P.ws + WS_XB); float* SSQ = (float*)(P.ws + WS_SSQ);
    for (int m = gw; m < MROWS; m += NGW) {
        const GAS f32x4* xr = (const GAS f32x4*)(P.x + (size_t)m * DM) + lane;
        GAS v2u* o8 = (GAS v2u*)(XB + (size_t)m * DM) + lane;
        float s = 0.f;
#pragma unroll
        for (int jj = 0; jj < 4; ++jj) { const f32x4 v = xr[64 * jj]; s += (v.x * v.x + v.y * v.y) + (v.z * v.z + v.w * v.w); v2u w; w.x = pk2(v.x, v.y); w.y = pk2(v.z, v.w); o8[64 * jj] = w; }
        s = wave_sum(s);
        if (lane < 16) SSQ[(size_t)m * 16 + lane] = lane == 0 ? s : 0.f;
    }
    float* BT = (float*)(P.ws + WS_BIAS);
    for (int i = vcu * 512 + tid; i < NG * NH * 132; i += G * 512) {
        const int g = i / (NH * 132), r = i % (NH * 132), h = r / 132, st = r % 132;
        const int dil = g == 0 ? 1 : (g == 1 ? 4 : 16);
        BT[i] = st <= 128 ? P.rel_bias[t5_bucket(st * dil) * (NG * NH) + g * NH + h] * LOG2E : 0.f;
    }
}
__device__ __forceinline__ void conv_pass(const bf16* V, bf16* GY, const float* cw  , int gtid, int gthreads) {
    for (int idx = gtid; idx < MROWS * (CE / 8); idx += gthreads) {
        const int row = idx / (CE / 8), e0 = (idx % (CE / 8)) * 8, t = row & (SEQ - 1);
        const size_t o = (size_t)row * CE + e0;
        const v4u g = *(const v4u*)(GY + o), v2 = *(const v4u*)(V + o);
        v4u v1 = (v4u){0u, 0u, 0u, 0u}, v0 = (v4u){0u, 0u, 0u, 0u};
        if (t >= 1) v1 = *(const v4u*)(V + o - CE);
        if (t >= 2) v0 = *(const v4u*)(V + o - 2 * CE);
        float w0[8], w1[8], w2[8];
#pragma unroll
        for (int c = 0; c < 2; ++c) { const f32x4 a = *(const f32x4*)(cw + e0 + 4 * c), b = *(const f32x4*)(cw + CE + e0 + 4 * c), d = *(const f32x4*)(cw + 2 * CE + e0 + 4 * c);
#pragma unroll
            for (int i = 0; i < 4; ++i) { w0[4 * c + i] = a[i]; w1[4 * c + i] = b[i]; w2[4 * c + i] = d[i]; } }
        float y[8];
#pragma unroll
        for (int i = 0; i < 4; ++i) {
            y[2 * i] = bflo(g[i]) * (w0[2 * i] * bflo(v0[i]) + w1[2 * i] * bflo(v1[i]) + w2[2 * i] * bflo(v2[i]));
            y[2 * i + 1] = bfhi(g[i]) * (w0[2 * i + 1] * bfhi(v0[i]) + w1[2 * i + 1] * bfhi(v1[i]) + w2[2 * i + 1] * bfhi(v2[i]));
        }
        v4u w; w.x = pk2(y[0], y[1]); w.y = pk2(y[2], y[3]); w.z = pk2(y[4], y[5]); w.w = pk2(y[6], y[7]);
        *(v4u*)(GY + o) = w;
    }
}

#ifndef OPT_C1
#define OPT_C1 0
#endif
#ifndef OPT_RES
#define OPT_RES 0
#endif
#ifndef OPT_A1
#define OPT_A1 0
#endif
#ifndef OPT_A2
#define OPT_A2 0
#endif
#ifndef OPT_A3
#define OPT_A3 0
#endif
#ifndef MK_PER_PHASE
#define MK_PER_PHASE 1
#endif
constexpr int LDS_BYTES = 155648;
constexpr int MISC_OFF = 151552;
struct Args { const float* in[11]; float* out; unsigned char* ws; int ph_lo, ph_hi; };

__global__ void __launch_bounds__(512, 2) mk_fwd(Args args) {
    extern __shared__ __attribute__((aligned(16))) unsigned char lds_raw[];
    LAS unsigned char* lds = (LAS unsigned char*)lds_raw;
    volatile LAS unsigned* MISC = (volatile LAS unsigned*)(lds + MISC_OFF);
    const int tid = threadIdx.x, lane = tid & 63, wave = __builtin_amdgcn_readfirstlane(tid >> 6);
    const int G = gridDim.x, bx = blockIdx.x, vcu = (G % 8 == 0) ? (bx % 8) * (G / 8) + bx / 8 : bx;
    Ptrs P;
    P.x = args.in[0]; P.conv_norm = args.in[1]; P.conv_w_in = args.in[2]; P.conv_w = args.in[3]; P.conv_w_out = args.in[4]; P.attn_norm = args.in[5];
    P.attn_w_in = args.in[6]; P.q_gain = args.in[7]; P.k_gain = args.in[8]; P.attn_w_out = args.in[9]; P.rel_bias = args.in[10]; P.out = args.out; P.ws = args.ws;
    unsigned char* ws = args.ws;
    gu32* ctl = (gu32*)(ws + WS_CTL);
    for (int u = tid; u < (LDS_BYTES - MISC_OFF) / 4; u += 512) ((LAS unsigned*)(lds + MISC_OFF))[u] = 0u;
    __syncthreads();
    XcdBarrier bar; bar.bar = (unsigned*)(ctl + CW_BAR); bar.x = 0; bar.st = nullptr;
    const bool use_bar = (args.ph_hi - args.ph_lo) > 1;
    if (use_bar) bar = xcd_barrier_post((unsigned*)(ctl + CW_BAR), MISC + 8);

    float* SSQ = (float*)(ws + WS_SSQ); bf16* XB = (bf16*)(ws + WS_XB);
    bf16* CV = (bf16*)(ws + WS_CV); bf16* CG = (bf16*)(ws + WS_CG);
    bf16* KB = (bf16*)(ws + WS_K); bf16* VB = (bf16*)(ws + WS_V); bf16* YB = (bf16*)(ws + WS_Y);
    float* LSE = (float*)(ws + WS_LSE); const float* BT = (const float*)(ws + WS_BIAS);
    LAS float* smf = (LAS float*)lds;
    const int gtid = vcu * 512 + tid, gthreads = G * 512;

    for (int ph = args.ph_lo; ph < args.ph_hi; ++ph) {
        if (ph == 0) { p0_prologue(P, lds, vcu, G, wave, lane, tid); }
        else {
            const int p = ph - 1, j = p / 11, s = p % 11;
            if (s == 0) {
#if OPT_C1
                pg8::Gemm g{XB, (const bf16*)(ws + WS_W1) + (size_t)j * CN * DM, MROWS, CN, DM}; pg8::StaticOrder S; S.init(MROWS, CN, G, bx);
                epi::ConvIn E{SSQ, CV, CG};
                pg8::gemm_phase<epi::ConvIn, pg8::StaticOrder, true, true>(lds, g, S, E);
#else
                naive::c1(smf, XB, SSQ, P.conv_w_in + (size_t)j * DM * CN, P.conv_norm + j * DM, CV, CG, bx, G);
#endif
            } else if (s == 1) {
                conv_pass(CV, CG, P.conv_w + (size_t)j * 3 * CE, gtid, gthreads);
            } else if (s == 2 || s == 10) {
                const bf16* A = s == 2 ? CG : YB; const int K = s == 2 ? CE : DM;
                const float* xin = (j == 0 && s == 2) ? P.x : P.out;
#if OPT_RES
                pg8::Gemm g{A, (const bf16*)(ws + (s == 2 ? WS_W2 : WS_W4)) + (size_t)j * DM * K, MROWS, DM, K}; pg8::StaticOrder S; S.init(MROWS, DM, G, bx);
                epi::Resid E{xin, P.out, XB, SSQ};
                pg8::gemm_phase<epi::Resid, pg8::StaticOrder, false, true>(lds, g, S, E);
#else
                naive::resid(smf, A, K, s == 2 ? P.conv_w_out + (size_t)j * CE * DM : P.attn_w_out + (size_t)j * DM * DM, xin, P.out, XB, SSQ, bx, G);
#endif
            } else if (s == 9) {
                const bf16* O0 = (const bf16*)(ws + WS_QO); const bf16* O1 = O0 + (size_t)MROWS * DM; const bf16* O2 = O1 + (size_t)MROWS * DM;
#if OPT_A3
                pg8::Gemm g{XB, (const bf16*)(ws + WS_W3) + (size_t)j * AN * DM + (size_t)QKVC * DM, MROWS, DM, DM}; pg8::StaticOrder S; S.init(MROWS, DM, G, bx);
                epi::ZMerge E{SSQ, O0, O1, O2, LSE, YB};
                pg8::gemm_phase<epi::ZMerge, pg8::StaticOrder, false, true>(lds, g, S, E);
#else
                naive::a3(smf, XB, SSQ, P.attn_w_in + (size_t)j * DM * AN, P.attn_norm + j * DM, O0, O1, O2, LSE, YB, bx, G);
#endif
            } else {
                const int g = (s - 3) >> 1; bf16* QO = (bf16*)(ws + WS_QO) + (size_t)g * MROWS * DM;
                if (((s - 3) & 1) == 0) {
#if OPT_A1
                    pg8::Gemm gm{XB, (const bf16*)(ws + WS_W3) + (size_t)j * AN * DM + (size_t)g * 3072 * DM, MROWS, 3072, DM}; pg8::StaticOrder S; S.init(MROWS, 3072, G, bx);
                    epi::QKV E{SSQ, QO, KB, VB, P.q_gain + (j * NG + g) * HD, P.k_gain + (j * NG + g) * HD};
                    pg8::gemm_phase<epi::QKV, pg8::StaticOrder, true, true>(lds, gm, S, E);
#else
                    naive::a1(smf, XB, SSQ, P.attn_w_in + (size_t)j * DM * AN, P.attn_norm + j * DM, g, P.q_gain + (j * NG + g) * HD, P.k_gain + (j * NG + g) * HD, QO, KB, VB, bx, G);
#endif
                } else {
                    const int dil = g == 0 ? 1 : (g == 1 ? 4 : 16);
#if OPT_A2
                    attn::phase(lds, QO, KB, VB, BT + g * NH * 132, LSE + (size_t)g * MROWS * 16, dil, vcu, G);
#else
                    naive::a2(QO, KB, VB, BT + g * NH * 132, LSE + (size_t)g * MROWS * 16, dil, gtid, gthreads);
#endif
                }
            }
        }
        if (ph + 1 < args.ph_hi) xcd_barrier(bar);
    }
}

extern "C" void kernel_launch(void* const* d_in, const int* in_sizes, int n_in, void* d_out, int out_size, void* d_ws, size_t ws_size, hipStream_t stream) {
    static int grid = 0;
    if (grid == 0) {
        if (n_in != 11 || in_sizes[0] != MROWS * DM || out_size != MROWS * DM || ws_size < WS_END) { fprintf(stderr, "kernel_launch: unexpected shapes (n_in %d, ws %zu); nothing launched\n", n_in, ws_size); grid = -1; return; }
        int dev = 0, cus = 0, per_cu = 0;
        if (hipGetDevice(&dev) != hipSuccess || hipDeviceGetAttribute(&cus, hipDeviceAttributeMultiprocessorCount, dev) != hipSuccess) { grid = -1; return; }
        if (hipFuncSetAttribute((const void*)mk_fwd, hipFuncAttributeMaxDynamicSharedMemorySize, LDS_BYTES) != hipSuccess) { fprintf(stderr, "kernel_launch: hipFuncSetAttribute failed\n"); grid = -1; return; }
        if (hipOccupancyMaxActiveBlocksPerMultiprocessor(&per_cu, (const void*)mk_fwd, 512, LDS_BYTES) != hipSuccess || per_cu < 1) { fprintf(stderr, "kernel_launch: occupancy query says %d blocks per CU; nothing launched\n", per_cu); (void)hipGetLastError(); grid = -1; return; }
        grid = cus;
    }
    if (grid < 0) return;
    (void)hipMemsetAsync((char*)d_ws + WS_CTL, 0, CTL_ZERO_BYTES, stream);
    Args a{};
    for (int i = 0; i < 11; ++i) a.in[i] = (const float*)d_in[i];
    a.out = (float*)d_out; a.ws = (unsigned char*)d_ws;
#if MK_PER_PHASE
    for (int ph = 0; ph < NPHASE; ++ph) { a.ph_lo = ph; a.ph_hi = ph + 1; hipLaunchKernelGGL(mk_fwd, dim3(grid), dim3(512), LDS_BYTES, stream, a); }
#else
    a.ph_lo = 0; a.ph_hi = NPHASE; hipLaunchKernelGGL(mk_fwd, dim3(grid), dim3(512), LDS_BYTES, stream, a);
#endif
}
```

```cpp
#include <hip/hip_runtime.h>
#include <cstdio>
#include <cstdint>
#include <cmath>
#define MK_PER_PHASE 0
#define OPT_C1 1
#define OPT_RES 1
#define OPT_A1 1
#define OPT_A3 1
namespace pg8 {
#define PG8_LAS __attribute__((address_space(3)))
typedef unsigned short bf16_t;
typedef short bf16x8 __attribute__((ext_vector_type(8)));
typedef float f32x4 __attribute__((ext_vector_type(4)));
typedef unsigned u32x4 __attribute__((ext_vector_type(4)));
constexpr int BM = 256, BK = 64, HALF = 128, HTB = HALF * BK * 2  , STAGE_BYTES = 8 * HTB, NXCD = 8, WGM = 8;

__host__ __device__ __forceinline__ int lds_byte(int r, int c) { const int st = (r >> 4) * 2 + (c >> 5), rr = r & 15, cc = c & 31, ob = rr * 64 + cc * 2; return st * 1024 + (ob ^ (((ob >> 9) & 1) << 5)); }
__host__ __device__ __forceinline__ void stage_rc(int b, int& R, int& C) { const int st = b / 1024, sb = b % 1024, swz = sb ^ (((sb >> 9) & 1) << 5); R = (st >> 1) * 16 + swz / 64; C = (st & 1) * 32 + (swz % 64) / 2; }
__host__ __device__ __forceinline__ int perm32(int rho) { const int n = rho >> 4, i = rho & 15; return 8 * (i >> 2) + 4 * n + (i & 3); }

struct Unit { int pm, pn; };
struct Gemm { const bf16_t* A; const bf16_t* Bt; int M, N, K; };

struct StaticOrder {
    int nM, nN, nwg, G, c;
    __host__ __device__ void init(int M, int N, int G_, int c_) { nM = M / BM; nN = N / BM; nwg = nM * nN; G = G_; c = c_; }
    __host__ __device__ bool next(int i, Unit& u) const {
        const long L = (long)i * G + c; if (L >= nwg) return false;
        int wgid = (int)L; { const int q = nwg / NXCD, r = nwg % NXCD, xcd = wgid % NXCD, off = wgid / NXCD; wgid = (xcd < r ? xcd * (q + 1) : r * (q + 1) + (xcd - r) * q) + off; }
        const int nig = WGM * nN, gid = wgid / nig, fm = gid * WGM, gsz = (nM - fm) < WGM ? (nM - fm) : WGM;
        u.pm = fm + ((wgid % nig) % gsz); u.pn = (wgid % nig) / gsz; return true;
    }
    __device__ __forceinline__ void a_ready(const Unit&) const {}
    __device__ __forceinline__ void done(const Unit&) const {}
};

__device__ __forceinline__ unsigned cvt_pk_bf16(float lo, float hi) { unsigned r; asm volatile("v_cvt_pk_bf16_f32 %0, %1, %2" : "=v"(r) : "v"(lo), "v"(hi)); return r; }
typedef float f32x2 __attribute__((ext_vector_type(2)));

template <class Epi, class Sched, bool ALIGN_EPI = false, bool SP2 = false>
__device__ __forceinline__ void gemm_phase(PG8_LAS unsigned char* lds, const Gemm g, const Sched& S, const Epi& E) {
    const int tid = threadIdx.x, wid = __builtin_amdgcn_readfirstlane(tid >> 6), lane = tid & 63, wr = wid >> 2, wc = wid & 3, fr = lane & 15, fq = lane >> 4;
    const int K = g.K, nt = K / BK;
    unsigned voffA[2], voffB[2];
#pragma unroll
    for (int i = 0; i < 2; ++i) { int R, C; stage_rc(tid * 16 + i * 8192, R, C); const int Rb = Epi::PERM ? ((R & ~31) + perm32(R & 31)) : R;
        voffA[i] = (unsigned)(R * K + C) * 2u; voffB[i] = (unsigned)(Rb * K + C) * 2u; }
    const size_t kstep = (size_t)(BK * 2);
    const size_t hstep = (size_t)HALF * K * 2;
    const size_t tstep = 2 * hstep;
    const unsigned ldsw = (unsigned)wid * 1024u;
    const int aoff = lds_byte(wr * 64 + fr, fq * 8), boff = lds_byte(wc * 32 + fr, fq * 8);
#define PG8_SA(b, h) (((b) * 2 + (h)) * HTB)
#define PG8_SB(b, h) ((4 + (b) * 2 + (h)) * HTB)
#define PG8_STAGE(bufoff, gbase, voff) do { _Pragma("unroll") for (int _i = 0; _i < 2; ++_i) \
        __builtin_amdgcn_global_load_lds((const unsigned*)((const char*)(gbase) + (voff)[_i]), (PG8_LAS unsigned*)(lds + (bufoff) + ldsw + _i * 8192), 16, 0, 0); } while (0)
#define PG8_LDA(dst, b, h) do { _Pragma("unroll") for (int m = 0; m < 4; ++m) _Pragma("unroll") for (int k = 0; k < 2; ++k) dst[m][k] = *(const PG8_LAS bf16x8*)(lds + PG8_SA(b, h) + aoff + m * 2048 + k * 1024); } while (0)
#define PG8_LDB(dst, b, h) do { _Pragma("unroll") for (int n = 0; n < 2; ++n) _Pragma("unroll") for (int k = 0; k < 2; ++k) dst[n][k] = *(const PG8_LAS bf16x8*)(lds + PG8_SB(b, h) + boff + n * 2048 + k * 1024); } while (0)
#define PG8_MMA(ai, bj, At, Bt) do { __builtin_amdgcn_s_setprio(1); _Pragma("unroll") for (int m = 0; m < 4; ++m) _Pragma("unroll") for (int n = 0; n < 2; ++n) _Pragma("unroll") for (int k = 0; k < 2; ++k) \
        acc[ai][bj][m][n] = __builtin_amdgcn_mfma_f32_16x16x32_bf16(Bt[n][k], At[m][k], acc[ai][bj][m][n], 0, 0, 0); __builtin_amdgcn_s_setprio(0); } while (0)
#define PG8_WAIT_V(n) asm volatile("s_waitcnt vmcnt(" #n ")" ::: "memory")
#define PG8_WAIT_L(n) asm volatile("s_waitcnt lgkmcnt(" #n ")" ::: "memory")
#define PG8_BAR __builtin_amdgcn_s_barrier()
#define PG8_SCHED __builtin_amdgcn_sched_barrier(0)
    Unit cur, nxt; int ui = 0;
    if (!S.next(0, cur)) return;
    f32x4 acc[2][2][4][2];
#pragma unroll
    for (int a = 0; a < 2; ++a)
#pragma unroll
        for (int b = 0; b < 2; ++b)
#pragma unroll
            for (int m = 0; m < 4; ++m)
#pragma unroll
                for (int n = 0; n < 2; ++n) acc[a][b][m][n] = (f32x4){0.f, 0.f, 0.f, 0.f};
    bf16x8 At[4][2], B0[2][2], B1[2][2];
    const char* cA = (const char*)g.A + (size_t)cur.pm * tstep; const char* cB = (const char*)g.Bt + (size_t)cur.pn * tstep;
    S.a_ready(cur);
    if constexpr (SP2) {
        PG8_STAGE(PG8_SB(0, 0), cB, voffB); PG8_STAGE(PG8_SB(0, 1), cB + hstep, voffB); PG8_STAGE(PG8_SA(0, 0), cA, voffA); PG8_STAGE(PG8_SA(0, 1), cA + hstep, voffA);
        if (wr == 1) PG8_BAR;
        PG8_WAIT_V(2); PG8_BAR;
        PG8_STAGE(PG8_SB(1, 0), cB + kstep, voffB); PG8_STAGE(PG8_SA(1, 0), cA + kstep, voffA); PG8_STAGE(PG8_SB(1, 1), cB + hstep + kstep, voffB);
        PG8_WAIT_V(6); PG8_BAR;
    } else {
        PG8_STAGE(PG8_SB(0, 0), cB, voffB); PG8_STAGE(PG8_SA(0, 0), cA, voffA); PG8_STAGE(PG8_SB(0, 1), cB + hstep, voffB); PG8_STAGE(PG8_SA(0, 1), cA + hstep, voffA);
        if (wr == 1) PG8_BAR;
        PG8_WAIT_V(4); PG8_BAR;
        PG8_STAGE(PG8_SB(1, 0), cB + kstep, voffB); PG8_STAGE(PG8_SA(1, 0), cA + kstep, voffA); PG8_STAGE(PG8_SB(1, 1), cB + hstep + kstep, voffB);
        PG8_WAIT_V(6); PG8_BAR;
    }
    for (;;) {
        const bool has_next = S.next(ui + 1, nxt);
        const char* nA = has_next ? (const char*)g.A + (size_t)nxt.pm * tstep : cA; const char* nB = has_next ? (const char*)g.Bt + (size_t)nxt.pn * tstep : cB;
        for (int t = 0; t < nt; t += 2) {
            const bool last = (t == nt - 2);
            const char* a1 = cA + (size_t)(t + 1) * kstep;
            const char* a2 = last ? nA : cA + (size_t)(t + 2) * kstep; const char* b2 = last ? nB : cB + (size_t)(t + 2) * kstep;
            const char* a3 = a2 + kstep; const char* b3 = b2 + kstep;
            if (last && has_next) S.a_ready(nxt);
            if constexpr (SP2) {
            PG8_LDB(B0, 0, 0); PG8_LDB(B1, 0, 1); PG8_SCHED; PG8_LDA(At, 0, 0); PG8_STAGE(PG8_SA(1, 1), a1 + hstep, voffA);
            PG8_WAIT_V(8); PG8_WAIT_L(0); PG8_BAR; PG8_MMA(0, 0, At, B0); PG8_MMA(0, 1, At, B1); PG8_BAR; PG8_SCHED;
            PG8_LDA(At, 0, 1); PG8_STAGE(PG8_SB(0, 0), b2, voffB); PG8_STAGE(PG8_SB(0, 1), b2 + hstep, voffB); PG8_STAGE(PG8_SA(0, 0), a2, voffA);
            PG8_WAIT_V(8); PG8_WAIT_L(0); PG8_BAR; PG8_MMA(1, 0, At, B0); PG8_MMA(1, 1, At, B1); PG8_BAR; PG8_SCHED;
            PG8_LDB(B0, 1, 0); PG8_LDB(B1, 1, 1); PG8_SCHED; PG8_LDA(At, 1, 0); PG8_STAGE(PG8_SA(0, 1), a2 + hstep, voffA);
            PG8_WAIT_V(8); PG8_WAIT_L(0); PG8_BAR; PG8_MMA(0, 0, At, B0); PG8_MMA(0, 1, At, B1); PG8_BAR; PG8_SCHED;
            PG8_LDA(At, 1, 1); PG8_STAGE(PG8_SB(1, 0), b3, voffB); PG8_STAGE(PG8_SB(1, 1), b3 + hstep, voffB); PG8_STAGE(PG8_SA(1, 0), a3, voffA);
            PG8_WAIT_V(8); PG8_WAIT_L(0); PG8_BAR; PG8_MMA(1, 0, At, B0); PG8_MMA(1, 1, At, B1); PG8_BAR; PG8_SCHED;
            } else {
            PG8_LDB(B0, 0, 0); PG8_SCHED; PG8_LDA(At, 0, 0); PG8_STAGE(PG8_SA(1, 1), a1 + hstep, voffA);
            PG8_WAIT_L(8); PG8_BAR; PG8_WAIT_L(0); PG8_MMA(0, 0, At, B0); PG8_BAR; PG8_SCHED;
            PG8_LDB(B1, 0, 1); PG8_STAGE(PG8_SB(0, 0), b2, voffB);
            PG8_BAR; PG8_WAIT_L(0); PG8_MMA(0, 1, At, B1); PG8_BAR;
            PG8_LDA(At, 0, 1); PG8_STAGE(PG8_SA(0, 0), a2, voffA);
            PG8_BAR; PG8_WAIT_L(0); PG8_MMA(1, 0, At, B0); PG8_BAR; PG8_SCHED;
            PG8_STAGE(PG8_SB(0, 1), b2 + hstep, voffB);
            PG8_WAIT_V(6); PG8_BAR; PG8_MMA(1, 1, At, B1); PG8_BAR;
            PG8_LDB(B0, 1, 0); PG8_SCHED; PG8_LDA(At, 1, 0); PG8_STAGE(PG8_SA(0, 1), a2 + hstep, voffA);
            PG8_WAIT_L(8); PG8_BAR; PG8_WAIT_L(0); PG8_MMA(0, 0, At, B0); PG8_BAR; PG8_SCHED;
            PG8_LDB(B1, 1, 1); PG8_STAGE(PG8_SB(1, 0), b3, voffB);
            PG8_BAR; PG8_WAIT_L(0); PG8_MMA(0, 1, At, B1); PG8_BAR;
            PG8_LDA(At, 1, 1); PG8_STAGE(PG8_SA(1, 0), a3, voffA);
            PG8_BAR; PG8_WAIT_L(0); PG8_MMA(1, 0, At, B0); PG8_BAR; PG8_SCHED;
            PG8_STAGE(PG8_SB(1, 1), b3 + hstep, voffB);
            PG8_WAIT_V(6); PG8_BAR; PG8_MMA(1, 1, At, B1); PG8_BAR;
            }
        }
        if constexpr (ALIGN_EPI) { if (wr == 0) PG8_BAR; }
        if constexpr (!Epi::AFTER_DRAIN) { E(acc, cur, wr, wc, fr, fq); S.done(cur); }
        if (!has_next) break;
#pragma unroll
        for (int a = 0; a < 2; ++a)
#pragma unroll
            for (int b = 0; b < 2; ++b)
#pragma unroll
                for (int m = 0; m < 4; ++m)
#pragma unroll
                    for (int n = 0; n < 2; ++n) acc[a][b][m][n] = (f32x4){0.f, 0.f, 0.f, 0.f};
        cur = nxt; cA = nA; cB = nB; ++ui;
        if constexpr (ALIGN_EPI) { if (wr == 1) PG8_BAR; }
    }
    PG8_WAIT_V(0);
    if constexpr (!ALIGN_EPI) { if (wr == 0) PG8_BAR; }
    PG8_BAR;
    if constexpr (Epi::AFTER_DRAIN) { E.fused(acc, cur, wr, wc, fr, fq, lds, wid, lane); S.done(cur); }
#undef PG8_SA
#undef PG8_SB
#undef PG8_STAGE
#undef PG8_LDA
#undef PG8_LDB
#undef PG8_MMA
#undef PG8_WAIT_V
#undef PG8_WAIT_L
#undef PG8_BAR
#undef PG8_SCHED
}
}

constexpr int BATCH = 4, SEQ = 4096, DM = 1024, MROWS = BATCH * SEQ;
constexpr int CE = 2048, CN = 4 * CE;
constexpr int NH = 16, HD = 64, NG = 3, QKVC = 9216, AN = 10240;
constexpr float EPS = 1e-6f, LOG2E = 1.4426950408889634f, QSCALE = 0.125f * LOG2E;
constexpr int NPHASE = 23;

constexpr size_t MiB = 1u << 20;
constexpr size_t WS_CTL = 0, CTL_ZERO_BYTES = 1 * MiB;
constexpr size_t WS_SSQ = 1 * MiB;
constexpr size_t WS_W1 = 2 * MiB, WS_W2 = 34 * MiB, WS_W3 = 42 * MiB, WS_W4 = 82 * MiB;
constexpr size_t WS_LSE = 86 * MiB;
constexpr size_t WS_BIAS = 89 * MiB;
constexpr size_t WS_XB = 90 * MiB;
constexpr size_t WS_CV = 122 * MiB, WS_CG = 186 * MiB;
constexpr size_t WS_QO = 122 * MiB;
constexpr size_t WS_K = 218 * MiB, WS_V = 250 * MiB, WS_Y = WS_K;
constexpr size_t WS_END = 282 * MiB;
constexpr int CW_TMO = 0, CW_BAR = 4096;

#define GAS __attribute__((address_space(1)))
#define LAS __attribute__((address_space(3)))
typedef unsigned short bf16;
typedef unsigned v4u __attribute__((ext_vector_type(4)));
typedef unsigned v2u __attribute__((ext_vector_type(2)));
typedef float f32x4 __attribute__((ext_vector_type(4)));
typedef short bf16x8 __attribute__((ext_vector_type(8)));
typedef GAS unsigned gu32;
#define RLX_AGENT __ATOMIC_RELAXED, __HIP_MEMORY_SCOPE_AGENT
#define LDS_WAIT() asm volatile("s_waitcnt lgkmcnt(0)" ::: "memory")
#define VM_WAIT() asm volatile("s_waitcnt vmcnt(0)" ::: "memory")
__device__ __forceinline__ unsigned f2bf(float f) { unsigned u = __builtin_bit_cast(unsigned, f); return (u + 0x7fffu + ((u >> 16) & 1u)) >> 16; }
__device__ __forceinline__ unsigned pk2(float lo, float hi) { return f2bf(lo) | (f2bf(hi) << 16); }
__device__ __forceinline__ float bf2f(unsigned h) { return __builtin_bit_cast(float, h << 16); }
__device__ __forceinline__ float bflo(unsigned w) { return __builtin_bit_cast(float, w << 16); }
__device__ __forceinline__ float bfhi(unsigned w) { return __builtin_bit_cast(float, w & 0xffff0000u); }
__device__ __forceinline__ float sigmoidf_(float z) { return 1.0f / (1.0f + __builtin_amdgcn_exp2f(-z * LOG2E)); }
__device__ __forceinline__ float row_rs(const float* ssq, int row) {
    const f32x4* p = (const f32x4*)(ssq + (size_t)row * 16);
    const f32x4 s = (p[0] + p[1]) + (p[2] + p[3]);
    return 1.0f / sqrtf(((s.x + s.y) + (s.z + s.w)) * (1.0f / DM) + EPS);
}
__device__ __forceinline__ float wave_sum(float v) {
#pragma unroll
    for (int o = 1; o < 64; o <<= 1) v += __shfl_xor(v, o);
    return v;
}
__device__ __forceinline__ int t5_bucket(int d) {
    if (d < 16) return d;
    int b = 15;
    b += (d >= 16); b += (d >= 22); b += (d >= 30); b += (d >= 40); b += (d >= 54); b += (d >= 73); b += (d >= 99); b += (d >= 134);
    b += (d >= 182); b += (d >= 246); b += (d >= 332); b += (d >= 450); b += (d >= 609); b += (d >= 825); b += (d >= 1117); b += (d >= 1513);
    return b;
}

#define XB_TMO      128
#define XB_XCNT(j)  (256  + 64 * (j))
#define XB_XSUB(j)  (1280 + 64 * (j))
#define XB_XGEN(j)  (2304 + 64 * (j))
#define XB_TOP      3328
#define XB_TOPGEN   3392
#define XCD_BAR_WORDS 3456
#define XB_SPIN_CAP (1u << 18)

__device__ __forceinline__ unsigned xb_ld(unsigned* p)              { return __hip_atomic_load(p, __ATOMIC_RELAXED, __HIP_MEMORY_SCOPE_AGENT); }
__device__ __forceinline__ unsigned xb_add(unsigned* p, unsigned v) { return __hip_atomic_fetch_add(p, v, __ATOMIC_RELAXED, __HIP_MEMORY_SCOPE_AGENT); }
__device__ __forceinline__ unsigned xb_xcc_id() { return (unsigned)__builtin_amdgcn_s_getreg((3 << 11) | 20) & 0xFu; }
#define XB_SPIN(cond, bar) do { unsigned _sp = 0; while (cond) { __builtin_amdgcn_s_sleep(1); \
    if ((++_sp & 255u) == 0u) { if (xb_ld(&(bar)[XB_TMO])) break; if (_sp > XB_SPIN_CAP) { atomicAdd(&(bar)[XB_TMO], 1u); break; } } } } while (0)

struct XcdBarrier {
    unsigned* bar; unsigned x;
    volatile LAS unsigned* st;
};

__device__ __forceinline__ XcdBarrier xcd_barrier_post(unsigned* bar, volatile LAS unsigned* st) {
    XcdBarrier b; b.bar = bar; b.x = xb_xcc_id(); b.st = st;
    if (threadIdx.x == 0) (void)xb_add(&bar[XB_XCNT(b.x)], 1u);
    return b;
}
__device__ __forceinline__ void xcd_barrier_complete(unsigned* bar, unsigned x, unsigned& nloc, unsigned& nx) {
    const unsigned G = gridDim.x * gridDim.y * gridDim.z;
    unsigned sum, cnt, mine, sp = 0u;
    for (;;) {
        sum = 0u; cnt = 0u; mine = 0u;
#pragma unroll
        for (unsigned j = 0; j < 16; ++j) { const unsigned c = xb_ld(&bar[XB_XCNT(j)]); sum += c; cnt += (c > 0u) ? 1u : 0u; mine = (j == x) ? c : mine; }
        if (sum == G) break;
        __builtin_amdgcn_s_sleep(1);
        if ((++sp & 255u) == 0u) { if (xb_ld(&bar[XB_TMO])) break; if (sp > XB_SPIN_CAP) { atomicAdd(&bar[XB_TMO], 1u); break; } }
    }
    nloc = mine > 0u ? mine : 1u; nx = cnt > 0u ? cnt : 1u;
}

__device__ __forceinline__ void xcd_barrier(const XcdBarrier& b) {
    asm volatile("s_waitcnt vmcnt(0)" ::: "memory");
    __syncthreads();
    if (threadIdx.x == 0) {
        unsigned* bar = b.bar;
        __builtin_amdgcn_s_waitcnt(0);
        unsigned nloc = b.st[0], nx = b.st[1];
        if (nloc == 0u) { xcd_barrier_complete(bar, b.x, nloc, nx); b.st[0] = nloc; b.st[1] = nx; }
        const unsigned old = xb_add(&bar[XB_XSUB(b.x)], 1u);
        const unsigned gen = old / nloc;
        if (old + 1u == (gen + 1u) * nloc) {
            __builtin_amdgcn_fence(__ATOMIC_RELEASE, "agent");
            asm volatile("s_waitcnt vmcnt(0)" ::: "memory");
            const unsigned og = xb_add(&bar[XB_TOP], 1u);
            const unsigned tg = og / nx;
            if (og + 1u == (tg + 1u) * nx) xb_add(&bar[XB_TOPGEN], 1u);
            else XB_SPIN(xb_ld(&bar[XB_TOPGEN]) == tg, bar);
            __builtin_amdgcn_fence(__ATOMIC_ACQUIRE, "agent");
            xb_add(&bar[XB_XGEN(b.x)], 1u);
            asm volatile("s_waitcnt vmcnt(0)" ::: "memory");
        } else {
            XB_SPIN(xb_ld(&bar[XB_XGEN(b.x)]) == gen, bar);
            __builtin_amdgcn_fence(__ATOMIC_ACQUIRE, "agent");
            asm volatile("s_waitcnt vmcnt(0)" ::: "memory");
        }
    }
    __syncthreads();
}

namespace epi {
using pg8::Unit; using pg8::bf16_t;
struct ConvIn {
    static constexpr bool PERM = false, AFTER_DRAIN = false;
    const float* ssq; bf16_t* V; bf16_t* G;
    __device__ __forceinline__ void operator()(const f32x4 (&acc)[2][2][4][2], const Unit& u, int wr, int wc, int fr, int fq) const {
        const int ch0 = u.pn * 64 + wc * 16 + 4 * fq;
#pragma unroll
        for (int ai = 0; ai < 2; ++ai)
#pragma unroll
            for (int m = 0; m < 4; ++m) {
                const int row = u.pm * 256 + ai * 128 + wr * 64 + m * 16 + fr;
                const float rs = row_rs(ssq, row);
                const f32x4 b = acc[ai][0][m][0] * rs, c = acc[ai][0][m][1] * rs, uu = acc[ai][1][m][0] * rs, z = acc[ai][1][m][1] * rs;
                const f32x4 v = c * uu;
                f32x4 g;
#pragma unroll
                for (int i = 0; i < 4; ++i) g[i] = b[i] * z[i] * sigmoidf_(z[i]);
                v2u wv, wg; wv.x = pk2(v[0], v[1]); wv.y = pk2(v[2], v[3]); wg.x = pk2(g[0], g[1]); wg.y = pk2(g[2], g[3]);
                *(v2u*)(V + (size_t)row * CE + ch0) = wv;
                *(v2u*)(G + (size_t)row * CE + ch0) = wg;
            }
    }
};
struct Resid {
    static constexpr bool PERM = false, AFTER_DRAIN = false;
    const float* xin; float* xout; bf16_t* xb; float* ssq;
    __device__ __forceinline__ void operator()(const f32x4 (&acc)[2][2][4][2], const Unit& u, int wr, int wc, int fr, int fq) const {
        const int col0 = u.pn * 256 + wc * 32 + 4 * fq;
#pragma unroll
        for (int ai = 0; ai < 2; ++ai)
#pragma unroll
            for (int m = 0; m < 4; ++m) {
                const int row = u.pm * 256 + ai * 128 + wr * 64 + m * 16 + fr;
                const size_t off = (size_t)row * DM + col0;
                float ss = 0.f;
#pragma unroll
                for (int bj = 0; bj < 2; ++bj)
#pragma unroll
                    for (int n = 0; n < 2; ++n) {
                        const f32x4 xo = *(const f32x4*)(xin + off + bj * 128 + n * 16);
                        const f32x4 xn = xo + acc[ai][bj][m][n];
                        *(f32x4*)(xout + off + bj * 128 + n * 16) = xn;
                        v2u w; w.x = pk2(xn[0], xn[1]); w.y = pk2(xn[2], xn[3]);
                        *(v2u*)(xb + off + bj * 128 + n * 16) = w;
                        ss += (xn[0] * xn[0] + xn[1] * xn[1]) + (xn[2] * xn[2] + xn[3] * xn[3]);
                    }
                ss += __shfl_xor(ss, 16); ss += __shfl_xor(ss, 32);
                if (fq == 0) ssq[(size_t)row * 16 + u.pn * 4 + wc] = ss;
            }
    }
};
struct QKV {
    static constexpr bool PERM = true, AFTER_DRAIN = false;
    const float* ssq; bf16_t* Q; bf16_t* K; bf16_t* Vv; const float* qg; const float* kg;
    __device__ __forceinline__ void operator()(const f32x4 (&acc)[2][2][4][2], const Unit& u, int wr, int wc, int fr, int fq) const {
        const int which = u.pn >> 2, h = (u.pn & 3) * 4 + wc;
        bf16_t* base = Q + (ptrdiff_t)(which == 1) * (K - Q) + (ptrdiff_t)(which == 2) * (Vv - Q);
        const float* gp = qg + (ptrdiff_t)(which == 1) * (kg - qg); const float gsc = which == 0 ? QSCALE : 1.0f; const bool nrm = which < 2;
        const f32x4 g00 = *(const f32x4*)(gp + 8 * fq), g01 = *(const f32x4*)(gp + 8 * fq + 4), g10 = *(const f32x4*)(gp + 32 + 8 * fq), g11 = *(const f32x4*)(gp + 32 + 8 * fq + 4);
#pragma unroll
        for (int ai = 0; ai < 2; ++ai)
#pragma unroll
            for (int m = 0; m < 4; ++m) {
                const int row = u.pm * 256 + ai * 128 + wr * 64 + m * 16 + fr;
                const float rs = row_rs(ssq, row);
                f32x4 v[2][2]; float ss = 0.f;
#pragma unroll
                for (int bj = 0; bj < 2; ++bj)
#pragma unroll
                    for (int n = 0; n < 2; ++n) { v[bj][n] = acc[ai][bj][m][n] * rs; const f32x4 t = v[bj][n]; ss += (t[0] * t[0] + t[1] * t[1]) + (t[2] * t[2] + t[3] * t[3]); }
                ss += __shfl_xor(ss, 16); ss += __shfl_xor(ss, 32);
                const float rn = gsc / sqrtf(ss * (1.0f / HD) + EPS);
#pragma unroll
                for (int bj = 0; bj < 2; ++bj) {
                    f32x4 a = v[bj][0], b = v[bj][1];
                    if (nrm) { a = a * (bj == 0 ? g00 : g10) * rn; b = b * (bj == 0 ? g01 : g11) * rn; }
                    v4u w; w.x = pk2(a[0], a[1]); w.y = pk2(a[2], a[3]); w.z = pk2(b[0], b[1]); w.w = pk2(b[2], b[3]);
                    *(v4u*)(base + (size_t)row * DM + h * HD + 32 * bj + 8 * fq) = w;
                }
            }
    }
};
struct ZMerge {
    static constexpr bool PERM = true, AFTER_DRAIN = false;
    const float* ssq; const bf16_t* O0; const bf16_t* O1; const bf16_t* O2; const float* lse; bf16_t* Y;
    __device__ __forceinline__ void operator()(const f32x4 (&acc)[2][2][4][2], const Unit& u, int wr, int wc, int fr, int fq) const {
        const int h = u.pn * 4 + wc;
#pragma unroll
        for (int ai = 0; ai < 2; ++ai)
#pragma unroll
            for (int m = 0; m < 4; ++m) {
                const int row = u.pm * 256 + ai * 128 + wr * 64 + m * 16 + fr;
                const float rs = row_rs(ssq, row);
                const float l0 = lse[((size_t)0 * MROWS + row) * 16 + h], l1 = lse[((size_t)1 * MROWS + row) * 16 + h], l2 = lse[((size_t)2 * MROWS + row) * 16 + h];
                const float mx = fmaxf(l0, fmaxf(l1, l2));
                float w0 = __builtin_amdgcn_exp2f(l0 - mx), w1 = __builtin_amdgcn_exp2f(l1 - mx), w2 = __builtin_amdgcn_exp2f(l2 - mx);
                const float inv = 1.0f / (w0 + w1 + w2); w0 *= inv; w1 *= inv; w2 *= inv;
#pragma unroll
                for (int bj = 0; bj < 2; ++bj) {
                    const size_t off = (size_t)row * DM + h * HD + 32 * bj + 8 * fq;
                    const v4u a = *(const v4u*)(O0 + off), b = *(const v4u*)(O1 + off), c = *(const v4u*)(O2 + off);
                    float o[8];
#pragma unroll
                    for (int i = 0; i < 4; ++i) { o[2 * i] = w0 * bflo(a[i]) + w1 * bflo(b[i]) + w2 * bflo(c[i]); o[2 * i + 1] = w0 * bfhi(a[i]) + w1 * bfhi(b[i]) + w2 * bfhi(c[i]); }
                    const f32x4 z0 = acc[ai][bj][m][0] * rs, z1 = acc[ai][bj][m][1] * rs;
                    float y[8];
#pragma unroll
                    for (int i = 0; i < 4; ++i) { y[i] = o[i] * z0[i] * sigmoidf_(z0[i]); y[4 + i] = o[4 + i] * z1[i] * sigmoidf_(z1[i]); }
                    v4u w; w.x = pk2(y[0], y[1]); w.y = pk2(y[2], y[3]); w.z = pk2(y[4], y[5]); w.w = pk2(y[6], y[7]);
                    *(v4u*)(Y + off) = w;
                }
            }
    }
};
}

namespace naive {
template <class AL, class BL, class EP>
__device__ __forceinline__ void gemm_tile(LAS float* sm, int K, int row0, const AL& al, const BL& bl, const EP& ep) {
    const int tid = threadIdx.x, tx = tid & 15, ty = tid >> 4;
    LAS float* sA = sm; LAS float* sB = sm + 16 * 132;
    float acc[4][4];
#pragma unroll
    for (int i = 0; i < 4; ++i)
#pragma unroll
        for (int j = 0; j < 4; ++j) acc[i][j] = 0.f;
    for (int k0 = 0; k0 < K; k0 += 16) {
#pragma unroll
        for (int i = 0; i < 4; ++i) { const int idx = tid + 512 * i, r = idx >> 4, kk = idx & 15; sA[kk * 132 + r] = al(row0 + r, k0 + kk); }
#pragma unroll
        for (int i = 0; i < 2; ++i) { const int idx = tid + 512 * i, kk = idx >> 6, c = idx & 63; sB[kk * 68 + c] = bl(k0 + kk, c); }
        __syncthreads();
#pragma unroll
        for (int kk = 0; kk < 16; ++kk) {
            float a[4], b[4];
#pragma unroll
            for (int i = 0; i < 4; ++i) a[i] = sA[kk * 132 + ty * 4 + i];
#pragma unroll
            for (int j = 0; j < 4; ++j) b[j] = sB[kk * 68 + tx + 16 * j];
#pragma unroll
            for (int i = 0; i < 4; ++i)
#pragma unroll
                for (int j = 0; j < 4; ++j) acc[i][j] = fmaf(a[i], b[j], acc[i][j]);
        }
        __syncthreads();
    }
#pragma unroll
    for (int i = 0; i < 4; ++i) ep(row0 + ty * 4 + i, tx, acc[i][0], acc[i][1], acc[i][2], acc[i][3]);
}
struct ALbf { const bf16* A; int ld; __device__ __forceinline__ float operator()(int r, int k) const { return bf2f(A[(size_t)r * ld + k]); } };
__device__ __forceinline__ float red16(float v) { v += __shfl_xor(v, 1); v += __shfl_xor(v, 2); v += __shfl_xor(v, 4); v += __shfl_xor(v, 8); return v; }

struct BLc1 { const float* w; const float* nrm; int ct; __device__ __forceinline__ float operator()(int k, int c) const { return w[(size_t)k * CN + (c >> 4) * CE + ct * 16 + (c & 15)] * nrm[k]; } };
struct EPc1 { const float* ssq; bf16* V; bf16* G; int ct;
    __device__ __forceinline__ void operator()(int row, int tx, float a0, float a1, float a2, float a3) const {
        const float rs = row_rs(ssq, row); const float b = a0 * rs, c = a1 * rs, u = a2 * rs, z = a3 * rs;
        const int e = ct * 16 + tx; V[(size_t)row * CE + e] = (bf16)f2bf(c * u); G[(size_t)row * CE + e] = (bf16)f2bf(b * z * sigmoidf_(z)); } };
__device__ __forceinline__ void c1(LAS float* sm, const bf16* xb, const float* ssq, const float* w, const float* nrm, bf16* V, bf16* G, int bid, int nb) {
    const int nct = CE / 16, ntile = (MROWS / 128) * nct;
    for (int t = bid; t < ntile; t += nb) { const int rt = t / nct, ct = t % nct; gemm_tile(sm, DM, rt * 128, ALbf{xb, DM}, BLc1{w, nrm, ct}, EPc1{ssq, V, G, ct}); }
}
struct BLres { const float* w; int ct; __device__ __forceinline__ float operator()(int k, int c) const { return w[(size_t)k * DM + ct * 64 + c]; } };
struct EPres { const float* xin; float* xout; bf16* xb; float* ssq; int ct;
    __device__ __forceinline__ void operator()(int row, int tx, float a0, float a1, float a2, float a3) const {
        const size_t o = (size_t)row * DM + ct * 64 + tx;
        const float x0 = xin[o] + a0, x1 = xin[o + 16] + a1, x2 = xin[o + 32] + a2, x3 = xin[o + 48] + a3;
        xout[o] = x0; xout[o + 16] = x1; xout[o + 32] = x2; xout[o + 48] = x3;
        xb[o] = (bf16)f2bf(x0); xb[o + 16] = (bf16)f2bf(x1); xb[o + 32] = (bf16)f2bf(x2); xb[o + 48] = (bf16)f2bf(x3);
        const float ss = red16((x0 * x0 + x1 * x1) + (x2 * x2 + x3 * x3));
        if (tx == 0) ssq[(size_t)row * 16 + ct] = ss; } };
__device__ __forceinline__ void resid(LAS float* sm, const bf16* A, int K, const float* w, const float* xin, float* xout, bf16* xb, float* ssq, int bid, int nb) {
    const int ntile = (MROWS / 128) * 16;
    for (int t = bid; t < ntile; t += nb) { const int rt = t / 16, ct = t % 16; gemm_tile(sm, K, rt * 128, ALbf{A, K}, BLres{w, ct}, EPres{xin, xout, xb, ssq, ct}); }
}
struct BLa1 { const float* w; const float* nrm; int col0; __device__ __forceinline__ float operator()(int k, int c) const { return w[(size_t)k * AN + col0 + c] * nrm[k]; } };
struct EPa1 { const float* ssq; bf16* dst; const float* gain; float sc; int h;
    __device__ __forceinline__ void operator()(int row, int tx, float a0, float a1, float a2, float a3) const {
        const float rs = row_rs(ssq, row); float v0 = a0 * rs, v1 = a1 * rs, v2 = a2 * rs, v3 = a3 * rs;
        const float ss = red16((v0 * v0 + v1 * v1) + (v2 * v2 + v3 * v3));
        if (gain) { const float rn = sc / sqrtf(ss * (1.0f / HD) + EPS); v0 *= rn * gain[tx]; v1 *= rn * gain[tx + 16]; v2 *= rn * gain[tx + 32]; v3 *= rn * gain[tx + 48]; }
        const size_t o = (size_t)row * DM + h * HD + tx;
        dst[o] = (bf16)f2bf(v0); dst[o + 16] = (bf16)f2bf(v1); dst[o + 32] = (bf16)f2bf(v2); dst[o + 48] = (bf16)f2bf(v3); } };
__device__ __forceinline__ void a1(LAS float* sm, const bf16* xb, const float* ssq, const float* w, const float* nrm, int g, const float* qg, const float* kg, bf16* Q, bf16* K, bf16* V, int bid, int nb) {
    const int ntile = (MROWS / 128) * 48;
    for (int t = bid; t < ntile; t += nb) { const int rt = t / 48, ct = t % 48, which = ct / 16, h = ct % 16;
        gemm_tile(sm, DM, rt * 128, ALbf{xb, DM}, BLa1{w, nrm, g * 3072 + which * 1024 + h * 64},
                  EPa1{ssq, which == 0 ? Q : (which == 1 ? K : V), which == 0 ? qg : (which == 1 ? kg : nullptr), which == 0 ? QSCALE : 1.0f, h}); }
}
struct EPa3 { const float* ssq; const bf16* O0; const bf16* O1; const bf16* O2; const float* lse; bf16* Y; int h;
    __device__ __forceinline__ void operator()(int row, int tx, float a0, float a1, float a2, float a3) const {
        const float rs = row_rs(ssq, row);
        const float l0 = lse[((size_t)0 * MROWS + row) * 16 + h], l1 = lse[((size_t)1 * MROWS + row) * 16 + h], l2 = lse[((size_t)2 * MROWS + row) * 16 + h];
        const float mx = fmaxf(l0, fmaxf(l1, l2)); float w0 = exp2f(l0 - mx), w1 = exp2f(l1 - mx), w2 = exp2f(l2 - mx); const float inv = 1.0f / (w0 + w1 + w2); w0 *= inv; w1 *= inv; w2 *= inv;
        const float zz[4] = {a0 * rs, a1 * rs, a2 * rs, a3 * rs};
#pragma unroll
        for (int j = 0; j < 4; ++j) { const size_t o = (size_t)row * DM + h * HD + tx + 16 * j;
            const float ov = w0 * bf2f(O0[o]) + w1 * bf2f(O1[o]) + w2 * bf2f(O2[o]); Y[o] = (bf16)f2bf(ov * zz[j] * sigmoidf_(zz[j])); } } };
__device__ __forceinline__ void a3(LAS float* sm, const bf16* xb, const float* ssq, const float* w, const float* nrm, const bf16* O0, const bf16* O1, const bf16* O2, const float* lse, bf16* Y, int bid, int nb) {
    const int ntile = (MROWS / 128) * 16;
    for (int t = bid; t < ntile; t += nb) { const int rt = t / 16, h = t % 16; gemm_tile(sm, DM, rt * 128, ALbf{xb, DM}, BLa1{w, nrm, QKVC + h * 64}, EPa3{ssq, O0, O1, O2, lse, Y, h}); }
}
__device__ __forceinline__ void a2(bf16* QO, const bf16* K, const bf16* V, const float* biasT  , float* lse  , int dil, int gtid, int gthreads) {
    for (int idx = gtid; idx < MROWS * NH; idx += gthreads) {
        const int row = idx >> 4, h = idx & 15, t = row & (SEQ - 1);
        bf16* qp = QO + (size_t)row * DM + h * HD;
        float q[64], o[64];
#pragma unroll
        for (int c = 0; c < 8; ++c) { const v4u w = *(const v4u*)(qp + 8 * c);
#pragma unroll
            for (int i = 0; i < 4; ++i) { q[8 * c + 2 * i] = bflo(w[i]); q[8 * c + 2 * i + 1] = bfhi(w[i]); } }
#pragma unroll
        for (int d = 0; d < 64; ++d) o[d] = 0.f;
        float m = -INFINITY, l = 0.f;
        for (int j = 0; j <= 128; ++j) {
            const int tk = t - dil * j; if (tk < 0) break;
            const size_t ko = (size_t)(row - dil * j) * DM + h * HD;
            float s = 0.f;
#pragma unroll
            for (int c = 0; c < 8; ++c) { const v4u w = *(const v4u*)(K + ko + 8 * c);
#pragma unroll
                for (int i = 0; i < 4; ++i) { s = fmaf(q[8 * c + 2 * i], bflo(w[i]), s); s = fmaf(q[8 * c + 2 * i + 1], bfhi(w[i]), s); } }
            s += biasT[h * 132 + j];
            const float mn = fmaxf(m, s), f = exp2f(m - mn), p = exp2f(s - mn);
            l = l * f + p; m = mn;
#pragma unroll
            for (int c = 0; c < 8; ++c) { const v4u w = *(const v4u*)(V + ko + 8 * c);
#pragma unroll
                for (int i = 0; i < 4; ++i) { o[8 * c + 2 * i] = o[8 * c + 2 * i] * f + p * bflo(w[i]); o[8 * c + 2 * i + 1] = o[8 * c + 2 * i + 1] * f + p * bfhi(w[i]); } }
        }
        const float il = 1.0f / l;
#pragma unroll
        for (int c = 0; c < 8; ++c) { v4u w;
#pragma unroll
            for (int i = 0; i < 4; ++i) w[i] = pk2(o[8 * c + 2 * i] * il, o[8 * c + 2 * i + 1] * il);
            *(v4u*)(qp + 8 * c) = w; }
        lse[(size_t)row * 16 + h] = m + log2f(l);
    }
}
}

template <int MODE> __device__ __forceinline__ int wt_dest_row(int n) {
    if (MODE == 1) { const int type = n >> 11, e = n & 2047, pn = e >> 6, el = e & 63; return 256 * pn + 128 * (type >> 1) + 32 * (el >> 4) + 16 * (type & 1) + (el & 15); }
    if (MODE == 3) { const int blk = n >> 10, r = n & 1023, h = r >> 6, d = r & 63; return blk * 1024 + 256 * (h >> 2) + 128 * (d >> 5) + 32 * (h & 3) + (d & 31); }
    return n;
}
template <int MODE> __device__ __forceinline__ void p0_transpose_item(const float* W, int K, int N, const float* scale, bf16* WT, LAS float* scr, int item, int lane) {
    const int nblk = N / 32, kb = item / nblk, nb = item % nblk, k0 = 64 * kb, n0 = 32 * nb;
#pragma unroll 8
    for (int i = 0; i < 32; ++i) { const int kk = 2 * i + (lane >> 5); const float s = scale ? scale[k0 + kk] : 1.0f; scr[kk * 33 + (lane & 31)] = W[(size_t)(k0 + kk) * N + n0 + (lane & 31)] * s; }
    LDS_WAIT(); asm volatile("" ::: "memory");
    const int c = lane & 7;
#pragma unroll
    for (int j = 0; j < 4; ++j) { const int n = (lane >> 3) + 8 * j; const LAS float* s = scr + (8 * c) * 33 + n;
        v4u o; o.x = pk2(s[0 * 33], s[1 * 33]); o.y = pk2(s[2 * 33], s[3 * 33]); o.z = pk2(s[4 * 33], s[5 * 33]); o.w = pk2(s[6 * 33], s[7 * 33]);
        *(GAS v4u*)(WT + (size_t)wt_dest_row<MODE>(n0 + n) * K + k0 + 8 * c) = o; }
    LDS_WAIT(); asm volatile("" ::: "memory");
}
struct Ptrs {
    const float *x, *conv_norm, *conv_w_in, *conv_w, *conv_w_out, *attn_norm, *attn_w_in, *q_gain, *k_gain, *attn_w_out, *rel_bias;
    float* out; unsigned char* ws;
};
__device__ __forceinline__ void p0_prologue(const Ptrs& P, LAS unsigned char* lds, int vcu, int G, int wave, int lane, int tid) {
    LAS float* scr = (LAS float*)(lds + wave * 16384);
    const int gw = vcu * 8 + wave, NGW = G * 8;
    bf16* W1 = (bf16*)(P.ws + WS_W1); bf16* W2 = (bf16*)(P.ws + WS_W2); bf16* W3 = (bf16*)(P.ws + WS_W3); bf16* W4 = (bf16*)(P.ws + WS_W4);
    constexpr int I1 = (DM / 64) * (CN / 32), I2 = (CE / 64) * (DM / 32), I3 = (DM / 64) * (AN / 32), I4 = (DM / 64) * (DM / 32), IL = I1 + I2 + I3 + I4;
    for (int it = gw; it < 2 * IL; it += NGW) {
        const int j = it / IL; int r = it % IL;
        if (r < I1) { p0_transpose_item<1>(P.conv_w_in + (size_t)j * DM * CN, DM, CN, P.conv_norm + j * DM, W1 + (size_t)j * CN * DM, scr, r, lane); continue; } r -= I1;
        if (r < I2) { p0_transpose_item<0>(P.conv_w_out + (size_t)j * CE * DM, CE, DM, nullptr, W2 + (size_t)j * DM * CE, scr, r, lane); continue; } r -= I2;
        if (r < I3) { p0_transpose_item<3>(P.attn_w_in + (size_t)j * DM * AN, DM, AN, P.attn_norm + j * DM, W3 + (size_t)j * AN * DM, scr, r, lane); continue; } r -= I3;
        p0_transpose_item<0>(P.attn_w_out + (size_t)j * DM * DM, DM, DM, nullptr, W4 + (size_t)j * DM * DM, scr, r, lane);
    }
    bf16* XB = (bf16*)(P.ws + WS_XB); float* SSQ = (float*)(P.ws + WS_SSQ);
    for (int m = gw; m < MROWS; m += NGW) {
        const GAS f32x4* xr = (const GAS f32x4*)(P.x + (size_t)m * DM) + lane;
        GAS v2u* o8 = (GAS v2u*)(XB + (size_t)m * DM) + lane;
        float s = 0.f;
#pragma unroll
        for (int jj = 0; jj < 4; ++jj) { const f32x4 v = xr[64 * jj]; s += (v.x * v.x + v.y * v.y) + (v.z * v.z + v.w * v.w); v2u w; w.x = pk2(v.x, v.y); w.y = pk2(v.z, v.w); o8[64 * jj] = w; }
        s = wave_sum(s);
        if (lane < 16) SSQ[(size_t)m * 16 + lane] = lane == 0 ? s : 0.f;
    }
    float* BT = (float*)(P.ws + WS_BIAS);
    for (int i = vcu * 512 + tid; i < NG * NH * 132; i += G * 512) {
        const int g = i / (NH * 132), r = i % (NH * 132), h = r / 132, st = r % 132;
        const int dil = g == 0 ? 1 : (g == 1 ? 4 : 16);
        BT[i] = st <= 128 ? P.rel_bias[t5_bucket(st * dil) * (NG * NH) + g * NH + h] * LOG2E : 0.f;
    }
}
__device__ __forceinline__ void conv_pass(const bf16* V, bf16* GY, const float* cw  , int gtid, int gthreads) {
    for (int idx = gtid; idx < MROWS * (CE / 8); idx += gthreads) {
        const int row = idx / (CE / 8), e0 = (idx % (CE / 8)) * 8, t = row & (SEQ - 1);
        const size_t o = (size_t)row * CE + e0;
        const v4u g = *(const v4u*)(GY + o), v2 = *(const v4u*)(V + o);
        v4u v1 = (v4u){0u, 0u, 0u, 0u}, v0 = (v4u){0u, 0u, 0u, 0u};
        if (t >= 1) v1 = *(const v4u*)(V + o - CE);
        if (t >= 2) v0 = *(const v4u*)(V + o - 2 * CE);
        float w0[8], w1[8], w2[8];
#pragma unroll
        for (int c = 0; c < 2; ++c) { const f32x4 a = *(const f32x4*)(cw + e0 + 4 * c), b = *(const f32x4*)(cw + CE + e0 + 4 * c), d = *(const f32x4*)(cw + 2 * CE + e0 + 4 * c);
#pragma unroll
            for (int i = 0; i < 4; ++i) { w0[4 * c + i] = a[i]; w1[4 * c + i] = b[i]; w2[4 * c + i] = d[i]; } }
        float y[8];
#pragma unroll
        for (int i = 0; i < 4; ++i) {
            y[2 * i] = bflo(g[i]) * (w0[2 * i] * bflo(v0[i]) + w1[2 * i] * bflo(v1[i]) + w2[2 * i] * bflo(v2[i]));
            y[2 * i + 1] = bfhi(g[i]) * (w0[2 * i + 1] * bfhi(v0[i]) + w1[2 * i + 1] * bfhi(v1[i]) + w2[2 * i + 1] * bfhi(v2[i]));
        }
        v4u w; w.x = pk2(y[0], y[1]); w.y = pk2(y[2], y[3]); w.z = pk2(y[4], y[5]); w.w = pk2(y[6], y[7]);
        *(v4u*)(GY + o) = w;
    }
}

#ifndef OPT_C1
#define OPT_C1 0
#endif
#ifndef OPT_RES
#define OPT_RES 0
#endif
#ifndef OPT_A1
#define OPT_A1 0
#endif
#ifndef OPT_A2
#define OPT_A2 0
#endif
#ifndef OPT_A3
#define OPT_A3 0
#endif
#ifndef MK_PER_PHASE
#define MK_PER_PHASE 1
#endif
constexpr int LDS_BYTES = 155648;
constexpr int MISC_OFF = 151552;
struct Args { const float* in[11]; float* out; unsigned char* ws; int ph_lo, ph_hi; };

template <int PH> __device__ __forceinline__ void run_phase(const Args& args, LAS unsigned char* lds) {
    const int tid = threadIdx.x, lane = tid & 63, wave = __builtin_amdgcn_readfirstlane(tid >> 6);
    const int G = gridDim.x, bx = blockIdx.x, vcu = (G % 8 == 0) ? (bx % 8) * (G / 8) + bx / 8 : bx;
    unsigned char* ws = args.ws;
    float* SSQ = (float*)(ws + WS_SSQ); bf16* XB = (bf16*)(ws + WS_XB);
    LAS float* smf = (LAS float*)lds;
    const int gtid = vcu * 512 + tid, gthreads = G * 512;
    (void)lane; (void)wave; (void)smf; (void)gtid; (void)gthreads; (void)SSQ; (void)XB;
    if constexpr (PH == 0) {
        Ptrs P;
        P.x = args.in[0]; P.conv_norm = args.in[1]; P.conv_w_in = args.in[2]; P.conv_w = args.in[3]; P.conv_w_out = args.in[4]; P.attn_norm = args.in[5];
        P.attn_w_in = args.in[6]; P.q_gain = args.in[7]; P.k_gain = args.in[8]; P.attn_w_out = args.in[9]; P.rel_bias = args.in[10]; P.out = args.out; P.ws = args.ws;
        p0_prologue(P, lds, vcu, G, wave, lane, tid);
    } else {
        constexpr int p = PH - 1, j = p / 11, s = p % 11;
        if constexpr (s == 0) {
            bf16* CV = (bf16*)(ws + WS_CV); bf16* CG = (bf16*)(ws + WS_CG);
#if OPT_C1
            pg8::Gemm g{XB, (const bf16*)(ws + WS_W1) + (size_t)j * CN * DM, MROWS, CN, DM}; pg8::StaticOrder S; S.init(MROWS, CN, G, bx);
            epi::ConvIn E{SSQ, CV, CG};
            pg8::gemm_phase<epi::ConvIn, pg8::StaticOrder, true, true>(lds, g, S, E);
#else
            naive::c1(smf, XB, SSQ, args.in[2] + (size_t)j * DM * CN, args.in[1] + j * DM, CV, CG, bx, G);
#endif
        } else if constexpr (s == 1) {
            conv_pass((const bf16*)(ws + WS_CV), (bf16*)(ws + WS_CG), args.in[3] + (size_t)j * 3 * CE, gtid, gthreads);
        } else if constexpr (s == 2 || s == 10) {
            const bf16* A = (const bf16*)(ws + (s == 2 ? WS_CG : WS_Y)); constexpr int K = s == 2 ? CE : DM;
            const float* xin = (j == 0 && s == 2) ? args.in[0] : args.out;
#if OPT_RES
            pg8::Gemm g{A, (const bf16*)(ws + (s == 2 ? WS_W2 : WS_W4)) + (size_t)j * DM * K, MROWS, DM, K}; pg8::StaticOrder S; S.init(MROWS, DM, G, bx);
            epi::Resid E{xin, args.out, XB, SSQ};
            pg8::gemm_phase<epi::Resid, pg8::StaticOrder, false, true>(lds, g, S, E);
#else
            naive::resid(smf, A, K, s == 2 ? args.in[4] + (size_t)j * CE * DM : args.in[9] + (size_t)j * DM * DM, xin, args.out, XB, SSQ, bx, G);
#endif
        } else if constexpr (s == 9) {
            const bf16* O0 = (const bf16*)(ws + WS_QO); const bf16* O1 = O0 + (size_t)MROWS * DM; const bf16* O2 = O1 + (size_t)MROWS * DM;
            float* LSE = (float*)(ws + WS_LSE); bf16* YB = (bf16*)(ws + WS_Y);
#if OPT_A3
            pg8::Gemm g{XB, (const bf16*)(ws + WS_W3) + (size_t)j * AN * DM + (size_t)QKVC * DM, MROWS, DM, DM}; pg8::StaticOrder S; S.init(MROWS, DM, G, bx);
            epi::ZMerge E{SSQ, O0, O1, O2, LSE, YB};
            pg8::gemm_phase<epi::ZMerge, pg8::StaticOrder, false, true>(lds, g, S, E);
#else
            naive::a3(smf, XB, SSQ, args.in[6] + (size_t)j * DM * AN, args.in[5] + j * DM, O0, O1, O2, LSE, YB, bx, G);
#endif
        } else {
            constexpr int g = (s - 3) >> 1; bf16* QO = (bf16*)(ws + WS_QO) + (size_t)g * MROWS * DM;
            bf16* KB = (bf16*)(ws + WS_K); bf16* VB = (bf16*)(ws + WS_V);
            if constexpr (((s - 3) & 1) == 0) {
#if OPT_A1
                pg8::Gemm gm{XB, (const bf16*)(ws + WS_W3) + (size_t)j * AN * DM + (size_t)g * 3072 * DM, MROWS, 3072, DM}; pg8::StaticOrder S; S.init(MROWS, 3072, G, bx);
                epi::QKV E{SSQ, QO, KB, VB, args.in[7] + (j * NG + g) * HD, args.in[8] + (j * NG + g) * HD};
                pg8::gemm_phase<epi::QKV, pg8::StaticOrder, true, true>(lds, gm, S, E);
#else
                naive::a1(smf, XB, SSQ, args.in[6] + (size_t)j * DM * AN, args.in[5] + j * DM, g, args.in[7] + (j * NG + g) * HD, args.in[8] + (j * NG + g) * HD, QO, KB, VB, bx, G);
#endif
            } else {
                constexpr int dil = g == 0 ? 1 : (g == 1 ? 4 : 16);
                float* LSE = (float*)(ws + WS_LSE); const float* BT = (const float*)(ws + WS_BIAS);
#if OPT_A2
                attn::phase<dil>(lds, QO, KB, VB, BT + g * NH * 132, LSE + (size_t)g * MROWS * 16, vcu, G);
#else
                naive::a2(QO, KB, VB, BT + g * NH * 132, LSE + (size_t)g * MROWS * 16, dil, gtid, gthreads);
#endif
            }
        }
    }
}

__global__ void __launch_bounds__(512, 2) mk_fwd(Args args) {
    extern __shared__ __attribute__((aligned(16))) unsigned char lds_raw[];
    LAS unsigned char* lds = (LAS unsigned char*)lds_raw;
    volatile LAS unsigned* MISC = (volatile LAS unsigned*)(lds + MISC_OFF);
    for (int u = threadIdx.x; u < (LDS_BYTES - MISC_OFF) / 4; u += 512) ((LAS unsigned*)(lds + MISC_OFF))[u] = 0u;
    __syncthreads();
    gu32* ctl = (gu32*)(args.ws + WS_CTL);
    XcdBarrier bar; bar.bar = (unsigned*)(ctl + CW_BAR); bar.x = 0; bar.st = nullptr;
    const int lo = args.ph_lo, hi = args.ph_hi;
    if (hi - lo > 1) bar = xcd_barrier_post((unsigned*)(ctl + CW_BAR), MISC + 8);
#define RUN(k) if (lo <= (k) && (k) < hi) { run_phase<(k)>(args, lds); if ((k) + 1 < hi) xcd_barrier(bar); }
    RUN(0) RUN(1) RUN(2) RUN(3) RUN(4) RUN(5) RUN(6) RUN(7) RUN(8) RUN(9) RUN(10) RUN(11)
    RUN(12) RUN(13) RUN(14) RUN(15) RUN(16) RUN(17) RUN(18) RUN(19) RUN(20) RUN(21) RUN(22)
#undef RUN
}

extern "C" void kernel_launch(void* const* d_in, const int* in_sizes, int n_in, void* d_out, int out_size, void* d_ws, size_t ws_size, hipStream_t stream) {
    static int grid = 0;
    if (grid == 0) {
        if (n_in != 11 || in_sizes[0] != MROWS * DM || out_size != MROWS * DM || ws_size < WS_END) { fprintf(stderr, "kernel_launch: unexpected shapes (n_in %d, ws %zu); nothing launched\n", n_in, ws_size); grid = -1; return; }
        int dev = 0, cus = 0, per_cu = 0;
        if (hipGetDevice(&dev) != hipSuccess || hipDeviceGetAttribute(&cus, hipDeviceAttributeMultiprocessorCount, dev) != hipSuccess) { grid = -1; return; }
        if (hipFuncSetAttribute((const void*)mk_fwd, hipFuncAttributeMaxDynamicSharedMemorySize, LDS_BYTES) != hipSuccess) { fprintf(stderr, "kernel_launch: hipFuncSetAttribute failed\n"); grid = -1; return; }
        if (hipOccupancyMaxActiveBlocksPerMultiprocessor(&per_cu, (const void*)mk_fwd, 512, LDS_BYTES) != hipSuccess || per_cu < 1) { fprintf(stderr, "kernel_launch: occupancy query says %d blocks per CU; nothing launched\n", per_cu); (void)hipGetLastError(); grid = -1; return; }
        grid = cus;
    }
    if (grid < 0) return;
    (void)hipMemsetAsync((char*)d_ws + WS_CTL, 0, CTL_ZERO_BYTES, stream);
    Args a{};
    for (int i = 0; i < 11; ++i) a.in[i] = (const float*)d_in[i];
    a.out = (float*)d_out; a.ws = (unsigned char*)d_ws;
#if MK_PER_PHASE
    for (int ph = 0; ph < NPHASE; ++ph) { a.ph_lo = ph; a.ph_hi = ph + 1; hipLaunchKernelGGL(mk_fwd, dim3(grid), dim3(512), LDS_BYTES, stream, a); }
#else
    a.ph_lo = 0; a.ph_hi = NPHASE; hipLaunchKernelGGL(mk_fwd, dim3(grid), dim3(512), LDS_BYTES, stream, a);
#endif
}
```

```cpp
#include <hip/hip_runtime.h>
#include <cstdio>
#include <cstdint>
#include <cmath>
#define MK_PER_PHASE 0
#define OPT_C1 1
#define OPT_RES 1
#define OPT_A1 1
#define OPT_A3 1
#define OPT_A2 1
namespace pg8 {
#define PG8_LAS __attribute__((address_space(3)))
typedef unsigned short bf16_t;
typedef short bf16x8 __attribute__((ext_vector_type(8)));
typedef float f32x4 __attribute__((ext_vector_type(4)));
typedef unsigned u32x4 __attribute__((ext_vector_type(4)));
constexpr int BM = 256, BK = 64, HALF = 128, HTB = HALF * BK * 2  , STAGE_BYTES = 8 * HTB, NXCD = 8, WGM = 8;

__host__ __device__ __forceinline__ int lds_byte(int r, int c) { const int st = (r >> 4) * 2 + (c >> 5), rr = r & 15, cc = c & 31, ob = rr * 64 + cc * 2; return st * 1024 + (ob ^ (((ob >> 9) & 1) << 5)); }
__host__ __device__ __forceinline__ void stage_rc(int b, int& R, int& C) { const int st = b / 1024, sb = b % 1024, swz = sb ^ (((sb >> 9) & 1) << 5); R = (st >> 1) * 16 + swz / 64; C = (st & 1) * 32 + (swz % 64) / 2; }
__host__ __device__ __forceinline__ int perm32(int rho) { const int n = rho >> 4, i = rho & 15; return 8 * (i >> 2) + 4 * n + (i & 3); }

struct Unit { int pm, pn; };
struct Gemm { const bf16_t* A; const bf16_t* Bt; int M, N, K; };

struct StaticOrder {
    int nM, nN, nwg, G, c;
    __host__ __device__ void init(int M, int N, int G_, int c_) { nM = M / BM; nN = N / BM; nwg = nM * nN; G = G_; c = c_; }
    __host__ __device__ bool next(int i, Unit& u) const {
        const long L = (long)i * G + c; if (L >= nwg) return false;
        int wgid = (int)L; { const int q = nwg / NXCD, r = nwg % NXCD, xcd = wgid % NXCD, off = wgid / NXCD; wgid = (xcd < r ? xcd * (q + 1) : r * (q + 1) + (xcd - r) * q) + off; }
        const int nig = WGM * nN, gid = wgid / nig, fm = gid * WGM, gsz = (nM - fm) < WGM ? (nM - fm) : WGM;
        u.pm = fm + ((wgid % nig) % gsz); u.pn = (wgid % nig) / gsz; return true;
    }
    __device__ __forceinline__ void a_ready(const Unit&) const {}
    __device__ __forceinline__ void done(const Unit&) const {}
};

__device__ __forceinline__ unsigned cvt_pk_bf16(float lo, float hi) { unsigned r; asm volatile("v_cvt_pk_bf16_f32 %0, %1, %2" : "=v"(r) : "v"(lo), "v"(hi)); return r; }
typedef float f32x2 __attribute__((ext_vector_type(2)));

template <class Epi, class Sched, bool ALIGN_EPI = false, bool SP2 = false>
__device__ __forceinline__ void gemm_phase(PG8_LAS unsigned char* lds, const Gemm g, const Sched& S, const Epi& E) {
    const int tid = threadIdx.x, wid = __builtin_amdgcn_readfirstlane(tid >> 6), lane = tid & 63, wr = wid >> 2, wc = wid & 3, fr = lane & 15, fq = lane >> 4;
    const int K = g.K, nt = K / BK;
    unsigned voffA[2], voffB[2];
#pragma unroll
    for (int i = 0; i < 2; ++i) { int R, C; stage_rc(tid * 16 + i * 8192, R, C); const int Rb = Epi::PERM ? ((R & ~31) + perm32(R & 31)) : R;
        voffA[i] = (unsigned)(R * K + C) * 2u; voffB[i] = (unsigned)(Rb * K + C) * 2u; }
    const size_t kstep = (size_t)(BK * 2);
    const size_t hstep = (size_t)HALF * K * 2;
    const size_t tstep = 2 * hstep;
    const unsigned ldsw = (unsigned)wid * 1024u;
    const int aoff = lds_byte(wr * 64 + fr, fq * 8), boff = lds_byte(wc * 32 + fr, fq * 8);
#define PG8_SA(b, h) (((b) * 2 + (h)) * HTB)
#define PG8_SB(b, h) ((4 + (b) * 2 + (h)) * HTB)
#define PG8_STAGE(bufoff, gbase, voff) do { _Pragma("unroll") for (int _i = 0; _i < 2; ++_i) \
        __builtin_amdgcn_global_load_lds((const unsigned*)((const char*)(gbase) + (voff)[_i]), (PG8_LAS unsigned*)(lds + (bufoff) + ldsw + _i * 8192), 16, 0, 0); } while (0)
#define PG8_LDA(dst, b, h) do { _Pragma("unroll") for (int m = 0; m < 4; ++m) _Pragma("unroll") for (int k = 0; k < 2; ++k) dst[m][k] = *(const PG8_LAS bf16x8*)(lds + PG8_SA(b, h) + aoff + m * 2048 + k * 1024); } while (0)
#define PG8_LDB(dst, b, h) do { _Pragma("unroll") for (int n = 0; n < 2; ++n) _Pragma("unroll") for (int k = 0; k < 2; ++k) dst[n][k] = *(const PG8_LAS bf16x8*)(lds + PG8_SB(b, h) + boff + n * 2048 + k * 1024); } while (0)
#define PG8_MMA(ai, bj, At, Bt) do { __builtin_amdgcn_s_setprio(1); _Pragma("unroll") for (int m = 0; m < 4; ++m) _Pragma("unroll") for (int n = 0; n < 2; ++n) _Pragma("unroll") for (int k = 0; k < 2; ++k) \
        acc[ai][bj][m][n] = __builtin_amdgcn_mfma_f32_16x16x32_bf16(Bt[n][k], At[m][k], acc[ai][bj][m][n], 0, 0, 0); __builtin_amdgcn_s_setprio(0); } while (0)
#define PG8_WAIT_V(n) asm volatile("s_waitcnt vmcnt(" #n ")" ::: "memory")
#define PG8_WAIT_L(n) asm volatile("s_waitcnt lgkmcnt(" #n ")" ::: "memory")
#define PG8_BAR __builtin_amdgcn_s_barrier()
#define PG8_SCHED __builtin_amdgcn_sched_barrier(0)
    Unit cur, nxt; int ui = 0;
    if (!S.next(0, cur)) return;
    f32x4 acc[2][2][4][2];
#pragma unroll
    for (int a = 0; a < 2; ++a)
#pragma unroll
        for (int b = 0; b < 2; ++b)
#pragma unroll
            for (int m = 0; m < 4; ++m)
#pragma unroll
                for (int n = 0; n < 2; ++n) acc[a][b][m][n] = (f32x4){0.f, 0.f, 0.f, 0.f};
    bf16x8 At[4][2], B0[2][2], B1[2][2];
    const char* cA = (const char*)g.A + (size_t)cur.pm * tstep; const char* cB = (const char*)g.Bt + (size_t)cur.pn * tstep;
    S.a_ready(cur);
    if constexpr (SP2) {
        PG8_STAGE(PG8_SB(0, 0), cB, voffB); PG8_STAGE(PG8_SB(0, 1), cB + hstep, voffB); PG8_STAGE(PG8_SA(0, 0), cA, voffA); PG8_STAGE(PG8_SA(0, 1), cA + hstep, voffA);
        if (wr == 1) PG8_BAR;
        PG8_WAIT_V(2); PG8_BAR;
        PG8_STAGE(PG8_SB(1, 0), cB + kstep, voffB); PG8_STAGE(PG8_SA(1, 0), cA + kstep, voffA); PG8_STAGE(PG8_SB(1, 1), cB + hstep + kstep, voffB);
        PG8_WAIT_V(6); PG8_BAR;
    } else {
        PG8_STAGE(PG8_SB(0, 0), cB, voffB); PG8_STAGE(PG8_SA(0, 0), cA, voffA); PG8_STAGE(PG8_SB(0, 1), cB + hstep, voffB); PG8_STAGE(PG8_SA(0, 1), cA + hstep, voffA);
        if (wr == 1) PG8_BAR;
        PG8_WAIT_V(4); PG8_BAR;
        PG8_STAGE(PG8_SB(1, 0), cB + kstep, voffB); PG8_STAGE(PG8_SA(1, 0), cA + kstep, voffA); PG8_STAGE(PG8_SB(1, 1), cB + hstep + kstep, voffB);
        PG8_WAIT_V(6); PG8_BAR;
    }
    for (;;) {
        const bool has_next = S.next(ui + 1, nxt);
        const char* nA = has_next ? (const char*)g.A + (size_t)nxt.pm * tstep : cA; const char* nB = has_next ? (const char*)g.Bt + (size_t)nxt.pn * tstep : cB;
        for (int t = 0; t < nt; t += 2) {
            const bool last = (t == nt - 2);
            const char* a1 = cA + (size_t)(t + 1) * kstep;
            const char* a2 = last ? nA : cA + (size_t)(t + 2) * kstep; const char* b2 = last ? nB : cB + (size_t)(t + 2) * kstep;
            const char* a3 = a2 + kstep; const char* b3 = b2 + kstep;
            if (last && has_next) S.a_ready(nxt);
            if constexpr (SP2) {
            PG8_LDB(B0, 0, 0); PG8_LDB(B1, 0, 1); PG8_SCHED; PG8_LDA(At, 0, 0); PG8_STAGE(PG8_SA(1, 1), a1 + hstep, voffA);
            PG8_WAIT_V(8); PG8_WAIT_L(0); PG8_BAR; PG8_MMA(0, 0, At, B0); PG8_MMA(0, 1, At, B1); PG8_BAR; PG8_SCHED;
            PG8_LDA(At, 0, 1); PG8_STAGE(PG8_SB(0, 0), b2, voffB); PG8_STAGE(PG8_SB(0, 1), b2 + hstep, voffB); PG8_STAGE(PG8_SA(0, 0), a2, voffA);
            PG8_WAIT_V(8); PG8_WAIT_L(0); PG8_BAR; PG8_MMA(1, 0, At, B0); PG8_MMA(1, 1, At, B1); PG8_BAR; PG8_SCHED;
            PG8_LDB(B0, 1, 0); PG8_LDB(B1, 1, 1); PG8_SCHED; PG8_LDA(At, 1, 0); PG8_STAGE(PG8_SA(0, 1), a2 + hstep, voffA);
            PG8_WAIT_V(8); PG8_WAIT_L(0); PG8_BAR; PG8_MMA(0, 0, At, B0); PG8_MMA(0, 1, At, B1); PG8_BAR; PG8_SCHED;
            PG8_LDA(At, 1, 1); PG8_STAGE(PG8_SB(1, 0), b3, voffB); PG8_STAGE(PG8_SB(1, 1), b3 + hstep, voffB); PG8_STAGE(PG8_SA(1, 0), a3, voffA);
            PG8_WAIT_V(8); PG8_WAIT_L(0); PG8_BAR; PG8_MMA(1, 0, At, B0); PG8_MMA(1, 1, At, B1); PG8_BAR; PG8_SCHED;
            } else {
            PG8_LDB(B0, 0, 0); PG8_SCHED; PG8_LDA(At, 0, 0); PG8_STAGE(PG8_SA(1, 1), a1 + hstep, voffA);
            PG8_WAIT_L(8); PG8_BAR; PG8_WAIT_L(0); PG8_MMA(0, 0, At, B0); PG8_BAR; PG8_SCHED;
            PG8_LDB(B1, 0, 1); PG8_STAGE(PG8_SB(0, 0), b2, voffB);
            PG8_BAR; PG8_WAIT_L(0); PG8_MMA(0, 1, At, B1); PG8_BAR;
            PG8_LDA(At, 0, 1); PG8_STAGE(PG8_SA(0, 0), a2, voffA);
            PG8_BAR; PG8_WAIT_L(0); PG8_MMA(1, 0, At, B0); PG8_BAR; PG8_SCHED;
            PG8_STAGE(PG8_SB(0, 1), b2 + hstep, voffB);
            PG8_WAIT_V(6); PG8_BAR; PG8_MMA(1, 1, At, B1); PG8_BAR;
            PG8_LDB(B0, 1, 0); PG8_SCHED; PG8_LDA(At, 1, 0); PG8_STAGE(PG8_SA(0, 1), a2 + hstep, voffA);
            PG8_WAIT_L(8); PG8_BAR; PG8_WAIT_L(0); PG8_MMA(0, 0, At, B0); PG8_BAR; PG8_SCHED;
            PG8_LDB(B1, 1, 1); PG8_STAGE(PG8_SB(1, 0), b3, voffB);
            PG8_BAR; PG8_WAIT_L(0); PG8_MMA(0, 1, At, B1); PG8_BAR;
            PG8_LDA(At, 1, 1); PG8_STAGE(PG8_SA(1, 0), a3, voffA);
            PG8_BAR; PG8_WAIT_L(0); PG8_MMA(1, 0, At, B0); PG8_BAR; PG8_SCHED;
            PG8_STAGE(PG8_SB(1, 1), b3 + hstep, voffB);
            PG8_WAIT_V(6); PG8_BAR; PG8_MMA(1, 1, At, B1); PG8_BAR;
            }
        }
        if constexpr (ALIGN_EPI) { if (wr == 0) PG8_BAR; }
        if constexpr (!Epi::AFTER_DRAIN) { E(acc, cur, wr, wc, fr, fq); S.done(cur); }
        if (!has_next) break;
#pragma unroll
        for (int a = 0; a < 2; ++a)
#pragma unroll
            for (int b = 0; b < 2; ++b)
#pragma unroll
                for (int m = 0; m < 4; ++m)
#pragma unroll
                    for (int n = 0; n < 2; ++n) acc[a][b][m][n] = (f32x4){0.f, 0.f, 0.f, 0.f};
        cur = nxt; cA = nA; cB = nB; ++ui;
        if constexpr (ALIGN_EPI) { if (wr == 1) PG8_BAR; }
    }
    PG8_WAIT_V(0);
    if constexpr (!ALIGN_EPI) { if (wr == 0) PG8_BAR; }
    PG8_BAR;
    if constexpr (Epi::AFTER_DRAIN) { E.fused(acc, cur, wr, wc, fr, fq, lds, wid, lane); S.done(cur); }
#undef PG8_SA
#undef PG8_SB
#undef PG8_STAGE
#undef PG8_LDA
#undef PG8_LDB
#undef PG8_MMA
#undef PG8_WAIT_V
#undef PG8_WAIT_L
#undef PG8_BAR
#undef PG8_SCHED
}
}

constexpr int BATCH = 4, SEQ = 4096, DM = 1024, MROWS = BATCH * SEQ;
constexpr int CE = 2048, CN = 4 * CE;
constexpr int NH = 16, HD = 64, NG = 3, QKVC = 9216, AN = 10240;
constexpr float EPS = 1e-6f, LOG2E = 1.4426950408889634f, QSCALE = 0.125f * LOG2E;
constexpr int NPHASE = 23;

constexpr size_t MiB = 1u << 20;
constexpr size_t WS_CTL = 0, CTL_ZERO_BYTES = 1 * MiB;
constexpr size_t WS_SSQ = 1 * MiB;
constexpr size_t WS_W1 = 2 * MiB, WS_W2 = 34 * MiB, WS_W3 = 42 * MiB, WS_W4 = 82 * MiB;
constexpr size_t WS_LSE = 86 * MiB;
constexpr size_t WS_BIAS = 89 * MiB;
constexpr size_t WS_XB = 90 * MiB;
constexpr size_t WS_CV = 122 * MiB, WS_CG = 186 * MiB;
constexpr size_t WS_QO = 122 * MiB;
constexpr size_t WS_K = 218 * MiB, WS_V = 250 * MiB, WS_Y = WS_K;
constexpr size_t WS_END = 282 * MiB;
constexpr int CW_TMO = 0, CW_BAR = 4096;

#define GAS __attribute__((address_space(1)))
#define LAS __attribute__((address_space(3)))
typedef unsigned short bf16;
typedef unsigned v4u __attribute__((ext_vector_type(4)));
typedef unsigned v2u __attribute__((ext_vector_type(2)));
typedef float f32x4 __attribute__((ext_vector_type(4)));
typedef short bf16x8 __attribute__((ext_vector_type(8)));
typedef GAS unsigned gu32;
#define RLX_AGENT __ATOMIC_RELAXED, __HIP_MEMORY_SCOPE_AGENT
#define LDS_WAIT() asm volatile("s_waitcnt lgkmcnt(0)" ::: "memory")
#define VM_WAIT() asm volatile("s_waitcnt vmcnt(0)" ::: "memory")
__device__ __forceinline__ unsigned f2bf(float f) { unsigned u = __builtin_bit_cast(unsigned, f); return (u + 0x7fffu + ((u >> 16) & 1u)) >> 16; }
__device__ __forceinline__ unsigned pk2(float lo, float hi) { return f2bf(lo) | (f2bf(hi) << 16); }
__device__ __forceinline__ float bf2f(unsigned h) { return __builtin_bit_cast(float, h << 16); }
__device__ __forceinline__ float bflo(unsigned w) { return __builtin_bit_cast(float, w << 16); }
__device__ __forceinline__ float bfhi(unsigned w) { return __builtin_bit_cast(float, w & 0xffff0000u); }
__device__ __forceinline__ float sigmoidf_(float z) { return 1.0f / (1.0f + __builtin_amdgcn_exp2f(-z * LOG2E)); }
__device__ __forceinline__ float row_rs(const float* ssq, int row) {
    const f32x4* p = (const f32x4*)(ssq + (size_t)row * 16);
    const f32x4 s = (p[0] + p[1]) + (p[2] + p[3]);
    return 1.0f / sqrtf(((s.x + s.y) + (s.z + s.w)) * (1.0f / DM) + EPS);
}
__device__ __forceinline__ float wave_sum(float v) {
#pragma unroll
    for (int o = 1; o < 64; o <<= 1) v += __shfl_xor(v, o);
    return v;
}
__device__ __forceinline__ int t5_bucket(int d) {
    if (d < 16) return d;
    int b = 15;
    b += (d >= 16); b += (d >= 22); b += (d >= 30); b += (d >= 40); b += (d >= 54); b += (d >= 73); b += (d >= 99); b += (d >= 134);
    b += (d >= 182); b += (d >= 246); b += (d >= 332); b += (d >= 450); b += (d >= 609); b += (d >= 825); b += (d >= 1117); b += (d >= 1513);
    return b;
}

#define XB_TMO      128
#define XB_XCNT(j)  (256  + 64 * (j))
#define XB_XSUB(j)  (1280 + 64 * (j))
#define XB_XGEN(j)  (2304 + 64 * (j))
#define XB_TOP      3328
#define XB_TOPGEN   3392
#define XCD_BAR_WORDS 3456
#define XB_SPIN_CAP (1u << 18)

__device__ __forceinline__ unsigned xb_ld(unsigned* p)              { return __hip_atomic_load(p, __ATOMIC_RELAXED, __HIP_MEMORY_SCOPE_AGENT); }
__device__ __forceinline__ unsigned xb_add(unsigned* p, unsigned v) { return __hip_atomic_fetch_add(p, v, __ATOMIC_RELAXED, __HIP_MEMORY_SCOPE_AGENT); }
__device__ __forceinline__ unsigned xb_xcc_id() { return (unsigned)__builtin_amdgcn_s_getreg((3 << 11) | 20) & 0xFu; }
#define XB_SPIN(cond, bar) do { unsigned _sp = 0; while (cond) { __builtin_amdgcn_s_sleep(1); \
    if ((++_sp & 255u) == 0u) { if (xb_ld(&(bar)[XB_TMO])) break; if (_sp > XB_SPIN_CAP) { atomicAdd(&(bar)[XB_TMO], 1u); break; } } } } while (0)

struct XcdBarrier {
    unsigned* bar; unsigned x;
    volatile LAS unsigned* st;
};

__device__ __forceinline__ XcdBarrier xcd_barrier_post(unsigned* bar, volatile LAS unsigned* st) {
    XcdBarrier b; b.bar = bar; b.x = xb_xcc_id(); b.st = st;
    if (threadIdx.x == 0) (void)xb_add(&bar[XB_XCNT(b.x)], 1u);
    return b;
}
__device__ __forceinline__ void xcd_barrier_complete(unsigned* bar, unsigned x, unsigned& nloc, unsigned& nx) {
    const unsigned G = gridDim.x * gridDim.y * gridDim.z;
    unsigned sum, cnt, mine, sp = 0u;
    for (;;) {
        sum = 0u; cnt = 0u; mine = 0u;
#pragma unroll
        for (unsigned j = 0; j < 16; ++j) { const unsigned c = xb_ld(&bar[XB_XCNT(j)]); sum += c; cnt += (c > 0u) ? 1u : 0u; mine = (j == x) ? c : mine; }
        if (sum == G) break;
        __builtin_amdgcn_s_sleep(1);
        if ((++sp & 255u) == 0u) { if (xb_ld(&bar[XB_TMO])) break; if (sp > XB_SPIN_CAP) { atomicAdd(&bar[XB_TMO], 1u); break; } }
    }
    nloc = mine > 0u ? mine : 1u; nx = cnt > 0u ? cnt : 1u;
}

__device__ __forceinline__ void xcd_barrier(const XcdBarrier& b) {
    asm volatile("s_waitcnt vmcnt(0)" ::: "memory");
    __syncthreads();
    if (threadIdx.x == 0) {
        unsigned* bar = b.bar;
        __builtin_amdgcn_s_waitcnt(0);
        unsigned nloc = b.st[0], nx = b.st[1];
        if (nloc == 0u) { xcd_barrier_complete(bar, b.x, nloc, nx); b.st[0] = nloc; b.st[1] = nx; }
        const unsigned old = xb_add(&bar[XB_XSUB(b.x)], 1u);
        const unsigned gen = old / nloc;
        if (old + 1u == (gen + 1u) * nloc) {
            __builtin_amdgcn_fence(__ATOMIC_RELEASE, "agent");
            asm volatile("s_waitcnt vmcnt(0)" ::: "memory");
            const unsigned og = xb_add(&bar[XB_TOP], 1u);
            const unsigned tg = og / nx;
            if (og + 1u == (tg + 1u) * nx) xb_add(&bar[XB_TOPGEN], 1u);
            else XB_SPIN(xb_ld(&bar[XB_TOPGEN]) == tg, bar);
            __builtin_amdgcn_fence(__ATOMIC_ACQUIRE, "agent");
            xb_add(&bar[XB_XGEN(b.x)], 1u);
            asm volatile("s_waitcnt vmcnt(0)" ::: "memory");
        } else {
            XB_SPIN(xb_ld(&bar[XB_XGEN(b.x)]) == gen, bar);
            __builtin_amdgcn_fence(__ATOMIC_ACQUIRE, "agent");
            asm volatile("s_waitcnt vmcnt(0)" ::: "memory");
        }
    }
    __syncthreads();
}

namespace epi {
using pg8::Unit; using pg8::bf16_t;
struct ConvIn {
    static constexpr bool PERM = false, AFTER_DRAIN = false;
    const float* ssq; bf16_t* V; bf16_t* G;
    __device__ __forceinline__ void operator()(const f32x4 (&acc)[2][2][4][2], const Unit& u, int wr, int wc, int fr, int fq) const {
        const int ch0 = u.pn * 64 + wc * 16 + 4 * fq;
#pragma unroll
        for (int ai = 0; ai < 2; ++ai)
#pragma unroll
            for (int m = 0; m < 4; ++m) {
                const int row = u.pm * 256 + ai * 128 + wr * 64 + m * 16 + fr;
                const float rs = row_rs(ssq, row);
                const f32x4 b = acc[ai][0][m][0] * rs, c = acc[ai][0][m][1] * rs, uu = acc[ai][1][m][0] * rs, z = acc[ai][1][m][1] * rs;
                const f32x4 v = c * uu;
                f32x4 g;
#pragma unroll
                for (int i = 0; i < 4; ++i) g[i] = b[i] * z[i] * sigmoidf_(z[i]);
                v2u wv, wg; wv.x = pk2(v[0], v[1]); wv.y = pk2(v[2], v[3]); wg.x = pk2(g[0], g[1]); wg.y = pk2(g[2], g[3]);
                *(v2u*)(V + (size_t)row * CE + ch0) = wv;
                *(v2u*)(G + (size_t)row * CE + ch0) = wg;
            }
    }
};
struct Resid {
    static constexpr bool PERM = false, AFTER_DRAIN = false;
    const float* xin; float* xout; bf16_t* xb; float* ssq;
    __device__ __forceinline__ void operator()(const f32x4 (&acc)[2][2][4][2], const Unit& u, int wr, int wc, int fr, int fq) const {
        const int col0 = u.pn * 256 + wc * 32 + 4 * fq;
#pragma unroll
        for (int ai = 0; ai < 2; ++ai)
#pragma unroll
            for (int m = 0; m < 4; ++m) {
                const int row = u.pm * 256 + ai * 128 + wr * 64 + m * 16 + fr;
                const size_t off = (size_t)row * DM + col0;
                float ss = 0.f;
#pragma unroll
                for (int bj = 0; bj < 2; ++bj)
#pragma unroll
                    for (int n = 0; n < 2; ++n) {
                        const f32x4 xo = *(const f32x4*)(xin + off + bj * 128 + n * 16);
                        const f32x4 xn = xo + acc[ai][bj][m][n];
                        *(f32x4*)(xout + off + bj * 128 + n * 16) = xn;
                        v2u w; w.x = pk2(xn[0], xn[1]); w.y = pk2(xn[2], xn[3]);
                        *(v2u*)(xb + off + bj * 128 + n * 16) = w;
                        ss += (xn[0] * xn[0] + xn[1] * xn[1]) + (xn[2] * xn[2] + xn[3] * xn[3]);
                    }
                ss += __shfl_xor(ss, 16); ss += __shfl_xor(ss, 32);
                if (fq == 0) ssq[(size_t)row * 16 + u.pn * 4 + wc] = ss;
            }
    }
};
struct QKV {
    static constexpr bool PERM = true, AFTER_DRAIN = false;
    const float* ssq; bf16_t* Q; bf16_t* K; bf16_t* Vv; const float* qg; const float* kg;
    __device__ __forceinline__ void operator()(const f32x4 (&acc)[2][2][4][2], const Unit& u, int wr, int wc, int fr, int fq) const {
        const int which = u.pn >> 2, h = (u.pn & 3) * 4 + wc;
        bf16_t* base = Q + (ptrdiff_t)(which == 1) * (K - Q) + (ptrdiff_t)(which == 2) * (Vv - Q);
        const float* gp = qg + (ptrdiff_t)(which == 1) * (kg - qg); const float gsc = which == 0 ? QSCALE : 1.0f; const bool nrm = which < 2;
        const f32x4 g00 = *(const f32x4*)(gp + 8 * fq), g01 = *(const f32x4*)(gp + 8 * fq + 4), g10 = *(const f32x4*)(gp + 32 + 8 * fq), g11 = *(const f32x4*)(gp + 32 + 8 * fq + 4);
#pragma unroll
        for (int ai = 0; ai < 2; ++ai)
#pragma unroll
            for (int m = 0; m < 4; ++m) {
                const int row = u.pm * 256 + ai * 128 + wr * 64 + m * 16 + fr;
                const float rs = row_rs(ssq, row);
                f32x4 v[2][2]; float ss = 0.f;
#pragma unroll
                for (int bj = 0; bj < 2; ++bj)
#pragma unroll
                    for (int n = 0; n < 2; ++n) { v[bj][n] = acc[ai][bj][m][n] * rs; const f32x4 t = v[bj][n]; ss += (t[0] * t[0] + t[1] * t[1]) + (t[2] * t[2] + t[3] * t[3]); }
                ss += __shfl_xor(ss, 16); ss += __shfl_xor(ss, 32);
                const float rn = gsc / sqrtf(ss * (1.0f / HD) + EPS);
#pragma unroll
                for (int bj = 0; bj < 2; ++bj) {
                    f32x4 a = v[bj][0], b = v[bj][1];
                    if (nrm) { a = a * (bj == 0 ? g00 : g10) * rn; b = b * (bj == 0 ? g01 : g11) * rn; }
                    v4u w; w.x = pk2(a[0], a[1]); w.y = pk2(a[2], a[3]); w.z = pk2(b[0], b[1]); w.w = pk2(b[2], b[3]);
                    *(v4u*)(base + (size_t)row * DM + h * HD + 32 * bj + 8 * fq) = w;
                }
            }
    }
};
struct ZMerge {
    static constexpr bool PERM = true, AFTER_DRAIN = false;
    const float* ssq; const bf16_t* O0; const bf16_t* O1; const bf16_t* O2; const float* lse; bf16_t* Y;
    __device__ __forceinline__ void operator()(const f32x4 (&acc)[2][2][4][2], const Unit& u, int wr, int wc, int fr, int fq) const {
        const int h = u.pn * 4 + wc;
#pragma unroll
        for (int ai = 0; ai < 2; ++ai)
#pragma unroll
            for (int m = 0; m < 4; ++m) {
                const int row = u.pm * 256 + ai * 128 + wr * 64 + m * 16 + fr;
                const float rs = row_rs(ssq, row);
                const float l0 = lse[((size_t)0 * MROWS + row) * 16 + h], l1 = lse[((size_t)1 * MROWS + row) * 16 + h], l2 = lse[((size_t)2 * MROWS + row) * 16 + h];
                const float mx = fmaxf(l0, fmaxf(l1, l2));
                float w0 = __builtin_amdgcn_exp2f(l0 - mx), w1 = __builtin_amdgcn_exp2f(l1 - mx), w2 = __builtin_amdgcn_exp2f(l2 - mx);
                const float inv = 1.0f / (w0 + w1 + w2); w0 *= inv; w1 *= inv; w2 *= inv;
#pragma unroll
                for (int bj = 0; bj < 2; ++bj) {
                    const size_t off = (size_t)row * DM + h * HD + 32 * bj + 8 * fq;
                    const v4u a = *(const v4u*)(O0 + off), b = *(const v4u*)(O1 + off), c = *(const v4u*)(O2 + off);
                    float o[8];
#pragma unroll
                    for (int i = 0; i < 4; ++i) { o[2 * i] = w0 * bflo(a[i]) + w1 * bflo(b[i]) + w2 * bflo(c[i]); o[2 * i + 1] = w0 * bfhi(a[i]) + w1 * bfhi(b[i]) + w2 * bfhi(c[i]); }
                    const f32x4 z0 = acc[ai][bj][m][0] * rs, z1 = acc[ai][bj][m][1] * rs;
                    float y[8];
#pragma unroll
                    for (int i = 0; i < 4; ++i) { y[i] = o[i] * z0[i] * sigmoidf_(z0[i]); y[4 + i] = o[4 + i] * z1[i] * sigmoidf_(z1[i]); }
                    v4u w; w.x = pk2(y[0], y[1]); w.y = pk2(y[2], y[3]); w.z = pk2(y[4], y[5]); w.w = pk2(y[6], y[7]);
                    *(v4u*)(Y + off) = w;
                }
            }
    }
};
}

namespace naive {
template <class AL, class BL, class EP>
__device__ __forceinline__ void gemm_tile(LAS float* sm, int K, int row0, const AL& al, const BL& bl, const EP& ep) {
    const int tid = threadIdx.x, tx = tid & 15, ty = tid >> 4;
    LAS float* sA = sm; LAS float* sB = sm + 16 * 132;
    float acc[4][4];
#pragma unroll
    for (int i = 0; i < 4; ++i)
#pragma unroll
        for (int j = 0; j < 4; ++j) acc[i][j] = 0.f;
    for (int k0 = 0; k0 < K; k0 += 16) {
#pragma unroll
        for (int i = 0; i < 4; ++i) { const int idx = tid + 512 * i, r = idx >> 4, kk = idx & 15; sA[kk * 132 + r] = al(row0 + r, k0 + kk); }
#pragma unroll
        for (int i = 0; i < 2; ++i) { const int idx = tid + 512 * i, kk = idx >> 6, c = idx & 63; sB[kk * 68 + c] = bl(k0 + kk, c); }
        __syncthreads();
#pragma unroll
        for (int kk = 0; kk < 16; ++kk) {
            float a[4], b[4];
#pragma unroll
            for (int i = 0; i < 4; ++i) a[i] = sA[kk * 132 + ty * 4 + i];
#pragma unroll
            for (int j = 0; j < 4; ++j) b[j] = sB[kk * 68 + tx + 16 * j];
#pragma unroll
            for (int i = 0; i < 4; ++i)
#pragma unroll
                for (int j = 0; j < 4; ++j) acc[i][j] = fmaf(a[i], b[j], acc[i][j]);
        }
        __syncthreads();
    }
#pragma unroll
    for (int i = 0; i < 4; ++i) ep(row0 + ty * 4 + i, tx, acc[i][0], acc[i][1], acc[i][2], acc[i][3]);
}
struct ALbf { const bf16* A; int ld; __device__ __forceinline__ float operator()(int r, int k) const { return bf2f(A[(size_t)r * ld + k]); } };
__device__ __forceinline__ float red16(float v) { v += __shfl_xor(v, 1); v += __shfl_xor(v, 2); v += __shfl_xor(v, 4); v += __shfl_xor(v, 8); return v; }

struct BLc1 { const float* w; const float* nrm; int ct; __device__ __forceinline__ float operator()(int k, int c) const { return w[(size_t)k * CN + (c >> 4) * CE + ct * 16 + (c & 15)] * nrm[k]; } };
struct EPc1 { const float* ssq; bf16* V; bf16* G; int ct;
    __device__ __forceinline__ void operator()(int row, int tx, float a0, float a1, float a2, float a3) const {
        const float rs = row_rs(ssq, row); const float b = a0 * rs, c = a1 * rs, u = a2 * rs, z = a3 * rs;
        const int e = ct * 16 + tx; V[(size_t)row * CE + e] = (bf16)f2bf(c * u); G[(size_t)row * CE + e] = (bf16)f2bf(b * z * sigmoidf_(z)); } };
__device__ __forceinline__ void c1(LAS float* sm, const bf16* xb, const float* ssq, const float* w, const float* nrm, bf16* V, bf16* G, int bid, int nb) {
    const int nct = CE / 16, ntile = (MROWS / 128) * nct;
    for (int t = bid; t < ntile; t += nb) { const int rt = t / nct, ct = t % nct; gemm_tile(sm, DM, rt * 128, ALbf{xb, DM}, BLc1{w, nrm, ct}, EPc1{ssq, V, G, ct}); }
}
struct BLres { const float* w; int ct; __device__ __forceinline__ float operator()(int k, int c) const { return w[(size_t)k * DM + ct * 64 + c]; } };
struct EPres { const float* xin; float* xout; bf16* xb; float* ssq; int ct;
    __device__ __forceinline__ void operator()(int row, int tx, float a0, float a1, float a2, float a3) const {
        const size_t o = (size_t)row * DM + ct * 64 + tx;
        const float x0 = xin[o] + a0, x1 = xin[o + 16] + a1, x2 = xin[o + 32] + a2, x3 = xin[o + 48] + a3;
        xout[o] = x0; xout[o + 16] = x1; xout[o + 32] = x2; xout[o + 48] = x3;
        xb[o] = (bf16)f2bf(x0); xb[o + 16] = (bf16)f2bf(x1); xb[o + 32] = (bf16)f2bf(x2); xb[o + 48] = (bf16)f2bf(x3);
        const float ss = red16((x0 * x0 + x1 * x1) + (x2 * x2 + x3 * x3));
        if (tx == 0) ssq[(size_t)row * 16 + ct] = ss; } };
__device__ __forceinline__ void resid(LAS float* sm, const bf16* A, int K, const float* w, const float* xin, float* xout, bf16* xb, float* ssq, int bid, int nb) {
    const int ntile = (MROWS / 128) * 16;
    for (int t = bid; t < ntile; t += nb) { const int rt = t / 16, ct = t % 16; gemm_tile(sm, K, rt * 128, ALbf{A, K}, BLres{w, ct}, EPres{xin, xout, xb, ssq, ct}); }
}
struct BLa1 { const float* w; const float* nrm; int col0; __device__ __forceinline__ float operator()(int k, int c) const { return w[(size_t)k * AN + col0 + c] * nrm[k]; } };
struct EPa1 { const float* ssq; bf16* dst; const float* gain; float sc; int h;
    __device__ __forceinline__ void operator()(int row, int tx, float a0, float a1, float a2, float a3) const {
        const float rs = row_rs(ssq, row); float v0 = a0 * rs, v1 = a1 * rs, v2 = a2 * rs, v3 = a3 * rs;
        const float ss = red16((v0 * v0 + v1 * v1) + (v2 * v2 + v3 * v3));
        if (gain) { const float rn = sc / sqrtf(ss * (1.0f / HD) + EPS); v0 *= rn * gain[tx]; v1 *= rn * gain[tx + 16]; v2 *= rn * gain[tx + 32]; v3 *= rn * gain[tx + 48]; }
        const size_t o = (size_t)row * DM + h * HD + tx;
        dst[o] = (bf16)f2bf(v0); dst[o + 16] = (bf16)f2bf(v1); dst[o + 32] = (bf16)f2bf(v2); dst[o + 48] = (bf16)f2bf(v3); } };
__device__ __forceinline__ void a1(LAS float* sm, const bf16* xb, const float* ssq, const float* w, const float* nrm, int g, const float* qg, const float* kg, bf16* Q, bf16* K, bf16* V, int bid, int nb) {
    const int ntile = (MROWS / 128) * 48;
    for (int t = bid; t < ntile; t += nb) { const int rt = t / 48, ct = t % 48, which = ct / 16, h = ct % 16;
        gemm_tile(sm, DM, rt * 128, ALbf{xb, DM}, BLa1{w, nrm, g * 3072 + which * 1024 + h * 64},
                  EPa1{ssq, which == 0 ? Q : (which == 1 ? K : V), which == 0 ? qg : (which == 1 ? kg : nullptr), which == 0 ? QSCALE : 1.0f, h}); }
}
struct EPa3 { const float* ssq; const bf16* O0; const bf16* O1; const bf16* O2; const float* lse; bf16* Y; int h;
    __device__ __forceinline__ void operator()(int row, int tx, float a0, float a1, float a2, float a3) const {
        const float rs = row_rs(ssq, row);
        const float l0 = lse[((size_t)0 * MROWS + row) * 16 + h], l1 = lse[((size_t)1 * MROWS + row) * 16 + h], l2 = lse[((size_t)2 * MROWS + row) * 16 + h];
        const float mx = fmaxf(l0, fmaxf(l1, l2)); float w0 = exp2f(l0 - mx), w1 = exp2f(l1 - mx), w2 = exp2f(l2 - mx); const float inv = 1.0f / (w0 + w1 + w2); w0 *= inv; w1 *= inv; w2 *= inv;
        const float zz[4] = {a0 * rs, a1 * rs, a2 * rs, a3 * rs};
#pragma unroll
        for (int j = 0; j < 4; ++j) { const size_t o = (size_t)row * DM + h * HD + tx + 16 * j;
            const float ov = w0 * bf2f(O0[o]) + w1 * bf2f(O1[o]) + w2 * bf2f(O2[o]); Y[o] = (bf16)f2bf(ov * zz[j] * sigmoidf_(zz[j])); } } };
__device__ __forceinline__ void a3(LAS float* sm, const bf16* xb, const float* ssq, const float* w, const float* nrm, const bf16* O0, const bf16* O1, const bf16* O2, const float* lse, bf16* Y, int bid, int nb) {
    const int ntile = (MROWS / 128) * 16;
    for (int t = bid; t < ntile; t += nb) { const int rt = t / 16, h = t % 16; gemm_tile(sm, DM, rt * 128, ALbf{xb, DM}, BLa1{w, nrm, QKVC + h * 64}, EPa3{ssq, O0, O1, O2, lse, Y, h}); }
}
__device__ __forceinline__ void a2(bf16* QO, const bf16* K, const bf16* V, const float* biasT  , float* lse  , int dil, int gtid, int gthreads) {
    for (int idx = gtid; idx < MROWS * NH; idx += gthreads) {
        const int row = idx >> 4, h = idx & 15, t = row & (SEQ - 1);
        bf16* qp = QO + (size_t)row * DM + h * HD;
        float q[64], o[64];
#pragma unroll
        for (int c = 0; c < 8; ++c) { const v4u w = *(const v4u*)(qp + 8 * c);
#pragma unroll
            for (int i = 0; i < 4; ++i) { q[8 * c + 2 * i] = bflo(w[i]); q[8 * c + 2 * i + 1] = bfhi(w[i]); } }
#pragma unroll
        for (int d = 0; d < 64; ++d) o[d] = 0.f;
        float m = -INFINITY, l = 0.f;
        for (int j = 0; j <= 128; ++j) {
            const int tk = t - dil * j; if (tk < 0) break;
            const size_t ko = (size_t)(row - dil * j) * DM + h * HD;
            float s = 0.f;
#pragma unroll
            for (int c = 0; c < 8; ++c) { const v4u w = *(const v4u*)(K + ko + 8 * c);
#pragma unroll
                for (int i = 0; i < 4; ++i) { s = fmaf(q[8 * c + 2 * i], bflo(w[i]), s); s = fmaf(q[8 * c + 2 * i + 1], bfhi(w[i]), s); } }
            s += biasT[h * 132 + j];
            const float mn = fmaxf(m, s), f = exp2f(m - mn), p = exp2f(s - mn);
            l = l * f + p; m = mn;
#pragma unroll
            for (int c = 0; c < 8; ++c) { const v4u w = *(const v4u*)(V + ko + 8 * c);
#pragma unroll
                for (int i = 0; i < 4; ++i) { o[8 * c + 2 * i] = o[8 * c + 2 * i] * f + p * bflo(w[i]); o[8 * c + 2 * i + 1] = o[8 * c + 2 * i + 1] * f + p * bfhi(w[i]); } }
        }
        const float il = 1.0f / l;
#pragma unroll
        for (int c = 0; c < 8; ++c) { v4u w;
#pragma unroll
            for (int i = 0; i < 4; ++i) w[i] = pk2(o[8 * c + 2 * i] * il, o[8 * c + 2 * i + 1] * il);
            *(v4u*)(qp + 8 * c) = w; }
        lse[(size_t)row * 16 + h] = m + log2f(l);
    }
}
}

template <int MODE> __device__ __forceinline__ int wt_dest_row(int n) {
    if (MODE == 1) { const int type = n >> 11, e = n & 2047, pn = e >> 6, el = e & 63; return 256 * pn + 128 * (type >> 1) + 32 * (el >> 4) + 16 * (type & 1) + (el & 15); }
    if (MODE == 3) { const int blk = n >> 10, r = n & 1023, h = r >> 6, d = r & 63; return blk * 1024 + 256 * (h >> 2) + 128 * (d >> 5) + 32 * (h & 3) + (d & 31); }
    return n;
}
template <int MODE> __device__ __forceinline__ void p0_transpose_item(const float* W, int K, int N, const float* scale, bf16* WT, LAS float* scr, int item, int lane) {
    const int nblk = N / 32, kb = item / nblk, nb = item % nblk, k0 = 64 * kb, n0 = 32 * nb;
#pragma unroll 8
    for (int i = 0; i < 32; ++i) { const int kk = 2 * i + (lane >> 5); const float s = scale ? scale[k0 + kk] : 1.0f; scr[kk * 33 + (lane & 31)] = W[(size_t)(k0 + kk) * N + n0 + (lane & 31)] * s; }
    LDS_WAIT(); asm volatile("" ::: "memory");
    const int c = lane & 7;
#pragma unroll
    for (int j = 0; j < 4; ++j) { const int n = (lane >> 3) + 8 * j; const LAS float* s = scr + (8 * c) * 33 + n;
        v4u o; o.x = pk2(s[0 * 33], s[1 * 33]); o.y = pk2(s[2 * 33], s[3 * 33]); o.z = pk2(s[4 * 33], s[5 * 33]); o.w = pk2(s[6 * 33], s[7 * 33]);
        *(GAS v4u*)(WT + (size_t)wt_dest_row<MODE>(n0 + n) * K + k0 + 8 * c) = o; }
    LDS_WAIT(); asm volatile("" ::: "memory");
}
struct Ptrs {
    const float *x, *conv_norm, *conv_w_in, *conv_w, *conv_w_out, *attn_norm, *attn_w_in, *q_gain, *k_gain, *attn_w_out, *rel_bias;
    float* out; unsigned char* ws;
};
__device__ __forceinline__ void p0_prologue(const Ptrs& P, LAS unsigned char* lds, int vcu, int G, int wave, int lane, int tid) {
    LAS float* scr = (LAS float*)(lds + wave * 16384);
    const int gw = vcu * 8 + wave, NGW = G * 8;
    bf16* W1 = (bf16*)(P.ws + WS_W1); bf16* W2 = (bf16*)(P.ws + WS_W2); bf16* W3 = (bf16*)(P.ws + WS_W3); bf16* W4 = (bf16*)(P.ws + WS_W4);
    constexpr int I1 = (DM / 64) * (CN / 32), I2 = (CE / 64) * (DM / 32), I3 = (DM / 64) * (AN / 32), I4 = (DM / 64) * (DM / 32), IL = I1 + I2 + I3 + I4;
    for (int it = gw; it < 2 * IL; it += NGW) {
        const int j = it / IL; int r = it % IL;
        if (r < I1) { p0_transpose_item<1>(P.conv_w_in + (size_t)j * DM * CN, DM, CN, P.conv_norm + j * DM, W1 + (size_t)j * CN * DM, scr, r, lane); continue; } r -= I1;
        if (r < I2) { p0_transpose_item<0>(P.conv_w_out + (size_t)j * CE * DM, CE, DM, nullptr, W2 + (size_t)j * DM * CE, scr, r, lane); continue; } r -= I2;
        if (r < I3) { p0_transpose_item<3>(P.attn_w_in + (size_t)j * DM * AN, DM, AN, P.attn_norm + j * DM, W3 + (size_t)j * AN * DM, scr, r, lane); continue; } r -= I3;
        p0_transpose_item<0>(P.attn_w_out + (size_t)j * DM * DM, DM, DM, nullptr, W4 + (size_t)j * DM * DM, scr, r, lane);
    }
    bf16* XB = (bf16*)(P.ws + WS_XB); float* SSQ = (float*)(P.ws + WS_SSQ);
    for (int m = gw; m < MROWS; m += NGW) {
        const GAS f32x4* xr = (const GAS f32x4*)(P.x + (size_t)m * DM) + lane;
        GAS v2u* o8 = (GAS v2u*)(XB + (size_t)m * DM) + lane;
        float s = 0.f;
#pragma unroll
        for (int jj = 0; jj < 4; ++jj) { const f32x4 v = xr[64 * jj]; s += (v.x * v.x + v.y * v.y) + (v.z * v.z + v.w * v.w); v2u w; w.x = pk2(v.x, v.y); w.y = pk2(v.z, v.w); o8[64 * jj] = w; }
        s = wave_sum(s);
        if (lane < 16) SSQ[(size_t)m * 16 + lane] = lane == 0 ? s : 0.f;
    }
    float* BT = (float*)(P.ws + WS_BIAS);
    for (int i = vcu * 512 + tid; i < NG * NH * 132; i += G * 512) {
        const int g = i / (NH * 132), r = i % (NH * 132), h = r / 132, st = r % 132;
        const int dil = g == 0 ? 1 : (g == 1 ? 4 : 16);
        BT[i] = st <= 128 ? P.rel_bias[t5_bucket(st * dil) * (NG * NH) + g * NH + h] * LOG2E : 0.f;
    }
}
__device__ __forceinline__ void conv_pass(const bf16* V, bf16* GY, const float* cw  , int gtid, int gthreads) {
    for (int idx = gtid; idx < MROWS * (CE / 8); idx += gthreads) {
        const int row = idx / (CE / 8), e0 = (idx % (CE / 8)) * 8, t = row & (SEQ - 1);
        const size_t o = (size_t)row * CE + e0;
        const v4u g = *(const v4u*)(GY + o), v2 = *(const v4u*)(V + o);
        v4u v1 = (v4u){0u, 0u, 0u, 0u}, v0 = (v4u){0u, 0u, 0u, 0u};
        if (t >= 1) v1 = *(const v4u*)(V + o - CE);
        if (t >= 2) v0 = *(const v4u*)(V + o - 2 * CE);
        float w0[8], w1[8], w2[8];
#pragma unroll
        for (int c = 0; c < 2; ++c) { const f32x4 a = *(const f32x4*)(cw + e0 + 4 * c), b = *(const f32x4*)(cw + CE + e0 + 4 * c), d = *(const f32x4*)(cw + 2 * CE + e0 + 4 * c);
#pragma unroll
            for (int i = 0; i < 4; ++i) { w0[4 * c + i] = a[i]; w1[4 * c + i] = b[i]; w2[4 * c + i] = d[i]; } }
        float y[8];
#pragma unroll
        for (int i = 0; i < 4; ++i) {
            y[2 * i] = bflo(g[i]) * (w0[2 * i] * bflo(v0[i]) + w1[2 * i] * bflo(v1[i]) + w2[2 * i] * bflo(v2[i]));
            y[2 * i + 1] = bfhi(g[i]) * (w0[2 * i + 1] * bfhi(v0[i]) + w1[2 * i + 1] * bfhi(v1[i]) + w2[2 * i + 1] * bfhi(v2[i]));
        }
        v4u w; w.x = pk2(y[0], y[1]); w.y = pk2(y[2], y[3]); w.z = pk2(y[4], y[5]); w.w = pk2(y[6], y[7]);
        *(v4u*)(GY + o) = w;
    }
}

namespace attn {
typedef float f32x16 __attribute__((ext_vector_type(16)));
typedef short s16x4 __attribute__((ext_vector_type(4)));
typedef short v4i16_t __attribute__((ext_vector_type(4)));
constexpr int L_K = 0, L_V = 49152, L_B = 98304, L_O = 118784, L_END = 151552, L_WS = 151552 + 256;
static_assert(L_O + 8 * 4096 == L_END && L_B + 5 * 4096 == L_O, "attention LDS map");
__device__ __forceinline__ int crow(int r, int hi) { return (r & 3) + 8 * (r >> 2) + 4 * hi; }
__device__ __forceinline__ s16x4 vtr(LAS const unsigned char* p) { return __builtin_bit_cast(s16x4, __builtin_amdgcn_ds_read_tr16_b64_v4i16((LAS v4i16_t*)p)); }
__device__ __forceinline__ float swapmax(float m) { auto rr = __builtin_amdgcn_permlane32_swap(__float_as_uint(m), __float_as_uint(m), false, false); return fmaxf(__uint_as_float(rr[0]), __uint_as_float(rr[1])); }
__device__ __forceinline__ float swapsum(float m) { auto rr = __builtin_amdgcn_permlane32_swap(__float_as_uint(m), __float_as_uint(m), false, false); return __uint_as_float(rr[0]) + __uint_as_float(rr[1]); }

template <int DIL> __device__ __forceinline__ void phase(LAS unsigned char* lds, bf16* QO, const bf16* Kg, const bf16* Vg, const float* biasT  , float* lse  , int vcu, int G) {
    const int tid = threadIdx.x, lane = tid & 63, r32 = lane & 31, hi = lane >> 5;
    const int w = __builtin_amdgcn_readfirstlane(tid >> 6);
    constexpr int CPC = (SEQ / DIL) / 256;
    constexpr int NJS = BATCH * NH * 16;
    int cur_bh = -1;
    for (int id = vcu * 4; id < NJS; id += ((id & 3) == 3) ? (G * 4 - 3) : 1) {
        const int bh = id >> 4, sub = id & 15, c = sub / CPC, ck = sub % CPC;
        const int b = bh >> 4, h = bh & 15, n0 = ck * 256;
        const size_t rowb = (size_t)b * SEQ;
        if (bh != cur_bh) {
            cur_bh = bh;
#pragma unroll
            for (int i = 0; i < 10; ++i) {
                const int e = tid + 512 * i, j = e >> 10, rem = e & 1023, rg = rem >> 8, ln = (rem & 255) >> 2, i4 = rem & 3;
                const int r = 4 * rg + i4, a = ln & 31, hh = ln >> 5, kk = 32 * j + crow(r, hh), step = 128 + a - kk;
                float val = -INFINITY;
                if (step >= 0 && step <= 128) val = biasT[h * 132 + step];
                ((LAS float*)(lds + L_B))[e] = val;
            }
        }
#pragma unroll
        for (int i = 0; i < 12; ++i) {
            const int p = w * 12 + i;
            if (p < 48) {
                const int ch = p / 6, kb = p % 6;
                int pos = n0 - 128 + kb * 64 + lane; pos = pos < 0 ? 0 : pos;
                const bf16* src = Kg + (rowb + (size_t)pos * DIL + c) * DM + h * HD + ch * 8;
                __builtin_amdgcn_global_load_lds((const unsigned*)src, (LAS unsigned*)(lds + L_K + ch * 6144 + kb * 1024), 16, 0, 0);
            } else {
                const int q = p - 48, d0 = q / 24, vb = q % 24;
                int pos = n0 - 128 + vb * 16 + (lane >> 2); pos = pos < 0 ? 0 : pos;
                const bf16* src = Vg + (rowb + (size_t)pos * DIL + c) * DM + h * HD + d0 * 32 + (lane & 3) * 8;
                __builtin_amdgcn_global_load_lds((const unsigned*)src, (LAS unsigned*)(lds + L_V + d0 * 24576 + vb * 1024), 16, 0, 0);
            }
        }
        const size_t qrow = rowb + (size_t)(n0 + 32 * w + r32) * DIL + c;
        bf16x8 qr[4];
#pragma unroll
        for (int d0 = 0; d0 < 4; ++d0) qr[d0] = *(const bf16x8*)(QO + qrow * DM + h * HD + d0 * 16 + hi * 8);
        asm volatile("s_waitcnt vmcnt(0)" ::: "memory");
        __syncthreads();
        const int jstart = (n0 == 0 && w < 4) ? 4 - w : 0;
        f32x16 S[5];
#pragma unroll
        for (int j = 0; j < 5; ++j) {
            if (j < jstart) {
#pragma unroll
                for (int r = 0; r < 16; ++r) S[j][r] = -INFINITY;
            } else {
                f32x16 cinit;
#pragma unroll
                for (int rg = 0; rg < 4; ++rg) { const f32x4 t = *(const LAS f32x4*)(lds + L_B + j * 4096 + rg * 1024 + lane * 16); cinit[4 * rg] = t[0]; cinit[4 * rg + 1] = t[1]; cinit[4 * rg + 2] = t[2]; cinit[4 * rg + 3] = t[3]; }
#pragma unroll
                for (int d0 = 0; d0 < 4; ++d0) {
                    const bf16x8 kf = *(const LAS bf16x8*)(lds + L_K + (2 * d0 + hi) * 6144 + (32 * w + 32 * j + r32) * 16);
                    cinit = __builtin_amdgcn_mfma_f32_32x32x16_bf16(kf, qr[d0], cinit, 0, 0, 0);
                }
                S[j] = cinit;
            }
        }
        float m = -INFINITY;
#pragma unroll
        for (int j = 0; j < 5; ++j)
#pragma unroll
            for (int r = 0; r < 16; ++r) m = fmaxf(m, S[j][r]);
        m = swapmax(m);
        float lsum = 0.f;
#pragma unroll
        for (int j = 0; j < 5; ++j)
#pragma unroll
            for (int r = 0; r < 16; ++r) { const float p = __builtin_amdgcn_exp2f(S[j][r] - m); S[j][r] = p; lsum += p; }
        lsum = swapsum(lsum);
        f32x16 o[2];
#pragma unroll
        for (int r = 0; r < 16; ++r) { o[0][r] = 0.f; o[1][r] = 0.f; }
        const LAS unsigned char* vbase = lds + L_V + (32 * w + 4 * hi + ((lane & 15) >> 2)) * 64 + ((lane >> 4) & 1) * 32 + (lane & 3) * 8;
#pragma unroll
        for (int j = 0; j < 5; ++j)
#pragma unroll
            for (int s = 0; s < 2; ++s) {
                v4u pw; pw.x = pk2(S[j][8 * s], S[j][8 * s + 1]); pw.y = pk2(S[j][8 * s + 2], S[j][8 * s + 3]); pw.z = pk2(S[j][8 * s + 4], S[j][8 * s + 5]); pw.w = pk2(S[j][8 * s + 6], S[j][8 * s + 7]);
                const bf16x8 pa = __builtin_bit_cast(bf16x8, pw);
#pragma unroll
                for (int d0 = 0; d0 < 2; ++d0) {
                    const s16x4 lo = vtr(vbase + d0 * 24576 + (32 * j + 16 * s) * 64), hh = vtr(vbase + d0 * 24576 + (32 * j + 16 * s + 8) * 64);
                    const bf16x8 vf = (bf16x8){lo[0], lo[1], lo[2], lo[3], hh[0], hh[1], hh[2], hh[3]};
                    o[d0] = __builtin_amdgcn_mfma_f32_32x32x16_bf16(pa, vf, o[d0], 0, 0, 0);
                }
            }
        LAS float* wsf = (LAS float*)(lds + L_WS) + w * 64;
        if (hi == 0) { wsf[r32] = lsum; lse[qrow * 16 + h] = m + log2f(lsum); }
        asm volatile("s_waitcnt lgkmcnt(0)" ::: "memory");
        float rli[16];
#pragma unroll
        for (int r = 0; r < 16; ++r) rli[r] = 1.0f / wsf[crow(r, hi)];
        LAS bf16* stg = (LAS bf16*)(lds + L_O) + w * 2048;
#pragma unroll
        for (int r = 0; r < 16; ++r) { const int orow = crow(r, hi);
#pragma unroll
            for (int d0 = 0; d0 < 2; ++d0) stg[orow * 64 + d0 * 32 + r32] = (bf16)f2bf(o[d0][r] * rli[r]); }
        asm volatile("s_waitcnt lgkmcnt(0)" ::: "memory");
#pragma unroll
        for (int i = 0; i < 4; ++i) { const int row = i * 8 + (lane >> 3), ch = lane & 7; const v4u v = *(const LAS v4u*)(stg + row * 64 + ch * 8);
            *(v4u*)(QO + (rowb + (size_t)(n0 + 32 * w + row) * DIL + c) * DM + h * HD + ch * 8) = v; }
        __syncthreads();
    }
}
}

#ifndef OPT_C1
#define OPT_C1 0
#endif
#ifndef OPT_RES
#define OPT_RES 0
#endif
#ifndef OPT_A1
#define OPT_A1 0
#endif
#ifndef OPT_A2
#define OPT_A2 0
#endif
#ifndef OPT_A3
#define OPT_A3 0
#endif
#ifndef MK_PER_PHASE
#define MK_PER_PHASE 1
#endif
constexpr int LDS_BYTES = 155648;
constexpr int MISC_OFF = 151552;
struct Args { const float* in[11]; float* out; unsigned char* ws; int ph_lo, ph_hi; };

template <int PH> __device__ __forceinline__ void run_phase(const Args& args, LAS unsigned char* lds) {
    const int tid = threadIdx.x, lane = tid & 63, wave = __builtin_amdgcn_readfirstlane(tid >> 6);
    const int G = gridDim.x, bx = blockIdx.x, vcu = (G % 8 == 0) ? (bx % 8) * (G / 8) + bx / 8 : bx;
    unsigned char* ws = args.ws;
    float* SSQ = (float*)(ws + WS_SSQ); bf16* XB = (bf16*)(ws + WS_XB);
    LAS float* smf = (LAS float*)lds;
    const int gtid = vcu * 512 + tid, gthreads = G * 512;
    (void)lane; (void)wave; (void)smf; (void)gtid; (void)gthreads; (void)SSQ; (void)XB;
    if constexpr (PH == 0) {
        Ptrs P;
        P.x = args.in[0]; P.conv_norm = args.in[1]; P.conv_w_in = args.in[2]; P.conv_w = args.in[3]; P.conv_w_out = args.in[4]; P.attn_norm = args.in[5];
        P.attn_w_in = args.in[6]; P.q_gain = args.in[7]; P.k_gain = args.in[8]; P.attn_w_out = args.in[9]; P.rel_bias = args.in[10]; P.out = args.out; P.ws = args.ws;
        p0_prologue(P, lds, vcu, G, wave, lane, tid);
    } else {
        constexpr int p = PH - 1, j = p / 11, s = p % 11;
        if constexpr (s == 0) {
            bf16* CV = (bf16*)(ws + WS_CV); bf16* CG = (bf16*)(ws + WS_CG);
#if OPT_C1
            pg8::Gemm g{XB, (const bf16*)(ws + WS_W1) + (size_t)j * CN * DM, MROWS, CN, DM}; pg8::StaticOrder S; S.init(MROWS, CN, G, bx);
            epi::ConvIn E{SSQ, CV, CG};
            pg8::gemm_phase<epi::ConvIn, pg8::StaticOrder, true, true>(lds, g, S, E);
#else
            naive::c1(smf, XB, SSQ, args.in[2] + (size_t)j * DM * CN, args.in[1] + j * DM, CV, CG, bx, G);
#endif
        } else if constexpr (s == 1) {
            conv_pass((const bf16*)(ws + WS_CV), (bf16*)(ws + WS_CG), args.in[3] + (size_t)j * 3 * CE, gtid, gthreads);
        } else if constexpr (s == 2 || s == 10) {
            const bf16* A = (const bf16*)(ws + (s == 2 ? WS_CG : WS_Y)); constexpr int K = s == 2 ? CE : DM;
            const float* xin = (j == 0 && s == 2) ? args.in[0] : args.out;
#if OPT_RES
            pg8::Gemm g{A, (const bf16*)(ws + (s == 2 ? WS_W2 : WS_W4)) + (size_t)j * DM * K, MROWS, DM, K}; pg8::StaticOrder S; S.init(MROWS, DM, G, bx);
            epi::Resid E{xin, args.out, XB, SSQ};
            pg8::gemm_phase<epi::Resid, pg8::StaticOrder, false, true>(lds, g, S, E);
#else
            naive::resid(smf, A, K, s == 2 ? args.in[4] + (size_t)j * CE * DM : args.in[9] + (size_t)j * DM * DM, xin, args.out, XB, SSQ, bx, G);
#endif
        } else if constexpr (s == 9) {
            const bf16* O0 = (const bf16*)(ws + WS_QO); const bf16* O1 = O0 + (size_t)MROWS * DM; const bf16* O2 = O1 + (size_t)MROWS * DM;
            float* LSE = (float*)(ws + WS_LSE); bf16* YB = (bf16*)(ws + WS_Y);
#if OPT_A3
            pg8::Gemm g{XB, (const bf16*)(ws + WS_W3) + (size_t)j * AN * DM + (size_t)QKVC * DM, MROWS, DM, DM}; pg8::StaticOrder S; S.init(MROWS, DM, G, bx);
            epi::ZMerge E{SSQ, O0, O1, O2, LSE, YB};
            pg8::gemm_phase<epi::ZMerge, pg8::StaticOrder, false, true>(lds, g, S, E);
#else
            naive::a3(smf, XB, SSQ, args.in[6] + (size_t)j * DM * AN, args.in[5] + j * DM, O0, O1, O2, LSE, YB, bx, G);
#endif
        } else {
            constexpr int g = (s - 3) >> 1; bf16* QO = (bf16*)(ws + WS_QO) + (size_t)g * MROWS * DM;
            bf16* KB = (bf16*)(ws + WS_K); bf16* VB = (bf16*)(ws + WS_V);
            if constexpr (((s - 3) & 1) == 0) {
#if OPT_A1
                pg8::Gemm gm{XB, (const bf16*)(ws + WS_W3) + (size_t)j * AN * DM + (size_t)g * 3072 * DM, MROWS, 3072, DM}; pg8::StaticOrder S; S.init(MROWS, 3072, G, bx);
                epi::QKV E{SSQ, QO, KB, VB, args.in[7] + (j * NG + g) * HD, args.in[8] + (j * NG + g) * HD};
                pg8::gemm_phase<epi::QKV, pg8::StaticOrder, true, true>(lds, gm, S, E);
#else
                naive::a1(smf, XB, SSQ, args.in[6] + (size_t)j * DM * AN, args.in[5] + j * DM, g, args.in[7] + (j * NG + g) * HD, args.in[8] + (j * NG + g) * HD, QO, KB, VB, bx, G);
#endif
            } else {
                constexpr int dil = g == 0 ? 1 : (g == 1 ? 4 : 16);
                float* LSE = (float*)(ws + WS_LSE); const float* BT = (const float*)(ws + WS_BIAS);
#if OPT_A2
                attn::phase<dil>(lds, QO, KB, VB, BT + g * NH * 132, LSE + (size_t)g * MROWS * 16, vcu, G);
#else
                naive::a2(QO, KB, VB, BT + g * NH * 132, LSE + (size_t)g * MROWS * 16, dil, gtid, gthreads);
#endif
            }
        }
    }
}

__global__ void __launch_bounds__(512, 2) mk_fwd(Args args) {
    extern __shared__ __attribute__((aligned(16))) unsigned char lds_raw[];
    LAS unsigned char* lds = (LAS unsigned char*)lds_raw;
    volatile LAS unsigned* MISC = (volatile LAS unsigned*)(lds + MISC_OFF);
    for (int u = threadIdx.x; u < (LDS_BYTES - MISC_OFF) / 4; u += 512) ((LAS unsigned*)(lds + MISC_OFF))[u] = 0u;
    __syncthreads();
    gu32* ctl = (gu32*)(args.ws + WS_CTL);
    XcdBarrier bar; bar.bar = (unsigned*)(ctl + CW_BAR); bar.x = 0; bar.st = nullptr;
    const int lo = args.ph_lo, hi = args.ph_hi;
    if (hi - lo > 1) bar = xcd_barrier_post((unsigned*)(ctl + CW_BAR), MISC + 8);
#define RUN(k) if (lo <= (k) && (k) < hi) { run_phase<(k)>(args, lds); if ((k) + 1 < hi) xcd_barrier(bar); }
    RUN(0) RUN(1) RUN(2) RUN(3) RUN(4) RUN(5) RUN(6) RUN(7) RUN(8) RUN(9) RUN(10) RUN(11)
    RUN(12) RUN(13) RUN(14) RUN(15) RUN(16) RUN(17) RUN(18) RUN(19) RUN(20) RUN(21) RUN(22)
#undef RUN
}

extern "C" void kernel_launch(void* const* d_in, const int* in_sizes, int n_in, void* d_out, int out_size, void* d_ws, size_t ws_size, hipStream_t stream) {
    static int grid = 0;
    if (grid == 0) {
        if (n_in != 11 || in_sizes[0] != MROWS * DM || out_size != MROWS * DM || ws_size < WS_END) { fprintf(stderr, "kernel_launch: unexpected shapes (n_in %d, ws %zu); nothing launched\n", n_in, ws_size); grid = -1; return; }
        int dev = 0, cus = 0, per_cu = 0;
        if (hipGetDevice(&dev) != hipSuccess || hipDeviceGetAttribute(&cus, hipDeviceAttributeMultiprocessorCount, dev) != hipSuccess) { grid = -1; return; }
        if (hipFuncSetAttribute((const void*)mk_fwd, hipFuncAttributeMaxDynamicSharedMemorySize, LDS_BYTES) != hipSuccess) { fprintf(stderr, "kernel_launch: hipFuncSetAttribute failed\n"); grid = -1; return; }
        if (hipOccupancyMaxActiveBlocksPerMultiprocessor(&per_cu, (const void*)mk_fwd, 512, LDS_BYTES) != hipSuccess || per_cu < 1) { fprintf(stderr, "kernel_launch: occupancy query says %d blocks per CU; nothing launched\n", per_cu); (void)hipGetLastError(); grid = -1; return; }
        grid = cus;
    }
    if (grid < 0) return;
    (void)hipMemsetAsync((char*)d_ws + WS_CTL, 0, CTL_ZERO_BYTES, stream);
    Args a{};
    for (int i = 0; i < 11; ++i) a.in[i] = (const float*)d_in[i];
    a.out = (float*)d_out; a.ws = (unsigned char*)d_ws;
#if MK_PER_PHASE
    for (int ph = 0; ph < NPHASE; ++ph) { a.ph_lo = ph; a.ph_hi = ph + 1; hipLaunchKernelGGL(mk_fwd, dim3(grid), dim3(512), LDS_BYTES, stream, a); }
#else
    a.ph_lo = 0; a.ph_hi = NPHASE; hipLaunchKernelGGL(mk_fwd, dim3(grid), dim3(512), LDS_BYTES, stream, a);
#endif
}
```

```cpp
#include <hip/hip_runtime.h>
#include <cstdio>
#include <cstdint>
#include <cmath>
#define MK_PER_PHASE 0
#define OPT_C1 1
#define OPT_RES 1
#define OPT_A1 1
#define OPT_A3 1
#define OPT_A2 1
namespace pg8 {
#define PG8_LAS __attribute__((address_space(3)))
typedef unsigned short bf16_t;
typedef short bf16x8 __attribute__((ext_vector_type(8)));
typedef float f32x4 __attribute__((ext_vector_type(4)));
typedef unsigned u32x4 __attribute__((ext_vector_type(4)));
constexpr int BM = 256, BK = 64, HALF = 128, HTB = HALF * BK * 2  , STAGE_BYTES = 8 * HTB, NXCD = 8, WGM = 8;

__host__ __device__ __forceinline__ int lds_byte(int r, int c) { const int st = (r >> 4) * 2 + (c >> 5), rr = r & 15, cc = c & 31, ob = rr * 64 + cc * 2; return st * 1024 + (ob ^ (((ob >> 9) & 1) << 5)); }
__host__ __device__ __forceinline__ void stage_rc(int b, int& R, int& C) { const int st = b / 1024, sb = b % 1024, swz = sb ^ (((sb >> 9) & 1) << 5); R = (st >> 1) * 16 + swz / 64; C = (st & 1) * 32 + (swz % 64) / 2; }
__host__ __device__ __forceinline__ int perm32(int rho) { const int n = rho >> 4, i = rho & 15; return 8 * (i >> 2) + 4 * n + (i & 3); }

struct Unit { int pm, pn; };
struct Gemm { const bf16_t* A; const bf16_t* Bt; int M, N, K; };

struct StaticOrder {
    int nM, nN, nwg, G, c;
    __host__ __device__ void init(int M, int N, int G_, int c_) { nM = M / BM; nN = N / BM; nwg = nM * nN; G = G_; c = c_; }
    __host__ __device__ bool next(int i, Unit& u) const {
        const long L = (long)i * G + c; if (L >= nwg) return false;
        int wgid = (int)L; { const int q = nwg / NXCD, r = nwg % NXCD, xcd = wgid % NXCD, off = wgid / NXCD; wgid = (xcd < r ? xcd * (q + 1) : r * (q + 1) + (xcd - r) * q) + off; }
        const int nig = WGM * nN, gid = wgid / nig, fm = gid * WGM, gsz = (nM - fm) < WGM ? (nM - fm) : WGM;
        u.pm = fm + ((wgid % nig) % gsz); u.pn = (wgid % nig) / gsz; return true;
    }
    __device__ __forceinline__ void a_ready(const Unit&) const {}
    __device__ __forceinline__ void done(const Unit&) const {}
};

__device__ __forceinline__ unsigned cvt_pk_bf16(float lo, float hi) { unsigned r; asm volatile("v_cvt_pk_bf16_f32 %0, %1, %2" : "=v"(r) : "v"(lo), "v"(hi)); return r; }
typedef float f32x2 __attribute__((ext_vector_type(2)));

template <class Epi, class Sched, bool ALIGN_EPI = false, bool SP2 = false>
__device__ __forceinline__ void gemm_phase(PG8_LAS unsigned char* lds, const Gemm g, const Sched& S, const Epi& E) {
    const int tid = threadIdx.x, wid = __builtin_amdgcn_readfirstlane(tid >> 6), lane = tid & 63, wr = wid >> 2, wc = wid & 3, fr = lane & 15, fq = lane >> 4;
    const int K = g.K, nt = K / BK;
    unsigned voffA[2], voffB[2];
#pragma unroll
    for (int i = 0; i < 2; ++i) { int R, C; stage_rc(tid * 16 + i * 8192, R, C); const int Rb = Epi::PERM ? ((R & ~31) + perm32(R & 31)) : R;
        voffA[i] = (unsigned)(R * K + C) * 2u; voffB[i] = (unsigned)(Rb * K + C) * 2u; }
    const size_t kstep = (size_t)(BK * 2);
    const size_t hstep = (size_t)HALF * K * 2;
    const size_t tstep = 2 * hstep;
    const unsigned ldsw = (unsigned)wid * 1024u;
    const int aoff = lds_byte(wr * 64 + fr, fq * 8), boff = lds_byte(wc * 32 + fr, fq * 8);
#define PG8_SA(b, h) (((b) * 2 + (h)) * HTB)
#define PG8_SB(b, h) ((4 + (b) * 2 + (h)) * HTB)
#define PG8_STAGE(bufoff, gbase, voff) do { _Pragma("unroll") for (int _i = 0; _i < 2; ++_i) \
        __builtin_amdgcn_global_load_lds((const unsigned*)((const char*)(gbase) + (voff)[_i]), (PG8_LAS unsigned*)(lds + (bufoff) + ldsw + _i * 8192), 16, 0, 0); } while (0)
#define PG8_LDA(dst, b, h) do { _Pragma("unroll") for (int m = 0; m < 4; ++m) _Pragma("unroll") for (int k = 0; k < 2; ++k) dst[m][k] = *(const PG8_LAS bf16x8*)(lds + PG8_SA(b, h) + aoff + m * 2048 + k * 1024); } while (0)
#define PG8_LDB(dst, b, h) do { _Pragma("unroll") for (int n = 0; n < 2; ++n) _Pragma("unroll") for (int k = 0; k < 2; ++k) dst[n][k] = *(const PG8_LAS bf16x8*)(lds + PG8_SB(b, h) + boff + n * 2048 + k * 1024); } while (0)
#define PG8_MMA(ai, bj, At, Bt) do { __builtin_amdgcn_s_setprio(1); _Pragma("unroll") for (int m = 0; m < 4; ++m) _Pragma("unroll") for (int n = 0; n < 2; ++n) _Pragma("unroll") for (int k = 0; k < 2; ++k) \
        acc[ai][bj][m][n] = __builtin_amdgcn_mfma_f32_16x16x32_bf16(Bt[n][k], At[m][k], acc[ai][bj][m][n], 0, 0, 0); __builtin_amdgcn_s_setprio(0); } while (0)
#define PG8_WAIT_V(n) asm volatile("s_waitcnt vmcnt(" #n ")" ::: "memory")
#define PG8_WAIT_L(n) asm volatile("s_waitcnt lgkmcnt(" #n ")" ::: "memory")
#define PG8_BAR __builtin_amdgcn_s_barrier()
#define PG8_SCHED __builtin_amdgcn_sched_barrier(0)
    Unit cur, nxt; int ui = 0;
    if (!S.next(0, cur)) return;
    f32x4 acc[2][2][4][2];
#pragma unroll
    for (int a = 0; a < 2; ++a)
#pragma unroll
        for (int b = 0; b < 2; ++b)
#pragma unroll
            for (int m = 0; m < 4; ++m)
#pragma unroll
                for (int n = 0; n < 2; ++n) acc[a][b][m][n] = (f32x4){0.f, 0.f, 0.f, 0.f};
    bf16x8 At[4][2], B0[2][2], B1[2][2];
    const char* cA = (const char*)g.A + (size_t)cur.pm * tstep; const char* cB = (const char*)g.Bt + (size_t)cur.pn * tstep;
    S.a_ready(cur);
    if constexpr (SP2) {
        PG8_STAGE(PG8_SB(0, 0), cB, voffB); PG8_STAGE(PG8_SB(0, 1), cB + hstep, voffB); PG8_STAGE(PG8_SA(0, 0), cA, voffA); PG8_STAGE(PG8_SA(0, 1), cA + hstep, voffA);
        if (wr == 1) PG8_BAR;
        PG8_WAIT_V(2); PG8_BAR;
        PG8_STAGE(PG8_SB(1, 0), cB + kstep, voffB); PG8_STAGE(PG8_SA(1, 0), cA + kstep, voffA); PG8_STAGE(PG8_SB(1, 1), cB + hstep + kstep, voffB);
        PG8_WAIT_V(6); PG8_BAR;
    } else {
        PG8_STAGE(PG8_SB(0, 0), cB, voffB); PG8_STAGE(PG8_SA(0, 0), cA, voffA); PG8_STAGE(PG8_SB(0, 1), cB + hstep, voffB); PG8_STAGE(PG8_SA(0, 1), cA + hstep, voffA);
        if (wr == 1) PG8_BAR;
        PG8_WAIT_V(4); PG8_BAR;
        PG8_STAGE(PG8_SB(1, 0), cB + kstep, voffB); PG8_STAGE(PG8_SA(1, 0), cA + kstep, voffA); PG8_STAGE(PG8_SB(1, 1), cB + hstep + kstep, voffB);
        PG8_WAIT_V(6); PG8_BAR;
    }
    for (;;) {
        const bool has_next = S.next(ui + 1, nxt);
        const char* nA = has_next ? (const char*)g.A + (size_t)nxt.pm * tstep : cA; const char* nB = has_next ? (const char*)g.Bt + (size_t)nxt.pn * tstep : cB;
        for (int t = 0; t < nt; t += 2) {
            const bool last = (t == nt - 2);
            const char* a1 = cA + (size_t)(t + 1) * kstep;
            const char* a2 = last ? nA : cA + (size_t)(t + 2) * kstep; const char* b2 = last ? nB : cB + (size_t)(t + 2) * kstep;
            const char* a3 = a2 + kstep; const char* b3 = b2 + kstep;
            if (last && has_next) S.a_ready(nxt);
            if constexpr (SP2) {
            PG8_LDB(B0, 0, 0); PG8_LDB(B1, 0, 1); PG8_SCHED; PG8_LDA(At, 0, 0); PG8_STAGE(PG8_SA(1, 1), a1 + hstep, voffA);
            PG8_WAIT_V(8); PG8_WAIT_L(0); PG8_BAR; PG8_MMA(0, 0, At, B0); PG8_MMA(0, 1, At, B1); PG8_BAR; PG8_SCHED;
            PG8_LDA(At, 0, 1); PG8_STAGE(PG8_SB(0, 0), b2, voffB); PG8_STAGE(PG8_SB(0, 1), b2 + hstep, voffB); PG8_STAGE(PG8_SA(0, 0), a2, voffA);
            PG8_WAIT_V(8); PG8_WAIT_L(0); PG8_BAR; PG8_MMA(1, 0, At, B0); PG8_MMA(1, 1, At, B1); PG8_BAR; PG8_SCHED;
            PG8_LDB(B0, 1, 0); PG8_LDB(B1, 1, 1); PG8_SCHED; PG8_LDA(At, 1, 0); PG8_STAGE(PG8_SA(0, 1), a2 + hstep, voffA);
            PG8_WAIT_V(8); PG8_WAIT_L(0); PG8_BAR; PG8_MMA(0, 0, At, B0); PG8_MMA(0, 1, At, B1); PG8_BAR; PG8_SCHED;
            PG8_LDA(At, 1, 1); PG8_STAGE(PG8_SB(1, 0), b3, voffB); PG8_STAGE(PG8_SB(1, 1), b3 + hstep, voffB); PG8_STAGE(PG8_SA(1, 0), a3, voffA);
            PG8_WAIT_V(8); PG8_WAIT_L(0); PG8_BAR; PG8_MMA(1, 0, At, B0); PG8_MMA(1, 1, At, B1); PG8_BAR; PG8_SCHED;
            } else {
            PG8_LDB(B0, 0, 0); PG8_SCHED; PG8_LDA(At, 0, 0); PG8_STAGE(PG8_SA(1, 1), a1 + hstep, voffA);
            PG8_WAIT_L(8); PG8_BAR; PG8_WAIT_L(0); PG8_MMA(0, 0, At, B0); PG8_BAR; PG8_SCHED;
            PG8_LDB(B1, 0, 1); PG8_STAGE(PG8_SB(0, 0), b2, voffB);
            PG8_BAR; PG8_WAIT_L(0); PG8_MMA(0, 1, At, B1); PG8_BAR;
            PG8_LDA(At, 0, 1); PG8_STAGE(PG8_SA(0, 0), a2, voffA);
            PG8_BAR; PG8_WAIT_L(0); PG8_MMA(1, 0, At, B0); PG8_BAR; PG8_SCHED;
            PG8_STAGE(PG8_SB(0, 1), b2 + hstep, voffB);
            PG8_WAIT_V(6); PG8_BAR; PG8_MMA(1, 1, At, B1); PG8_BAR;
            PG8_LDB(B0, 1, 0); PG8_SCHED; PG8_LDA(At, 1, 0); PG8_STAGE(PG8_SA(0, 1), a2 + hstep, voffA);
            PG8_WAIT_L(8); PG8_BAR; PG8_WAIT_L(0); PG8_MMA(0, 0, At, B0); PG8_BAR; PG8_SCHED;
            PG8_LDB(B1, 1, 1); PG8_STAGE(PG8_SB(1, 0), b3, voffB);
            PG8_BAR; PG8_WAIT_L(0); PG8_MMA(0, 1, At, B1); PG8_BAR;
            PG8_LDA(At, 1, 1); PG8_STAGE(PG8_SA(1, 0), a3, voffA);
            PG8_BAR; PG8_WAIT_L(0); PG8_MMA(1, 0, At, B0); PG8_BAR; PG8_SCHED;
            PG8_STAGE(PG8_SB(1, 1), b3 + hstep, voffB);
            PG8_WAIT_V(6); PG8_BAR; PG8_MMA(1, 1, At, B1); PG8_BAR;
            }
        }
        if constexpr (ALIGN_EPI) { if (wr == 0) PG8_BAR; }
        if constexpr (!Epi::AFTER_DRAIN) { E(acc, cur, wr, wc, fr, fq); S.done(cur); }
        if (!has_next) break;
#pragma unroll
        for (int a = 0; a < 2; ++a)
#pragma unroll
            for (int b = 0; b < 2; ++b)
#pragma unroll
                for (int m = 0; m < 4; ++m)
#pragma unroll
                    for (int n = 0; n < 2; ++n) acc[a][b][m][n] = (f32x4){0.f, 0.f, 0.f, 0.f};
        cur = nxt; cA = nA; cB = nB; ++ui;
        if constexpr (ALIGN_EPI) { if (wr == 1) PG8_BAR; }
    }
    PG8_WAIT_V(0);
    if constexpr (!ALIGN_EPI) { if (wr == 0) PG8_BAR; }
    PG8_BAR;
    if constexpr (Epi::AFTER_DRAIN) { E.fused(acc, cur, wr, wc, fr, fq, lds, wid, lane); S.done(cur); }
#undef PG8_SA
#undef PG8_SB
#undef PG8_STAGE
#undef PG8_LDA
#undef PG8_LDB
#undef PG8_MMA
#undef PG8_WAIT_V
#undef PG8_WAIT_L
#undef PG8_BAR
#undef PG8_SCHED
}
}

constexpr int BATCH = 4, SEQ = 4096, DM = 1024, MROWS = BATCH * SEQ;
constexpr int CE = 2048, CN = 4 * CE;
constexpr int NH = 16, HD = 64, NG = 3, QKVC = 9216, AN = 10240;
constexpr float EPS = 1e-6f, LOG2E = 1.4426950408889634f, QSCALE = 0.125f * LOG2E;
constexpr int NPHASE = 23;

constexpr size_t MiB = 1u << 20;
constexpr size_t WS_CTL = 0, CTL_ZERO_BYTES = 1 * MiB;
constexpr size_t WS_SSQ = 1 * MiB;
constexpr size_t WS_W1 = 2 * MiB, WS_W2 = 34 * MiB, WS_W3 = 42 * MiB, WS_W4 = 82 * MiB;
constexpr size_t WS_LSE = 86 * MiB;
constexpr size_t WS_BIAS = 89 * MiB;
constexpr size_t WS_XB = 90 * MiB;
constexpr size_t WS_CV = 122 * MiB, WS_CG = 186 * MiB;
constexpr size_t WS_QO = 122 * MiB;
constexpr size_t WS_K = 218 * MiB, WS_V = 250 * MiB, WS_Y = WS_K;
constexpr size_t WS_END = 282 * MiB;
constexpr int CW_TMO = 0, CW_BAR = 4096;

#define GAS __attribute__((address_space(1)))
#define LAS __attribute__((address_space(3)))
typedef unsigned short bf16;
typedef unsigned v4u __attribute__((ext_vector_type(4)));
typedef unsigned v2u __attribute__((ext_vector_type(2)));
typedef float f32x4 __attribute__((ext_vector_type(4)));
typedef short bf16x8 __attribute__((ext_vector_type(8)));
typedef GAS unsigned gu32;
#define RLX_AGENT __ATOMIC_RELAXED, __HIP_MEMORY_SCOPE_AGENT
#define LDS_WAIT() asm volatile("s_waitcnt lgkmcnt(0)" ::: "memory")
#define VM_WAIT() asm volatile("s_waitcnt vmcnt(0)" ::: "memory")
__device__ __forceinline__ unsigned f2bf(float f) { unsigned u = __builtin_bit_cast(unsigned, f); return (u + 0x7fffu + ((u >> 16) & 1u)) >> 16; }
__device__ __forceinline__ unsigned pk2(float lo, float hi) { return f2bf(lo) | (f2bf(hi) << 16); }
__device__ __forceinline__ float bf2f(unsigned h) { return __builtin_bit_cast(float, h << 16); }
__device__ __forceinline__ float bflo(unsigned w) { return __builtin_bit_cast(float, w << 16); }
__device__ __forceinline__ float bfhi(unsigned w) { return __builtin_bit_cast(float, w & 0xffff0000u); }
__device__ __forceinline__ float sigmoidf_(float z) { return 1.0f / (1.0f + __builtin_amdgcn_exp2f(-z * LOG2E)); }
__device__ __forceinline__ float row_rs(const float* ssq, int row) {
    const f32x4* p = (const f32x4*)(ssq + (size_t)row * 16);
    const f32x4 s = (p[0] + p[1]) + (p[2] + p[3]);
    return 1.0f / sqrtf(((s.x + s.y) + (s.z + s.w)) * (1.0f / DM) + EPS);
}
__device__ __forceinline__ float wave_sum(float v) {
#pragma unroll
    for (int o = 1; o < 64; o <<= 1) v += __shfl_xor(v, o);
    return v;
}
__device__ __forceinline__ int t5_bucket(int d) {
    if (d < 16) return d;
    int b = 15;
    b += (d >= 16); b += (d >= 22); b += (d >= 30); b += (d >= 40); b += (d >= 54); b += (d >= 73); b += (d >= 99); b += (d >= 134);
    b += (d >= 182); b += (d >= 246); b += (d >= 332); b += (d >= 450); b += (d >= 609); b += (d >= 825); b += (d >= 1117); b += (d >= 1513);
    return b;
}

#define XB_TMO      128
#define XB_XCNT(j)  (256  + 64 * (j))
#define XB_XSUB(j)  (1280 + 64 * (j))
#define XB_XGEN(j)  (2304 + 64 * (j))
#define XB_TOP      3328
#define XB_TOPGEN   3392
#define XCD_BAR_WORDS 3456
#define XB_SPIN_CAP (1u << 18)

__device__ __forceinline__ unsigned xb_ld(unsigned* p)              { return __hip_atomic_load(p, __ATOMIC_RELAXED, __HIP_MEMORY_SCOPE_AGENT); }
__device__ __forceinline__ unsigned xb_add(unsigned* p, unsigned v) { return __hip_atomic_fetch_add(p, v, __ATOMIC_RELAXED, __HIP_MEMORY_SCOPE_AGENT); }
__device__ __forceinline__ unsigned xb_xcc_id() { return (unsigned)__builtin_amdgcn_s_getreg((3 << 11) | 20) & 0xFu; }
#define XB_SPIN(cond, bar) do { unsigned _sp = 0; while (cond) { __builtin_amdgcn_s_sleep(1); \
    if ((++_sp & 255u) == 0u) { if (xb_ld(&(bar)[XB_TMO])) break; if (_sp > XB_SPIN_CAP) { atomicAdd(&(bar)[XB_TMO], 1u); break; } } } } while (0)

struct XcdBarrier {
    unsigned* bar; unsigned x;
    volatile LAS unsigned* st;
};

__device__ __forceinline__ XcdBarrier xcd_barrier_post(unsigned* bar, volatile LAS unsigned* st) {
    XcdBarrier b; b.bar = bar; b.x = xb_xcc_id(); b.st = st;
    if (threadIdx.x == 0) (void)xb_add(&bar[XB_XCNT(b.x)], 1u);
    return b;
}
__device__ __forceinline__ void xcd_barrier_complete(unsigned* bar, unsigned x, unsigned& nloc, unsigned& nx) {
    const unsigned G = gridDim.x * gridDim.y * gridDim.z;
    unsigned sum, cnt, mine, sp = 0u;
    for (;;) {
        sum = 0u; cnt = 0u; mine = 0u;
#pragma unroll
        for (unsigned j = 0; j < 16; ++j) { const unsigned c = xb_ld(&bar[XB_XCNT(j)]); sum += c; cnt += (c > 0u) ? 1u : 0u; mine = (j == x) ? c : mine; }
        if (sum == G) break;
        __builtin_amdgcn_s_sleep(1);
        if ((++sp & 255u) == 0u) { if (xb_ld(&bar[XB_TMO])) break; if (sp > XB_SPIN_CAP) { atomicAdd(&bar[XB_TMO], 1u); break; } }
    }
    nloc = mine > 0u ? mine : 1u; nx = cnt > 0u ? cnt : 1u;
}

__device__ __forceinline__ void xcd_barrier(const XcdBarrier& b) {
    asm volatile("s_waitcnt vmcnt(0)" ::: "memory");
    __syncthreads();
    if (threadIdx.x == 0) {
        unsigned* bar = b.bar;
        __builtin_amdgcn_s_waitcnt(0);
        unsigned nloc = b.st[0], nx = b.st[1];
        if (nloc == 0u) { xcd_barrier_complete(bar, b.x, nloc, nx); b.st[0] = nloc; b.st[1] = nx; }
        const unsigned old = xb_add(&bar[XB_XSUB(b.x)], 1u);
        const unsigned gen = old / nloc;
        if (old + 1u == (gen + 1u) * nloc) {
            __builtin_amdgcn_fence(__ATOMIC_RELEASE, "agent");
            asm volatile("s_waitcnt vmcnt(0)" ::: "memory");
            const unsigned og = xb_add(&bar[XB_TOP], 1u);
            const unsigned tg = og / nx;
            if (og + 1u == (tg + 1u) * nx) xb_add(&bar[XB_TOPGEN], 1u);
            else XB_SPIN(xb_ld(&bar[XB_TOPGEN]) == tg, bar);
            __builtin_amdgcn_fence(__ATOMIC_ACQUIRE, "agent");
            xb_add(&bar[XB_XGEN(b.x)], 1u);
            asm volatile("s_waitcnt vmcnt(0)" ::: "memory");
        } else {
            XB_SPIN(xb_ld(&bar[XB_XGEN(b.x)]) == gen, bar);
            __builtin_amdgcn_fence(__ATOMIC_ACQUIRE, "agent");
            asm volatile("s_waitcnt vmcnt(0)" ::: "memory");
        }
    }
    __syncthreads();
}

namespace epi {
using pg8::Unit; using pg8::bf16_t;

__device__ __forceinline__ void rows_rs(const float* ssq, int row0  , int fq, float (&rs)[2][4]) {
    f32x4 pp[2][4];
#pragma unroll
    for (int ai = 0; ai < 2; ++ai)
#pragma unroll
        for (int m = 0; m < 4; ++m) pp[ai][m] = *(const f32x4*)(ssq + (size_t)(row0 + ai * 128 + m * 16) * 16 + 4 * fq);
#pragma unroll
    for (int ai = 0; ai < 2; ++ai)
#pragma unroll
        for (int m = 0; m < 4; ++m) { float t = (pp[ai][m][0] + pp[ai][m][1]) + (pp[ai][m][2] + pp[ai][m][3]); t += __shfl_xor(t, 16); t += __shfl_xor(t, 32); rs[ai][m] = 1.0f / sqrtf(t * (1.0f / DM) + EPS); }
}
struct ConvIn {
    static constexpr bool PERM = false, AFTER_DRAIN = false;
    const float* ssq; bf16_t* V; bf16_t* G;
    __device__ __forceinline__ void operator()(const f32x4 (&acc)[2][2][4][2], const Unit& u, int wr, int wc, int fr, int fq) const {
        const int ch0 = u.pn * 64 + wc * 16 + 4 * fq;
        float rsv[2][4]; rows_rs(ssq, u.pm * 256 + wr * 64 + fr, fq, rsv);
#pragma unroll
        for (int ai = 0; ai < 2; ++ai)
#pragma unroll
            for (int m = 0; m < 4; ++m) {
                const int row = u.pm * 256 + ai * 128 + wr * 64 + m * 16 + fr;
                const float rs = rsv[ai][m];
                const f32x4 b = acc[ai][0][m][0] * rs, c = acc[ai][0][m][1] * rs, uu = acc[ai][1][m][0] * rs, z = acc[ai][1][m][1] * rs;
                const f32x4 v = c * uu;
                f32x4 g;
#pragma unroll
                for (int i = 0; i < 4; ++i) g[i] = b[i] * z[i] * sigmoidf_(z[i]);
                v2u wv, wg; wv.x = pk2(v[0], v[1]); wv.y = pk2(v[2], v[3]); wg.x = pk2(g[0], g[1]); wg.y = pk2(g[2], g[3]);
                *(v2u*)(V + (size_t)row * CE + ch0) = wv;
                *(v2u*)(G + (size_t)row * CE + ch0) = wg;
            }
    }
};
struct Resid {
    static constexpr bool PERM = false, AFTER_DRAIN = false;
    const float* xin; float* xout; bf16_t* xb; float* ssq;
    __device__ __forceinline__ void operator()(const f32x4 (&acc)[2][2][4][2], const Unit& u, int wr, int wc, int fr, int fq) const {
        const int col0 = u.pn * 256 + wc * 32 + 4 * fq;
        const size_t off0 = (size_t)(u.pm * 256 + wr * 64 + fr) * DM + col0;
        f32x4 pre[4][2][2];
#pragma unroll
        for (int i = 0; i < 4; ++i)
#pragma unroll
            for (int bj = 0; bj < 2; ++bj)
#pragma unroll
                for (int n = 0; n < 2; ++n) pre[i][bj][n] = *(const f32x4*)(xin + off0 + (size_t)(16 * i) * DM + bj * 128 + n * 16);
#pragma unroll
        for (int i = 0; i < 8; ++i) {
            const int ai = i >> 2, m = i & 3;
            const size_t off = off0 + (size_t)(ai * 128 + m * 16) * DM;
            float ss = 0.f; f32x4 xn[2][2];
#pragma unroll
            for (int bj = 0; bj < 2; ++bj)
#pragma unroll
                for (int n = 0; n < 2; ++n) { xn[bj][n] = pre[i & 3][bj][n] + acc[ai][bj][m][n]; const f32x4 t = xn[bj][n]; ss += (t[0] * t[0] + t[1] * t[1]) + (t[2] * t[2] + t[3] * t[3]); }
            if (i < 4) {
#pragma unroll
                for (int bj = 0; bj < 2; ++bj)
#pragma unroll
                    for (int n = 0; n < 2; ++n) pre[i & 3][bj][n] = *(const f32x4*)(xin + off + (size_t)128 * DM + bj * 128 + n * 16);
            }
#pragma unroll
            for (int bj = 0; bj < 2; ++bj)
#pragma unroll
                for (int n = 0; n < 2; ++n) {
                    *(f32x4*)(xout + off + bj * 128 + n * 16) = xn[bj][n];
                    v2u w; w.x = pk2(xn[bj][n][0], xn[bj][n][1]); w.y = pk2(xn[bj][n][2], xn[bj][n][3]);
                    *(v2u*)(xb + off + bj * 128 + n * 16) = w;
                }
            ss += __shfl_xor(ss, 16); ss += __shfl_xor(ss, 32);
            if (fq == 0) ssq[(size_t)(u.pm * 256 + ai * 128 + wr * 64 + m * 16 + fr) * 16 + u.pn * 4 + wc] = ss;
        }
    }
};
struct QKV {
    static constexpr bool PERM = true, AFTER_DRAIN = false;
    const float* ssq; bf16_t* Q; bf16_t* K; bf16_t* Vv; const float* qg; const float* kg;
    __device__ __forceinline__ void operator()(const f32x4 (&acc)[2][2][4][2], const Unit& u, int wr, int wc, int fr, int fq) const {
        const int which = u.pn >> 2, h = (u.pn & 3) * 4 + wc;
        bf16_t* base = Q + (ptrdiff_t)(which == 1) * (K - Q) + (ptrdiff_t)(which == 2) * (Vv - Q);
        const float* gp = qg + (ptrdiff_t)(which == 1) * (kg - qg); const float gsc = which == 0 ? QSCALE : 1.0f; const bool nrm = which < 2;
        const f32x4 g00 = *(const f32x4*)(gp + 8 * fq), g01 = *(const f32x4*)(gp + 8 * fq + 4), g10 = *(const f32x4*)(gp + 32 + 8 * fq), g11 = *(const f32x4*)(gp + 32 + 8 * fq + 4);
        float rsv[2][4]; rows_rs(ssq, u.pm * 256 + wr * 64 + fr, fq, rsv);
#pragma unroll
        for (int ai = 0; ai < 2; ++ai)
#pragma unroll
            for (int m = 0; m < 4; ++m) {
                const int row = u.pm * 256 + ai * 128 + wr * 64 + m * 16 + fr;
                const float rs = rsv[ai][m];
                f32x4 v[2][2]; float ss = 0.f;
#pragma unroll
                for (int bj = 0; bj < 2; ++bj)
#pragma unroll
                    for (int n = 0; n < 2; ++n) { v[bj][n] = acc[ai][bj][m][n] * rs; const f32x4 t = v[bj][n]; ss += (t[0] * t[0] + t[1] * t[1]) + (t[2] * t[2] + t[3] * t[3]); }
                ss += __shfl_xor(ss, 16); ss += __shfl_xor(ss, 32);
                const float rn = gsc / sqrtf(ss * (1.0f / HD) + EPS);
#pragma unroll
                for (int bj = 0; bj < 2; ++bj) {
                    f32x4 a = v[bj][0], b = v[bj][1];
                    if (nrm) { a = a * (bj == 0 ? g00 : g10) * rn; b = b * (bj == 0 ? g01 : g11) * rn; }
                    v4u w; w.x = pk2(a[0], a[1]); w.y = pk2(a[2], a[3]); w.z = pk2(b[0], b[1]); w.w = pk2(b[2], b[3]);
                    *(v4u*)(base + (size_t)row * DM + h * HD + 32 * bj + 8 * fq) = w;
                }
            }
    }
};
struct ZMerge {
    static constexpr bool PERM = true, AFTER_DRAIN = false;
    const float* ssq; const bf16_t* O0; const bf16_t* O1; const bf16_t* O2; const float* lse; bf16_t* Y;
    struct RowIn { v4u a[2], b[2], c[2]; f32x4 sq; float l0, l1, l2; };
    __device__ __forceinline__ void load_row(RowIn& r, int row, int h, int fq) const {
        const size_t off = (size_t)row * DM + h * HD + 8 * fq;
        r.sq = *(const f32x4*)(ssq + (size_t)row * 16 + 4 * fq);
        r.l0 = lse[((size_t)0 * MROWS + row) * 16 + h]; r.l1 = lse[((size_t)1 * MROWS + row) * 16 + h]; r.l2 = lse[((size_t)2 * MROWS + row) * 16 + h];
#pragma unroll
        for (int bj = 0; bj < 2; ++bj) { r.a[bj] = *(const v4u*)(O0 + off + 32 * bj); r.b[bj] = *(const v4u*)(O1 + off + 32 * bj); r.c[bj] = *(const v4u*)(O2 + off + 32 * bj); }
    }
    __device__ __forceinline__ void operator()(const f32x4 (&acc)[2][2][4][2], const Unit& u, int wr, int wc, int fr, int fq) const {
        const int h = u.pn * 4 + wc, row0 = u.pm * 256 + wr * 64 + fr;
        RowIn in[2];
        load_row(in[0], row0, h, fq);
#pragma unroll
        for (int i = 0; i < 8; ++i) {
            const int ai = i >> 2, m = i & 3, row = row0 + ai * 128 + m * 16;
            if (i + 1 < 8) load_row(in[(i + 1) & 1], row0 + ((i + 1) >> 2) * 128 + ((i + 1) & 3) * 16, h, fq);
            const RowIn& r = in[i & 1];
            float tq = (r.sq[0] + r.sq[1]) + (r.sq[2] + r.sq[3]); tq += __shfl_xor(tq, 16); tq += __shfl_xor(tq, 32);
            const float rs = 1.0f / sqrtf(tq * (1.0f / DM) + EPS);
            const float mx = fmaxf(r.l0, fmaxf(r.l1, r.l2));
            float w0 = __builtin_amdgcn_exp2f(r.l0 - mx), w1 = __builtin_amdgcn_exp2f(r.l1 - mx), w2 = __builtin_amdgcn_exp2f(r.l2 - mx);
            const float inv = 1.0f / (w0 + w1 + w2); w0 *= inv; w1 *= inv; w2 *= inv;
#pragma unroll
            for (int bj = 0; bj < 2; ++bj) {
                const v4u a = r.a[bj], b = r.b[bj], c = r.c[bj];
                float o[8];
#pragma unroll
                for (int k = 0; k < 4; ++k) { o[2 * k] = w0 * bflo(a[k]) + w1 * bflo(b[k]) + w2 * bflo(c[k]); o[2 * k + 1] = w0 * bfhi(a[k]) + w1 * bfhi(b[k]) + w2 * bfhi(c[k]); }
                const f32x4 z0 = acc[ai][bj][m][0] * rs, z1 = acc[ai][bj][m][1] * rs;
                float y[8];
#pragma unroll
                for (int k = 0; k < 4; ++k) { y[k] = o[k] * z0[k] * sigmoidf_(z0[k]); y[4 + k] = o[4 + k] * z1[k] * sigmoidf_(z1[k]); }
                v4u w; w.x = pk2(y[0], y[1]); w.y = pk2(y[2], y[3]); w.z = pk2(y[4], y[5]); w.w = pk2(y[6], y[7]);
                *(v4u*)(Y + (size_t)row * DM + h * HD + 32 * bj + 8 * fq) = w;
            }
        }
    }
};
}

namespace naive {
template <class AL, class BL, class EP>
__device__ __forceinline__ void gemm_tile(LAS float* sm, int K, int row0, const AL& al, const BL& bl, const EP& ep) {
    const int tid = threadIdx.x, tx = tid & 15, ty = tid >> 4;
    LAS float* sA = sm; LAS float* sB = sm + 16 * 132;
    float acc[4][4];
#pragma unroll
    for (int i = 0; i < 4; ++i)
#pragma unroll
        for (int j = 0; j < 4; ++j) acc[i][j] = 0.f;
    for (int k0 = 0; k0 < K; k0 += 16) {
#pragma unroll
        for (int i = 0; i < 4; ++i) { const int idx = tid + 512 * i, r = idx >> 4, kk = idx & 15; sA[kk * 132 + r] = al(row0 + r, k0 + kk); }
#pragma unroll
        for (int i = 0; i < 2; ++i) { const int idx = tid + 512 * i, kk = idx >> 6, c = idx & 63; sB[kk * 68 + c] = bl(k0 + kk, c); }
        __syncthreads();
#pragma unroll
        for (int kk = 0; kk < 16; ++kk) {
            float a[4], b[4];
#pragma unroll
            for (int i = 0; i < 4; ++i) a[i] = sA[kk * 132 + ty * 4 + i];
#pragma unroll
            for (int j = 0; j < 4; ++j) b[j] = sB[kk * 68 + tx + 16 * j];
#pragma unroll
            for (int i = 0; i < 4; ++i)
#pragma unroll
                for (int j = 0; j < 4; ++j) acc[i][j] = fmaf(a[i], b[j], acc[i][j]);
        }
        __syncthreads();
    }
#pragma unroll
    for (int i = 0; i < 4; ++i) ep(row0 + ty * 4 + i, tx, acc[i][0], acc[i][1], acc[i][2], acc[i][3]);
}
struct ALbf { const bf16* A; int ld; __device__ __forceinline__ float operator()(int r, int k) const { return bf2f(A[(size_t)r * ld + k]); } };
__device__ __forceinline__ float red16(float v) { v += __shfl_xor(v, 1); v += __shfl_xor(v, 2); v += __shfl_xor(v, 4); v += __shfl_xor(v, 8); return v; }

struct BLc1 { const float* w; const float* nrm; int ct; __device__ __forceinline__ float operator()(int k, int c) const { return w[(size_t)k * CN + (c >> 4) * CE + ct * 16 + (c & 15)] * nrm[k]; } };
struct EPc1 { const float* ssq; bf16* V; bf16* G; int ct;
    __device__ __forceinline__ void operator()(int row, int tx, float a0, float a1, float a2, float a3) const {
        const float rs = row_rs(ssq, row); const float b = a0 * rs, c = a1 * rs, u = a2 * rs, z = a3 * rs;
        const int e = ct * 16 + tx; V[(size_t)row * CE + e] = (bf16)f2bf(c * u); G[(size_t)row * CE + e] = (bf16)f2bf(b * z * sigmoidf_(z)); } };
__device__ __forceinline__ void c1(LAS float* sm, const bf16* xb, const float* ssq, const float* w, const float* nrm, bf16* V, bf16* G, int bid, int nb) {
    const int nct = CE / 16, ntile = (MROWS / 128) * nct;
    for (int t = bid; t < ntile; t += nb) { const int rt = t / nct, ct = t % nct; gemm_tile(sm, DM, rt * 128, ALbf{xb, DM}, BLc1{w, nrm, ct}, EPc1{ssq, V, G, ct}); }
}
struct BLres { const float* w; int ct; __device__ __forceinline__ float operator()(int k, int c) const { return w[(size_t)k * DM + ct * 64 + c]; } };
struct EPres { const float* xin; float* xout; bf16* xb; float* ssq; int ct;
    __device__ __forceinline__ void operator()(int row, int tx, float a0, float a1, float a2, float a3) const {
        const size_t o = (size_t)row * DM + ct * 64 + tx;
        const float x0 = xin[o] + a0, x1 = xin[o + 16] + a1, x2 = xin[o + 32] + a2, x3 = xin[o + 48] + a3;
        xout[o] = x0; xout[o + 16] = x1; xout[o + 32] = x2; xout[o + 48] = x3;
        xb[o] = (bf16)f2bf(x0); xb[o + 16] = (bf16)f2bf(x1); xb[o + 32] = (bf16)f2bf(x2); xb[o + 48] = (bf16)f2bf(x3);
        const float ss = red16((x0 * x0 + x1 * x1) + (x2 * x2 + x3 * x3));
        if (tx == 0) ssq[(size_t)row * 16 + ct] = ss; } };
__device__ __forceinline__ void resid(LAS float* sm, const bf16* A, int K, const float* w, const float* xin, float* xout, bf16* xb, float* ssq, int bid, int nb) {
    const int ntile = (MROWS / 128) * 16;
    for (int t = bid; t < ntile; t += nb) { const int rt = t / 16, ct = t % 16; gemm_tile(sm, K, rt * 128, ALbf{A, K}, BLres{w, ct}, EPres{xin, xout, xb, ssq, ct}); }
}
struct BLa1 { const float* w; const float* nrm; int col0; __device__ __forceinline__ float operator()(int k, int c) const { return w[(size_t)k * AN + col0 + c] * nrm[k]; } };
struct EPa1 { const float* ssq; bf16* dst; const float* gain; float sc; int h;
    __device__ __forceinline__ void operator()(int row, int tx, float a0, float a1, float a2, float a3) const {
        const float rs = row_rs(ssq, row); float v0 = a0 * rs, v1 = a1 * rs, v2 = a2 * rs, v3 = a3 * rs;
        const float ss = red16((v0 * v0 + v1 * v1) + (v2 * v2 + v3 * v3));
        if (gain) { const float rn = sc / sqrtf(ss * (1.0f / HD) + EPS); v0 *= rn * gain[tx]; v1 *= rn * gain[tx + 16]; v2 *= rn * gain[tx + 32]; v3 *= rn * gain[tx + 48]; }
        const size_t o = (size_t)row * DM + h * HD + tx;
        dst[o] = (bf16)f2bf(v0); dst[o + 16] = (bf16)f2bf(v1); dst[o + 32] = (bf16)f2bf(v2); dst[o + 48] = (bf16)f2bf(v3); } };
__device__ __forceinline__ void a1(LAS float* sm, const bf16* xb, const float* ssq, const float* w, const float* nrm, int g, const float* qg, const float* kg, bf16* Q, bf16* K, bf16* V, int bid, int nb) {
    const int ntile = (MROWS / 128) * 48;
    for (int t = bid; t < ntile; t += nb) { const int rt = t / 48, ct = t % 48, which = ct / 16, h = ct % 16;
        gemm_tile(sm, DM, rt * 128, ALbf{xb, DM}, BLa1{w, nrm, g * 3072 + which * 1024 + h * 64},
                  EPa1{ssq, which == 0 ? Q : (which == 1 ? K : V), which == 0 ? qg : (which == 1 ? kg : nullptr), which == 0 ? QSCALE : 1.0f, h}); }
}
struct EPa3 { const float* ssq; const bf16* O0; const bf16* O1; const bf16* O2; const float* lse; bf16* Y; int h;
    __device__ __forceinline__ void operator()(int row, int tx, float a0, float a1, float a2, float a3) const {
        const float rs = row_rs(ssq, row);
        const float l0 = lse[((size_t)0 * MROWS + row) * 16 + h], l1 = lse[((size_t)1 * MROWS + row) * 16 + h], l2 = lse[((size_t)2 * MROWS + row) * 16 + h];
        const float mx = fmaxf(l0, fmaxf(l1, l2)); float w0 = exp2f(l0 - mx), w1 = exp2f(l1 - mx), w2 = exp2f(l2 - mx); const float inv = 1.0f / (w0 + w1 + w2); w0 *= inv; w1 *= inv; w2 *= inv;
        const float zz[4] = {a0 * rs, a1 * rs, a2 * rs, a3 * rs};
#pragma unroll
        for (int j = 0; j < 4; ++j) { const size_t o = (size_t)row * DM + h * HD + tx + 16 * j;
            const float ov = w0 * bf2f(O0[o]) + w1 * bf2f(O1[o]) + w2 * bf2f(O2[o]); Y[o] = (bf16)f2bf(ov * zz[j] * sigmoidf_(zz[j])); } } };
__device__ __forceinline__ void a3(LAS float* sm, const bf16* xb, const float* ssq, const float* w, const float* nrm, const bf16* O0, const bf16* O1, const bf16* O2, const float* lse, bf16* Y, int bid, int nb) {
    const int ntile = (MROWS / 128) * 16;
    for (int t = bid; t < ntile; t += nb) { const int rt = t / 16, h = t % 16; gemm_tile(sm, DM, rt * 128, ALbf{xb, DM}, BLa1{w, nrm, QKVC + h * 64}, EPa3{ssq, O0, O1, O2, lse, Y, h}); }
}
__device__ __forceinline__ void a2(bf16* QO, const bf16* K, const bf16* V, const float* biasT  , float* lse  , int dil, int gtid, int gthreads) {
    for (int idx = gtid; idx < MROWS * NH; idx += gthreads) {
        const int row = idx >> 4, h = idx & 15, t = row & (SEQ - 1);
        bf16* qp = QO + (size_t)row * DM + h * HD;
        float q[64], o[64];
#pragma unroll
        for (int c = 0; c < 8; ++c) { const v4u w = *(const v4u*)(qp + 8 * c);
#pragma unroll
            for (int i = 0; i < 4; ++i) { q[8 * c + 2 * i] = bflo(w[i]); q[8 * c + 2 * i + 1] = bfhi(w[i]); } }
#pragma unroll
        for (int d = 0; d < 64; ++d) o[d] = 0.f;
        float m = -INFINITY, l = 0.f;
        for (int j = 0; j <= 128; ++j) {
            const int tk = t - dil * j; if (tk < 0) break;
            const size_t ko = (size_t)(row - dil * j) * DM + h * HD;
            float s = 0.f;
#pragma unroll
            for (int c = 0; c < 8; ++c) { const v4u w = *(const v4u*)(K + ko + 8 * c);
#pragma unroll
                for (int i = 0; i < 4; ++i) { s = fmaf(q[8 * c + 2 * i], bflo(w[i]), s); s = fmaf(q[8 * c + 2 * i + 1], bfhi(w[i]), s); } }
            s += biasT[h * 132 + j];
            const float mn = fmaxf(m, s), f = exp2f(m - mn), p = exp2f(s - mn);
            l = l * f + p; m = mn;
#pragma unroll
            for (int c = 0; c < 8; ++c) { const v4u w = *(const v4u*)(V + ko + 8 * c);
#pragma unroll
                for (int i = 0; i < 4; ++i) { o[8 * c + 2 * i] = o[8 * c + 2 * i] * f + p * bflo(w[i]); o[8 * c + 2 * i + 1] = o[8 * c + 2 * i + 1] * f + p * bfhi(w[i]); } }
        }
        const float il = 1.0f / l;
#pragma unroll
        for (int c = 0; c < 8; ++c) { v4u w;
#pragma unroll
            for (int i = 0; i < 4; ++i) w[i] = pk2(o[8 * c + 2 * i] * il, o[8 * c + 2 * i + 1] * il);
            *(v4u*)(qp + 8 * c) = w; }
        lse[(size_t)row * 16 + h] = m + log2f(l);
    }
}
}

template <int MODE> __device__ __forceinline__ int wt_dest_row(int n) {
    if (MODE == 1) { const int type = n >> 11, e = n & 2047, pn = e >> 6, el = e & 63; return 256 * pn + 128 * (type >> 1) + 32 * (el >> 4) + 16 * (type & 1) + (el & 15); }
    if (MODE == 3) { const int blk = n >> 10, r = n & 1023, h = r >> 6, d = r & 63; return blk * 1024 + 256 * (h >> 2) + 128 * (d >> 5) + 32 * (h & 3) + (d & 31); }
    return n;
}
template <int MODE> __device__ __forceinline__ void p0_transpose_item(const float* W, int K, int N, const float* scale, bf16* WT, LAS float* scr  , int item, int lane) {
    const int nblk = N / 64, kb = item / nblk, nb = item % nblk, k0 = 64 * kb, n0 = 64 * nb;
    const int kr = lane >> 4, c4 = lane & 15;
    f32x4 v[16];
#pragma unroll
    for (int i = 0; i < 16; ++i) v[i] = *(const GAS f32x4*)(W + (size_t)(k0 + 4 * i + kr) * N + n0 + 4 * c4);
#pragma unroll
    for (int i = 0; i < 16; ++i) { const float s = scale ? scale[k0 + 4 * i + kr] : 1.0f; LAS float* d = scr + (4 * i + kr) * 65 + 4 * c4;
        d[0] = v[i][0] * s; d[1] = v[i][1] * s; d[2] = v[i][2] * s; d[3] = v[i][3] * s; }
    LDS_WAIT(); asm volatile("" ::: "memory");
    const int c = lane & 7, nl = lane >> 3;
#pragma unroll
    for (int j = 0; j < 8; ++j) { const int n = nl + 8 * j; const LAS float* s = scr + (8 * c) * 65 + n;
        v4u o; o.x = pk2(s[0 * 65], s[1 * 65]); o.y = pk2(s[2 * 65], s[3 * 65]); o.z = pk2(s[4 * 65], s[5 * 65]); o.w = pk2(s[6 * 65], s[7 * 65]);
        *(GAS v4u*)(WT + (size_t)wt_dest_row<MODE>(n0 + n) * K + k0 + 8 * c) = o; }
    LDS_WAIT(); asm volatile("" ::: "memory");
}
struct Ptrs {
    const float *x, *conv_norm, *conv_w_in, *conv_w, *conv_w_out, *attn_norm, *attn_w_in, *q_gain, *k_gain, *attn_w_out, *rel_bias;
    float* out; unsigned char* ws;
};
__device__ __forceinline__ void p0_prologue(const Ptrs& P, LAS unsigned char* lds, int vcu, int G, int wave, int lane, int tid) {
    LAS float* scr = (LAS float*)(lds + wave * 16640);
    const int gw = vcu * 8 + wave, NGW = G * 8;
    bf16* W1 = (bf16*)(P.ws + WS_W1); bf16* W2 = (bf16*)(P.ws + WS_W2); bf16* W3 = (bf16*)(P.ws + WS_W3); bf16* W4 = (bf16*)(P.ws + WS_W4);
    constexpr int I1 = (DM / 64) * (CN / 64), I2 = (CE / 64) * (DM / 64), I3 = (DM / 64) * (AN / 64), I4 = (DM / 64) * (DM / 64), IL = I1 + I2 + I3 + I4;
    for (int it = gw; it < 2 * IL; it += NGW) {
        const int j = it / IL; int r = it % IL;
        if (r < I1) { p0_transpose_item<1>(P.conv_w_in + (size_t)j * DM * CN, DM, CN, P.conv_norm + j * DM, W1 + (size_t)j * CN * DM, scr, r, lane); continue; } r -= I1;
        if (r < I2) { p0_transpose_item<0>(P.conv_w_out + (size_t)j * CE * DM, CE, DM, nullptr, W2 + (size_t)j * DM * CE, scr, r, lane); continue; } r -= I2;
        if (r < I3) { p0_transpose_item<3>(P.attn_w_in + (size_t)j * DM * AN, DM, AN, P.attn_norm + j * DM, W3 + (size_t)j * AN * DM, scr, r, lane); continue; } r -= I3;
        p0_transpose_item<0>(P.attn_w_out + (size_t)j * DM * DM, DM, DM, nullptr, W4 + (size_t)j * DM * DM, scr, r, lane);
    }
    bf16* XB = (bf16*)(P.ws + WS_XB); float* SSQ = (float*)(P.ws + WS_SSQ);
    for (int m = 2 * gw; m < MROWS; m += 2 * NGW) {
        const GAS f32x4* xr = (const GAS f32x4*)(P.x + (size_t)m * DM) + lane;
        GAS v2u* o8 = (GAS v2u*)(XB + (size_t)m * DM) + lane;
        f32x4 v[8];
#pragma unroll
        for (int jj = 0; jj < 8; ++jj) v[jj] = xr[64 * jj];
        float s0 = 0.f, s1 = 0.f;
#pragma unroll
        for (int jj = 0; jj < 8; ++jj) { const f32x4 t = v[jj]; const float q = (t.x * t.x + t.y * t.y) + (t.z * t.z + t.w * t.w); if (jj < 4) s0 += q; else s1 += q;
            v2u w; w.x = pk2(t.x, t.y); w.y = pk2(t.z, t.w); o8[64 * jj] = w; }
        s0 = wave_sum(s0); s1 = wave_sum(s1);
        if (lane < 32) SSQ[(size_t)m * 16 + lane] = lane == 0 ? s0 : (lane == 16 ? s1 : 0.f);
    }
    float* BT = (float*)(P.ws + WS_BIAS);
    for (int i = vcu * 512 + tid; i < NG * NH * 132; i += G * 512) {
        const int g = i / (NH * 132), r = i % (NH * 132), h = r / 132, st = r % 132;
        const int dil = g == 0 ? 1 : (g == 1 ? 4 : 16);
        BT[i] = st <= 128 ? P.rel_bias[t5_bucket(st * dil) * (NG * NH) + g * NH + h] * LOG2E : 0.f;
    }
}
template <bool WRAP> __device__ __forceinline__ void conv_pass(const bf16* V, const bf16* GY, bf16* OUT, const float* cw  , int gtid, int gthreads) {
    for (int idx = gtid; idx < MROWS * (CE / 8); idx += gthreads) {
        const int row = idx / (CE / 8), e0 = (idx % (CE / 8)) * 8, t = row & (SEQ - 1);
        const size_t o = (size_t)row * CE + e0;
        const v4u g = *(const v4u*)(GY + o), v2 = *(const v4u*)(V + o);
        v4u v1 = (v4u){0u, 0u, 0u, 0u}, v0 = (v4u){0u, 0u, 0u, 0u};
        if (t >= 1) v1 = *(const v4u*)(V + o - CE);
        if (t >= 2) v0 = *(const v4u*)(V + o - 2 * CE);
        float w0[8], w1[8], w2[8];
#pragma unroll
        for (int c = 0; c < 2; ++c) { const f32x4 a = *(const f32x4*)(cw + e0 + 4 * c), b = *(const f32x4*)(cw + CE + e0 + 4 * c), d = *(const f32x4*)(cw + 2 * CE + e0 + 4 * c);
#pragma unroll
            for (int i = 0; i < 4; ++i) { w0[4 * c + i] = a[i]; w1[4 * c + i] = b[i]; w2[4 * c + i] = d[i]; } }
        float y[8];
#pragma unroll
        for (int i = 0; i < 4; ++i) {
            y[2 * i] = bflo(g[i]) * (w0[2 * i] * bflo(v0[i]) + w1[2 * i] * bflo(v1[i]) + w2[2 * i] * bflo(v2[i]));
            y[2 * i + 1] = bfhi(g[i]) * (w0[2 * i + 1] * bfhi(v0[i]) + w1[2 * i + 1] * bfhi(v1[i]) + w2[2 * i + 1] * bfhi(v2[i]));
        }
        v4u w; w.x = pk2(y[0], y[1]); w.y = pk2(y[2], y[3]); w.z = pk2(y[4], y[5]); w.w = pk2(y[6], y[7]);
        *(v4u*)(OUT + (WRAP ? (o & (size_t)(16 * 1024 * 1024 - 1)) : o)) = w;
    }
}

namespace attn {
typedef float f32x16 __attribute__((ext_vector_type(16)));
typedef short s16x4 __attribute__((ext_vector_type(4)));
typedef short v4i16_t __attribute__((ext_vector_type(4)));
constexpr int L_K = 0, L_V = 49152, L_B = 98304, L_O = 118784, L_END = 151552, L_WS = 151552 + 256;
static_assert(L_O + 8 * 4096 == L_END && L_B + 5 * 4096 == L_O, "attention LDS map");
__device__ __forceinline__ int crow(int r, int hi) { return (r & 3) + 8 * (r >> 2) + 4 * hi; }
__device__ __forceinline__ s16x4 vtr(LAS const unsigned char* p) { return __builtin_bit_cast(s16x4, __builtin_amdgcn_ds_read_tr16_b64_v4i16((LAS v4i16_t*)p)); }
__device__ __forceinline__ float swapmax(float m) { auto rr = __builtin_amdgcn_permlane32_swap(__float_as_uint(m), __float_as_uint(m), false, false); return fmaxf(__uint_as_float(rr[0]), __uint_as_float(rr[1])); }
__device__ __forceinline__ float swapsum(float m) { auto rr = __builtin_amdgcn_permlane32_swap(__float_as_uint(m), __float_as_uint(m), false, false); return __uint_as_float(rr[0]) + __uint_as_float(rr[1]); }

template <int DIL> __device__ __forceinline__ void phase(LAS unsigned char* lds, const bf16* QO, bf16* OUT, const bf16* Kg, const bf16* Vg, const float* biasT  , float* lse  , int vcu, int G) {
    const int tid = threadIdx.x, lane = tid & 63, r32 = lane & 31, hi = lane >> 5;
    const int w = __builtin_amdgcn_readfirstlane(tid >> 6);
    constexpr int CPC = (SEQ / DIL) / 256;
    constexpr int NJS = BATCH * NH * 16;
    int cur_bh = -1;
    for (int id = vcu * 4; id < NJS; id += ((id & 3) == 3) ? (G * 4 - 3) : 1) {
        const int bh = id >> 4, sub = id & 15, c = sub / CPC, ck = sub % CPC;
        const int b = bh >> 4, h = bh & 15, n0 = ck * 256;
        const size_t rowb = (size_t)b * SEQ;
        if (bh != cur_bh) {
            cur_bh = bh;
#pragma unroll
            for (int i = 0; i < 10; ++i) {
                const int e = tid + 512 * i, j = e >> 10, rem = e & 1023, rg = rem >> 8, ln = (rem & 255) >> 2, i4 = rem & 3;
                const int r = 4 * rg + i4, a = ln & 31, hh = ln >> 5, kk = 32 * j + crow(r, hh), step = 128 + a - kk;
                float val = -INFINITY;
                if (step >= 0 && step <= 128) val = biasT[h * 132 + step];
                ((LAS float*)(lds + L_B))[e] = val;
            }
        }
#pragma unroll
        for (int i = 0; i < 12; ++i) {
            const int p = w * 12 + i;
            if (p < 48) {
                const int ch = p / 6, kb = p % 6;
                int pos = n0 - 128 + kb * 64 + lane; pos = pos < 0 ? 0 : pos;
                const bf16* src = Kg + (rowb + (size_t)pos * DIL + c) * DM + h * HD + ch * 8;
                __builtin_amdgcn_global_load_lds((const unsigned*)src, (LAS unsigned*)(lds + L_K + ch * 6144 + kb * 1024), 16, 0, 0);
            } else {
                const int q = p - 48, d0 = q / 24, vb = q % 24;
                int pos = n0 - 128 + vb * 16 + (lane >> 2); pos = pos < 0 ? 0 : pos;
                const bf16* src = Vg + (rowb + (size_t)pos * DIL + c) * DM + h * HD + d0 * 32 + (lane & 3) * 8;
                __builtin_amdgcn_global_load_lds((const unsigned*)src, (LAS unsigned*)(lds + L_V + d0 * 24576 + vb * 1024), 16, 0, 0);
            }
        }
        const size_t qrow = rowb + (size_t)(n0 + 32 * w + r32) * DIL + c;
        bf16x8 qr[4];
#pragma unroll
        for (int d0 = 0; d0 < 4; ++d0) qr[d0] = *(const bf16x8*)(QO + qrow * DM + h * HD + d0 * 16 + hi * 8);
        asm volatile("s_waitcnt vmcnt(0)" ::: "memory");
        __syncthreads();
        const int jstart = (n0 == 0 && w < 4) ? 4 - w : 0;
        f32x16 S[5];
#pragma unroll
        for (int j = 0; j < 5; ++j) {
            if (j < jstart) {
#pragma unroll
                for (int r = 0; r < 16; ++r) S[j][r] = -INFINITY;
            } else {
                f32x16 cinit;
#pragma unroll
                for (int rg = 0; rg < 4; ++rg) { const f32x4 t = *(const LAS f32x4*)(lds + L_B + j * 4096 + rg * 1024 + lane * 16); cinit[4 * rg] = t[0]; cinit[4 * rg + 1] = t[1]; cinit[4 * rg + 2] = t[2]; cinit[4 * rg + 3] = t[3]; }
#pragma unroll
                for (int d0 = 0; d0 < 4; ++d0) {
                    const bf16x8 kf = *(const LAS bf16x8*)(lds + L_K + (2 * d0 + hi) * 6144 + (32 * w + 32 * j + r32) * 16);
                    cinit = __builtin_amdgcn_mfma_f32_32x32x16_bf16(kf, qr[d0], cinit, 0, 0, 0);
                }
                S[j] = cinit;
            }
        }
        float m = -INFINITY;
#pragma unroll
        for (int j = 0; j < 5; ++j)
#pragma unroll
            for (int r = 0; r < 16; ++r) m = fmaxf(m, S[j][r]);
        m = swapmax(m);
        float lsum = 0.f;
#pragma unroll
        for (int j = 0; j < 5; ++j)
#pragma unroll
            for (int r = 0; r < 16; ++r) { const float p = __builtin_amdgcn_exp2f(S[j][r] - m); S[j][r] = p; lsum += p; }
        lsum = swapsum(lsum);
        f32x16 o[2];
#pragma unroll
        for (int r = 0; r < 16; ++r) { o[0][r] = 0.f; o[1][r] = 0.f; }
        const LAS unsigned char* vbase = lds + L_V + (32 * w + 4 * hi + ((lane & 15) >> 2)) * 64 + ((lane >> 4) & 1) * 32 + (lane & 3) * 8;
#pragma unroll
        for (int j = 0; j < 5; ++j)
#pragma unroll
            for (int s = 0; s < 2; ++s) {
                v4u pw; pw.x = pk2(S[j][8 * s], S[j][8 * s + 1]); pw.y = pk2(S[j][8 * s + 2], S[j][8 * s + 3]); pw.z = pk2(S[j][8 * s + 4], S[j][8 * s + 5]); pw.w = pk2(S[j][8 * s + 6], S[j][8 * s + 7]);
                const bf16x8 pa = __builtin_bit_cast(bf16x8, pw);
#pragma unroll
                for (int d0 = 0; d0 < 2; ++d0) {
                    const s16x4 lo = vtr(vbase + d0 * 24576 + (32 * j + 16 * s) * 64), hh = vtr(vbase + d0 * 24576 + (32 * j + 16 * s + 8) * 64);
                    const bf16x8 vf = (bf16x8){lo[0], lo[1], lo[2], lo[3], hh[0], hh[1], hh[2], hh[3]};
                    o[d0] = __builtin_amdgcn_mfma_f32_32x32x16_bf16(pa, vf, o[d0], 0, 0, 0);
                }
            }
        LAS float* wsf = (LAS float*)(lds + L_WS) + w * 64;
        if (hi == 0) { wsf[r32] = lsum; lse[qrow * 16 + h] = m + log2f(lsum); }
        asm volatile("s_waitcnt lgkmcnt(0)" ::: "memory");
        float rli[16];
#pragma unroll
        for (int r = 0; r < 16; ++r) rli[r] = 1.0f / wsf[crow(r, hi)];
        LAS bf16* stg = (LAS bf16*)(lds + L_O) + w * 2048;
#pragma unroll
        for (int r = 0; r < 16; ++r) { const int orow = crow(r, hi);
#pragma unroll
            for (int d0 = 0; d0 < 2; ++d0) stg[orow * 64 + d0 * 32 + r32] = (bf16)f2bf(o[d0][r] * rli[r]); }
        asm volatile("s_waitcnt lgkmcnt(0)" ::: "memory");
#pragma unroll
        for (int i = 0; i < 4; ++i) { const int row = i * 8 + (lane >> 3), ch = lane & 7; const v4u v = *(const LAS v4u*)(stg + row * 64 + ch * 8);
            *(v4u*)(OUT + (rowb + (size_t)(n0 + 32 * w + row) * DIL + c) * DM + h * HD + ch * 8) = v; }
        __syncthreads();
    }
}
}

#ifndef OPT_C1
#define OPT_C1 0
#endif
#ifndef OPT_RES
#define OPT_RES 0
#endif
#ifndef OPT_A1
#define OPT_A1 0
#endif
#ifndef OPT_A2
#define OPT_A2 0
#endif
#ifndef OPT_A3
#define OPT_A3 0
#endif
#ifndef DUP_A2
#define DUP_A2 0
#endif
#ifndef DUP_A1
#define DUP_A1 0
#endif
#ifndef DUP_C1
#define DUP_C1 0
#endif
#ifndef DUP_A3
#define DUP_A3 0
#endif
#ifndef DUP_P0
#define DUP_P0 0
#endif
#ifndef DUP_C3
#define DUP_C3 0
#endif
#ifndef DUP_C2
#define DUP_C2 0
#endif
#ifndef MK_PER_PHASE
#define MK_PER_PHASE 1
#endif
constexpr int LDS_BYTES = 155648;
constexpr int MISC_OFF = 151552;
struct Args { const float* in[11]; float* out; unsigned char* ws; int ph_lo, ph_hi; };

template <int PH> __device__ __forceinline__ void run_phase(const Args& args, LAS unsigned char* lds) {
    const int tid = threadIdx.x, lane = tid & 63, wave = __builtin_amdgcn_readfirstlane(tid >> 6);
    const int G = gridDim.x, bx = blockIdx.x, vcu = (G % 8 == 0) ? (bx % 8) * (G / 8) + bx / 8 : bx;
    unsigned char* ws = args.ws;
    float* SSQ = (float*)(ws + WS_SSQ); bf16* XB = (bf16*)(ws + WS_XB);
    LAS float* smf = (LAS float*)lds;
    const int gtid = vcu * 512 + tid, gthreads = G * 512;
    (void)lane; (void)wave; (void)smf; (void)gtid; (void)gthreads; (void)SSQ; (void)XB;
    if constexpr (PH == 0) {
        Ptrs P;
        P.x = args.in[0]; P.conv_norm = args.in[1]; P.conv_w_in = args.in[2]; P.conv_w = args.in[3]; P.conv_w_out = args.in[4]; P.attn_norm = args.in[5];
        P.attn_w_in = args.in[6]; P.q_gain = args.in[7]; P.k_gain = args.in[8]; P.attn_w_out = args.in[9]; P.rel_bias = args.in[10]; P.out = args.out; P.ws = args.ws;
#if DUP_P0
        p0_prologue(P, lds, vcu, G, wave, lane, tid);
#endif
        p0_prologue(P, lds, vcu, G, wave, lane, tid);
    } else {
        constexpr int p = PH - 1, j = p / 11, s = p % 11;
        if constexpr (s == 0) {
            bf16* CV = (bf16*)(ws + WS_CV); bf16* CG = (bf16*)(ws + WS_CG);
#if OPT_C1
            pg8::Gemm g{XB, (const bf16*)(ws + WS_W1) + (size_t)j * CN * DM, MROWS, CN, DM}; pg8::StaticOrder S; S.init(MROWS, CN, G, bx);
            epi::ConvIn E{SSQ, CV, CG};
#if DUP_C1
            pg8::gemm_phase<epi::ConvIn, pg8::StaticOrder, true, true>(lds, g, S, E);
#endif
            pg8::gemm_phase<epi::ConvIn, pg8::StaticOrder, true, true>(lds, g, S, E);
#else
            naive::c1(smf, XB, SSQ, args.in[2] + (size_t)j * DM * CN, args.in[1] + j * DM, CV, CG, bx, G);
#endif
        } else if constexpr (s == 1) {
#if DUP_C2
            conv_pass<true>((const bf16*)(ws + WS_CV), (bf16*)(ws + WS_CG), (bf16*)(ws + WS_END), args.in[3] + (size_t)j * 3 * CE, gtid, gthreads);
#endif
            conv_pass<false>((const bf16*)(ws + WS_CV), (bf16*)(ws + WS_CG), (bf16*)(ws + WS_CG), args.in[3] + (size_t)j * 3 * CE, gtid, gthreads);
        } else if constexpr (s == 2 || s == 10) {
            const bf16* A = (const bf16*)(ws + (s == 2 ? WS_CG : WS_Y)); constexpr int K = s == 2 ? CE : DM;
            const float* xin = (j == 0 && s == 2) ? args.in[0] : args.out;
#if OPT_RES
            pg8::Gemm g{A, (const bf16*)(ws + (s == 2 ? WS_W2 : WS_W4)) + (size_t)j * DM * K, MROWS, DM, K}; pg8::StaticOrder S; S.init(MROWS, DM, G, bx);
            epi::Resid E{xin, args.out, XB, SSQ};
#if DUP_C3
            if constexpr (j == 0 && s == 2) pg8::gemm_phase<epi::Resid, pg8::StaticOrder, false, true>(lds, g, S, E);
#endif
            pg8::gemm_phase<epi::Resid, pg8::StaticOrder, false, true>(lds, g, S, E);
#else
            naive::resid(smf, A, K, s == 2 ? args.in[4] + (size_t)j * CE * DM : args.in[9] + (size_t)j * DM * DM, xin, args.out, XB, SSQ, bx, G);
#endif
        } else if constexpr (s == 9) {
            const bf16* O0 = (const bf16*)(ws + WS_QO); const bf16* O1 = O0 + (size_t)MROWS * DM; const bf16* O2 = O1 + (size_t)MROWS * DM;
            float* LSE = (float*)(ws + WS_LSE); bf16* YB = (bf16*)(ws + WS_Y);
#if OPT_A3
            pg8::Gemm g{XB, (const bf16*)(ws + WS_W3) + (size_t)j * AN * DM + (size_t)QKVC * DM, MROWS, DM, DM}; pg8::StaticOrder S; S.init(MROWS, DM, G, bx);
            epi::ZMerge E{SSQ, O0, O1, O2, LSE, YB};
#if DUP_A3
            pg8::gemm_phase<epi::ZMerge, pg8::StaticOrder, false, true>(lds, g, S, E);
#endif
            pg8::gemm_phase<epi::ZMerge, pg8::StaticOrder, false, true>(lds, g, S, E);
#else
            naive::a3(smf, XB, SSQ, args.in[6] + (size_t)j * DM * AN, args.in[5] + j * DM, O0, O1, O2, LSE, YB, bx, G);
#endif
        } else {
            constexpr int g = (s - 3) >> 1; bf16* QO = (bf16*)(ws + WS_QO) + (size_t)g * MROWS * DM;
            bf16* KB = (bf16*)(ws + WS_K); bf16* VB = (bf16*)(ws + WS_V);
            if constexpr (((s - 3) & 1) == 0) {
#if OPT_A1
                pg8::Gemm gm{XB, (const bf16*)(ws + WS_W3) + (size_t)j * AN * DM + (size_t)g * 3072 * DM, MROWS, 3072, DM}; pg8::StaticOrder S; S.init(MROWS, 3072, G, bx);
                epi::QKV E{SSQ, QO, KB, VB, args.in[7] + (j * NG + g) * HD, args.in[8] + (j * NG + g) * HD};
#if DUP_A1
                pg8::gemm_phase<epi::QKV, pg8::StaticOrder, true, true>(lds, gm, S, E);
#endif
                pg8::gemm_phase<epi::QKV, pg8::StaticOrder, true, true>(lds, gm, S, E);
#else
                naive::a1(smf, XB, SSQ, args.in[6] + (size_t)j * DM * AN, args.in[5] + j * DM, g, args.in[7] + (j * NG + g) * HD, args.in[8] + (j * NG + g) * HD, QO, KB, VB, bx, G);
#endif
            } else {
                constexpr int dil = g == 0 ? 1 : (g == 1 ? 4 : 16);
                float* LSE = (float*)(ws + WS_LSE); const float* BT = (const float*)(ws + WS_BIAS);
#if OPT_A2
#if DUP_A2
                attn::phase<dil>(lds, QO, (bf16*)(ws + WS_END), KB, VB, BT + g * NH * 132, LSE + (size_t)g * MROWS * 16, vcu, G);
#endif
                attn::phase<dil>(lds, QO, QO, KB, VB, BT + g * NH * 132, LSE + (size_t)g * MROWS * 16, vcu, G);
#else
                naive::a2(QO, KB, VB, BT + g * NH * 132, LSE + (size_t)g * MROWS * 16, dil, gtid, gthreads);
#endif
            }
        }
    }
}

__global__ void __launch_bounds__(512, 2) mk_fwd(Args args) {
    extern __shared__ __attribute__((aligned(16))) unsigned char lds_raw[];
    LAS unsigned char* lds = (LAS unsigned char*)lds_raw;
    volatile LAS unsigned* MISC = (volatile LAS unsigned*)(lds + MISC_OFF);
    for (int u = threadIdx.x; u < (LDS_BYTES - MISC_OFF) / 4; u += 512) ((LAS unsigned*)(lds + MISC_OFF))[u] = 0u;
    __syncthreads();
    gu32* ctl = (gu32*)(args.ws + WS_CTL);
    XcdBarrier bar; bar.bar = (unsigned*)(ctl + CW_BAR); bar.x = 0; bar.st = nullptr;
    const int lo = args.ph_lo, hi = args.ph_hi;
    if (hi - lo > 1) bar = xcd_barrier_post((unsigned*)(ctl + CW_BAR), MISC + 8);
#define RUN(k) if (lo <= (k) && (k) < hi) { run_phase<(k)>(args, lds); if ((k) + 1 < hi) xcd_barrier(bar); }
    RUN(0) RUN(1) RUN(2) RUN(3) RUN(4) RUN(5) RUN(6) RUN(7) RUN(8) RUN(9) RUN(10) RUN(11)
    RUN(12) RUN(13) RUN(14) RUN(15) RUN(16) RUN(17) RUN(18) RUN(19) RUN(20) RUN(21) RUN(22)
#undef RUN
}

extern "C" void kernel_launch(void* const* d_in, const int* in_sizes, int n_in, void* d_out, int out_size, void* d_ws, size_t ws_size, hipStream_t stream) {
    static int grid = 0;
    if (grid == 0) {
        if (n_in != 11 || in_sizes[0] != MROWS * DM || out_size != MROWS * DM || ws_size < WS_END) { fprintf(stderr, "kernel_launch: unexpected shapes (n_in %d, ws %zu); nothing launched\n", n_in, ws_size); grid = -1; return; }
        int dev = 0, cus = 0, per_cu = 0;
        if (hipGetDevice(&dev) != hipSuccess || hipDeviceGetAttribute(&cus, hipDeviceAttributeMultiprocessorCount, dev) != hipSuccess) { grid = -1; return; }
        if (hipFuncSetAttribute((const void*)mk_fwd, hipFuncAttributeMaxDynamicSharedMemorySize, LDS_BYTES) != hipSuccess) { fprintf(stderr, "kernel_launch: hipFuncSetAttribute failed\n"); grid = -1; return; }
        if (hipOccupancyMaxActiveBlocksPerMultiprocessor(&per_cu, (const void*)mk_fwd, 512, LDS_BYTES) != hipSuccess || per_cu < 1) { fprintf(stderr, "kernel_launch: occupancy query says %d blocks per CU; nothing launched\n", per_cu); (void)hipGetLastError(); grid = -1; return; }
        grid = cus;
    }
    if (grid < 0) return;
    (void)hipMemsetAsync((char*)d_ws + WS_CTL, 0, CTL_ZERO_BYTES, stream);
    Args a{};
    for (int i = 0; i < 11; ++i) a.in[i] = (const float*)d_in[i];
    a.out = (float*)d_out; a.ws = (unsigned char*)d_ws;
#if MK_PER_PHASE
    for (int ph = 0; ph < NPHASE; ++ph) { a.ph_lo = ph; a.ph_hi = ph + 1; hipLaunchKernelGGL(mk_fwd, dim3(grid), dim3(512), LDS_BYTES, stream, a); }
#else
    a.ph_lo = 0; a.ph_hi = NPHASE; hipLaunchKernelGGL(mk_fwd, dim3(grid), dim3(512), LDS_BYTES, stream, a);
#endif
}
```

```cpp
#include <hip/hip_runtime.h>
#include <cstdio>
#include <cstdint>
#include <cmath>
#define MK_PER_PHASE 0
#define OPT_C1 1
#define OPT_RES 1
#define OPT_A1 1
#define OPT_A3 1
#define OPT_A2 1
namespace pg8 {
#define PG8_LAS __attribute__((address_space(3)))
typedef unsigned short bf16_t;
typedef short bf16x8 __attribute__((ext_vector_type(8)));
typedef float f32x4 __attribute__((ext_vector_type(4)));
typedef unsigned u32x4 __attribute__((ext_vector_type(4)));
constexpr int BM = 256, BK = 64, HALF = 128, HTB = HALF * BK * 2  , STAGE_BYTES = 8 * HTB, NXCD = 8, WGM = 8;

__host__ __device__ __forceinline__ int lds_byte(int r, int c) { const int st = (r >> 4) * 2 + (c >> 5), rr = r & 15, cc = c & 31, ob = rr * 64 + cc * 2; return st * 1024 + (ob ^ (((ob >> 9) & 1) << 5)); }
__host__ __device__ __forceinline__ void stage_rc(int b, int& R, int& C) { const int st = b / 1024, sb = b % 1024, swz = sb ^ (((sb >> 9) & 1) << 5); R = (st >> 1) * 16 + swz / 64; C = (st & 1) * 32 + (swz % 64) / 2; }
__host__ __device__ __forceinline__ int perm32(int rho) { const int n = rho >> 4, i = rho & 15; return 8 * (i >> 2) + 4 * n + (i & 3); }

struct Unit { int pm, pn; };
struct Gemm { const bf16_t* A; const bf16_t* Bt; int M, N, K; };

struct StaticOrder {
    int nM, nN, nwg, G, c;
    __host__ __device__ void init(int M, int N, int G_, int c_) { nM = M / BM; nN = N / BM; nwg = nM * nN; G = G_; c = c_; }
    __host__ __device__ bool next(int i, Unit& u) const {
        const long L = (long)i * G + c; if (L >= nwg) return false;
        int wgid = (int)L; { const int q = nwg / NXCD, r = nwg % NXCD, xcd = wgid % NXCD, off = wgid / NXCD; wgid = (xcd < r ? xcd * (q + 1) : r * (q + 1) + (xcd - r) * q) + off; }
        const int nig = WGM * nN, gid = wgid / nig, fm = gid * WGM, gsz = (nM - fm) < WGM ? (nM - fm) : WGM;
        u.pm = fm + ((wgid % nig) % gsz); u.pn = (wgid % nig) / gsz; return true;
    }
    __device__ __forceinline__ void a_ready(const Unit&) const {}
    __device__ __forceinline__ void done(const Unit&) const {}
};

__device__ __forceinline__ unsigned cvt_pk_bf16(float lo, float hi) { unsigned r; asm volatile("v_cvt_pk_bf16_f32 %0, %1, %2" : "=v"(r) : "v"(lo), "v"(hi)); return r; }
typedef float f32x2 __attribute__((ext_vector_type(2)));

template <class Epi, class Sched, bool ALIGN_EPI = false, bool SP2 = false>
__device__ __forceinline__ void gemm_phase(PG8_LAS unsigned char* lds, const Gemm g, const Sched& S, const Epi& E) {
    const int tid = threadIdx.x, wid = __builtin_amdgcn_readfirstlane(tid >> 6), lane = tid & 63, wr = wid >> 2, wc = wid & 3, fr = lane & 15, fq = lane >> 4;
    const int K = g.K, nt = K / BK;
    unsigned voffA[2], voffB[2];
#pragma unroll
    for (int i = 0; i < 2; ++i) { int R, C; stage_rc(tid * 16 + i * 8192, R, C); const int Rb = Epi::PERM ? ((R & ~31) + perm32(R & 31)) : R;
        voffA[i] = (unsigned)(R * K + C) * 2u; voffB[i] = (unsigned)(Rb * K + C) * 2u; }
    const size_t kstep = (size_t)(BK * 2);
    const size_t hstep = (size_t)HALF * K * 2;
    const size_t tstep = 2 * hstep;
    const unsigned ldsw = (unsigned)wid * 1024u;
    const int aoff = lds_byte(wr * 64 + fr, fq * 8), boff = lds_byte(wc * 32 + fr, fq * 8);
#define PG8_SA(b, h) (((b) * 2 + (h)) * HTB)
#define PG8_SB(b, h) ((4 + (b) * 2 + (h)) * HTB)
#define PG8_STAGE(bufoff, gbase, voff) do { _Pragma("unroll") for (int _i = 0; _i < 2; ++_i) \
        __builtin_amdgcn_global_load_lds((const unsigned*)((const char*)(gbase) + (voff)[_i]), (PG8_LAS unsigned*)(lds + (bufoff) + ldsw + _i * 8192), 16, 0, 0); } while (0)
#define PG8_LDA(dst, b, h) do { _Pragma("unroll") for (int m = 0; m < 4; ++m) _Pragma("unroll") for (int k = 0; k < 2; ++k) dst[m][k] = *(const PG8_LAS bf16x8*)(lds + PG8_SA(b, h) + aoff + m * 2048 + k * 1024); } while (0)
#define PG8_LDB(dst, b, h) do { _Pragma("unroll") for (int n = 0; n < 2; ++n) _Pragma("unroll") for (int k = 0; k < 2; ++k) dst[n][k] = *(const PG8_LAS bf16x8*)(lds + PG8_SB(b, h) + boff + n * 2048 + k * 1024); } while (0)
#define PG8_MMA(ai, bj, At, Bt) do { __builtin_amdgcn_s_setprio(1); _Pragma("unroll") for (int m = 0; m < 4; ++m) _Pragma("unroll") for (int n = 0; n < 2; ++n) _Pragma("unroll") for (int k = 0; k < 2; ++k) \
        acc[ai][bj][m][n] = __builtin_amdgcn_mfma_f32_16x16x32_bf16(Bt[n][k], At[m][k], acc[ai][bj][m][n], 0, 0, 0); __builtin_amdgcn_s_setprio(0); } while (0)
#define PG8_WAIT_V(n) asm volatile("s_waitcnt vmcnt(" #n ")" ::: "memory")
#define PG8_WAIT_L(n) asm volatile("s_waitcnt lgkmcnt(" #n ")" ::: "memory")
#define PG8_BAR __builtin_amdgcn_s_barrier()
#define PG8_SCHED __builtin_amdgcn_sched_barrier(0)
    Unit cur, nxt; int ui = 0;
    if (!S.next(0, cur)) return;
    f32x4 acc[2][2][4][2];
#pragma unroll
    for (int a = 0; a < 2; ++a)
#pragma unroll
        for (int b = 0; b < 2; ++b)
#pragma unroll
            for (int m = 0; m < 4; ++m)
#pragma unroll
                for (int n = 0; n < 2; ++n) acc[a][b][m][n] = (f32x4){0.f, 0.f, 0.f, 0.f};
    bf16x8 At[4][2], B0[2][2], B1[2][2];
    const char* cA = (const char*)g.A + (size_t)cur.pm * tstep; const char* cB = (const char*)g.Bt + (size_t)cur.pn * tstep;
    S.a_ready(cur);
    if constexpr (SP2) {
        PG8_STAGE(PG8_SB(0, 0), cB, voffB); PG8_STAGE(PG8_SB(0, 1), cB + hstep, voffB); PG8_STAGE(PG8_SA(0, 0), cA, voffA); PG8_STAGE(PG8_SA(0, 1), cA + hstep, voffA);
        if (wr == 1) PG8_BAR;
        PG8_WAIT_V(2); PG8_BAR;
        PG8_STAGE(PG8_SB(1, 0), cB + kstep, voffB); PG8_STAGE(PG8_SA(1, 0), cA + kstep, voffA); PG8_STAGE(PG8_SB(1, 1), cB + hstep + kstep, voffB);
        PG8_WAIT_V(6); PG8_BAR;
    } else {
        PG8_STAGE(PG8_SB(0, 0), cB, voffB); PG8_STAGE(PG8_SA(0, 0), cA, voffA); PG8_STAGE(PG8_SB(0, 1), cB + hstep, voffB); PG8_STAGE(PG8_SA(0, 1), cA + hstep, voffA);
        if (wr == 1) PG8_BAR;
        PG8_WAIT_V(4); PG8_BAR;
        PG8_STAGE(PG8_SB(1, 0), cB + kstep, voffB); PG8_STAGE(PG8_SA(1, 0), cA + kstep, voffA); PG8_STAGE(PG8_SB(1, 1), cB + hstep + kstep, voffB);
        PG8_WAIT_V(6); PG8_BAR;
    }
    for (;;) {
        const bool has_next = S.next(ui + 1, nxt);
        const char* nA = has_next ? (const char*)g.A + (size_t)nxt.pm * tstep : cA; const char* nB = has_next ? (const char*)g.Bt + (size_t)nxt.pn * tstep : cB;
        for (int t = 0; t < nt; t += 2) {
            const bool last = (t == nt - 2);
            const char* a1 = cA + (size_t)(t + 1) * kstep;
            const char* a2 = last ? nA : cA + (size_t)(t + 2) * kstep; const char* b2 = last ? nB : cB + (size_t)(t + 2) * kstep;
            const char* a3 = a2 + kstep; const char* b3 = b2 + kstep;
            if (last && has_next) S.a_ready(nxt);
            if constexpr (SP2) {
            PG8_LDB(B0, 0, 0); PG8_LDB(B1, 0, 1); PG8_SCHED; PG8_LDA(At, 0, 0); PG8_STAGE(PG8_SA(1, 1), a1 + hstep, voffA);
            PG8_WAIT_V(8); PG8_WAIT_L(0); PG8_BAR; PG8_MMA(0, 0, At, B0); PG8_MMA(0, 1, At, B1); PG8_BAR; PG8_SCHED;
            PG8_LDA(At, 0, 1); PG8_STAGE(PG8_SB(0, 0), b2, voffB); PG8_STAGE(PG8_SB(0, 1), b2 + hstep, voffB); PG8_STAGE(PG8_SA(0, 0), a2, voffA);
            PG8_WAIT_V(8); PG8_WAIT_L(0); PG8_BAR; PG8_MMA(1, 0, At, B0); PG8_MMA(1, 1, At, B1); PG8_BAR; PG8_SCHED;
            PG8_LDB(B0, 1, 0); PG8_LDB(B1, 1, 1); PG8_SCHED; PG8_LDA(At, 1, 0); PG8_STAGE(PG8_SA(0, 1), a2 + hstep, voffA);
            PG8_WAIT_V(8); PG8_WAIT_L(0); PG8_BAR; PG8_MMA(0, 0, At, B0); PG8_MMA(0, 1, At, B1); PG8_BAR; PG8_SCHED;
            PG8_LDA(At, 1, 1); PG8_STAGE(PG8_SB(1, 0), b3, voffB); PG8_STAGE(PG8_SB(1, 1), b3 + hstep, voffB); PG8_STAGE(PG8_SA(1, 0), a3, voffA);
            PG8_WAIT_V(8); PG8_WAIT_L(0); PG8_BAR; PG8_MMA(1, 0, At, B0); PG8_MMA(1, 1, At, B1); PG8_BAR; PG8_SCHED;
            } else {
            PG8_LDB(B0, 0, 0); PG8_SCHED; PG8_LDA(At, 0, 0); PG8_STAGE(PG8_SA(1, 1), a1 + hstep, voffA);
            PG8_WAIT_L(8); PG8_BAR; PG8_WAIT_L(0); PG8_MMA(0, 0, At, B0); PG8_BAR; PG8_SCHED;
            PG8_LDB(B1, 0, 1); PG8_STAGE(PG8_SB(0, 0), b2, voffB);
            PG8_BAR; PG8_WAIT_L(0); PG8_MMA(0, 1, At, B1); PG8_BAR;
            PG8_LDA(At, 0, 1); PG8_STAGE(PG8_SA(0, 0), a2, voffA);
            PG8_BAR; PG8_WAIT_L(0); PG8_MMA(1, 0, At, B0); PG8_BAR; PG8_SCHED;
            PG8_STAGE(PG8_SB(0, 1), b2 + hstep, voffB);
            PG8_WAIT_V(6); PG8_BAR; PG8_MMA(1, 1, At, B1); PG8_BAR;
            PG8_LDB(B0, 1, 0); PG8_SCHED; PG8_LDA(At, 1, 0); PG8_STAGE(PG8_SA(0, 1), a2 + hstep, voffA);
            PG8_WAIT_L(8); PG8_BAR; PG8_WAIT_L(0); PG8_MMA(0, 0, At, B0); PG8_BAR; PG8_SCHED;
            PG8_LDB(B1, 1, 1); PG8_STAGE(PG8_SB(1, 0), b3, voffB);
            PG8_BAR; PG8_WAIT_L(0); PG8_MMA(0, 1, At, B1); PG8_BAR;
            PG8_LDA(At, 1, 1); PG8_STAGE(PG8_SA(1, 0), a3, voffA);
            PG8_BAR; PG8_WAIT_L(0); PG8_MMA(1, 0, At, B0); PG8_BAR; PG8_SCHED;
            PG8_STAGE(PG8_SB(1, 1), b3 + hstep, voffB);
            PG8_WAIT_V(6); PG8_BAR; PG8_MMA(1, 1, At, B1); PG8_BAR;
            }
        }
        if constexpr (ALIGN_EPI) { if (wr == 0) PG8_BAR; }
        if constexpr (!Epi::AFTER_DRAIN) { E(acc, cur, wr, wc, fr, fq); S.done(cur); }
        if (!has_next) break;
#pragma unroll
        for (int a = 0; a < 2; ++a)
#pragma unroll
            for (int b = 0; b < 2; ++b)
#pragma unroll
                for (int m = 0; m < 4; ++m)
#pragma unroll
                    for (int n = 0; n < 2; ++n) acc[a][b][m][n] = (f32x4){0.f, 0.f, 0.f, 0.f};
        cur = nxt; cA = nA; cB = nB; ++ui;
        if constexpr (ALIGN_EPI) { if (wr == 1) PG8_BAR; }
    }
    PG8_WAIT_V(0);
    if constexpr (!ALIGN_EPI) { if (wr == 0) PG8_BAR; }
    PG8_BAR;
    if constexpr (Epi::AFTER_DRAIN) { E.fused(acc, cur, wr, wc, fr, fq, lds, wid, lane); S.done(cur); }
#undef PG8_SA
#undef PG8_SB
#undef PG8_STAGE
#undef PG8_LDA
#undef PG8_LDB
#undef PG8_MMA
#undef PG8_WAIT_V
#undef PG8_WAIT_L
#undef PG8_BAR
#undef PG8_SCHED
}
}

constexpr int BATCH = 4, SEQ = 4096, DM = 1024, MROWS = BATCH * SEQ;
constexpr int CE = 2048, CN = 4 * CE;
constexpr int NH = 16, HD = 64, NG = 3, QKVC = 9216, AN = 10240;
constexpr float EPS = 1e-6f, LOG2E = 1.4426950408889634f, QSCALE = 0.125f * LOG2E;
constexpr int NPHASE = 23;

constexpr size_t MiB = 1u << 20;
constexpr size_t WS_CTL = 0, CTL_ZERO_BYTES = 1 * MiB;
constexpr size_t WS_SSQ = 1 * MiB;
constexpr size_t WS_W1 = 2 * MiB, WS_W2 = 34 * MiB, WS_W3 = 42 * MiB, WS_W4 = 82 * MiB;
constexpr size_t WS_LSE = 86 * MiB;
constexpr size_t WS_BIAS = 89 * MiB;
constexpr size_t WS_XB = 90 * MiB;
constexpr size_t WS_CV = 122 * MiB, WS_CG = 186 * MiB;
constexpr size_t WS_QO = 122 * MiB;
constexpr size_t WS_K = 218 * MiB, WS_V = 250 * MiB, WS_Y = WS_K;
constexpr size_t WS_END = 282 * MiB;
constexpr int CW_TMO = 0, CW_BAR = 4096;

#define GAS __attribute__((address_space(1)))
#define LAS __attribute__((address_space(3)))
typedef unsigned short bf16;
typedef unsigned v4u __attribute__((ext_vector_type(4)));
typedef unsigned v2u __attribute__((ext_vector_type(2)));
typedef float f32x4 __attribute__((ext_vector_type(4)));
typedef short bf16x8 __attribute__((ext_vector_type(8)));
typedef GAS unsigned gu32;
#define RLX_AGENT __ATOMIC_RELAXED, __HIP_MEMORY_SCOPE_AGENT
#define LDS_WAIT() asm volatile("s_waitcnt lgkmcnt(0)" ::: "memory")
#define VM_WAIT() asm volatile("s_waitcnt vmcnt(0)" ::: "memory")
__device__ __forceinline__ unsigned f2bf(float f) { unsigned u = __builtin_bit_cast(unsigned, f); return (u + 0x7fffu + ((u >> 16) & 1u)) >> 16; }
typedef float f32x2_t __attribute__((ext_vector_type(2))); typedef __bf16 bf16x2_t __attribute__((ext_vector_type(2)));
__device__ __forceinline__ unsigned pk2(float lo, float hi) { f32x2_t v = {lo, hi}; bf16x2_t b = __builtin_convertvector(v, bf16x2_t); return __builtin_bit_cast(unsigned, b); }
__device__ __forceinline__ float bf2f(unsigned h) { return __builtin_bit_cast(float, h << 16); }
__device__ __forceinline__ float bflo(unsigned w) { return __builtin_bit_cast(float, w << 16); }
__device__ __forceinline__ float bfhi(unsigned w) { return __builtin_bit_cast(float, w & 0xffff0000u); }
__device__ __forceinline__ float sigmoidf_(float z) { return __builtin_amdgcn_rcpf(1.0f + __builtin_amdgcn_exp2f(-z * LOG2E)); }
__device__ __forceinline__ float row_rs(const float* ssq, int row) {
    const f32x4* p = (const f32x4*)(ssq + (size_t)row * 16);
    const f32x4 s = (p[0] + p[1]) + (p[2] + p[3]);
    return 1.0f / sqrtf(((s.x + s.y) + (s.z + s.w)) * (1.0f / DM) + EPS);
}
__device__ __forceinline__ float wave_sum(float v) {
#pragma unroll
    for (int o = 1; o < 64; o <<= 1) v += __shfl_xor(v, o);
    return v;
}
__device__ __forceinline__ int t5_bucket(int d) {
    if (d < 16) return d;
    int b = 15;
    b += (d >= 16); b += (d >= 22); b += (d >= 30); b += (d >= 40); b += (d >= 54); b += (d >= 73); b += (d >= 99); b += (d >= 134);
    b += (d >= 182); b += (d >= 246); b += (d >= 332); b += (d >= 450); b += (d >= 609); b += (d >= 825); b += (d >= 1117); b += (d >= 1513);
    return b;
}

#define XB_TMO      128
#define XB_XCNT(j)  (256  + 64 * (j))
#define XB_XSUB(j)  (1280 + 64 * (j))
#define XB_XGEN(j)  (2304 + 64 * (j))
#define XB_TOP      3328
#define XB_TOPGEN   3392
#define XCD_BAR_WORDS 3456
#define XB_SPIN_CAP (1u << 18)

__device__ __forceinline__ unsigned xb_ld(unsigned* p)              { return __hip_atomic_load(p, __ATOMIC_RELAXED, __HIP_MEMORY_SCOPE_AGENT); }
__device__ __forceinline__ unsigned xb_add(unsigned* p, unsigned v) { return __hip_atomic_fetch_add(p, v, __ATOMIC_RELAXED, __HIP_MEMORY_SCOPE_AGENT); }
__device__ __forceinline__ unsigned xb_xcc_id() { return (unsigned)__builtin_amdgcn_s_getreg((3 << 11) | 20) & 0xFu; }
#define XB_SPIN(cond, bar) do { unsigned _sp = 0; while (cond) { __builtin_amdgcn_s_sleep(1); \
    if ((++_sp & 255u) == 0u) { if (xb_ld(&(bar)[XB_TMO])) break; if (_sp > XB_SPIN_CAP) { atomicAdd(&(bar)[XB_TMO], 1u); break; } } } } while (0)

struct XcdBarrier {
    unsigned* bar; unsigned x;
    volatile LAS unsigned* st;
};

__device__ __forceinline__ XcdBarrier xcd_barrier_post(unsigned* bar, volatile LAS unsigned* st) {
    XcdBarrier b; b.bar = bar; b.x = xb_xcc_id(); b.st = st;
    if (threadIdx.x == 0) (void)xb_add(&bar[XB_XCNT(b.x)], 1u);
    return b;
}
__device__ __forceinline__ void xcd_barrier_complete(unsigned* bar, unsigned x, unsigned& nloc, unsigned& nx) {
    const unsigned G = gridDim.x * gridDim.y * gridDim.z;
    unsigned sum, cnt, mine, sp = 0u;
    for (;;) {
        sum = 0u; cnt = 0u; mine = 0u;
#pragma unroll
        for (unsigned j = 0; j < 16; ++j) { const unsigned c = xb_ld(&bar[XB_XCNT(j)]); sum += c; cnt += (c > 0u) ? 1u : 0u; mine = (j == x) ? c : mine; }
        if (sum == G) break;
        __builtin_amdgcn_s_sleep(1);
        if ((++sp & 255u) == 0u) { if (xb_ld(&bar[XB_TMO])) break; if (sp > XB_SPIN_CAP) { atomicAdd(&bar[XB_TMO], 1u); break; } }
    }
    nloc = mine > 0u ? mine : 1u; nx = cnt > 0u ? cnt : 1u;
}

__device__ __forceinline__ void xcd_barrier(const XcdBarrier& b) {
    asm volatile("s_waitcnt vmcnt(0)" ::: "memory");
    __syncthreads();
    if (threadIdx.x == 0) {
        unsigned* bar = b.bar;
        __builtin_amdgcn_s_waitcnt(0);
        unsigned nloc = b.st[0], nx = b.st[1];
        if (nloc == 0u) { xcd_barrier_complete(bar, b.x, nloc, nx); b.st[0] = nloc; b.st[1] = nx; }
        const unsigned old = xb_add(&bar[XB_XSUB(b.x)], 1u);
        const unsigned gen = old / nloc;
        if (old + 1u == (gen + 1u) * nloc) {
            __builtin_amdgcn_fence(__ATOMIC_RELEASE, "agent");
            asm volatile("s_waitcnt vmcnt(0)" ::: "memory");
            const unsigned og = xb_add(&bar[XB_TOP], 1u);
            const unsigned tg = og / nx;
            if (og + 1u == (tg + 1u) * nx) xb_add(&bar[XB_TOPGEN], 1u);
            else XB_SPIN(xb_ld(&bar[XB_TOPGEN]) == tg, bar);
            __builtin_amdgcn_fence(__ATOMIC_ACQUIRE, "agent");
            xb_add(&bar[XB_XGEN(b.x)], 1u);
            asm volatile("s_waitcnt vmcnt(0)" ::: "memory");
        } else {
            XB_SPIN(xb_ld(&bar[XB_XGEN(b.x)]) == gen, bar);
            __builtin_amdgcn_fence(__ATOMIC_ACQUIRE, "agent");
            asm volatile("s_waitcnt vmcnt(0)" ::: "memory");
        }
    }
    __syncthreads();
}

namespace epi {
using pg8::Unit; using pg8::bf16_t;

__device__ __forceinline__ void rows_rs(const float* ssq, int row0  , int fq, float (&rs)[2][4]) {
    f32x4 pp[2][4];
#pragma unroll
    for (int ai = 0; ai < 2; ++ai)
#pragma unroll
        for (int m = 0; m < 4; ++m) pp[ai][m] = *(const f32x4*)(ssq + (size_t)(row0 + ai * 128 + m * 16) * 16 + 4 * fq);
#pragma unroll
    for (int ai = 0; ai < 2; ++ai)
#pragma unroll
        for (int m = 0; m < 4; ++m) { float t = (pp[ai][m][0] + pp[ai][m][1]) + (pp[ai][m][2] + pp[ai][m][3]); t += __shfl_xor(t, 16); t += __shfl_xor(t, 32); rs[ai][m] = __builtin_amdgcn_rsqf(t * (1.0f / DM) + EPS); }
}
struct ConvIn {
    static constexpr bool PERM = false, AFTER_DRAIN = false;
    const float* ssq; bf16_t* V; bf16_t* G;
    __device__ __forceinline__ void operator()(const f32x4 (&acc)[2][2][4][2], const Unit& u, int wr, int wc, int fr, int fq) const {
        const int ch0 = u.pn * 64 + wc * 16 + 4 * fq;
        float rsv[2][4]; rows_rs(ssq, u.pm * 256 + wr * 64 + fr, fq, rsv);
#pragma unroll
        for (int ai = 0; ai < 2; ++ai)
#pragma unroll
            for (int m = 0; m < 4; ++m) {
                const int row = u.pm * 256 + ai * 128 + wr * 64 + m * 16 + fr;
                const float rs = rsv[ai][m];
                const f32x4 b = acc[ai][0][m][0] * rs, c = acc[ai][0][m][1] * rs, uu = acc[ai][1][m][0] * rs, z = acc[ai][1][m][1] * rs;
                const f32x4 v = c * uu;
                f32x4 g;
#pragma unroll
                for (int i = 0; i < 4; ++i) g[i] = b[i] * z[i] * sigmoidf_(z[i]);
                v2u wv, wg; wv.x = pk2(v[0], v[1]); wv.y = pk2(v[2], v[3]); wg.x = pk2(g[0], g[1]); wg.y = pk2(g[2], g[3]);
                *(v2u*)(V + (size_t)row * CE + ch0) = wv;
                *(v2u*)(G + (size_t)row * CE + ch0) = wg;
            }
    }
};
struct Resid {
    static constexpr bool PERM = false, AFTER_DRAIN = false;
    const float* xin; float* xout; bf16_t* xb; float* ssq;
    __device__ __forceinline__ void operator()(const f32x4 (&acc)[2][2][4][2], const Unit& u, int wr, int wc, int fr, int fq) const {
        const int col0 = u.pn * 256 + wc * 32 + 4 * fq;
        const size_t off0 = (size_t)(u.pm * 256 + wr * 64 + fr) * DM + col0;
        f32x4 pre[4][2][2];
#pragma unroll
        for (int i = 0; i < 4; ++i)
#pragma unroll
            for (int bj = 0; bj < 2; ++bj)
#pragma unroll
                for (int n = 0; n < 2; ++n) pre[i][bj][n] = *(const f32x4*)(xin + off0 + (size_t)(16 * i) * DM + bj * 128 + n * 16);
#pragma unroll
        for (int i = 0; i < 8; ++i) {
            const int ai = i >> 2, m = i & 3;
            const size_t off = off0 + (size_t)(ai * 128 + m * 16) * DM;
            float ss = 0.f; f32x4 xn[2][2];
#pragma unroll
            for (int bj = 0; bj < 2; ++bj)
#pragma unroll
                for (int n = 0; n < 2; ++n) { xn[bj][n] = pre[i & 3][bj][n] + acc[ai][bj][m][n]; const f32x4 t = xn[bj][n]; ss += (t[0] * t[0] + t[1] * t[1]) + (t[2] * t[2] + t[3] * t[3]); }
            if (i < 4) {
#pragma unroll
                for (int bj = 0; bj < 2; ++bj)
#pragma unroll
                    for (int n = 0; n < 2; ++n) pre[i & 3][bj][n] = *(const f32x4*)(xin + off + (size_t)128 * DM + bj * 128 + n * 16);
            }
#pragma unroll
            for (int bj = 0; bj < 2; ++bj)
#pragma unroll
                for (int n = 0; n < 2; ++n) {
                    *(f32x4*)(xout + off + bj * 128 + n * 16) = xn[bj][n];
                    v2u w; w.x = pk2(xn[bj][n][0], xn[bj][n][1]); w.y = pk2(xn[bj][n][2], xn[bj][n][3]);
                    *(v2u*)(xb + off + bj * 128 + n * 16) = w;
                }
            ss += __shfl_xor(ss, 16); ss += __shfl_xor(ss, 32);
            if (fq == 0) ssq[(size_t)(u.pm * 256 + ai * 128 + wr * 64 + m * 16 + fr) * 16 + u.pn * 4 + wc] = ss;
        }
    }
};
struct QKV {
    static constexpr bool PERM = true, AFTER_DRAIN = false;
    const float* ssq; bf16_t* Q; bf16_t* K; bf16_t* Vv; const float* qg; const float* kg;
    __device__ __forceinline__ void operator()(const f32x4 (&acc)[2][2][4][2], const Unit& u, int wr, int wc, int fr, int fq) const {
        const int which = u.pn >> 2, h = (u.pn & 3) * 4 + wc;
        bf16_t* base = Q + (ptrdiff_t)(which == 1) * (K - Q) + (ptrdiff_t)(which == 2) * (Vv - Q);
        const float* gp = qg + (ptrdiff_t)(which == 1) * (kg - qg); const float gsc = which == 0 ? QSCALE : 1.0f; const bool nrm = which < 2;
        const f32x4 g00 = *(const f32x4*)(gp + 8 * fq), g01 = *(const f32x4*)(gp + 8 * fq + 4), g10 = *(const f32x4*)(gp + 32 + 8 * fq), g11 = *(const f32x4*)(gp + 32 + 8 * fq + 4);
        float rsv[2][4]; rows_rs(ssq, u.pm * 256 + wr * 64 + fr, fq, rsv);
#pragma unroll
        for (int ai = 0; ai < 2; ++ai)
#pragma unroll
            for (int m = 0; m < 4; ++m) {
                const int row = u.pm * 256 + ai * 128 + wr * 64 + m * 16 + fr;
                const float rs = rsv[ai][m];
                f32x4 v[2][2]; float ss = 0.f;
#pragma unroll
                for (int bj = 0; bj < 2; ++bj)
#pragma unroll
                    for (int n = 0; n < 2; ++n) { v[bj][n] = acc[ai][bj][m][n] * rs; const f32x4 t = v[bj][n]; ss += (t[0] * t[0] + t[1] * t[1]) + (t[2] * t[2] + t[3] * t[3]); }
                ss += __shfl_xor(ss, 16); ss += __shfl_xor(ss, 32);
                const float rn = gsc * __builtin_amdgcn_rsqf(ss * (1.0f / HD) + EPS);
#pragma unroll
                for (int bj = 0; bj < 2; ++bj) {
                    f32x4 a = v[bj][0], b = v[bj][1];
                    if (nrm) { a = a * (bj == 0 ? g00 : g10) * rn; b = b * (bj == 0 ? g01 : g11) * rn; }
                    v4u w; w.x = pk2(a[0], a[1]); w.y = pk2(a[2], a[3]); w.z = pk2(b[0], b[1]); w.w = pk2(b[2], b[3]);
                    *(v4u*)(base + (size_t)row * DM + h * HD + 32 * bj + 8 * fq) = w;
                }
            }
    }
};
struct ZMerge {
    static constexpr bool PERM = true, AFTER_DRAIN = false;
    const float* ssq; const bf16_t* O0; const bf16_t* O1; const bf16_t* O2; const float* lse; bf16_t* Y;
    struct RowIn { v4u a[2], b[2], c[2]; f32x4 sq; float l0, l1, l2; };
    __device__ __forceinline__ void load_row(RowIn& r, int row, int h, int fq) const {
        const size_t off = (size_t)row * DM + h * HD + 8 * fq;
        r.sq = *(const f32x4*)(ssq + (size_t)row * 16 + 4 * fq);
        r.l0 = lse[((size_t)0 * MROWS + row) * 16 + h]; r.l1 = lse[((size_t)1 * MROWS + row) * 16 + h]; r.l2 = lse[((size_t)2 * MROWS + row) * 16 + h];
#pragma unroll
        for (int bj = 0; bj < 2; ++bj) { r.a[bj] = *(const v4u*)(O0 + off + 32 * bj); r.b[bj] = *(const v4u*)(O1 + off + 32 * bj); r.c[bj] = *(const v4u*)(O2 + off + 32 * bj); }
    }
    __device__ __forceinline__ void operator()(const f32x4 (&acc)[2][2][4][2], const Unit& u, int wr, int wc, int fr, int fq) const {
        const int h = u.pn * 4 + wc, row0 = u.pm * 256 + wr * 64 + fr;
        RowIn in[2];
        load_row(in[0], row0, h, fq);
#pragma unroll
        for (int i = 0; i < 8; ++i) {
            const int ai = i >> 2, m = i & 3, row = row0 + ai * 128 + m * 16;
            if (i + 1 < 8) load_row(in[(i + 1) & 1], row0 + ((i + 1) >> 2) * 128 + ((i + 1) & 3) * 16, h, fq);
            const RowIn& r = in[i & 1];
            float tq = (r.sq[0] + r.sq[1]) + (r.sq[2] + r.sq[3]); tq += __shfl_xor(tq, 16); tq += __shfl_xor(tq, 32);
            const float rs = __builtin_amdgcn_rsqf(tq * (1.0f / DM) + EPS);
            const float mx = fmaxf(r.l0, fmaxf(r.l1, r.l2));
            float w0 = __builtin_amdgcn_exp2f(r.l0 - mx), w1 = __builtin_amdgcn_exp2f(r.l1 - mx), w2 = __builtin_amdgcn_exp2f(r.l2 - mx);
            const float inv = __builtin_amdgcn_rcpf(w0 + w1 + w2); w0 *= inv; w1 *= inv; w2 *= inv;
#pragma unroll
            for (int bj = 0; bj < 2; ++bj) {
                const v4u a = r.a[bj], b = r.b[bj], c = r.c[bj];
                float o[8];
#pragma unroll
                for (int k = 0; k < 4; ++k) { o[2 * k] = w0 * bflo(a[k]) + w1 * bflo(b[k]) + w2 * bflo(c[k]); o[2 * k + 1] = w0 * bfhi(a[k]) + w1 * bfhi(b[k]) + w2 * bfhi(c[k]); }
                const f32x4 z0 = acc[ai][bj][m][0] * rs, z1 = acc[ai][bj][m][1] * rs;
                float y[8];
#pragma unroll
                for (int k = 0; k < 4; ++k) { y[k] = o[k] * z0[k] * sigmoidf_(z0[k]); y[4 + k] = o[4 + k] * z1[k] * sigmoidf_(z1[k]); }
                v4u w; w.x = pk2(y[0], y[1]); w.y = pk2(y[2], y[3]); w.z = pk2(y[4], y[5]); w.w = pk2(y[6], y[7]);
                *(v4u*)(Y + (size_t)row * DM + h * HD + 32 * bj + 8 * fq) = w;
            }
        }
    }
};
}

namespace naive {
template <class AL, class BL, class EP>
__device__ __forceinline__ void gemm_tile(LAS float* sm, int K, int row0, const AL& al, const BL& bl, const EP& ep) {
    const int tid = threadIdx.x, tx = tid & 15, ty = tid >> 4;
    LAS float* sA = sm; LAS float* sB = sm + 16 * 132;
    float acc[4][4];
#pragma unroll
    for (int i = 0; i < 4; ++i)
#pragma unroll
        for (int j = 0; j < 4; ++j) acc[i][j] = 0.f;
    for (int k0 = 0; k0 < K; k0 += 16) {
#pragma unroll
        for (int i = 0; i < 4; ++i) { const int idx = tid + 512 * i, r = idx >> 4, kk = idx & 15; sA[kk * 132 + r] = al(row0 + r, k0 + kk); }
#pragma unroll
        for (int i = 0; i < 2; ++i) { const int idx = tid + 512 * i, kk = idx >> 6, c = idx & 63; sB[kk * 68 + c] = bl(k0 + kk, c); }
        __syncthreads();
#pragma unroll
        for (int kk = 0; kk < 16; ++kk) {
            float a[4], b[4];
#pragma unroll
            for (int i = 0; i < 4; ++i) a[i] = sA[kk * 132 + ty * 4 + i];
#pragma unroll
            for (int j = 0; j < 4; ++j) b[j] = sB[kk * 68 + tx + 16 * j];
#pragma unroll
            for (int i = 0; i < 4; ++i)
#pragma unroll
                for (int j = 0; j < 4; ++j) acc[i][j] = fmaf(a[i], b[j], acc[i][j]);
        }
        __syncthreads();
    }
#pragma unroll
    for (int i = 0; i < 4; ++i) ep(row0 + ty * 4 + i, tx, acc[i][0], acc[i][1], acc[i][2], acc[i][3]);
}
struct ALbf { const bf16* A; int ld; __device__ __forceinline__ float operator()(int r, int k) const { return bf2f(A[(size_t)r * ld + k]); } };
__device__ __forceinline__ float red16(float v) { v += __shfl_xor(v, 1); v += __shfl_xor(v, 2); v += __shfl_xor(v, 4); v += __shfl_xor(v, 8); return v; }

struct BLc1 { const float* w; const float* nrm; int ct; __device__ __forceinline__ float operator()(int k, int c) const { return w[(size_t)k * CN + (c >> 4) * CE + ct * 16 + (c & 15)] * nrm[k]; } };
struct EPc1 { const float* ssq; bf16* V; bf16* G; int ct;
    __device__ __forceinline__ void operator()(int row, int tx, float a0, float a1, float a2, float a3) const {
        const float rs = row_rs(ssq, row); const float b = a0 * rs, c = a1 * rs, u = a2 * rs, z = a3 * rs;
        const int e = ct * 16 + tx; V[(size_t)row * CE + e] = (bf16)f2bf(c * u); G[(size_t)row * CE + e] = (bf16)f2bf(b * z * sigmoidf_(z)); } };
__device__ __forceinline__ void c1(LAS float* sm, const bf16* xb, const float* ssq, const float* w, const float* nrm, bf16* V, bf16* G, int bid, int nb) {
    const int nct = CE / 16, ntile = (MROWS / 128) * nct;
    for (int t = bid; t < ntile; t += nb) { const int rt = t / nct, ct = t % nct; gemm_tile(sm, DM, rt * 128, ALbf{xb, DM}, BLc1{w, nrm, ct}, EPc1{ssq, V, G, ct}); }
}
struct BLres { const float* w; int ct; __device__ __forceinline__ float operator()(int k, int c) const { return w[(size_t)k * DM + ct * 64 + c]; } };
struct EPres { const float* xin; float* xout; bf16* xb; float* ssq; int ct;
    __device__ __forceinline__ void operator()(int row, int tx, float a0, float a1, float a2, float a3) const {
        const size_t o = (size_t)row * DM + ct * 64 + tx;
        const float x0 = xin[o] + a0, x1 = xin[o + 16] + a1, x2 = xin[o + 32] + a2, x3 = xin[o + 48] + a3;
        xout[o] = x0; xout[o + 16] = x1; xout[o + 32] = x2; xout[o + 48] = x3;
        xb[o] = (bf16)f2bf(x0); xb[o + 16] = (bf16)f2bf(x1); xb[o + 32] = (bf16)f2bf(x2); xb[o + 48] = (bf16)f2bf(x3);
        const float ss = red16((x0 * x0 + x1 * x1) + (x2 * x2 + x3 * x3));
        if (tx == 0) ssq[(size_t)row * 16 + ct] = ss; } };
__device__ __forceinline__ void resid(LAS float* sm, const bf16* A, int K, const float* w, const float* xin, float* xout, bf16* xb, float* ssq, int bid, int nb) {
    const int ntile = (MROWS / 128) * 16;
    for (int t = bid; t < ntile; t += nb) { const int rt = t / 16, ct = t % 16; gemm_tile(sm, K, rt * 128, ALbf{A, K}, BLres{w, ct}, EPres{xin, xout, xb, ssq, ct}); }
}
struct BLa1 { const float* w; const float* nrm; int col0; __device__ __forceinline__ float operator()(int k, int c) const { return w[(size_t)k * AN + col0 + c] * nrm[k]; } };
struct EPa1 { const float* ssq; bf16* dst; const float* gain; float sc; int h;
    __device__ __forceinline__ void operator()(int row, int tx, float a0, float a1, float a2, float a3) const {
        const float rs = row_rs(ssq, row); float v0 = a0 * rs, v1 = a1 * rs, v2 = a2 * rs, v3 = a3 * rs;
        const float ss = red16((v0 * v0 + v1 * v1) + (v2 * v2 + v3 * v3));
        if (gain) { const float rn = sc / sqrtf(ss * (1.0f / HD) + EPS); v0 *= rn * gain[tx]; v1 *= rn * gain[tx + 16]; v2 *= rn * gain[tx + 32]; v3 *= rn * gain[tx + 48]; }
        const size_t o = (size_t)row * DM + h * HD + tx;
        dst[o] = (bf16)f2bf(v0); dst[o + 16] = (bf16)f2bf(v1); dst[o + 32] = (bf16)f2bf(v2); dst[o + 48] = (bf16)f2bf(v3); } };
__device__ __forceinline__ void a1(LAS float* sm, const bf16* xb, const float* ssq, const float* w, const float* nrm, int g, const float* qg, const float* kg, bf16* Q, bf16* K, bf16* V, int bid, int nb) {
    const int ntile = (MROWS / 128) * 48;
    for (int t = bid; t < ntile; t += nb) { const int rt = t / 48, ct = t % 48, which = ct / 16, h = ct % 16;
        gemm_tile(sm, DM, rt * 128, ALbf{xb, DM}, BLa1{w, nrm, g * 3072 + which * 1024 + h * 64},
                  EPa1{ssq, which == 0 ? Q : (which == 1 ? K : V), which == 0 ? qg : (which == 1 ? kg : nullptr), which == 0 ? QSCALE : 1.0f, h}); }
}
struct EPa3 { const float* ssq; const bf16* O0; const bf16* O1; const bf16* O2; const float* lse; bf16* Y; int h;
    __device__ __forceinline__ void operator()(int row, int tx, float a0, float a1, float a2, float a3) const {
        const float rs = row_rs(ssq, row);
        const float l0 = lse[((size_t)0 * MROWS + row) * 16 + h], l1 = lse[((size_t)1 * MROWS + row) * 16 + h], l2 = lse[((size_t)2 * MROWS + row) * 16 + h];
        const float mx = fmaxf(l0, fmaxf(l1, l2)); float w0 = exp2f(l0 - mx), w1 = exp2f(l1 - mx), w2 = exp2f(l2 - mx); const float inv = 1.0f / (w0 + w1 + w2); w0 *= inv; w1 *= inv; w2 *= inv;
        const float zz[4] = {a0 * rs, a1 * rs, a2 * rs, a3 * rs};
#pragma unroll
        for (int j = 0; j < 4; ++j) { const size_t o = (size_t)row * DM + h * HD + tx + 16 * j;
            const float ov = w0 * bf2f(O0[o]) + w1 * bf2f(O1[o]) + w2 * bf2f(O2[o]); Y[o] = (bf16)f2bf(ov * zz[j] * sigmoidf_(zz[j])); } } };
__device__ __forceinline__ void a3(LAS float* sm, const bf16* xb, const float* ssq, const float* w, const float* nrm, const bf16* O0, const bf16* O1, const bf16* O2, const float* lse, bf16* Y, int bid, int nb) {
    const int ntile = (MROWS / 128) * 16;
    for (int t = bid; t < ntile; t += nb) { const int rt = t / 16, h = t % 16; gemm_tile(sm, DM, rt * 128, ALbf{xb, DM}, BLa1{w, nrm, QKVC + h * 64}, EPa3{ssq, O0, O1, O2, lse, Y, h}); }
}
__device__ __forceinline__ void a2(bf16* QO, const bf16* K, const bf16* V, const float* biasT  , float* lse  , int dil, int gtid, int gthreads) {
    for (int idx = gtid; idx < MROWS * NH; idx += gthreads) {
        const int row = idx >> 4, h = idx & 15, t = row & (SEQ - 1);
        bf16* qp = QO + (size_t)row * DM + h * HD;
        float q[64], o[64];
#pragma unroll
        for (int c = 0; c < 8; ++c) { const v4u w = *(const v4u*)(qp + 8 * c);
#pragma unroll
            for (int i = 0; i < 4; ++i) { q[8 * c + 2 * i] = bflo(w[i]); q[8 * c + 2 * i + 1] = bfhi(w[i]); } }
#pragma unroll
        for (int d = 0; d < 64; ++d) o[d] = 0.f;
        float m = -INFINITY, l = 0.f;
        for (int j = 0; j <= 128; ++j) {
            const int tk = t - dil * j; if (tk < 0) break;
            const size_t ko = (size_t)(row - dil * j) * DM + h * HD;
            float s = 0.f;
#pragma unroll
            for (int c = 0; c < 8; ++c) { const v4u w = *(const v4u*)(K + ko + 8 * c);
#pragma unroll
                for (int i = 0; i < 4; ++i) { s = fmaf(q[8 * c + 2 * i], bflo(w[i]), s); s = fmaf(q[8 * c + 2 * i + 1], bfhi(w[i]), s); } }
            s += biasT[h * 132 + j];
            const float mn = fmaxf(m, s), f = exp2f(m - mn), p = exp2f(s - mn);
            l = l * f + p; m = mn;
#pragma unroll
            for (int c = 0; c < 8; ++c) { const v4u w = *(const v4u*)(V + ko + 8 * c);
#pragma unroll
                for (int i = 0; i < 4; ++i) { o[8 * c + 2 * i] = o[8 * c + 2 * i] * f + p * bflo(w[i]); o[8 * c + 2 * i + 1] = o[8 * c + 2 * i + 1] * f + p * bfhi(w[i]); } }
        }
        const float il = 1.0f / l;
#pragma unroll
        for (int c = 0; c < 8; ++c) { v4u w;
#pragma unroll
            for (int i = 0; i < 4; ++i) w[i] = pk2(o[8 * c + 2 * i] * il, o[8 * c + 2 * i + 1] * il);
            *(v4u*)(qp + 8 * c) = w; }
        lse[(size_t)row * 16 + h] = m + log2f(l);
    }
}
}

template <int MODE> __device__ __forceinline__ int wt_dest_row(int n) {
    if (MODE == 1) { const int type = n >> 11, e = n & 2047, pn = e >> 6, el = e & 63; return 256 * pn + 128 * (type >> 1) + 32 * (el >> 4) + 16 * (type & 1) + (el & 15); }
    if (MODE == 3) { const int blk = n >> 10, r = n & 1023, h = r >> 6, d = r & 63; return blk * 1024 + 256 * (h >> 2) + 128 * (d >> 5) + 32 * (h & 3) + (d & 31); }
    return n;
}
template <int MODE> __device__ __forceinline__ void p0_transpose_item(const float* W, int K, int N, const float* scale, bf16* WT, LAS float* scr  , int item, int lane) {
    const int nblk = N / 64, kb = item / nblk, nb = item % nblk, k0 = 64 * kb, n0 = 64 * nb;
    const int kr = lane >> 4, c4 = lane & 15;
    f32x4 v[16];
#pragma unroll
    for (int i = 0; i < 16; ++i) v[i] = *(const GAS f32x4*)(W + (size_t)(k0 + 4 * i + kr) * N + n0 + 4 * c4);
#pragma unroll
    for (int i = 0; i < 16; ++i) { const float s = scale ? scale[k0 + 4 * i + kr] : 1.0f; LAS float* d = scr + (4 * i + kr) * 65 + 4 * c4;
        d[0] = v[i][0] * s; d[1] = v[i][1] * s; d[2] = v[i][2] * s; d[3] = v[i][3] * s; }
    LDS_WAIT(); asm volatile("" ::: "memory");
    const int c = lane & 7, nl = lane >> 3;
#pragma unroll
    for (int j = 0; j < 8; ++j) { const int n = nl + 8 * j; const LAS float* s = scr + (8 * c) * 65 + n;
        v4u o; o.x = pk2(s[0 * 65], s[1 * 65]); o.y = pk2(s[2 * 65], s[3 * 65]); o.z = pk2(s[4 * 65], s[5 * 65]); o.w = pk2(s[6 * 65], s[7 * 65]);
        *(GAS v4u*)(WT + (size_t)wt_dest_row<MODE>(n0 + n) * K + k0 + 8 * c) = o; }
    LDS_WAIT(); asm volatile("" ::: "memory");
}
struct Ptrs {
    const float *x, *conv_norm, *conv_w_in, *conv_w, *conv_w_out, *attn_norm, *attn_w_in, *q_gain, *k_gain, *attn_w_out, *rel_bias;
    float* out; unsigned char* ws;
};
__device__ __forceinline__ void p0_prologue(const Ptrs& P, LAS unsigned char* lds, int vcu, int G, int wave, int lane, int tid) {
    LAS float* scr = (LAS float*)(lds + wave * 16640);
    const int gw = vcu * 8 + wave, NGW = G * 8;
    bf16* W1 = (bf16*)(P.ws + WS_W1); bf16* W2 = (bf16*)(P.ws + WS_W2); bf16* W3 = (bf16*)(P.ws + WS_W3); bf16* W4 = (bf16*)(P.ws + WS_W4);
    constexpr int I1 = (DM / 64) * (CN / 64), I2 = (CE / 64) * (DM / 64), I3 = (DM / 64) * (AN / 64), I4 = (DM / 64) * (DM / 64), IL = I1 + I2 + I3 + I4;
    for (int it = gw; it < 2 * IL; it += NGW) {
        const int j = it / IL; int r = it % IL;
        if (r < I1) { p0_transpose_item<1>(P.conv_w_in + (size_t)j * DM * CN, DM, CN, P.conv_norm + j * DM, W1 + (size_t)j * CN * DM, scr, r, lane); continue; } r -= I1;
        if (r < I2) { p0_transpose_item<0>(P.conv_w_out + (size_t)j * CE * DM, CE, DM, nullptr, W2 + (size_t)j * DM * CE, scr, r, lane); continue; } r -= I2;
        if (r < I3) { p0_transpose_item<3>(P.attn_w_in + (size_t)j * DM * AN, DM, AN, P.attn_norm + j * DM, W3 + (size_t)j * AN * DM, scr, r, lane); continue; } r -= I3;
        p0_transpose_item<0>(P.attn_w_out + (size_t)j * DM * DM, DM, DM, nullptr, W4 + (size_t)j * DM * DM, scr, r, lane);
    }
    bf16* XB = (bf16*)(P.ws + WS_XB); float* SSQ = (float*)(P.ws + WS_SSQ);
    for (int m = 2 * gw; m < MROWS; m += 2 * NGW) {
        const GAS f32x4* xr = (const GAS f32x4*)(P.x + (size_t)m * DM) + lane;
        GAS v2u* o8 = (GAS v2u*)(XB + (size_t)m * DM) + lane;
        f32x4 v[8];
#pragma unroll
        for (int jj = 0; jj < 8; ++jj) v[jj] = xr[64 * jj];
        float s0 = 0.f, s1 = 0.f;
#pragma unroll
        for (int jj = 0; jj < 8; ++jj) { const f32x4 t = v[jj]; const float q = (t.x * t.x + t.y * t.y) + (t.z * t.z + t.w * t.w); if (jj < 4) s0 += q; else s1 += q;
            v2u w; w.x = pk2(t.x, t.y); w.y = pk2(t.z, t.w); o8[64 * jj] = w; }
        s0 = wave_sum(s0); s1 = wave_sum(s1);
        if (lane < 32) SSQ[(size_t)m * 16 + lane] = lane == 0 ? s0 : (lane == 16 ? s1 : 0.f);
    }
    float* BT = (float*)(P.ws + WS_BIAS);
    for (int i = vcu * 512 + tid; i < NG * NH * 132; i += G * 512) {
        const int g = i / (NH * 132), r = i % (NH * 132), h = r / 132, st = r % 132;
        const int dil = g == 0 ? 1 : (g == 1 ? 4 : 16);
        BT[i] = st <= 128 ? P.rel_bias[t5_bucket(st * dil) * (NG * NH) + g * NH + h] * LOG2E : 0.f;
    }
}
template <bool WRAP> __device__ __forceinline__ void conv_pass(const bf16* V, const bf16* GY, bf16* OUT, const float* cw  , int gtid, int gthreads) {
    for (int idx = gtid; idx < MROWS * (CE / 8); idx += gthreads) {
        const int row = idx / (CE / 8), e0 = (idx % (CE / 8)) * 8, t = row & (SEQ - 1);
        const size_t o = (size_t)row * CE + e0;
        const v4u g = *(const v4u*)(GY + o), v2 = *(const v4u*)(V + o);
        v4u v1 = (v4u){0u, 0u, 0u, 0u}, v0 = (v4u){0u, 0u, 0u, 0u};
        if (t >= 1) v1 = *(const v4u*)(V + o - CE);
        if (t >= 2) v0 = *(const v4u*)(V + o - 2 * CE);
        float w0[8], w1[8], w2[8];
#pragma unroll
        for (int c = 0; c < 2; ++c) { const f32x4 a = *(const f32x4*)(cw + e0 + 4 * c), b = *(const f32x4*)(cw + CE + e0 + 4 * c), d = *(const f32x4*)(cw + 2 * CE + e0 + 4 * c);
#pragma unroll
            for (int i = 0; i < 4; ++i) { w0[4 * c + i] = a[i]; w1[4 * c + i] = b[i]; w2[4 * c + i] = d[i]; } }
        float y[8];
#pragma unroll
        for (int i = 0; i < 4; ++i) {
            y[2 * i] = bflo(g[i]) * (w0[2 * i] * bflo(v0[i]) + w1[2 * i] * bflo(v1[i]) + w2[2 * i] * bflo(v2[i]));
            y[2 * i + 1] = bfhi(g[i]) * (w0[2 * i + 1] * bfhi(v0[i]) + w1[2 * i + 1] * bfhi(v1[i]) + w2[2 * i + 1] * bfhi(v2[i]));
        }
        v4u w; w.x = pk2(y[0], y[1]); w.y = pk2(y[2], y[3]); w.z = pk2(y[4], y[5]); w.w = pk2(y[6], y[7]);
        *(v4u*)(OUT + (WRAP ? (o & (size_t)(16 * 1024 * 1024 - 1)) : o)) = w;
    }
}

namespace attn {
typedef float f32x16 __attribute__((ext_vector_type(16)));
typedef short s16x4 __attribute__((ext_vector_type(4)));
typedef short v4i16_t __attribute__((ext_vector_type(4)));
constexpr int L_K = 0, L_V = 49152, L_B = 98304, L_O = 118784, L_END = 151552, L_WS = 151552 + 256;
static_assert(L_O + 8 * 4096 == L_END && L_B + 5 * 4096 == L_O, "attention LDS map");
__device__ __forceinline__ int crow(int r, int hi) { return (r & 3) + 8 * (r >> 2) + 4 * hi; }
__device__ __forceinline__ s16x4 vtr(LAS const unsigned char* p) { return __builtin_bit_cast(s16x4, __builtin_amdgcn_ds_read_tr16_b64_v4i16((LAS v4i16_t*)p)); }
__device__ __forceinline__ float swapmax(float m) { auto rr = __builtin_amdgcn_permlane32_swap(__float_as_uint(m), __float_as_uint(m), false, false); return fmaxf(__uint_as_float(rr[0]), __uint_as_float(rr[1])); }
__device__ __forceinline__ float swapsum(float m) { auto rr = __builtin_amdgcn_permlane32_swap(__float_as_uint(m), __float_as_uint(m), false, false); return __uint_as_float(rr[0]) + __uint_as_float(rr[1]); }

template <int DIL> __device__ __forceinline__ void phase(LAS unsigned char* lds, const bf16* QO, bf16* OUT, const bf16* Kg, const bf16* Vg, const float* biasT  , float* lse  , int vcu, int G) {
    const int tid = threadIdx.x, lane = tid & 63, r32 = lane & 31, hi = lane >> 5;
    const int w = __builtin_amdgcn_readfirstlane(tid >> 6);
    constexpr int CPC = (SEQ / DIL) / 256;
    constexpr int NJS = BATCH * NH * 16;
    int cur_bh = -1;
    for (int id = vcu * 4; id < NJS; id += ((id & 3) == 3) ? (G * 4 - 3) : 1) {
        const int bh = id >> 4, sub = id & 15, c = sub / CPC, ck = sub % CPC;
        const int b = bh >> 4, h = bh & 15, n0 = ck * 256;
        const size_t rowb = (size_t)b * SEQ;
        if (bh != cur_bh) {
            cur_bh = bh;
#pragma unroll
            for (int i = 0; i < 10; ++i) {
                const int e = tid + 512 * i, j = e >> 10, rem = e & 1023, rg = rem >> 8, ln = (rem & 255) >> 2, i4 = rem & 3;
                const int r = 4 * rg + i4, a = ln & 31, hh = ln >> 5, kk = 32 * j + crow(r, hh), step = 128 + a - kk;
                float val = -INFINITY;
                if (step >= 0 && step <= 128) val = biasT[h * 132 + step];
                ((LAS float*)(lds + L_B))[e] = val;
            }
        }
#pragma unroll
        for (int i = 0; i < 12; ++i) {
            const int p = w * 12 + i;
            if (p < 48) {
                const int ch = p / 6, kb = p % 6;
                int pos = n0 - 128 + kb * 64 + lane; pos = pos < 0 ? 0 : pos;
                const bf16* src = Kg + (rowb + (size_t)pos * DIL + c) * DM + h * HD + ch * 8;
                __builtin_amdgcn_global_load_lds((const unsigned*)src, (LAS unsigned*)(lds + L_K + ch * 6144 + kb * 1024), 16, 0, 0);
            } else {
                const int q = p - 48, d0 = q / 24, vb = q % 24;
                int pos = n0 - 128 + vb * 16 + (lane >> 2); pos = pos < 0 ? 0 : pos;
                const bf16* src = Vg + (rowb + (size_t)pos * DIL + c) * DM + h * HD + d0 * 32 + (lane & 3) * 8;
                __builtin_amdgcn_global_load_lds((const unsigned*)src, (LAS unsigned*)(lds + L_V + d0 * 24576 + vb * 1024), 16, 0, 0);
            }
        }
        const size_t qrow = rowb + (size_t)(n0 + 32 * w + r32) * DIL + c;
        bf16x8 qr[4];
#pragma unroll
        for (int d0 = 0; d0 < 4; ++d0) qr[d0] = *(const bf16x8*)(QO + qrow * DM + h * HD + d0 * 16 + hi * 8);
        asm volatile("s_waitcnt vmcnt(0)" ::: "memory");
        __syncthreads();
        const int jstart = (n0 == 0 && w < 4) ? 4 - w : 0;
        f32x16 S[5];
#pragma unroll
        for (int j = 0; j < 5; ++j) {
            if (j < jstart) {
#pragma unroll
                for (int r = 0; r < 16; ++r) S[j][r] = -INFINITY;
            } else {
                f32x16 cinit;
#pragma unroll
                for (int rg = 0; rg < 4; ++rg) { const f32x4 t = *(const LAS f32x4*)(lds + L_B + j * 4096 + rg * 1024 + lane * 16); cinit[4 * rg] = t[0]; cinit[4 * rg + 1] = t[1]; cinit[4 * rg + 2] = t[2]; cinit[4 * rg + 3] = t[3]; }
#pragma unroll
                for (int d0 = 0; d0 < 4; ++d0) {
                    const bf16x8 kf = *(const LAS bf16x8*)(lds + L_K + (2 * d0 + hi) * 6144 + (32 * w + 32 * j + r32) * 16);
                    cinit = __builtin_amdgcn_mfma_f32_32x32x16_bf16(kf, qr[d0], cinit, 0, 0, 0);
                }
                S[j] = cinit;
            }
        }
        float m = -INFINITY;
#pragma unroll
        for (int j = 0; j < 5; ++j)
#pragma unroll
            for (int r = 0; r < 16; ++r) m = fmaxf(m, S[j][r]);
        m = swapmax(m);
        float lsum = 0.f;
#pragma unroll
        for (int j = 0; j < 5; ++j)
#pragma unroll
            for (int r = 0; r < 16; ++r) { const float p = __builtin_amdgcn_exp2f(S[j][r] - m); S[j][r] = p; lsum += p; }
        lsum = swapsum(lsum);
        f32x16 o[2];
#pragma unroll
        for (int r = 0; r < 16; ++r) { o[0][r] = 0.f; o[1][r] = 0.f; }
        const LAS unsigned char* vbase = lds + L_V + (32 * w + 4 * hi + ((lane & 15) >> 2)) * 64 + ((lane >> 4) & 1) * 32 + (lane & 3) * 8;
#pragma unroll
        for (int j = 0; j < 5; ++j)
#pragma unroll
            for (int s = 0; s < 2; ++s) {
                v4u pw; pw.x = pk2(S[j][8 * s], S[j][8 * s + 1]); pw.y = pk2(S[j][8 * s + 2], S[j][8 * s + 3]); pw.z = pk2(S[j][8 * s + 4], S[j][8 * s + 5]); pw.w = pk2(S[j][8 * s + 6], S[j][8 * s + 7]);
                const bf16x8 pa = __builtin_bit_cast(bf16x8, pw);
#pragma unroll
                for (int d0 = 0; d0 < 2; ++d0) {
                    const s16x4 lo = vtr(vbase + d0 * 24576 + (32 * j + 16 * s) * 64), hh = vtr(vbase + d0 * 24576 + (32 * j + 16 * s + 8) * 64);
                    const bf16x8 vf = (bf16x8){lo[0], lo[1], lo[2], lo[3], hh[0], hh[1], hh[2], hh[3]};
                    o[d0] = __builtin_amdgcn_mfma_f32_32x32x16_bf16(pa, vf, o[d0], 0, 0, 0);
                }
            }
        LAS float* wsf = (LAS float*)(lds + L_WS) + w * 64;
        if (hi == 0) { wsf[r32] = lsum; lse[qrow * 16 + h] = m + log2f(lsum); }
        asm volatile("s_waitcnt lgkmcnt(0)" ::: "memory");
        float rli[16];
#pragma unroll
        for (int r = 0; r < 16; ++r) rli[r] = __builtin_amdgcn_rcpf(wsf[crow(r, hi)]);
        LAS bf16* stg = (LAS bf16*)(lds + L_O) + w * 2048;
#pragma unroll
        for (int r = 0; r < 16; ++r) { const int orow = crow(r, hi);
#pragma unroll
            for (int d0 = 0; d0 < 2; ++d0) stg[orow * 64 + d0 * 32 + r32] = (bf16)(pk2(o[d0][r] * rli[r], 0.f) & 0xffffu); }
        asm volatile("s_waitcnt lgkmcnt(0)" ::: "memory");
#pragma unroll
        for (int i = 0; i < 4; ++i) { const int row = i * 8 + (lane >> 3), ch = lane & 7; const v4u v = *(const LAS v4u*)(stg + row * 64 + ch * 8);
            *(v4u*)(OUT + (rowb + (size_t)(n0 + 32 * w + row) * DIL + c) * DM + h * HD + ch * 8) = v; }
        __syncthreads();
    }
}
}

#ifndef OPT_C1
#define OPT_C1 0
#endif
#ifndef OPT_RES
#define OPT_RES 0
#endif
#ifndef OPT_A1
#define OPT_A1 0
#endif
#ifndef OPT_A2
#define OPT_A2 0
#endif
#ifndef OPT_A3
#define OPT_A3 0
#endif
#ifndef DUP_A2
#define DUP_A2 0
#endif
#ifndef DUP_A1
#define DUP_A1 0
#endif
#ifndef DUP_C1
#define DUP_C1 0
#endif
#ifndef DUP_A3
#define DUP_A3 0
#endif
#ifndef DUP_P0
#define DUP_P0 0
#endif
#ifndef DUP_C3
#define DUP_C3 0
#endif
#ifndef DUP_C2
#define DUP_C2 0
#endif
#ifndef MK_PER_PHASE
#define MK_PER_PHASE 1
#endif
constexpr int LDS_BYTES = 155648;
constexpr int MISC_OFF = 151552;
struct Args { const float* in[11]; float* out; unsigned char* ws; int ph_lo, ph_hi; };

template <int PH> __device__ __forceinline__ void run_phase(const Args& args, LAS unsigned char* lds) {
    const int tid = threadIdx.x, lane = tid & 63, wave = __builtin_amdgcn_readfirstlane(tid >> 6);
    const int G = gridDim.x, bx = blockIdx.x, vcu = (G % 8 == 0) ? (bx % 8) * (G / 8) + bx / 8 : bx;
    unsigned char* ws = args.ws;
    float* SSQ = (float*)(ws + WS_SSQ); bf16* XB = (bf16*)(ws + WS_XB);
    LAS float* smf = (LAS float*)lds;
    const int gtid = vcu * 512 + tid, gthreads = G * 512;
    (void)lane; (void)wave; (void)smf; (void)gtid; (void)gthreads; (void)SSQ; (void)XB;
    if constexpr (PH == 0) {
        Ptrs P;
        P.x = args.in[0]; P.conv_norm = args.in[1]; P.conv_w_in = args.in[2]; P.conv_w = args.in[3]; P.conv_w_out = args.in[4]; P.attn_norm = args.in[5];
        P.attn_w_in = args.in[6]; P.q_gain = args.in[7]; P.k_gain = args.in[8]; P.attn_w_out = args.in[9]; P.rel_bias = args.in[10]; P.out = args.out; P.ws = args.ws;
#if DUP_P0
        p0_prologue(P, lds, vcu, G, wave, lane, tid);
#endif
        p0_prologue(P, lds, vcu, G, wave, lane, tid);
    } else {
        constexpr int p = PH - 1, j = p / 11, s = p % 11;
        if constexpr (s == 0) {
            bf16* CV = (bf16*)(ws + WS_CV); bf16* CG = (bf16*)(ws + WS_CG);
#if OPT_C1
            pg8::Gemm g{XB, (const bf16*)(ws + WS_W1) + (size_t)j * CN * DM, MROWS, CN, DM}; pg8::StaticOrder S; S.init(MROWS, CN, G, bx);
            epi::ConvIn E{SSQ, CV, CG};
#if DUP_C1
            pg8::gemm_phase<epi::ConvIn, pg8::StaticOrder, true, true>(lds, g, S, E);
#endif
            pg8::gemm_phase<epi::ConvIn, pg8::StaticOrder, true, true>(lds, g, S, E);
#else
            naive::c1(smf, XB, SSQ, args.in[2] + (size_t)j * DM * CN, args.in[1] + j * DM, CV, CG, bx, G);
#endif
        } else if constexpr (s == 1) {
#if DUP_C2
            conv_pass<true>((const bf16*)(ws + WS_CV), (bf16*)(ws + WS_CG), (bf16*)(ws + WS_END), args.in[3] + (size_t)j * 3 * CE, gtid, gthreads);
#endif
            conv_pass<false>((const bf16*)(ws + WS_CV), (bf16*)(ws + WS_CG), (bf16*)(ws + WS_CG), args.in[3] + (size_t)j * 3 * CE, gtid, gthreads);
        } else if constexpr (s == 2 || s == 10) {
            const bf16* A = (const bf16*)(ws + (s == 2 ? WS_CG : WS_Y)); constexpr int K = s == 2 ? CE : DM;
            const float* xin = (j == 0 && s == 2) ? args.in[0] : args.out;
#if OPT_RES
            pg8::Gemm g{A, (const bf16*)(ws + (s == 2 ? WS_W2 : WS_W4)) + (size_t)j * DM * K, MROWS, DM, K}; pg8::StaticOrder S; S.init(MROWS, DM, G, bx);
            epi::Resid E{xin, args.out, XB, SSQ};
#if DUP_C3
            if constexpr (j == 0 && s == 2) pg8::gemm_phase<epi::Resid, pg8::StaticOrder, false, true>(lds, g, S, E);
#endif
            pg8::gemm_phase<epi::Resid, pg8::StaticOrder, false, true>(lds, g, S, E);
#else
            naive::resid(smf, A, K, s == 2 ? args.in[4] + (size_t)j * CE * DM : args.in[9] + (size_t)j * DM * DM, xin, args.out, XB, SSQ, bx, G);
#endif
        } else if constexpr (s == 9) {
            const bf16* O0 = (const bf16*)(ws + WS_QO); const bf16* O1 = O0 + (size_t)MROWS * DM; const bf16* O2 = O1 + (size_t)MROWS * DM;
            float* LSE = (float*)(ws + WS_LSE); bf16* YB = (bf16*)(ws + WS_Y);
#if OPT_A3
            pg8::Gemm g{XB, (const bf16*)(ws + WS_W3) + (size_t)j * AN * DM + (size_t)QKVC * DM, MROWS, DM, DM}; pg8::StaticOrder S; S.init(MROWS, DM, G, bx);
            epi::ZMerge E{SSQ, O0, O1, O2, LSE, YB};
#if DUP_A3
            pg8::gemm_phase<epi::ZMerge, pg8::StaticOrder, false, true>(lds, g, S, E);
#endif
            pg8::gemm_phase<epi::ZMerge, pg8::StaticOrder, false, true>(lds, g, S, E);
#else
            naive::a3(smf, XB, SSQ, args.in[6] + (size_t)j * DM * AN, args.in[5] + j * DM, O0, O1, O2, LSE, YB, bx, G);
#endif
        } else {
            constexpr int g = (s - 3) >> 1; bf16* QO = (bf16*)(ws + WS_QO) + (size_t)g * MROWS * DM;
            bf16* KB = (bf16*)(ws + WS_K); bf16* VB = (bf16*)(ws + WS_V);
            if constexpr (((s - 3) & 1) == 0) {
#if OPT_A1
                pg8::Gemm gm{XB, (const bf16*)(ws + WS_W3) + (size_t)j * AN * DM + (size_t)g * 3072 * DM, MROWS, 3072, DM}; pg8::StaticOrder S; S.init(MROWS, 3072, G, bx);
                epi::QKV E{SSQ, QO, KB, VB, args.in[7] + (j * NG + g) * HD, args.in[8] + (j * NG + g) * HD};
#if DUP_A1
                pg8::gemm_phase<epi::QKV, pg8::StaticOrder, true, true>(lds, gm, S, E);
#endif
                pg8::gemm_phase<epi::QKV, pg8::StaticOrder, true, true>(lds, gm, S, E);
#else
                naive::a1(smf, XB, SSQ, args.in[6] + (size_t)j * DM * AN, args.in[5] + j * DM, g, args.in[7] + (j * NG + g) * HD, args.in[8] + (j * NG + g) * HD, QO, KB, VB, bx, G);
#endif
            } else {
                constexpr int dil = g == 0 ? 1 : (g == 1 ? 4 : 16);
                float* LSE = (float*)(ws + WS_LSE); const float* BT = (const float*)(ws + WS_BIAS);
#if OPT_A2
#if DUP_A2
                attn::phase<dil>(lds, QO, (bf16*)(ws + WS_END), KB, VB, BT + g * NH * 132, LSE + (size_t)g * MROWS * 16, vcu, G);
#endif
                attn::phase<dil>(lds, QO, QO, KB, VB, BT + g * NH * 132, LSE + (size_t)g * MROWS * 16, vcu, G);
#else
                naive::a2(QO, KB, VB, BT + g * NH * 132, LSE + (size_t)g * MROWS * 16, dil, gtid, gthreads);
#endif
            }
        }
    }
}

__global__ void __launch_bounds__(512, 2) mk_fwd(Args args) {
    extern __shared__ __attribute__((aligned(16))) unsigned char lds_raw[];
    LAS unsigned char* lds = (LAS unsigned char*)lds_raw;
    volatile LAS unsigned* MISC = (volatile LAS unsigned*)(lds + MISC_OFF);
    for (int u = threadIdx.x; u < (LDS_BYTES - MISC_OFF) / 4; u += 512) ((LAS unsigned*)(lds + MISC_OFF))[u] = 0u;
    __syncthreads();
    gu32* ctl = (gu32*)(args.ws + WS_CTL);
    XcdBarrier bar; bar.bar = (unsigned*)(ctl + CW_BAR); bar.x = 0; bar.st = nullptr;
    const int lo = args.ph_lo, hi = args.ph_hi;
    if (hi - lo > 1) bar = xcd_barrier_post((unsigned*)(ctl + CW_BAR), MISC + 8);
#define RUN(k) if (lo <= (k) && (k) < hi) { run_phase<(k)>(args, lds); if ((k) + 1 < hi) xcd_barrier(bar); }
    RUN(0) RUN(1) RUN(2) RUN(3) RUN(4) RUN(5) RUN(6) RUN(7) RUN(8) RUN(9) RUN(10) RUN(11)
    RUN(12) RUN(13) RUN(14) RUN(15) RUN(16) RUN(17) RUN(18) RUN(19) RUN(20) RUN(21) RUN(22)
#undef RUN
}

extern "C" void kernel_launch(void* const* d_in, const int* in_sizes, int n_in, void* d_out, int out_size, void* d_ws, size_t ws_size, hipStream_t stream) {
    static int grid = 0;
    if (grid == 0) {
        if (n_in != 11 || in_sizes[0] != MROWS * DM || out_size != MROWS * DM || ws_size < WS_END) { fprintf(stderr, "kernel_launch: unexpected shapes (n_in %d, ws %zu); nothing launched\n", n_in, ws_size); grid = -1; return; }
        int dev = 0, cus = 0, per_cu = 0;
        if (hipGetDevice(&dev) != hipSuccess || hipDeviceGetAttribute(&cus, hipDeviceAttributeMultiprocessorCount, dev) != hipSuccess) { grid = -1; return; }
        if (hipFuncSetAttribute((const void*)mk_fwd, hipFuncAttributeMaxDynamicSharedMemorySize, LDS_BYTES) != hipSuccess) { fprintf(stderr, "kernel_launch: hipFuncSetAttribute failed\n"); grid = -1; return; }
        if (hipOccupancyMaxActiveBlocksPerMultiprocessor(&per_cu, (const void*)mk_fwd, 512, LDS_BYTES) != hipSuccess || per_cu < 1) { fprintf(stderr, "kernel_launch: occupancy query says %d blocks per CU; nothing launched\n", per_cu); (void)hipGetLastError(); grid = -1; return; }
        grid = cus;
    }
    if (grid < 0) return;
    (void)hipMemsetAsync((char*)d_ws + WS_CTL, 0, CTL_ZERO_BYTES, stream);
    Args a{};
    for (int i = 0; i < 11; ++i) a.in[i] = (const float*)d_in[i];
    a.out = (float*)d_out; a.ws = (unsigned char*)d_ws;
#if MK_PER_PHASE
    for (int ph = 0; ph < NPHASE; ++ph) { a.ph_lo = ph; a.ph_hi = ph + 1; hipLaunchKernelGGL(mk_fwd, dim3(grid), dim3(512), LDS_BYTES, stream, a); }
#else
    a.ph_lo = 0; a.ph_hi = NPHASE; hipLaunchKernelGGL(mk_fwd, dim3(grid), dim3(512), LDS_BYTES, stream, a);
#endif
}
```

```cpp
#include <hip/hip_runtime.h>
#include <cstdio>
#include <cstdint>
#include <cmath>
#define MK_PER_PHASE 0
#define OPT_C1 1
#define OPT_RES 1
#define OPT_A1 1
#define OPT_A3 1
#define OPT_A2 1
namespace pg8 {
#define PG8_LAS __attribute__((address_space(3)))
typedef unsigned short bf16_t;
typedef short bf16x8 __attribute__((ext_vector_type(8)));
typedef float f32x4 __attribute__((ext_vector_type(4)));
typedef unsigned u32x4 __attribute__((ext_vector_type(4)));
constexpr int BM = 256, BK = 64, HALF = 128, HTB = HALF * BK * 2  , STAGE_BYTES = 8 * HTB, NXCD = 8, WGM = 8;

__host__ __device__ __forceinline__ int lds_byte(int r, int c) { const int st = (r >> 4) * 2 + (c >> 5), rr = r & 15, cc = c & 31, ob = rr * 64 + cc * 2; return st * 1024 + (ob ^ (((ob >> 9) & 1) << 5)); }
__host__ __device__ __forceinline__ void stage_rc(int b, int& R, int& C) { const int st = b / 1024, sb = b % 1024, swz = sb ^ (((sb >> 9) & 1) << 5); R = (st >> 1) * 16 + swz / 64; C = (st & 1) * 32 + (swz % 64) / 2; }
__host__ __device__ __forceinline__ int perm32(int rho) { const int n = rho >> 4, i = rho & 15; return 8 * (i >> 2) + 4 * n + (i & 3); }

struct Unit { int pm, pn; };
struct Gemm { const bf16_t* A; const bf16_t* Bt; int M, N, K; };

struct StaticOrder {
    int nM, nN, nwg, G, c;
    __host__ __device__ void init(int M, int N, int G_, int c_) { nM = M / BM; nN = N / BM; nwg = nM * nN; G = G_; c = c_; }
    __host__ __device__ bool next(int i, Unit& u) const {
        const long L = (long)i * G + c; if (L >= nwg) return false;
        int wgid = (int)L; { const int q = nwg / NXCD, r = nwg % NXCD, xcd = wgid % NXCD, off = wgid / NXCD; wgid = (xcd < r ? xcd * (q + 1) : r * (q + 1) + (xcd - r) * q) + off; }
        const int nig = WGM * nN, gid = wgid / nig, fm = gid * WGM, gsz = (nM - fm) < WGM ? (nM - fm) : WGM;
        u.pm = fm + ((wgid % nig) % gsz); u.pn = (wgid % nig) / gsz; return true;
    }
    __device__ __forceinline__ void a_ready(const Unit&) const {}
    __device__ __forceinline__ void done(const Unit&) const {}
};

__device__ __forceinline__ unsigned cvt_pk_bf16(float lo, float hi) { unsigned r; asm volatile("v_cvt_pk_bf16_f32 %0, %1, %2" : "=v"(r) : "v"(lo), "v"(hi)); return r; }
typedef float f32x2 __attribute__((ext_vector_type(2)));

template <class Epi, class Sched, bool ALIGN_EPI = false, bool SP2 = false>
__device__ __forceinline__ void gemm_phase(PG8_LAS unsigned char* lds, const Gemm g, const Sched& S, const Epi& E) {
    const int tid = threadIdx.x, wid = __builtin_amdgcn_readfirstlane(tid >> 6), lane = tid & 63, wr = wid >> 2, wc = wid & 3, fr = lane & 15, fq = lane >> 4;
    const int K = g.K, nt = K / BK;
    unsigned voffA[2], voffB[2];
#pragma unroll
    for (int i = 0; i < 2; ++i) { int R, C; stage_rc(tid * 16 + i * 8192, R, C); const int Rb = Epi::PERM ? ((R & ~31) + perm32(R & 31)) : R;
        voffA[i] = (unsigned)(R * K + C) * 2u; voffB[i] = (unsigned)(Rb * K + C) * 2u; }
    const size_t kstep = (size_t)(BK * 2);
    const size_t hstep = (size_t)HALF * K * 2;
    const size_t tstep = 2 * hstep;
    const unsigned ldsw = (unsigned)wid * 1024u;
    const int aoff = lds_byte(wr * 64 + fr, fq * 8), boff = lds_byte(wc * 32 + fr, fq * 8);
#define PG8_SA(b, h) (((b) * 2 + (h)) * HTB)
#define PG8_SB(b, h) ((4 + (b) * 2 + (h)) * HTB)
#define PG8_STAGE(bufoff, gbase, voff) do { _Pragma("unroll") for (int _i = 0; _i < 2; ++_i) \
        __builtin_amdgcn_global_load_lds((const unsigned*)((const char*)(gbase) + (voff)[_i]), (PG8_LAS unsigned*)(lds + (bufoff) + ldsw + _i * 8192), 16, 0, 0); } while (0)
#define PG8_LDA(dst, b, h) do { _Pragma("unroll") for (int m = 0; m < 4; ++m) _Pragma("unroll") for (int k = 0; k < 2; ++k) dst[m][k] = *(const PG8_LAS bf16x8*)(lds + PG8_SA(b, h) + aoff + m * 2048 + k * 1024); } while (0)
#define PG8_LDB(dst, b, h) do { _Pragma("unroll") for (int n = 0; n < 2; ++n) _Pragma("unroll") for (int k = 0; k < 2; ++k) dst[n][k] = *(const PG8_LAS bf16x8*)(lds + PG8_SB(b, h) + boff + n * 2048 + k * 1024); } while (0)
#define PG8_MMA(ai, bj, At, Bt) do { __builtin_amdgcn_s_setprio(1); _Pragma("unroll") for (int m = 0; m < 4; ++m) _Pragma("unroll") for (int n = 0; n < 2; ++n) _Pragma("unroll") for (int k = 0; k < 2; ++k) \
        acc[ai][bj][m][n] = __builtin_amdgcn_mfma_f32_16x16x32_bf16(Bt[n][k], At[m][k], acc[ai][bj][m][n], 0, 0, 0); __builtin_amdgcn_s_setprio(0); } while (0)
#define PG8_WAIT_V(n) asm volatile("s_waitcnt vmcnt(" #n ")" ::: "memory")
#define PG8_WAIT_L(n) asm volatile("s_waitcnt lgkmcnt(" #n ")" ::: "memory")
#define PG8_BAR __builtin_amdgcn_s_barrier()
#define PG8_SCHED __builtin_amdgcn_sched_barrier(0)
    Unit cur, nxt; int ui = 0;
    if (!S.next(0, cur)) return;
    f32x4 acc[2][2][4][2];
#pragma unroll
    for (int a = 0; a < 2; ++a)
#pragma unroll
        for (int b = 0; b < 2; ++b)
#pragma unroll
            for (int m = 0; m < 4; ++m)
#pragma unroll
                for (int n = 0; n < 2; ++n) acc[a][b][m][n] = (f32x4){0.f, 0.f, 0.f, 0.f};
    bf16x8 At[4][2], B0[2][2], B1[2][2];
    const char* cA = (const char*)g.A + (size_t)cur.pm * tstep; const char* cB = (const char*)g.Bt + (size_t)cur.pn * tstep;
    S.a_ready(cur);
    if constexpr (SP2) {
        PG8_STAGE(PG8_SB(0, 0), cB, voffB); PG8_STAGE(PG8_SB(0, 1), cB + hstep, voffB); PG8_STAGE(PG8_SA(0, 0), cA, voffA); PG8_STAGE(PG8_SA(0, 1), cA + hstep, voffA);
        if (wr == 1) PG8_BAR;
        PG8_WAIT_V(2); PG8_BAR;
        PG8_STAGE(PG8_SB(1, 0), cB + kstep, voffB); PG8_STAGE(PG8_SA(1, 0), cA + kstep, voffA); PG8_STAGE(PG8_SB(1, 1), cB + hstep + kstep, voffB);
        PG8_WAIT_V(6); PG8_BAR;
    } else {
        PG8_STAGE(PG8_SB(0, 0), cB, voffB); PG8_STAGE(PG8_SA(0, 0), cA, voffA); PG8_STAGE(PG8_SB(0, 1), cB + hstep, voffB); PG8_STAGE(PG8_SA(0, 1), cA + hstep, voffA);
        if (wr == 1) PG8_BAR;
        PG8_WAIT_V(4); PG8_BAR;
        PG8_STAGE(PG8_SB(1, 0), cB + kstep, voffB); PG8_STAGE(PG8_SA(1, 0), cA + kstep, voffA); PG8_STAGE(PG8_SB(1, 1), cB + hstep + kstep, voffB);
        PG8_WAIT_V(6); PG8_BAR;
    }
    for (;;) {
        const bool has_next = S.next(ui + 1, nxt);
        const char* nA = has_next ? (const char*)g.A + (size_t)nxt.pm * tstep : cA; const char* nB = has_next ? (const char*)g.Bt + (size_t)nxt.pn * tstep : cB;
        for (int t = 0; t < nt; t += 2) {
            const bool last = (t == nt - 2);
            const char* a1 = cA + (size_t)(t + 1) * kstep;
            const char* a2 = last ? nA : cA + (size_t)(t + 2) * kstep; const char* b2 = last ? nB : cB + (size_t)(t + 2) * kstep;
            const char* a3 = a2 + kstep; const char* b3 = b2 + kstep;
            if (last && has_next) S.a_ready(nxt);
            if constexpr (SP2) {
            PG8_LDB(B0, 0, 0); PG8_LDB(B1, 0, 1); PG8_SCHED; PG8_LDA(At, 0, 0); PG8_STAGE(PG8_SA(1, 1), a1 + hstep, voffA);
            PG8_WAIT_V(8); PG8_WAIT_L(0); PG8_BAR; PG8_MMA(0, 0, At, B0); PG8_MMA(0, 1, At, B1); PG8_BAR; PG8_SCHED;
            PG8_LDA(At, 0, 1); PG8_STAGE(PG8_SB(0, 0), b2, voffB); PG8_STAGE(PG8_SB(0, 1), b2 + hstep, voffB); PG8_STAGE(PG8_SA(0, 0), a2, voffA);
            PG8_WAIT_V(8); PG8_WAIT_L(0); PG8_BAR; PG8_MMA(1, 0, At, B0); PG8_MMA(1, 1, At, B1); PG8_BAR; PG8_SCHED;
            PG8_LDB(B0, 1, 0); PG8_LDB(B1, 1, 1); PG8_SCHED; PG8_LDA(At, 1, 0); PG8_STAGE(PG8_SA(0, 1), a2 + hstep, voffA);
            PG8_WAIT_V(8); PG8_WAIT_L(0); PG8_BAR; PG8_MMA(0, 0, At, B0); PG8_MMA(0, 1, At, B1); PG8_BAR; PG8_SCHED;
            PG8_LDA(At, 1, 1); PG8_STAGE(PG8_SB(1, 0), b3, voffB); PG8_STAGE(PG8_SB(1, 1), b3 + hstep, voffB); PG8_STAGE(PG8_SA(1, 0), a3, voffA);
            PG8_WAIT_V(8); PG8_WAIT_L(0); PG8_BAR; PG8_MMA(1, 0, At, B0); PG8_MMA(1, 1, At, B1); PG8_BAR; PG8_SCHED;
            } else {
            PG8_LDB(B0, 0, 0); PG8_SCHED; PG8_LDA(At, 0, 0); PG8_STAGE(PG8_SA(1, 1), a1 + hstep, voffA);
            PG8_WAIT_L(8); PG8_BAR; PG8_WAIT_L(0); PG8_MMA(0, 0, At, B0); PG8_BAR; PG8_SCHED;
            PG8_LDB(B1, 0, 1); PG8_STAGE(PG8_SB(0, 0), b2, voffB);
            PG8_BAR; PG8_WAIT_L(0); PG8_MMA(0, 1, At, B1); PG8_BAR;
            PG8_LDA(At, 0, 1); PG8_STAGE(PG8_SA(0, 0), a2, voffA);
            PG8_BAR; PG8_WAIT_L(0); PG8_MMA(1, 0, At, B0); PG8_BAR; PG8_SCHED;
            PG8_STAGE(PG8_SB(0, 1), b2 + hstep, voffB);
            PG8_WAIT_V(6); PG8_BAR; PG8_MMA(1, 1, At, B1); PG8_BAR;
            PG8_LDB(B0, 1, 0); PG8_SCHED; PG8_LDA(At, 1, 0); PG8_STAGE(PG8_SA(0, 1), a2 + hstep, voffA);
            PG8_WAIT_L(8); PG8_BAR; PG8_WAIT_L(0); PG8_MMA(0, 0, At, B0); PG8_BAR; PG8_SCHED;
            PG8_LDB(B1, 1, 1); PG8_STAGE(PG8_SB(1, 0), b3, voffB);
            PG8_BAR; PG8_WAIT_L(0); PG8_MMA(0, 1, At, B1); PG8_BAR;
            PG8_LDA(At, 1, 1); PG8_STAGE(PG8_SA(1, 0), a3, voffA);
            PG8_BAR; PG8_WAIT_L(0); PG8_MMA(1, 0, At, B0); PG8_BAR; PG8_SCHED;
            PG8_STAGE(PG8_SB(1, 1), b3 + hstep, voffB);
            PG8_WAIT_V(6); PG8_BAR; PG8_MMA(1, 1, At, B1); PG8_BAR;
            }
        }
        if constexpr (ALIGN_EPI) { if (wr == 0) PG8_BAR; }
        if constexpr (!Epi::AFTER_DRAIN) { E(acc, cur, wr, wc, fr, fq); if constexpr (Epi::DUP) { asm volatile("" ::: "memory"); E(acc, cur, wr, wc, fr, fq); } S.done(cur); }
        if (!has_next) break;
#pragma unroll
        for (int a = 0; a < 2; ++a)
#pragma unroll
            for (int b = 0; b < 2; ++b)
#pragma unroll
                for (int m = 0; m < 4; ++m)
#pragma unroll
                    for (int n = 0; n < 2; ++n) acc[a][b][m][n] = (f32x4){0.f, 0.f, 0.f, 0.f};
        cur = nxt; cA = nA; cB = nB; ++ui;
        if constexpr (ALIGN_EPI) { if (wr == 1) PG8_BAR; }
    }
    PG8_WAIT_V(0);
    if constexpr (!ALIGN_EPI) { if (wr == 0) PG8_BAR; }
    PG8_BAR;
    if constexpr (Epi::AFTER_DRAIN) { E.fused(acc, cur, wr, wc, fr, fq, lds, wid, lane); S.done(cur); }
#undef PG8_SA
#undef PG8_SB
#undef PG8_STAGE
#undef PG8_LDA
#undef PG8_LDB
#undef PG8_MMA
#undef PG8_WAIT_V
#undef PG8_WAIT_L
#undef PG8_BAR
#undef PG8_SCHED
}
}

constexpr int BATCH = 4, SEQ = 4096, DM = 1024, MROWS = BATCH * SEQ;
constexpr int CE = 2048, CN = 4 * CE;
constexpr int NH = 16, HD = 64, NG = 3, QKVC = 9216, AN = 10240;
constexpr float EPS = 1e-6f, LOG2E = 1.4426950408889634f, QSCALE = 0.125f * LOG2E;
constexpr int NPHASE = 23;

constexpr size_t MiB = 1u << 20;
constexpr size_t WS_CTL = 0, CTL_ZERO_BYTES = 1 * MiB;
constexpr size_t WS_SSQ = 1 * MiB;
constexpr size_t WS_W1 = 2 * MiB, WS_W2 = 34 * MiB, WS_W3 = 42 * MiB, WS_W4 = 82 * MiB;
constexpr size_t WS_LSE = 86 * MiB;
constexpr size_t WS_BIAS = 89 * MiB;
constexpr size_t WS_XB = 90 * MiB;
constexpr size_t WS_CV = 122 * MiB, WS_CG = 186 * MiB;
constexpr size_t WS_QO = 122 * MiB;
constexpr size_t WS_K = 218 * MiB, WS_V = 250 * MiB, WS_Y = WS_K;
constexpr size_t WS_END = 282 * MiB;
constexpr int CW_TMO = 0, CW_BAR = 4096;

#define GAS __attribute__((address_space(1)))
#define LAS __attribute__((address_space(3)))
typedef unsigned short bf16;
typedef unsigned v4u __attribute__((ext_vector_type(4)));
typedef unsigned v2u __attribute__((ext_vector_type(2)));
typedef float f32x4 __attribute__((ext_vector_type(4)));
typedef short bf16x8 __attribute__((ext_vector_type(8)));
typedef GAS unsigned gu32;
#define RLX_AGENT __ATOMIC_RELAXED, __HIP_MEMORY_SCOPE_AGENT
#define LDS_WAIT() asm volatile("s_waitcnt lgkmcnt(0)" ::: "memory")
#define VM_WAIT() asm volatile("s_waitcnt vmcnt(0)" ::: "memory")
__device__ __forceinline__ unsigned f2bf(float f) { unsigned u = __builtin_bit_cast(unsigned, f); return (u + 0x7fffu + ((u >> 16) & 1u)) >> 16; }
typedef float f32x2_t __attribute__((ext_vector_type(2))); typedef __bf16 bf16x2_t __attribute__((ext_vector_type(2)));
__device__ __forceinline__ unsigned pk2(float lo, float hi) { f32x2_t v = {lo, hi}; bf16x2_t b = __builtin_convertvector(v, bf16x2_t); return __builtin_bit_cast(unsigned, b); }
__device__ __forceinline__ float bf2f(unsigned h) { return __builtin_bit_cast(float, h << 16); }
__device__ __forceinline__ float bflo(unsigned w) { return __builtin_bit_cast(float, w << 16); }
__device__ __forceinline__ float bfhi(unsigned w) { return __builtin_bit_cast(float, w & 0xffff0000u); }
__device__ __forceinline__ float sigmoidf_(float z) { return __builtin_amdgcn_rcpf(1.0f + __builtin_amdgcn_exp2f(-z * LOG2E)); }
__device__ __forceinline__ float row_rs(const float* ssq, int row) {
    const f32x4* p = (const f32x4*)(ssq + (size_t)row * 16);
    const f32x4 s = (p[0] + p[1]) + (p[2] + p[3]);
    return 1.0f / sqrtf(((s.x + s.y) + (s.z + s.w)) * (1.0f / DM) + EPS);
}
__device__ __forceinline__ float wave_sum(float v) {
#pragma unroll
    for (int o = 1; o < 64; o <<= 1) v += __shfl_xor(v, o);
    return v;
}
__device__ __forceinline__ int t5_bucket(int d) {
    if (d < 16) return d;
    int b = 15;
    b += (d >= 16); b += (d >= 22); b += (d >= 30); b += (d >= 40); b += (d >= 54); b += (d >= 73); b += (d >= 99); b += (d >= 134);
    b += (d >= 182); b += (d >= 246); b += (d >= 332); b += (d >= 450); b += (d >= 609); b += (d >= 825); b += (d >= 1117); b += (d >= 1513);
    return b;
}

#define XB_TMO      128
#define XB_XCNT(j)  (256  + 64 * (j))
#define XB_XSUB(j)  (1280 + 64 * (j))
#define XB_XGEN(j)  (2304 + 64 * (j))
#define XB_TOP      3328
#define XB_TOPGEN   3392
#define XCD_BAR_WORDS 3456
#define XB_SPIN_CAP (1u << 18)

__device__ __forceinline__ unsigned xb_ld(unsigned* p)              { return __hip_atomic_load(p, __ATOMIC_RELAXED, __HIP_MEMORY_SCOPE_AGENT); }
__device__ __forceinline__ unsigned xb_add(unsigned* p, unsigned v) { return __hip_atomic_fetch_add(p, v, __ATOMIC_RELAXED, __HIP_MEMORY_SCOPE_AGENT); }
__device__ __forceinline__ unsigned xb_xcc_id() { return (unsigned)__builtin_amdgcn_s_getreg((3 << 11) | 20) & 0xFu; }
#define XB_SPIN(cond, bar) do { unsigned _sp = 0; while (cond) { __builtin_amdgcn_s_sleep(1); \
    if ((++_sp & 255u) == 0u) { if (xb_ld(&(bar)[XB_TMO])) break; if (_sp > XB_SPIN_CAP) { atomicAdd(&(bar)[XB_TMO], 1u); break; } } } } while (0)

struct XcdBarrier {
    unsigned* bar; unsigned x;
    volatile LAS unsigned* st;
};

__device__ __forceinline__ XcdBarrier xcd_barrier_post(unsigned* bar, volatile LAS unsigned* st) {
    XcdBarrier b; b.bar = bar; b.x = xb_xcc_id(); b.st = st;
    if (threadIdx.x == 0) (void)xb_add(&bar[XB_XCNT(b.x)], 1u);
    return b;
}
__device__ __forceinline__ void xcd_barrier_complete(unsigned* bar, unsigned x, unsigned& nloc, unsigned& nx) {
    const unsigned G = gridDim.x * gridDim.y * gridDim.z;
    unsigned sum, cnt, mine, sp = 0u;
    for (;;) {
        sum = 0u; cnt = 0u; mine = 0u;
#pragma unroll
        for (unsigned j = 0; j < 16; ++j) { const unsigned c = xb_ld(&bar[XB_XCNT(j)]); sum += c; cnt += (c > 0u) ? 1u : 0u; mine = (j == x) ? c : mine; }
        if (sum == G) break;
        __builtin_amdgcn_s_sleep(1);
        if ((++sp & 255u) == 0u) { if (xb_ld(&bar[XB_TMO])) break; if (sp > XB_SPIN_CAP) { atomicAdd(&bar[XB_TMO], 1u); break; } }
    }
    nloc = mine > 0u ? mine : 1u; nx = cnt > 0u ? cnt : 1u;
}

__device__ __forceinline__ void xcd_barrier(const XcdBarrier& b) {
    asm volatile("s_waitcnt vmcnt(0)" ::: "memory");
    __syncthreads();
    if (threadIdx.x == 0) {
        unsigned* bar = b.bar;
        __builtin_amdgcn_s_waitcnt(0);
        unsigned nloc = b.st[0], nx = b.st[1];
        if (nloc == 0u) { xcd_barrier_complete(bar, b.x, nloc, nx); b.st[0] = nloc; b.st[1] = nx; }
        const unsigned old = xb_add(&bar[XB_XSUB(b.x)], 1u);
        const unsigned gen = old / nloc;
        if (old + 1u == (gen + 1u) * nloc) {
            __builtin_amdgcn_fence(__ATOMIC_RELEASE, "agent");
            asm volatile("s_waitcnt vmcnt(0)" ::: "memory");
            const unsigned og = xb_add(&bar[XB_TOP], 1u);
            const unsigned tg = og / nx;
            if (og + 1u == (tg + 1u) * nx) xb_add(&bar[XB_TOPGEN], 1u);
            else XB_SPIN(xb_ld(&bar[XB_TOPGEN]) == tg, bar);
            __builtin_amdgcn_fence(__ATOMIC_ACQUIRE, "agent");
            xb_add(&bar[XB_XGEN(b.x)], 1u);
            asm volatile("s_waitcnt vmcnt(0)" ::: "memory");
        } else {
            XB_SPIN(xb_ld(&bar[XB_XGEN(b.x)]) == gen, bar);
            __builtin_amdgcn_fence(__ATOMIC_ACQUIRE, "agent");
            asm volatile("s_waitcnt vmcnt(0)" ::: "memory");
        }
    }
    __syncthreads();
}

#ifndef DUP_EPI
#define DUP_EPI 0
#endif
namespace epi {
using pg8::Unit; using pg8::bf16_t;

__device__ __forceinline__ void rows_rs(const float* ssq, int row0  , int fq, float (&rs)[2][4]) {
    f32x4 pp[2][4];
#pragma unroll
    for (int ai = 0; ai < 2; ++ai)
#pragma unroll
        for (int m = 0; m < 4; ++m) pp[ai][m] = *(const f32x4*)(ssq + (size_t)(row0 + ai * 128 + m * 16) * 16 + 4 * fq);
#pragma unroll
    for (int ai = 0; ai < 2; ++ai)
#pragma unroll
        for (int m = 0; m < 4; ++m) { float t = (pp[ai][m][0] + pp[ai][m][1]) + (pp[ai][m][2] + pp[ai][m][3]); t += __shfl_xor(t, 16); t += __shfl_xor(t, 32); rs[ai][m] = __builtin_amdgcn_rsqf(t * (1.0f / DM) + EPS); }
}
struct ConvIn {
    static constexpr bool PERM = false, AFTER_DRAIN = false, DUP = (DUP_EPI != 0);
    const float* ssq; bf16_t* V; bf16_t* G;
    __device__ __forceinline__ void operator()(const f32x4 (&acc)[2][2][4][2], const Unit& u, int wr, int wc, int fr, int fq) const {
        const int ch0 = u.pn * 64 + wc * 16 + 4 * fq;
        float rsv[2][4]; rows_rs(ssq, u.pm * 256 + wr * 64 + fr, fq, rsv);
#pragma unroll
        for (int ai = 0; ai < 2; ++ai)
#pragma unroll
            for (int m = 0; m < 4; ++m) {
                const int row = u.pm * 256 + ai * 128 + wr * 64 + m * 16 + fr;
                const float rs = rsv[ai][m];
                const f32x4 b = acc[ai][0][m][0] * rs, c = acc[ai][0][m][1] * rs, uu = acc[ai][1][m][0] * rs, z = acc[ai][1][m][1] * rs;
                const f32x4 v = c * uu;
                f32x4 g;
#pragma unroll
                for (int i = 0; i < 4; ++i) g[i] = b[i] * z[i] * sigmoidf_(z[i]);
                v2u wv, wg; wv.x = pk2(v[0], v[1]); wv.y = pk2(v[2], v[3]); wg.x = pk2(g[0], g[1]); wg.y = pk2(g[2], g[3]);
                *(v2u*)(V + (size_t)row * CE + ch0) = wv;
                *(v2u*)(G + (size_t)row * CE + ch0) = wg;
            }
    }
};
struct Resid {
    static constexpr bool PERM = false, AFTER_DRAIN = false, DUP = false;
    const float* xin; float* xout; bf16_t* xb; float* ssq;
    __device__ __forceinline__ void operator()(const f32x4 (&acc)[2][2][4][2], const Unit& u, int wr, int wc, int fr, int fq) const {
        const int col0 = u.pn * 256 + wc * 32 + 4 * fq;
        const size_t off0 = (size_t)(u.pm * 256 + wr * 64 + fr) * DM + col0;
        f32x4 pre[4][2][2];
#pragma unroll
        for (int i = 0; i < 4; ++i)
#pragma unroll
            for (int bj = 0; bj < 2; ++bj)
#pragma unroll
                for (int n = 0; n < 2; ++n) pre[i][bj][n] = *(const f32x4*)(xin + off0 + (size_t)(16 * i) * DM + bj * 128 + n * 16);
#pragma unroll
        for (int i = 0; i < 8; ++i) {
            const int ai = i >> 2, m = i & 3;
            const size_t off = off0 + (size_t)(ai * 128 + m * 16) * DM;
            float ss = 0.f; f32x4 xn[2][2];
#pragma unroll
            for (int bj = 0; bj < 2; ++bj)
#pragma unroll
                for (int n = 0; n < 2; ++n) { xn[bj][n] = pre[i & 3][bj][n] + acc[ai][bj][m][n]; const f32x4 t = xn[bj][n]; ss += (t[0] * t[0] + t[1] * t[1]) + (t[2] * t[2] + t[3] * t[3]); }
            if (i < 4) {
#pragma unroll
                for (int bj = 0; bj < 2; ++bj)
#pragma unroll
                    for (int n = 0; n < 2; ++n) pre[i & 3][bj][n] = *(const f32x4*)(xin + off + (size_t)128 * DM + bj * 128 + n * 16);
            }
#pragma unroll
            for (int bj = 0; bj < 2; ++bj)
#pragma unroll
                for (int n = 0; n < 2; ++n) {
                    *(f32x4*)(xout + off + bj * 128 + n * 16) = xn[bj][n];
                    v2u w; w.x = pk2(xn[bj][n][0], xn[bj][n][1]); w.y = pk2(xn[bj][n][2], xn[bj][n][3]);
                    *(v2u*)(xb + off + bj * 128 + n * 16) = w;
                }
            ss += __shfl_xor(ss, 16); ss += __shfl_xor(ss, 32);
            if (fq == 0) ssq[(size_t)(u.pm * 256 + ai * 128 + wr * 64 + m * 16 + fr) * 16 + u.pn * 4 + wc] = ss;
        }
    }
};
struct QKV {
    static constexpr bool PERM = true, AFTER_DRAIN = false, DUP = (DUP_EPI != 0);
    const float* ssq; bf16_t* Q; bf16_t* K; bf16_t* Vv; const float* qg; const float* kg;
    __device__ __forceinline__ void operator()(const f32x4 (&acc)[2][2][4][2], const Unit& u, int wr, int wc, int fr, int fq) const {
        const int which = u.pn >> 2, h = (u.pn & 3) * 4 + wc;
        bf16_t* base = Q + (ptrdiff_t)(which == 1) * (K - Q) + (ptrdiff_t)(which == 2) * (Vv - Q);
        const float* gp = qg + (ptrdiff_t)(which == 1) * (kg - qg); const float gsc = which == 0 ? QSCALE : 1.0f; const bool nrm = which < 2;
        const f32x4 g00 = *(const f32x4*)(gp + 8 * fq), g01 = *(const f32x4*)(gp + 8 * fq + 4), g10 = *(const f32x4*)(gp + 32 + 8 * fq), g11 = *(const f32x4*)(gp + 32 + 8 * fq + 4);
        float rsv[2][4]; rows_rs(ssq, u.pm * 256 + wr * 64 + fr, fq, rsv);
#pragma unroll
        for (int ai = 0; ai < 2; ++ai)
#pragma unroll
            for (int m = 0; m < 4; ++m) {
                const int row = u.pm * 256 + ai * 128 + wr * 64 + m * 16 + fr;
                const float rs = rsv[ai][m];
                f32x4 v[2][2]; float ss = 0.f;
#pragma unroll
                for (int bj = 0; bj < 2; ++bj)
#pragma unroll
                    for (int n = 0; n < 2; ++n) { v[bj][n] = acc[ai][bj][m][n] * rs; const f32x4 t = v[bj][n]; ss += (t[0] * t[0] + t[1] * t[1]) + (t[2] * t[2] + t[3] * t[3]); }
                ss += __shfl_xor(ss, 16); ss += __shfl_xor(ss, 32);
                const float rn = gsc * __builtin_amdgcn_rsqf(ss * (1.0f / HD) + EPS);
#pragma unroll
                for (int bj = 0; bj < 2; ++bj) {
                    f32x4 a = v[bj][0], b = v[bj][1];
                    if (nrm) { a = a * (bj == 0 ? g00 : g10) * rn; b = b * (bj == 0 ? g01 : g11) * rn; }
                    v4u w; w.x = pk2(a[0], a[1]); w.y = pk2(a[2], a[3]); w.z = pk2(b[0], b[1]); w.w = pk2(b[2], b[3]);
                    *(v4u*)(base + (size_t)row * DM + h * HD + 32 * bj + 8 * fq) = w;
                }
            }
    }
};
struct ZMerge {
    static constexpr bool PERM = true, AFTER_DRAIN = false, DUP = false;
    const float* ssq; const bf16_t* O0; const bf16_t* O1; const bf16_t* O2; const float* lse; bf16_t* Y;
    struct RowIn { v4u a[2], b[2], c[2]; f32x4 sq; float l0, l1, l2; };
    __device__ __forceinline__ void load_row(RowIn& r, int row, int h, int fq) const {
        const size_t off = (size_t)row * DM + h * HD + 8 * fq;
        r.sq = *(const f32x4*)(ssq + (size_t)row * 16 + 4 * fq);
        r.l0 = lse[((size_t)0 * MROWS + row) * 16 + h]; r.l1 = lse[((size_t)1 * MROWS + row) * 16 + h]; r.l2 = lse[((size_t)2 * MROWS + row) * 16 + h];
#pragma unroll
        for (int bj = 0; bj < 2; ++bj) { r.a[bj] = *(const v4u*)(O0 + off + 32 * bj); r.b[bj] = *(const v4u*)(O1 + off + 32 * bj); r.c[bj] = *(const v4u*)(O2 + off + 32 * bj); }
    }
    __device__ __forceinline__ void operator()(const f32x4 (&acc)[2][2][4][2], const Unit& u, int wr, int wc, int fr, int fq) const {
        const int h = u.pn * 4 + wc, row0 = u.pm * 256 + wr * 64 + fr;
        RowIn in[2];
        load_row(in[0], row0, h, fq);
#pragma unroll
        for (int i = 0; i < 8; ++i) {
            const int ai = i >> 2, m = i & 3, row = row0 + ai * 128 + m * 16;
            if (i + 1 < 8) load_row(in[(i + 1) & 1], row0 + ((i + 1) >> 2) * 128 + ((i + 1) & 3) * 16, h, fq);
            const RowIn& r = in[i & 1];
            float tq = (r.sq[0] + r.sq[1]) + (r.sq[2] + r.sq[3]); tq += __shfl_xor(tq, 16); tq += __shfl_xor(tq, 32);
            const float rs = __builtin_amdgcn_rsqf(tq * (1.0f / DM) + EPS);
            const float mx = fmaxf(r.l0, fmaxf(r.l1, r.l2));
            float w0 = __builtin_amdgcn_exp2f(r.l0 - mx), w1 = __builtin_amdgcn_exp2f(r.l1 - mx), w2 = __builtin_amdgcn_exp2f(r.l2 - mx);
            const float inv = __builtin_amdgcn_rcpf(w0 + w1 + w2); w0 *= inv; w1 *= inv; w2 *= inv;
#pragma unroll
            for (int bj = 0; bj < 2; ++bj) {
                const v4u a = r.a[bj], b = r.b[bj], c = r.c[bj];
                float o[8];
#pragma unroll
                for (int k = 0; k < 4; ++k) { o[2 * k] = w0 * bflo(a[k]) + w1 * bflo(b[k]) + w2 * bflo(c[k]); o[2 * k + 1] = w0 * bfhi(a[k]) + w1 * bfhi(b[k]) + w2 * bfhi(c[k]); }
                const f32x4 z0 = acc[ai][bj][m][0] * rs, z1 = acc[ai][bj][m][1] * rs;
                float y[8];
#pragma unroll
                for (int k = 0; k < 4; ++k) { y[k] = o[k] * z0[k] * sigmoidf_(z0[k]); y[4 + k] = o[4 + k] * z1[k] * sigmoidf_(z1[k]); }
                v4u w; w.x = pk2(y[0], y[1]); w.y = pk2(y[2], y[3]); w.z = pk2(y[4], y[5]); w.w = pk2(y[6], y[7]);
                *(v4u*)(Y + (size_t)row * DM + h * HD + 32 * bj + 8 * fq) = w;
            }
        }
    }
};
}

namespace naive {
template <class AL, class BL, class EP>
__device__ __forceinline__ void gemm_tile(LAS float* sm, int K, int row0, const AL& al, const BL& bl, const EP& ep) {
    const int tid = threadIdx.x, tx = tid & 15, ty = tid >> 4;
    LAS float* sA = sm; LAS float* sB = sm + 16 * 132;
    float acc[4][4];
#pragma unroll
    for (int i = 0; i < 4; ++i)
#pragma unroll
        for (int j = 0; j < 4; ++j) acc[i][j] = 0.f;
    for (int k0 = 0; k0 < K; k0 += 16) {
#pragma unroll
        for (int i = 0; i < 4; ++i) { const int idx = tid + 512 * i, r = idx >> 4, kk = idx & 15; sA[kk * 132 + r] = al(row0 + r, k0 + kk); }
#pragma unroll
        for (int i = 0; i < 2; ++i) { const int idx = tid + 512 * i, kk = idx >> 6, c = idx & 63; sB[kk * 68 + c] = bl(k0 + kk, c); }
        __syncthreads();
#pragma unroll
        for (int kk = 0; kk < 16; ++kk) {
            float a[4], b[4];
#pragma unroll
            for (int i = 0; i < 4; ++i) a[i] = sA[kk * 132 + ty * 4 + i];
#pragma unroll
            for (int j = 0; j < 4; ++j) b[j] = sB[kk * 68 + tx + 16 * j];
#pragma unroll
            for (int i = 0; i < 4; ++i)
#pragma unroll
                for (int j = 0; j < 4; ++j) acc[i][j] = fmaf(a[i], b[j], acc[i][j]);
        }
        __syncthreads();
    }
#pragma unroll
    for (int i = 0; i < 4; ++i) ep(row0 + ty * 4 + i, tx, acc[i][0], acc[i][1], acc[i][2], acc[i][3]);
}
struct ALbf { const bf16* A; int ld; __device__ __forceinline__ float operator()(int r, int k) const { return bf2f(A[(size_t)r * ld + k]); } };
__device__ __forceinline__ float red16(float v) { v += __shfl_xor(v, 1); v += __shfl_xor(v, 2); v += __shfl_xor(v, 4); v += __shfl_xor(v, 8); return v; }

struct BLc1 { const float* w; const float* nrm; int ct; __device__ __forceinline__ float operator()(int k, int c) const { return w[(size_t)k * CN + (c >> 4) * CE + ct * 16 + (c & 15)] * nrm[k]; } };
struct EPc1 { const float* ssq; bf16* V; bf16* G; int ct;
    __device__ __forceinline__ void operator()(int row, int tx, float a0, float a1, float a2, float a3) const {
        const float rs = row_rs(ssq, row); const float b = a0 * rs, c = a1 * rs, u = a2 * rs, z = a3 * rs;
        const int e = ct * 16 + tx; V[(size_t)row * CE + e] = (bf16)f2bf(c * u); G[(size_t)row * CE + e] = (bf16)f2bf(b * z * sigmoidf_(z)); } };
__device__ __forceinline__ void c1(LAS float* sm, const bf16* xb, const float* ssq, const float* w, const float* nrm, bf16* V, bf16* G, int bid, int nb) {
    const int nct = CE / 16, ntile = (MROWS / 128) * nct;
    for (int t = bid; t < ntile; t += nb) { const int rt = t / nct, ct = t % nct; gemm_tile(sm, DM, rt * 128, ALbf{xb, DM}, BLc1{w, nrm, ct}, EPc1{ssq, V, G, ct}); }
}
struct BLres { const float* w; int ct; __device__ __forceinline__ float operator()(int k, int c) const { return w[(size_t)k * DM + ct * 64 + c]; } };
struct EPres { const float* xin; float* xout; bf16* xb; float* ssq; int ct;
    __device__ __forceinline__ void operator()(int row, int tx, float a0, float a1, float a2, float a3) const {
        const size_t o = (size_t)row * DM + ct * 64 + tx;
        const float x0 = xin[o] + a0, x1 = xin[o + 16] + a1, x2 = xin[o + 32] + a2, x3 = xin[o + 48] + a3;
        xout[o] = x0; xout[o + 16] = x1; xout[o + 32] = x2; xout[o + 48] = x3;
        xb[o] = (bf16)f2bf(x0); xb[o + 16] = (bf16)f2bf(x1); xb[o + 32] = (bf16)f2bf(x2); xb[o + 48] = (bf16)f2bf(x3);
        const float ss = red16((x0 * x0 + x1 * x1) + (x2 * x2 + x3 * x3));
        if (tx == 0) ssq[(size_t)row * 16 + ct] = ss; } };
__device__ __forceinline__ void resid(LAS float* sm, const bf16* A, int K, const float* w, const float* xin, float* xout, bf16* xb, float* ssq, int bid, int nb) {
    const int ntile = (MROWS / 128) * 16;
    for (int t = bid; t < ntile; t += nb) { const int rt = t / 16, ct = t % 16; gemm_tile(sm, K, rt * 128, ALbf{A, K}, BLres{w, ct}, EPres{xin, xout, xb, ssq, ct}); }
}
struct BLa1 { const float* w; const float* nrm; int col0; __device__ __forceinline__ float operator()(int k, int c) const { return w[(size_t)k * AN + col0 + c] * nrm[k]; } };
struct EPa1 { const float* ssq; bf16* dst; const float* gain; float sc; int h;
    __device__ __forceinline__ void operator()(int row, int tx, float a0, float a1, float a2, float a3) const {
        const float rs = row_rs(ssq, row); float v0 = a0 * rs, v1 = a1 * rs, v2 = a2 * rs, v3 = a3 * rs;
        const float ss = red16((v0 * v0 + v1 * v1) + (v2 * v2 + v3 * v3));
        if (gain) { const float rn = sc / sqrtf(ss * (1.0f / HD) + EPS); v0 *= rn * gain[tx]; v1 *= rn * gain[tx + 16]; v2 *= rn * gain[tx + 32]; v3 *= rn * gain[tx + 48]; }
        const size_t o = (size_t)row * DM + h * HD + tx;
        dst[o] = (bf16)f2bf(v0); dst[o + 16] = (bf16)f2bf(v1); dst[o + 32] = (bf16)f2bf(v2); dst[o + 48] = (bf16)f2bf(v3); } };
__device__ __forceinline__ void a1(LAS float* sm, const bf16* xb, const float* ssq, const float* w, const float* nrm, int g, const float* qg, const float* kg, bf16* Q, bf16* K, bf16* V, int bid, int nb) {
    const int ntile = (MROWS / 128) * 48;
    for (int t = bid; t < ntile; t += nb) { const int rt = t / 48, ct = t % 48, which = ct / 16, h = ct % 16;
        gemm_tile(sm, DM, rt * 128, ALbf{xb, DM}, BLa1{w, nrm, g * 3072 + which * 1024 + h * 64},
                  EPa1{ssq, which == 0 ? Q : (which == 1 ? K : V), which == 0 ? qg : (which == 1 ? kg : nullptr), which == 0 ? QSCALE : 1.0f, h}); }
}
struct EPa3 { const float* ssq; const bf16* O0; const bf16* O1; const bf16* O2; const float* lse; bf16* Y; int h;
    __device__ __forceinline__ void operator()(int row, int tx, float a0, float a1, float a2, float a3) const {
        const float rs = row_rs(ssq, row);
        const float l0 = lse[((size_t)0 * MROWS + row) * 16 + h], l1 = lse[((size_t)1 * MROWS + row) * 16 + h], l2 = lse[((size_t)2 * MROWS + row) * 16 + h];
        const float mx = fmaxf(l0, fmaxf(l1, l2)); float w0 = exp2f(l0 - mx), w1 = exp2f(l1 - mx), w2 = exp2f(l2 - mx); const float inv = 1.0f / (w0 + w1 + w2); w0 *= inv; w1 *= inv; w2 *= inv;
        const float zz[4] = {a0 * rs, a1 * rs, a2 * rs, a3 * rs};
#pragma unroll
        for (int j = 0; j < 4; ++j) { const size_t o = (size_t)row * DM + h * HD + tx + 16 * j;
            const float ov = w0 * bf2f(O0[o]) + w1 * bf2f(O1[o]) + w2 * bf2f(O2[o]); Y[o] = (bf16)f2bf(ov * zz[j] * sigmoidf_(zz[j])); } } };
__device__ __forceinline__ void a3(LAS float* sm, const bf16* xb, const float* ssq, const float* w, const float* nrm, const bf16* O0, const bf16* O1, const bf16* O2, const float* lse, bf16* Y, int bid, int nb) {
    const int ntile = (MROWS / 128) * 16;
    for (int t = bid; t < ntile; t += nb) { const int rt = t / 16, h = t % 16; gemm_tile(sm, DM, rt * 128, ALbf{xb, DM}, BLa1{w, nrm, QKVC + h * 64}, EPa3{ssq, O0, O1, O2, lse, Y, h}); }
}
__device__ __forceinline__ void a2(bf16* QO, const bf16* K, const bf16* V, const float* biasT  , float* lse  , int dil, int gtid, int gthreads) {
    for (int idx = gtid; idx < MROWS * NH; idx += gthreads) {
        const int row = idx >> 4, h = idx & 15, t = row & (SEQ - 1);
        bf16* qp = QO + (size_t)row * DM + h * HD;
        float q[64], o[64];
#pragma unroll
        for (int c = 0; c < 8; ++c) { const v4u w = *(const v4u*)(qp + 8 * c);
#pragma unroll
            for (int i = 0; i < 4; ++i) { q[8 * c + 2 * i] = bflo(w[i]); q[8 * c + 2 * i + 1] = bfhi(w[i]); } }
#pragma unroll
        for (int d = 0; d < 64; ++d) o[d] = 0.f;
        float m = -INFINITY, l = 0.f;
        for (int j = 0; j <= 128; ++j) {
            const int tk = t - dil * j; if (tk < 0) break;
            const size_t ko = (size_t)(row - dil * j) * DM + h * HD;
            float s = 0.f;
#pragma unroll
            for (int c = 0; c < 8; ++c) { const v4u w = *(const v4u*)(K + ko + 8 * c);
#pragma unroll
                for (int i = 0; i < 4; ++i) { s = fmaf(q[8 * c + 2 * i], bflo(w[i]), s); s = fmaf(q[8 * c + 2 * i + 1], bfhi(w[i]), s); } }
            s += biasT[h * 132 + j];
            const float mn = fmaxf(m, s), f = exp2f(m - mn), p = exp2f(s - mn);
            l = l * f + p; m = mn;
#pragma unroll
            for (int c = 0; c < 8; ++c) { const v4u w = *(const v4u*)(V + ko + 8 * c);
#pragma unroll
                for (int i = 0; i < 4; ++i) { o[8 * c + 2 * i] = o[8 * c + 2 * i] * f + p * bflo(w[i]); o[8 * c + 2 * i + 1] = o[8 * c + 2 * i + 1] * f + p * bfhi(w[i]); } }
        }
        const float il = 1.0f / l;
#pragma unroll
        for (int c = 0; c < 8; ++c) { v4u w;
#pragma unroll
            for (int i = 0; i < 4; ++i) w[i] = pk2(o[8 * c + 2 * i] * il, o[8 * c + 2 * i + 1] * il);
            *(v4u*)(qp + 8 * c) = w; }
        lse[(size_t)row * 16 + h] = m + log2f(l);
    }
}
}

template <int MODE> __device__ __forceinline__ int wt_dest_row(int n) {
    if (MODE == 1) { const int type = n >> 11, e = n & 2047, pn = e >> 6, el = e & 63; return 256 * pn + 128 * (type >> 1) + 32 * (el >> 4) + 16 * (type & 1) + (el & 15); }
    if (MODE == 3) { const int blk = n >> 10, r = n & 1023, h = r >> 6, d = r & 63; return blk * 1024 + 256 * (h >> 2) + 128 * (d >> 5) + 32 * (h & 3) + (d & 31); }
    return n;
}
template <int MODE> __device__ __forceinline__ void p0_transpose_item(const float* W, int K, int N, const float* scale, bf16* WT, LAS float* scr  , int item, int lane) {
    const int nblk = N / 64, kb = item / nblk, nb = item % nblk, k0 = 64 * kb, n0 = 64 * nb;
    const int kr = lane >> 4, c4 = lane & 15;
    f32x4 v[16];
#pragma unroll
    for (int i = 0; i < 16; ++i) v[i] = *(const GAS f32x4*)(W + (size_t)(k0 + 4 * i + kr) * N + n0 + 4 * c4);
#pragma unroll
    for (int i = 0; i < 16; ++i) { const float s = scale ? scale[k0 + 4 * i + kr] : 1.0f; LAS float* d = scr + (4 * i + kr) * 65 + 4 * c4;
        d[0] = v[i][0] * s; d[1] = v[i][1] * s; d[2] = v[i][2] * s; d[3] = v[i][3] * s; }
    LDS_WAIT(); asm volatile("" ::: "memory");
    const int c = lane & 7, nl = lane >> 3;
#pragma unroll
    for (int j = 0; j < 8; ++j) { const int n = nl + 8 * j; const LAS float* s = scr + (8 * c) * 65 + n;
        v4u o; o.x = pk2(s[0 * 65], s[1 * 65]); o.y = pk2(s[2 * 65], s[3 * 65]); o.z = pk2(s[4 * 65], s[5 * 65]); o.w = pk2(s[6 * 65], s[7 * 65]);
        *(GAS v4u*)(WT + (size_t)wt_dest_row<MODE>(n0 + n) * K + k0 + 8 * c) = o; }
    LDS_WAIT(); asm volatile("" ::: "memory");
}
struct Ptrs {
    const float *x, *conv_norm, *conv_w_in, *conv_w, *conv_w_out, *attn_norm, *attn_w_in, *q_gain, *k_gain, *attn_w_out, *rel_bias;
    float* out; unsigned char* ws;
};
__device__ __forceinline__ void p0_prologue(const Ptrs& P, LAS unsigned char* lds, int vcu, int G, int wave, int lane, int tid) {
    LAS float* scr = (LAS float*)(lds + wave * 16640);
    const int gw = vcu * 8 + wave, NGW = G * 8;
    bf16* W1 = (bf16*)(P.ws + WS_W1); bf16* W2 = (bf16*)(P.ws + WS_W2); bf16* W3 = (bf16*)(P.ws + WS_W3); bf16* W4 = (bf16*)(P.ws + WS_W4);
    constexpr int I1 = (DM / 64) * (CN / 64), I2 = (CE / 64) * (DM / 64), I3 = (DM / 64) * (AN / 64), I4 = (DM / 64) * (DM / 64), IL = I1 + I2 + I3 + I4;
    for (int it = gw; it < 2 * IL; it += NGW) {
        const int j = it / IL; int r = it % IL;
        if (r < I1) { p0_transpose_item<1>(P.conv_w_in + (size_t)j * DM * CN, DM, CN, P.conv_norm + j * DM, W1 + (size_t)j * CN * DM, scr, r, lane); continue; } r -= I1;
        if (r < I2) { p0_transpose_item<0>(P.conv_w_out + (size_t)j * CE * DM, CE, DM, nullptr, W2 + (size_t)j * DM * CE, scr, r, lane); continue; } r -= I2;
        if (r < I3) { p0_transpose_item<3>(P.attn_w_in + (size_t)j * DM * AN, DM, AN, P.attn_norm + j * DM, W3 + (size_t)j * AN * DM, scr, r, lane); continue; } r -= I3;
        p0_transpose_item<0>(P.attn_w_out + (size_t)j * DM * DM, DM, DM, nullptr, W4 + (size_t)j * DM * DM, scr, r, lane);
    }
    bf16* XB = (bf16*)(P.ws + WS_XB); float* SSQ = (float*)(P.ws + WS_SSQ);
    for (int m = 2 * gw; m < MROWS; m += 2 * NGW) {
        const GAS f32x4* xr = (const GAS f32x4*)(P.x + (size_t)m * DM) + lane;
        GAS v2u* o8 = (GAS v2u*)(XB + (size_t)m * DM) + lane;
        f32x4 v[8];
#pragma unroll
        for (int jj = 0; jj < 8; ++jj) v[jj] = xr[64 * jj];
        float s0 = 0.f, s1 = 0.f;
#pragma unroll
        for (int jj = 0; jj < 8; ++jj) { const f32x4 t = v[jj]; const float q = (t.x * t.x + t.y * t.y) + (t.z * t.z + t.w * t.w); if (jj < 4) s0 += q; else s1 += q;
            v2u w; w.x = pk2(t.x, t.y); w.y = pk2(t.z, t.w); o8[64 * jj] = w; }
        s0 = wave_sum(s0); s1 = wave_sum(s1);
        if (lane < 32) SSQ[(size_t)m * 16 + lane] = lane == 0 ? s0 : (lane == 16 ? s1 : 0.f);
    }
    float* BT = (float*)(P.ws + WS_BIAS);
    for (int i = vcu * 512 + tid; i < NG * NH * 132; i += G * 512) {
        const int g = i / (NH * 132), r = i % (NH * 132), h = r / 132, st = r % 132;
        const int dil = g == 0 ? 1 : (g == 1 ? 4 : 16);
        BT[i] = st <= 128 ? P.rel_bias[t5_bucket(st * dil) * (NG * NH) + g * NH + h] * LOG2E : 0.f;
    }
}
template <bool WRAP> __device__ __forceinline__ void conv_pass(const bf16* V, const bf16* GY, bf16* OUT, const float* cw  , int gtid, int gthreads) {
    for (int idx = gtid; idx < MROWS * (CE / 8); idx += gthreads) {
        const int row = idx / (CE / 8), e0 = (idx % (CE / 8)) * 8, t = row & (SEQ - 1);
        const size_t o = (size_t)row * CE + e0;
        const v4u g = *(const v4u*)(GY + o), v2 = *(const v4u*)(V + o);
        v4u v1 = (v4u){0u, 0u, 0u, 0u}, v0 = (v4u){0u, 0u, 0u, 0u};
        if (t >= 1) v1 = *(const v4u*)(V + o - CE);
        if (t >= 2) v0 = *(const v4u*)(V + o - 2 * CE);
        float w0[8], w1[8], w2[8];
#pragma unroll
        for (int c = 0; c < 2; ++c) { const f32x4 a = *(const f32x4*)(cw + e0 + 4 * c), b = *(const f32x4*)(cw + CE + e0 + 4 * c), d = *(const f32x4*)(cw + 2 * CE + e0 + 4 * c);
#pragma unroll
            for (int i = 0; i < 4; ++i) { w0[4 * c + i] = a[i]; w1[4 * c + i] = b[i]; w2[4 * c + i] = d[i]; } }
        float y[8];
#pragma unroll
        for (int i = 0; i < 4; ++i) {
            y[2 * i] = bflo(g[i]) * (w0[2 * i] * bflo(v0[i]) + w1[2 * i] * bflo(v1[i]) + w2[2 * i] * bflo(v2[i]));
            y[2 * i + 1] = bfhi(g[i]) * (w0[2 * i + 1] * bfhi(v0[i]) + w1[2 * i + 1] * bfhi(v1[i]) + w2[2 * i + 1] * bfhi(v2[i]));
        }
        v4u w; w.x = pk2(y[0], y[1]); w.y = pk2(y[2], y[3]); w.z = pk2(y[4], y[5]); w.w = pk2(y[6], y[7]);
        *(v4u*)(OUT + (WRAP ? (o & (size_t)(16 * 1024 * 1024 - 1)) : o)) = w;
    }
}

namespace attn {
typedef float f32x16 __attribute__((ext_vector_type(16)));
typedef short s16x4 __attribute__((ext_vector_type(4)));
typedef short v4i16_t __attribute__((ext_vector_type(4)));
constexpr int L_K = 0, L_V = 49152, L_B = 98304, L_O = 118784, L_END = 151552, L_WS = 151552 + 256;
static_assert(L_O + 8 * 4096 == L_END && L_B + 5 * 4096 == L_O, "attention LDS map");
__device__ __forceinline__ int crow(int r, int hi) { return (r & 3) + 8 * (r >> 2) + 4 * hi; }
__device__ __forceinline__ s16x4 vtr(LAS const unsigned char* p) { return __builtin_bit_cast(s16x4, __builtin_amdgcn_ds_read_tr16_b64_v4i16((LAS v4i16_t*)p)); }
__device__ __forceinline__ float swapmax(float m) { auto rr = __builtin_amdgcn_permlane32_swap(__float_as_uint(m), __float_as_uint(m), false, false); return fmaxf(__uint_as_float(rr[0]), __uint_as_float(rr[1])); }
__device__ __forceinline__ float swapsum(float m) { auto rr = __builtin_amdgcn_permlane32_swap(__float_as_uint(m), __float_as_uint(m), false, false); return __uint_as_float(rr[0]) + __uint_as_float(rr[1]); }

template <int DIL> __device__ __forceinline__ void phase(LAS unsigned char* lds, const bf16* QO, bf16* OUT, const bf16* Kg, const bf16* Vg, const float* biasT  , float* lse  , int vcu, int G) {
    const int tid = threadIdx.x, lane = tid & 63, r32 = lane & 31, hi = lane >> 5;
    const int w = __builtin_amdgcn_readfirstlane(tid >> 6);
    constexpr int CPC = (SEQ / DIL) / 256;
    constexpr int NJS = BATCH * NH * 16;
    int cur_bh = -1;
    for (int id = vcu * 4; id < NJS; id += ((id & 3) == 3) ? (G * 4 - 3) : 1) {
        const int bh = id >> 4, sub = id & 15, c = sub / CPC, ck = sub % CPC;
        const int b = bh >> 4, h = bh & 15, n0 = ck * 256;
        const size_t rowb = (size_t)b * SEQ;
#pragma unroll
        for (int i = 0; i < 12; ++i) {
            const int p = w * 12 + i, kb = p < 48 ? p : p - 48;
            const int row = kb * 8 + (lane >> 3), pc = lane & 7;
            int pos = n0 - 128 + row; pos = pos < 0 ? 0 : pos;
            const size_t ro = (rowb + (size_t)pos * DIL + c) * DM + h * HD;
            if (p < 48) {
                __builtin_amdgcn_global_load_lds((const unsigned*)(Kg + ro + ((pc ^ ((row >> 1) & 7)) * 8)), (LAS unsigned*)(lds + L_K + kb * 1024), 16, 0, 0);
            } else {
                __builtin_amdgcn_global_load_lds((const unsigned*)(Vg + ro + ((((pc >> 2) ^ ((row >> 1) & 1)) * 32) + (pc & 3) * 8)), (LAS unsigned*)(lds + L_V + kb * 1024), 16, 0, 0);
            }
        }
        const size_t qrow = rowb + (size_t)(n0 + 32 * w + r32) * DIL + c;
        bf16x8 qr[4];
#pragma unroll
        for (int d0 = 0; d0 < 4; ++d0) qr[d0] = *(const bf16x8*)(QO + qrow * DM + h * HD + d0 * 16 + hi * 8);
        if (bh != cur_bh) {
            cur_bh = bh;
#pragma unroll
            for (int i = 0; i < 10; ++i) {
                const int e = tid + 512 * i, j = e >> 10, rem = e & 1023, rg = rem >> 8, ln = (rem & 255) >> 2, i4 = rem & 3;
                const int r = 4 * rg + i4, a = ln & 31, hh = ln >> 5, kk = 32 * j + crow(r, hh), step = 128 + a - kk;
                float val = -INFINITY;
                if (step >= 0 && step <= 128) val = biasT[h * 132 + step];
                ((LAS float*)(lds + L_B))[e] = val;
            }
        }
        asm volatile("s_waitcnt vmcnt(0)" ::: "memory");
        __syncthreads();
        const int jstart = (n0 == 0 && w < 4) ? 4 - w : 0;
        f32x16 S[5];
#pragma unroll
        for (int j = 0; j < 5; ++j) {
            if (j < jstart) {
#pragma unroll
                for (int r = 0; r < 16; ++r) S[j][r] = -INFINITY;
            } else {
                f32x16 cinit;
#pragma unroll
                for (int rg = 0; rg < 4; ++rg) { const f32x4 t = *(const LAS f32x4*)(lds + L_B + j * 4096 + rg * 1024 + lane * 16); cinit[4 * rg] = t[0]; cinit[4 * rg + 1] = t[1]; cinit[4 * rg + 2] = t[2]; cinit[4 * rg + 3] = t[3]; }
#pragma unroll
                for (int d0 = 0; d0 < 4; ++d0) {
                    const bf16x8 kf = *(const LAS bf16x8*)(lds + L_K + (32 * w + 32 * j + r32) * 128 + (((2 * d0 + hi) ^ ((r32 >> 1) & 7)) * 16));
                    cinit = __builtin_amdgcn_mfma_f32_32x32x16_bf16(kf, qr[d0], cinit, 0, 0, 0);
                }
                S[j] = cinit;
            }
        }
        float m = -INFINITY;
#pragma unroll
        for (int j = 0; j < 5; ++j)
#pragma unroll
            for (int r = 0; r < 16; ++r) m = fmaxf(m, S[j][r]);
        m = swapmax(m);
        float lsum = 0.f;
#pragma unroll
        for (int j = 0; j < 5; ++j)
#pragma unroll
            for (int r = 0; r < 16; ++r) { const float p = __builtin_amdgcn_exp2f(S[j][r] - m); S[j][r] = p; lsum += p; }
        lsum = swapsum(lsum);
        f32x16 o[2];
#pragma unroll
        for (int r = 0; r < 16; ++r) { o[0][r] = 0.f; o[1][r] = 0.f; }
        const int vq = (lane & 15) >> 2, vx = (vq >> 1) & 1;
        const LAS unsigned char* vrow = lds + L_V + (32 * w + 4 * hi + vq) * 128 + ((lane >> 4) & 1) * 32 + (lane & 3) * 8;
        const LAS unsigned char* vbh[2] = {vrow + vx * 64, vrow + (1 - vx) * 64};
#pragma unroll
        for (int j = 0; j < 5; ++j)
#pragma unroll
            for (int s = 0; s < 2; ++s) {
                v4u pw; pw.x = pk2(S[j][8 * s], S[j][8 * s + 1]); pw.y = pk2(S[j][8 * s + 2], S[j][8 * s + 3]); pw.z = pk2(S[j][8 * s + 4], S[j][8 * s + 5]); pw.w = pk2(S[j][8 * s + 6], S[j][8 * s + 7]);
                const bf16x8 pa = __builtin_bit_cast(bf16x8, pw);
#pragma unroll
                for (int d0 = 0; d0 < 2; ++d0) {
                    const s16x4 lo = vtr(vbh[d0] + (32 * j + 16 * s) * 128), hh = vtr(vbh[d0] + (32 * j + 16 * s + 8) * 128);
                    const bf16x8 vf = (bf16x8){lo[0], lo[1], lo[2], lo[3], hh[0], hh[1], hh[2], hh[3]};
                    o[d0] = __builtin_amdgcn_mfma_f32_32x32x16_bf16(pa, vf, o[d0], 0, 0, 0);
                }
            }
        LAS float* wsf = (LAS float*)(lds + L_WS) + w * 64;
        if (hi == 0) { wsf[r32] = lsum; lse[qrow * 16 + h] = m + log2f(lsum); }
        asm volatile("s_waitcnt lgkmcnt(0)" ::: "memory");
        float rli[16];
#pragma unroll
        for (int r = 0; r < 16; ++r) rli[r] = __builtin_amdgcn_rcpf(wsf[crow(r, hi)]);
        LAS bf16* stg = (LAS bf16*)(lds + L_O) + w * 2048;
#pragma unroll
        for (int r = 0; r < 16; ++r) { const int orow = crow(r, hi);
#pragma unroll
            for (int d0 = 0; d0 < 2; ++d0) stg[orow * 64 + d0 * 32 + r32] = (bf16)(pk2(o[d0][r] * rli[r], 0.f) & 0xffffu); }
        asm volatile("s_waitcnt lgkmcnt(0)" ::: "memory");
#pragma unroll
        for (int i = 0; i < 4; ++i) { const int row = i * 8 + (lane >> 3), ch = lane & 7; const v4u v = *(const LAS v4u*)(stg + row * 64 + ch * 8);
            *(v4u*)(OUT + (rowb + (size_t)(n0 + 32 * w + row) * DIL + c) * DM + h * HD + ch * 8) = v; }
        __syncthreads();
    }
}
}

#ifndef OPT_C1
#define OPT_C1 0
#endif
#ifndef OPT_RES
#define OPT_RES 0
#endif
#ifndef OPT_A1
#define OPT_A1 0
#endif
#ifndef OPT_A2
#define OPT_A2 0
#endif
#ifndef OPT_A3
#define OPT_A3 0
#endif
#ifndef DUP_A2
#define DUP_A2 0
#endif
#ifndef DUP_A1
#define DUP_A1 0
#endif
#ifndef DUP_C1
#define DUP_C1 0
#endif
#ifndef DUP_A3
#define DUP_A3 0
#endif
#ifndef DUP_P0
#define DUP_P0 0
#endif
#ifndef DUP_C3
#define DUP_C3 0
#endif
#ifndef DUP_C2
#define DUP_C2 0
#endif
#ifndef DUP_BAR
#define DUP_BAR 0
#endif
#ifndef MK_PER_PHASE
#define MK_PER_PHASE 1
#endif
constexpr int LDS_BYTES = 155648;
constexpr int MISC_OFF = 151552;
struct Args { const float* in[11]; float* out; unsigned char* ws; int ph_lo, ph_hi; };

template <int PH> __device__ __forceinline__ void run_phase(const Args& args, LAS unsigned char* lds) {
    const int tid = threadIdx.x, lane = tid & 63, wave = __builtin_amdgcn_readfirstlane(tid >> 6);
    const int G = gridDim.x, bx = blockIdx.x, vcu = (G % 8 == 0) ? (bx % 8) * (G / 8) + bx / 8 : bx;
    unsigned char* ws = args.ws;
    float* SSQ = (float*)(ws + WS_SSQ); bf16* XB = (bf16*)(ws + WS_XB);
    LAS float* smf = (LAS float*)lds;
    const int gtid = vcu * 512 + tid, gthreads = G * 512;
    (void)lane; (void)wave; (void)smf; (void)gtid; (void)gthreads; (void)SSQ; (void)XB;
    if constexpr (PH == 0) {
        Ptrs P;
        P.x = args.in[0]; P.conv_norm = args.in[1]; P.conv_w_in = args.in[2]; P.conv_w = args.in[3]; P.conv_w_out = args.in[4]; P.attn_norm = args.in[5];
        P.attn_w_in = args.in[6]; P.q_gain = args.in[7]; P.k_gain = args.in[8]; P.attn_w_out = args.in[9]; P.rel_bias = args.in[10]; P.out = args.out; P.ws = args.ws;
#if DUP_P0
        p0_prologue(P, lds, vcu, G, wave, lane, tid);
#endif
        p0_prologue(P, lds, vcu, G, wave, lane, tid);
    } else {
        constexpr int p = PH - 1, j = p / 11, s = p % 11;
        if constexpr (s == 0) {
            bf16* CV = (bf16*)(ws + WS_CV); bf16* CG = (bf16*)(ws + WS_CG);
#if OPT_C1
            pg8::Gemm g{XB, (const bf16*)(ws + WS_W1) + (size_t)j * CN * DM, MROWS, CN, DM}; pg8::StaticOrder S; S.init(MROWS, CN, G, bx);
            epi::ConvIn E{SSQ, CV, CG};
#if DUP_C1
            pg8::gemm_phase<epi::ConvIn, pg8::StaticOrder, true, true>(lds, g, S, E);
#endif
            pg8::gemm_phase<epi::ConvIn, pg8::StaticOrder, true, true>(lds, g, S, E);
#else
            naive::c1(smf, XB, SSQ, args.in[2] + (size_t)j * DM * CN, args.in[1] + j * DM, CV, CG, bx, G);
#endif
        } else if constexpr (s == 1) {
#if DUP_C2
            conv_pass<true>((const bf16*)(ws + WS_CV), (bf16*)(ws + WS_CG), (bf16*)(ws + WS_END), args.in[3] + (size_t)j * 3 * CE, gtid, gthreads);
#endif
            conv_pass<false>((const bf16*)(ws + WS_CV), (bf16*)(ws + WS_CG), (bf16*)(ws + WS_CG), args.in[3] + (size_t)j * 3 * CE, gtid, gthreads);
        } else if constexpr (s == 2 || s == 10) {
            const bf16* A = (const bf16*)(ws + (s == 2 ? WS_CG : WS_Y)); constexpr int K = s == 2 ? CE : DM;
            const float* xin = (j == 0 && s == 2) ? args.in[0] : args.out;
#if OPT_RES
            pg8::Gemm g{A, (const bf16*)(ws + (s == 2 ? WS_W2 : WS_W4)) + (size_t)j * DM * K, MROWS, DM, K}; pg8::StaticOrder S; S.init(MROWS, DM, G, bx);
            epi::Resid E{xin, args.out, XB, SSQ};
#if DUP_C3
            if constexpr (j == 0 && s == 2) pg8::gemm_phase<epi::Resid, pg8::StaticOrder, false, true>(lds, g, S, E);
#endif
            pg8::gemm_phase<epi::Resid, pg8::StaticOrder, false, true>(lds, g, S, E);
#else
            naive::resid(smf, A, K, s == 2 ? args.in[4] + (size_t)j * CE * DM : args.in[9] + (size_t)j * DM * DM, xin, args.out, XB, SSQ, bx, G);
#endif
        } else if constexpr (s == 9) {
            const bf16* O0 = (const bf16*)(ws + WS_QO); const bf16* O1 = O0 + (size_t)MROWS * DM; const bf16* O2 = O1 + (size_t)MROWS * DM;
            float* LSE = (float*)(ws + WS_LSE); bf16* YB = (bf16*)(ws + WS_Y);
#if OPT_A3
            pg8::Gemm g{XB, (const bf16*)(ws + WS_W3) + (size_t)j * AN * DM + (size_t)QKVC * DM, MROWS, DM, DM}; pg8::StaticOrder S; S.init(MROWS, DM, G, bx);
            epi::ZMerge E{SSQ, O0, O1, O2, LSE, YB};
#if DUP_A3
            pg8::gemm_phase<epi::ZMerge, pg8::StaticOrder, false, true>(lds, g, S, E);
#endif
            pg8::gemm_phase<epi::ZMerge, pg8::StaticOrder, false, true>(lds, g, S, E);
#else
            naive::a3(smf, XB, SSQ, args.in[6] + (size_t)j * DM * AN, args.in[5] + j * DM, O0, O1, O2, LSE, YB, bx, G);
#endif
        } else {
            constexpr int g = (s - 3) >> 1; bf16* QO = (bf16*)(ws + WS_QO) + (size_t)g * MROWS * DM;
            bf16* KB = (bf16*)(ws + WS_K); bf16* VB = (bf16*)(ws + WS_V);
            if constexpr (((s - 3) & 1) == 0) {
#if OPT_A1
                pg8::Gemm gm{XB, (const bf16*)(ws + WS_W3) + (size_t)j * AN * DM + (size_t)g * 3072 * DM, MROWS, 3072, DM}; pg8::StaticOrder S; S.init(MROWS, 3072, G, bx);
                epi::QKV E{SSQ, QO, KB, VB, args.in[7] + (j * NG + g) * HD, args.in[8] + (j * NG + g) * HD};
#if DUP_A1
                pg8::gemm_phase<epi::QKV, pg8::StaticOrder, true, true>(lds, gm, S, E);
#endif
                pg8::gemm_phase<epi::QKV, pg8::StaticOrder, true, true>(lds, gm, S, E);
#else
                naive::a1(smf, XB, SSQ, args.in[6] + (size_t)j * DM * AN, args.in[5] + j * DM, g, args.in[7] + (j * NG + g) * HD, args.in[8] + (j * NG + g) * HD, QO, KB, VB, bx, G);
#endif
            } else {
                constexpr int dil = g == 0 ? 1 : (g == 1 ? 4 : 16);
                float* LSE = (float*)(ws + WS_LSE); const float* BT = (const float*)(ws + WS_BIAS);
#if OPT_A2
#if DUP_A2
                attn::phase<dil>(lds, QO, (bf16*)(ws + WS_END), KB, VB, BT + g * NH * 132, LSE + (size_t)g * MROWS * 16, vcu, G);
#endif
                attn::phase<dil>(lds, QO, QO, KB, VB, BT + g * NH * 132, LSE + (size_t)g * MROWS * 16, vcu, G);
#else
                naive::a2(QO, KB, VB, BT + g * NH * 132, LSE + (size_t)g * MROWS * 16, dil, gtid, gthreads);
#endif
            }
        }
    }
}

__global__ void __launch_bounds__(512, 2) mk_fwd(Args args) {
    extern __shared__ __attribute__((aligned(16))) unsigned char lds_raw[];
    LAS unsigned char* lds = (LAS unsigned char*)lds_raw;
    volatile LAS unsigned* MISC = (volatile LAS unsigned*)(lds + MISC_OFF);
    for (int u = threadIdx.x; u < (LDS_BYTES - MISC_OFF) / 4; u += 512) ((LAS unsigned*)(lds + MISC_OFF))[u] = 0u;
    __syncthreads();
    gu32* ctl = (gu32*)(args.ws + WS_CTL);
    XcdBarrier bar; bar.bar = (unsigned*)(ctl + CW_BAR); bar.x = 0; bar.st = nullptr;
    const int lo = args.ph_lo, hi = args.ph_hi;
    if (hi - lo > 1) bar = xcd_barrier_post((unsigned*)(ctl + CW_BAR), MISC + 8);
#if DUP_BAR
#define RUN(k) if (lo <= (k) && (k) < hi) { run_phase<(k)>(args, lds); if ((k) + 1 < hi) { xcd_barrier(bar); xcd_barrier(bar); } }
#else
#define RUN(k) if (lo <= (k) && (k) < hi) { run_phase<(k)>(args, lds); if ((k) + 1 < hi) xcd_barrier(bar); }
#endif
    RUN(0) RUN(1) RUN(2) RUN(3) RUN(4) RUN(5) RUN(6) RUN(7) RUN(8) RUN(9) RUN(10) RUN(11)
    RUN(12) RUN(13) RUN(14) RUN(15) RUN(16) RUN(17) RUN(18) RUN(19) RUN(20) RUN(21) RUN(22)
#undef RUN
}

extern "C" void kernel_launch(void* const* d_in, const int* in_sizes, int n_in, void* d_out, int out_size, void* d_ws, size_t ws_size, hipStream_t stream) {
    static int grid = 0;
    if (grid == 0) {
        if (n_in != 11 || in_sizes[0] != MROWS * DM || out_size != MROWS * DM || ws_size < WS_END) { fprintf(stderr, "kernel_launch: unexpected shapes (n_in %d, ws %zu); nothing launched\n", n_in, ws_size); grid = -1; return; }
        int dev = 0, cus = 0, per_cu = 0;
        if (hipGetDevice(&dev) != hipSuccess || hipDeviceGetAttribute(&cus, hipDeviceAttributeMultiprocessorCount, dev) != hipSuccess) { grid = -1; return; }
        if (hipFuncSetAttribute((const void*)mk_fwd, hipFuncAttributeMaxDynamicSharedMemorySize, LDS_BYTES) != hipSuccess) { fprintf(stderr, "kernel_launch: hipFuncSetAttribute failed\n"); grid = -1; return; }
        if (hipOccupancyMaxActiveBlocksPerMultiprocessor(&per_cu, (const void*)mk_fwd, 512, LDS_BYTES) != hipSuccess || per_cu < 1) { fprintf(stderr, "kernel_launch: occupancy query says %d blocks per CU; nothing launched\n", per_cu); (void)hipGetLastError(); grid = -1; return; }
        grid = cus;
    }
    if (grid < 0) return;
    (void)hipMemsetAsync((char*)d_ws + WS_CTL, 0, CTL_ZERO_BYTES, stream);
    Args a{};
    for (int i = 0; i < 11; ++i) a.in[i] = (const float*)d_in[i];
    a.out = (float*)d_out; a.ws = (unsigned char*)d_ws;
#if MK_PER_PHASE
    for (int ph = 0; ph < NPHASE; ++ph) { a.ph_lo = ph; a.ph_hi = ph + 1; hipLaunchKernelGGL(mk_fwd, dim3(grid), dim3(512), LDS_BYTES, stream, a); }
#else
    a.ph_lo = 0; a.ph_hi = NPHASE; hipLaunchKernelGGL(mk_fwd, dim3(grid), dim3(512), LDS_BYTES, stream, a);
#endif
}
```

```cpp
#include <hip/hip_runtime.h>
#include <cstdio>
#include <cstdint>
#include <cmath>
#define MK_PER_PHASE 0
#define OPT_C1 1
#define OPT_RES 1
#define OPT_A1 1
#define OPT_A3 1
#define OPT_A2 1
namespace pg8 {
#define PG8_LAS __attribute__((address_space(3)))
typedef unsigned short bf16_t;
typedef short bf16x8 __attribute__((ext_vector_type(8)));
typedef float f32x4 __attribute__((ext_vector_type(4)));
typedef unsigned u32x4 __attribute__((ext_vector_type(4)));
constexpr int BM = 256, BK = 64, HALF = 128, HTB = HALF * BK * 2  , STAGE_BYTES = 8 * HTB, NXCD = 8, WGM = 8;

__host__ __device__ __forceinline__ int lds_byte(int r, int c) { const int st = (r >> 4) * 2 + (c >> 5), rr = r & 15, cc = c & 31, ob = rr * 64 + cc * 2; return st * 1024 + (ob ^ (((ob >> 9) & 1) << 5)); }
__host__ __device__ __forceinline__ void stage_rc(int b, int& R, int& C) { const int st = b / 1024, sb = b % 1024, swz = sb ^ (((sb >> 9) & 1) << 5); R = (st >> 1) * 16 + swz / 64; C = (st & 1) * 32 + (swz % 64) / 2; }
__host__ __device__ __forceinline__ int perm32(int rho) { const int n = rho >> 4, i = rho & 15; return 8 * (i >> 2) + 4 * n + (i & 3); }

struct Unit { int pm, pn; };
struct Gemm { const bf16_t* A; const bf16_t* Bt; int M, N, K; };

struct StaticOrder {
    int nM, nN, nwg, G, c;
    __host__ __device__ void init(int M, int N, int G_, int c_) { nM = M / BM; nN = N / BM; nwg = nM * nN; G = G_; c = c_; }
    __host__ __device__ bool next(int i, Unit& u) const {
        const long L = (long)i * G + c; if (L >= nwg) return false;
        int wgid = (int)L; { const int q = nwg / NXCD, r = nwg % NXCD, xcd = wgid % NXCD, off = wgid / NXCD; wgid = (xcd < r ? xcd * (q + 1) : r * (q + 1) + (xcd - r) * q) + off; }
        const int nig = WGM * nN, gid = wgid / nig, fm = gid * WGM, gsz = (nM - fm) < WGM ? (nM - fm) : WGM;
        u.pm = fm + ((wgid % nig) % gsz); u.pn = (wgid % nig) / gsz; return true;
    }
    __device__ __forceinline__ void a_ready(const Unit&) const {}
    __device__ __forceinline__ void done(const Unit&) const {}
};

__device__ __forceinline__ unsigned cvt_pk_bf16(float lo, float hi) { unsigned r; asm volatile("v_cvt_pk_bf16_f32 %0, %1, %2" : "=v"(r) : "v"(lo), "v"(hi)); return r; }
typedef float f32x2 __attribute__((ext_vector_type(2)));

template <class Epi, class Sched, bool ALIGN_EPI = false, bool SP2 = false>
__device__ __forceinline__ void gemm_phase(PG8_LAS unsigned char* lds, const Gemm g, const Sched& S, const Epi& E) {
    const int tid = threadIdx.x, wid = __builtin_amdgcn_readfirstlane(tid >> 6), lane = tid & 63, wr = wid >> 2, wc = wid & 3, fr = lane & 15, fq = lane >> 4;
    const int K = g.K, nt = K / BK;
    unsigned voffA[2], voffB[2];
#pragma unroll
    for (int i = 0; i < 2; ++i) { int R, C; stage_rc(tid * 16 + i * 8192, R, C); const int Rb = Epi::PERM ? ((R & ~31) + perm32(R & 31)) : R;
        voffA[i] = (unsigned)(R * K + C) * 2u; voffB[i] = (unsigned)(Rb * K + C) * 2u; }
    const size_t kstep = (size_t)(BK * 2);
    const size_t hstep = (size_t)HALF * K * 2;
    const size_t tstep = 2 * hstep;
    const unsigned ldsw = (unsigned)wid * 1024u;
    const int aoff = lds_byte(wr * 64 + fr, fq * 8), boff = lds_byte(wc * 32 + fr, fq * 8);
#define PG8_SA(b, h) (((b) * 2 + (h)) * HTB)
#define PG8_SB(b, h) ((4 + (b) * 2 + (h)) * HTB)
#define PG8_STAGE(bufoff, gbase, voff) do { _Pragma("unroll") for (int _i = 0; _i < 2; ++_i) \
        __builtin_amdgcn_global_load_lds((const unsigned*)((const char*)(gbase) + (voff)[_i]), (PG8_LAS unsigned*)(lds + (bufoff) + ldsw + _i * 8192), 16, 0, 0); } while (0)
#define PG8_LDA(dst, b, h) do { _Pragma("unroll") for (int m = 0; m < 4; ++m) _Pragma("unroll") for (int k = 0; k < 2; ++k) dst[m][k] = *(const PG8_LAS bf16x8*)(lds + PG8_SA(b, h) + aoff + m * 2048 + k * 1024); } while (0)
#define PG8_LDB(dst, b, h) do { _Pragma("unroll") for (int n = 0; n < 2; ++n) _Pragma("unroll") for (int k = 0; k < 2; ++k) dst[n][k] = *(const PG8_LAS bf16x8*)(lds + PG8_SB(b, h) + boff + n * 2048 + k * 1024); } while (0)
#define PG8_MMA(ai, bj, At, Bt) do { __builtin_amdgcn_s_setprio(1); _Pragma("unroll") for (int m = 0; m < 4; ++m) _Pragma("unroll") for (int n = 0; n < 2; ++n) _Pragma("unroll") for (int k = 0; k < 2; ++k) \
        acc[ai][bj][m][n] = __builtin_amdgcn_mfma_f32_16x16x32_bf16(Bt[n][k], At[m][k], acc[ai][bj][m][n], 0, 0, 0); __builtin_amdgcn_s_setprio(0); } while (0)
#define PG8_WAIT_V(n) asm volatile("s_waitcnt vmcnt(" #n ")" ::: "memory")
#define PG8_WAIT_L(n) asm volatile("s_waitcnt lgkmcnt(" #n ")" ::: "memory")
#define PG8_BAR __builtin_amdgcn_s_barrier()
#define PG8_SCHED __builtin_amdgcn_sched_barrier(0)
    Unit cur, nxt; int ui = 0;
    if (!S.next(0, cur)) return;
    f32x4 acc[2][2][4][2];
#pragma unroll
    for (int a = 0; a < 2; ++a)
#pragma unroll
        for (int b = 0; b < 2; ++b)
#pragma unroll
            for (int m = 0; m < 4; ++m)
#pragma unroll
                for (int n = 0; n < 2; ++n) acc[a][b][m][n] = (f32x4){0.f, 0.f, 0.f, 0.f};
    bf16x8 At[4][2], B0[2][2], B1[2][2];
    const char* cA = (const char*)g.A + (size_t)cur.pm * tstep; const char* cB = (const char*)g.Bt + (size_t)cur.pn * tstep;
    S.a_ready(cur);
    if constexpr (SP2) {
        PG8_STAGE(PG8_SB(0, 0), cB, voffB); PG8_STAGE(PG8_SB(0, 1), cB + hstep, voffB); PG8_STAGE(PG8_SA(0, 0), cA, voffA); PG8_STAGE(PG8_SA(0, 1), cA + hstep, voffA);
        if (wr == 1) PG8_BAR;
        PG8_WAIT_V(2); PG8_BAR;
        PG8_STAGE(PG8_SB(1, 0), cB + kstep, voffB); PG8_STAGE(PG8_SA(1, 0), cA + kstep, voffA); PG8_STAGE(PG8_SB(1, 1), cB + hstep + kstep, voffB);
        PG8_WAIT_V(6); PG8_BAR;
    } else {
        PG8_STAGE(PG8_SB(0, 0), cB, voffB); PG8_STAGE(PG8_SA(0, 0), cA, voffA); PG8_STAGE(PG8_SB(0, 1), cB + hstep, voffB); PG8_STAGE(PG8_SA(0, 1), cA + hstep, voffA);
        if (wr == 1) PG8_BAR;
        PG8_WAIT_V(4); PG8_BAR;
        PG8_STAGE(PG8_SB(1, 0), cB + kstep, voffB); PG8_STAGE(PG8_SA(1, 0), cA + kstep, voffA); PG8_STAGE(PG8_SB(1, 1), cB + hstep + kstep, voffB);
        PG8_WAIT_V(6); PG8_BAR;
    }
    for (;;) {
        const bool has_next = S.next(ui + 1, nxt);
        const char* nA = has_next ? (const char*)g.A + (size_t)nxt.pm * tstep : cA; const char* nB = has_next ? (const char*)g.Bt + (size_t)nxt.pn * tstep : cB;
        for (int t = 0; t < nt; t += 2) {
            const bool last = (t == nt - 2);
            const char* a1 = cA + (size_t)(t + 1) * kstep;
            const char* a2 = last ? nA : cA + (size_t)(t + 2) * kstep; const char* b2 = last ? nB : cB + (size_t)(t + 2) * kstep;
            const char* a3 = a2 + kstep; const char* b3 = b2 + kstep;
            if (last && has_next) S.a_ready(nxt);
            if constexpr (SP2) {
            PG8_LDB(B0, 0, 0); PG8_LDB(B1, 0, 1); PG8_SCHED; PG8_LDA(At, 0, 0); PG8_STAGE(PG8_SA(1, 1), a1 + hstep, voffA);
            PG8_WAIT_V(8); PG8_WAIT_L(0); PG8_BAR; PG8_MMA(0, 0, At, B0); PG8_MMA(0, 1, At, B1); PG8_BAR; PG8_SCHED;
            PG8_LDA(At, 0, 1); PG8_STAGE(PG8_SB(0, 0), b2, voffB); PG8_STAGE(PG8_SB(0, 1), b2 + hstep, voffB); PG8_STAGE(PG8_SA(0, 0), a2, voffA);
            PG8_WAIT_V(8); PG8_WAIT_L(0); PG8_BAR; PG8_MMA(1, 0, At, B0); PG8_MMA(1, 1, At, B1); PG8_BAR; PG8_SCHED;
            PG8_LDB(B0, 1, 0); PG8_LDB(B1, 1, 1); PG8_SCHED; PG8_LDA(At, 1, 0); PG8_STAGE(PG8_SA(0, 1), a2 + hstep, voffA);
            PG8_WAIT_V(8); PG8_WAIT_L(0); PG8_BAR; PG8_MMA(0, 0, At, B0); PG8_MMA(0, 1, At, B1); PG8_BAR; PG8_SCHED;
            PG8_LDA(At, 1, 1); PG8_STAGE(PG8_SB(1, 0), b3, voffB); PG8_STAGE(PG8_SB(1, 1), b3 + hstep, voffB); PG8_STAGE(PG8_SA(1, 0), a3, voffA);
            PG8_WAIT_V(8); PG8_WAIT_L(0); PG8_BAR; PG8_MMA(1, 0, At, B0); PG8_MMA(1, 1, At, B1); PG8_BAR; PG8_SCHED;
            } else {
            PG8_LDB(B0, 0, 0); PG8_SCHED; PG8_LDA(At, 0, 0); PG8_STAGE(PG8_SA(1, 1), a1 + hstep, voffA);
            PG8_WAIT_L(8); PG8_BAR; PG8_WAIT_L(0); PG8_MMA(0, 0, At, B0); PG8_BAR; PG8_SCHED;
            PG8_LDB(B1, 0, 1); PG8_STAGE(PG8_SB(0, 0), b2, voffB);
            PG8_BAR; PG8_WAIT_L(0); PG8_MMA(0, 1, At, B1); PG8_BAR;
            PG8_LDA(At, 0, 1); PG8_STAGE(PG8_SA(0, 0), a2, voffA);
            PG8_BAR; PG8_WAIT_L(0); PG8_MMA(1, 0, At, B0); PG8_BAR; PG8_SCHED;
            PG8_STAGE(PG8_SB(0, 1), b2 + hstep, voffB);
            PG8_WAIT_V(6); PG8_BAR; PG8_MMA(1, 1, At, B1); PG8_BAR;
            PG8_LDB(B0, 1, 0); PG8_SCHED; PG8_LDA(At, 1, 0); PG8_STAGE(PG8_SA(0, 1), a2 + hstep, voffA);
            PG8_WAIT_L(8); PG8_BAR; PG8_WAIT_L(0); PG8_MMA(0, 0, At, B0); PG8_BAR; PG8_SCHED;
            PG8_LDB(B1, 1, 1); PG8_STAGE(PG8_SB(1, 0), b3, voffB);
            PG8_BAR; PG8_WAIT_L(0); PG8_MMA(0, 1, At, B1); PG8_BAR;
            PG8_LDA(At, 1, 1); PG8_STAGE(PG8_SA(1, 0), a3, voffA);
            PG8_BAR; PG8_WAIT_L(0); PG8_MMA(1, 0, At, B0); PG8_BAR; PG8_SCHED;
            PG8_STAGE(PG8_SB(1, 1), b3 + hstep, voffB);
            PG8_WAIT_V(6); PG8_BAR; PG8_MMA(1, 1, At, B1); PG8_BAR;
            }
        }
        if constexpr (ALIGN_EPI) { if (wr == 0) PG8_BAR; }
        if constexpr (!Epi::AFTER_DRAIN) { E(acc, cur, wr, wc, fr, fq); if constexpr (Epi::DUP) { asm volatile("" ::: "memory"); E(acc, cur, wr, wc, fr, fq); } S.done(cur); }
        if (!has_next) break;
#pragma unroll
        for (int a = 0; a < 2; ++a)
#pragma unroll
            for (int b = 0; b < 2; ++b)
#pragma unroll
                for (int m = 0; m < 4; ++m)
#pragma unroll
                    for (int n = 0; n < 2; ++n) acc[a][b][m][n] = (f32x4){0.f, 0.f, 0.f, 0.f};
        cur = nxt; cA = nA; cB = nB; ++ui;
        if constexpr (ALIGN_EPI) { if (wr == 1) PG8_BAR; }
    }
    PG8_WAIT_V(0);
    if constexpr (!ALIGN_EPI) { if (wr == 0) PG8_BAR; }
    PG8_BAR;
    if constexpr (Epi::AFTER_DRAIN) { E.fused(acc, cur, wr, wc, fr, fq, lds, wid, lane); S.done(cur); }
#undef PG8_SA
#undef PG8_SB
#undef PG8_STAGE
#undef PG8_LDA
#undef PG8_LDB
#undef PG8_MMA
#undef PG8_WAIT_V
#undef PG8_WAIT_L
#undef PG8_BAR
#undef PG8_SCHED
}
}

constexpr int BATCH = 4, SEQ = 4096, DM = 1024, MROWS = BATCH * SEQ;
constexpr int CE = 2048, CN = 4 * CE;
constexpr int NH = 16, HD = 64, NG = 3, QKVC = 9216, AN = 10240;
constexpr float EPS = 1e-6f, LOG2E = 1.4426950408889634f, QSCALE = 0.125f * LOG2E;
constexpr int NPHASE = 23;

constexpr size_t MiB = 1u << 20;
constexpr size_t WS_CTL = 0, CTL_ZERO_BYTES = 1 * MiB;
constexpr size_t WS_SSQ = 1 * MiB;
constexpr size_t WS_W1 = 2 * MiB, WS_W2 = 34 * MiB, WS_W3 = 42 * MiB, WS_W4 = 82 * MiB;
constexpr size_t WS_LSE = 86 * MiB;
constexpr size_t WS_BIAS = 89 * MiB;
constexpr size_t WS_XB = 90 * MiB;
constexpr size_t WS_CV = 122 * MiB, WS_CG = 186 * MiB;
constexpr size_t WS_QO = 122 * MiB;
constexpr size_t WS_K = 218 * MiB, WS_V = 250 * MiB, WS_Y = WS_K;
constexpr size_t WS_END = 282 * MiB;
constexpr int CW_TMO = 0, CW_BAR = 4096;

#define GAS __attribute__((address_space(1)))
#define LAS __attribute__((address_space(3)))
typedef unsigned short bf16;
typedef unsigned v4u __attribute__((ext_vector_type(4)));
typedef unsigned v2u __attribute__((ext_vector_type(2)));
typedef float f32x4 __attribute__((ext_vector_type(4)));
typedef short bf16x8 __attribute__((ext_vector_type(8)));
typedef GAS unsigned gu32;
#define RLX_AGENT __ATOMIC_RELAXED, __HIP_MEMORY_SCOPE_AGENT
#define LDS_WAIT() asm volatile("s_waitcnt lgkmcnt(0)" ::: "memory")
#define VM_WAIT() asm volatile("s_waitcnt vmcnt(0)" ::: "memory")
__device__ __forceinline__ unsigned f2bf(float f) { unsigned u = __builtin_bit_cast(unsigned, f); return (u + 0x7fffu + ((u >> 16) & 1u)) >> 16; }
typedef float f32x2_t __attribute__((ext_vector_type(2))); typedef __bf16 bf16x2_t __attribute__((ext_vector_type(2)));
__device__ __forceinline__ unsigned pk2(float lo, float hi) { f32x2_t v = {lo, hi}; bf16x2_t b = __builtin_convertvector(v, bf16x2_t); return __builtin_bit_cast(unsigned, b); }
__device__ __forceinline__ float bf2f(unsigned h) { return __builtin_bit_cast(float, h << 16); }
__device__ __forceinline__ float bflo(unsigned w) { return __builtin_bit_cast(float, w << 16); }
__device__ __forceinline__ float bfhi(unsigned w) { return __builtin_bit_cast(float, w & 0xffff0000u); }
__device__ __forceinline__ float sigmoidf_(float z) { return __builtin_amdgcn_rcpf(1.0f + __builtin_amdgcn_exp2f(-z * LOG2E)); }
__device__ __forceinline__ float row_rs(const float* ssq, int row) {
    const f32x4* p = (const f32x4*)(ssq + (size_t)row * 16);
    const f32x4 s = (p[0] + p[1]) + (p[2] + p[3]);
    return 1.0f / sqrtf(((s.x + s.y) + (s.z + s.w)) * (1.0f / DM) + EPS);
}
__device__ __forceinline__ float wave_sum(float v) {
#pragma unroll
    for (int o = 1; o < 64; o <<= 1) v += __shfl_xor(v, o);
    return v;
}
__device__ __forceinline__ int t5_bucket(int d) {
    if (d < 16) return d;
    int b = 15;
    b += (d >= 16); b += (d >= 22); b += (d >= 30); b += (d >= 40); b += (d >= 54); b += (d >= 73); b += (d >= 99); b += (d >= 134);
    b += (d >= 182); b += (d >= 246); b += (d >= 332); b += (d >= 450); b += (d >= 609); b += (d >= 825); b += (d >= 1117); b += (d >= 1513);
    return b;
}

#define XB_TMO      128
#define XB_XCNT(j)  (256  + 64 * (j))
#define XB_XSUB(j)  (1280 + 64 * (j))
#define XB_XGEN(j)  (2304 + 64 * (j))
#define XB_TOP      3328
#define XB_TOPGEN   3392
#define XCD_BAR_WORDS 3456
#define XB_SPIN_CAP (1u << 18)

__device__ __forceinline__ unsigned xb_ld(unsigned* p)              { return __hip_atomic_load(p, __ATOMIC_RELAXED, __HIP_MEMORY_SCOPE_AGENT); }
__device__ __forceinline__ unsigned xb_add(unsigned* p, unsigned v) { return __hip_atomic_fetch_add(p, v, __ATOMIC_RELAXED, __HIP_MEMORY_SCOPE_AGENT); }
__device__ __forceinline__ unsigned xb_xcc_id() { return (unsigned)__builtin_amdgcn_s_getreg((3 << 11) | 20) & 0xFu; }
#define XB_SPIN(cond, bar) do { unsigned _sp = 0; while (cond) { __builtin_amdgcn_s_sleep(1); \
    if ((++_sp & 255u) == 0u) { if (xb_ld(&(bar)[XB_TMO])) break; if (_sp > XB_SPIN_CAP) { atomicAdd(&(bar)[XB_TMO], 1u); break; } } } } while (0)

struct XcdBarrier {
    unsigned* bar; unsigned x;
    volatile LAS unsigned* st;
};

__device__ __forceinline__ XcdBarrier xcd_barrier_post(unsigned* bar, volatile LAS unsigned* st) {
    XcdBarrier b; b.bar = bar; b.x = xb_xcc_id(); b.st = st;
    if (threadIdx.x == 0) (void)xb_add(&bar[XB_XCNT(b.x)], 1u);
    return b;
}
__device__ __forceinline__ void xcd_barrier_complete(unsigned* bar, unsigned x, unsigned& nloc, unsigned& nx) {
    const unsigned G = gridDim.x * gridDim.y * gridDim.z;
    unsigned sum, cnt, mine, sp = 0u;
    for (;;) {
        sum = 0u; cnt = 0u; mine = 0u;
#pragma unroll
        for (unsigned j = 0; j < 16; ++j) { const unsigned c = xb_ld(&bar[XB_XCNT(j)]); sum += c; cnt += (c > 0u) ? 1u : 0u; mine = (j == x) ? c : mine; }
        if (sum == G) break;
        __builtin_amdgcn_s_sleep(1);
        if ((++sp & 255u) == 0u) { if (xb_ld(&bar[XB_TMO])) break; if (sp > XB_SPIN_CAP) { atomicAdd(&bar[XB_TMO], 1u); break; } }
    }
    nloc = mine > 0u ? mine : 1u; nx = cnt > 0u ? cnt : 1u;
}

__device__ __forceinline__ void xcd_barrier(const XcdBarrier& b) {
    asm volatile("s_waitcnt vmcnt(0)" ::: "memory");
    __syncthreads();
    if (threadIdx.x == 0) {
        unsigned* bar = b.bar;
        __builtin_amdgcn_s_waitcnt(0);
        unsigned nloc = b.st[0], nx = b.st[1];
        if (nloc == 0u) { xcd_barrier_complete(bar, b.x, nloc, nx); b.st[0] = nloc; b.st[1] = nx; }
        const unsigned old = xb_add(&bar[XB_XSUB(b.x)], 1u);
        const unsigned gen = old / nloc;
        if (old + 1u == (gen + 1u) * nloc) {
            __builtin_amdgcn_fence(__ATOMIC_RELEASE, "agent");
            asm volatile("s_waitcnt vmcnt(0)" ::: "memory");
            const unsigned og = xb_add(&bar[XB_TOP], 1u);
            const unsigned tg = og / nx;
            if (og + 1u == (tg + 1u) * nx) xb_add(&bar[XB_TOPGEN], 1u);
            else XB_SPIN(xb_ld(&bar[XB_TOPGEN]) == tg, bar);
            __builtin_amdgcn_fence(__ATOMIC_ACQUIRE, "agent");
            xb_add(&bar[XB_XGEN(b.x)], 1u);
            asm volatile("s_waitcnt vmcnt(0)" ::: "memory");
        } else {
            XB_SPIN(xb_ld(&bar[XB_XGEN(b.x)]) == gen, bar);
            __builtin_amdgcn_fence(__ATOMIC_ACQUIRE, "agent");
            asm volatile("s_waitcnt vmcnt(0)" ::: "memory");
        }
    }
    __syncthreads();
}

#ifndef DUP_EPI
#define DUP_EPI 0
#endif
namespace epi {
using pg8::Unit; using pg8::bf16_t;

__device__ __forceinline__ void rows_rs(const float* ssq, int row0  , int fq, float (&rs)[2][4]) {
    f32x4 pp[2][4];
#pragma unroll
    for (int ai = 0; ai < 2; ++ai)
#pragma unroll
        for (int m = 0; m < 4; ++m) pp[ai][m] = *(const f32x4*)(ssq + (size_t)(row0 + ai * 128 + m * 16) * 16 + 4 * fq);
#pragma unroll
    for (int ai = 0; ai < 2; ++ai)
#pragma unroll
        for (int m = 0; m < 4; ++m) { float t = (pp[ai][m][0] + pp[ai][m][1]) + (pp[ai][m][2] + pp[ai][m][3]); t += __shfl_xor(t, 16); t += __shfl_xor(t, 32); rs[ai][m] = __builtin_amdgcn_rsqf(t * (1.0f / DM) + EPS); }
}
struct ConvIn {
    static constexpr bool PERM = false, AFTER_DRAIN = false, DUP = (DUP_EPI != 0);
    const float* ssq; bf16_t* V; bf16_t* G;
    __device__ __forceinline__ void operator()(const f32x4 (&acc)[2][2][4][2], const Unit& u, int wr, int wc, int fr, int fq) const {
        const int ch0 = u.pn * 64 + wc * 16 + 4 * fq;
        float rsv[2][4]; rows_rs(ssq, u.pm * 256 + wr * 64 + fr, fq, rsv);
#pragma unroll
        for (int ai = 0; ai < 2; ++ai)
#pragma unroll
            for (int m = 0; m < 4; ++m) {
                const int row = u.pm * 256 + ai * 128 + wr * 64 + m * 16 + fr;
                const float rs = rsv[ai][m];
                const f32x4 b = acc[ai][0][m][0] * rs, c = acc[ai][0][m][1] * rs, uu = acc[ai][1][m][0] * rs, z = acc[ai][1][m][1] * rs;
                const f32x4 v = c * uu;
                f32x4 g;
#pragma unroll
                for (int i = 0; i < 4; ++i) g[i] = b[i] * z[i] * sigmoidf_(z[i]);
                v2u wv, wg; wv.x = pk2(v[0], v[1]); wv.y = pk2(v[2], v[3]); wg.x = pk2(g[0], g[1]); wg.y = pk2(g[2], g[3]);
                *(v2u*)(V + (size_t)row * CE + ch0) = wv;
                *(v2u*)(G + (size_t)row * CE + ch0) = wg;
            }
    }
};
struct Resid {
    static constexpr bool PERM = false, AFTER_DRAIN = false, DUP = false;
    const float* xin; float* xout; bf16_t* xb; float* ssq;
    __device__ __forceinline__ void operator()(const f32x4 (&acc)[2][2][4][2], const Unit& u, int wr, int wc, int fr, int fq) const {
        const int col0 = u.pn * 256 + wc * 32 + 4 * fq;
        const size_t off0 = (size_t)(u.pm * 256 + wr * 64 + fr) * DM + col0;
        f32x4 pre[4][2][2];
#pragma unroll
        for (int i = 0; i < 4; ++i)
#pragma unroll
            for (int bj = 0; bj < 2; ++bj)
#pragma unroll
                for (int n = 0; n < 2; ++n) pre[i][bj][n] = *(const f32x4*)(xin + off0 + (size_t)(16 * i) * DM + bj * 128 + n * 16);
#pragma unroll
        for (int i = 0; i < 8; ++i) {
            const int ai = i >> 2, m = i & 3;
            const size_t off = off0 + (size_t)(ai * 128 + m * 16) * DM;
            float ss = 0.f; f32x4 xn[2][2];
#pragma unroll
            for (int bj = 0; bj < 2; ++bj)
#pragma unroll
                for (int n = 0; n < 2; ++n) { xn[bj][n] = pre[i & 3][bj][n] + acc[ai][bj][m][n]; const f32x4 t = xn[bj][n]; ss += (t[0] * t[0] + t[1] * t[1]) + (t[2] * t[2] + t[3] * t[3]); }
            if (i < 4) {
#pragma unroll
                for (int bj = 0; bj < 2; ++bj)
#pragma unroll
                    for (int n = 0; n < 2; ++n) pre[i & 3][bj][n] = *(const f32x4*)(xin + off + (size_t)128 * DM + bj * 128 + n * 16);
            }
#pragma unroll
            for (int bj = 0; bj < 2; ++bj)
#pragma unroll
                for (int n = 0; n < 2; ++n) {
                    *(f32x4*)(xout + off + bj * 128 + n * 16) = xn[bj][n];
                    v2u w; w.x = pk2(xn[bj][n][0], xn[bj][n][1]); w.y = pk2(xn[bj][n][2], xn[bj][n][3]);
                    *(v2u*)(xb + off + bj * 128 + n * 16) = w;
                }
            ss += __shfl_xor(ss, 16); ss += __shfl_xor(ss, 32);
            if (fq == 0) ssq[(size_t)(u.pm * 256 + ai * 128 + wr * 64 + m * 16 + fr) * 16 + u.pn * 4 + wc] = ss;
        }
    }
};
struct QKV {
    static constexpr bool PERM = true, AFTER_DRAIN = false, DUP = (DUP_EPI != 0);
    const float* ssq; bf16_t* Q; bf16_t* K; bf16_t* Vv; const float* qg; const float* kg;
    __device__ __forceinline__ void operator()(const f32x4 (&acc)[2][2][4][2], const Unit& u, int wr, int wc, int fr, int fq) const {
        const int which = u.pn >> 2, h = (u.pn & 3) * 4 + wc;
        bf16_t* base = Q + (ptrdiff_t)(which == 1) * (K - Q) + (ptrdiff_t)(which == 2) * (Vv - Q);
        const float* gp = qg + (ptrdiff_t)(which == 1) * (kg - qg); const float gsc = which == 0 ? QSCALE : 1.0f; const bool nrm = which < 2;
        const f32x4 g00 = *(const f32x4*)(gp + 8 * fq), g01 = *(const f32x4*)(gp + 8 * fq + 4), g10 = *(const f32x4*)(gp + 32 + 8 * fq), g11 = *(const f32x4*)(gp + 32 + 8 * fq + 4);
        float rsv[2][4]; rows_rs(ssq, u.pm * 256 + wr * 64 + fr, fq, rsv);
#pragma unroll
        for (int ai = 0; ai < 2; ++ai)
#pragma unroll
            for (int m = 0; m < 4; ++m) {
                const int row = u.pm * 256 + ai * 128 + wr * 64 + m * 16 + fr;
                const float rs = rsv[ai][m];
                f32x4 v[2][2]; float ss = 0.f;
#pragma unroll
                for (int bj = 0; bj < 2; ++bj)
#pragma unroll
                    for (int n = 0; n < 2; ++n) { v[bj][n] = acc[ai][bj][m][n] * rs; const f32x4 t = v[bj][n]; ss += (t[0] * t[0] + t[1] * t[1]) + (t[2] * t[2] + t[3] * t[3]); }
                ss += __shfl_xor(ss, 16); ss += __shfl_xor(ss, 32);
                const float rn = gsc * __builtin_amdgcn_rsqf(ss * (1.0f / HD) + EPS);
#pragma unroll
                for (int bj = 0; bj < 2; ++bj) {
                    f32x4 a = v[bj][0], b = v[bj][1];
                    if (nrm) { a = a * (bj == 0 ? g00 : g10) * rn; b = b * (bj == 0 ? g01 : g11) * rn; }
                    v4u w; w.x = pk2(a[0], a[1]); w.y = pk2(a[2], a[3]); w.z = pk2(b[0], b[1]); w.w = pk2(b[2], b[3]);
                    *(v4u*)(base + (size_t)row * DM + h * HD + 32 * bj + 8 * fq) = w;
                }
            }
    }
};
struct ZMerge {
    static constexpr bool PERM = true, AFTER_DRAIN = false, DUP = false;
    const float* ssq; const bf16_t* O0; const bf16_t* O1; const bf16_t* O2; const float* lse; bf16_t* Y;
    struct RowIn { v4u a[2], b[2], c[2]; f32x4 sq; float l0, l1, l2; };
    __device__ __forceinline__ void load_row(RowIn& r, int row, int h, int fq) const {
        const size_t off = (size_t)row * DM + h * HD + 8 * fq;
        r.sq = *(const f32x4*)(ssq + (size_t)row * 16 + 4 * fq);
        r.l0 = lse[((size_t)0 * MROWS + row) * 16 + h]; r.l1 = lse[((size_t)1 * MROWS + row) * 16 + h]; r.l2 = lse[((size_t)2 * MROWS + row) * 16 + h];
#pragma unroll
        for (int bj = 0; bj < 2; ++bj) { r.a[bj] = *(const v4u*)(O0 + off + 32 * bj); r.b[bj] = *(const v4u*)(O1 + off + 32 * bj); r.c[bj] = *(const v4u*)(O2 + off + 32 * bj); }
    }
    __device__ __forceinline__ void operator()(const f32x4 (&acc)[2][2][4][2], const Unit& u, int wr, int wc, int fr, int fq) const {
        const int h = u.pn * 4 + wc, row0 = u.pm * 256 + wr * 64 + fr;
        RowIn in[2];
        load_row(in[0], row0, h, fq);
#pragma unroll
        for (int i = 0; i < 8; ++i) {
            const int ai = i >> 2, m = i & 3, row = row0 + ai * 128 + m * 16;
            if (i + 1 < 8) load_row(in[(i + 1) & 1], row0 + ((i + 1) >> 2) * 128 + ((i + 1) & 3) * 16, h, fq);
            const RowIn& r = in[i & 1];
            float tq = (r.sq[0] + r.sq[1]) + (r.sq[2] + r.sq[3]); tq += __shfl_xor(tq, 16); tq += __shfl_xor(tq, 32);
            const float rs = __builtin_amdgcn_rsqf(tq * (1.0f / DM) + EPS);
            const float mx = fmaxf(r.l0, fmaxf(r.l1, r.l2));
            float w0 = __builtin_amdgcn_exp2f(r.l0 - mx), w1 = __builtin_amdgcn_exp2f(r.l1 - mx), w2 = __builtin_amdgcn_exp2f(r.l2 - mx);
            const float inv = __builtin_amdgcn_rcpf(w0 + w1 + w2); w0 *= inv; w1 *= inv; w2 *= inv;
#pragma unroll
            for (int bj = 0; bj < 2; ++bj) {
                const v4u a = r.a[bj], b = r.b[bj], c = r.c[bj];
                float o[8];
#pragma unroll
                for (int k = 0; k < 4; ++k) { o[2 * k] = w0 * bflo(a[k]) + w1 * bflo(b[k]) + w2 * bflo(c[k]); o[2 * k + 1] = w0 * bfhi(a[k]) + w1 * bfhi(b[k]) + w2 * bfhi(c[k]); }
                const f32x4 z0 = acc[ai][bj][m][0] * rs, z1 = acc[ai][bj][m][1] * rs;
                float y[8];
#pragma unroll
                for (int k = 0; k < 4; ++k) { y[k] = o[k] * z0[k] * sigmoidf_(z0[k]); y[4 + k] = o[4 + k] * z1[k] * sigmoidf_(z1[k]); }
                v4u w; w.x = pk2(y[0], y[1]); w.y = pk2(y[2], y[3]); w.z = pk2(y[4], y[5]); w.w = pk2(y[6], y[7]);
                *(v4u*)(Y + (size_t)row * DM + h * HD + 32 * bj + 8 * fq) = w;
            }
        }
    }
};
}

namespace naive {
template <class AL, class BL, class EP>
__device__ __forceinline__ void gemm_tile(LAS float* sm, int K, int row0, const AL& al, const BL& bl, const EP& ep) {
    const int tid = threadIdx.x, tx = tid & 15, ty = tid >> 4;
    LAS float* sA = sm; LAS float* sB = sm + 16 * 132;
    float acc[4][4];
#pragma unroll
    for (int i = 0; i < 4; ++i)
#pragma unroll
        for (int j = 0; j < 4; ++j) acc[i][j] = 0.f;
    for (int k0 = 0; k0 < K; k0 += 16) {
#pragma unroll
        for (int i = 0; i < 4; ++i) { const int idx = tid + 512 * i, r = idx >> 4, kk = idx & 15; sA[kk * 132 + r] = al(row0 + r, k0 + kk); }
#pragma unroll
        for (int i = 0; i < 2; ++i) { const int idx = tid + 512 * i, kk = idx >> 6, c = idx & 63; sB[kk * 68 + c] = bl(k0 + kk, c); }
        __syncthreads();
#pragma unroll
        for (int kk = 0; kk < 16; ++kk) {
            float a[4], b[4];
#pragma unroll
            for (int i = 0; i < 4; ++i) a[i] = sA[kk * 132 + ty * 4 + i];
#pragma unroll
            for (int j = 0; j < 4; ++j) b[j] = sB[kk * 68 + tx + 16 * j];
#pragma unroll
            for (int i = 0; i < 4; ++i)
#pragma unroll
                for (int j = 0; j < 4; ++j) acc[i][j] = fmaf(a[i], b[j], acc[i][j]);
        }
        __syncthreads();
    }
#pragma unroll
    for (int i = 0; i < 4; ++i) ep(row0 + ty * 4 + i, tx, acc[i][0], acc[i][1], acc[i][2], acc[i][3]);
}
struct ALbf { const bf16* A; int ld; __device__ __forceinline__ float operator()(int r, int k) const { return bf2f(A[(size_t)r * ld + k]); } };
__device__ __forceinline__ float red16(float v) { v += __shfl_xor(v, 1); v += __shfl_xor(v, 2); v += __shfl_xor(v, 4); v += __shfl_xor(v, 8); return v; }

struct BLc1 { const float* w; const float* nrm; int ct; __device__ __forceinline__ float operator()(int k, int c) const { return w[(size_t)k * CN + (c >> 4) * CE + ct * 16 + (c & 15)] * nrm[k]; } };
struct EPc1 { const float* ssq; bf16* V; bf16* G; int ct;
    __device__ __forceinline__ void operator()(int row, int tx, float a0, float a1, float a2, float a3) const {
        const float rs = row_rs(ssq, row); const float b = a0 * rs, c = a1 * rs, u = a2 * rs, z = a3 * rs;
        const int e = ct * 16 + tx; V[(size_t)row * CE + e] = (bf16)f2bf(c * u); G[(size_t)row * CE + e] = (bf16)f2bf(b * z * sigmoidf_(z)); } };
__device__ __forceinline__ void c1(LAS float* sm, const bf16* xb, const float* ssq, const float* w, const float* nrm, bf16* V, bf16* G, int bid, int nb) {
    const int nct = CE / 16, ntile = (MROWS / 128) * nct;
    for (int t = bid; t < ntile; t += nb) { const int rt = t / nct, ct = t % nct; gemm_tile(sm, DM, rt * 128, ALbf{xb, DM}, BLc1{w, nrm, ct}, EPc1{ssq, V, G, ct}); }
}
struct BLres { const float* w; int ct; __device__ __forceinline__ float operator()(int k, int c) const { return w[(size_t)k * DM + ct * 64 + c]; } };
struct EPres { const float* xin; float* xout; bf16* xb; float* ssq; int ct;
    __device__ __forceinline__ void operator()(int row, int tx, float a0, float a1, float a2, float a3) const {
        const size_t o = (size_t)row * DM + ct * 64 + tx;
        const float x0 = xin[o] + a0, x1 = xin[o + 16] + a1, x2 = xin[o + 32] + a2, x3 = xin[o + 48] + a3;
        xout[o] = x0; xout[o + 16] = x1; xout[o + 32] = x2; xout[o + 48] = x3;
        xb[o] = (bf16)f2bf(x0); xb[o + 16] = (bf16)f2bf(x1); xb[o + 32] = (bf16)f2bf(x2); xb[o + 48] = (bf16)f2bf(x3);
        const float ss = red16((x0 * x0 + x1 * x1) + (x2 * x2 + x3 * x3));
        if (tx == 0) ssq[(size_t)row * 16 + ct] = ss; } };
__device__ __forceinline__ void resid(LAS float* sm, const bf16* A, int K, const float* w, const float* xin, float* xout, bf16* xb, float* ssq, int bid, int nb) {
    const int ntile = (MROWS / 128) * 16;
    for (int t = bid; t < ntile; t += nb) { const int rt = t / 16, ct = t % 16; gemm_tile(sm, K, rt * 128, ALbf{A, K}, BLres{w, ct}, EPres{xin, xout, xb, ssq, ct}); }
}
struct BLa1 { const float* w; const float* nrm; int col0; __device__ __forceinline__ float operator()(int k, int c) const { return w[(size_t)k * AN + col0 + c] * nrm[k]; } };
struct EPa1 { const float* ssq; bf16* dst; const float* gain; float sc; int h;
    __device__ __forceinline__ void operator()(int row, int tx, float a0, float a1, float a2, float a3) const {
        const float rs = row_rs(ssq, row); float v0 = a0 * rs, v1 = a1 * rs, v2 = a2 * rs, v3 = a3 * rs;
        const float ss = red16((v0 * v0 + v1 * v1) + (v2 * v2 + v3 * v3));
        if (gain) { const float rn = sc / sqrtf(ss * (1.0f / HD) + EPS); v0 *= rn * gain[tx]; v1 *= rn * gain[tx + 16]; v2 *= rn * gain[tx + 32]; v3 *= rn * gain[tx + 48]; }
        const size_t o = (size_t)row * DM + h * HD + tx;
        dst[o] = (bf16)f2bf(v0); dst[o + 16] = (bf16)f2bf(v1); dst[o + 32] = (bf16)f2bf(v2); dst[o + 48] = (bf16)f2bf(v3); } };
__device__ __forceinline__ void a1(LAS float* sm, const bf16* xb, const float* ssq, const float* w, const float* nrm, int g, const float* qg, const float* kg, bf16* Q, bf16* K, bf16* V, int bid, int nb) {
    const int ntile = (MROWS / 128) * 48;
    for (int t = bid; t < ntile; t += nb) { const int rt = t / 48, ct = t % 48, which = ct / 16, h = ct % 16;
        gemm_tile(sm, DM, rt * 128, ALbf{xb, DM}, BLa1{w, nrm, g * 3072 + which * 1024 + h * 64},
                  EPa1{ssq, which == 0 ? Q : (which == 1 ? K : V), which == 0 ? qg : (which == 1 ? kg : nullptr), which == 0 ? QSCALE : 1.0f, h}); }
}
struct EPa3 { const float* ssq; const bf16* O0; const bf16* O1; const bf16* O2; const float* lse; bf16* Y; int h;
    __device__ __forceinline__ void operator()(int row, int tx, float a0, float a1, float a2, float a3) const {
        const float rs = row_rs(ssq, row);
        const float l0 = lse[((size_t)0 * MROWS + row) * 16 + h], l1 = lse[((size_t)1 * MROWS + row) * 16 + h], l2 = lse[((size_t)2 * MROWS + row) * 16 + h];
        const float mx = fmaxf(l0, fmaxf(l1, l2)); float w0 = exp2f(l0 - mx), w1 = exp2f(l1 - mx), w2 = exp2f(l2 - mx); const float inv = 1.0f / (w0 + w1 + w2); w0 *= inv; w1 *= inv; w2 *= inv;
        const float zz[4] = {a0 * rs, a1 * rs, a2 * rs, a3 * rs};
#pragma unroll
        for (int j = 0; j < 4; ++j) { const size_t o = (size_t)row * DM + h * HD + tx + 16 * j;
            const float ov = w0 * bf2f(O0[o]) + w1 * bf2f(O1[o]) + w2 * bf2f(O2[o]); Y[o] = (bf16)f2bf(ov * zz[j] * sigmoidf_(zz[j])); } } };
__device__ __forceinline__ void a3(LAS float* sm, const bf16* xb, const float* ssq, const float* w, const float* nrm, const bf16* O0, const bf16* O1, const bf16* O2, const float* lse, bf16* Y, int bid, int nb) {
    const int ntile = (MROWS / 128) * 16;
    for (int t = bid; t < ntile; t += nb) { const int rt = t / 16, h = t % 16; gemm_tile(sm, DM, rt * 128, ALbf{xb, DM}, BLa1{w, nrm, QKVC + h * 64}, EPa3{ssq, O0, O1, O2, lse, Y, h}); }
}
__device__ __forceinline__ void a2(bf16* QO, const bf16* K, const bf16* V, const float* biasT  , float* lse  , int dil, int gtid, int gthreads) {
    for (int idx = gtid; idx < MROWS * NH; idx += gthreads) {
        const int row = idx >> 4, h = idx & 15, t = row & (SEQ - 1);
        bf16* qp = QO + (size_t)row * DM + h * HD;
        float q[64], o[64];
#pragma unroll
        for (int c = 0; c < 8; ++c) { const v4u w = *(const v4u*)(qp + 8 * c);
#pragma unroll
            for (int i = 0; i < 4; ++i) { q[8 * c + 2 * i] = bflo(w[i]); q[8 * c + 2 * i + 1] = bfhi(w[i]); } }
#pragma unroll
        for (int d = 0; d < 64; ++d) o[d] = 0.f;
        float m = -INFINITY, l = 0.f;
        for (int j = 0; j <= 128; ++j) {
            const int tk = t - dil * j; if (tk < 0) break;
            const size_t ko = (size_t)(row - dil * j) * DM + h * HD;
            float s = 0.f;
#pragma unroll
            for (int c = 0; c < 8; ++c) { const v4u w = *(const v4u*)(K + ko + 8 * c);
#pragma unroll
                for (int i = 0; i < 4; ++i) { s = fmaf(q[8 * c + 2 * i], bflo(w[i]), s); s = fmaf(q[8 * c + 2 * i + 1], bfhi(w[i]), s); } }
            s += biasT[h * 132 + j];
            const float mn = fmaxf(m, s), f = exp2f(m - mn), p = exp2f(s - mn);
            l = l * f + p; m = mn;
#pragma unroll
            for (int c = 0; c < 8; ++c) { const v4u w = *(const v4u*)(V + ko + 8 * c);
#pragma unroll
                for (int i = 0; i < 4; ++i) { o[8 * c + 2 * i] = o[8 * c + 2 * i] * f + p * bflo(w[i]); o[8 * c + 2 * i + 1] = o[8 * c + 2 * i + 1] * f + p * bfhi(w[i]); } }
        }
        const float il = 1.0f / l;
#pragma unroll
        for (int c = 0; c < 8; ++c) { v4u w;
#pragma unroll
            for (int i = 0; i < 4; ++i) w[i] = pk2(o[8 * c + 2 * i] * il, o[8 * c + 2 * i + 1] * il);
            *(v4u*)(qp + 8 * c) = w; }
        lse[(size_t)row * 16 + h] = m + log2f(l);
    }
}
}

template <int MODE> __device__ __forceinline__ int wt_dest_row(int n) {
    if (MODE == 1) { const int type = n >> 11, e = n & 2047, pn = e >> 6, el = e & 63; return 256 * pn + 128 * (type >> 1) + 32 * (el >> 4) + 16 * (type & 1) + (el & 15); }
    if (MODE == 3) { const int blk = n >> 10, r = n & 1023, h = r >> 6, d = r & 63; return blk * 1024 + 256 * (h >> 2) + 128 * (d >> 5) + 32 * (h & 3) + (d & 31); }
    return n;
}
template <int MODE> __device__ __forceinline__ void p0_transpose_item(const float* W, int K, int N, const float* scale, bf16* WT, LAS float* scr  , int item, int lane) {
    const int nblk = N / 64, kb = item / nblk, nb = item % nblk, k0 = 64 * kb, n0 = 64 * nb;
    const int kr = lane >> 4, c4 = lane & 15;
    f32x4 v[16];
#pragma unroll
    for (int i = 0; i < 16; ++i) v[i] = *(const GAS f32x4*)(W + (size_t)(k0 + 4 * i + kr) * N + n0 + 4 * c4);
#pragma unroll
    for (int i = 0; i < 16; ++i) { const float s = scale ? scale[k0 + 4 * i + kr] : 1.0f; LAS float* d = scr + (4 * i + kr) * 65 + 4 * c4;
        d[0] = v[i][0] * s; d[1] = v[i][1] * s; d[2] = v[i][2] * s; d[3] = v[i][3] * s; }
    LDS_WAIT(); asm volatile("" ::: "memory");
    const int c = lane & 7, nl = lane >> 3;
#pragma unroll
    for (int j = 0; j < 8; ++j) { const int n = nl + 8 * j; const LAS float* s = scr + (8 * c) * 65 + n;
        v4u o; o.x = pk2(s[0 * 65], s[1 * 65]); o.y = pk2(s[2 * 65], s[3 * 65]); o.z = pk2(s[4 * 65], s[5 * 65]); o.w = pk2(s[6 * 65], s[7 * 65]);
        *(GAS v4u*)(WT + (size_t)wt_dest_row<MODE>(n0 + n) * K + k0 + 8 * c) = o; }
    LDS_WAIT(); asm volatile("" ::: "memory");
}
struct Ptrs {
    const float *x, *conv_norm, *conv_w_in, *conv_w, *conv_w_out, *attn_norm, *attn_w_in, *q_gain, *k_gain, *attn_w_out, *rel_bias;
    float* out; unsigned char* ws;
};
__device__ __forceinline__ void p0_prologue(const Ptrs& P, LAS unsigned char* lds, int vcu, int G, int wave, int lane, int tid) {
    LAS float* scr = (LAS float*)(lds + wave * 16640);
    const int gw = vcu * 8 + wave, NGW = G * 8;
    bf16* W1 = (bf16*)(P.ws + WS_W1); bf16* W2 = (bf16*)(P.ws + WS_W2); bf16* W3 = (bf16*)(P.ws + WS_W3); bf16* W4 = (bf16*)(P.ws + WS_W4);
    constexpr int I1 = (DM / 64) * (CN / 64), I2 = (CE / 64) * (DM / 64), I3 = (DM / 64) * (AN / 64), I4 = (DM / 64) * (DM / 64), IL = I1 + I2 + I3 + I4;
    for (int it = gw; it < 2 * IL; it += NGW) {
        const int j = it / IL; int r = it % IL;
        if (r < I1) { p0_transpose_item<1>(P.conv_w_in + (size_t)j * DM * CN, DM, CN, P.conv_norm + j * DM, W1 + (size_t)j * CN * DM, scr, r, lane); continue; } r -= I1;
        if (r < I2) { p0_transpose_item<0>(P.conv_w_out + (size_t)j * CE * DM, CE, DM, nullptr, W2 + (size_t)j * DM * CE, scr, r, lane); continue; } r -= I2;
        if (r < I3) { p0_transpose_item<3>(P.attn_w_in + (size_t)j * DM * AN, DM, AN, P.attn_norm + j * DM, W3 + (size_t)j * AN * DM, scr, r, lane); continue; } r -= I3;
        p0_transpose_item<0>(P.attn_w_out + (size_t)j * DM * DM, DM, DM, nullptr, W4 + (size_t)j * DM * DM, scr, r, lane);
    }
    bf16* XB = (bf16*)(P.ws + WS_XB); float* SSQ = (float*)(P.ws + WS_SSQ);
    for (int m = 2 * gw; m < MROWS; m += 2 * NGW) {
        const GAS f32x4* xr = (const GAS f32x4*)(P.x + (size_t)m * DM) + lane;
        GAS v2u* o8 = (GAS v2u*)(XB + (size_t)m * DM) + lane;
        f32x4 v[8];
#pragma unroll
        for (int jj = 0; jj < 8; ++jj) v[jj] = xr[64 * jj];
        float s0 = 0.f, s1 = 0.f;
#pragma unroll
        for (int jj = 0; jj < 8; ++jj) { const f32x4 t = v[jj]; const float q = (t.x * t.x + t.y * t.y) + (t.z * t.z + t.w * t.w); if (jj < 4) s0 += q; else s1 += q;
            v2u w; w.x = pk2(t.x, t.y); w.y = pk2(t.z, t.w); o8[64 * jj] = w; }
        s0 = wave_sum(s0); s1 = wave_sum(s1);
        if (lane < 32) SSQ[(size_t)m * 16 + lane] = lane == 0 ? s0 : (lane == 16 ? s1 : 0.f);
    }
    float* BT = (float*)(P.ws + WS_BIAS);
    for (int i = vcu * 512 + tid; i < NG * NH * 132; i += G * 512) {
        const int g = i / (NH * 132), r = i % (NH * 132), h = r / 132, st = r % 132;
        const int dil = g == 0 ? 1 : (g == 1 ? 4 : 16);
        BT[i] = st <= 128 ? P.rel_bias[t5_bucket(st * dil) * (NG * NH) + g * NH + h] * LOG2E : 0.f;
    }
}
template <bool WRAP> __device__ __forceinline__ void conv_pass(const bf16* V, const bf16* GY, bf16* OUT, const float* cw  , int gtid, int gthreads) {
    for (int idx = gtid; idx < MROWS * (CE / 8); idx += gthreads) {
        const int row = idx / (CE / 8), e0 = (idx % (CE / 8)) * 8, t = row & (SEQ - 1);
        const size_t o = (size_t)row * CE + e0;
        const v4u g = *(const v4u*)(GY + o), v2 = *(const v4u*)(V + o);
        v4u v1 = (v4u){0u, 0u, 0u, 0u}, v0 = (v4u){0u, 0u, 0u, 0u};
        if (t >= 1) v1 = *(const v4u*)(V + o - CE);
        if (t >= 2) v0 = *(const v4u*)(V + o - 2 * CE);
        float w0[8], w1[8], w2[8];
#pragma unroll
        for (int c = 0; c < 2; ++c) { const f32x4 a = *(const f32x4*)(cw + e0 + 4 * c), b = *(const f32x4*)(cw + CE + e0 + 4 * c), d = *(const f32x4*)(cw + 2 * CE + e0 + 4 * c);
#pragma unroll
            for (int i = 0; i < 4; ++i) { w0[4 * c + i] = a[i]; w1[4 * c + i] = b[i]; w2[4 * c + i] = d[i]; } }
        float y[8];
#pragma unroll
        for (int i = 0; i < 4; ++i) {
            y[2 * i] = bflo(g[i]) * (w0[2 * i] * bflo(v0[i]) + w1[2 * i] * bflo(v1[i]) + w2[2 * i] * bflo(v2[i]));
            y[2 * i + 1] = bfhi(g[i]) * (w0[2 * i + 1] * bfhi(v0[i]) + w1[2 * i + 1] * bfhi(v1[i]) + w2[2 * i + 1] * bfhi(v2[i]));
        }
        v4u w; w.x = pk2(y[0], y[1]); w.y = pk2(y[2], y[3]); w.z = pk2(y[4], y[5]); w.w = pk2(y[6], y[7]);
        *(v4u*)(OUT + (WRAP ? (o & (size_t)(16 * 1024 * 1024 - 1)) : o)) = w;
    }
}

namespace attn {
typedef float f32x16 __attribute__((ext_vector_type(16)));
typedef short s16x4 __attribute__((ext_vector_type(4)));
typedef short v4i16_t __attribute__((ext_vector_type(4)));
constexpr int L_K = 0, L_V = 49152, L_B = 98304, L_O = 118784, L_END = 151552, L_WS = 151552 + 256;
static_assert(L_O + 8 * 4096 == L_END && L_B + 5 * 4096 == L_O, "attention LDS map");
__device__ __forceinline__ int crow(int r, int hi) { return (r & 3) + 8 * (r >> 2) + 4 * hi; }
__device__ __forceinline__ s16x4 vtr(LAS const unsigned char* p) { return __builtin_bit_cast(s16x4, __builtin_amdgcn_ds_read_tr16_b64_v4i16((LAS v4i16_t*)p)); }
__device__ __forceinline__ float swapmax(float m) { auto rr = __builtin_amdgcn_permlane32_swap(__float_as_uint(m), __float_as_uint(m), false, false); return fmaxf(__uint_as_float(rr[0]), __uint_as_float(rr[1])); }
__device__ __forceinline__ float swapsum(float m) { auto rr = __builtin_amdgcn_permlane32_swap(__float_as_uint(m), __float_as_uint(m), false, false); return __uint_as_float(rr[0]) + __uint_as_float(rr[1]); }

#define ATT_BAR() asm volatile("s_waitcnt lgkmcnt(0)\n\ts_barrier" ::: "memory")
__device__ __forceinline__ void glds16(const void* gsrc, unsigned lds_dst) { unsigned keep;
    asm volatile("s_mov_b32 %0, m0\n\ts_mov_b32 m0, %2\n\ts_nop 0\n\tglobal_load_lds_dwordx4 %1, off\n\ts_mov_b32 m0, %0" : "=&s"(keep) : "v"(gsrc), "s"(lds_dst) : "memory"); }
template <int DIL> struct Job {
    int bh, c, n0, h; size_t rowb;
    __device__ __forceinline__ void decode(int id) { constexpr int CPC = (SEQ / DIL) / 256; bh = id >> 4; const int sub = id & 15; c = sub / CPC; n0 = (sub % CPC) * 256; h = bh & 15; rowb = (size_t)(bh >> 4) * SEQ; }
};
template <int DIL, bool ISV> __device__ __forceinline__ void issue_kv(LAS unsigned char* lds, const bf16* src, const Job<DIL>& J, int w, int lane) {
#pragma unroll
    for (int i = 0; i < 6; ++i) {
        const int kb = w * 6 + i, row = kb * 8 + (lane >> 3), pc = lane & 7;
        int pos = J.n0 - 128 + row; pos = pos < 0 ? 0 : pos;
        const size_t ro = (J.rowb + (size_t)pos * DIL + J.c) * DM + J.h * HD;
        const int sw = ISV ? ((((pc >> 2) ^ ((row >> 1) & 1)) * 32) + (pc & 3) * 8) : ((pc ^ ((row >> 1) & 7)) * 8);
        glds16(src + ro + sw, (unsigned)__builtin_amdgcn_readfirstlane((int)((unsigned)(uintptr_t)lds + (ISV ? L_V : L_K) + kb * 1024)));
    }
}
__device__ __forceinline__ void ld16_asm(bf16x8& dst, const bf16* p) { asm volatile("global_load_dwordx4 %0, %1, off" : "=v"(dst) : "v"(p) : "memory"); }

template <int DIL> __device__ __forceinline__ void phase(LAS unsigned char* lds, const bf16* QO, bf16* OUT, const bf16* Kg, const bf16* Vg, const float* biasT  , float* lse  , int vcu, int G) {
    const int tid = threadIdx.x, lane = tid & 63, r32 = lane & 31, hi = lane >> 5;
    const int w = __builtin_amdgcn_readfirstlane(tid >> 6);
    constexpr int NJS = BATCH * NH * 16;
    int id = vcu * 4;
    if (id >= NJS) return;
    Job<DIL> J; J.decode(id);
    bf16x8 q0, q1, q2, q3;
    issue_kv<DIL, false>(lds, Kg, J, w, lane);
    { const bf16* qp = QO + (J.rowb + (size_t)(J.n0 + 32 * w + r32) * DIL + J.c) * DM + J.h * HD + hi * 8; ld16_asm(q0, qp); ld16_asm(q1, qp + 16); ld16_asm(q2, qp + 32); ld16_asm(q3, qp + 48); }
    issue_kv<DIL, true>(lds, Vg, J, w, lane);
    int cur_bh = -1; bool first = true;
    for (;;) {
        const int nid = id + (((id & 3) == 3) ? (G * 4 - 3) : 1);
        const bool has_next = nid < NJS;
        Job<DIL> JN; JN.decode(has_next ? nid : id);
        if (J.bh != cur_bh) {
            cur_bh = J.bh;
#pragma unroll
            for (int i = 0; i < 10; ++i) {
                const int e = tid + 512 * i, j = e >> 10, rem = e & 1023, rg = rem >> 8, ln = (rem & 255) >> 2, i4 = rem & 3;
                const int r = 4 * rg + i4, a = ln & 31, hh = ln >> 5, kk = 32 * j + crow(r, hh), step = 128 + a - kk;
                float val = -INFINITY;
                if (step >= 0 && step <= 128) val = biasT[J.h * 132 + step];
                ((LAS float*)(lds + L_B))[e] = val;
            }
        }
        if (first) { first = false; asm volatile("s_waitcnt vmcnt(6)" : "+v"(q0), "+v"(q1), "+v"(q2), "+v"(q3) :: "memory"); }
        ATT_BAR();
        const int n0 = J.n0, h = J.h, c = J.c; const size_t rowb = J.rowb;
        const size_t qrow = rowb + (size_t)(n0 + 32 * w + r32) * DIL + c;
        const int jstart = (n0 == 0 && w < 4) ? 4 - w : 0;
        f32x16 S[5];
#pragma unroll
        for (int j = 0; j < 5; ++j) {
            if (j < jstart) {
#pragma unroll
                for (int r = 0; r < 16; ++r) S[j][r] = -INFINITY;
            } else {
                f32x16 cinit;
#pragma unroll
                for (int rg = 0; rg < 4; ++rg) { const f32x4 t = *(const LAS f32x4*)(lds + L_B + j * 4096 + rg * 1024 + lane * 16); cinit[4 * rg] = t[0]; cinit[4 * rg + 1] = t[1]; cinit[4 * rg + 2] = t[2]; cinit[4 * rg + 3] = t[3]; }
#pragma unroll
                for (int d0 = 0; d0 < 4; ++d0) {
                    const bf16x8 kf = *(const LAS bf16x8*)(lds + L_K + (32 * w + 32 * j + r32) * 128 + (((2 * d0 + hi) ^ ((r32 >> 1) & 7)) * 16));
                    cinit = __builtin_amdgcn_mfma_f32_32x32x16_bf16(kf, d0 == 0 ? q0 : (d0 == 1 ? q1 : (d0 == 2 ? q2 : q3)), cinit, 0, 0, 0);
                }
                S[j] = cinit;
            }
        }
        ATT_BAR();
        bf16x8 n0q, n1q, n2q, n3q;
        if (has_next) {
            issue_kv<DIL, false>(lds, Kg, JN, w, lane);
            const bf16* qp = QO + (JN.rowb + (size_t)(JN.n0 + 32 * w + r32) * DIL + JN.c) * DM + JN.h * HD + hi * 8; ld16_asm(n0q, qp); ld16_asm(n1q, qp + 16); ld16_asm(n2q, qp + 32); ld16_asm(n3q, qp + 48);
        }
        float m = -INFINITY;
#pragma unroll
        for (int j = 0; j < 5; ++j)
#pragma unroll
            for (int r = 0; r < 16; ++r) m = fmaxf(m, S[j][r]);
        m = swapmax(m);
        float lsum = 0.f;
#pragma unroll
        for (int j = 0; j < 5; ++j)
#pragma unroll
            for (int r = 0; r < 16; ++r) { const float p = __builtin_amdgcn_exp2f(S[j][r] - m); S[j][r] = p; lsum += p; }
        lsum = swapsum(lsum);
        if (has_next) asm volatile("s_waitcnt vmcnt(10)" ::: "memory"); else asm volatile("s_waitcnt vmcnt(0)" ::: "memory");
        ATT_BAR();
        f32x16 o[2];
#pragma unroll
        for (int r = 0; r < 16; ++r) { o[0][r] = 0.f; o[1][r] = 0.f; }
        const int vq = (lane & 15) >> 2, vx = (vq >> 1) & 1;
        const LAS unsigned char* vrow = lds + L_V + (32 * w + 4 * hi + vq) * 128 + ((lane >> 4) & 1) * 32 + (lane & 3) * 8;
        const LAS unsigned char* vbh[2] = {vrow + vx * 64, vrow + (1 - vx) * 64};
#pragma unroll
        for (int j = 0; j < 5; ++j)
#pragma unroll
            for (int s = 0; s < 2; ++s) {
                v4u pw; pw.x = pk2(S[j][8 * s], S[j][8 * s + 1]); pw.y = pk2(S[j][8 * s + 2], S[j][8 * s + 3]); pw.z = pk2(S[j][8 * s + 4], S[j][8 * s + 5]); pw.w = pk2(S[j][8 * s + 6], S[j][8 * s + 7]);
                const bf16x8 pa = __builtin_bit_cast(bf16x8, pw);
#pragma unroll
                for (int d0 = 0; d0 < 2; ++d0) {
                    const s16x4 lo = vtr(vbh[d0] + (32 * j + 16 * s) * 128), hh = vtr(vbh[d0] + (32 * j + 16 * s + 8) * 128);
                    const bf16x8 vf = (bf16x8){lo[0], lo[1], lo[2], lo[3], hh[0], hh[1], hh[2], hh[3]};
                    o[d0] = __builtin_amdgcn_mfma_f32_32x32x16_bf16(pa, vf, o[d0], 0, 0, 0);
                }
            }
        ATT_BAR();
        if (has_next) issue_kv<DIL, true>(lds, Vg, JN, w, lane);
        LAS float* wsf = (LAS float*)(lds + L_WS) + w * 64;
        if (hi == 0) { wsf[r32] = lsum; lse[qrow * 16 + h] = m + log2f(lsum); }
        asm volatile("s_waitcnt lgkmcnt(0)" ::: "memory");
        float rli[16];
#pragma unroll
        for (int r = 0; r < 16; ++r) rli[r] = __builtin_amdgcn_rcpf(wsf[crow(r, hi)]);
        LAS bf16* stg = (LAS bf16*)(lds + L_O) + w * 2048;
#pragma unroll
        for (int r = 0; r < 16; ++r) { const int orow = crow(r, hi);
#pragma unroll
            for (int d0 = 0; d0 < 2; ++d0) stg[orow * 64 + d0 * 32 + r32] = (bf16)(pk2(o[d0][r] * rli[r], 0.f) & 0xffffu); }
        asm volatile("s_waitcnt lgkmcnt(0)" ::: "memory");
#pragma unroll
        for (int i = 0; i < 4; ++i) { const int row = i * 8 + (lane >> 3), ch = lane & 7; const v4u v = *(const LAS v4u*)(stg + row * 64 + ch * 8);
            *(v4u*)(OUT + (rowb + (size_t)(n0 + 32 * w + row) * DIL + c) * DM + h * HD + ch * 8) = v; }
        if (!has_next) break;
        asm volatile("s_waitcnt vmcnt(6)" : "+v"(n0q), "+v"(n1q), "+v"(n2q), "+v"(n3q) :: "memory");
        id = nid; J = JN; q0 = n0q; q1 = n1q; q2 = n2q; q3 = n3q;
    }
    asm volatile("s_waitcnt vmcnt(0) lgkmcnt(0)\n\ts_barrier" ::: "memory");
}
#undef ATT_BAR
}

#ifndef OPT_C1
#define OPT_C1 0
#endif
#ifndef OPT_RES
#define OPT_RES 0
#endif
#ifndef OPT_A1
#define OPT_A1 0
#endif
#ifndef OPT_A2
#define OPT_A2 0
#endif
#ifndef OPT_A3
#define OPT_A3 0
#endif
#ifndef DUP_A2
#define DUP_A2 0
#endif
#ifndef DUP_A1
#define DUP_A1 0
#endif
#ifndef DUP_C1
#define DUP_C1 0
#endif
#ifndef DUP_A3
#define DUP_A3 0
#endif
#ifndef DUP_P0
#define DUP_P0 0
#endif
#ifndef DUP_C3
#define DUP_C3 0
#endif
#ifndef DUP_C2
#define DUP_C2 0
#endif
#ifndef DUP_BAR
#define DUP_BAR 0
#endif
#ifndef MK_PER_PHASE
#define MK_PER_PHASE 1
#endif
constexpr int LDS_BYTES = 155648;
constexpr int MISC_OFF = 151552;
struct Args { const float* in[11]; float* out; unsigned char* ws; int ph_lo, ph_hi; };

template <int PH> __device__ __forceinline__ void run_phase(const Args& args, LAS unsigned char* lds) {
    const int tid = threadIdx.x, lane = tid & 63, wave = __builtin_amdgcn_readfirstlane(tid >> 6);
    const int G = gridDim.x, bx = blockIdx.x, vcu = (G % 8 == 0) ? (bx % 8) * (G / 8) + bx / 8 : bx;
    unsigned char* ws = args.ws;
    float* SSQ = (float*)(ws + WS_SSQ); bf16* XB = (bf16*)(ws + WS_XB);
    LAS float* smf = (LAS float*)lds;
    const int gtid = vcu * 512 + tid, gthreads = G * 512;
    (void)lane; (void)wave; (void)smf; (void)gtid; (void)gthreads; (void)SSQ; (void)XB;
    if constexpr (PH == 0) {
        Ptrs P;
        P.x = args.in[0]; P.conv_norm = args.in[1]; P.conv_w_in = args.in[2]; P.conv_w = args.in[3]; P.conv_w_out = args.in[4]; P.attn_norm = args.in[5];
        P.attn_w_in = args.in[6]; P.q_gain = args.in[7]; P.k_gain = args.in[8]; P.attn_w_out = args.in[9]; P.rel_bias = args.in[10]; P.out = args.out; P.ws = args.ws;
#if DUP_P0
        p0_prologue(P, lds, vcu, G, wave, lane, tid);
#endif
        p0_prologue(P, lds, vcu, G, wave, lane, tid);
    } else {
        constexpr int p = PH - 1, j = p / 11, s = p % 11;
        if constexpr (s == 0) {
            bf16* CV = (bf16*)(ws + WS_CV); bf16* CG = (bf16*)(ws + WS_CG);
#if OPT_C1
            pg8::Gemm g{XB, (const bf16*)(ws + WS_W1) + (size_t)j * CN * DM, MROWS, CN, DM}; pg8::StaticOrder S; S.init(MROWS, CN, G, bx);
            epi::ConvIn E{SSQ, CV, CG};
#if DUP_C1
            pg8::gemm_phase<epi::ConvIn, pg8::StaticOrder, true, true>(lds, g, S, E);
#endif
            pg8::gemm_phase<epi::ConvIn, pg8::StaticOrder, true, true>(lds, g, S, E);
#else
            naive::c1(smf, XB, SSQ, args.in[2] + (size_t)j * DM * CN, args.in[1] + j * DM, CV, CG, bx, G);
#endif
        } else if constexpr (s == 1) {
#if DUP_C2
            conv_pass<true>((const bf16*)(ws + WS_CV), (bf16*)(ws + WS_CG), (bf16*)(ws + WS_END), args.in[3] + (size_t)j * 3 * CE, gtid, gthreads);
#endif
            conv_pass<false>((const bf16*)(ws + WS_CV), (bf16*)(ws + WS_CG), (bf16*)(ws + WS_CG), args.in[3] + (size_t)j * 3 * CE, gtid, gthreads);
        } else if constexpr (s == 2 || s == 10) {
            const bf16* A = (const bf16*)(ws + (s == 2 ? WS_CG : WS_Y)); constexpr int K = s == 2 ? CE : DM;
            const float* xin = (j == 0 && s == 2) ? args.in[0] : args.out;
#if OPT_RES
            pg8::Gemm g{A, (const bf16*)(ws + (s == 2 ? WS_W2 : WS_W4)) + (size_t)j * DM * K, MROWS, DM, K}; pg8::StaticOrder S; S.init(MROWS, DM, G, bx);
            epi::Resid E{xin, args.out, XB, SSQ};
#if DUP_C3
            if constexpr (j == 0 && s == 2) pg8::gemm_phase<epi::Resid, pg8::StaticOrder, false, true>(lds, g, S, E);
#endif
            pg8::gemm_phase<epi::Resid, pg8::StaticOrder, false, true>(lds, g, S, E);
#else
            naive::resid(smf, A, K, s == 2 ? args.in[4] + (size_t)j * CE * DM : args.in[9] + (size_t)j * DM * DM, xin, args.out, XB, SSQ, bx, G);
#endif
        } else if constexpr (s == 9) {
            const bf16* O0 = (const bf16*)(ws + WS_QO); const bf16* O1 = O0 + (size_t)MROWS * DM; const bf16* O2 = O1 + (size_t)MROWS * DM;
            float* LSE = (float*)(ws + WS_LSE); bf16* YB = (bf16*)(ws + WS_Y);
#if OPT_A3
            pg8::Gemm g{XB, (const bf16*)(ws + WS_W3) + (size_t)j * AN * DM + (size_t)QKVC * DM, MROWS, DM, DM}; pg8::StaticOrder S; S.init(MROWS, DM, G, bx);
            epi::ZMerge E{SSQ, O0, O1, O2, LSE, YB};
#if DUP_A3
            pg8::gemm_phase<epi::ZMerge, pg8::StaticOrder, false, true>(lds, g, S, E);
#endif
            pg8::gemm_phase<epi::ZMerge, pg8::StaticOrder, false, true>(lds, g, S, E);
#else
            naive::a3(smf, XB, SSQ, args.in[6] + (size_t)j * DM * AN, args.in[5] + j * DM, O0, O1, O2, LSE, YB, bx, G);
#endif
        } else {
            constexpr int g = (s - 3) >> 1; bf16* QO = (bf16*)(ws + WS_QO) + (size_t)g * MROWS * DM;
            bf16* KB = (bf16*)(ws + WS_K); bf16* VB = (bf16*)(ws + WS_V);
            if constexpr (((s - 3) & 1) == 0) {
#if OPT_A1
                pg8::Gemm gm{XB, (const bf16*)(ws + WS_W3) + (size_t)j * AN * DM + (size_t)g * 3072 * DM, MROWS, 3072, DM}; pg8::StaticOrder S; S.init(MROWS, 3072, G, bx);
                epi::QKV E{SSQ, QO, KB, VB, args.in[7] + (j * NG + g) * HD, args.in[8] + (j * NG + g) * HD};
#if DUP_A1
                pg8::gemm_phase<epi::QKV, pg8::StaticOrder, true, true>(lds, gm, S, E);
#endif
                pg8::gemm_phase<epi::QKV, pg8::StaticOrder, true, true>(lds, gm, S, E);
#else
                naive::a1(smf, XB, SSQ, args.in[6] + (size_t)j * DM * AN, args.in[5] + j * DM, g, args.in[7] + (j * NG + g) * HD, args.in[8] + (j * NG + g) * HD, QO, KB, VB, bx, G);
#endif
            } else {
                constexpr int dil = g == 0 ? 1 : (g == 1 ? 4 : 16);
                float* LSE = (float*)(ws + WS_LSE); const float* BT = (const float*)(ws + WS_BIAS);
#if OPT_A2
#if DUP_A2
                attn::phase<dil>(lds, QO, (bf16*)(ws + WS_END), KB, VB, BT + g * NH * 132, LSE + (size_t)g * MROWS * 16, vcu, G);
#endif
                attn::phase<dil>(lds, QO, QO, KB, VB, BT + g * NH * 132, LSE + (size_t)g * MROWS * 16, vcu, G);
#else
                naive::a2(QO, KB, VB, BT + g * NH * 132, LSE + (size_t)g * MROWS * 16, dil, gtid, gthreads);
#endif
            }
        }
    }
}

__global__ void __launch_bounds__(512, 2) mk_fwd(Args args) {
    extern __shared__ __attribute__((aligned(16))) unsigned char lds_raw[];
    LAS unsigned char* lds = (LAS unsigned char*)lds_raw;
    volatile LAS unsigned* MISC = (volatile LAS unsigned*)(lds + MISC_OFF);
    for (int u = threadIdx.x; u < (LDS_BYTES - MISC_OFF) / 4; u += 512) ((LAS unsigned*)(lds + MISC_OFF))[u] = 0u;
    __syncthreads();
    gu32* ctl = (gu32*)(args.ws + WS_CTL);
    XcdBarrier bar; bar.bar = (unsigned*)(ctl + CW_BAR); bar.x = 0; bar.st = nullptr;
    const int lo = args.ph_lo, hi = args.ph_hi;
    if (hi - lo > 1) bar = xcd_barrier_post((unsigned*)(ctl + CW_BAR), MISC + 8);
#if DUP_BAR
#define RUN(k) if (lo <= (k) && (k) < hi) { run_phase<(k)>(args, lds); if ((k) + 1 < hi) { xcd_barrier(bar); xcd_barrier(bar); } }
#else
#define RUN(k) if (lo <= (k) && (k) < hi) { run_phase<(k)>(args, lds); if ((k) + 1 < hi) xcd_barrier(bar); }
#endif
    RUN(0) RUN(1) RUN(2) RUN(3) RUN(4) RUN(5) RUN(6) RUN(7) RUN(8) RUN(9) RUN(10) RUN(11)
    RUN(12) RUN(13) RUN(14) RUN(15) RUN(16) RUN(17) RUN(18) RUN(19) RUN(20) RUN(21) RUN(22)
#undef RUN
}

extern "C" void kernel_launch(void* const* d_in, const int* in_sizes, int n_in, void* d_out, int out_size, void* d_ws, size_t ws_size, hipStream_t stream) {
    static int grid = 0;
    if (grid == 0) {
        if (n_in != 11 || in_sizes[0] != MROWS * DM || out_size != MROWS * DM || ws_size < WS_END) { fprintf(stderr, "kernel_launch: unexpected shapes (n_in %d, ws %zu); nothing launched\n", n_in, ws_size); grid = -1; return; }
        int dev = 0, cus = 0, per_cu = 0;
        if (hipGetDevice(&dev) != hipSuccess || hipDeviceGetAttribute(&cus, hipDeviceAttributeMultiprocessorCount, dev) != hipSuccess) { grid = -1; return; }
        if (hipFuncSetAttribute((const void*)mk_fwd, hipFuncAttributeMaxDynamicSharedMemorySize, LDS_BYTES) != hipSuccess) { fprintf(stderr, "kernel_launch: hipFuncSetAttribute failed\n"); grid = -1; return; }
        if (hipOccupancyMaxActiveBlocksPerMultiprocessor(&per_cu, (const void*)mk_fwd, 512, LDS_BYTES) != hipSuccess || per_cu < 1) { fprintf(stderr, "kernel_launch: occupancy query says %d blocks per CU; nothing launched\n", per_cu); (void)hipGetLastError(); grid = -1; return; }
        grid = cus;
    }
    if (grid < 0) return;
    (void)hipMemsetAsync((char*)d_ws + WS_CTL, 0, CTL_ZERO_BYTES, stream);
    Args a{};
    for (int i = 0; i < 11; ++i) a.in[i] = (const float*)d_in[i];
    a.out = (float*)d_out; a.ws = (unsigned char*)d_ws;
#if MK_PER_PHASE
    for (int ph = 0; ph < NPHASE; ++ph) { a.ph_lo = ph; a.ph_hi = ph + 1; hipLaunchKernelGGL(mk_fwd, dim3(grid), dim3(512), LDS_BYTES, stream, a); }
#else
    a.ph_lo = 0; a.ph_hi = NPHASE; hipLaunchKernelGGL(mk_fwd, dim3(grid), dim3(512), LDS_BYTES, stream, a);
#endif
}
```

```cpp
#include <hip/hip_runtime.h>
#include <cstdio>
#include <cstdint>
#include <cmath>
#define MK_PER_PHASE 0
#define OPT_C1 1
#define OPT_RES 1
#define OPT_A1 1
#define OPT_A3 1
#define OPT_A2 1
#define FUSE_CONV 1
namespace pg8 {
#define PG8_LAS __attribute__((address_space(3)))
typedef unsigned short bf16_t;
typedef short bf16x8 __attribute__((ext_vector_type(8)));
typedef float f32x4 __attribute__((ext_vector_type(4)));
typedef unsigned u32x4 __attribute__((ext_vector_type(4)));
constexpr int BM = 256, BK = 64, HALF = 128, HTB = HALF * BK * 2  , STAGE_BYTES = 8 * HTB, NXCD = 8, WGM = 8;

__host__ __device__ __forceinline__ int lds_byte(int r, int c) { const int st = (r >> 4) * 2 + (c >> 5), rr = r & 15, cc = c & 31, ob = rr * 64 + cc * 2; return st * 1024 + (ob ^ (((ob >> 9) & 1) << 5)); }
__host__ __device__ __forceinline__ void stage_rc(int b, int& R, int& C) { const int st = b / 1024, sb = b % 1024, swz = sb ^ (((sb >> 9) & 1) << 5); R = (st >> 1) * 16 + swz / 64; C = (st & 1) * 32 + (swz % 64) / 2; }
__host__ __device__ __forceinline__ int perm32(int rho) { const int n = rho >> 4, i = rho & 15; return 8 * (i >> 2) + 4 * n + (i & 3); }

struct Unit { int pm, pn; };
struct Gemm { const bf16_t* A; const bf16_t* Bt; int M, N, K; };

struct StaticOrder {
    int nM, nN, nwg, G, c;
    __host__ __device__ void init(int M, int N, int G_, int c_) { nM = M / BM; nN = N / BM; nwg = nM * nN; G = G_; c = c_; }
    __host__ __device__ bool next(int i, Unit& u) const {
        const long L = (long)i * G + c; if (L >= nwg) return false;
        int wgid = (int)L; { const int q = nwg / NXCD, r = nwg % NXCD, xcd = wgid % NXCD, off = wgid / NXCD; wgid = (xcd < r ? xcd * (q + 1) : r * (q + 1) + (xcd - r) * q) + off; }
        const int nig = WGM * nN, gid = wgid / nig, fm = gid * WGM, gsz = (nM - fm) < WGM ? (nM - fm) : WGM;
        u.pm = fm + ((wgid % nig) % gsz); u.pn = (wgid % nig) / gsz; return true;
    }
    __device__ __forceinline__ void a_ready(const Unit&) const {}
    __device__ __forceinline__ void done(const Unit&) const {}
};

__device__ __forceinline__ unsigned cvt_pk_bf16(float lo, float hi) { unsigned r; asm volatile("v_cvt_pk_bf16_f32 %0, %1, %2" : "=v"(r) : "v"(lo), "v"(hi)); return r; }
typedef float f32x2 __attribute__((ext_vector_type(2)));

template <class Epi, class Sched, bool ALIGN_EPI = false, bool SP2 = false>
__device__ __forceinline__ void gemm_phase(PG8_LAS unsigned char* lds, const Gemm g, const Sched& S, const Epi& E) {
    const int tid = threadIdx.x, wid = __builtin_amdgcn_readfirstlane(tid >> 6), lane = tid & 63, wr = wid >> 2, wc = wid & 3, fr = lane & 15, fq = lane >> 4;
    const int K = g.K, nt = K / BK;
    unsigned voffA[2], voffB[2];
#pragma unroll
    for (int i = 0; i < 2; ++i) { int R, C; stage_rc(tid * 16 + i * 8192, R, C); const int Rb = Epi::PERM ? ((R & ~31) + perm32(R & 31)) : R;
        voffA[i] = (unsigned)(R * K + C) * 2u; voffB[i] = (unsigned)(Rb * K + C) * 2u; }
    const size_t kstep = (size_t)(BK * 2);
    const size_t hstep = (size_t)HALF * K * 2;
    const size_t tstep = 2 * hstep;
    const unsigned ldsw = (unsigned)wid * 1024u;
    const int aoff = lds_byte(wr * 64 + fr, fq * 8), boff = lds_byte(wc * 32 + fr, fq * 8);
#define PG8_SA(b, h) (((b) * 2 + (h)) * HTB)
#define PG8_SB(b, h) ((4 + (b) * 2 + (h)) * HTB)
#define PG8_STAGE(bufoff, gbase, voff) do { _Pragma("unroll") for (int _i = 0; _i < 2; ++_i) \
        __builtin_amdgcn_global_load_lds((const unsigned*)((const char*)(gbase) + (voff)[_i]), (PG8_LAS unsigned*)(lds + (bufoff) + ldsw + _i * 8192), 16, 0, 0); } while (0)
#define PG8_LDA(dst, b, h) do { _Pragma("unroll") for (int m = 0; m < 4; ++m) _Pragma("unroll") for (int k = 0; k < 2; ++k) dst[m][k] = *(const PG8_LAS bf16x8*)(lds + PG8_SA(b, h) + aoff + m * 2048 + k * 1024); } while (0)
#define PG8_LDB(dst, b, h) do { _Pragma("unroll") for (int n = 0; n < 2; ++n) _Pragma("unroll") for (int k = 0; k < 2; ++k) dst[n][k] = *(const PG8_LAS bf16x8*)(lds + PG8_SB(b, h) + boff + n * 2048 + k * 1024); } while (0)
#define PG8_MMA(ai, bj, At, Bt) do { __builtin_amdgcn_s_setprio(1); _Pragma("unroll") for (int m = 0; m < 4; ++m) _Pragma("unroll") for (int n = 0; n < 2; ++n) _Pragma("unroll") for (int k = 0; k < 2; ++k) \
        acc[ai][bj][m][n] = __builtin_amdgcn_mfma_f32_16x16x32_bf16(Bt[n][k], At[m][k], acc[ai][bj][m][n], 0, 0, 0); __builtin_amdgcn_s_setprio(0); } while (0)
#define PG8_WAIT_V(n) asm volatile("s_waitcnt vmcnt(" #n ")" ::: "memory")
#define PG8_WAIT_L(n) asm volatile("s_waitcnt lgkmcnt(" #n ")" ::: "memory")
#define PG8_BAR __builtin_amdgcn_s_barrier()
#define PG8_SCHED __builtin_amdgcn_sched_barrier(0)
    Unit cur, nxt; int ui = 0;
    if (!S.next(0, cur)) return;
    f32x4 acc[2][2][4][2];
#pragma unroll
    for (int a = 0; a < 2; ++a)
#pragma unroll
        for (int b = 0; b < 2; ++b)
#pragma unroll
            for (int m = 0; m < 4; ++m)
#pragma unroll
                for (int n = 0; n < 2; ++n) acc[a][b][m][n] = (f32x4){0.f, 0.f, 0.f, 0.f};
    bf16x8 At[4][2], B0[2][2], B1[2][2];
    const char* cA = (const char*)g.A + (size_t)cur.pm * tstep; const char* cB = (const char*)g.Bt + (size_t)cur.pn * tstep;
    S.a_ready(cur);
    if constexpr (SP2) {
        PG8_STAGE(PG8_SB(0, 0), cB, voffB); PG8_STAGE(PG8_SB(0, 1), cB + hstep, voffB); PG8_STAGE(PG8_SA(0, 0), cA, voffA); PG8_STAGE(PG8_SA(0, 1), cA + hstep, voffA);
        if (wr == 1) PG8_BAR;
        PG8_WAIT_V(2); PG8_BAR;
        PG8_STAGE(PG8_SB(1, 0), cB + kstep, voffB); PG8_STAGE(PG8_SA(1, 0), cA + kstep, voffA); PG8_STAGE(PG8_SB(1, 1), cB + hstep + kstep, voffB);
        PG8_WAIT_V(6); PG8_BAR;
    } else {
        PG8_STAGE(PG8_SB(0, 0), cB, voffB); PG8_STAGE(PG8_SA(0, 0), cA, voffA); PG8_STAGE(PG8_SB(0, 1), cB + hstep, voffB); PG8_STAGE(PG8_SA(0, 1), cA + hstep, voffA);
        if (wr == 1) PG8_BAR;
        PG8_WAIT_V(4); PG8_BAR;
        PG8_STAGE(PG8_SB(1, 0), cB + kstep, voffB); PG8_STAGE(PG8_SA(1, 0), cA + kstep, voffA); PG8_STAGE(PG8_SB(1, 1), cB + hstep + kstep, voffB);
        PG8_WAIT_V(6); PG8_BAR;
    }
    for (;;) {
        const bool has_next = S.next(ui + 1, nxt);
        const char* nA = has_next ? (const char*)g.A + (size_t)nxt.pm * tstep : cA; const char* nB = has_next ? (const char*)g.Bt + (size_t)nxt.pn * tstep : cB;
        for (int t = 0; t < nt; t += 2) {
            const bool last = (t == nt - 2);
            const char* a1 = cA + (size_t)(t + 1) * kstep;
            const char* a2 = last ? nA : cA + (size_t)(t + 2) * kstep; const char* b2 = last ? nB : cB + (size_t)(t + 2) * kstep;
            const char* a3 = a2 + kstep; const char* b3 = b2 + kstep;
            if (last && has_next) S.a_ready(nxt);
            if constexpr (SP2) {
            PG8_LDB(B0, 0, 0); PG8_LDB(B1, 0, 1); PG8_SCHED; PG8_LDA(At, 0, 0); PG8_STAGE(PG8_SA(1, 1), a1 + hstep, voffA);
            PG8_WAIT_V(8); PG8_WAIT_L(0); PG8_BAR; PG8_MMA(0, 0, At, B0); PG8_MMA(0, 1, At, B1); PG8_BAR; PG8_SCHED;
            PG8_LDA(At, 0, 1); PG8_STAGE(PG8_SB(0, 0), b2, voffB); PG8_STAGE(PG8_SB(0, 1), b2 + hstep, voffB); PG8_STAGE(PG8_SA(0, 0), a2, voffA);
            PG8_WAIT_V(8); PG8_WAIT_L(0); PG8_BAR; PG8_MMA(1, 0, At, B0); PG8_MMA(1, 1, At, B1); PG8_BAR; PG8_SCHED;
            PG8_LDB(B0, 1, 0); PG8_LDB(B1, 1, 1); PG8_SCHED; PG8_LDA(At, 1, 0); PG8_STAGE(PG8_SA(0, 1), a2 + hstep, voffA);
            PG8_WAIT_V(8); PG8_WAIT_L(0); PG8_BAR; PG8_MMA(0, 0, At, B0); PG8_MMA(0, 1, At, B1); PG8_BAR; PG8_SCHED;
            PG8_LDA(At, 1, 1); PG8_STAGE(PG8_SB(1, 0), b3, voffB); PG8_STAGE(PG8_SB(1, 1), b3 + hstep, voffB); PG8_STAGE(PG8_SA(1, 0), a3, voffA);
            PG8_WAIT_V(8); PG8_WAIT_L(0); PG8_BAR; PG8_MMA(1, 0, At, B0); PG8_MMA(1, 1, At, B1); PG8_BAR; PG8_SCHED;
            } else {
            PG8_LDB(B0, 0, 0); PG8_SCHED; PG8_LDA(At, 0, 0); PG8_STAGE(PG8_SA(1, 1), a1 + hstep, voffA);
            PG8_WAIT_L(8); PG8_BAR; PG8_WAIT_L(0); PG8_MMA(0, 0, At, B0); PG8_BAR; PG8_SCHED;
            PG8_LDB(B1, 0, 1); PG8_STAGE(PG8_SB(0, 0), b2, voffB);
            PG8_BAR; PG8_WAIT_L(0); PG8_MMA(0, 1, At, B1); PG8_BAR;
            PG8_LDA(At, 0, 1); PG8_STAGE(PG8_SA(0, 0), a2, voffA);
            PG8_BAR; PG8_WAIT_L(0); PG8_MMA(1, 0, At, B0); PG8_BAR; PG8_SCHED;
            PG8_STAGE(PG8_SB(0, 1), b2 + hstep, voffB);
            PG8_WAIT_V(6); PG8_BAR; PG8_MMA(1, 1, At, B1); PG8_BAR;
            PG8_LDB(B0, 1, 0); PG8_SCHED; PG8_LDA(At, 1, 0); PG8_STAGE(PG8_SA(0, 1), a2 + hstep, voffA);
            PG8_WAIT_L(8); PG8_BAR; PG8_WAIT_L(0); PG8_MMA(0, 0, At, B0); PG8_BAR; PG8_SCHED;
            PG8_LDB(B1, 1, 1); PG8_STAGE(PG8_SB(1, 0), b3, voffB);
            PG8_BAR; PG8_WAIT_L(0); PG8_MMA(0, 1, At, B1); PG8_BAR;
            PG8_LDA(At, 1, 1); PG8_STAGE(PG8_SA(1, 0), a3, voffA);
            PG8_BAR; PG8_WAIT_L(0); PG8_MMA(1, 0, At, B0); PG8_BAR; PG8_SCHED;
            PG8_STAGE(PG8_SB(1, 1), b3 + hstep, voffB);
            PG8_WAIT_V(6); PG8_BAR; PG8_MMA(1, 1, At, B1); PG8_BAR;
            }
        }
        if constexpr (ALIGN_EPI) { if (wr == 0) PG8_BAR; }
        if constexpr (!Epi::AFTER_DRAIN) { E(acc, cur, wr, wc, fr, fq); if constexpr (Epi::DUP) { asm volatile("" ::: "memory"); E(acc, cur, wr, wc, fr, fq); } S.done(cur); }
        if (!has_next) break;
#pragma unroll
        for (int a = 0; a < 2; ++a)
#pragma unroll
            for (int b = 0; b < 2; ++b)
#pragma unroll
                for (int m = 0; m < 4; ++m)
#pragma unroll
                    for (int n = 0; n < 2; ++n) acc[a][b][m][n] = (f32x4){0.f, 0.f, 0.f, 0.f};
        cur = nxt; cA = nA; cB = nB; ++ui;
        if constexpr (ALIGN_EPI) { if (wr == 1) PG8_BAR; }
    }
    PG8_WAIT_V(0);
    if constexpr (!ALIGN_EPI) { if (wr == 0) PG8_BAR; }
    PG8_BAR;
    if constexpr (Epi::AFTER_DRAIN) { E.fused(acc, cur, wr, wc, fr, fq, lds, wid, lane); S.done(cur); }
#undef PG8_SA
#undef PG8_SB
#undef PG8_STAGE
#undef PG8_LDA
#undef PG8_LDB
#undef PG8_MMA
#undef PG8_WAIT_V
#undef PG8_WAIT_L
#undef PG8_BAR
#undef PG8_SCHED
}
}

constexpr int BATCH = 4, SEQ = 4096, DM = 1024, MROWS = BATCH * SEQ;
constexpr int CE = 2048, CN = 4 * CE;
constexpr int NH = 16, HD = 64, NG = 3, QKVC = 9216, AN = 10240;
constexpr float EPS = 1e-6f, LOG2E = 1.4426950408889634f, QSCALE = 0.125f * LOG2E;
constexpr int NPHASE = 23;

constexpr size_t MiB = 1u << 20;
constexpr size_t WS_CTL = 0, CTL_ZERO_BYTES = 1 * MiB;
constexpr size_t WS_SSQ = 1 * MiB;
constexpr size_t WS_W1 = 2 * MiB, WS_W2 = 34 * MiB, WS_W3 = 42 * MiB, WS_W4 = 82 * MiB;
constexpr size_t WS_LSE = 86 * MiB;
constexpr size_t WS_BIAS = 89 * MiB;
constexpr size_t WS_XB = 90 * MiB;
constexpr size_t WS_CV = 122 * MiB, WS_CG = 186 * MiB;
constexpr size_t WS_QO = 122 * MiB;
constexpr size_t WS_K = 218 * MiB, WS_V = 250 * MiB, WS_Y = WS_K;
constexpr size_t WS_END = 282 * MiB;
constexpr size_t WS_SIDE = 316 * MiB;
constexpr int CW_TMO = 0, CW_BAR = 4096;

#define GAS __attribute__((address_space(1)))
#define LAS __attribute__((address_space(3)))
typedef unsigned short bf16;
typedef unsigned v4u __attribute__((ext_vector_type(4)));
typedef unsigned v2u __attribute__((ext_vector_type(2)));
typedef float f32x4 __attribute__((ext_vector_type(4)));
typedef short bf16x8 __attribute__((ext_vector_type(8)));
typedef GAS unsigned gu32;
#define RLX_AGENT __ATOMIC_RELAXED, __HIP_MEMORY_SCOPE_AGENT
#define LDS_WAIT() asm volatile("s_waitcnt lgkmcnt(0)" ::: "memory")
#define VM_WAIT() asm volatile("s_waitcnt vmcnt(0)" ::: "memory")
__device__ __forceinline__ unsigned f2bf(float f) { unsigned u = __builtin_bit_cast(unsigned, f); return (u + 0x7fffu + ((u >> 16) & 1u)) >> 16; }
typedef float f32x2_t __attribute__((ext_vector_type(2))); typedef __bf16 bf16x2_t __attribute__((ext_vector_type(2)));
__device__ __forceinline__ unsigned pk2(float lo, float hi) { f32x2_t v = {lo, hi}; bf16x2_t b = __builtin_convertvector(v, bf16x2_t); return __builtin_bit_cast(unsigned, b); }
__device__ __forceinline__ float bf2f(unsigned h) { return __builtin_bit_cast(float, h << 16); }
__device__ __forceinline__ float bflo(unsigned w) { return __builtin_bit_cast(float, w << 16); }
__device__ __forceinline__ float bfhi(unsigned w) { return __builtin_bit_cast(float, w & 0xffff0000u); }
__device__ __forceinline__ float sigmoidf_(float z) { return __builtin_amdgcn_rcpf(1.0f + __builtin_amdgcn_exp2f(-z * LOG2E)); }
__device__ __forceinline__ float row_rs(const float* ssq, int row) {
    const f32x4* p = (const f32x4*)(ssq + (size_t)row * 16);
    const f32x4 s = (p[0] + p[1]) + (p[2] + p[3]);
    return 1.0f / sqrtf(((s.x + s.y) + (s.z + s.w)) * (1.0f / DM) + EPS);
}
__device__ __forceinline__ float wave_sum(float v) {
#pragma unroll
    for (int o = 1; o < 64; o <<= 1) v += __shfl_xor(v, o);
    return v;
}
__device__ __forceinline__ int t5_bucket(int d) {
    if (d < 16) return d;
    int b = 15;
    b += (d >= 16); b += (d >= 22); b += (d >= 30); b += (d >= 40); b += (d >= 54); b += (d >= 73); b += (d >= 99); b += (d >= 134);
    b += (d >= 182); b += (d >= 246); b += (d >= 332); b += (d >= 450); b += (d >= 609); b += (d >= 825); b += (d >= 1117); b += (d >= 1513);
    return b;
}

#define XB_TMO      128
#define XB_XCNT(j)  (256  + 64 * (j))
#define XB_XSUB(j)  (1280 + 64 * (j))
#define XB_XGEN(j)  (2304 + 64 * (j))
#define XB_TOP      3328
#define XB_TOPGEN   3392
#define XCD_BAR_WORDS 3456
#define XB_SPIN_CAP (1u << 18)

__device__ __forceinline__ unsigned xb_ld(unsigned* p)              { return __hip_atomic_load(p, __ATOMIC_RELAXED, __HIP_MEMORY_SCOPE_AGENT); }
__device__ __forceinline__ unsigned xb_add(unsigned* p, unsigned v) { return __hip_atomic_fetch_add(p, v, __ATOMIC_RELAXED, __HIP_MEMORY_SCOPE_AGENT); }
__device__ __forceinline__ unsigned xb_xcc_id() { return (unsigned)__builtin_amdgcn_s_getreg((3 << 11) | 20) & 0xFu; }
#define XB_SPIN(cond, bar) do { unsigned _sp = 0; while (cond) { __builtin_amdgcn_s_sleep(1); \
    if ((++_sp & 255u) == 0u) { if (xb_ld(&(bar)[XB_TMO])) break; if (_sp > XB_SPIN_CAP) { atomicAdd(&(bar)[XB_TMO], 1u); break; } } } } while (0)

struct XcdBarrier {
    unsigned* bar; unsigned x;
    volatile LAS unsigned* st;
};

__device__ __forceinline__ XcdBarrier xcd_barrier_post(unsigned* bar, volatile LAS unsigned* st) {
    XcdBarrier b; b.bar = bar; b.x = xb_xcc_id(); b.st = st;
    if (threadIdx.x == 0) (void)xb_add(&bar[XB_XCNT(b.x)], 1u);
    return b;
}
__device__ __forceinline__ void xcd_barrier_complete(unsigned* bar, unsigned x, unsigned& nloc, unsigned& nx) {
    const unsigned G = gridDim.x * gridDim.y * gridDim.z;
    unsigned sum, cnt, mine, sp = 0u;
    for (;;) {
        sum = 0u; cnt = 0u; mine = 0u;
#pragma unroll
        for (unsigned j = 0; j < 16; ++j) { const unsigned c = xb_ld(&bar[XB_XCNT(j)]); sum += c; cnt += (c > 0u) ? 1u : 0u; mine = (j == x) ? c : mine; }
        if (sum == G) break;
        __builtin_amdgcn_s_sleep(1);
        if ((++sp & 255u) == 0u) { if (xb_ld(&bar[XB_TMO])) break; if (sp > XB_SPIN_CAP) { atomicAdd(&bar[XB_TMO], 1u); break; } }
    }
    nloc = mine > 0u ? mine : 1u; nx = cnt > 0u ? cnt : 1u;
}

__device__ __forceinline__ void xcd_barrier(const XcdBarrier& b) {
    asm volatile("s_waitcnt vmcnt(0)" ::: "memory");
    __syncthreads();
    if (threadIdx.x == 0) {
        unsigned* bar = b.bar;
        __builtin_amdgcn_s_waitcnt(0);
        unsigned nloc = b.st[0], nx = b.st[1];
        if (nloc == 0u) { xcd_barrier_complete(bar, b.x, nloc, nx); b.st[0] = nloc; b.st[1] = nx; }
        const unsigned old = xb_add(&bar[XB_XSUB(b.x)], 1u);
        const unsigned gen = old / nloc;
        if (old + 1u == (gen + 1u) * nloc) {
            __builtin_amdgcn_fence(__ATOMIC_RELEASE, "agent");
            asm volatile("s_waitcnt vmcnt(0)" ::: "memory");
            const unsigned og = xb_add(&bar[XB_TOP], 1u);
            const unsigned tg = og / nx;
            if (og + 1u == (tg + 1u) * nx) xb_add(&bar[XB_TOPGEN], 1u);
            else XB_SPIN(xb_ld(&bar[XB_TOPGEN]) == tg, bar);
            __builtin_amdgcn_fence(__ATOMIC_ACQUIRE, "agent");
            xb_add(&bar[XB_XGEN(b.x)], 1u);
            asm volatile("s_waitcnt vmcnt(0)" ::: "memory");
        } else {
            XB_SPIN(xb_ld(&bar[XB_XGEN(b.x)]) == gen, bar);
            __builtin_amdgcn_fence(__ATOMIC_ACQUIRE, "agent");
            asm volatile("s_waitcnt vmcnt(0)" ::: "memory");
        }
    }
    __syncthreads();
}

#ifndef DUP_EPI
#define DUP_EPI 0
#endif
namespace epi {
using pg8::Unit; using pg8::bf16_t;

__device__ __forceinline__ void rows_rs(const float* ssq, int row0  , int fq, float (&rs)[2][4]) {
    f32x4 pp[2][4];
#pragma unroll
    for (int ai = 0; ai < 2; ++ai)
#pragma unroll
        for (int m = 0; m < 4; ++m) pp[ai][m] = *(const f32x4*)(ssq + (size_t)(row0 + ai * 128 + m * 16) * 16 + 4 * fq);
#pragma unroll
    for (int ai = 0; ai < 2; ++ai)
#pragma unroll
        for (int m = 0; m < 4; ++m) { float t = (pp[ai][m][0] + pp[ai][m][1]) + (pp[ai][m][2] + pp[ai][m][3]); t += __shfl_xor(t, 16); t += __shfl_xor(t, 32); rs[ai][m] = __builtin_amdgcn_rsqf(t * (1.0f / DM) + EPS); }
}
struct ConvIn {
    static constexpr bool PERM = false, AFTER_DRAIN = false, DUP = (DUP_EPI != 0);
    const float* ssq; bf16_t* V; bf16_t* G;
    __device__ __forceinline__ void operator()(const f32x4 (&acc)[2][2][4][2], const Unit& u, int wr, int wc, int fr, int fq) const {
        const int ch0 = u.pn * 64 + wc * 16 + 4 * fq;
        float rsv[2][4]; rows_rs(ssq, u.pm * 256 + wr * 64 + fr, fq, rsv);
#pragma unroll
        for (int ai = 0; ai < 2; ++ai)
#pragma unroll
            for (int m = 0; m < 4; ++m) {
                const int row = u.pm * 256 + ai * 128 + wr * 64 + m * 16 + fr;
                const float rs = rsv[ai][m];
                const f32x4 b = acc[ai][0][m][0] * rs, c = acc[ai][0][m][1] * rs, uu = acc[ai][1][m][0] * rs, z = acc[ai][1][m][1] * rs;
                const f32x4 v = c * uu;
                f32x4 g;
#pragma unroll
                for (int i = 0; i < 4; ++i) g[i] = b[i] * z[i] * sigmoidf_(z[i]);
                v2u wv, wg; wv.x = pk2(v[0], v[1]); wv.y = pk2(v[2], v[3]); wg.x = pk2(g[0], g[1]); wg.y = pk2(g[2], g[3]);
                *(v2u*)(V + (size_t)row * CE + ch0) = wv;
                *(v2u*)(G + (size_t)row * CE + ch0) = wg;
            }
    }
};

struct ConvFused {
    static constexpr bool PERM = false, AFTER_DRAIN = false, DUP = false;
    const float* ssq; bf16_t* Y; const float* cw; float* side; LAS unsigned char* xch;
    static __device__ __forceinline__ f32x4 unpk(v2u p) { return (f32x4){bflo(p.x), bfhi(p.x), bflo(p.y), bfhi(p.y)}; }
    __device__ __forceinline__ void operator()(const f32x4 (&acc)[2][2][4][2], const Unit& u, int wr, int wc, int fr, int fq) const {
        const int ch0 = u.pn * 64 + wc * 16 + 4 * fq;
        float rsv[2][4]; rows_rs(ssq, u.pm * 256 + wr * 64 + fr, fq, rsv);
        const f32x4 w0 = *(const f32x4*)(cw + ch0), w1 = *(const f32x4*)(cw + CE + ch0), w2 = *(const f32x4*)(cw + 2 * CE + ch0);
        v2u vq[2][4]; f32x4 gt[2][4];
#pragma unroll
        for (int ai = 0; ai < 2; ++ai)
#pragma unroll
            for (int m = 0; m < 4; ++m) {
                const float rs = rsv[ai][m];
                const f32x4 b = acc[ai][0][m][0] * rs, c = acc[ai][0][m][1] * rs, uu = acc[ai][1][m][0] * rs, z = acc[ai][1][m][1] * rs;
                const f32x4 v = c * uu;
                vq[ai][m].x = pk2(v[0], v[1]); vq[ai][m].y = pk2(v[2], v[3]);
#pragma unroll
                for (int i = 0; i < 4; ++i) gt[ai][m][i] = b[i] * z[i] * sigmoidf_(z[i]);
            }
        LAS unsigned char* my = xch + (wr * 4 + wc) * 2720 + fq * 8;
        LAS unsigned char* other = xch + ((1 - wr) * 4 + wc) * 2720 + fq * 8;
        const bool seq_start = (u.pm & 15) == 0;
        if (fr >= 14) {
            const int hr = fr - 14;
            *(LAS v2u*)(other + ((wr == 0 ? 0 : 66) + hr) * 40) = vq[0][3];
            if (wr == 0) *(LAS v2u*)(other + (66 + hr) * 40) = vq[1][3];
            else *(f32x4*)(side + ((size_t)u.pm * 6 + 4 + hr) * CE + ch0) = unpk(vq[1][3]);
        }
        if (wr == 0 && fr < 2) *(LAS v2u*)(my + fr * 40) = (v2u){0u, 0u};
#pragma unroll
        for (int m = 0; m < 4; ++m) *(LAS v2u*)(my + (2 + 16 * m + fr) * 40) = vq[0][m];
        asm volatile("s_waitcnt lgkmcnt(0)\n\ts_barrier" ::: "memory");
#pragma unroll
        for (int ai = 0; ai < 2; ++ai) {
            if (ai == 1) {
#pragma unroll
                for (int m = 0; m < 4; ++m) *(LAS v2u*)(my + (2 + 16 * m + fr) * 40) = vq[1][m];
                asm volatile("s_waitcnt lgkmcnt(0)" ::: "memory");
            }
#pragma unroll
            for (int m = 0; m < 4; ++m) {
                const int k = 16 * m + fr;
                int r1 = k + 1, r2 = k;
                if (ai == 1) { if (k < 1) r1 = 67; if (k < 2) r2 = 66 + k; }
                const f32x4 p1 = unpk(*(const LAS v2u*)(my + r1 * 40)), p2 = unpk(*(const LAS v2u*)(my + r2 * 40)), v = unpk(vq[ai][m]);
#ifdef DBG_NOPREV
                const f32x4 cv = w2 * v + (w1 * p1 + w0 * p2) * 0.0f;
#else
                const f32x4 cv = w2 * v + w1 * p1 + w0 * p2;
#endif
#ifdef DBG_Y0
                const f32x4 y = gt[ai][m] * cv * 0.0f;
#else
                const f32x4 y = gt[ai][m] * cv;
#endif
                const int row = u.pm * 256 + ai * 128 + wr * 64 + k;
                v2u wy; wy.x = pk2(y[0], y[1]); wy.y = pk2(y[2], y[3]);
                *(v2u*)(Y + (size_t)row * CE + ch0) = wy;
                if (ai == 0 && m == 0 && wr == 0 && fr < 2 && !seq_start) {
                    *(f32x4*)(side + ((size_t)u.pm * 6 + fr) * CE + ch0) = gt[0][0];
                    *(f32x4*)(side + ((size_t)u.pm * 6 + 2 + fr) * CE + ch0) = cv;
                }
            }
        }
    }
};
struct Resid {
    static constexpr bool PERM = false, AFTER_DRAIN = false, DUP = false;
    const float* xin; float* xout; bf16_t* xb; float* ssq;
    __device__ __forceinline__ void operator()(const f32x4 (&acc)[2][2][4][2], const Unit& u, int wr, int wc, int fr, int fq) const {
        const int col0 = u.pn * 256 + wc * 32 + 4 * fq;
        const size_t off0 = (size_t)(u.pm * 256 + wr * 64 + fr) * DM + col0;
        f32x4 pre[4][2][2];
#pragma unroll
        for (int i = 0; i < 4; ++i)
#pragma unroll
            for (int bj = 0; bj < 2; ++bj)
#pragma unroll
                for (int n = 0; n < 2; ++n) pre[i][bj][n] = *(const f32x4*)(xin + off0 + (size_t)(16 * i) * DM + bj * 128 + n * 16);
#pragma unroll
        for (int i = 0; i < 8; ++i) {
            const int ai = i >> 2, m = i & 3;
            const size_t off = off0 + (size_t)(ai * 128 + m * 16) * DM;
            float ss = 0.f; f32x4 xn[2][2];
#pragma unroll
            for (int bj = 0; bj < 2; ++bj)
#pragma unroll
                for (int n = 0; n < 2; ++n) { xn[bj][n] = pre[i & 3][bj][n] + acc[ai][bj][m][n]; const f32x4 t = xn[bj][n]; ss += (t[0] * t[0] + t[1] * t[1]) + (t[2] * t[2] + t[3] * t[3]); }
            if (i < 4) {
#pragma unroll
                for (int bj = 0; bj < 2; ++bj)
#pragma unroll
                    for (int n = 0; n < 2; ++n) pre[i & 3][bj][n] = *(const f32x4*)(xin + off + (size_t)128 * DM + bj * 128 + n * 16);
            }
#pragma unroll
            for (int bj = 0; bj < 2; ++bj)
#pragma unroll
                for (int n = 0; n < 2; ++n) {
                    *(f32x4*)(xout + off + bj * 128 + n * 16) = xn[bj][n];
                    v2u w; w.x = pk2(xn[bj][n][0], xn[bj][n][1]); w.y = pk2(xn[bj][n][2], xn[bj][n][3]);
                    *(v2u*)(xb + off + bj * 128 + n * 16) = w;
                }
            ss += __shfl_xor(ss, 16); ss += __shfl_xor(ss, 32);
            if (fq == 0) ssq[(size_t)(u.pm * 256 + ai * 128 + wr * 64 + m * 16 + fr) * 16 + u.pn * 4 + wc] = ss;
        }
    }
};
struct QKV {
    static constexpr bool PERM = true, AFTER_DRAIN = false, DUP = (DUP_EPI != 0);
    const float* ssq; bf16_t* Q; bf16_t* K; bf16_t* Vv; const float* qg; const float* kg;
    __device__ __forceinline__ void operator()(const f32x4 (&acc)[2][2][4][2], const Unit& u, int wr, int wc, int fr, int fq) const {
        const int which = u.pn >> 2, h = (u.pn & 3) * 4 + wc;
        bf16_t* base = Q + (ptrdiff_t)(which == 1) * (K - Q) + (ptrdiff_t)(which == 2) * (Vv - Q);
        const float* gp = qg + (ptrdiff_t)(which == 1) * (kg - qg); const float gsc = which == 0 ? QSCALE : 1.0f; const bool nrm = which < 2;
        const f32x4 g00 = *(const f32x4*)(gp + 8 * fq), g01 = *(const f32x4*)(gp + 8 * fq + 4), g10 = *(const f32x4*)(gp + 32 + 8 * fq), g11 = *(const f32x4*)(gp + 32 + 8 * fq + 4);
        float rsv[2][4]; rows_rs(ssq, u.pm * 256 + wr * 64 + fr, fq, rsv);
#pragma unroll
        for (int ai = 0; ai < 2; ++ai)
#pragma unroll
            for (int m = 0; m < 4; ++m) {
                const int row = u.pm * 256 + ai * 128 + wr * 64 + m * 16 + fr;
                const float rs = rsv[ai][m];
                f32x4 v[2][2]; float ss = 0.f;
#pragma unroll
                for (int bj = 0; bj < 2; ++bj)
#pragma unroll
                    for (int n = 0; n < 2; ++n) { v[bj][n] = acc[ai][bj][m][n] * rs; const f32x4 t = v[bj][n]; ss += (t[0] * t[0] + t[1] * t[1]) + (t[2] * t[2] + t[3] * t[3]); }
                ss += __shfl_xor(ss, 16); ss += __shfl_xor(ss, 32);
                const float rn = gsc * __builtin_amdgcn_rsqf(ss * (1.0f / HD) + EPS);
#pragma unroll
                for (int bj = 0; bj < 2; ++bj) {
                    f32x4 a = v[bj][0], b = v[bj][1];
                    if (nrm) { a = a * (bj == 0 ? g00 : g10) * rn; b = b * (bj == 0 ? g01 : g11) * rn; }
                    v4u w; w.x = pk2(a[0], a[1]); w.y = pk2(a[2], a[3]); w.z = pk2(b[0], b[1]); w.w = pk2(b[2], b[3]);
                    *(v4u*)(base + (size_t)row * DM + h * HD + 32 * bj + 8 * fq) = w;
                }
            }
    }
};
struct ZMerge {
    static constexpr bool PERM = true, AFTER_DRAIN = false, DUP = false;
    const float* ssq; const bf16_t* O0; const bf16_t* O1; const bf16_t* O2; const float* lse; bf16_t* Y;
    struct RowIn { v4u a[2], b[2], c[2]; f32x4 sq; float l0, l1, l2; };
    __device__ __forceinline__ void load_row(RowIn& r, int row, int h, int fq) const {
        const size_t off = (size_t)row * DM + h * HD + 8 * fq;
        r.sq = *(const f32x4*)(ssq + (size_t)row * 16 + 4 * fq);
        r.l0 = lse[((size_t)0 * MROWS + row) * 16 + h]; r.l1 = lse[((size_t)1 * MROWS + row) * 16 + h]; r.l2 = lse[((size_t)2 * MROWS + row) * 16 + h];
#pragma unroll
        for (int bj = 0; bj < 2; ++bj) { r.a[bj] = *(const v4u*)(O0 + off + 32 * bj); r.b[bj] = *(const v4u*)(O1 + off + 32 * bj); r.c[bj] = *(const v4u*)(O2 + off + 32 * bj); }
    }
    __device__ __forceinline__ void operator()(const f32x4 (&acc)[2][2][4][2], const Unit& u, int wr, int wc, int fr, int fq) const {
        const int h = u.pn * 4 + wc, row0 = u.pm * 256 + wr * 64 + fr;
        RowIn in[2];
        load_row(in[0], row0, h, fq);
#pragma unroll
        for (int i = 0; i < 8; ++i) {
            const int ai = i >> 2, m = i & 3, row = row0 + ai * 128 + m * 16;
            if (i + 1 < 8) load_row(in[(i + 1) & 1], row0 + ((i + 1) >> 2) * 128 + ((i + 1) & 3) * 16, h, fq);
            const RowIn& r = in[i & 1];
            float tq = (r.sq[0] + r.sq[1]) + (r.sq[2] + r.sq[3]); tq += __shfl_xor(tq, 16); tq += __shfl_xor(tq, 32);
            const float rs = __builtin_amdgcn_rsqf(tq * (1.0f / DM) + EPS);
            const float mx = fmaxf(r.l0, fmaxf(r.l1, r.l2));
            float w0 = __builtin_amdgcn_exp2f(r.l0 - mx), w1 = __builtin_amdgcn_exp2f(r.l1 - mx), w2 = __builtin_amdgcn_exp2f(r.l2 - mx);
            const float inv = __builtin_amdgcn_rcpf(w0 + w1 + w2); w0 *= inv; w1 *= inv; w2 *= inv;
#pragma unroll
            for (int bj = 0; bj < 2; ++bj) {
                const v4u a = r.a[bj], b = r.b[bj], c = r.c[bj];
                float o[8];
#pragma unroll
                for (int k = 0; k < 4; ++k) { o[2 * k] = w0 * bflo(a[k]) + w1 * bflo(b[k]) + w2 * bflo(c[k]); o[2 * k + 1] = w0 * bfhi(a[k]) + w1 * bfhi(b[k]) + w2 * bfhi(c[k]); }
                const f32x4 z0 = acc[ai][bj][m][0] * rs, z1 = acc[ai][bj][m][1] * rs;
                float y[8];
#pragma unroll
                for (int k = 0; k < 4; ++k) { y[k] = o[k] * z0[k] * sigmoidf_(z0[k]); y[4 + k] = o[4 + k] * z1[k] * sigmoidf_(z1[k]); }
                v4u w; w.x = pk2(y[0], y[1]); w.y = pk2(y[2], y[3]); w.z = pk2(y[4], y[5]); w.w = pk2(y[6], y[7]);
                *(v4u*)(Y + (size_t)row * DM + h * HD + 32 * bj + 8 * fq) = w;
            }
        }
    }
};
}

namespace naive {
template <class AL, class BL, class EP>
__device__ __forceinline__ void gemm_tile(LAS float* sm, int K, int row0, const AL& al, const BL& bl, const EP& ep) {
    const int tid = threadIdx.x, tx = tid & 15, ty = tid >> 4;
    LAS float* sA = sm; LAS float* sB = sm + 16 * 132;
    float acc[4][4];
#pragma unroll
    for (int i = 0; i < 4; ++i)
#pragma unroll
        for (int j = 0; j < 4; ++j) acc[i][j] = 0.f;
    for (int k0 = 0; k0 < K; k0 += 16) {
#pragma unroll
        for (int i = 0; i < 4; ++i) { const int idx = tid + 512 * i, r = idx >> 4, kk = idx & 15; sA[kk * 132 + r] = al(row0 + r, k0 + kk); }
#pragma unroll
        for (int i = 0; i < 2; ++i) { const int idx = tid + 512 * i, kk = idx >> 6, c = idx & 63; sB[kk * 68 + c] = bl(k0 + kk, c); }
        __syncthreads();
#pragma unroll
        for (int kk = 0; kk < 16; ++kk) {
            float a[4], b[4];
#pragma unroll
            for (int i = 0; i < 4; ++i) a[i] = sA[kk * 132 + ty * 4 + i];
#pragma unroll
            for (int j = 0; j < 4; ++j) b[j] = sB[kk * 68 + tx + 16 * j];
#pragma unroll
            for (int i = 0; i < 4; ++i)
#pragma unroll
                for (int j = 0; j < 4; ++j) acc[i][j] = fmaf(a[i], b[j], acc[i][j]);
        }
        __syncthreads();
    }
#pragma unroll
    for (int i = 0; i < 4; ++i) ep(row0 + ty * 4 + i, tx, acc[i][0], acc[i][1], acc[i][2], acc[i][3]);
}
struct ALbf { const bf16* A; int ld; __device__ __forceinline__ float operator()(int r, int k) const { return bf2f(A[(size_t)r * ld + k]); } };
__device__ __forceinline__ float red16(float v) { v += __shfl_xor(v, 1); v += __shfl_xor(v, 2); v += __shfl_xor(v, 4); v += __shfl_xor(v, 8); return v; }

struct BLc1 { const float* w; const float* nrm; int ct; __device__ __forceinline__ float operator()(int k, int c) const { return w[(size_t)k * CN + (c >> 4) * CE + ct * 16 + (c & 15)] * nrm[k]; } };
struct EPc1 { const float* ssq; bf16* V; bf16* G; int ct;
    __device__ __forceinline__ void operator()(int row, int tx, float a0, float a1, float a2, float a3) const {
        const float rs = row_rs(ssq, row); const float b = a0 * rs, c = a1 * rs, u = a2 * rs, z = a3 * rs;
        const int e = ct * 16 + tx; V[(size_t)row * CE + e] = (bf16)f2bf(c * u); G[(size_t)row * CE + e] = (bf16)f2bf(b * z * sigmoidf_(z)); } };
__device__ __forceinline__ void c1(LAS float* sm, const bf16* xb, const float* ssq, const float* w, const float* nrm, bf16* V, bf16* G, int bid, int nb) {
    const int nct = CE / 16, ntile = (MROWS / 128) * nct;
    for (int t = bid; t < ntile; t += nb) { const int rt = t / nct, ct = t % nct; gemm_tile(sm, DM, rt * 128, ALbf{xb, DM}, BLc1{w, nrm, ct}, EPc1{ssq, V, G, ct}); }
}
struct BLres { const float* w; int ct; __device__ __forceinline__ float operator()(int k, int c) const { return w[(size_t)k * DM + ct * 64 + c]; } };
struct EPres { const float* xin; float* xout; bf16* xb; float* ssq; int ct;
    __device__ __forceinline__ void operator()(int row, int tx, float a0, float a1, float a2, float a3) const {
        const size_t o = (size_t)row * DM + ct * 64 + tx;
        const float x0 = xin[o] + a0, x1 = xin[o + 16] + a1, x2 = xin[o + 32] + a2, x3 = xin[o + 48] + a3;
        xout[o] = x0; xout[o + 16] = x1; xout[o + 32] = x2; xout[o + 48] = x3;
        xb[o] = (bf16)f2bf(x0); xb[o + 16] = (bf16)f2bf(x1); xb[o + 32] = (bf16)f2bf(x2); xb[o + 48] = (bf16)f2bf(x3);
        const float ss = red16((x0 * x0 + x1 * x1) + (x2 * x2 + x3 * x3));
        if (tx == 0) ssq[(size_t)row * 16 + ct] = ss; } };
__device__ __forceinline__ void resid(LAS float* sm, const bf16* A, int K, const float* w, const float* xin, float* xout, bf16* xb, float* ssq, int bid, int nb) {
    const int ntile = (MROWS / 128) * 16;
    for (int t = bid; t < ntile; t += nb) { const int rt = t / 16, ct = t % 16; gemm_tile(sm, K, rt * 128, ALbf{A, K}, BLres{w, ct}, EPres{xin, xout, xb, ssq, ct}); }
}
struct BLa1 { const float* w; const float* nrm; int col0; __device__ __forceinline__ float operator()(int k, int c) const { return w[(size_t)k * AN + col0 + c] * nrm[k]; } };
struct EPa1 { const float* ssq; bf16* dst; const float* gain; float sc; int h;
    __device__ __forceinline__ void operator()(int row, int tx, float a0, float a1, float a2, float a3) const {
        const float rs = row_rs(ssq, row); float v0 = a0 * rs, v1 = a1 * rs, v2 = a2 * rs, v3 = a3 * rs;
        const float ss = red16((v0 * v0 + v1 * v1) + (v2 * v2 + v3 * v3));
        if (gain) { const float rn = sc / sqrtf(ss * (1.0f / HD) + EPS); v0 *= rn * gain[tx]; v1 *= rn * gain[tx + 16]; v2 *= rn * gain[tx + 32]; v3 *= rn * gain[tx + 48]; }
        const size_t o = (size_t)row * DM + h * HD + tx;
        dst[o] = (bf16)f2bf(v0); dst[o + 16] = (bf16)f2bf(v1); dst[o + 32] = (bf16)f2bf(v2); dst[o + 48] = (bf16)f2bf(v3); } };
__device__ __forceinline__ void a1(LAS float* sm, const bf16* xb, const float* ssq, const float* w, const float* nrm, int g, const float* qg, const float* kg, bf16* Q, bf16* K, bf16* V, int bid, int nb) {
    const int ntile = (MROWS / 128) * 48;
    for (int t = bid; t < ntile; t += nb) { const int rt = t / 48, ct = t % 48, which = ct / 16, h = ct % 16;
        gemm_tile(sm, DM, rt * 128, ALbf{xb, DM}, BLa1{w, nrm, g * 3072 + which * 1024 + h * 64},
                  EPa1{ssq, which == 0 ? Q : (which == 1 ? K : V), which == 0 ? qg : (which == 1 ? kg : nullptr), which == 0 ? QSCALE : 1.0f, h}); }
}
struct EPa3 { const float* ssq; const bf16* O0; const bf16* O1; const bf16* O2; const float* lse; bf16* Y; int h;
    __device__ __forceinline__ void operator()(int row, int tx, float a0, float a1, float a2, float a3) const {
        const float rs = row_rs(ssq, row);
        const float l0 = lse[((size_t)0 * MROWS + row) * 16 + h], l1 = lse[((size_t)1 * MROWS + row) * 16 + h], l2 = lse[((size_t)2 * MROWS + row) * 16 + h];
        const float mx = fmaxf(l0, fmaxf(l1, l2)); float w0 = exp2f(l0 - mx), w1 = exp2f(l1 - mx), w2 = exp2f(l2 - mx); const float inv = 1.0f / (w0 + w1 + w2); w0 *= inv; w1 *= inv; w2 *= inv;
        const float zz[4] = {a0 * rs, a1 * rs, a2 * rs, a3 * rs};
#pragma unroll
        for (int j = 0; j < 4; ++j) { const size_t o = (size_t)row * DM + h * HD + tx + 16 * j;
            const float ov = w0 * bf2f(O0[o]) + w1 * bf2f(O1[o]) + w2 * bf2f(O2[o]); Y[o] = (bf16)f2bf(ov * zz[j] * sigmoidf_(zz[j])); } } };
__device__ __forceinline__ void a3(LAS float* sm, const bf16* xb, const float* ssq, const float* w, const float* nrm, const bf16* O0, const bf16* O1, const bf16* O2, const float* lse, bf16* Y, int bid, int nb) {
    const int ntile = (MROWS / 128) * 16;
    for (int t = bid; t < ntile; t += nb) { const int rt = t / 16, h = t % 16; gemm_tile(sm, DM, rt * 128, ALbf{xb, DM}, BLa1{w, nrm, QKVC + h * 64}, EPa3{ssq, O0, O1, O2, lse, Y, h}); }
}
__device__ __forceinline__ void a2(bf16* QO, const bf16* K, const bf16* V, const float* biasT  , float* lse  , int dil, int gtid, int gthreads) {
    for (int idx = gtid; idx < MROWS * NH; idx += gthreads) {
        const int row = idx >> 4, h = idx & 15, t = row & (SEQ - 1);
        bf16* qp = QO + (size_t)row * DM + h * HD;
        float q[64], o[64];
#pragma unroll
        for (int c = 0; c < 8; ++c) { const v4u w = *(const v4u*)(qp + 8 * c);
#pragma unroll
            for (int i = 0; i < 4; ++i) { q[8 * c + 2 * i] = bflo(w[i]); q[8 * c + 2 * i + 1] = bfhi(w[i]); } }
#pragma unroll
        for (int d = 0; d < 64; ++d) o[d] = 0.f;
        float m = -INFINITY, l = 0.f;
        for (int j = 0; j <= 128; ++j) {
            const int tk = t - dil * j; if (tk < 0) break;
            const size_t ko = (size_t)(row - dil * j) * DM + h * HD;
            float s = 0.f;
#pragma unroll
            for (int c = 0; c < 8; ++c) { const v4u w = *(const v4u*)(K + ko + 8 * c);
#pragma unroll
                for (int i = 0; i < 4; ++i) { s = fmaf(q[8 * c + 2 * i], bflo(w[i]), s); s = fmaf(q[8 * c + 2 * i + 1], bfhi(w[i]), s); } }
            s += biasT[h * 132 + j];
            const float mn = fmaxf(m, s), f = exp2f(m - mn), p = exp2f(s - mn);
            l = l * f + p; m = mn;
#pragma unroll
            for (int c = 0; c < 8; ++c) { const v4u w = *(const v4u*)(V + ko + 8 * c);
#pragma unroll
                for (int i = 0; i < 4; ++i) { o[8 * c + 2 * i] = o[8 * c + 2 * i] * f + p * bflo(w[i]); o[8 * c + 2 * i + 1] = o[8 * c + 2 * i + 1] * f + p * bfhi(w[i]); } }
        }
        const float il = 1.0f / l;
#pragma unroll
        for (int c = 0; c < 8; ++c) { v4u w;
#pragma unroll
            for (int i = 0; i < 4; ++i) w[i] = pk2(o[8 * c + 2 * i] * il, o[8 * c + 2 * i + 1] * il);
            *(v4u*)(qp + 8 * c) = w; }
        lse[(size_t)row * 16 + h] = m + log2f(l);
    }
}
}

template <int MODE> __device__ __forceinline__ int wt_dest_row(int n) {
    if (MODE == 1) { const int type = n >> 11, e = n & 2047, pn = e >> 6, el = e & 63; return 256 * pn + 128 * (type >> 1) + 32 * (el >> 4) + 16 * (type & 1) + (el & 15); }
    if (MODE == 3) { const int blk = n >> 10, r = n & 1023, h = r >> 6, d = r & 63; return blk * 1024 + 256 * (h >> 2) + 128 * (d >> 5) + 32 * (h & 3) + (d & 31); }
    return n;
}
template <int MODE> __device__ __forceinline__ void p0_transpose_item(const float* W, int K, int N, const float* scale, bf16* WT, LAS float* scr  , int item, int lane) {
    const int nblk = N / 64, kb = item / nblk, nb = item % nblk, k0 = 64 * kb, n0 = 64 * nb;
    const int kr = lane >> 4, c4 = lane & 15;
    f32x4 v[16];
#pragma unroll
    for (int i = 0; i < 16; ++i) v[i] = *(const GAS f32x4*)(W + (size_t)(k0 + 4 * i + kr) * N + n0 + 4 * c4);
#pragma unroll
    for (int i = 0; i < 16; ++i) { const float s = scale ? scale[k0 + 4 * i + kr] : 1.0f; LAS float* d = scr + (4 * i + kr) * 65 + 4 * c4;
        d[0] = v[i][0] * s; d[1] = v[i][1] * s; d[2] = v[i][2] * s; d[3] = v[i][3] * s; }
    LDS_WAIT(); asm volatile("" ::: "memory");
    const int c = lane & 7, nl = lane >> 3;
#pragma unroll
    for (int j = 0; j < 8; ++j) { const int n = nl + 8 * j; const LAS float* s = scr + (8 * c) * 65 + n;
        v4u o; o.x = pk2(s[0 * 65], s[1 * 65]); o.y = pk2(s[2 * 65], s[3 * 65]); o.z = pk2(s[4 * 65], s[5 * 65]); o.w = pk2(s[6 * 65], s[7 * 65]);
        *(GAS v4u*)(WT + (size_t)wt_dest_row<MODE>(n0 + n) * K + k0 + 8 * c) = o; }
    LDS_WAIT(); asm volatile("" ::: "memory");
}
struct Ptrs {
    const float *x, *conv_norm, *conv_w_in, *conv_w, *conv_w_out, *attn_norm, *attn_w_in, *q_gain, *k_gain, *attn_w_out, *rel_bias;
    float* out; unsigned char* ws;
};
__device__ __forceinline__ void p0_prologue(const Ptrs& P, LAS unsigned char* lds, int vcu, int G, int wave, int lane, int tid) {
    LAS float* scr = (LAS float*)(lds + wave * 16640);
    const int gw = vcu * 8 + wave, NGW = G * 8;
    bf16* W1 = (bf16*)(P.ws + WS_W1); bf16* W2 = (bf16*)(P.ws + WS_W2); bf16* W3 = (bf16*)(P.ws + WS_W3); bf16* W4 = (bf16*)(P.ws + WS_W4);
    constexpr int I1 = (DM / 64) * (CN / 64), I2 = (CE / 64) * (DM / 64), I3 = (DM / 64) * (AN / 64), I4 = (DM / 64) * (DM / 64), IL = I1 + I2 + I3 + I4;
    for (int it = gw; it < 2 * IL; it += NGW) {
        const int j = it / IL; int r = it % IL;
        if (r < I1) { p0_transpose_item<1>(P.conv_w_in + (size_t)j * DM * CN, DM, CN, P.conv_norm + j * DM, W1 + (size_t)j * CN * DM, scr, r, lane); continue; } r -= I1;
        if (r < I2) { p0_transpose_item<0>(P.conv_w_out + (size_t)j * CE * DM, CE, DM, nullptr, W2 + (size_t)j * DM * CE, scr, r, lane); continue; } r -= I2;
        if (r < I3) { p0_transpose_item<3>(P.attn_w_in + (size_t)j * DM * AN, DM, AN, P.attn_norm + j * DM, W3 + (size_t)j * AN * DM, scr, r, lane); continue; } r -= I3;
        p0_transpose_item<0>(P.attn_w_out + (size_t)j * DM * DM, DM, DM, nullptr, W4 + (size_t)j * DM * DM, scr, r, lane);
    }
    bf16* XB = (bf16*)(P.ws + WS_XB); float* SSQ = (float*)(P.ws + WS_SSQ);
    for (int m = 2 * gw; m < MROWS; m += 2 * NGW) {
        const GAS f32x4* xr = (const GAS f32x4*)(P.x + (size_t)m * DM) + lane;
        GAS v2u* o8 = (GAS v2u*)(XB + (size_t)m * DM) + lane;
        f32x4 v[8];
#pragma unroll
        for (int jj = 0; jj < 8; ++jj) v[jj] = xr[64 * jj];
        float s0 = 0.f, s1 = 0.f;
#pragma unroll
        for (int jj = 0; jj < 8; ++jj) { const f32x4 t = v[jj]; const float q = (t.x * t.x + t.y * t.y) + (t.z * t.z + t.w * t.w); if (jj < 4) s0 += q; else s1 += q;
            v2u w; w.x = pk2(t.x, t.y); w.y = pk2(t.z, t.w); o8[64 * jj] = w; }
        s0 = wave_sum(s0); s1 = wave_sum(s1);
        if (lane < 32) SSQ[(size_t)m * 16 + lane] = lane == 0 ? s0 : (lane == 16 ? s1 : 0.f);
    }
    float* BT = (float*)(P.ws + WS_BIAS);
    for (int i = vcu * 512 + tid; i < NG * NH * 132; i += G * 512) {
        const int g = i / (NH * 132), r = i % (NH * 132), h = r / 132, st = r % 132;
        const int dil = g == 0 ? 1 : (g == 1 ? 4 : 16);
        BT[i] = st <= 128 ? P.rel_bias[t5_bucket(st * dil) * (NG * NH) + g * NH + h] * LOG2E : 0.f;
    }
}
template <bool WRAP> __device__ __forceinline__ void conv_pass(const bf16* V, const bf16* GY, bf16* OUT, const float* cw  , int gtid, int gthreads) {
    for (int idx = gtid; idx < MROWS * (CE / 8); idx += gthreads) {
        const int row = idx / (CE / 8), e0 = (idx % (CE / 8)) * 8, t = row & (SEQ - 1);
        const size_t o = (size_t)row * CE + e0;
        const v4u g = *(const v4u*)(GY + o), v2 = *(const v4u*)(V + o);
        v4u v1 = (v4u){0u, 0u, 0u, 0u}, v0 = (v4u){0u, 0u, 0u, 0u};
        if (t >= 1) v1 = *(const v4u*)(V + o - CE);
        if (t >= 2) v0 = *(const v4u*)(V + o - 2 * CE);
        float w0[8], w1[8], w2[8];
#pragma unroll
        for (int c = 0; c < 2; ++c) { const f32x4 a = *(const f32x4*)(cw + e0 + 4 * c), b = *(const f32x4*)(cw + CE + e0 + 4 * c), d = *(const f32x4*)(cw + 2 * CE + e0 + 4 * c);
#pragma unroll
            for (int i = 0; i < 4; ++i) { w0[4 * c + i] = a[i]; w1[4 * c + i] = b[i]; w2[4 * c + i] = d[i]; } }
        float y[8];
#pragma unroll
        for (int i = 0; i < 4; ++i) {
            y[2 * i] = bflo(g[i]) * (w0[2 * i] * bflo(v0[i]) + w1[2 * i] * bflo(v1[i]) + w2[2 * i] * bflo(v2[i]));
            y[2 * i + 1] = bfhi(g[i]) * (w0[2 * i + 1] * bfhi(v0[i]) + w1[2 * i + 1] * bfhi(v1[i]) + w2[2 * i + 1] * bfhi(v2[i]));
        }
        v4u w; w.x = pk2(y[0], y[1]); w.y = pk2(y[2], y[3]); w.z = pk2(y[4], y[5]); w.w = pk2(y[6], y[7]);
        *(v4u*)(OUT + (WRAP ? (o & (size_t)(16 * 1024 * 1024 - 1)) : o)) = w;
    }
}

__device__ __forceinline__ void conv_fixup(bf16* Y, const float* side, const float* cw, int pm, int tid) {
    if ((pm & 15) == 0) return;
    const int ch = 4 * tid;
    const f32x4 g0 = *(const f32x4*)(side + ((size_t)pm * 6 + 0) * CE + ch), g1 = *(const f32x4*)(side + ((size_t)pm * 6 + 1) * CE + ch);
    const f32x4 c0 = *(const f32x4*)(side + ((size_t)pm * 6 + 2) * CE + ch), c1 = *(const f32x4*)(side + ((size_t)pm * 6 + 3) * CE + ch);
    const f32x4 va = *(const f32x4*)(side + ((size_t)(pm - 1) * 6 + 4) * CE + ch), vb = *(const f32x4*)(side + ((size_t)(pm - 1) * 6 + 5) * CE + ch);
    const f32x4 w0 = *(const f32x4*)(cw + ch), w1 = *(const f32x4*)(cw + CE + ch);
    const f32x4 y0 = g0 * (c0 + w1 * vb + w0 * va), y1 = g1 * (c1 + w0 * vb);
    v2u a, b; a.x = pk2(y0[0], y0[1]); a.y = pk2(y0[2], y0[3]); b.x = pk2(y1[0], y1[1]); b.y = pk2(y1[2], y1[3]);
    *(v2u*)(Y + (size_t)(pm * 256) * CE + ch) = a; *(v2u*)(Y + (size_t)(pm * 256 + 1) * CE + ch) = b;
}

namespace attn {
typedef float f32x16 __attribute__((ext_vector_type(16)));
typedef short s16x4 __attribute__((ext_vector_type(4)));
typedef short v4i16_t __attribute__((ext_vector_type(4)));
constexpr int L_K = 0, L_V = 49152, L_B = 98304, L_O = 118784, L_END = 151552, L_WS = 155648 + 256;
static_assert(L_O + 8 * 4096 == L_END && L_B + 5 * 4096 == L_O, "attention LDS map");
__device__ __forceinline__ int crow(int r, int hi) { return (r & 3) + 8 * (r >> 2) + 4 * hi; }
__device__ __forceinline__ s16x4 vtr(LAS const unsigned char* p) { return __builtin_bit_cast(s16x4, __builtin_amdgcn_ds_read_tr16_b64_v4i16((LAS v4i16_t*)p)); }
__device__ __forceinline__ float swapmax(float m) { auto rr = __builtin_amdgcn_permlane32_swap(__float_as_uint(m), __float_as_uint(m), false, false); return fmaxf(__uint_as_float(rr[0]), __uint_as_float(rr[1])); }
__device__ __forceinline__ float swapsum(float m) { auto rr = __builtin_amdgcn_permlane32_swap(__float_as_uint(m), __float_as_uint(m), false, false); return __uint_as_float(rr[0]) + __uint_as_float(rr[1]); }

#define ATT_BAR() asm volatile("s_waitcnt lgkmcnt(0)\n\ts_barrier" ::: "memory")
__device__ __forceinline__ void glds16(const void* gsrc, unsigned lds_dst) { unsigned keep;
    asm volatile("s_mov_b32 %0, m0\n\ts_mov_b32 m0, %2\n\ts_nop 0\n\tglobal_load_lds_dwordx4 %1, off\n\ts_mov_b32 m0, %0" : "=&s"(keep) : "v"(gsrc), "s"(lds_dst) : "memory"); }
template <int DIL> struct Job {
    int bh, c, n0, h; size_t rowb;
    __device__ __forceinline__ void decode(int id) { constexpr int CPC = (SEQ / DIL) / 256; bh = id >> 4; const int sub = id & 15; c = sub / CPC; n0 = (sub % CPC) * 256; h = bh & 15; rowb = (size_t)(bh >> 4) * SEQ; }
};
template <int DIL, bool ISV> __device__ __forceinline__ void issue_kv(LAS unsigned char* lds, const bf16* src, const Job<DIL>& J, int w, int lane) {
#pragma unroll
    for (int i = 0; i < 6; ++i) {
        const int kb = w * 6 + i, row = kb * 8 + (lane >> 3), pc = lane & 7;
        int pos = J.n0 - 128 + row; pos = pos < 0 ? 0 : pos;
        const size_t ro = (J.rowb + (size_t)pos * DIL + J.c) * DM + J.h * HD;
        const int sw = ISV ? ((((pc >> 2) ^ ((row >> 1) & 1)) * 32) + (pc & 3) * 8) : ((pc ^ ((row >> 1) & 7)) * 8);
        glds16(src + ro + sw, (unsigned)__builtin_amdgcn_readfirstlane((int)((unsigned)(uintptr_t)lds + (ISV ? L_V : L_K) + kb * 1024)));
    }
}
__device__ __forceinline__ void ld16_asm(bf16x8& dst, const bf16* p) { asm volatile("global_load_dwordx4 %0, %1, off" : "=v"(dst) : "v"(p) : "memory"); }

template <int DIL> __device__ __forceinline__ void phase(LAS unsigned char* lds, const bf16* QO, bf16* OUT, const bf16* Kg, const bf16* Vg, const float* biasT  , float* lse  , int vcu, int G) {
    const int tid = threadIdx.x, lane = tid & 63, r32 = lane & 31, hi = lane >> 5;
    const int w = __builtin_amdgcn_readfirstlane(tid >> 6);
    constexpr int NJS = BATCH * NH * 16;
    int id = vcu * 4;
    if (id >= NJS) return;
    Job<DIL> J; J.decode(id);
    bf16x8 q0, q1, q2, q3;
    issue_kv<DIL, false>(lds, Kg, J, w, lane);
    { const bf16* qp = QO + (J.rowb + (size_t)(J.n0 + 32 * w + r32) * DIL + J.c) * DM + J.h * HD + hi * 8; ld16_asm(q0, qp); ld16_asm(q1, qp + 16); ld16_asm(q2, qp + 32); ld16_asm(q3, qp + 48); }
    issue_kv<DIL, true>(lds, Vg, J, w, lane);
    int cur_bh = -1; bool first = true;
    for (;;) {
        const int nid = id + (((id & 3) == 3) ? (G * 4 - 3) : 1);
        const bool has_next = nid < NJS;
        Job<DIL> JN; JN.decode(has_next ? nid : id);
        if (J.bh != cur_bh) {
            cur_bh = J.bh;
#pragma unroll
            for (int i = 0; i < 10; ++i) {
                const int e = tid + 512 * i, j = e >> 10, rem = e & 1023, rg = rem >> 8, ln = (rem & 255) >> 2, i4 = rem & 3;
                const int r = 4 * rg + i4, a = ln & 31, hh = ln >> 5, kk = 32 * j + crow(r, hh), step = 128 + a - kk;
                float val = -INFINITY;
                if (step >= 0 && step <= 128) val = biasT[J.h * 132 + step];
                ((LAS float*)(lds + L_B))[e] = val;
            }
        }
        if (first) { first = false; asm volatile("s_waitcnt vmcnt(6)" : "+v"(q0), "+v"(q1), "+v"(q2), "+v"(q3) :: "memory"); }
        ATT_BAR();
        const int n0 = J.n0, h = J.h, c = J.c; const size_t rowb = J.rowb;
        const size_t qrow = rowb + (size_t)(n0 + 32 * w + r32) * DIL + c;
        const int jstart = (n0 == 0 && w < 4) ? 4 - w : 0;
        f32x16 S[5];
#pragma unroll
        for (int j = 0; j < 5; ++j) {
            if (j < jstart) {
#pragma unroll
                for (int r = 0; r < 16; ++r) S[j][r] = -INFINITY;
            } else {
                f32x16 cinit;
#pragma unroll
                for (int rg = 0; rg < 4; ++rg) { const f32x4 t = *(const LAS f32x4*)(lds + L_B + j * 4096 + rg * 1024 + lane * 16); cinit[4 * rg] = t[0]; cinit[4 * rg + 1] = t[1]; cinit[4 * rg + 2] = t[2]; cinit[4 * rg + 3] = t[3]; }
#pragma unroll
                for (int d0 = 0; d0 < 4; ++d0) {
                    const bf16x8 kf = *(const LAS bf16x8*)(lds + L_K + (32 * w + 32 * j + r32) * 128 + (((2 * d0 + hi) ^ ((r32 >> 1) & 7)) * 16));
                    cinit = __builtin_amdgcn_mfma_f32_32x32x16_bf16(kf, d0 == 0 ? q0 : (d0 == 1 ? q1 : (d0 == 2 ? q2 : q3)), cinit, 0, 0, 0);
                }
                S[j] = cinit;
            }
        }
        ATT_BAR();
        bf16x8 n0q, n1q, n2q, n3q;
        if (has_next) {
            issue_kv<DIL, false>(lds, Kg, JN, w, lane);
            const bf16* qp = QO + (JN.rowb + (size_t)(JN.n0 + 32 * w + r32) * DIL + JN.c) * DM + JN.h * HD + hi * 8; ld16_asm(n0q, qp); ld16_asm(n1q, qp + 16); ld16_asm(n2q, qp + 32); ld16_asm(n3q, qp + 48);
        }
        float m = -INFINITY;
#pragma unroll
        for (int j = 0; j < 5; ++j)
#pragma unroll
            for (int r = 0; r < 16; ++r) m = fmaxf(m, S[j][r]);
        m = swapmax(m);
        float lsum = 0.f;
#pragma unroll
        for (int j = 0; j < 5; ++j)
#pragma unroll
            for (int r = 0; r < 16; ++r) { const float p = __builtin_amdgcn_exp2f(S[j][r] - m); S[j][r] = p; lsum += p; }
        lsum = swapsum(lsum);
        if (has_next) asm volatile("s_waitcnt vmcnt(10)" ::: "memory"); else asm volatile("s_waitcnt vmcnt(0)" ::: "memory");
        ATT_BAR();
        f32x16 o[2];
#pragma unroll
        for (int r = 0; r < 16; ++r) { o[0][r] = 0.f; o[1][r] = 0.f; }
        const int vq = (lane & 15) >> 2, vx = (vq >> 1) & 1;
        const LAS unsigned char* vrow = lds + L_V + (32 * w + 4 * hi + vq) * 128 + ((lane >> 4) & 1) * 32 + (lane & 3) * 8;
        const LAS unsigned char* vbh[2] = {vrow + vx * 64, vrow + (1 - vx) * 64};
#pragma unroll
        for (int j = 0; j < 5; ++j)
#pragma unroll
            for (int s = 0; s < 2; ++s) {
                v4u pw; pw.x = pk2(S[j][8 * s], S[j][8 * s + 1]); pw.y = pk2(S[j][8 * s + 2], S[j][8 * s + 3]); pw.z = pk2(S[j][8 * s + 4], S[j][8 * s + 5]); pw.w = pk2(S[j][8 * s + 6], S[j][8 * s + 7]);
                const bf16x8 pa = __builtin_bit_cast(bf16x8, pw);
#pragma unroll
                for (int d0 = 0; d0 < 2; ++d0) {
                    const s16x4 lo = vtr(vbh[d0] + (32 * j + 16 * s) * 128), hh = vtr(vbh[d0] + (32 * j + 16 * s + 8) * 128);
                    const bf16x8 vf = (bf16x8){lo[0], lo[1], lo[2], lo[3], hh[0], hh[1], hh[2], hh[3]};
                    o[d0] = __builtin_amdgcn_mfma_f32_32x32x16_bf16(pa, vf, o[d0], 0, 0, 0);
                }
            }
        ATT_BAR();
        if (has_next) issue_kv<DIL, true>(lds, Vg, JN, w, lane);
        LAS float* wsf = (LAS float*)(lds + L_WS) + w * 64;
        if (hi == 0) { wsf[r32] = lsum; lse[qrow * 16 + h] = m + log2f(lsum); }
        asm volatile("s_waitcnt lgkmcnt(0)" ::: "memory");
        float rli[16];
#pragma unroll
        for (int r = 0; r < 16; ++r) rli[r] = __builtin_amdgcn_rcpf(wsf[crow(r, hi)]);
        LAS bf16* stg = (LAS bf16*)(lds + L_O) + w * 2048;
#pragma unroll
        for (int r = 0; r < 16; ++r) { const int orow = crow(r, hi);
#pragma unroll
            for (int d0 = 0; d0 < 2; ++d0) stg[orow * 64 + d0 * 32 + r32] = (bf16)(pk2(o[d0][r] * rli[r], 0.f) & 0xffffu); }
        asm volatile("s_waitcnt lgkmcnt(0)" ::: "memory");
#pragma unroll
        for (int i = 0; i < 4; ++i) { const int row = i * 8 + (lane >> 3), ch = lane & 7; const v4u v = *(const LAS v4u*)(stg + row * 64 + ch * 8);
            *(v4u*)(OUT + (rowb + (size_t)(n0 + 32 * w + row) * DIL + c) * DM + h * HD + ch * 8) = v; }
        if (!has_next) break;
        asm volatile("s_waitcnt vmcnt(6)" : "+v"(n0q), "+v"(n1q), "+v"(n2q), "+v"(n3q) :: "memory");
        id = nid; J = JN; q0 = n0q; q1 = n1q; q2 = n2q; q3 = n3q;
    }
    asm volatile("s_waitcnt vmcnt(0) lgkmcnt(0)\n\ts_barrier" ::: "memory");
}
#undef ATT_BAR
}

#ifndef OPT_C1
#define OPT_C1 0
#endif
#ifndef OPT_RES
#define OPT_RES 0
#endif
#ifndef OPT_A1
#define OPT_A1 0
#endif
#ifndef OPT_A2
#define OPT_A2 0
#endif
#ifndef OPT_A3
#define OPT_A3 0
#endif
#ifndef DUP_A2
#define DUP_A2 0
#endif
#ifndef DUP_A1
#define DUP_A1 0
#endif
#ifndef DUP_C1
#define DUP_C1 0
#endif
#ifndef DUP_A3
#define DUP_A3 0
#endif
#ifndef DUP_P0
#define DUP_P0 0
#endif
#ifndef DUP_C3
#define DUP_C3 0
#endif
#ifndef DUP_C2
#define DUP_C2 0
#endif
#ifndef DUP_BAR
#define DUP_BAR 0
#endif
#ifndef FUSE_CONV
#define FUSE_CONV 0
#endif
#ifndef MK_PER_PHASE
#define MK_PER_PHASE 1
#endif
constexpr int LDS_BYTES = 159744;
constexpr int XCH_OFF = 131072;
constexpr int MISC_OFF = 155648;
struct Args { const float* in[11]; float* out; unsigned char* ws; int ph_lo, ph_hi; };

template <int PH> __device__ __forceinline__ void run_phase(const Args& args, LAS unsigned char* lds) {
    const int tid = threadIdx.x, lane = tid & 63, wave = __builtin_amdgcn_readfirstlane(tid >> 6);
    const int G = gridDim.x, bx = blockIdx.x, vcu = (G % 8 == 0) ? (bx % 8) * (G / 8) + bx / 8 : bx;
    unsigned char* ws = args.ws;
    float* SSQ = (float*)(ws + WS_SSQ); bf16* XB = (bf16*)(ws + WS_XB);
    LAS float* smf = (LAS float*)lds;
    const int gtid = vcu * 512 + tid, gthreads = G * 512;
    (void)lane; (void)wave; (void)smf; (void)gtid; (void)gthreads; (void)SSQ; (void)XB;
    if constexpr (PH == 0) {
        Ptrs P;
        P.x = args.in[0]; P.conv_norm = args.in[1]; P.conv_w_in = args.in[2]; P.conv_w = args.in[3]; P.conv_w_out = args.in[4]; P.attn_norm = args.in[5];
        P.attn_w_in = args.in[6]; P.q_gain = args.in[7]; P.k_gain = args.in[8]; P.attn_w_out = args.in[9]; P.rel_bias = args.in[10]; P.out = args.out; P.ws = args.ws;
#if DUP_P0
        p0_prologue(P, lds, vcu, G, wave, lane, tid);
#endif
        p0_prologue(P, lds, vcu, G, wave, lane, tid);
    } else {
        constexpr int p = PH - 1, j = p / 11, s = p % 11;
        if constexpr (s == 0) {
            bf16* CV = (bf16*)(ws + WS_CV); bf16* CG = (bf16*)(ws + WS_CG);
#if OPT_C1
            pg8::Gemm g{XB, (const bf16*)(ws + WS_W1) + (size_t)j * CN * DM, MROWS, CN, DM}; pg8::StaticOrder S; S.init(MROWS, CN, G, bx);
#if FUSE_CONV
            epi::ConvFused E{SSQ, CG, args.in[3] + (size_t)j * 3 * CE, (float*)(ws + WS_SIDE), lds + XCH_OFF};
            pg8::gemm_phase<epi::ConvFused, pg8::StaticOrder, true, true>(lds, g, S, E);
#else
            epi::ConvIn E{SSQ, CV, CG};
#if DUP_C1
            pg8::gemm_phase<epi::ConvIn, pg8::StaticOrder, true, true>(lds, g, S, E);
#endif
            pg8::gemm_phase<epi::ConvIn, pg8::StaticOrder, true, true>(lds, g, S, E);
#endif
#else
            naive::c1(smf, XB, SSQ, args.in[2] + (size_t)j * DM * CN, args.in[1] + j * DM, CV, CG, bx, G);
#endif
        } else if constexpr (s == 1) {
#if !(FUSE_CONV && OPT_C1)
#if DUP_C2
            conv_pass<true>((const bf16*)(ws + WS_CV), (bf16*)(ws + WS_CG), (bf16*)(ws + WS_END), args.in[3] + (size_t)j * 3 * CE, gtid, gthreads);
#endif
            conv_pass<false>((const bf16*)(ws + WS_CV), (bf16*)(ws + WS_CG), (bf16*)(ws + WS_CG), args.in[3] + (size_t)j * 3 * CE, gtid, gthreads);
#endif
        } else if constexpr (s == 2 || s == 10) {
            const bf16* A = (const bf16*)(ws + (s == 2 ? WS_CG : WS_Y)); constexpr int K = s == 2 ? CE : DM;
            const float* xin = (j == 0 && s == 2) ? args.in[0] : args.out;
#if OPT_RES
            pg8::Gemm g{A, (const bf16*)(ws + (s == 2 ? WS_W2 : WS_W4)) + (size_t)j * DM * K, MROWS, DM, K}; pg8::StaticOrder S; S.init(MROWS, DM, G, bx);
#if FUSE_CONV && OPT_C1 && !defined(NOFIX)
            if constexpr (s == 2) { pg8::Unit fu; for (int i = 0; S.next(i, fu); ++i) conv_fixup((bf16*)(ws + WS_CG), (const float*)(ws + WS_SIDE), args.in[3] + (size_t)j * 3 * CE, fu.pm, tid);
                asm volatile("s_waitcnt vmcnt(0)" ::: "memory"); __syncthreads(); }
#endif
            epi::Resid E{xin, args.out, XB, SSQ};
#if DUP_C3
            if constexpr (j == 0 && s == 2) pg8::gemm_phase<epi::Resid, pg8::StaticOrder, false, true>(lds, g, S, E);
#endif
            pg8::gemm_phase<epi::Resid, pg8::StaticOrder, false, true>(lds, g, S, E);
#else
            naive::resid(smf, A, K, s == 2 ? args.in[4] + (size_t)j * CE * DM : args.in[9] + (size_t)j * DM * DM, xin, args.out, XB, SSQ, bx, G);
#endif
        } else if constexpr (s == 9) {
            const bf16* O0 = (const bf16*)(ws + WS_QO); const bf16* O1 = O0 + (size_t)MROWS * DM; const bf16* O2 = O1 + (size_t)MROWS * DM;
            float* LSE = (float*)(ws + WS_LSE); bf16* YB = (bf16*)(ws + WS_Y);
#if OPT_A3
            pg8::Gemm g{XB, (const bf16*)(ws + WS_W3) + (size_t)j * AN * DM + (size_t)QKVC * DM, MROWS, DM, DM}; pg8::StaticOrder S; S.init(MROWS, DM, G, bx);
            epi::ZMerge E{SSQ, O0, O1, O2, LSE, YB};
#if DUP_A3
            pg8::gemm_phase<epi::ZMerge, pg8::StaticOrder, false, true>(lds, g, S, E);
#endif
            pg8::gemm_phase<epi::ZMerge, pg8::StaticOrder, false, true>(lds, g, S, E);
#else
            naive::a3(smf, XB, SSQ, args.in[6] + (size_t)j * DM * AN, args.in[5] + j * DM, O0, O1, O2, LSE, YB, bx, G);
#endif
        } else {
            constexpr int g = (s - 3) >> 1; bf16* QO = (bf16*)(ws + WS_QO) + (size_t)g * MROWS * DM;
            bf16* KB = (bf16*)(ws + WS_K); bf16* VB = (bf16*)(ws + WS_V);
            if constexpr (((s - 3) & 1) == 0) {
#if OPT_A1
                pg8::Gemm gm{XB, (const bf16*)(ws + WS_W3) + (size_t)j * AN * DM + (size_t)g * 3072 * DM, MROWS, 3072, DM}; pg8::StaticOrder S; S.init(MROWS, 3072, G, bx);
                epi::QKV E{SSQ, QO, KB, VB, args.in[7] + (j * NG + g) * HD, args.in[8] + (j * NG + g) * HD};
#if DUP_A1
                pg8::gemm_phase<epi::QKV, pg8::StaticOrder, true, true>(lds, gm, S, E);
#endif
                pg8::gemm_phase<epi::QKV, pg8::StaticOrder, true, true>(lds, gm, S, E);
#else
                naive::a1(smf, XB, SSQ, args.in[6] + (size_t)j * DM * AN, args.in[5] + j * DM, g, args.in[7] + (j * NG + g) * HD, args.in[8] + (j * NG + g) * HD, QO, KB, VB, bx, G);
#endif
            } else {
                constexpr int dil = g == 0 ? 1 : (g == 1 ? 4 : 16);
                float* LSE = (float*)(ws + WS_LSE); const float* BT = (const float*)(ws + WS_BIAS);
#if OPT_A2
#if DUP_A2
                attn::phase<dil>(lds, QO, (bf16*)(ws + WS_END), KB, VB, BT + g * NH * 132, LSE + (size_t)g * MROWS * 16, vcu, G);
#endif
                attn::phase<dil>(lds, QO, QO, KB, VB, BT + g * NH * 132, LSE + (size_t)g * MROWS * 16, vcu, G);
#else
                naive::a2(QO, KB, VB, BT + g * NH * 132, LSE + (size_t)g * MROWS * 16, dil, gtid, gthreads);
#endif
            }
        }
    }
}

__global__ void __launch_bounds__(512, 2) mk_fwd(Args args) {
    extern __shared__ __attribute__((aligned(16))) unsigned char lds_raw[];
    LAS unsigned char* lds = (LAS unsigned char*)lds_raw;
    volatile LAS unsigned* MISC = (volatile LAS unsigned*)(lds + MISC_OFF);
    for (int u = threadIdx.x; u < (LDS_BYTES - MISC_OFF) / 4; u += 512) ((LAS unsigned*)(lds + MISC_OFF))[u] = 0u;
    __syncthreads();
    gu32* ctl = (gu32*)(args.ws + WS_CTL);
    XcdBarrier bar; bar.bar = (unsigned*)(ctl + CW_BAR); bar.x = 0; bar.st = nullptr;
    const int lo = args.ph_lo, hi = args.ph_hi;
    if (hi - lo > 1) bar = xcd_barrier_post((unsigned*)(ctl + CW_BAR), MISC + 8);
#ifdef KEEP_NOP_BAR
#define PH_NOP(k) 0
#else
#define PH_NOP(k) (FUSE_CONV && OPT_C1 && (k) > 0 && (((k) - 1) % 11) == 1)
#endif
#if DUP_BAR
#define RUN(k) if (lo <= (k) && (k) < hi && !PH_NOP(k)) { run_phase<(k)>(args, lds); if ((k) + 1 < hi) { xcd_barrier(bar); xcd_barrier(bar); } }
#else
#define RUN(k) if (lo <= (k) && (k) < hi && !PH_NOP(k)) { run_phase<(k)>(args, lds); if ((k) + 1 < hi) xcd_barrier(bar); }
#endif
    RUN(0) RUN(1) RUN(2) RUN(3) RUN(4) RUN(5) RUN(6) RUN(7) RUN(8) RUN(9) RUN(10) RUN(11)
    RUN(12) RUN(13) RUN(14) RUN(15) RUN(16) RUN(17) RUN(18) RUN(19) RUN(20) RUN(21) RUN(22)
#undef RUN
}

extern "C" void kernel_launch(void* const* d_in, const int* in_sizes, int n_in, void* d_out, int out_size, void* d_ws, size_t ws_size, hipStream_t stream) {
    static int grid = 0;
    if (grid == 0) {
        if (n_in != 11 || in_sizes[0] != MROWS * DM || out_size != MROWS * DM || ws_size < WS_END) { fprintf(stderr, "kernel_launch: unexpected shapes (n_in %d, ws %zu); nothing launched\n", n_in, ws_size); grid = -1; return; }
        int dev = 0, cus = 0, per_cu = 0;
        if (hipGetDevice(&dev) != hipSuccess || hipDeviceGetAttribute(&cus, hipDeviceAttributeMultiprocessorCount, dev) != hipSuccess) { grid = -1; return; }
        if (hipFuncSetAttribute((const void*)mk_fwd, hipFuncAttributeMaxDynamicSharedMemorySize, LDS_BYTES) != hipSuccess) { fprintf(stderr, "kernel_launch: hipFuncSetAttribute failed\n"); grid = -1; return; }
        if (hipOccupancyMaxActiveBlocksPerMultiprocessor(&per_cu, (const void*)mk_fwd, 512, LDS_BYTES) != hipSuccess || per_cu < 1) { fprintf(stderr, "kernel_launch: occupancy query says %d blocks per CU; nothing launched\n", per_cu); (void)hipGetLastError(); grid = -1; return; }
        grid = cus;
    }
    if (grid < 0) return;
    (void)hipMemsetAsync((char*)d_ws + WS_CTL, 0, CTL_ZERO_BYTES, stream);
    Args a{};
    for (int i = 0; i < 11; ++i) a.in[i] = (const float*)d_in[i];
    a.out = (float*)d_out; a.ws = (unsigned char*)d_ws;
#if MK_PER_PHASE
    for (int ph = 0; ph < NPHASE; ++ph) { a.ph_lo = ph; a.ph_hi = ph + 1; hipLaunchKernelGGL(mk_fwd, dim3(grid), dim3(512), LDS_BYTES, stream, a); }
#else
    a.ph_lo = 0; a.ph_hi = NPHASE; hipLaunchKernelGGL(mk_fwd, dim3(grid), dim3(512), LDS_BYTES, stream, a);
#endif
}
```

```cpp
#include <hip/hip_runtime.h>
#include <cstdio>
#include <cstdint>
#include <cmath>
#define MK_PER_PHASE 0
#define OPT_C1 1
#define OPT_RES 1
#define OPT_A1 1
#define OPT_A3 1
#define OPT_A2 1
#define FUSE_CONV 1
#define RES_BF16 1
namespace pg8 {
#define PG8_LAS __attribute__((address_space(3)))
typedef unsigned short bf16_t;
typedef short bf16x8 __attribute__((ext_vector_type(8)));
typedef float f32x4 __attribute__((ext_vector_type(4)));
typedef unsigned u32x4 __attribute__((ext_vector_type(4)));
constexpr int BM = 256, BK = 64, HALF = 128, HTB = HALF * BK * 2  , STAGE_BYTES = 8 * HTB, NXCD = 8, WGM = 8;

__host__ __device__ __forceinline__ int lds_byte(int r, int c) { const int st = (r >> 4) * 2 + (c >> 5), rr = r & 15, cc = c & 31, ob = rr * 64 + cc * 2; return st * 1024 + (ob ^ (((ob >> 9) & 1) << 5)); }
__host__ __device__ __forceinline__ void stage_rc(int b, int& R, int& C) { const int st = b / 1024, sb = b % 1024, swz = sb ^ (((sb >> 9) & 1) << 5); R = (st >> 1) * 16 + swz / 64; C = (st & 1) * 32 + (swz % 64) / 2; }
__host__ __device__ __forceinline__ int perm32(int rho) { const int n = rho >> 4, i = rho & 15; return 8 * (i >> 2) + 4 * n + (i & 3); }

struct Unit { int pm, pn; };
struct Gemm { const bf16_t* A; const bf16_t* Bt; int M, N, K; };

struct StaticOrder {
    int nM, nN, nwg, G, c;
    __host__ __device__ void init(int M, int N, int G_, int c_) { nM = M / BM; nN = N / BM; nwg = nM * nN; G = G_; c = c_; }
    __host__ __device__ bool next(int i, Unit& u) const {
        const long L = (long)i * G + c; if (L >= nwg) return false;
        int wgid = (int)L; { const int q = nwg / NXCD, r = nwg % NXCD, xcd = wgid % NXCD, off = wgid / NXCD; wgid = (xcd < r ? xcd * (q + 1) : r * (q + 1) + (xcd - r) * q) + off; }
        const int nig = WGM * nN, gid = wgid / nig, fm = gid * WGM, gsz = (nM - fm) < WGM ? (nM - fm) : WGM;
        u.pm = fm + ((wgid % nig) % gsz); u.pn = (wgid % nig) / gsz; return true;
    }
    __device__ __forceinline__ void a_ready(const Unit&) const {}
    __device__ __forceinline__ void done(const Unit&) const {}
};

__device__ __forceinline__ unsigned cvt_pk_bf16(float lo, float hi) { unsigned r; asm volatile("v_cvt_pk_bf16_f32 %0, %1, %2" : "=v"(r) : "v"(lo), "v"(hi)); return r; }
typedef float f32x2 __attribute__((ext_vector_type(2)));

template <class Epi, class Sched, bool ALIGN_EPI = false, bool SP2 = false>
__device__ __forceinline__ void gemm_phase(PG8_LAS unsigned char* lds, const Gemm g, const Sched& S, const Epi& E) {
    const int tid = threadIdx.x, wid = __builtin_amdgcn_readfirstlane(tid >> 6), lane = tid & 63, wr = wid >> 2, wc = wid & 3, fr = lane & 15, fq = lane >> 4;
    const int K = g.K, nt = K / BK;
    unsigned voffA[2], voffB[2];
#pragma unroll
    for (int i = 0; i < 2; ++i) { int R, C; stage_rc(tid * 16 + i * 8192, R, C); const int Rb = Epi::PERM ? ((R & ~31) + perm32(R & 31)) : R;
        voffA[i] = (unsigned)(R * K + C) * 2u; voffB[i] = (unsigned)(Rb * K + C) * 2u; }
    const size_t kstep = (size_t)(BK * 2);
    const size_t hstep = (size_t)HALF * K * 2;
    const size_t tstep = 2 * hstep;
    const unsigned ldsw = (unsigned)wid * 1024u;
    const int aoff = lds_byte(wr * 64 + fr, fq * 8), boff = lds_byte(wc * 32 + fr, fq * 8);
#define PG8_SA(b, h) (((b) * 2 + (h)) * HTB)
#define PG8_SB(b, h) ((4 + (b) * 2 + (h)) * HTB)
#define PG8_STAGE(bufoff, gbase, voff) do { _Pragma("unroll") for (int _i = 0; _i < 2; ++_i) \
        __builtin_amdgcn_global_load_lds((const unsigned*)((const char*)(gbase) + (voff)[_i]), (PG8_LAS unsigned*)(lds + (bufoff) + ldsw + _i * 8192), 16, 0, 0); } while (0)
#define PG8_LDA(dst, b, h) do { _Pragma("unroll") for (int m = 0; m < 4; ++m) _Pragma("unroll") for (int k = 0; k < 2; ++k) dst[m][k] = *(const PG8_LAS bf16x8*)(lds + PG8_SA(b, h) + aoff + m * 2048 + k * 1024); } while (0)
#define PG8_LDB(dst, b, h) do { _Pragma("unroll") for (int n = 0; n < 2; ++n) _Pragma("unroll") for (int k = 0; k < 2; ++k) dst[n][k] = *(const PG8_LAS bf16x8*)(lds + PG8_SB(b, h) + boff + n * 2048 + k * 1024); } while (0)
#define PG8_MMA(ai, bj, At, Bt) do { __builtin_amdgcn_s_setprio(1); _Pragma("unroll") for (int m = 0; m < 4; ++m) _Pragma("unroll") for (int n = 0; n < 2; ++n) _Pragma("unroll") for (int k = 0; k < 2; ++k) \
        acc[ai][bj][m][n] = __builtin_amdgcn_mfma_f32_16x16x32_bf16(Bt[n][k], At[m][k], acc[ai][bj][m][n], 0, 0, 0); __builtin_amdgcn_s_setprio(0); } while (0)
#define PG8_WAIT_V(n) asm volatile("s_waitcnt vmcnt(" #n ")" ::: "memory")
#define PG8_WAIT_L(n) asm volatile("s_waitcnt lgkmcnt(" #n ")" ::: "memory")
#define PG8_BAR __builtin_amdgcn_s_barrier()
#define PG8_SCHED __builtin_amdgcn_sched_barrier(0)
    Unit cur, nxt; int ui = 0;
    if (!S.next(0, cur)) return;
    f32x4 acc[2][2][4][2];
#pragma unroll
    for (int a = 0; a < 2; ++a)
#pragma unroll
        for (int b = 0; b < 2; ++b)
#pragma unroll
            for (int m = 0; m < 4; ++m)
#pragma unroll
                for (int n = 0; n < 2; ++n) acc[a][b][m][n] = (f32x4){0.f, 0.f, 0.f, 0.f};
    bf16x8 At[4][2], B0[2][2], B1[2][2];
    const char* cA = (const char*)g.A + (size_t)cur.pm * tstep; const char* cB = (const char*)g.Bt + (size_t)cur.pn * tstep;
    S.a_ready(cur);
    if constexpr (SP2) {
        PG8_STAGE(PG8_SB(0, 0), cB, voffB); PG8_STAGE(PG8_SB(0, 1), cB + hstep, voffB); PG8_STAGE(PG8_SA(0, 0), cA, voffA); PG8_STAGE(PG8_SA(0, 1), cA + hstep, voffA);
        if (wr == 1) PG8_BAR;
        PG8_WAIT_V(2); PG8_BAR;
        PG8_STAGE(PG8_SB(1, 0), cB + kstep, voffB); PG8_STAGE(PG8_SA(1, 0), cA + kstep, voffA); PG8_STAGE(PG8_SB(1, 1), cB + hstep + kstep, voffB);
        PG8_WAIT_V(6); PG8_BAR;
    } else {
        PG8_STAGE(PG8_SB(0, 0), cB, voffB); PG8_STAGE(PG8_SA(0, 0), cA, voffA); PG8_STAGE(PG8_SB(0, 1), cB + hstep, voffB); PG8_STAGE(PG8_SA(0, 1), cA + hstep, voffA);
        if (wr == 1) PG8_BAR;
        PG8_WAIT_V(4); PG8_BAR;
        PG8_STAGE(PG8_SB(1, 0), cB + kstep, voffB); PG8_STAGE(PG8_SA(1, 0), cA + kstep, voffA); PG8_STAGE(PG8_SB(1, 1), cB + hstep + kstep, voffB);
        PG8_WAIT_V(6); PG8_BAR;
    }
    for (;;) {
        const bool has_next = S.next(ui + 1, nxt);
        const char* nA = has_next ? (const char*)g.A + (size_t)nxt.pm * tstep : cA; const char* nB = has_next ? (const char*)g.Bt + (size_t)nxt.pn * tstep : cB;
        for (int t = 0; t < nt; t += 2) {
            const bool last = (t == nt - 2);
            const char* a1 = cA + (size_t)(t + 1) * kstep;
            const char* a2 = last ? nA : cA + (size_t)(t + 2) * kstep; const char* b2 = last ? nB : cB + (size_t)(t + 2) * kstep;
            const char* a3 = a2 + kstep; const char* b3 = b2 + kstep;
            if (last && has_next) S.a_ready(nxt);
            if constexpr (SP2) {
            PG8_LDB(B0, 0, 0); PG8_LDB(B1, 0, 1); PG8_SCHED; PG8_LDA(At, 0, 0); PG8_STAGE(PG8_SA(1, 1), a1 + hstep, voffA);
            PG8_WAIT_V(8); PG8_WAIT_L(0); PG8_BAR; PG8_MMA(0, 0, At, B0); PG8_MMA(0, 1, At, B1); PG8_BAR; PG8_SCHED;
            PG8_LDA(At, 0, 1); PG8_STAGE(PG8_SB(0, 0), b2, voffB); PG8_STAGE(PG8_SB(0, 1), b2 + hstep, voffB); PG8_STAGE(PG8_SA(0, 0), a2, voffA);
            PG8_WAIT_V(8); PG8_WAIT_L(0); PG8_BAR; PG8_MMA(1, 0, At, B0); PG8_MMA(1, 1, At, B1); PG8_BAR; PG8_SCHED;
            PG8_LDB(B0, 1, 0); PG8_LDB(B1, 1, 1); PG8_SCHED; PG8_LDA(At, 1, 0); PG8_STAGE(PG8_SA(0, 1), a2 + hstep, voffA);
            PG8_WAIT_V(8); PG8_WAIT_L(0); PG8_BAR; PG8_MMA(0, 0, At, B0); PG8_MMA(0, 1, At, B1); PG8_BAR; PG8_SCHED;
            PG8_LDA(At, 1, 1); PG8_STAGE(PG8_SB(1, 0), b3, voffB); PG8_STAGE(PG8_SB(1, 1), b3 + hstep, voffB); PG8_STAGE(PG8_SA(1, 0), a3, voffA);
            PG8_WAIT_V(8); PG8_WAIT_L(0); PG8_BAR; PG8_MMA(1, 0, At, B0); PG8_MMA(1, 1, At, B1); PG8_BAR; PG8_SCHED;
            } else {
            PG8_LDB(B0, 0, 0); PG8_SCHED; PG8_LDA(At, 0, 0); PG8_STAGE(PG8_SA(1, 1), a1 + hstep, voffA);
            PG8_WAIT_L(8); PG8_BAR; PG8_WAIT_L(0); PG8_MMA(0, 0, At, B0); PG8_BAR; PG8_SCHED;
            PG8_LDB(B1, 0, 1); PG8_STAGE(PG8_SB(0, 0), b2, voffB);
            PG8_BAR; PG8_WAIT_L(0); PG8_MMA(0, 1, At, B1); PG8_BAR;
            PG8_LDA(At, 0, 1); PG8_STAGE(PG8_SA(0, 0), a2, voffA);
            PG8_BAR; PG8_WAIT_L(0); PG8_MMA(1, 0, At, B0); PG8_BAR; PG8_SCHED;
            PG8_STAGE(PG8_SB(0, 1), b2 + hstep, voffB);
            PG8_WAIT_V(6); PG8_BAR; PG8_MMA(1, 1, At, B1); PG8_BAR;
            PG8_LDB(B0, 1, 0); PG8_SCHED; PG8_LDA(At, 1, 0); PG8_STAGE(PG8_SA(0, 1), a2 + hstep, voffA);
            PG8_WAIT_L(8); PG8_BAR; PG8_WAIT_L(0); PG8_MMA(0, 0, At, B0); PG8_BAR; PG8_SCHED;
            PG8_LDB(B1, 1, 1); PG8_STAGE(PG8_SB(1, 0), b3, voffB);
            PG8_BAR; PG8_WAIT_L(0); PG8_MMA(0, 1, At, B1); PG8_BAR;
            PG8_LDA(At, 1, 1); PG8_STAGE(PG8_SA(1, 0), a3, voffA);
            PG8_BAR; PG8_WAIT_L(0); PG8_MMA(1, 0, At, B0); PG8_BAR; PG8_SCHED;
            PG8_STAGE(PG8_SB(1, 1), b3 + hstep, voffB);
            PG8_WAIT_V(6); PG8_BAR; PG8_MMA(1, 1, At, B1); PG8_BAR;
            }
        }
        if constexpr (ALIGN_EPI) { if (wr == 0) PG8_BAR; }
        if constexpr (!Epi::AFTER_DRAIN) { E(acc, cur, wr, wc, fr, fq); if constexpr (Epi::DUP) { asm volatile("" ::: "memory"); E(acc, cur, wr, wc, fr, fq); } S.done(cur); }
        if (!has_next) break;
#pragma unroll
        for (int a = 0; a < 2; ++a)
#pragma unroll
            for (int b = 0; b < 2; ++b)
#pragma unroll
                for (int m = 0; m < 4; ++m)
#pragma unroll
                    for (int n = 0; n < 2; ++n) acc[a][b][m][n] = (f32x4){0.f, 0.f, 0.f, 0.f};
        cur = nxt; cA = nA; cB = nB; ++ui;
        if constexpr (ALIGN_EPI) { if (wr == 1) PG8_BAR; }
    }
    PG8_WAIT_V(0);
    if constexpr (!ALIGN_EPI) { if (wr == 0) PG8_BAR; }
    PG8_BAR;
    if constexpr (Epi::AFTER_DRAIN) { E.fused(acc, cur, wr, wc, fr, fq, lds, wid, lane); S.done(cur); }
#undef PG8_SA
#undef PG8_SB
#undef PG8_STAGE
#undef PG8_LDA
#undef PG8_LDB
#undef PG8_MMA
#undef PG8_WAIT_V
#undef PG8_WAIT_L
#undef PG8_BAR
#undef PG8_SCHED
}
}

constexpr int BATCH = 4, SEQ = 4096, DM = 1024, MROWS = BATCH * SEQ;
constexpr int CE = 2048, CN = 4 * CE;
constexpr int NH = 16, HD = 64, NG = 3, QKVC = 9216, AN = 10240;
constexpr float EPS = 1e-6f, LOG2E = 1.4426950408889634f, QSCALE = 0.125f * LOG2E;
constexpr int NPHASE = 23;

constexpr size_t MiB = 1u << 20;
constexpr size_t WS_CTL = 0, CTL_ZERO_BYTES = 1 * MiB;
constexpr size_t WS_SSQ = 1 * MiB;
constexpr size_t WS_W1 = 2 * MiB, WS_W2 = 34 * MiB, WS_W3 = 42 * MiB, WS_W4 = 82 * MiB;
constexpr size_t WS_LSE = 86 * MiB;
constexpr size_t WS_BIAS = 89 * MiB;
constexpr size_t WS_XB = 90 * MiB;
constexpr size_t WS_CV = 122 * MiB, WS_CG = 186 * MiB;
constexpr size_t WS_QO = 122 * MiB;
constexpr size_t WS_K = 218 * MiB, WS_V = 250 * MiB, WS_Y = WS_K;
constexpr size_t WS_END = 282 * MiB;
constexpr size_t WS_SIDE = 316 * MiB;
constexpr int CW_TMO = 0, CW_BAR = 4096;

#define GAS __attribute__((address_space(1)))
#define LAS __attribute__((address_space(3)))
typedef unsigned short bf16;
typedef unsigned v4u __attribute__((ext_vector_type(4)));
typedef unsigned v2u __attribute__((ext_vector_type(2)));
typedef float f32x4 __attribute__((ext_vector_type(4)));
typedef short bf16x8 __attribute__((ext_vector_type(8)));
typedef GAS unsigned gu32;
#define RLX_AGENT __ATOMIC_RELAXED, __HIP_MEMORY_SCOPE_AGENT
#define LDS_WAIT() asm volatile("s_waitcnt lgkmcnt(0)" ::: "memory")
#define VM_WAIT() asm volatile("s_waitcnt vmcnt(0)" ::: "memory")
__device__ __forceinline__ unsigned f2bf(float f) { unsigned u = __builtin_bit_cast(unsigned, f); return (u + 0x7fffu + ((u >> 16) & 1u)) >> 16; }
typedef float f32x2_t __attribute__((ext_vector_type(2))); typedef __bf16 bf16x2_t __attribute__((ext_vector_type(2)));
__device__ __forceinline__ unsigned pk2(float lo, float hi) { f32x2_t v = {lo, hi}; bf16x2_t b = __builtin_convertvector(v, bf16x2_t); return __builtin_bit_cast(unsigned, b); }
__device__ __forceinline__ float bf2f(unsigned h) { return __builtin_bit_cast(float, h << 16); }
__device__ __forceinline__ float bflo(unsigned w) { return __builtin_bit_cast(float, w << 16); }
__device__ __forceinline__ float bfhi(unsigned w) { return __builtin_bit_cast(float, w & 0xffff0000u); }
__device__ __forceinline__ float sigmoidf_(float z) { return __builtin_amdgcn_rcpf(1.0f + __builtin_amdgcn_exp2f(-z * LOG2E)); }
__device__ __forceinline__ float row_rs(const float* ssq, int row) {
    const f32x4* p = (const f32x4*)(ssq + (size_t)row * 16);
    const f32x4 s = (p[0] + p[1]) + (p[2] + p[3]);
    return 1.0f / sqrtf(((s.x + s.y) + (s.z + s.w)) * (1.0f / DM) + EPS);
}
__device__ __forceinline__ float wave_sum(float v) {
#pragma unroll
    for (int o = 1; o < 64; o <<= 1) v += __shfl_xor(v, o);
    return v;
}
__device__ __forceinline__ int t5_bucket(int d) {
    if (d < 16) return d;
    int b = 15;
    b += (d >= 16); b += (d >= 22); b += (d >= 30); b += (d >= 40); b += (d >= 54); b += (d >= 73); b += (d >= 99); b += (d >= 134);
    b += (d >= 182); b += (d >= 246); b += (d >= 332); b += (d >= 450); b += (d >= 609); b += (d >= 825); b += (d >= 1117); b += (d >= 1513);
    return b;
}

#define XB_TMO      128
#define XB_XCNT(j)  (256  + 64 * (j))
#define XB_XSUB(j)  (1280 + 64 * (j))
#define XB_XGEN(j)  (2304 + 64 * (j))
#define XB_TOP      3328
#define XB_TOPGEN   3392
#define XCD_BAR_WORDS 3456
#define XB_SPIN_CAP (1u << 18)

__device__ __forceinline__ unsigned xb_ld(unsigned* p)              { return __hip_atomic_load(p, __ATOMIC_RELAXED, __HIP_MEMORY_SCOPE_AGENT); }
__device__ __forceinline__ unsigned xb_add(unsigned* p, unsigned v) { return __hip_atomic_fetch_add(p, v, __ATOMIC_RELAXED, __HIP_MEMORY_SCOPE_AGENT); }
__device__ __forceinline__ unsigned xb_xcc_id() { return (unsigned)__builtin_amdgcn_s_getreg((3 << 11) | 20) & 0xFu; }
#define XB_SPIN(cond, bar) do { unsigned _sp = 0; while (cond) { __builtin_amdgcn_s_sleep(1); \
    if ((++_sp & 255u) == 0u) { if (xb_ld(&(bar)[XB_TMO])) break; if (_sp > XB_SPIN_CAP) { atomicAdd(&(bar)[XB_TMO], 1u); break; } } } } while (0)

struct XcdBarrier {
    unsigned* bar; unsigned x;
    volatile LAS unsigned* st;
};

__device__ __forceinline__ XcdBarrier xcd_barrier_post(unsigned* bar, volatile LAS unsigned* st) {
    XcdBarrier b; b.bar = bar; b.x = xb_xcc_id(); b.st = st;
    if (threadIdx.x == 0) (void)xb_add(&bar[XB_XCNT(b.x)], 1u);
    return b;
}
__device__ __forceinline__ void xcd_barrier_complete(unsigned* bar, unsigned x, unsigned& nloc, unsigned& nx) {
    const unsigned G = gridDim.x * gridDim.y * gridDim.z;
    unsigned sum, cnt, mine, sp = 0u;
    for (;;) {
        sum = 0u; cnt = 0u; mine = 0u;
#pragma unroll
        for (unsigned j = 0; j < 16; ++j) { const unsigned c = xb_ld(&bar[XB_XCNT(j)]); sum += c; cnt += (c > 0u) ? 1u : 0u; mine = (j == x) ? c : mine; }
        if (sum == G) break;
        __builtin_amdgcn_s_sleep(1);
        if ((++sp & 255u) == 0u) { if (xb_ld(&bar[XB_TMO])) break; if (sp > XB_SPIN_CAP) { atomicAdd(&bar[XB_TMO], 1u); break; } }
    }
    nloc = mine > 0u ? mine : 1u; nx = cnt > 0u ? cnt : 1u;
}

__device__ __forceinline__ void xcd_barrier(const XcdBarrier& b) {
    asm volatile("s_waitcnt vmcnt(0)" ::: "memory");
    __syncthreads();
    if (threadIdx.x == 0) {
        unsigned* bar = b.bar;
        __builtin_amdgcn_s_waitcnt(0);
        unsigned nloc = b.st[0], nx = b.st[1];
        if (nloc == 0u) { xcd_barrier_complete(bar, b.x, nloc, nx); b.st[0] = nloc; b.st[1] = nx; }
        const unsigned old = xb_add(&bar[XB_XSUB(b.x)], 1u);
        const unsigned gen = old / nloc;
        if (old + 1u == (gen + 1u) * nloc) {
            __builtin_amdgcn_fence(__ATOMIC_RELEASE, "agent");
            asm volatile("s_waitcnt vmcnt(0)" ::: "memory");
            const unsigned og = xb_add(&bar[XB_TOP], 1u);
            const unsigned tg = og / nx;
            if (og + 1u == (tg + 1u) * nx) xb_add(&bar[XB_TOPGEN], 1u);
            else XB_SPIN(xb_ld(&bar[XB_TOPGEN]) == tg, bar);
            __builtin_amdgcn_fence(__ATOMIC_ACQUIRE, "agent");
            xb_add(&bar[XB_XGEN(b.x)], 1u);
            asm volatile("s_waitcnt vmcnt(0)" ::: "memory");
        } else {
            XB_SPIN(xb_ld(&bar[XB_XGEN(b.x)]) == gen, bar);
            __builtin_amdgcn_fence(__ATOMIC_ACQUIRE, "agent");
            asm volatile("s_waitcnt vmcnt(0)" ::: "memory");
        }
    }
    __syncthreads();
}

#ifndef DUP_EPI
#define DUP_EPI 0
#endif
namespace epi {
using pg8::Unit; using pg8::bf16_t;

__device__ __forceinline__ void rows_rs(const float* ssq, int row0  , int fq, float (&rs)[2][4]) {
    f32x4 pp[2][4];
#pragma unroll
    for (int ai = 0; ai < 2; ++ai)
#pragma unroll
        for (int m = 0; m < 4; ++m) pp[ai][m] = *(const f32x4*)(ssq + (size_t)(row0 + ai * 128 + m * 16) * 16 + 4 * fq);
#pragma unroll
    for (int ai = 0; ai < 2; ++ai)
#pragma unroll
        for (int m = 0; m < 4; ++m) { float t = (pp[ai][m][0] + pp[ai][m][1]) + (pp[ai][m][2] + pp[ai][m][3]); t += __shfl_xor(t, 16); t += __shfl_xor(t, 32); rs[ai][m] = __builtin_amdgcn_rsqf(t * (1.0f / DM) + EPS); }
}
struct ConvIn {
    static constexpr bool PERM = false, AFTER_DRAIN = false, DUP = (DUP_EPI != 0);
    const float* ssq; bf16_t* V; bf16_t* G;
    __device__ __forceinline__ void operator()(const f32x4 (&acc)[2][2][4][2], const Unit& u, int wr, int wc, int fr, int fq) const {
        const int ch0 = u.pn * 64 + wc * 16 + 4 * fq;
        float rsv[2][4]; rows_rs(ssq, u.pm * 256 + wr * 64 + fr, fq, rsv);
#pragma unroll
        for (int ai = 0; ai < 2; ++ai)
#pragma unroll
            for (int m = 0; m < 4; ++m) {
                const int row = u.pm * 256 + ai * 128 + wr * 64 + m * 16 + fr;
                const float rs = rsv[ai][m];
                const f32x4 b = acc[ai][0][m][0] * rs, c = acc[ai][0][m][1] * rs, uu = acc[ai][1][m][0] * rs, z = acc[ai][1][m][1] * rs;
                const f32x4 v = c * uu;
                f32x4 g;
#pragma unroll
                for (int i = 0; i < 4; ++i) g[i] = b[i] * z[i] * sigmoidf_(z[i]);
                v2u wv, wg; wv.x = pk2(v[0], v[1]); wv.y = pk2(v[2], v[3]); wg.x = pk2(g[0], g[1]); wg.y = pk2(g[2], g[3]);
                *(v2u*)(V + (size_t)row * CE + ch0) = wv;
                *(v2u*)(G + (size_t)row * CE + ch0) = wg;
            }
    }
};

struct ConvFused {
    static constexpr bool PERM = false, AFTER_DRAIN = false, DUP = false;
    const float* ssq; bf16_t* Y; const float* cw; float* side; LAS unsigned char* xch;
    static __device__ __forceinline__ f32x4 unpk(v2u p) { return (f32x4){bflo(p.x), bfhi(p.x), bflo(p.y), bfhi(p.y)}; }
    __device__ __forceinline__ void operator()(const f32x4 (&acc)[2][2][4][2], const Unit& u, int wr, int wc, int fr, int fq) const {
        const int ch0 = u.pn * 64 + wc * 16 + 4 * fq;
        float rsv[2][4]; rows_rs(ssq, u.pm * 256 + wr * 64 + fr, fq, rsv);
        const f32x4 w0 = *(const f32x4*)(cw + ch0), w1 = *(const f32x4*)(cw + CE + ch0), w2 = *(const f32x4*)(cw + 2 * CE + ch0);
        v2u vq[2][4]; f32x4 gt[2][4];
#pragma unroll
        for (int ai = 0; ai < 2; ++ai)
#pragma unroll
            for (int m = 0; m < 4; ++m) {
                const float rs = rsv[ai][m];
                const f32x4 b = acc[ai][0][m][0] * rs, c = acc[ai][0][m][1] * rs, uu = acc[ai][1][m][0] * rs, z = acc[ai][1][m][1] * rs;
                const f32x4 v = c * uu;
                vq[ai][m].x = pk2(v[0], v[1]); vq[ai][m].y = pk2(v[2], v[3]);
#pragma unroll
                for (int i = 0; i < 4; ++i) gt[ai][m][i] = b[i] * z[i] * sigmoidf_(z[i]);
            }
        LAS unsigned char* my = xch + (wr * 4 + wc) * 2720 + fq * 8;
        LAS unsigned char* other = xch + ((1 - wr) * 4 + wc) * 2720 + fq * 8;
        const bool seq_start = (u.pm & 15) == 0;
        if (fr >= 14) {
            const int hr = fr - 14;
            *(LAS v2u*)(other + ((wr == 0 ? 0 : 66) + hr) * 40) = vq[0][3];
            if (wr == 0) *(LAS v2u*)(other + (66 + hr) * 40) = vq[1][3];
            else *(f32x4*)(side + ((size_t)u.pm * 6 + 4 + hr) * CE + ch0) = unpk(vq[1][3]);
        }
        if (wr == 0 && fr < 2) *(LAS v2u*)(my + fr * 40) = (v2u){0u, 0u};
#pragma unroll
        for (int m = 0; m < 4; ++m) *(LAS v2u*)(my + (2 + 16 * m + fr) * 40) = vq[0][m];
        asm volatile("s_waitcnt lgkmcnt(0)\n\ts_barrier" ::: "memory");
#pragma unroll
        for (int ai = 0; ai < 2; ++ai) {
            if (ai == 1) {
#pragma unroll
                for (int m = 0; m < 4; ++m) *(LAS v2u*)(my + (2 + 16 * m + fr) * 40) = vq[1][m];
                asm volatile("s_waitcnt lgkmcnt(0)" ::: "memory");
            }
#pragma unroll
            for (int m = 0; m < 4; ++m) {
                const int k = 16 * m + fr;
                int r1 = k + 1, r2 = k;
                if (ai == 1) { if (k < 1) r1 = 67; if (k < 2) r2 = 66 + k; }
                const f32x4 p1 = unpk(*(const LAS v2u*)(my + r1 * 40)), p2 = unpk(*(const LAS v2u*)(my + r2 * 40)), v = unpk(vq[ai][m]);
#ifdef DBG_NOPREV
                const f32x4 cv = w2 * v + (w1 * p1 + w0 * p2) * 0.0f;
#else
                const f32x4 cv = w2 * v + w1 * p1 + w0 * p2;
#endif
#ifdef DBG_Y0
                const f32x4 y = gt[ai][m] * cv * 0.0f;
#else
                const f32x4 y = gt[ai][m] * cv;
#endif
                const int row = u.pm * 256 + ai * 128 + wr * 64 + k;
                v2u wy; wy.x = pk2(y[0], y[1]); wy.y = pk2(y[2], y[3]);
                *(v2u*)(Y + (size_t)row * CE + ch0) = wy;
                if (ai == 0 && m == 0 && wr == 0 && fr < 2 && !seq_start) {
                    *(f32x4*)(side + ((size_t)u.pm * 6 + fr) * CE + ch0) = gt[0][0];
                    *(f32x4*)(side + ((size_t)u.pm * 6 + 2 + fr) * CE + ch0) = cv;
                }
            }
        }
    }
};
struct Resid {
    static constexpr bool PERM = false, AFTER_DRAIN = false, DUP = false;
    const float* xin; float* xout; bf16_t* xb; float* ssq;
    __device__ __forceinline__ void operator()(const f32x4 (&acc)[2][2][4][2], const Unit& u, int wr, int wc, int fr, int fq) const {
        const int col0 = u.pn * 256 + wc * 32 + 4 * fq;
        const size_t off0 = (size_t)(u.pm * 256 + wr * 64 + fr) * DM + col0;
        f32x4 pre[4][2][2];
#pragma unroll
        for (int i = 0; i < 4; ++i)
#pragma unroll
            for (int bj = 0; bj < 2; ++bj)
#pragma unroll
                for (int n = 0; n < 2; ++n) pre[i][bj][n] = *(const f32x4*)(xin + off0 + (size_t)(16 * i) * DM + bj * 128 + n * 16);
#pragma unroll
        for (int i = 0; i < 8; ++i) {
            const int ai = i >> 2, m = i & 3;
            const size_t off = off0 + (size_t)(ai * 128 + m * 16) * DM;
            float ss = 0.f; f32x4 xn[2][2];
#pragma unroll
            for (int bj = 0; bj < 2; ++bj)
#pragma unroll
                for (int n = 0; n < 2; ++n) { xn[bj][n] = pre[i & 3][bj][n] + acc[ai][bj][m][n]; const f32x4 t = xn[bj][n]; ss += (t[0] * t[0] + t[1] * t[1]) + (t[2] * t[2] + t[3] * t[3]); }
            if (i < 4) {
#pragma unroll
                for (int bj = 0; bj < 2; ++bj)
#pragma unroll
                    for (int n = 0; n < 2; ++n) pre[i & 3][bj][n] = *(const f32x4*)(xin + off + (size_t)128 * DM + bj * 128 + n * 16);
            }
#pragma unroll
            for (int bj = 0; bj < 2; ++bj)
#pragma unroll
                for (int n = 0; n < 2; ++n) {
                    *(f32x4*)(xout + off + bj * 128 + n * 16) = xn[bj][n];
                    v2u w; w.x = pk2(xn[bj][n][0], xn[bj][n][1]); w.y = pk2(xn[bj][n][2], xn[bj][n][3]);
                    *(v2u*)(xb + off + bj * 128 + n * 16) = w;
                }
            ss += __shfl_xor(ss, 16); ss += __shfl_xor(ss, 32);
            if (fq == 0) ssq[(size_t)(u.pm * 256 + ai * 128 + wr * 64 + m * 16 + fr) * 16 + u.pn * 4 + wc] = ss;
        }
    }
};
template <int MODE> struct ResidB {
    static constexpr bool PERM = false, AFTER_DRAIN = false, DUP = false;
    const float* xin; float* xout; bf16_t* xb; float* ssq;
    __device__ __forceinline__ void operator()(const f32x4 (&acc)[2][2][4][2], const Unit& u, int wr, int wc, int fr, int fq) const {
        const int col0 = u.pn * 256 + wc * 32 + 4 * fq;
        const size_t off0 = (size_t)(u.pm * 256 + wr * 64 + fr) * DM + col0;
        if constexpr (MODE == 0) {
            f32x4 pre[4][2][2];
#pragma unroll
            for (int i = 0; i < 4; ++i)
#pragma unroll
                for (int bj = 0; bj < 2; ++bj)
#pragma unroll
                    for (int n = 0; n < 2; ++n) pre[i][bj][n] = *(const f32x4*)(xin + off0 + (size_t)(16 * i) * DM + bj * 128 + n * 16);
#pragma unroll
            for (int i = 0; i < 8; ++i) {
                const int ai = i >> 2, m = i & 3;
                const size_t off = off0 + (size_t)(ai * 128 + m * 16) * DM;
                float ss = 0.f; f32x4 xn[2][2];
#pragma unroll
                for (int bj = 0; bj < 2; ++bj)
#pragma unroll
                    for (int n = 0; n < 2; ++n) { xn[bj][n] = pre[i & 3][bj][n] + acc[ai][bj][m][n]; const f32x4 t = xn[bj][n]; ss += (t[0] * t[0] + t[1] * t[1]) + (t[2] * t[2] + t[3] * t[3]); }
                if (i < 4) {
#pragma unroll
                    for (int bj = 0; bj < 2; ++bj)
#pragma unroll
                        for (int n = 0; n < 2; ++n) pre[i & 3][bj][n] = *(const f32x4*)(xin + off + (size_t)128 * DM + bj * 128 + n * 16);
                }
#pragma unroll
                for (int bj = 0; bj < 2; ++bj)
#pragma unroll
                    for (int n = 0; n < 2; ++n) { v2u w; w.x = pk2(xn[bj][n][0], xn[bj][n][1]); w.y = pk2(xn[bj][n][2], xn[bj][n][3]); *(v2u*)(xb + off + bj * 128 + n * 16) = w; }
                ss += __shfl_xor(ss, 16); ss += __shfl_xor(ss, 32);
                if (fq == 0) ssq[(size_t)(u.pm * 256 + ai * 128 + wr * 64 + m * 16 + fr) * 16 + u.pn * 4 + wc] = ss;
            }
        } else {
            v2u pre[8][2][2];
#pragma unroll
            for (int i = 0; i < 8; ++i)
#pragma unroll
                for (int bj = 0; bj < 2; ++bj)
#pragma unroll
                    for (int n = 0; n < 2; ++n) pre[i][bj][n] = *(const v2u*)(xb + off0 + (size_t)((i >> 2) * 128 + (i & 3) * 16) * DM + bj * 128 + n * 16);
#pragma unroll
            for (int i = 0; i < 8; ++i) {
                const int ai = i >> 2, m = i & 3;
                const size_t off = off0 + (size_t)(ai * 128 + m * 16) * DM;
                float ss = 0.f;
#pragma unroll
                for (int bj = 0; bj < 2; ++bj)
#pragma unroll
                    for (int n = 0; n < 2; ++n) {
                        const v2u p = pre[i][bj][n];
                        const f32x4 t = (f32x4){bflo(p.x), bfhi(p.x), bflo(p.y), bfhi(p.y)} + acc[ai][bj][m][n];
                        if constexpr (MODE == 2) { *(f32x4*)(xout + off + bj * 128 + n * 16) = t; }
                        else { ss += (t[0] * t[0] + t[1] * t[1]) + (t[2] * t[2] + t[3] * t[3]); v2u w; w.x = pk2(t[0], t[1]); w.y = pk2(t[2], t[3]); *(v2u*)(xb + off + bj * 128 + n * 16) = w; }
                    }
                if constexpr (MODE != 2) {
                    ss += __shfl_xor(ss, 16); ss += __shfl_xor(ss, 32);
                    if (fq == 0) ssq[(size_t)(u.pm * 256 + ai * 128 + wr * 64 + m * 16 + fr) * 16 + u.pn * 4 + wc] = ss;
                }
            }
        }
    }
};
struct QKV {
    static constexpr bool PERM = true, AFTER_DRAIN = false, DUP = (DUP_EPI != 0);
    const float* ssq; bf16_t* Q; bf16_t* K; bf16_t* Vv; const float* qg; const float* kg;
    __device__ __forceinline__ void operator()(const f32x4 (&acc)[2][2][4][2], const Unit& u, int wr, int wc, int fr, int fq) const {
        const int which = u.pn >> 2, h = (u.pn & 3) * 4 + wc;
        bf16_t* base = Q + (ptrdiff_t)(which == 1) * (K - Q) + (ptrdiff_t)(which == 2) * (Vv - Q);
        const float* gp = qg + (ptrdiff_t)(which == 1) * (kg - qg); const float gsc = which == 0 ? QSCALE : 1.0f; const bool nrm = which < 2;
        const f32x4 g00 = *(const f32x4*)(gp + 8 * fq), g01 = *(const f32x4*)(gp + 8 * fq + 4), g10 = *(const f32x4*)(gp + 32 + 8 * fq), g11 = *(const f32x4*)(gp + 32 + 8 * fq + 4);
        float rsv[2][4]; rows_rs(ssq, u.pm * 256 + wr * 64 + fr, fq, rsv);
#pragma unroll
        for (int ai = 0; ai < 2; ++ai)
#pragma unroll
            for (int m = 0; m < 4; ++m) {
                const int row = u.pm * 256 + ai * 128 + wr * 64 + m * 16 + fr;
                const float rs = rsv[ai][m];
                f32x4 v[2][2]; float ss = 0.f;
#pragma unroll
                for (int bj = 0; bj < 2; ++bj)
#pragma unroll
                    for (int n = 0; n < 2; ++n) { v[bj][n] = acc[ai][bj][m][n] * rs; const f32x4 t = v[bj][n]; ss += (t[0] * t[0] + t[1] * t[1]) + (t[2] * t[2] + t[3] * t[3]); }
                ss += __shfl_xor(ss, 16); ss += __shfl_xor(ss, 32);
                const float rn = gsc * __builtin_amdgcn_rsqf(ss * (1.0f / HD) + EPS);
#pragma unroll
                for (int bj = 0; bj < 2; ++bj) {
                    f32x4 a = v[bj][0], b = v[bj][1];
                    if (nrm) { a = a * (bj == 0 ? g00 : g10) * rn; b = b * (bj == 0 ? g01 : g11) * rn; }
                    v4u w; w.x = pk2(a[0], a[1]); w.y = pk2(a[2], a[3]); w.z = pk2(b[0], b[1]); w.w = pk2(b[2], b[3]);
                    *(v4u*)(base + (size_t)row * DM + h * HD + 32 * bj + 8 * fq) = w;
                }
            }
    }
};
struct ZMerge {
    static constexpr bool PERM = true, AFTER_DRAIN = false, DUP = false;
    const float* ssq; const bf16_t* O0; const bf16_t* O1; const bf16_t* O2; const float* lse; bf16_t* Y;
    struct RowIn { v4u a[2], b[2], c[2]; f32x4 sq; float l0, l1, l2; };
    __device__ __forceinline__ void load_row(RowIn& r, int row, int h, int fq) const {
        const size_t off = (size_t)row * DM + h * HD + 8 * fq;
        r.sq = *(const f32x4*)(ssq + (size_t)row * 16 + 4 * fq);
        r.l0 = lse[((size_t)0 * MROWS + row) * 16 + h]; r.l1 = lse[((size_t)1 * MROWS + row) * 16 + h]; r.l2 = lse[((size_t)2 * MROWS + row) * 16 + h];
#pragma unroll
        for (int bj = 0; bj < 2; ++bj) { r.a[bj] = *(const v4u*)(O0 + off + 32 * bj); r.b[bj] = *(const v4u*)(O1 + off + 32 * bj); r.c[bj] = *(const v4u*)(O2 + off + 32 * bj); }
    }
    __device__ __forceinline__ void operator()(const f32x4 (&acc)[2][2][4][2], const Unit& u, int wr, int wc, int fr, int fq) const {
        const int h = u.pn * 4 + wc, row0 = u.pm * 256 + wr * 64 + fr;
        RowIn in[2];
        load_row(in[0], row0, h, fq);
#pragma unroll
        for (int i = 0; i < 8; ++i) {
            const int ai = i >> 2, m = i & 3, row = row0 + ai * 128 + m * 16;
            if (i + 1 < 8) load_row(in[(i + 1) & 1], row0 + ((i + 1) >> 2) * 128 + ((i + 1) & 3) * 16, h, fq);
            const RowIn& r = in[i & 1];
            float tq = (r.sq[0] + r.sq[1]) + (r.sq[2] + r.sq[3]); tq += __shfl_xor(tq, 16); tq += __shfl_xor(tq, 32);
            const float rs = __builtin_amdgcn_rsqf(tq * (1.0f / DM) + EPS);
            const float mx = fmaxf(r.l0, fmaxf(r.l1, r.l2));
            float w0 = __builtin_amdgcn_exp2f(r.l0 - mx), w1 = __builtin_amdgcn_exp2f(r.l1 - mx), w2 = __builtin_amdgcn_exp2f(r.l2 - mx);
            const float inv = __builtin_amdgcn_rcpf(w0 + w1 + w2); w0 *= inv; w1 *= inv; w2 *= inv;
#pragma unroll
            for (int bj = 0; bj < 2; ++bj) {
                const v4u a = r.a[bj], b = r.b[bj], c = r.c[bj];
                float o[8];
#pragma unroll
                for (int k = 0; k < 4; ++k) { o[2 * k] = w0 * bflo(a[k]) + w1 * bflo(b[k]) + w2 * bflo(c[k]); o[2 * k + 1] = w0 * bfhi(a[k]) + w1 * bfhi(b[k]) + w2 * bfhi(c[k]); }
                const f32x4 z0 = acc[ai][bj][m][0] * rs, z1 = acc[ai][bj][m][1] * rs;
                float y[8];
#pragma unroll
                for (int k = 0; k < 4; ++k) { y[k] = o[k] * z0[k] * sigmoidf_(z0[k]); y[4 + k] = o[4 + k] * z1[k] * sigmoidf_(z1[k]); }
                v4u w; w.x = pk2(y[0], y[1]); w.y = pk2(y[2], y[3]); w.z = pk2(y[4], y[5]); w.w = pk2(y[6], y[7]);
                *(v4u*)(Y + (size_t)row * DM + h * HD + 32 * bj + 8 * fq) = w;
            }
        }
    }
};
}

namespace naive {
template <class AL, class BL, class EP>
__device__ __forceinline__ void gemm_tile(LAS float* sm, int K, int row0, const AL& al, const BL& bl, const EP& ep) {
    const int tid = threadIdx.x, tx = tid & 15, ty = tid >> 4;
    LAS float* sA = sm; LAS float* sB = sm + 16 * 132;
    float acc[4][4];
#pragma unroll
    for (int i = 0; i < 4; ++i)
#pragma unroll
        for (int j = 0; j < 4; ++j) acc[i][j] = 0.f;
    for (int k0 = 0; k0 < K; k0 += 16) {
#pragma unroll
        for (int i = 0; i < 4; ++i) { const int idx = tid + 512 * i, r = idx >> 4, kk = idx & 15; sA[kk * 132 + r] = al(row0 + r, k0 + kk); }
#pragma unroll
        for (int i = 0; i < 2; ++i) { const int idx = tid + 512 * i, kk = idx >> 6, c = idx & 63; sB[kk * 68 + c] = bl(k0 + kk, c); }
        __syncthreads();
#pragma unroll
        for (int kk = 0; kk < 16; ++kk) {
            float a[4], b[4];
#pragma unroll
            for (int i = 0; i < 4; ++i) a[i] = sA[kk * 132 + ty * 4 + i];
#pragma unroll
            for (int j = 0; j < 4; ++j) b[j] = sB[kk * 68 + tx + 16 * j];
#pragma unroll
            for (int i = 0; i < 4; ++i)
#pragma unroll
                for (int j = 0; j < 4; ++j) acc[i][j] = fmaf(a[i], b[j], acc[i][j]);
        }
        __syncthreads();
    }
#pragma unroll
    for (int i = 0; i < 4; ++i) ep(row0 + ty * 4 + i, tx, acc[i][0], acc[i][1], acc[i][2], acc[i][3]);
}
struct ALbf { const bf16* A; int ld; __device__ __forceinline__ float operator()(int r, int k) const { return bf2f(A[(size_t)r * ld + k]); } };
__device__ __forceinline__ float red16(float v) { v += __shfl_xor(v, 1); v += __shfl_xor(v, 2); v += __shfl_xor(v, 4); v += __shfl_xor(v, 8); return v; }

struct BLc1 { const float* w; const float* nrm; int ct; __device__ __forceinline__ float operator()(int k, int c) const { return w[(size_t)k * CN + (c >> 4) * CE + ct * 16 + (c & 15)] * nrm[k]; } };
struct EPc1 { const float* ssq; bf16* V; bf16* G; int ct;
    __device__ __forceinline__ void operator()(int row, int tx, float a0, float a1, float a2, float a3) const {
        const float rs = row_rs(ssq, row); const float b = a0 * rs, c = a1 * rs, u = a2 * rs, z = a3 * rs;
        const int e = ct * 16 + tx; V[(size_t)row * CE + e] = (bf16)f2bf(c * u); G[(size_t)row * CE + e] = (bf16)f2bf(b * z * sigmoidf_(z)); } };
__device__ __forceinline__ void c1(LAS float* sm, const bf16* xb, const float* ssq, const float* w, const float* nrm, bf16* V, bf16* G, int bid, int nb) {
    const int nct = CE / 16, ntile = (MROWS / 128) * nct;
    for (int t = bid; t < ntile; t += nb) { const int rt = t / nct, ct = t % nct; gemm_tile(sm, DM, rt * 128, ALbf{xb, DM}, BLc1{w, nrm, ct}, EPc1{ssq, V, G, ct}); }
}
struct BLres { const float* w; int ct; __device__ __forceinline__ float operator()(int k, int c) const { return w[(size_t)k * DM + ct * 64 + c]; } };
struct EPres { const float* xin; float* xout; bf16* xb; float* ssq; int ct;
    __device__ __forceinline__ void operator()(int row, int tx, float a0, float a1, float a2, float a3) const {
        const size_t o = (size_t)row * DM + ct * 64 + tx;
        const float x0 = xin[o] + a0, x1 = xin[o + 16] + a1, x2 = xin[o + 32] + a2, x3 = xin[o + 48] + a3;
        xout[o] = x0; xout[o + 16] = x1; xout[o + 32] = x2; xout[o + 48] = x3;
        xb[o] = (bf16)f2bf(x0); xb[o + 16] = (bf16)f2bf(x1); xb[o + 32] = (bf16)f2bf(x2); xb[o + 48] = (bf16)f2bf(x3);
        const float ss = red16((x0 * x0 + x1 * x1) + (x2 * x2 + x3 * x3));
        if (tx == 0) ssq[(size_t)row * 16 + ct] = ss; } };
__device__ __forceinline__ void resid(LAS float* sm, const bf16* A, int K, const float* w, const float* xin, float* xout, bf16* xb, float* ssq, int bid, int nb) {
    const int ntile = (MROWS / 128) * 16;
    for (int t = bid; t < ntile; t += nb) { const int rt = t / 16, ct = t % 16; gemm_tile(sm, K, rt * 128, ALbf{A, K}, BLres{w, ct}, EPres{xin, xout, xb, ssq, ct}); }
}
struct BLa1 { const float* w; const float* nrm; int col0; __device__ __forceinline__ float operator()(int k, int c) const { return w[(size_t)k * AN + col0 + c] * nrm[k]; } };
struct EPa1 { const float* ssq; bf16* dst; const float* gain; float sc; int h;
    __device__ __forceinline__ void operator()(int row, int tx, float a0, float a1, float a2, float a3) const {
        const float rs = row_rs(ssq, row); float v0 = a0 * rs, v1 = a1 * rs, v2 = a2 * rs, v3 = a3 * rs;
        const float ss = red16((v0 * v0 + v1 * v1) + (v2 * v2 + v3 * v3));
        if (gain) { const float rn = sc / sqrtf(ss * (1.0f / HD) + EPS); v0 *= rn * gain[tx]; v1 *= rn * gain[tx + 16]; v2 *= rn * gain[tx + 32]; v3 *= rn * gain[tx + 48]; }
        const size_t o = (size_t)row * DM + h * HD + tx;
        dst[o] = (bf16)f2bf(v0); dst[o + 16] = (bf16)f2bf(v1); dst[o + 32] = (bf16)f2bf(v2); dst[o + 48] = (bf16)f2bf(v3); } };
__device__ __forceinline__ void a1(LAS float* sm, const bf16* xb, const float* ssq, const float* w, const float* nrm, int g, const float* qg, const float* kg, bf16* Q, bf16* K, bf16* V, int bid, int nb) {
    const int ntile = (MROWS / 128) * 48;
    for (int t = bid; t < ntile; t += nb) { const int rt = t / 48, ct = t % 48, which = ct / 16, h = ct % 16;
        gemm_tile(sm, DM, rt * 128, ALbf{xb, DM}, BLa1{w, nrm, g * 3072 + which * 1024 + h * 64},
                  EPa1{ssq, which == 0 ? Q : (which == 1 ? K : V), which == 0 ? qg : (which == 1 ? kg : nullptr), which == 0 ? QSCALE : 1.0f, h}); }
}
struct EPa3 { const float* ssq; const bf16* O0; const bf16* O1; const bf16* O2; const float* lse; bf16* Y; int h;
    __device__ __forceinline__ void operator()(int row, int tx, float a0, float a1, float a2, float a3) const {
        const float rs = row_rs(ssq, row);
        const float l0 = lse[((size_t)0 * MROWS + row) * 16 + h], l1 = lse[((size_t)1 * MROWS + row) * 16 + h], l2 = lse[((size_t)2 * MROWS + row) * 16 + h];
        const float mx = fmaxf(l0, fmaxf(l1, l2)); float w0 = exp2f(l0 - mx), w1 = exp2f(l1 - mx), w2 = exp2f(l2 - mx); const float inv = 1.0f / (w0 + w1 + w2); w0 *= inv; w1 *= inv; w2 *= inv;
        const float zz[4] = {a0 * rs, a1 * rs, a2 * rs, a3 * rs};
#pragma unroll
        for (int j = 0; j < 4; ++j) { const size_t o = (size_t)row * DM + h * HD + tx + 16 * j;
            const float ov = w0 * bf2f(O0[o]) + w1 * bf2f(O1[o]) + w2 * bf2f(O2[o]); Y[o] = (bf16)f2bf(ov * zz[j] * sigmoidf_(zz[j])); } } };
__device__ __forceinline__ void a3(LAS float* sm, const bf16* xb, const float* ssq, const float* w, const float* nrm, const bf16* O0, const bf16* O1, const bf16* O2, const float* lse, bf16* Y, int bid, int nb) {
    const int ntile = (MROWS / 128) * 16;
    for (int t = bid; t < ntile; t += nb) { const int rt = t / 16, h = t % 16; gemm_tile(sm, DM, rt * 128, ALbf{xb, DM}, BLa1{w, nrm, QKVC + h * 64}, EPa3{ssq, O0, O1, O2, lse, Y, h}); }
}
__device__ __forceinline__ void a2(bf16* QO, const bf16* K, const bf16* V, const float* biasT  , float* lse  , int dil, int gtid, int gthreads) {
    for (int idx = gtid; idx < MROWS * NH; idx += gthreads) {
        const int row = idx >> 4, h = idx & 15, t = row & (SEQ - 1);
        bf16* qp = QO + (size_t)row * DM + h * HD;
        float q[64], o[64];
#pragma unroll
        for (int c = 0; c < 8; ++c) { const v4u w = *(const v4u*)(qp + 8 * c);
#pragma unroll
            for (int i = 0; i < 4; ++i) { q[8 * c + 2 * i] = bflo(w[i]); q[8 * c + 2 * i + 1] = bfhi(w[i]); } }
#pragma unroll
        for (int d = 0; d < 64; ++d) o[d] = 0.f;
        float m = -INFINITY, l = 0.f;
        for (int j = 0; j <= 128; ++j) {
            const int tk = t - dil * j; if (tk < 0) break;
            const size_t ko = (size_t)(row - dil * j) * DM + h * HD;
            float s = 0.f;
#pragma unroll
            for (int c = 0; c < 8; ++c) { const v4u w = *(const v4u*)(K + ko + 8 * c);
#pragma unroll
                for (int i = 0; i < 4; ++i) { s = fmaf(q[8 * c + 2 * i], bflo(w[i]), s); s = fmaf(q[8 * c + 2 * i + 1], bfhi(w[i]), s); } }
            s += biasT[h * 132 + j];
            const float mn = fmaxf(m, s), f = exp2f(m - mn), p = exp2f(s - mn);
            l = l * f + p; m = mn;
#pragma unroll
            for (int c = 0; c < 8; ++c) { const v4u w = *(const v4u*)(V + ko + 8 * c);
#pragma unroll
                for (int i = 0; i < 4; ++i) { o[8 * c + 2 * i] = o[8 * c + 2 * i] * f + p * bflo(w[i]); o[8 * c + 2 * i + 1] = o[8 * c + 2 * i + 1] * f + p * bfhi(w[i]); } }
        }
        const float il = 1.0f / l;
#pragma unroll
        for (int c = 0; c < 8; ++c) { v4u w;
#pragma unroll
            for (int i = 0; i < 4; ++i) w[i] = pk2(o[8 * c + 2 * i] * il, o[8 * c + 2 * i + 1] * il);
            *(v4u*)(qp + 8 * c) = w; }
        lse[(size_t)row * 16 + h] = m + log2f(l);
    }
}
}

template <int MODE> __device__ __forceinline__ int wt_dest_row(int n) {
    if (MODE == 1) { const int type = n >> 11, e = n & 2047, pn = e >> 6, el = e & 63; return 256 * pn + 128 * (type >> 1) + 32 * (el >> 4) + 16 * (type & 1) + (el & 15); }
    if (MODE == 3) { const int blk = n >> 10, r = n & 1023, h = r >> 6, d = r & 63; return blk * 1024 + 256 * (h >> 2) + 128 * (d >> 5) + 32 * (h & 3) + (d & 31); }
    return n;
}
template <int MODE> __device__ __forceinline__ void p0_transpose_item(const float* W, int K, int N, const float* scale, bf16* WT, LAS float* scr  , int item, int lane) {
    const int nblk = N / 64, kb = item / nblk, nb = item % nblk, k0 = 64 * kb, n0 = 64 * nb;
    const int kr = lane >> 4, c4 = lane & 15;
    f32x4 v[16];
#pragma unroll
    for (int i = 0; i < 16; ++i) v[i] = *(const GAS f32x4*)(W + (size_t)(k0 + 4 * i + kr) * N + n0 + 4 * c4);
#pragma unroll
    for (int i = 0; i < 16; ++i) { const float s = scale ? scale[k0 + 4 * i + kr] : 1.0f; LAS float* d = scr + (4 * i + kr) * 65 + 4 * c4;
        d[0] = v[i][0] * s; d[1] = v[i][1] * s; d[2] = v[i][2] * s; d[3] = v[i][3] * s; }
    LDS_WAIT(); asm volatile("" ::: "memory");
    const int c = lane & 7, nl = lane >> 3;
#pragma unroll
    for (int j = 0; j < 8; ++j) { const int n = nl + 8 * j; const LAS float* s = scr + (8 * c) * 65 + n;
        v4u o; o.x = pk2(s[0 * 65], s[1 * 65]); o.y = pk2(s[2 * 65], s[3 * 65]); o.z = pk2(s[4 * 65], s[5 * 65]); o.w = pk2(s[6 * 65], s[7 * 65]);
        *(GAS v4u*)(WT + (size_t)wt_dest_row<MODE>(n0 + n) * K + k0 + 8 * c) = o; }
    LDS_WAIT(); asm volatile("" ::: "memory");
}
struct Ptrs {
    const float *x, *conv_norm, *conv_w_in, *conv_w, *conv_w_out, *attn_norm, *attn_w_in, *q_gain, *k_gain, *attn_w_out, *rel_bias;
    float* out; unsigned char* ws;
};
__device__ __forceinline__ void p0_prologue(const Ptrs& P, LAS unsigned char* lds, int vcu, int G, int wave, int lane, int tid) {
    LAS float* scr = (LAS float*)(lds + wave * 16640);
    const int gw = vcu * 8 + wave, NGW = G * 8;
    bf16* W1 = (bf16*)(P.ws + WS_W1); bf16* W2 = (bf16*)(P.ws + WS_W2); bf16* W3 = (bf16*)(P.ws + WS_W3); bf16* W4 = (bf16*)(P.ws + WS_W4);
    constexpr int I1 = (DM / 64) * (CN / 64), I2 = (CE / 64) * (DM / 64), I3 = (DM / 64) * (AN / 64), I4 = (DM / 64) * (DM / 64), IL = I1 + I2 + I3 + I4;
    for (int it = gw; it < 2 * IL; it += NGW) {
        const int j = it / IL; int r = it % IL;
        if (r < I1) { p0_transpose_item<1>(P.conv_w_in + (size_t)j * DM * CN, DM, CN, P.conv_norm + j * DM, W1 + (size_t)j * CN * DM, scr, r, lane); continue; } r -= I1;
        if (r < I2) { p0_transpose_item<0>(P.conv_w_out + (size_t)j * CE * DM, CE, DM, nullptr, W2 + (size_t)j * DM * CE, scr, r, lane); continue; } r -= I2;
        if (r < I3) { p0_transpose_item<3>(P.attn_w_in + (size_t)j * DM * AN, DM, AN, P.attn_norm + j * DM, W3 + (size_t)j * AN * DM, scr, r, lane); continue; } r -= I3;
        p0_transpose_item<0>(P.attn_w_out + (size_t)j * DM * DM, DM, DM, nullptr, W4 + (size_t)j * DM * DM, scr, r, lane);
    }
    bf16* XB = (bf16*)(P.ws + WS_XB); float* SSQ = (float*)(P.ws + WS_SSQ);
    for (int m = 2 * gw; m < MROWS; m += 2 * NGW) {
        const GAS f32x4* xr = (const GAS f32x4*)(P.x + (size_t)m * DM) + lane;
        GAS v2u* o8 = (GAS v2u*)(XB + (size_t)m * DM) + lane;
        f32x4 v[8];
#pragma unroll
        for (int jj = 0; jj < 8; ++jj) v[jj] = xr[64 * jj];
        float s0 = 0.f, s1 = 0.f;
#pragma unroll
        for (int jj = 0; jj < 8; ++jj) { const f32x4 t = v[jj]; const float q = (t.x * t.x + t.y * t.y) + (t.z * t.z + t.w * t.w); if (jj < 4) s0 += q; else s1 += q;
            v2u w; w.x = pk2(t.x, t.y); w.y = pk2(t.z, t.w); o8[64 * jj] = w; }
        s0 = wave_sum(s0); s1 = wave_sum(s1);
        if (lane < 32) SSQ[(size_t)m * 16 + lane] = lane == 0 ? s0 : (lane == 16 ? s1 : 0.f);
    }
    float* BT = (float*)(P.ws + WS_BIAS);
    for (int i = vcu * 512 + tid; i < NG * NH * 132; i += G * 512) {
        const int g = i / (NH * 132), r = i % (NH * 132), h = r / 132, st = r % 132;
        const int dil = g == 0 ? 1 : (g == 1 ? 4 : 16);
        BT[i] = st <= 128 ? P.rel_bias[t5_bucket(st * dil) * (NG * NH) + g * NH + h] * LOG2E : 0.f;
    }
}
template <bool WRAP> __device__ __forceinline__ void conv_pass(const bf16* V, const bf16* GY, bf16* OUT, const float* cw  , int gtid, int gthreads) {
    for (int idx = gtid; idx < MROWS * (CE / 8); idx += gthreads) {
        const int row = idx / (CE / 8), e0 = (idx % (CE / 8)) * 8, t = row & (SEQ - 1);
        const size_t o = (size_t)row * CE + e0;
        const v4u g = *(const v4u*)(GY + o), v2 = *(const v4u*)(V + o);
        v4u v1 = (v4u){0u, 0u, 0u, 0u}, v0 = (v4u){0u, 0u, 0u, 0u};
        if (t >= 1) v1 = *(const v4u*)(V + o - CE);
        if (t >= 2) v0 = *(const v4u*)(V + o - 2 * CE);
        float w0[8], w1[8], w2[8];
#pragma unroll
        for (int c = 0; c < 2; ++c) { const f32x4 a = *(const f32x4*)(cw + e0 + 4 * c), b = *(const f32x4*)(cw + CE + e0 + 4 * c), d = *(const f32x4*)(cw + 2 * CE + e0 + 4 * c);
#pragma unroll
            for (int i = 0; i < 4; ++i) { w0[4 * c + i] = a[i]; w1[4 * c + i] = b[i]; w2[4 * c + i] = d[i]; } }
        float y[8];
#pragma unroll
        for (int i = 0; i < 4; ++i) {
            y[2 * i] = bflo(g[i]) * (w0[2 * i] * bflo(v0[i]) + w1[2 * i] * bflo(v1[i]) + w2[2 * i] * bflo(v2[i]));
            y[2 * i + 1] = bfhi(g[i]) * (w0[2 * i + 1] * bfhi(v0[i]) + w1[2 * i + 1] * bfhi(v1[i]) + w2[2 * i + 1] * bfhi(v2[i]));
        }
        v4u w; w.x = pk2(y[0], y[1]); w.y = pk2(y[2], y[3]); w.z = pk2(y[4], y[5]); w.w = pk2(y[6], y[7]);
        *(v4u*)(OUT + (WRAP ? (o & (size_t)(16 * 1024 * 1024 - 1)) : o)) = w;
    }
}

__device__ __forceinline__ void conv_fixup(bf16* Y, const float* side, const float* cw, int pm, int tid) {
    if ((pm & 15) == 0) return;
    const int ch = 4 * tid;
    const f32x4 g0 = *(const f32x4*)(side + ((size_t)pm * 6 + 0) * CE + ch), g1 = *(const f32x4*)(side + ((size_t)pm * 6 + 1) * CE + ch);
    const f32x4 c0 = *(const f32x4*)(side + ((size_t)pm * 6 + 2) * CE + ch), c1 = *(const f32x4*)(side + ((size_t)pm * 6 + 3) * CE + ch);
    const f32x4 va = *(const f32x4*)(side + ((size_t)(pm - 1) * 6 + 4) * CE + ch), vb = *(const f32x4*)(side + ((size_t)(pm - 1) * 6 + 5) * CE + ch);
    const f32x4 w0 = *(const f32x4*)(cw + ch), w1 = *(const f32x4*)(cw + CE + ch);
    const f32x4 y0 = g0 * (c0 + w1 * vb + w0 * va), y1 = g1 * (c1 + w0 * vb);
    v2u a, b; a.x = pk2(y0[0], y0[1]); a.y = pk2(y0[2], y0[3]); b.x = pk2(y1[0], y1[1]); b.y = pk2(y1[2], y1[3]);
    *(v2u*)(Y + (size_t)(pm * 256) * CE + ch) = a; *(v2u*)(Y + (size_t)(pm * 256 + 1) * CE + ch) = b;
}

namespace attn {
typedef float f32x16 __attribute__((ext_vector_type(16)));
typedef short s16x4 __attribute__((ext_vector_type(4)));
typedef short v4i16_t __attribute__((ext_vector_type(4)));
constexpr int L_K = 0, L_V = 49152, L_B = 98304, L_O = 118784, L_END = 151552, L_WS = 155648 + 256;
static_assert(L_O + 8 * 4096 == L_END && L_B + 5 * 4096 == L_O, "attention LDS map");
__device__ __forceinline__ int crow(int r, int hi) { return (r & 3) + 8 * (r >> 2) + 4 * hi; }
__device__ __forceinline__ s16x4 vtr(LAS const unsigned char* p) { return __builtin_bit_cast(s16x4, __builtin_amdgcn_ds_read_tr16_b64_v4i16((LAS v4i16_t*)p)); }
__device__ __forceinline__ float swapmax(float m) { auto rr = __builtin_amdgcn_permlane32_swap(__float_as_uint(m), __float_as_uint(m), false, false); return fmaxf(__uint_as_float(rr[0]), __uint_as_float(rr[1])); }
__device__ __forceinline__ float swapsum(float m) { auto rr = __builtin_amdgcn_permlane32_swap(__float_as_uint(m), __float_as_uint(m), false, false); return __uint_as_float(rr[0]) + __uint_as_float(rr[1]); }

#define ATT_BAR() asm volatile("s_waitcnt lgkmcnt(0)\n\ts_barrier" ::: "memory")
__device__ __forceinline__ void glds16(const void* gsrc, unsigned lds_dst) { unsigned keep;
    asm volatile("s_mov_b32 %0, m0\n\ts_mov_b32 m0, %2\n\ts_nop 0\n\tglobal_load_lds_dwordx4 %1, off\n\ts_mov_b32 m0, %0" : "=&s"(keep) : "v"(gsrc), "s"(lds_dst) : "memory"); }
template <int DIL> struct Job {
    int bh, c, n0, h; size_t rowb;
    __device__ __forceinline__ void decode(int id) { constexpr int CPC = (SEQ / DIL) / 256; bh = id >> 4; const int sub = id & 15; c = sub / CPC; n0 = (sub % CPC) * 256; h = bh & 15; rowb = (size_t)(bh >> 4) * SEQ; }
};
template <int DIL, bool ISV> __device__ __forceinline__ void issue_kv(LAS unsigned char* lds, const bf16* src, const Job<DIL>& J, int w, int lane) {
#pragma unroll
    for (int i = 0; i < 6; ++i) {
        const int kb = w * 6 + i, row = kb * 8 + (lane >> 3), pc = lane & 7;
        int pos = J.n0 - 128 + row; pos = pos < 0 ? 0 : pos;
        const size_t ro = (J.rowb + (size_t)pos * DIL + J.c) * DM + J.h * HD;
        const int sw = ISV ? ((((pc >> 2) ^ ((row >> 1) & 1)) * 32) + (pc & 3) * 8) : ((pc ^ ((row >> 1) & 7)) * 8);
        glds16(src + ro + sw, (unsigned)__builtin_amdgcn_readfirstlane((int)((unsigned)(uintptr_t)lds + (ISV ? L_V : L_K) + kb * 1024)));
    }
}
__device__ __forceinline__ void ld16_asm(bf16x8& dst, const bf16* p) { asm volatile("global_load_dwordx4 %0, %1, off" : "=v"(dst) : "v"(p) : "memory"); }

template <int DIL> __device__ __forceinline__ void phase(LAS unsigned char* lds, const bf16* QO, bf16* OUT, const bf16* Kg, const bf16* Vg, const float* biasT  , float* lse  , int vcu, int G) {
    const int tid = threadIdx.x, lane = tid & 63, r32 = lane & 31, hi = lane >> 5;
    const int w = __builtin_amdgcn_readfirstlane(tid >> 6);
    constexpr int NJS = BATCH * NH * 16;
    int id = vcu * 4;
    if (id >= NJS) return;
    Job<DIL> J; J.decode(id);
    bf16x8 q0, q1, q2, q3;
    issue_kv<DIL, false>(lds, Kg, J, w, lane);
    { const bf16* qp = QO + (J.rowb + (size_t)(J.n0 + 32 * w + r32) * DIL + J.c) * DM + J.h * HD + hi * 8; ld16_asm(q0, qp); ld16_asm(q1, qp + 16); ld16_asm(q2, qp + 32); ld16_asm(q3, qp + 48); }
    issue_kv<DIL, true>(lds, Vg, J, w, lane);
    int cur_bh = -1; bool first = true;
    for (;;) {
        const int nid = id + (((id & 3) == 3) ? (G * 4 - 3) : 1);
        const bool has_next = nid < NJS;
        Job<DIL> JN; JN.decode(has_next ? nid : id);
        if (J.bh != cur_bh) {
            cur_bh = J.bh;
#pragma unroll
            for (int i = 0; i < 10; ++i) {
                const int e = tid + 512 * i, j = e >> 10, rem = e & 1023, rg = rem >> 8, ln = (rem & 255) >> 2, i4 = rem & 3;
                const int r = 4 * rg + i4, a = ln & 31, hh = ln >> 5, kk = 32 * j + crow(r, hh), step = 128 + a - kk;
                float val = -INFINITY;
                if (step >= 0 && step <= 128) val = biasT[J.h * 132 + step];
                ((LAS float*)(lds + L_B))[e] = val;
            }
        }
        if (first) { first = false; asm volatile("s_waitcnt vmcnt(6)" : "+v"(q0), "+v"(q1), "+v"(q2), "+v"(q3) :: "memory"); }
        ATT_BAR();
        const int n0 = J.n0, h = J.h, c = J.c; const size_t rowb = J.rowb;
        const size_t qrow = rowb + (size_t)(n0 + 32 * w + r32) * DIL + c;
        const int jstart = (n0 == 0 && w < 4) ? 4 - w : 0;
        f32x16 S[5];
#pragma unroll
        for (int j = 0; j < 5; ++j) {
            if (j < jstart) {
#pragma unroll
                for (int r = 0; r < 16; ++r) S[j][r] = -INFINITY;
            } else {
                f32x16 cinit;
#pragma unroll
                for (int rg = 0; rg < 4; ++rg) { const f32x4 t = *(const LAS f32x4*)(lds + L_B + j * 4096 + rg * 1024 + lane * 16); cinit[4 * rg] = t[0]; cinit[4 * rg + 1] = t[1]; cinit[4 * rg + 2] = t[2]; cinit[4 * rg + 3] = t[3]; }
#pragma unroll
                for (int d0 = 0; d0 < 4; ++d0) {
                    const bf16x8 kf = *(const LAS bf16x8*)(lds + L_K + (32 * w + 32 * j + r32) * 128 + (((2 * d0 + hi) ^ ((r32 >> 1) & 7)) * 16));
                    cinit = __builtin_amdgcn_mfma_f32_32x32x16_bf16(kf, d0 == 0 ? q0 : (d0 == 1 ? q1 : (d0 == 2 ? q2 : q3)), cinit, 0, 0, 0);
                }
                S[j] = cinit;
            }
        }
        ATT_BAR();
        bf16x8 n0q, n1q, n2q, n3q;
        if (has_next) {
            issue_kv<DIL, false>(lds, Kg, JN, w, lane);
            const bf16* qp = QO + (JN.rowb + (size_t)(JN.n0 + 32 * w + r32) * DIL + JN.c) * DM + JN.h * HD + hi * 8; ld16_asm(n0q, qp); ld16_asm(n1q, qp + 16); ld16_asm(n2q, qp + 32); ld16_asm(n3q, qp + 48);
        }
        float m = -INFINITY;
#pragma unroll
        for (int j = 0; j < 5; ++j)
#pragma unroll
            for (int r = 0; r < 16; ++r) m = fmaxf(m, S[j][r]);
        m = swapmax(m);
        float lsum = 0.f;
#pragma unroll
        for (int j = 0; j < 5; ++j)
#pragma unroll
            for (int r = 0; r < 16; ++r) { const float p = __builtin_amdgcn_exp2f(S[j][r] - m); S[j][r] = p; lsum += p; }
        lsum = swapsum(lsum);
        if (has_next) asm volatile("s_waitcnt vmcnt(10)" ::: "memory"); else asm volatile("s_waitcnt vmcnt(0)" ::: "memory");
        ATT_BAR();
        f32x16 o[2];
#pragma unroll
        for (int r = 0; r < 16; ++r) { o[0][r] = 0.f; o[1][r] = 0.f; }
        const int vq = (lane & 15) >> 2, vx = (vq >> 1) & 1;
        const LAS unsigned char* vrow = lds + L_V + (32 * w + 4 * hi + vq) * 128 + ((lane >> 4) & 1) * 32 + (lane & 3) * 8;
        const LAS unsigned char* vbh[2] = {vrow + vx * 64, vrow + (1 - vx) * 64};
#pragma unroll
        for (int j = 0; j < 5; ++j)
#pragma unroll
            for (int s = 0; s < 2; ++s) {
                v4u pw; pw.x = pk2(S[j][8 * s], S[j][8 * s + 1]); pw.y = pk2(S[j][8 * s + 2], S[j][8 * s + 3]); pw.z = pk2(S[j][8 * s + 4], S[j][8 * s + 5]); pw.w = pk2(S[j][8 * s + 6], S[j][8 * s + 7]);
                const bf16x8 pa = __builtin_bit_cast(bf16x8, pw);
#pragma unroll
                for (int d0 = 0; d0 < 2; ++d0) {
                    const s16x4 lo = vtr(vbh[d0] + (32 * j + 16 * s) * 128), hh = vtr(vbh[d0] + (32 * j + 16 * s + 8) * 128);
                    const bf16x8 vf = (bf16x8){lo[0], lo[1], lo[2], lo[3], hh[0], hh[1], hh[2], hh[3]};
                    o[d0] = __builtin_amdgcn_mfma_f32_32x32x16_bf16(pa, vf, o[d0], 0, 0, 0);
                }
            }
        ATT_BAR();
        if (has_next) issue_kv<DIL, true>(lds, Vg, JN, w, lane);
        LAS float* wsf = (LAS float*)(lds + L_WS) + w * 64;
        if (hi == 0) { wsf[r32] = lsum; lse[qrow * 16 + h] = m + log2f(lsum); }
        asm volatile("s_waitcnt lgkmcnt(0)" ::: "memory");
        float rli[16];
#pragma unroll
        for (int r = 0; r < 16; ++r) rli[r] = __builtin_amdgcn_rcpf(wsf[crow(r, hi)]);
        LAS bf16* stg = (LAS bf16*)(lds + L_O) + w * 2048;
#pragma unroll
        for (int r = 0; r < 16; ++r) { const int orow = crow(r, hi);
#pragma unroll
            for (int d0 = 0; d0 < 2; ++d0) stg[orow * 64 + d0 * 32 + r32] = (bf16)(pk2(o[d0][r] * rli[r], 0.f) & 0xffffu); }
        asm volatile("s_waitcnt lgkmcnt(0)" ::: "memory");
#pragma unroll
        for (int i = 0; i < 4; ++i) { const int row = i * 8 + (lane >> 3), ch = lane & 7; const v4u v = *(const LAS v4u*)(stg + row * 64 + ch * 8);
            *(v4u*)(OUT + (rowb + (size_t)(n0 + 32 * w + row) * DIL + c) * DM + h * HD + ch * 8) = v; }
        if (!has_next) break;
        asm volatile("s_waitcnt vmcnt(6)" : "+v"(n0q), "+v"(n1q), "+v"(n2q), "+v"(n3q) :: "memory");
        id = nid; J = JN; q0 = n0q; q1 = n1q; q2 = n2q; q3 = n3q;
    }
    asm volatile("s_waitcnt vmcnt(0) lgkmcnt(0)\n\ts_barrier" ::: "memory");
}
#undef ATT_BAR
}

#ifndef OPT_C1
#define OPT_C1 0
#endif
#ifndef OPT_RES
#define OPT_RES 0
#endif
#ifndef OPT_A1
#define OPT_A1 0
#endif
#ifndef OPT_A2
#define OPT_A2 0
#endif
#ifndef OPT_A3
#define OPT_A3 0
#endif
#ifndef DUP_A2
#define DUP_A2 0
#endif
#ifndef DUP_A1
#define DUP_A1 0
#endif
#ifndef DUP_C1
#define DUP_C1 0
#endif
#ifndef DUP_A3
#define DUP_A3 0
#endif
#ifndef DUP_P0
#define DUP_P0 0
#endif
#ifndef DUP_C3
#define DUP_C3 0
#endif
#ifndef DUP_C2
#define DUP_C2 0
#endif
#ifndef DUP_BAR
#define DUP_BAR 0
#endif
#ifndef FUSE_CONV
#define FUSE_CONV 0
#endif
#ifndef RES_BF16
#define RES_BF16 0
#endif
#ifndef MK_PER_PHASE
#define MK_PER_PHASE 1
#endif
constexpr int LDS_BYTES = 159744;
constexpr int XCH_OFF = 131072;
constexpr int MISC_OFF = 155648;
struct Args { const float* in[11]; float* out; unsigned char* ws; int ph_lo, ph_hi; };

template <int PH> __device__ __forceinline__ void run_phase(const Args& args, LAS unsigned char* lds) {
    const int tid = threadIdx.x, lane = tid & 63, wave = __builtin_amdgcn_readfirstlane(tid >> 6);
    const int G = gridDim.x, bx = blockIdx.x, vcu = (G % 8 == 0) ? (bx % 8) * (G / 8) + bx / 8 : bx;
    unsigned char* ws = args.ws;
    float* SSQ = (float*)(ws + WS_SSQ); bf16* XB = (bf16*)(ws + WS_XB);
    LAS float* smf = (LAS float*)lds;
    const int gtid = vcu * 512 + tid, gthreads = G * 512;
    (void)lane; (void)wave; (void)smf; (void)gtid; (void)gthreads; (void)SSQ; (void)XB;
    if constexpr (PH == 0) {
        Ptrs P;
        P.x = args.in[0]; P.conv_norm = args.in[1]; P.conv_w_in = args.in[2]; P.conv_w = args.in[3]; P.conv_w_out = args.in[4]; P.attn_norm = args.in[5];
        P.attn_w_in = args.in[6]; P.q_gain = args.in[7]; P.k_gain = args.in[8]; P.attn_w_out = args.in[9]; P.rel_bias = args.in[10]; P.out = args.out; P.ws = args.ws;
#if DUP_P0
        p0_prologue(P, lds, vcu, G, wave, lane, tid);
#endif
        p0_prologue(P, lds, vcu, G, wave, lane, tid);
    } else {
        constexpr int p = PH - 1, j = p / 11, s = p % 11;
        if constexpr (s == 0) {
            bf16* CV = (bf16*)(ws + WS_CV); bf16* CG = (bf16*)(ws + WS_CG);
#if OPT_C1
            pg8::Gemm g{XB, (const bf16*)(ws + WS_W1) + (size_t)j * CN * DM, MROWS, CN, DM}; pg8::StaticOrder S; S.init(MROWS, CN, G, bx);
#if FUSE_CONV
            epi::ConvFused E{SSQ, CG, args.in[3] + (size_t)j * 3 * CE, (float*)(ws + WS_SIDE), lds + XCH_OFF};
            pg8::gemm_phase<epi::ConvFused, pg8::StaticOrder, true, true>(lds, g, S, E);
#else
            epi::ConvIn E{SSQ, CV, CG};
#if DUP_C1
            pg8::gemm_phase<epi::ConvIn, pg8::StaticOrder, true, true>(lds, g, S, E);
#endif
            pg8::gemm_phase<epi::ConvIn, pg8::StaticOrder, true, true>(lds, g, S, E);
#endif
#else
            naive::c1(smf, XB, SSQ, args.in[2] + (size_t)j * DM * CN, args.in[1] + j * DM, CV, CG, bx, G);
#endif
        } else if constexpr (s == 1) {
#if !(FUSE_CONV && OPT_C1)
#if DUP_C2
            conv_pass<true>((const bf16*)(ws + WS_CV), (bf16*)(ws + WS_CG), (bf16*)(ws + WS_END), args.in[3] + (size_t)j * 3 * CE, gtid, gthreads);
#endif
            conv_pass<false>((const bf16*)(ws + WS_CV), (bf16*)(ws + WS_CG), (bf16*)(ws + WS_CG), args.in[3] + (size_t)j * 3 * CE, gtid, gthreads);
#endif
        } else if constexpr (s == 2 || s == 10) {
            const bf16* A = (const bf16*)(ws + (s == 2 ? WS_CG : WS_Y)); constexpr int K = s == 2 ? CE : DM;
            const float* xin = (j == 0 && s == 2) ? args.in[0] : args.out;
#if OPT_RES
            pg8::Gemm g{A, (const bf16*)(ws + (s == 2 ? WS_W2 : WS_W4)) + (size_t)j * DM * K, MROWS, DM, K}; pg8::StaticOrder S; S.init(MROWS, DM, G, bx);
#if FUSE_CONV && OPT_C1 && !defined(NOFIX)
            if constexpr (s == 2) { pg8::Unit fu; for (int i = 0; S.next(i, fu); ++i) conv_fixup((bf16*)(ws + WS_CG), (const float*)(ws + WS_SIDE), args.in[3] + (size_t)j * 3 * CE, fu.pm, tid);
                asm volatile("s_waitcnt vmcnt(0)" ::: "memory"); __syncthreads(); }
#endif
#if RES_BF16
            constexpr int RMODE = (j == 0 && s == 2) ? 0 : ((j == 1 && s == 10) ? 2 : 1);
            epi::ResidB<RMODE> E{xin, args.out, XB, SSQ};
            pg8::gemm_phase<epi::ResidB<RMODE>, pg8::StaticOrder, false, true>(lds, g, S, E);
#else
            epi::Resid E{xin, args.out, XB, SSQ};
#if DUP_C3
            if constexpr (j == 0 && s == 2) pg8::gemm_phase<epi::Resid, pg8::StaticOrder, false, true>(lds, g, S, E);
#endif
            pg8::gemm_phase<epi::Resid, pg8::StaticOrder, false, true>(lds, g, S, E);
#endif
#else
            naive::resid(smf, A, K, s == 2 ? args.in[4] + (size_t)j * CE * DM : args.in[9] + (size_t)j * DM * DM, xin, args.out, XB, SSQ, bx, G);
#endif
        } else if constexpr (s == 9) {
            const bf16* O0 = (const bf16*)(ws + WS_QO); const bf16* O1 = O0 + (size_t)MROWS * DM; const bf16* O2 = O1 + (size_t)MROWS * DM;
            float* LSE = (float*)(ws + WS_LSE); bf16* YB = (bf16*)(ws + WS_Y);
#if OPT_A3
            pg8::Gemm g{XB, (const bf16*)(ws + WS_W3) + (size_t)j * AN * DM + (size_t)QKVC * DM, MROWS, DM, DM}; pg8::StaticOrder S; S.init(MROWS, DM, G, bx);
            epi::ZMerge E{SSQ, O0, O1, O2, LSE, YB};
#if DUP_A3
            pg8::gemm_phase<epi::ZMerge, pg8::StaticOrder, false, true>(lds, g, S, E);
#endif
            pg8::gemm_phase<epi::ZMerge, pg8::StaticOrder, false, true>(lds, g, S, E);
#else
            naive::a3(smf, XB, SSQ, args.in[6] + (size_t)j * DM * AN, args.in[5] + j * DM, O0, O1, O2, LSE, YB, bx, G);
#endif
        } else {
            constexpr int g = (s - 3) >> 1; bf16* QO = (bf16*)(ws + WS_QO) + (size_t)g * MROWS * DM;
            bf16* KB = (bf16*)(ws + WS_K); bf16* VB = (bf16*)(ws + WS_V);
            if constexpr (((s - 3) & 1) == 0) {
#if OPT_A1
                pg8::Gemm gm{XB, (const bf16*)(ws + WS_W3) + (size_t)j * AN * DM + (size_t)g * 3072 * DM, MROWS, 3072, DM}; pg8::StaticOrder S; S.init(MROWS, 3072, G, bx);
                epi::QKV E{SSQ, QO, KB, VB, args.in[7] + (j * NG + g) * HD, args.in[8] + (j * NG + g) * HD};
#if DUP_A1
                pg8::gemm_phase<epi::QKV, pg8::StaticOrder, true, true>(lds, gm, S, E);
#endif
                pg8::gemm_phase<epi::QKV, pg8::StaticOrder, true, true>(lds, gm, S, E);
#else
                naive::a1(smf, XB, SSQ, args.in[6] + (size_t)j * DM * AN, args.in[5] + j * DM, g, args.in[7] + (j * NG + g) * HD, args.in[8] + (j * NG + g) * HD, QO, KB, VB, bx, G);
#endif
            } else {
                constexpr int dil = g == 0 ? 1 : (g == 1 ? 4 : 16);
                float* LSE = (float*)(ws + WS_LSE); const float* BT = (const float*)(ws + WS_BIAS);
#if OPT_A2
#if DUP_A2
                attn::phase<dil>(lds, QO, (bf16*)(ws + WS_END), KB, VB, BT + g * NH * 132, LSE + (size_t)g * MROWS * 16, vcu, G);
#endif
                attn::phase<dil>(lds, QO, QO, KB, VB, BT + g * NH * 132, LSE + (size_t)g * MROWS * 16, vcu, G);
#else
                naive::a2(QO, KB, VB, BT + g * NH * 132, LSE + (size_t)g * MROWS * 16, dil, gtid, gthreads);
#endif
            }
        }
    }
}

__global__ void __launch_bounds__(512, 2) mk_fwd(Args args) {
    extern __shared__ __attribute__((aligned(16))) unsigned char lds_raw[];
    LAS unsigned char* lds = (LAS unsigned char*)lds_raw;
    volatile LAS unsigned* MISC = (volatile LAS unsigned*)(lds + MISC_OFF);
    for (int u = threadIdx.x; u < (LDS_BYTES - MISC_OFF) / 4; u += 512) ((LAS unsigned*)(lds + MISC_OFF))[u] = 0u;
    __syncthreads();
    gu32* ctl = (gu32*)(args.ws + WS_CTL);
    XcdBarrier bar; bar.bar = (unsigned*)(ctl + CW_BAR); bar.x = 0; bar.st = nullptr;
    const int lo = args.ph_lo, hi = args.ph_hi;
    if (hi - lo > 1) bar = xcd_barrier_post((unsigned*)(ctl + CW_BAR), MISC + 8);
#ifdef KEEP_NOP_BAR
#define PH_NOP(k) 0
#else
#define PH_NOP(k) (FUSE_CONV && OPT_C1 && (k) > 0 && (((k) - 1) % 11) == 1)
#endif
#if DUP_BAR
#define RUN(k) if (lo <= (k) && (k) < hi && !PH_NOP(k)) { run_phase<(k)>(args, lds); if ((k) + 1 < hi) { xcd_barrier(bar); xcd_barrier(bar); } }
#else
#define RUN(k) if (lo <= (k) && (k) < hi && !PH_NOP(k)) { run_phase<(k)>(args, lds); if ((k) + 1 < hi) xcd_barrier(bar); }
#endif
    RUN(0) RUN(1) RUN(2) RUN(3) RUN(4) RUN(5) RUN(6) RUN(7) RUN(8) RUN(9) RUN(10) RUN(11)
    RUN(12) RUN(13) RUN(14) RUN(15) RUN(16) RUN(17) RUN(18) RUN(19) RUN(20) RUN(21) RUN(22)
#undef RUN
}

extern "C" void kernel_launch(void* const* d_in, const int* in_sizes, int n_in, void* d_out, int out_size, void* d_ws, size_t ws_size, hipStream_t stream) {
    static int grid = 0;
    if (grid == 0) {
        if (n_in != 11 || in_sizes[0] != MROWS * DM || out_size != MROWS * DM || ws_size < WS_END) { fprintf(stderr, "kernel_launch: unexpected shapes (n_in %d, ws %zu); nothing launched\n", n_in, ws_size); grid = -1; return; }
        int dev = 0, cus = 0, per_cu = 0;
        if (hipGetDevice(&dev) != hipSuccess || hipDeviceGetAttribute(&cus, hipDeviceAttributeMultiprocessorCount, dev) != hipSuccess) { grid = -1; return; }
        if (hipFuncSetAttribute((const void*)mk_fwd, hipFuncAttributeMaxDynamicSharedMemorySize, LDS_BYTES) != hipSuccess) { fprintf(stderr, "kernel_launch: hipFuncSetAttribute failed\n"); grid = -1; return; }
        if (hipOccupancyMaxActiveBlocksPerMultiprocessor(&per_cu, (const void*)mk_fwd, 512, LDS_BYTES) != hipSuccess || per_cu < 1) { fprintf(stderr, "kernel_launch: occupancy query says %d blocks per CU; nothing launched\n", per_cu); (void)hipGetLastError(); grid = -1; return; }
        grid = cus;
    }
    if (grid < 0) return;
    (void)hipMemsetAsync((char*)d_ws + WS_CTL, 0, CTL_ZERO_BYTES, stream);
    Args a{};
    for (int i = 0; i < 11; ++i) a.in[i] = (const float*)d_in[i];
    a.out = (float*)d_out; a.ws = (unsigned char*)d_ws;
#if MK_PER_PHASE
    for (int ph = 0; ph < NPHASE; ++ph) { a.ph_lo = ph; a.ph_hi = ph + 1; hipLaunchKernelGGL(mk_fwd, dim3(grid), dim3(512), LDS_BYTES, stream, a); }
#else
    a.ph_lo = 0; a.ph_hi = NPHASE; hipLaunchKernelGGL(mk_fwd, dim3(grid), dim3(512), LDS_BYTES, stream, a);
#endif
}
```

```cpp
#include <hip/hip_runtime.h>
#include <cstdio>
#include <cstdint>
#include <cmath>
#define MK_PER_PHASE 0
#define OPT_C1 1
#define OPT_RES 1
#define OPT_A1 1
#define OPT_A3 1
#define OPT_A2 1
#define FUSE_CONV 1
#define RES_BF16 1
namespace pg8 {
#define PG8_LAS __attribute__((address_space(3)))
typedef unsigned short bf16_t;
typedef short bf16x8 __attribute__((ext_vector_type(8)));
typedef float f32x4 __attribute__((ext_vector_type(4)));
typedef unsigned u32x4 __attribute__((ext_vector_type(4)));
constexpr int BM = 256, BK = 64, HALF = 128, HTB = HALF * BK * 2  , STAGE_BYTES = 8 * HTB, NXCD = 8, WGM = 8;

__host__ __device__ __forceinline__ int lds_byte(int r, int c) { const int st = (r >> 4) * 2 + (c >> 5), rr = r & 15, cc = c & 31, ob = rr * 64 + cc * 2; return st * 1024 + (ob ^ (((ob >> 9) & 1) << 5)); }
__host__ __device__ __forceinline__ void stage_rc(int b, int& R, int& C) { const int st = b / 1024, sb = b % 1024, swz = sb ^ (((sb >> 9) & 1) << 5); R = (st >> 1) * 16 + swz / 64; C = (st & 1) * 32 + (swz % 64) / 2; }
__host__ __device__ __forceinline__ int perm32(int rho) { const int n = rho >> 4, i = rho & 15; return 8 * (i >> 2) + 4 * n + (i & 3); }

struct Unit { int pm, pn; };
struct Gemm { const bf16_t* A; const bf16_t* Bt; int M, N, K; };

struct StaticOrder {
    int nM, nN, nwg, G, c;
    __host__ __device__ void init(int M, int N, int G_, int c_) { nM = M / BM; nN = N / BM; nwg = nM * nN; G = G_; c = c_; }
    __host__ __device__ bool next(int i, Unit& u) const {
        const long L = (long)i * G + c; if (L >= nwg) return false;
        int wgid = (int)L; { const int q = nwg / NXCD, r = nwg % NXCD, xcd = wgid % NXCD, off = wgid / NXCD; wgid = (xcd < r ? xcd * (q + 1) : r * (q + 1) + (xcd - r) * q) + off; }
        const int nig = WGM * nN, gid = wgid / nig, fm = gid * WGM, gsz = (nM - fm) < WGM ? (nM - fm) : WGM;
        u.pm = fm + ((wgid % nig) % gsz); u.pn = (wgid % nig) / gsz; return true;
    }
    __device__ __forceinline__ void a_ready(const Unit&) const {}
    __device__ __forceinline__ void done(const Unit&) const {}
};

__device__ __forceinline__ unsigned cvt_pk_bf16(float lo, float hi) { unsigned r; asm volatile("v_cvt_pk_bf16_f32 %0, %1, %2" : "=v"(r) : "v"(lo), "v"(hi)); return r; }
typedef float f32x2 __attribute__((ext_vector_type(2)));

template <class Epi, class Sched, bool ALIGN_EPI = false, bool SP2 = false>
__device__ __forceinline__ void gemm_phase(PG8_LAS unsigned char* lds, const Gemm g, const Sched& S, const Epi& E) {
    const int tid = threadIdx.x, wid = __builtin_amdgcn_readfirstlane(tid >> 6), lane = tid & 63, wr = wid >> 2, wc = wid & 3, fr = lane & 15, fq = lane >> 4;
    const int K = g.K, nt = K / BK;
    unsigned voffA[2], voffB[2];
#pragma unroll
    for (int i = 0; i < 2; ++i) { int R, C; stage_rc(tid * 16 + i * 8192, R, C); const int Rb = Epi::PERM ? ((R & ~31) + perm32(R & 31)) : R;
        voffA[i] = (unsigned)(R * K + C) * 2u; voffB[i] = (unsigned)(Rb * K + C) * 2u; }
    const size_t kstep = (size_t)(BK * 2);
    const size_t hstep = (size_t)HALF * K * 2;
    const size_t tstep = 2 * hstep;
    const unsigned ldsw = (unsigned)wid * 1024u;
    const int aoff = lds_byte(wr * 64 + fr, fq * 8), boff = lds_byte(wc * 32 + fr, fq * 8);
#define PG8_SA(b, h) (((b) * 2 + (h)) * HTB)
#define PG8_SB(b, h) ((4 + (b) * 2 + (h)) * HTB)
#define PG8_STAGE(bufoff, gbase, voff) do { _Pragma("unroll") for (int _i = 0; _i < 2; ++_i) \
        __builtin_amdgcn_global_load_lds((const unsigned*)((const char*)(gbase) + (voff)[_i]), (PG8_LAS unsigned*)(lds + (bufoff) + ldsw + _i * 8192), 16, 0, 0); } while (0)
#define PG8_LDA(dst, b, h) do { _Pragma("unroll") for (int m = 0; m < 4; ++m) _Pragma("unroll") for (int k = 0; k < 2; ++k) dst[m][k] = *(const PG8_LAS bf16x8*)(lds + PG8_SA(b, h) + aoff + m * 2048 + k * 1024); } while (0)
#define PG8_LDB(dst, b, h) do { _Pragma("unroll") for (int n = 0; n < 2; ++n) _Pragma("unroll") for (int k = 0; k < 2; ++k) dst[n][k] = *(const PG8_LAS bf16x8*)(lds + PG8_SB(b, h) + boff + n * 2048 + k * 1024); } while (0)
#define PG8_MMA(ai, bj, At, Bt) do { __builtin_amdgcn_s_setprio(1); _Pragma("unroll") for (int m = 0; m < 4; ++m) _Pragma("unroll") for (int n = 0; n < 2; ++n) _Pragma("unroll") for (int k = 0; k < 2; ++k) \
        acc[ai][bj][m][n] = __builtin_amdgcn_mfma_f32_16x16x32_bf16(Bt[n][k], At[m][k], acc[ai][bj][m][n], 0, 0, 0); __builtin_amdgcn_s_setprio(0); } while (0)
#define PG8_WAIT_V(n) asm volatile("s_waitcnt vmcnt(" #n ")" ::: "memory")
#define PG8_WAIT_L(n) asm volatile("s_waitcnt lgkmcnt(" #n ")" ::: "memory")
#define PG8_BAR __builtin_amdgcn_s_barrier()
#define PG8_SCHED __builtin_amdgcn_sched_barrier(0)
    Unit cur, nxt; int ui = 0;
    if (!S.next(0, cur)) return;
    f32x4 acc[2][2][4][2];
#pragma unroll
    for (int a = 0; a < 2; ++a)
#pragma unroll
        for (int b = 0; b < 2; ++b)
#pragma unroll
            for (int m = 0; m < 4; ++m)
#pragma unroll
                for (int n = 0; n < 2; ++n) acc[a][b][m][n] = (f32x4){0.f, 0.f, 0.f, 0.f};
    bf16x8 At[4][2], B0[2][2], B1[2][2];
    const char* cA = (const char*)g.A + (size_t)cur.pm * tstep; const char* cB = (const char*)g.Bt + (size_t)cur.pn * tstep;
    S.a_ready(cur);
    if constexpr (SP2) {
        PG8_STAGE(PG8_SB(0, 0), cB, voffB); PG8_STAGE(PG8_SB(0, 1), cB + hstep, voffB); PG8_STAGE(PG8_SA(0, 0), cA, voffA); PG8_STAGE(PG8_SA(0, 1), cA + hstep, voffA);
        E.begin(lds, S, tid);
        if (wr == 1) PG8_BAR;
        PG8_WAIT_V(2); PG8_BAR;
        PG8_STAGE(PG8_SB(1, 0), cB + kstep, voffB); PG8_STAGE(PG8_SA(1, 0), cA + kstep, voffA); PG8_STAGE(PG8_SB(1, 1), cB + hstep + kstep, voffB);
        PG8_WAIT_V(6); PG8_BAR;
    } else {
        PG8_STAGE(PG8_SB(0, 0), cB, voffB); PG8_STAGE(PG8_SA(0, 0), cA, voffA); PG8_STAGE(PG8_SB(0, 1), cB + hstep, voffB); PG8_STAGE(PG8_SA(0, 1), cA + hstep, voffA);
        if (wr == 1) PG8_BAR;
        PG8_WAIT_V(4); PG8_BAR;
        PG8_STAGE(PG8_SB(1, 0), cB + kstep, voffB); PG8_STAGE(PG8_SA(1, 0), cA + kstep, voffA); PG8_STAGE(PG8_SB(1, 1), cB + hstep + kstep, voffB);
        PG8_WAIT_V(6); PG8_BAR;
    }
    for (;;) {
        const bool has_next = S.next(ui + 1, nxt);
        const char* nA = has_next ? (const char*)g.A + (size_t)nxt.pm * tstep : cA; const char* nB = has_next ? (const char*)g.Bt + (size_t)nxt.pn * tstep : cB;
        for (int t = 0; t < nt; t += 2) {
            const bool last = (t == nt - 2);
            const char* a1 = cA + (size_t)(t + 1) * kstep;
            const char* a2 = last ? nA : cA + (size_t)(t + 2) * kstep; const char* b2 = last ? nB : cB + (size_t)(t + 2) * kstep;
            const char* a3 = a2 + kstep; const char* b3 = b2 + kstep;
            if (last && has_next) S.a_ready(nxt);
            if constexpr (SP2) {
            PG8_LDB(B0, 0, 0); PG8_LDB(B1, 0, 1); PG8_SCHED; PG8_LDA(At, 0, 0); PG8_STAGE(PG8_SA(1, 1), a1 + hstep, voffA);
            PG8_WAIT_V(8); PG8_WAIT_L(0); PG8_BAR; PG8_MMA(0, 0, At, B0); PG8_MMA(0, 1, At, B1); PG8_BAR; PG8_SCHED;
            PG8_LDA(At, 0, 1); PG8_STAGE(PG8_SB(0, 0), b2, voffB); PG8_STAGE(PG8_SB(0, 1), b2 + hstep, voffB); PG8_STAGE(PG8_SA(0, 0), a2, voffA);
            PG8_WAIT_V(8); PG8_WAIT_L(0); PG8_BAR; PG8_MMA(1, 0, At, B0); PG8_MMA(1, 1, At, B1); PG8_BAR; PG8_SCHED;
            PG8_LDB(B0, 1, 0); PG8_LDB(B1, 1, 1); PG8_SCHED; PG8_LDA(At, 1, 0); PG8_STAGE(PG8_SA(0, 1), a2 + hstep, voffA);
            PG8_WAIT_V(8); PG8_WAIT_L(0); PG8_BAR; PG8_MMA(0, 0, At, B0); PG8_MMA(0, 1, At, B1); PG8_BAR; PG8_SCHED;
            PG8_LDA(At, 1, 1); PG8_STAGE(PG8_SB(1, 0), b3, voffB); PG8_STAGE(PG8_SB(1, 1), b3 + hstep, voffB); PG8_STAGE(PG8_SA(1, 0), a3, voffA);
            PG8_WAIT_V(8); PG8_WAIT_L(0); PG8_BAR; PG8_MMA(1, 0, At, B0); PG8_MMA(1, 1, At, B1); PG8_BAR; PG8_SCHED;
            } else {
            PG8_LDB(B0, 0, 0); PG8_SCHED; PG8_LDA(At, 0, 0); PG8_STAGE(PG8_SA(1, 1), a1 + hstep, voffA);
            PG8_WAIT_L(8); PG8_BAR; PG8_WAIT_L(0); PG8_MMA(0, 0, At, B0); PG8_BAR; PG8_SCHED;
            PG8_LDB(B1, 0, 1); PG8_STAGE(PG8_SB(0, 0), b2, voffB);
            PG8_BAR; PG8_WAIT_L(0); PG8_MMA(0, 1, At, B1); PG8_BAR;
            PG8_LDA(At, 0, 1); PG8_STAGE(PG8_SA(0, 0), a2, voffA);
            PG8_BAR; PG8_WAIT_L(0); PG8_MMA(1, 0, At, B0); PG8_BAR; PG8_SCHED;
            PG8_STAGE(PG8_SB(0, 1), b2 + hstep, voffB);
            PG8_WAIT_V(6); PG8_BAR; PG8_MMA(1, 1, At, B1); PG8_BAR;
            PG8_LDB(B0, 1, 0); PG8_SCHED; PG8_LDA(At, 1, 0); PG8_STAGE(PG8_SA(0, 1), a2 + hstep, voffA);
            PG8_WAIT_L(8); PG8_BAR; PG8_WAIT_L(0); PG8_MMA(0, 0, At, B0); PG8_BAR; PG8_SCHED;
            PG8_LDB(B1, 1, 1); PG8_STAGE(PG8_SB(1, 0), b3, voffB);
            PG8_BAR; PG8_WAIT_L(0); PG8_MMA(0, 1, At, B1); PG8_BAR;
            PG8_LDA(At, 1, 1); PG8_STAGE(PG8_SA(1, 0), a3, voffA);
            PG8_BAR; PG8_WAIT_L(0); PG8_MMA(1, 0, At, B0); PG8_BAR; PG8_SCHED;
            PG8_STAGE(PG8_SB(1, 1), b3 + hstep, voffB);
            PG8_WAIT_V(6); PG8_BAR; PG8_MMA(1, 1, At, B1); PG8_BAR;
            }
        }
        if constexpr (ALIGN_EPI) { if (wr == 0) PG8_BAR; }
        if constexpr (!Epi::AFTER_DRAIN) { E(acc, cur, wr, wc, fr, fq, ui); S.done(cur); }
        if (!has_next) break;
#pragma unroll
        for (int a = 0; a < 2; ++a)
#pragma unroll
            for (int b = 0; b < 2; ++b)
#pragma unroll
                for (int m = 0; m < 4; ++m)
#pragma unroll
                    for (int n = 0; n < 2; ++n) acc[a][b][m][n] = (f32x4){0.f, 0.f, 0.f, 0.f};
        cur = nxt; cA = nA; cB = nB; ++ui;
        if constexpr (ALIGN_EPI) { if (wr == 1) PG8_BAR; }
    }
    PG8_WAIT_V(0);
    if constexpr (!ALIGN_EPI) { if (wr == 0) PG8_BAR; }
    PG8_BAR;
    if constexpr (Epi::AFTER_DRAIN) { E.fused(acc, cur, wr, wc, fr, fq, lds, wid, lane); S.done(cur); }
#undef PG8_SA
#undef PG8_SB
#undef PG8_STAGE
#undef PG8_LDA
#undef PG8_LDB
#undef PG8_MMA
#undef PG8_WAIT_V
#undef PG8_WAIT_L
#undef PG8_BAR
#undef PG8_SCHED
}
}

constexpr int BATCH = 4, SEQ = 4096, DM = 1024, MROWS = BATCH * SEQ;
constexpr int CE = 2048, CN = 4 * CE;
constexpr int NH = 16, HD = 64, NG = 3, QKVC = 9216, AN = 10240;
constexpr float EPS = 1e-6f, LOG2E = 1.4426950408889634f, QSCALE = 0.125f * LOG2E;
constexpr int NPHASE = 23;

constexpr size_t MiB = 1u << 20;
constexpr size_t WS_CTL = 0, CTL_ZERO_BYTES = 1 * MiB;
constexpr size_t WS_SSQ = 1 * MiB;
constexpr size_t WS_W1 = 2 * MiB, WS_W2 = 34 * MiB, WS_W3 = 42 * MiB, WS_W4 = 82 * MiB;
constexpr size_t WS_LSE = 86 * MiB;
constexpr size_t WS_BIAS = 89 * MiB;
constexpr size_t WS_XB = 90 * MiB;
constexpr size_t WS_CV = 122 * MiB, WS_CG = 186 * MiB;
constexpr size_t WS_QO = 122 * MiB;
constexpr size_t WS_K = 218 * MiB, WS_V = 250 * MiB, WS_Y = WS_K;
constexpr size_t WS_END = 282 * MiB;
constexpr size_t WS_SIDE = 316 * MiB;
constexpr int CW_TMO = 0, CW_BAR = 4096;

#define GAS __attribute__((address_space(1)))
#define LAS __attribute__((address_space(3)))
typedef unsigned short bf16;
typedef unsigned v4u __attribute__((ext_vector_type(4)));
typedef unsigned v2u __attribute__((ext_vector_type(2)));
typedef float f32x4 __attribute__((ext_vector_type(4)));
typedef short bf16x8 __attribute__((ext_vector_type(8)));
typedef GAS unsigned gu32;
#define RLX_AGENT __ATOMIC_RELAXED, __HIP_MEMORY_SCOPE_AGENT
#define LDS_WAIT() asm volatile("s_waitcnt lgkmcnt(0)" ::: "memory")
#define VM_WAIT() asm volatile("s_waitcnt vmcnt(0)" ::: "memory")
__device__ __forceinline__ unsigned f2bf(float f) { unsigned u = __builtin_bit_cast(unsigned, f); return (u + 0x7fffu + ((u >> 16) & 1u)) >> 16; }
typedef float f32x2_t __attribute__((ext_vector_type(2))); typedef __bf16 bf16x2_t __attribute__((ext_vector_type(2)));
__device__ __forceinline__ unsigned pk2(float lo, float hi) { f32x2_t v = {lo, hi}; bf16x2_t b = __builtin_convertvector(v, bf16x2_t); return __builtin_bit_cast(unsigned, b); }
__device__ __forceinline__ float bf2f(unsigned h) { return __builtin_bit_cast(float, h << 16); }
__device__ __forceinline__ float bflo(unsigned w) { return __builtin_bit_cast(float, w << 16); }
__device__ __forceinline__ float bfhi(unsigned w) { return __builtin_bit_cast(float, w & 0xffff0000u); }
__device__ __forceinline__ float sigmoidf_(float z) { return __builtin_amdgcn_rcpf(1.0f + __builtin_amdgcn_exp2f(-z * LOG2E)); }
__device__ __forceinline__ float row_rs(const float* ssq, int row) {
    const f32x4* p = (const f32x4*)(ssq + (size_t)row * 16);
    const f32x4 s = (p[0] + p[1]) + (p[2] + p[3]);
    return 1.0f / sqrtf(((s.x + s.y) + (s.z + s.w)) * (1.0f / DM) + EPS);
}
__device__ __forceinline__ float wave_sum(float v) {
#pragma unroll
    for (int o = 1; o < 64; o <<= 1) v += __shfl_xor(v, o);
    return v;
}
__device__ __forceinline__ int t5_bucket(int d) {
    if (d < 16) return d;
    int b = 15;
    b += (d >= 16); b += (d >= 22); b += (d >= 30); b += (d >= 40); b += (d >= 54); b += (d >= 73); b += (d >= 99); b += (d >= 134);
    b += (d >= 182); b += (d >= 246); b += (d >= 332); b += (d >= 450); b += (d >= 609); b += (d >= 825); b += (d >= 1117); b += (d >= 1513);
    return b;
}

#define XB_TMO      128
#define XB_XCNT(j)  (256  + 64 * (j))
#define XB_XSUB(j)  (1280 + 64 * (j))
#define XB_XGEN(j)  (2304 + 64 * (j))
#define XB_TOP      3328
#define XB_TOPGEN   3392
#define XCD_BAR_WORDS 3456
#define XB_SPIN_CAP (1u << 18)

__device__ __forceinline__ unsigned xb_ld(unsigned* p)              { return __hip_atomic_load(p, __ATOMIC_RELAXED, __HIP_MEMORY_SCOPE_AGENT); }
__device__ __forceinline__ unsigned xb_add(unsigned* p, unsigned v) { return __hip_atomic_fetch_add(p, v, __ATOMIC_RELAXED, __HIP_MEMORY_SCOPE_AGENT); }
__device__ __forceinline__ unsigned xb_xcc_id() { return (unsigned)__builtin_amdgcn_s_getreg((3 << 11) | 20) & 0xFu; }
#define XB_SPIN(cond, bar) do { unsigned _sp = 0; while (cond) { __builtin_amdgcn_s_sleep(1); \
    if ((++_sp & 255u) == 0u) { if (xb_ld(&(bar)[XB_TMO])) break; if (_sp > XB_SPIN_CAP) { atomicAdd(&(bar)[XB_TMO], 1u); break; } } } } while (0)

struct XcdBarrier {
    unsigned* bar; unsigned x;
    volatile LAS unsigned* st;
};

__device__ __forceinline__ XcdBarrier xcd_barrier_post(unsigned* bar, volatile LAS unsigned* st) {
    XcdBarrier b; b.bar = bar; b.x = xb_xcc_id(); b.st = st;
    if (threadIdx.x == 0) (void)xb_add(&bar[XB_XCNT(b.x)], 1u);
    return b;
}
__device__ __forceinline__ void xcd_barrier_complete(unsigned* bar, unsigned x, unsigned& nloc, unsigned& nx) {
    const unsigned G = gridDim.x * gridDim.y * gridDim.z;
    unsigned sum, cnt, mine, sp = 0u;
    for (;;) {
        sum = 0u; cnt = 0u; mine = 0u;
#pragma unroll
        for (unsigned j = 0; j < 16; ++j) { const unsigned c = xb_ld(&bar[XB_XCNT(j)]); sum += c; cnt += (c > 0u) ? 1u : 0u; mine = (j == x) ? c : mine; }
        if (sum == G) break;
        __builtin_amdgcn_s_sleep(1);
        if ((++sp & 255u) == 0u) { if (xb_ld(&bar[XB_TMO])) break; if (sp > XB_SPIN_CAP) { atomicAdd(&bar[XB_TMO], 1u); break; } }
    }
    nloc = mine > 0u ? mine : 1u; nx = cnt > 0u ? cnt : 1u;
}

__device__ __forceinline__ void xcd_barrier(const XcdBarrier& b) {
    asm volatile("s_waitcnt vmcnt(0)" ::: "memory");
    __syncthreads();
    if (threadIdx.x == 0) {
        unsigned* bar = b.bar;
        __builtin_amdgcn_s_waitcnt(0);
        unsigned nloc = b.st[0], nx = b.st[1];
        if (nloc == 0u) { xcd_barrier_complete(bar, b.x, nloc, nx); b.st[0] = nloc; b.st[1] = nx; }
        const unsigned old = xb_add(&bar[XB_XSUB(b.x)], 1u);
        const unsigned gen = old / nloc;
        if (old + 1u == (gen + 1u) * nloc) {
            __builtin_amdgcn_fence(__ATOMIC_RELEASE, "agent");
            asm volatile("s_waitcnt vmcnt(0)" ::: "memory");
            const unsigned og = xb_add(&bar[XB_TOP], 1u);
            const unsigned tg = og / nx;
            if (og + 1u == (tg + 1u) * nx) xb_add(&bar[XB_TOPGEN], 1u);
            else XB_SPIN(xb_ld(&bar[XB_TOPGEN]) == tg, bar);
            __builtin_amdgcn_fence(__ATOMIC_ACQUIRE, "agent");
            xb_add(&bar[XB_XGEN(b.x)], 1u);
            asm volatile("s_waitcnt vmcnt(0)" ::: "memory");
        } else {
            XB_SPIN(xb_ld(&bar[XB_XGEN(b.x)]) == gen, bar);
            __builtin_amdgcn_fence(__ATOMIC_ACQUIRE, "agent");
            asm volatile("s_waitcnt vmcnt(0)" ::: "memory");
        }
    }
    __syncthreads();
}

#ifndef DUP_EPI
#define DUP_EPI 0
#endif
namespace epi {
using pg8::Unit; using pg8::bf16_t;

__device__ __forceinline__ void rows_rs(const float* ssq, int row0  , int fq, float (&rs)[2][4]) {
    f32x4 pp[2][4];
#pragma unroll
    for (int ai = 0; ai < 2; ++ai)
#pragma unroll
        for (int m = 0; m < 4; ++m) pp[ai][m] = *(const f32x4*)(ssq + (size_t)(row0 + ai * 128 + m * 16) * 16 + 4 * fq);
#pragma unroll
    for (int ai = 0; ai < 2; ++ai)
#pragma unroll
        for (int m = 0; m < 4; ++m) { float t = (pp[ai][m][0] + pp[ai][m][1]) + (pp[ai][m][2] + pp[ai][m][3]); t += __shfl_xor(t, 16); t += __shfl_xor(t, 32); rs[ai][m] = __builtin_amdgcn_rsqf(t * (1.0f / DM) + EPS); }
}
struct ConvIn {
    static constexpr bool PERM = false, AFTER_DRAIN = false, DUP = (DUP_EPI != 0);
    const float* ssq; bf16_t* V; bf16_t* G;
    template <class Sched> __device__ __forceinline__ void begin(LAS unsigned char*, const Sched&, int) const {}
    __device__ __forceinline__ void operator()(const f32x4 (&acc)[2][2][4][2], const Unit& u, int wr, int wc, int fr, int fq, int) const {
        const int ch0 = u.pn * 64 + wc * 16 + 4 * fq;
        float rsv[2][4]; rows_rs(ssq, u.pm * 256 + wr * 64 + fr, fq, rsv);
#pragma unroll
        for (int ai = 0; ai < 2; ++ai)
#pragma unroll
            for (int m = 0; m < 4; ++m) {
                const int row = u.pm * 256 + ai * 128 + wr * 64 + m * 16 + fr;
                const float rs = rsv[ai][m];
                const f32x4 b = acc[ai][0][m][0] * rs, c = acc[ai][0][m][1] * rs, uu = acc[ai][1][m][0] * rs, z = acc[ai][1][m][1] * rs;
                const f32x4 v = c * uu;
                f32x4 g;
#pragma unroll
                for (int i = 0; i < 4; ++i) g[i] = b[i] * z[i] * sigmoidf_(z[i]);
                v2u wv, wg; wv.x = pk2(v[0], v[1]); wv.y = pk2(v[2], v[3]); wg.x = pk2(g[0], g[1]); wg.y = pk2(g[2], g[3]);
                *(v2u*)(V + (size_t)row * CE + ch0) = wv;
                *(v2u*)(G + (size_t)row * CE + ch0) = wg;
            }
    }
};


constexpr int RSTAB_OFF = 152832, GTAB_OFF = 161024;
template <class Sched> __device__ __forceinline__ void fill_rstab(LAS unsigned char* lds, const float* ssq, const Sched& S, int tid) {
    LAS float* tab = (LAS float*)(lds + RSTAB_OFF);
    Unit u;
    for (int i = tid >> 8; i < 8 && S.next(i, u); i += 2) {
        const f32x4* p = (const f32x4*)(ssq + (size_t)(u.pm * 256 + (tid & 255)) * 16);
        const f32x4 s = (p[0] + p[1]) + (p[2] + p[3]);
        tab[i * 256 + (tid & 255)] = __builtin_amdgcn_rsqf(((s[0] + s[1]) + (s[2] + s[3])) * (1.0f / DM) + EPS);
    }
}
__device__ __forceinline__ void tab_rs(LAS unsigned char* lds, int ui, int wr, int fr, float (&rs)[2][4]) {
    const LAS float* tab = (const LAS float*)(lds + RSTAB_OFF) + ui * 256 + wr * 64 + fr;
#pragma unroll
    for (int ai = 0; ai < 2; ++ai)
#pragma unroll
        for (int m = 0; m < 4; ++m) rs[ai][m] = tab[ai * 128 + m * 16];
}
struct ConvFused {
    static constexpr bool PERM = false, AFTER_DRAIN = false, DUP = false;
    const float* ssq; bf16_t* Y; const float* cw; float* side; LAS unsigned char* xch;
    static __device__ __forceinline__ f32x4 unpk(v2u p) { return (f32x4){bflo(p.x), bfhi(p.x), bflo(p.y), bfhi(p.y)}; }
    template <class Sched> __device__ __forceinline__ void begin(LAS unsigned char* lds, const Sched& S, int tid) const { fill_rstab(lds, ssq, S, tid); }
    __device__ __forceinline__ void operator()(const f32x4 (&acc)[2][2][4][2], const Unit& u, int wr, int wc, int fr, int fq, int ui) const {
        const int ch0 = u.pn * 64 + wc * 16 + 4 * fq;
        float rsv[2][4]; tab_rs(xch - 131072, ui, wr, fr, rsv);
        const f32x4 w0 = *(const f32x4*)(cw + ch0), w1 = *(const f32x4*)(cw + CE + ch0), w2 = *(const f32x4*)(cw + 2 * CE + ch0);
        v2u vq[2][4]; f32x4 gt[2][4];
#pragma unroll
        for (int ai = 0; ai < 2; ++ai)
#pragma unroll
            for (int m = 0; m < 4; ++m) {
                const float rs = rsv[ai][m];
                const f32x4 b = acc[ai][0][m][0] * rs, c = acc[ai][0][m][1] * rs, uu = acc[ai][1][m][0] * rs, z = acc[ai][1][m][1] * rs;
                const f32x4 v = c * uu;
                vq[ai][m].x = pk2(v[0], v[1]); vq[ai][m].y = pk2(v[2], v[3]);
#pragma unroll
                for (int i = 0; i < 4; ++i) gt[ai][m][i] = b[i] * z[i] * sigmoidf_(z[i]);
            }
        LAS unsigned char* my = xch + (wr * 4 + wc) * 2720 + fq * 8;
        LAS unsigned char* other = xch + ((1 - wr) * 4 + wc) * 2720 + fq * 8;
        const bool seq_start = (u.pm & 15) == 0;
        if (fr >= 14) {
            const int hr = fr - 14;
            *(LAS v2u*)(other + ((wr == 0 ? 0 : 66) + hr) * 40) = vq[0][3];
            if (wr == 0) *(LAS v2u*)(other + (66 + hr) * 40) = vq[1][3];
            else *(f32x4*)(side + ((size_t)u.pm * 6 + 4 + hr) * CE + ch0) = unpk(vq[1][3]);
        }
        if (wr == 0 && fr < 2) *(LAS v2u*)(my + fr * 40) = (v2u){0u, 0u};
#pragma unroll
        for (int m = 0; m < 4; ++m) *(LAS v2u*)(my + (2 + 16 * m + fr) * 40) = vq[0][m];
        asm volatile("s_waitcnt lgkmcnt(0)\n\ts_barrier" ::: "memory");
#pragma unroll
        for (int ai = 0; ai < 2; ++ai) {
            if (ai == 1) {
#pragma unroll
                for (int m = 0; m < 4; ++m) *(LAS v2u*)(my + (2 + 16 * m + fr) * 40) = vq[1][m];
                asm volatile("s_waitcnt lgkmcnt(0)" ::: "memory");
            }
#pragma unroll
            for (int m = 0; m < 4; ++m) {
                const int k = 16 * m + fr;
                int r1 = k + 1, r2 = k;
                if (ai == 1) { if (k < 1) r1 = 67; if (k < 2) r2 = 66 + k; }
                const f32x4 p1 = unpk(*(const LAS v2u*)(my + r1 * 40)), p2 = unpk(*(const LAS v2u*)(my + r2 * 40)), v = unpk(vq[ai][m]);
#ifdef DBG_NOPREV
                const f32x4 cv = w2 * v + (w1 * p1 + w0 * p2) * 0.0f;
#else
                const f32x4 cv = w2 * v + w1 * p1 + w0 * p2;
#endif
#ifdef DBG_Y0
                const f32x4 y = gt[ai][m] * cv * 0.0f;
#else
                const f32x4 y = gt[ai][m] * cv;
#endif
                const int row = u.pm * 256 + ai * 128 + wr * 64 + k;
                v2u wy; wy.x = pk2(y[0], y[1]); wy.y = pk2(y[2], y[3]);
                *(v2u*)(Y + (size_t)row * CE + ch0) = wy;
                if (ai == 0 && m == 0 && wr == 0 && fr < 2 && !seq_start) {
                    *(f32x4*)(side + ((size_t)u.pm * 6 + fr) * CE + ch0) = gt[0][0];
                    *(f32x4*)(side + ((size_t)u.pm * 6 + 2 + fr) * CE + ch0) = cv;
                }
            }
        }
    }
};
struct Resid {
    static constexpr bool PERM = false, AFTER_DRAIN = false, DUP = false;
    const float* xin; float* xout; bf16_t* xb; float* ssq;
    template <class Sched> __device__ __forceinline__ void begin(LAS unsigned char*, const Sched&, int) const {}
    __device__ __forceinline__ void operator()(const f32x4 (&acc)[2][2][4][2], const Unit& u, int wr, int wc, int fr, int fq, int) const {
        const int col0 = u.pn * 256 + wc * 32 + 4 * fq;
        const size_t off0 = (size_t)(u.pm * 256 + wr * 64 + fr) * DM + col0;
        f32x4 pre[4][2][2];
#pragma unroll
        for (int i = 0; i < 4; ++i)
#pragma unroll
            for (int bj = 0; bj < 2; ++bj)
#pragma unroll
                for (int n = 0; n < 2; ++n) pre[i][bj][n] = *(const f32x4*)(xin + off0 + (size_t)(16 * i) * DM + bj * 128 + n * 16);
#pragma unroll
        for (int i = 0; i < 8; ++i) {
            const int ai = i >> 2, m = i & 3;
            const size_t off = off0 + (size_t)(ai * 128 + m * 16) * DM;
            float ss = 0.f; f32x4 xn[2][2];
#pragma unroll
            for (int bj = 0; bj < 2; ++bj)
#pragma unroll
                for (int n = 0; n < 2; ++n) { xn[bj][n] = pre[i & 3][bj][n] + acc[ai][bj][m][n]; const f32x4 t = xn[bj][n]; ss += (t[0] * t[0] + t[1] * t[1]) + (t[2] * t[2] + t[3] * t[3]); }
            if (i < 4) {
#pragma unroll
                for (int bj = 0; bj < 2; ++bj)
#pragma unroll
                    for (int n = 0; n < 2; ++n) pre[i & 3][bj][n] = *(const f32x4*)(xin + off + (size_t)128 * DM + bj * 128 + n * 16);
            }
#pragma unroll
            for (int bj = 0; bj < 2; ++bj)
#pragma unroll
                for (int n = 0; n < 2; ++n) {
                    *(f32x4*)(xout + off + bj * 128 + n * 16) = xn[bj][n];
                    v2u w; w.x = pk2(xn[bj][n][0], xn[bj][n][1]); w.y = pk2(xn[bj][n][2], xn[bj][n][3]);
                    *(v2u*)(xb + off + bj * 128 + n * 16) = w;
                }
            ss += __shfl_xor(ss, 16); ss += __shfl_xor(ss, 32);
            if (fq == 0) ssq[(size_t)(u.pm * 256 + ai * 128 + wr * 64 + m * 16 + fr) * 16 + u.pn * 4 + wc] = ss;
        }
    }
};
template <int MODE> struct ResidB {
    static constexpr bool PERM = false, AFTER_DRAIN = false, DUP = false;
    const float* xin; float* xout; bf16_t* xb; float* ssq;
    template <class Sched> __device__ __forceinline__ void begin(LAS unsigned char*, const Sched&, int) const {}
    __device__ __forceinline__ void operator()(const f32x4 (&acc)[2][2][4][2], const Unit& u, int wr, int wc, int fr, int fq, int) const {
        const int col0 = u.pn * 256 + wc * 32 + 4 * fq;
        const size_t off0 = (size_t)(u.pm * 256 + wr * 64 + fr) * DM + col0;
        if constexpr (MODE == 0) {
            f32x4 pre[4][2][2];
#pragma unroll
            for (int i = 0; i < 4; ++i)
#pragma unroll
                for (int bj = 0; bj < 2; ++bj)
#pragma unroll
                    for (int n = 0; n < 2; ++n) pre[i][bj][n] = *(const f32x4*)(xin + off0 + (size_t)(16 * i) * DM + bj * 128 + n * 16);
#pragma unroll
            for (int i = 0; i < 8; ++i) {
                const int ai = i >> 2, m = i & 3;
                const size_t off = off0 + (size_t)(ai * 128 + m * 16) * DM;
                float ss = 0.f; f32x4 xn[2][2];
#pragma unroll
                for (int bj = 0; bj < 2; ++bj)
#pragma unroll
                    for (int n = 0; n < 2; ++n) { xn[bj][n] = pre[i & 3][bj][n] + acc[ai][bj][m][n]; const f32x4 t = xn[bj][n]; ss += (t[0] * t[0] + t[1] * t[1]) + (t[2] * t[2] + t[3] * t[3]); }
                if (i < 4) {
#pragma unroll
                    for (int bj = 0; bj < 2; ++bj)
#pragma unroll
                        for (int n = 0; n < 2; ++n) pre[i & 3][bj][n] = *(const f32x4*)(xin + off + (size_t)128 * DM + bj * 128 + n * 16);
                }
#pragma unroll
                for (int bj = 0; bj < 2; ++bj)
#pragma unroll
                    for (int n = 0; n < 2; ++n) { v2u w; w.x = pk2(xn[bj][n][0], xn[bj][n][1]); w.y = pk2(xn[bj][n][2], xn[bj][n][3]); *(v2u*)(xb + off + bj * 128 + n * 16) = w; }
                ss += __shfl_xor(ss, 16); ss += __shfl_xor(ss, 32);
                if (fq == 0) ssq[(size_t)(u.pm * 256 + ai * 128 + wr * 64 + m * 16 + fr) * 16 + u.pn * 4 + wc] = ss;
            }
        } else {
            v2u pre[8][2][2];
#pragma unroll
            for (int i = 0; i < 8; ++i)
#pragma unroll
                for (int bj = 0; bj < 2; ++bj)
#pragma unroll
                    for (int n = 0; n < 2; ++n) pre[i][bj][n] = *(const v2u*)(xb + off0 + (size_t)((i >> 2) * 128 + (i & 3) * 16) * DM + bj * 128 + n * 16);
#pragma unroll
            for (int i = 0; i < 8; ++i) {
                const int ai = i >> 2, m = i & 3;
                const size_t off = off0 + (size_t)(ai * 128 + m * 16) * DM;
                float ss = 0.f;
#pragma unroll
                for (int bj = 0; bj < 2; ++bj)
#pragma unroll
                    for (int n = 0; n < 2; ++n) {
                        const v2u p = pre[i][bj][n];
                        const f32x4 t = (f32x4){bflo(p.x), bfhi(p.x), bflo(p.y), bfhi(p.y)} + acc[ai][bj][m][n];
                        if constexpr (MODE == 2) { *(f32x4*)(xout + off + bj * 128 + n * 16) = t; }
                        else { ss += (t[0] * t[0] + t[1] * t[1]) + (t[2] * t[2] + t[3] * t[3]); v2u w; w.x = pk2(t[0], t[1]); w.y = pk2(t[2], t[3]); *(v2u*)(xb + off + bj * 128 + n * 16) = w; }
                    }
                if constexpr (MODE != 2) {
                    ss += __shfl_xor(ss, 16); ss += __shfl_xor(ss, 32);
                    if (fq == 0) ssq[(size_t)(u.pm * 256 + ai * 128 + wr * 64 + m * 16 + fr) * 16 + u.pn * 4 + wc] = ss;
                }
            }
        }
    }
};
struct QKV {
    static constexpr bool PERM = true, AFTER_DRAIN = false, DUP = (DUP_EPI != 0);
    const float* ssq; bf16_t* Q; bf16_t* K; bf16_t* Vv; const float* qg; const float* kg; LAS unsigned char* lds0;
    template <class Sched> __device__ __forceinline__ void begin(LAS unsigned char* lds, const Sched& S, int tid) const {
        fill_rstab(lds, ssq, S, tid);
        if (tid < 128) ((LAS float*)(lds + GTAB_OFF))[tid] = tid < 64 ? qg[tid] * QSCALE : kg[tid - 64];
    }
    __device__ __forceinline__ void operator()(const f32x4 (&acc)[2][2][4][2], const Unit& u, int wr, int wc, int fr, int fq, int ui) const {
        const int which = u.pn >> 2, h = (u.pn & 3) * 4 + wc;
        bf16_t* base = Q + (ptrdiff_t)(which == 1) * (K - Q) + (ptrdiff_t)(which == 2) * (Vv - Q);
        const LAS float* gp = (const LAS float*)(lds0 + GTAB_OFF) + (which == 1 ? 64 : 0); const float gsc = 1.0f; const bool nrm = which < 2;
        const f32x4 g00 = *(const LAS f32x4*)(gp + 8 * fq), g01 = *(const LAS f32x4*)(gp + 8 * fq + 4), g10 = *(const LAS f32x4*)(gp + 32 + 8 * fq), g11 = *(const LAS f32x4*)(gp + 32 + 8 * fq + 4);
        float rsv[2][4]; tab_rs(lds0, ui, wr, fr, rsv);
#pragma unroll
        for (int ai = 0; ai < 2; ++ai)
#pragma unroll
            for (int m = 0; m < 4; ++m) {
                const int row = u.pm * 256 + ai * 128 + wr * 64 + m * 16 + fr;
                const float rs = rsv[ai][m];
                f32x4 v[2][2]; float ss = 0.f;
#pragma unroll
                for (int bj = 0; bj < 2; ++bj)
#pragma unroll
                    for (int n = 0; n < 2; ++n) { v[bj][n] = acc[ai][bj][m][n] * rs; const f32x4 t = v[bj][n]; ss += (t[0] * t[0] + t[1] * t[1]) + (t[2] * t[2] + t[3] * t[3]); }
                ss += __shfl_xor(ss, 16); ss += __shfl_xor(ss, 32);
                const float rn = gsc * __builtin_amdgcn_rsqf(ss * (1.0f / HD) + EPS);
#pragma unroll
                for (int bj = 0; bj < 2; ++bj) {
                    f32x4 a = v[bj][0], b = v[bj][1];
                    if (nrm) { a = a * (bj == 0 ? g00 : g10) * rn; b = b * (bj == 0 ? g01 : g11) * rn; }
                    v4u w; w.x = pk2(a[0], a[1]); w.y = pk2(a[2], a[3]); w.z = pk2(b[0], b[1]); w.w = pk2(b[2], b[3]);
                    *(v4u*)(base + (size_t)row * DM + h * HD + 32 * bj + 8 * fq) = w;
                }
            }
    }
};
struct ZMerge {
    static constexpr bool PERM = true, AFTER_DRAIN = false, DUP = false;
    const float* ssq; const bf16_t* O0; const bf16_t* O1; const bf16_t* O2; const float* lse; bf16_t* Y;
    struct RowIn { v4u a[2], b[2], c[2]; f32x4 sq; float l0, l1, l2; };
    __device__ __forceinline__ void load_row(RowIn& r, int row, int h, int fq) const {
        const size_t off = (size_t)row * DM + h * HD + 8 * fq;
        r.sq = *(const f32x4*)(ssq + (size_t)row * 16 + 4 * fq);
        r.l0 = lse[((size_t)0 * MROWS + row) * 16 + h]; r.l1 = lse[((size_t)1 * MROWS + row) * 16 + h]; r.l2 = lse[((size_t)2 * MROWS + row) * 16 + h];
#pragma unroll
        for (int bj = 0; bj < 2; ++bj) { r.a[bj] = *(const v4u*)(O0 + off + 32 * bj); r.b[bj] = *(const v4u*)(O1 + off + 32 * bj); r.c[bj] = *(const v4u*)(O2 + off + 32 * bj); }
    }
    template <class Sched> __device__ __forceinline__ void begin(LAS unsigned char*, const Sched&, int) const {}
    __device__ __forceinline__ void operator()(const f32x4 (&acc)[2][2][4][2], const Unit& u, int wr, int wc, int fr, int fq, int) const {
        const int h = u.pn * 4 + wc, row0 = u.pm * 256 + wr * 64 + fr;
        RowIn in[2];
        load_row(in[0], row0, h, fq);
#pragma unroll
        for (int i = 0; i < 8; ++i) {
            const int ai = i >> 2, m = i & 3, row = row0 + ai * 128 + m * 16;
            if (i + 1 < 8) load_row(in[(i + 1) & 1], row0 + ((i + 1) >> 2) * 128 + ((i + 1) & 3) * 16, h, fq);
            const RowIn& r = in[i & 1];
            float tq = (r.sq[0] + r.sq[1]) + (r.sq[2] + r.sq[3]); tq += __shfl_xor(tq, 16); tq += __shfl_xor(tq, 32);
            const float rs = __builtin_amdgcn_rsqf(tq * (1.0f / DM) + EPS);
            const float mx = fmaxf(r.l0, fmaxf(r.l1, r.l2));
            float w0 = __builtin_amdgcn_exp2f(r.l0 - mx), w1 = __builtin_amdgcn_exp2f(r.l1 - mx), w2 = __builtin_amdgcn_exp2f(r.l2 - mx);
            const float inv = __builtin_amdgcn_rcpf(w0 + w1 + w2); w0 *= inv; w1 *= inv; w2 *= inv;
#pragma unroll
            for (int bj = 0; bj < 2; ++bj) {
                const v4u a = r.a[bj], b = r.b[bj], c = r.c[bj];
                float o[8];
#pragma unroll
                for (int k = 0; k < 4; ++k) { o[2 * k] = w0 * bflo(a[k]) + w1 * bflo(b[k]) + w2 * bflo(c[k]); o[2 * k + 1] = w0 * bfhi(a[k]) + w1 * bfhi(b[k]) + w2 * bfhi(c[k]); }
                const f32x4 z0 = acc[ai][bj][m][0] * rs, z1 = acc[ai][bj][m][1] * rs;
                float y[8];
#pragma unroll
                for (int k = 0; k < 4; ++k) { y[k] = o[k] * z0[k] * sigmoidf_(z0[k]); y[4 + k] = o[4 + k] * z1[k] * sigmoidf_(z1[k]); }
                v4u w; w.x = pk2(y[0], y[1]); w.y = pk2(y[2], y[3]); w.z = pk2(y[4], y[5]); w.w = pk2(y[6], y[7]);
                *(v4u*)(Y + (size_t)row * DM + h * HD + 32 * bj + 8 * fq) = w;
            }
        }
    }
};
}

namespace naive {
template <class AL, class BL, class EP>
__device__ __forceinline__ void gemm_tile(LAS float* sm, int K, int row0, const AL& al, const BL& bl, const EP& ep) {
    const int tid = threadIdx.x, tx = tid & 15, ty = tid >> 4;
    LAS float* sA = sm; LAS float* sB = sm + 16 * 132;
    float acc[4][4];
#pragma unroll
    for (int i = 0; i < 4; ++i)
#pragma unroll
        for (int j = 0; j < 4; ++j) acc[i][j] = 0.f;
    for (int k0 = 0; k0 < K; k0 += 16) {
#pragma unroll
        for (int i = 0; i < 4; ++i) { const int idx = tid + 512 * i, r = idx >> 4, kk = idx & 15; sA[kk * 132 + r] = al(row0 + r, k0 + kk); }
#pragma unroll
        for (int i = 0; i < 2; ++i) { const int idx = tid + 512 * i, kk = idx >> 6, c = idx & 63; sB[kk * 68 + c] = bl(k0 + kk, c); }
        __syncthreads();
#pragma unroll
        for (int kk = 0; kk < 16; ++kk) {
            float a[4], b[4];
#pragma unroll
            for (int i = 0; i < 4; ++i) a[i] = sA[kk * 132 + ty * 4 + i];
#pragma unroll
            for (int j = 0; j < 4; ++j) b[j] = sB[kk * 68 + tx + 16 * j];
#pragma unroll
            for (int i = 0; i < 4; ++i)
#pragma unroll
                for (int j = 0; j < 4; ++j) acc[i][j] = fmaf(a[i], b[j], acc[i][j]);
        }
        __syncthreads();
    }
#pragma unroll
    for (int i = 0; i < 4; ++i) ep(row0 + ty * 4 + i, tx, acc[i][0], acc[i][1], acc[i][2], acc[i][3]);
}
struct ALbf { const bf16* A; int ld; __device__ __forceinline__ float operator()(int r, int k) const { return bf2f(A[(size_t)r * ld + k]); } };
__device__ __forceinline__ float red16(float v) { v += __shfl_xor(v, 1); v += __shfl_xor(v, 2); v += __shfl_xor(v, 4); v += __shfl_xor(v, 8); return v; }

struct BLc1 { const float* w; const float* nrm; int ct; __device__ __forceinline__ float operator()(int k, int c) const { return w[(size_t)k * CN + (c >> 4) * CE + ct * 16 + (c & 15)] * nrm[k]; } };
struct EPc1 { const float* ssq; bf16* V; bf16* G; int ct;
    __device__ __forceinline__ void operator()(int row, int tx, float a0, float a1, float a2, float a3) const {
        const float rs = row_rs(ssq, row); const float b = a0 * rs, c = a1 * rs, u = a2 * rs, z = a3 * rs;
        const int e = ct * 16 + tx; V[(size_t)row * CE + e] = (bf16)f2bf(c * u); G[(size_t)row * CE + e] = (bf16)f2bf(b * z * sigmoidf_(z)); } };
__device__ __forceinline__ void c1(LAS float* sm, const bf16* xb, const float* ssq, const float* w, const float* nrm, bf16* V, bf16* G, int bid, int nb) {
    const int nct = CE / 16, ntile = (MROWS / 128) * nct;
    for (int t = bid; t < ntile; t += nb) { const int rt = t / nct, ct = t % nct; gemm_tile(sm, DM, rt * 128, ALbf{xb, DM}, BLc1{w, nrm, ct}, EPc1{ssq, V, G, ct}); }
}
struct BLres { const float* w; int ct; __device__ __forceinline__ float operator()(int k, int c) const { return w[(size_t)k * DM + ct * 64 + c]; } };
struct EPres { const float* xin; float* xout; bf16* xb; float* ssq; int ct;
    __device__ __forceinline__ void operator()(int row, int tx, float a0, float a1, float a2, float a3) const {
        const size_t o = (size_t)row * DM + ct * 64 + tx;
        const float x0 = xin[o] + a0, x1 = xin[o + 16] + a1, x2 = xin[o + 32] + a2, x3 = xin[o + 48] + a3;
        xout[o] = x0; xout[o + 16] = x1; xout[o + 32] = x2; xout[o + 48] = x3;
        xb[o] = (bf16)f2bf(x0); xb[o + 16] = (bf16)f2bf(x1); xb[o + 32] = (bf16)f2bf(x2); xb[o + 48] = (bf16)f2bf(x3);
        const float ss = red16((x0 * x0 + x1 * x1) + (x2 * x2 + x3 * x3));
        if (tx == 0) ssq[(size_t)row * 16 + ct] = ss; } };
__device__ __forceinline__ void resid(LAS float* sm, const bf16* A, int K, const float* w, const float* xin, float* xout, bf16* xb, float* ssq, int bid, int nb) {
    const int ntile = (MROWS / 128) * 16;
    for (int t = bid; t < ntile; t += nb) { const int rt = t / 16, ct = t % 16; gemm_tile(sm, K, rt * 128, ALbf{A, K}, BLres{w, ct}, EPres{xin, xout, xb, ssq, ct}); }
}
struct BLa1 { const float* w; const float* nrm; int col0; __device__ __forceinline__ float operator()(int k, int c) const { return w[(size_t)k * AN + col0 + c] * nrm[k]; } };
struct EPa1 { const float* ssq; bf16* dst; const float* gain; float sc; int h;
    __device__ __forceinline__ void operator()(int row, int tx, float a0, float a1, float a2, float a3) const {
        const float rs = row_rs(ssq, row); float v0 = a0 * rs, v1 = a1 * rs, v2 = a2 * rs, v3 = a3 * rs;
        const float ss = red16((v0 * v0 + v1 * v1) + (v2 * v2 + v3 * v3));
        if (gain) { const float rn = sc / sqrtf(ss * (1.0f / HD) + EPS); v0 *= rn * gain[tx]; v1 *= rn * gain[tx + 16]; v2 *= rn * gain[tx + 32]; v3 *= rn * gain[tx + 48]; }
        const size_t o = (size_t)row * DM + h * HD + tx;
        dst[o] = (bf16)f2bf(v0); dst[o + 16] = (bf16)f2bf(v1); dst[o + 32] = (bf16)f2bf(v2); dst[o + 48] = (bf16)f2bf(v3); } };
__device__ __forceinline__ void a1(LAS float* sm, const bf16* xb, const float* ssq, const float* w, const float* nrm, int g, const float* qg, const float* kg, bf16* Q, bf16* K, bf16* V, int bid, int nb) {
    const int ntile = (MROWS / 128) * 48;
    for (int t = bid; t < ntile; t += nb) { const int rt = t / 48, ct = t % 48, which = ct / 16, h = ct % 16;
        gemm_tile(sm, DM, rt * 128, ALbf{xb, DM}, BLa1{w, nrm, g * 3072 + which * 1024 + h * 64},
                  EPa1{ssq, which == 0 ? Q : (which == 1 ? K : V), which == 0 ? qg : (which == 1 ? kg : nullptr), which == 0 ? QSCALE : 1.0f, h}); }
}
struct EPa3 { const float* ssq; const bf16* O0; const bf16* O1; const bf16* O2; const float* lse; bf16* Y; int h;
    __device__ __forceinline__ void operator()(int row, int tx, float a0, float a1, float a2, float a3) const {
        const float rs = row_rs(ssq, row);
        const float l0 = lse[((size_t)0 * MROWS + row) * 16 + h], l1 = lse[((size_t)1 * MROWS + row) * 16 + h], l2 = lse[((size_t)2 * MROWS + row) * 16 + h];
        const float mx = fmaxf(l0, fmaxf(l1, l2)); float w0 = exp2f(l0 - mx), w1 = exp2f(l1 - mx), w2 = exp2f(l2 - mx); const float inv = 1.0f / (w0 + w1 + w2); w0 *= inv; w1 *= inv; w2 *= inv;
        const float zz[4] = {a0 * rs, a1 * rs, a2 * rs, a3 * rs};
#pragma unroll
        for (int j = 0; j < 4; ++j) { const size_t o = (size_t)row * DM + h * HD + tx + 16 * j;
            const float ov = w0 * bf2f(O0[o]) + w1 * bf2f(O1[o]) + w2 * bf2f(O2[o]); Y[o] = (bf16)f2bf(ov * zz[j] * sigmoidf_(zz[j])); } } };
__device__ __forceinline__ void a3(LAS float* sm, const bf16* xb, const float* ssq, const float* w, const float* nrm, const bf16* O0, const bf16* O1, const bf16* O2, const float* lse, bf16* Y, int bid, int nb) {
    const int ntile = (MROWS / 128) * 16;
    for (int t = bid; t < ntile; t += nb) { const int rt = t / 16, h = t % 16; gemm_tile(sm, DM, rt * 128, ALbf{xb, DM}, BLa1{w, nrm, QKVC + h * 64}, EPa3{ssq, O0, O1, O2, lse, Y, h}); }
}
__device__ __forceinline__ void a2(bf16* QO, const bf16* K, const bf16* V, const float* biasT  , float* lse  , int dil, int gtid, int gthreads) {
    for (int idx = gtid; idx < MROWS * NH; idx += gthreads) {
        const int row = idx >> 4, h = idx & 15, t = row & (SEQ - 1);
        bf16* qp = QO + (size_t)row * DM + h * HD;
        float q[64], o[64];
#pragma unroll
        for (int c = 0; c < 8; ++c) { const v4u w = *(const v4u*)(qp + 8 * c);
#pragma unroll
            for (int i = 0; i < 4; ++i) { q[8 * c + 2 * i] = bflo(w[i]); q[8 * c + 2 * i + 1] = bfhi(w[i]); } }
#pragma unroll
        for (int d = 0; d < 64; ++d) o[d] = 0.f;
        float m = -INFINITY, l = 0.f;
        for (int j = 0; j <= 128; ++j) {
            const int tk = t - dil * j; if (tk < 0) break;
            const size_t ko = (size_t)(row - dil * j) * DM + h * HD;
            float s = 0.f;
#pragma unroll
            for (int c = 0; c < 8; ++c) { const v4u w = *(const v4u*)(K + ko + 8 * c);
#pragma unroll
                for (int i = 0; i < 4; ++i) { s = fmaf(q[8 * c + 2 * i], bflo(w[i]), s); s = fmaf(q[8 * c + 2 * i + 1], bfhi(w[i]), s); } }
            s += biasT[h * 132 + j];
            const float mn = fmaxf(m, s), f = exp2f(m - mn), p = exp2f(s - mn);
            l = l * f + p; m = mn;
#pragma unroll
            for (int c = 0; c < 8; ++c) { const v4u w = *(const v4u*)(V + ko + 8 * c);
#pragma unroll
                for (int i = 0; i < 4; ++i) { o[8 * c + 2 * i] = o[8 * c + 2 * i] * f + p * bflo(w[i]); o[8 * c + 2 * i + 1] = o[8 * c + 2 * i + 1] * f + p * bfhi(w[i]); } }
        }
        const float il = 1.0f / l;
#pragma unroll
        for (int c = 0; c < 8; ++c) { v4u w;
#pragma unroll
            for (int i = 0; i < 4; ++i) w[i] = pk2(o[8 * c + 2 * i] * il, o[8 * c + 2 * i + 1] * il);
            *(v4u*)(qp + 8 * c) = w; }
        lse[(size_t)row * 16 + h] = m + log2f(l);
    }
}
}

template <int MODE> __device__ __forceinline__ int wt_dest_row(int n) {
    if (MODE == 1) { const int type = n >> 11, e = n & 2047, pn = e >> 6, el = e & 63; return 256 * pn + 128 * (type >> 1) + 32 * (el >> 4) + 16 * (type & 1) + (el & 15); }
    if (MODE == 3) { const int blk = n >> 10, r = n & 1023, h = r >> 6, d = r & 63; return blk * 1024 + 256 * (h >> 2) + 128 * (d >> 5) + 32 * (h & 3) + (d & 31); }
    return n;
}
template <int MODE> __device__ __forceinline__ void p0_transpose_item(const float* W, int K, int N, const float* scale, bf16* WT, LAS float* scr  , int item, int lane) {
    const int nblk = N / 64, kb = item / nblk, nb = item % nblk, k0 = 64 * kb, n0 = 64 * nb;
    const int kr = lane >> 4, c4 = lane & 15;
    f32x4 v[16];
#pragma unroll
    for (int i = 0; i < 16; ++i) v[i] = *(const GAS f32x4*)(W + (size_t)(k0 + 4 * i + kr) * N + n0 + 4 * c4);
#pragma unroll
    for (int i = 0; i < 16; ++i) { const float s = scale ? scale[k0 + 4 * i + kr] : 1.0f; LAS float* d = scr + (4 * i + kr) * 65 + 4 * c4;
        d[0] = v[i][0] * s; d[1] = v[i][1] * s; d[2] = v[i][2] * s; d[3] = v[i][3] * s; }
    LDS_WAIT(); asm volatile("" ::: "memory");
    const int c = lane & 7, nl = lane >> 3;
#pragma unroll
    for (int j = 0; j < 8; ++j) { const int n = nl + 8 * j; const LAS float* s = scr + (8 * c) * 65 + n;
        v4u o; o.x = pk2(s[0 * 65], s[1 * 65]); o.y = pk2(s[2 * 65], s[3 * 65]); o.z = pk2(s[4 * 65], s[5 * 65]); o.w = pk2(s[6 * 65], s[7 * 65]);
        *(GAS v4u*)(WT + (size_t)wt_dest_row<MODE>(n0 + n) * K + k0 + 8 * c) = o; }
    LDS_WAIT(); asm volatile("" ::: "memory");
}
struct Ptrs {
    const float *x, *conv_norm, *conv_w_in, *conv_w, *conv_w_out, *attn_norm, *attn_w_in, *q_gain, *k_gain, *attn_w_out, *rel_bias;
    float* out; unsigned char* ws;
};
__device__ __forceinline__ void p0_prologue(const Ptrs& P, LAS unsigned char* lds, int vcu, int G, int wave, int lane, int tid) {
    LAS float* scr = (LAS float*)(lds + wave * 16640);
    const int gw = vcu * 8 + wave, NGW = G * 8;
    bf16* W1 = (bf16*)(P.ws + WS_W1); bf16* W2 = (bf16*)(P.ws + WS_W2); bf16* W3 = (bf16*)(P.ws + WS_W3); bf16* W4 = (bf16*)(P.ws + WS_W4);
    constexpr int I1 = (DM / 64) * (CN / 64), I2 = (CE / 64) * (DM / 64), I3 = (DM / 64) * (AN / 64), I4 = (DM / 64) * (DM / 64), IL = I1 + I2 + I3 + I4;
    for (int it = gw; it < 2 * IL; it += NGW) {
        const int j = it / IL; int r = it % IL;
        if (r < I1) { p0_transpose_item<1>(P.conv_w_in + (size_t)j * DM * CN, DM, CN, P.conv_norm + j * DM, W1 + (size_t)j * CN * DM, scr, r, lane); continue; } r -= I1;
        if (r < I2) { p0_transpose_item<0>(P.conv_w_out + (size_t)j * CE * DM, CE, DM, nullptr, W2 + (size_t)j * DM * CE, scr, r, lane); continue; } r -= I2;
        if (r < I3) { p0_transpose_item<3>(P.attn_w_in + (size_t)j * DM * AN, DM, AN, P.attn_norm + j * DM, W3 + (size_t)j * AN * DM, scr, r, lane); continue; } r -= I3;
        p0_transpose_item<0>(P.attn_w_out + (size_t)j * DM * DM, DM, DM, nullptr, W4 + (size_t)j * DM * DM, scr, r, lane);
    }
    bf16* XB = (bf16*)(P.ws + WS_XB); float* SSQ = (float*)(P.ws + WS_SSQ);
    for (int m = 2 * gw; m < MROWS; m += 2 * NGW) {
        const GAS f32x4* xr = (const GAS f32x4*)(P.x + (size_t)m * DM) + lane;
        GAS v2u* o8 = (GAS v2u*)(XB + (size_t)m * DM) + lane;
        f32x4 v[8];
#pragma unroll
        for (int jj = 0; jj < 8; ++jj) v[jj] = xr[64 * jj];
        float s0 = 0.f, s1 = 0.f;
#pragma unroll
        for (int jj = 0; jj < 8; ++jj) { const f32x4 t = v[jj]; const float q = (t.x * t.x + t.y * t.y) + (t.z * t.z + t.w * t.w); if (jj < 4) s0 += q; else s1 += q;
            v2u w; w.x = pk2(t.x, t.y); w.y = pk2(t.z, t.w); o8[64 * jj] = w; }
        s0 = wave_sum(s0); s1 = wave_sum(s1);
        if (lane < 32) SSQ[(size_t)m * 16 + lane] = lane == 0 ? s0 : (lane == 16 ? s1 : 0.f);
    }
    float* BT = (float*)(P.ws + WS_BIAS);
    for (int i = vcu * 512 + tid; i < NG * NH * 132; i += G * 512) {
        const int g = i / (NH * 132), r = i % (NH * 132), h = r / 132, st = r % 132;
        const int dil = g == 0 ? 1 : (g == 1 ? 4 : 16);
        BT[i] = st <= 128 ? P.rel_bias[t5_bucket(st * dil) * (NG * NH) + g * NH + h] * LOG2E : 0.f;
    }
}
template <bool WRAP> __device__ __forceinline__ void conv_pass(const bf16* V, const bf16* GY, bf16* OUT, const float* cw  , int gtid, int gthreads) {
    for (int idx = gtid; idx < MROWS * (CE / 8); idx += gthreads) {
        const int row = idx / (CE / 8), e0 = (idx % (CE / 8)) * 8, t = row & (SEQ - 1);
        const size_t o = (size_t)row * CE + e0;
        const v4u g = *(const v4u*)(GY + o), v2 = *(const v4u*)(V + o);
        v4u v1 = (v4u){0u, 0u, 0u, 0u}, v0 = (v4u){0u, 0u, 0u, 0u};
        if (t >= 1) v1 = *(const v4u*)(V + o - CE);
        if (t >= 2) v0 = *(const v4u*)(V + o - 2 * CE);
        float w0[8], w1[8], w2[8];
#pragma unroll
        for (int c = 0; c < 2; ++c) { const f32x4 a = *(const f32x4*)(cw + e0 + 4 * c), b = *(const f32x4*)(cw + CE + e0 + 4 * c), d = *(const f32x4*)(cw + 2 * CE + e0 + 4 * c);
#pragma unroll
            for (int i = 0; i < 4; ++i) { w0[4 * c + i] = a[i]; w1[4 * c + i] = b[i]; w2[4 * c + i] = d[i]; } }
        float y[8];
#pragma unroll
        for (int i = 0; i < 4; ++i) {
            y[2 * i] = bflo(g[i]) * (w0[2 * i] * bflo(v0[i]) + w1[2 * i] * bflo(v1[i]) + w2[2 * i] * bflo(v2[i]));
            y[2 * i + 1] = bfhi(g[i]) * (w0[2 * i + 1] * bfhi(v0[i]) + w1[2 * i + 1] * bfhi(v1[i]) + w2[2 * i + 1] * bfhi(v2[i]));
        }
        v4u w; w.x = pk2(y[0], y[1]); w.y = pk2(y[2], y[3]); w.z = pk2(y[4], y[5]); w.w = pk2(y[6], y[7]);
        *(v4u*)(OUT + (WRAP ? (o & (size_t)(16 * 1024 * 1024 - 1)) : o)) = w;
    }
}

__device__ __forceinline__ void conv_fixup(bf16* Y, const float* side, const float* cw, int pm, int tid) {
    if ((pm & 15) == 0) return;
    const int ch = 4 * tid;
    const f32x4 g0 = *(const f32x4*)(side + ((size_t)pm * 6 + 0) * CE + ch), g1 = *(const f32x4*)(side + ((size_t)pm * 6 + 1) * CE + ch);
    const f32x4 c0 = *(const f32x4*)(side + ((size_t)pm * 6 + 2) * CE + ch), c1 = *(const f32x4*)(side + ((size_t)pm * 6 + 3) * CE + ch);
    const f32x4 va = *(const f32x4*)(side + ((size_t)(pm - 1) * 6 + 4) * CE + ch), vb = *(const f32x4*)(side + ((size_t)(pm - 1) * 6 + 5) * CE + ch);
    const f32x4 w0 = *(const f32x4*)(cw + ch), w1 = *(const f32x4*)(cw + CE + ch);
    const f32x4 y0 = g0 * (c0 + w1 * vb + w0 * va), y1 = g1 * (c1 + w0 * vb);
    v2u a, b; a.x = pk2(y0[0], y0[1]); a.y = pk2(y0[2], y0[3]); b.x = pk2(y1[0], y1[1]); b.y = pk2(y1[2], y1[3]);
    *(v2u*)(Y + (size_t)(pm * 256) * CE + ch) = a; *(v2u*)(Y + (size_t)(pm * 256 + 1) * CE + ch) = b;
}

namespace attn {
typedef float f32x16 __attribute__((ext_vector_type(16)));
typedef short s16x4 __attribute__((ext_vector_type(4)));
typedef short v4i16_t __attribute__((ext_vector_type(4)));
constexpr int L_K = 0, L_V = 49152, L_B = 98304, L_O = 118784, L_END = 151552, L_WS = 161536 + 256;
static_assert(L_O + 8 * 4096 == L_END && L_B + 5 * 4096 == L_O, "attention LDS map");
__device__ __forceinline__ int crow(int r, int hi) { return (r & 3) + 8 * (r >> 2) + 4 * hi; }
__device__ __forceinline__ s16x4 vtr(LAS const unsigned char* p) { return __builtin_bit_cast(s16x4, __builtin_amdgcn_ds_read_tr16_b64_v4i16((LAS v4i16_t*)p)); }
__device__ __forceinline__ float swapmax(float m) { auto rr = __builtin_amdgcn_permlane32_swap(__float_as_uint(m), __float_as_uint(m), false, false); return fmaxf(__uint_as_float(rr[0]), __uint_as_float(rr[1])); }
__device__ __forceinline__ float swapsum(float m) { auto rr = __builtin_amdgcn_permlane32_swap(__float_as_uint(m), __float_as_uint(m), false, false); return __uint_as_float(rr[0]) + __uint_as_float(rr[1]); }

#define ATT_BAR() asm volatile("s_waitcnt lgkmcnt(0)\n\ts_barrier" ::: "memory")
__device__ __forceinline__ void glds16(const void* gsrc, unsigned lds_dst) { unsigned keep;
    asm volatile("s_mov_b32 %0, m0\n\ts_mov_b32 m0, %2\n\ts_nop 0\n\tglobal_load_lds_dwordx4 %1, off\n\ts_mov_b32 m0, %0" : "=&s"(keep) : "v"(gsrc), "s"(lds_dst) : "memory"); }
template <int DIL> struct Job {
    int bh, c, n0, h; size_t rowb;
    __device__ __forceinline__ void decode(int id) { constexpr int CPC = (SEQ / DIL) / 256; bh = id >> 4; const int sub = id & 15; c = sub / CPC; n0 = (sub % CPC) * 256; h = bh & 15; rowb = (size_t)(bh >> 4) * SEQ; }
};
template <int DIL, bool ISV> __device__ __forceinline__ void issue_kv(LAS unsigned char* lds, const bf16* src, const Job<DIL>& J, int w, int lane) {
#pragma unroll
    for (int i = 0; i < 6; ++i) {
        const int kb = w * 6 + i, row = kb * 8 + (lane >> 3), pc = lane & 7;
        int pos = J.n0 - 128 + row; pos = pos < 0 ? 0 : pos;
        const size_t ro = (J.rowb + (size_t)pos * DIL + J.c) * DM + J.h * HD;
        const int sw = ISV ? ((((pc >> 2) ^ ((row >> 1) & 1)) * 32) + (pc & 3) * 8) : ((pc ^ ((row >> 1) & 7)) * 8);
        glds16(src + ro + sw, (unsigned)__builtin_amdgcn_readfirstlane((int)((unsigned)(uintptr_t)lds + (ISV ? L_V : L_K) + kb * 1024)));
    }
}
__device__ __forceinline__ void ld16_asm(bf16x8& dst, const bf16* p) { asm volatile("global_load_dwordx4 %0, %1, off" : "=v"(dst) : "v"(p) : "memory"); }

template <int DIL> __device__ __forceinline__ void phase(LAS unsigned char* lds, const bf16* QO, bf16* OUT, const bf16* Kg, const bf16* Vg, const float* biasT  , float* lse  , int vcu, int G) {
    const int tid = threadIdx.x, lane = tid & 63, r32 = lane & 31, hi = lane >> 5;
    const int w = __builtin_amdgcn_readfirstlane(tid >> 6);
    constexpr int NJS = BATCH * NH * 16;
    int id = vcu * 4;
    if (id >= NJS) return;
    Job<DIL> J; J.decode(id);
    bf16x8 q0, q1, q2, q3;
    issue_kv<DIL, false>(lds, Kg, J, w, lane);
    { const bf16* qp = QO + (J.rowb + (size_t)(J.n0 + 32 * w + r32) * DIL + J.c) * DM + J.h * HD + hi * 8; ld16_asm(q0, qp); ld16_asm(q1, qp + 16); ld16_asm(q2, qp + 32); ld16_asm(q3, qp + 48); }
    issue_kv<DIL, true>(lds, Vg, J, w, lane);
    int cur_bh = -1; bool first = true;
    for (;;) {
        const int nid = id + (((id & 3) == 3) ? (G * 4 - 3) : 1);
        const bool has_next = nid < NJS;
        Job<DIL> JN; JN.decode(has_next ? nid : id);
        if (J.bh != cur_bh) {
            cur_bh = J.bh;
#pragma unroll
            for (int i = 0; i < 10; ++i) {
                const int e = tid + 512 * i, j = e >> 10, rem = e & 1023, rg = rem >> 8, ln = (rem & 255) >> 2, i4 = rem & 3;
                const int r = 4 * rg + i4, a = ln & 31, hh = ln >> 5, kk = 32 * j + crow(r, hh), step = 128 + a - kk;
                float val = -INFINITY;
                if (step >= 0 && step <= 128) val = biasT[J.h * 132 + step];
                ((LAS float*)(lds + L_B))[e] = val;
            }
        }
        if (first) { first = false; asm volatile("s_waitcnt vmcnt(6)" : "+v"(q0), "+v"(q1), "+v"(q2), "+v"(q3) :: "memory"); }
        ATT_BAR();
        const int n0 = J.n0, h = J.h, c = J.c; const size_t rowb = J.rowb;
        const size_t qrow = rowb + (size_t)(n0 + 32 * w + r32) * DIL + c;
        const int jstart = (n0 == 0 && w < 4) ? 4 - w : 0;
        f32x16 S[5];
#pragma unroll
        for (int j = 0; j < 5; ++j) {
            if (j < jstart) {
#pragma unroll
                for (int r = 0; r < 16; ++r) S[j][r] = -INFINITY;
            } else {
                f32x16 cinit;
#pragma unroll
                for (int rg = 0; rg < 4; ++rg) { const f32x4 t = *(const LAS f32x4*)(lds + L_B + j * 4096 + rg * 1024 + lane * 16); cinit[4 * rg] = t[0]; cinit[4 * rg + 1] = t[1]; cinit[4 * rg + 2] = t[2]; cinit[4 * rg + 3] = t[3]; }
#pragma unroll
                for (int d0 = 0; d0 < 4; ++d0) {
                    const bf16x8 kf = *(const LAS bf16x8*)(lds + L_K + (32 * w + 32 * j + r32) * 128 + (((2 * d0 + hi) ^ ((r32 >> 1) & 7)) * 16));
                    cinit = __builtin_amdgcn_mfma_f32_32x32x16_bf16(kf, d0 == 0 ? q0 : (d0 == 1 ? q1 : (d0 == 2 ? q2 : q3)), cinit, 0, 0, 0);
                }
                S[j] = cinit;
            }
        }
        ATT_BAR();
        bf16x8 n0q, n1q, n2q, n3q;
        if (has_next) {
            issue_kv<DIL, false>(lds, Kg, JN, w, lane);
            const bf16* qp = QO + (JN.rowb + (size_t)(JN.n0 + 32 * w + r32) * DIL + JN.c) * DM + JN.h * HD + hi * 8; ld16_asm(n0q, qp); ld16_asm(n1q, qp + 16); ld16_asm(n2q, qp + 32); ld16_asm(n3q, qp + 48);
        }
        float m = -INFINITY;
#pragma unroll
        for (int j = 0; j < 5; ++j)
#pragma unroll
            for (int r = 0; r < 16; ++r) m = fmaxf(m, S[j][r]);
        m = swapmax(m);
        float lsum = 0.f;
#pragma unroll
        for (int j = 0; j < 5; ++j)
#pragma unroll
            for (int r = 0; r < 16; ++r) { const float p = __builtin_amdgcn_exp2f(S[j][r] - m); S[j][r] = p; lsum += p; }
        lsum = swapsum(lsum);
        if (has_next) asm volatile("s_waitcnt vmcnt(10)" ::: "memory"); else asm volatile("s_waitcnt vmcnt(0)" ::: "memory");
        ATT_BAR();
        f32x16 o[2];
#pragma unroll
        for (int r = 0; r < 16; ++r) { o[0][r] = 0.f; o[1][r] = 0.f; }
        const int vq = (lane & 15) >> 2, vx = (vq >> 1) & 1;
        const LAS unsigned char* vrow = lds + L_V + (32 * w + 4 * hi + vq) * 128 + ((lane >> 4) & 1) * 32 + (lane & 3) * 8;
        const LAS unsigned char* vbh[2] = {vrow + vx * 64, vrow + (1 - vx) * 64};
#pragma unroll
        for (int j = 0; j < 5; ++j)
#pragma unroll
            for (int s = 0; s < 2; ++s) {
                v4u pw; pw.x = pk2(S[j][8 * s], S[j][8 * s + 1]); pw.y = pk2(S[j][8 * s + 2], S[j][8 * s + 3]); pw.z = pk2(S[j][8 * s + 4], S[j][8 * s + 5]); pw.w = pk2(S[j][8 * s + 6], S[j][8 * s + 7]);
                const bf16x8 pa = __builtin_bit_cast(bf16x8, pw);
#pragma unroll
                for (int d0 = 0; d0 < 2; ++d0) {
                    const s16x4 lo = vtr(vbh[d0] + (32 * j + 16 * s) * 128), hh = vtr(vbh[d0] + (32 * j + 16 * s + 8) * 128);
                    const bf16x8 vf = (bf16x8){lo[0], lo[1], lo[2], lo[3], hh[0], hh[1], hh[2], hh[3]};
                    o[d0] = __builtin_amdgcn_mfma_f32_32x32x16_bf16(pa, vf, o[d0], 0, 0, 0);
                }
            }
        ATT_BAR();
        if (has_next) issue_kv<DIL, true>(lds, Vg, JN, w, lane);
        LAS float* wsf = (LAS float*)(lds + L_WS) + w * 64;
        if (hi == 0) { wsf[r32] = lsum; lse[qrow * 16 + h] = m + log2f(lsum); }
        asm volatile("s_waitcnt lgkmcnt(0)" ::: "memory");
        float rli[16];
#pragma unroll
        for (int r = 0; r < 16; ++r) rli[r] = __builtin_amdgcn_rcpf(wsf[crow(r, hi)]);
        LAS bf16* stg = (LAS bf16*)(lds + L_O) + w * 2048;
#pragma unroll
        for (int r = 0; r < 16; ++r) { const int orow = crow(r, hi);
#pragma unroll
            for (int d0 = 0; d0 < 2; ++d0) stg[orow * 64 + d0 * 32 + r32] = (bf16)(pk2(o[d0][r] * rli[r], 0.f) & 0xffffu); }
        asm volatile("s_waitcnt lgkmcnt(0)" ::: "memory");
#pragma unroll
        for (int i = 0; i < 4; ++i) { const int row = i * 8 + (lane >> 3), ch = lane & 7; const v4u v = *(const LAS v4u*)(stg + row * 64 + ch * 8);
            *(v4u*)(OUT + (rowb + (size_t)(n0 + 32 * w + row) * DIL + c) * DM + h * HD + ch * 8) = v; }
        if (!has_next) break;
        asm volatile("s_waitcnt vmcnt(6)" : "+v"(n0q), "+v"(n1q), "+v"(n2q), "+v"(n3q) :: "memory");
        id = nid; J = JN; q0 = n0q; q1 = n1q; q2 = n2q; q3 = n3q;
    }
    asm volatile("s_waitcnt vmcnt(0) lgkmcnt(0)\n\ts_barrier" ::: "memory");
}
#undef ATT_BAR
}

#ifndef OPT_C1
#define OPT_C1 0
#endif
#ifndef OPT_RES
#define OPT_RES 0
#endif
#ifndef OPT_A1
#define OPT_A1 0
#endif
#ifndef OPT_A2
#define OPT_A2 0
#endif
#ifndef OPT_A3
#define OPT_A3 0
#endif
#ifndef DUP_A2
#define DUP_A2 0
#endif
#ifndef DUP_A1
#define DUP_A1 0
#endif
#ifndef DUP_C1
#define DUP_C1 0
#endif
#ifndef DUP_A3
#define DUP_A3 0
#endif
#ifndef DUP_P0
#define DUP_P0 0
#endif
#ifndef DUP_C3
#define DUP_C3 0
#endif
#ifndef DUP_C2
#define DUP_C2 0
#endif
#ifndef DUP_BAR
#define DUP_BAR 0
#endif
#ifndef FUSE_CONV
#define FUSE_CONV 0
#endif
#ifndef RES_BF16
#define RES_BF16 0
#endif
#ifndef MK_PER_PHASE
#define MK_PER_PHASE 1
#endif
constexpr int LDS_BYTES = 163840;
constexpr int XCH_OFF = 131072;
constexpr int MISC_OFF = 161536;
struct Args { const float* in[11]; float* out; unsigned char* ws; int ph_lo, ph_hi; };

template <int PH> __device__ __forceinline__ void run_phase(const Args& args, LAS unsigned char* lds) {
    const int tid = threadIdx.x, lane = tid & 63, wave = __builtin_amdgcn_readfirstlane(tid >> 6);
    const int G = gridDim.x, bx = blockIdx.x, vcu = (G % 8 == 0) ? (bx % 8) * (G / 8) + bx / 8 : bx;
    unsigned char* ws = args.ws;
    float* SSQ = (float*)(ws + WS_SSQ); bf16* XB = (bf16*)(ws + WS_XB);
    LAS float* smf = (LAS float*)lds;
    const int gtid = vcu * 512 + tid, gthreads = G * 512;
    (void)lane; (void)wave; (void)smf; (void)gtid; (void)gthreads; (void)SSQ; (void)XB;
    if constexpr (PH == 0) {
        Ptrs P;
        P.x = args.in[0]; P.conv_norm = args.in[1]; P.conv_w_in = args.in[2]; P.conv_w = args.in[3]; P.conv_w_out = args.in[4]; P.attn_norm = args.in[5];
        P.attn_w_in = args.in[6]; P.q_gain = args.in[7]; P.k_gain = args.in[8]; P.attn_w_out = args.in[9]; P.rel_bias = args.in[10]; P.out = args.out; P.ws = args.ws;
#if DUP_P0
        p0_prologue(P, lds, vcu, G, wave, lane, tid);
#endif
        p0_prologue(P, lds, vcu, G, wave, lane, tid);
    } else {
        constexpr int p = PH - 1, j = p / 11, s = p % 11;
        if constexpr (s == 0) {
            bf16* CV = (bf16*)(ws + WS_CV); bf16* CG = (bf16*)(ws + WS_CG);
#if OPT_C1
            pg8::Gemm g{XB, (const bf16*)(ws + WS_W1) + (size_t)j * CN * DM, MROWS, CN, DM}; pg8::StaticOrder S; S.init(MROWS, CN, G, bx);
#if FUSE_CONV
            epi::ConvFused E{SSQ, CG, args.in[3] + (size_t)j * 3 * CE, (float*)(ws + WS_SIDE), lds + XCH_OFF};
            pg8::gemm_phase<epi::ConvFused, pg8::StaticOrder, true, true>(lds, g, S, E);
#else
            epi::ConvIn E{SSQ, CV, CG};
#if DUP_C1
            pg8::gemm_phase<epi::ConvIn, pg8::StaticOrder, true, true>(lds, g, S, E);
#endif
            pg8::gemm_phase<epi::ConvIn, pg8::StaticOrder, true, true>(lds, g, S, E);
#endif
#else
            naive::c1(smf, XB, SSQ, args.in[2] + (size_t)j * DM * CN, args.in[1] + j * DM, CV, CG, bx, G);
#endif
        } else if constexpr (s == 1) {
#if !(FUSE_CONV && OPT_C1)
#if DUP_C2
            conv_pass<true>((const bf16*)(ws + WS_CV), (bf16*)(ws + WS_CG), (bf16*)(ws + WS_END), args.in[3] + (size_t)j * 3 * CE, gtid, gthreads);
#endif
            conv_pass<false>((const bf16*)(ws + WS_CV), (bf16*)(ws + WS_CG), (bf16*)(ws + WS_CG), args.in[3] + (size_t)j * 3 * CE, gtid, gthreads);
#endif
        } else if constexpr (s == 2 || s == 10) {
            const bf16* A = (const bf16*)(ws + (s == 2 ? WS_CG : WS_Y)); constexpr int K = s == 2 ? CE : DM;
            const float* xin = (j == 0 && s == 2) ? args.in[0] : args.out;
#if OPT_RES
            pg8::Gemm g{A, (const bf16*)(ws + (s == 2 ? WS_W2 : WS_W4)) + (size_t)j * DM * K, MROWS, DM, K}; pg8::StaticOrder S; S.init(MROWS, DM, G, bx);
#if FUSE_CONV && OPT_C1 && !defined(NOFIX)
            if constexpr (s == 2) { pg8::Unit fu; for (int i = 0; S.next(i, fu); ++i) conv_fixup((bf16*)(ws + WS_CG), (const float*)(ws + WS_SIDE), args.in[3] + (size_t)j * 3 * CE, fu.pm, tid);
                asm volatile("s_waitcnt vmcnt(0)" ::: "memory"); __syncthreads(); }
#endif
#if RES_BF16
            constexpr int RMODE = (j == 0 && s == 2) ? 0 : ((j == 1 && s == 10) ? 2 : 1);
            epi::ResidB<RMODE> E{xin, args.out, XB, SSQ};
            pg8::gemm_phase<epi::ResidB<RMODE>, pg8::StaticOrder, false, true>(lds, g, S, E);
#else
            epi::Resid E{xin, args.out, XB, SSQ};
#if DUP_C3
            if constexpr (j == 0 && s == 2) pg8::gemm_phase<epi::Resid, pg8::StaticOrder, false, true>(lds, g, S, E);
#endif
            pg8::gemm_phase<epi::Resid, pg8::StaticOrder, false, true>(lds, g, S, E);
#endif
#else
            naive::resid(smf, A, K, s == 2 ? args.in[4] + (size_t)j * CE * DM : args.in[9] + (size_t)j * DM * DM, xin, args.out, XB, SSQ, bx, G);
#endif
        } else if constexpr (s == 9) {
            const bf16* O0 = (const bf16*)(ws + WS_QO); const bf16* O1 = O0 + (size_t)MROWS * DM; const bf16* O2 = O1 + (size_t)MROWS * DM;
            float* LSE = (float*)(ws + WS_LSE); bf16* YB = (bf16*)(ws + WS_Y);
#if OPT_A3
            pg8::Gemm g{XB, (const bf16*)(ws + WS_W3) + (size_t)j * AN * DM + (size_t)QKVC * DM, MROWS, DM, DM}; pg8::StaticOrder S; S.init(MROWS, DM, G, bx);
            epi::ZMerge E{SSQ, O0, O1, O2, LSE, YB};
#if DUP_A3
            pg8::gemm_phase<epi::ZMerge, pg8::StaticOrder, false, true>(lds, g, S, E);
#endif
            pg8::gemm_phase<epi::ZMerge, pg8::StaticOrder, false, true>(lds, g, S, E);
#else
            naive::a3(smf, XB, SSQ, args.in[6] + (size_t)j * DM * AN, args.in[5] + j * DM, O0, O1, O2, LSE, YB, bx, G);
#endif
        } else {
            constexpr int g = (s - 3) >> 1; bf16* QO = (bf16*)(ws + WS_QO) + (size_t)g * MROWS * DM;
            bf16* KB = (bf16*)(ws + WS_K); bf16* VB = (bf16*)(ws + WS_V);
            if constexpr (((s - 3) & 1) == 0) {
#if OPT_A1
                pg8::Gemm gm{XB, (const bf16*)(ws + WS_W3) + (size_t)j * AN * DM + (size_t)g * 3072 * DM, MROWS, 3072, DM}; pg8::StaticOrder S; S.init(MROWS, 3072, G, bx);
                epi::QKV E{SSQ, QO, KB, VB, args.in[7] + (j * NG + g) * HD, args.in[8] + (j * NG + g) * HD, lds};
#if DUP_A1
                pg8::gemm_phase<epi::QKV, pg8::StaticOrder, true, true>(lds, gm, S, E);
#endif
                pg8::gemm_phase<epi::QKV, pg8::StaticOrder, true, true>(lds, gm, S, E);
#else
                naive::a1(smf, XB, SSQ, args.in[6] + (size_t)j * DM * AN, args.in[5] + j * DM, g, args.in[7] + (j * NG + g) * HD, args.in[8] + (j * NG + g) * HD, QO, KB, VB, bx, G);
#endif
            } else {
                constexpr int dil = g == 0 ? 1 : (g == 1 ? 4 : 16);
                float* LSE = (float*)(ws + WS_LSE); const float* BT = (const float*)(ws + WS_BIAS);
#if OPT_A2
#if DUP_A2
                attn::phase<dil>(lds, QO, (bf16*)(ws + WS_END), KB, VB, BT + g * NH * 132, LSE + (size_t)g * MROWS * 16, vcu, G);
#endif
                attn::phase<dil>(lds, QO, QO, KB, VB, BT + g * NH * 132, LSE + (size_t)g * MROWS * 16, vcu, G);
#else
                naive::a2(QO, KB, VB, BT + g * NH * 132, LSE + (size_t)g * MROWS * 16, dil, gtid, gthreads);
#endif
            }
        }
    }
}

__global__ void __launch_bounds__(512, 2) mk_fwd(Args args) {
    extern __shared__ __attribute__((aligned(16))) unsigned char lds_raw[];
    LAS unsigned char* lds = (LAS unsigned char*)lds_raw;
    volatile LAS unsigned* MISC = (volatile LAS unsigned*)(lds + MISC_OFF);
    for (int u = threadIdx.x; u < (LDS_BYTES - MISC_OFF) / 4; u += 512) ((LAS unsigned*)(lds + MISC_OFF))[u] = 0u;
    __syncthreads();
    gu32* ctl = (gu32*)(args.ws + WS_CTL);
    XcdBarrier bar; bar.bar = (unsigned*)(ctl + CW_BAR); bar.x = 0; bar.st = nullptr;
    const int lo = args.ph_lo, hi = args.ph_hi;
    if (hi - lo > 1) bar = xcd_barrier_post((unsigned*)(ctl + CW_BAR), MISC + 8);
#ifdef KEEP_NOP_BAR
#define PH_NOP(k) 0
#else
#define PH_NOP(k) (FUSE_CONV && OPT_C1 && (k) > 0 && (((k) - 1) % 11) == 1)
#endif
#if DUP_BAR
#define RUN(k) if (lo <= (k) && (k) < hi && !PH_NOP(k)) { run_phase<(k)>(args, lds); if ((k) + 1 < hi) { xcd_barrier(bar); xcd_barrier(bar); } }
#else
#define RUN(k) if (lo <= (k) && (k) < hi && !PH_NOP(k)) { run_phase<(k)>(args, lds); if ((k) + 1 < hi) xcd_barrier(bar); }
#endif
    RUN(0) RUN(1) RUN(2) RUN(3) RUN(4) RUN(5) RUN(6) RUN(7) RUN(8) RUN(9) RUN(10) RUN(11)
    RUN(12) RUN(13) RUN(14) RUN(15) RUN(16) RUN(17) RUN(18) RUN(19) RUN(20) RUN(21) RUN(22)
#undef RUN
}

extern "C" void kernel_launch(void* const* d_in, const int* in_sizes, int n_in, void* d_out, int out_size, void* d_ws, size_t ws_size, hipStream_t stream) {
    static int grid = 0;
    if (grid == 0) {
        if (n_in != 11 || in_sizes[0] != MROWS * DM || out_size != MROWS * DM || ws_size < WS_END) { fprintf(stderr, "kernel_launch: unexpected shapes (n_in %d, ws %zu); nothing launched\n", n_in, ws_size); grid = -1; return; }
        int dev = 0, cus = 0, per_cu = 0;
        if (hipGetDevice(&dev) != hipSuccess || hipDeviceGetAttribute(&cus, hipDeviceAttributeMultiprocessorCount, dev) != hipSuccess) { grid = -1; return; }
        if (hipFuncSetAttribute((const void*)mk_fwd, hipFuncAttributeMaxDynamicSharedMemorySize, LDS_BYTES) != hipSuccess) { fprintf(stderr, "kernel_launch: hipFuncSetAttribute failed\n"); grid = -1; return; }
        if (hipOccupancyMaxActiveBlocksPerMultiprocessor(&per_cu, (const void*)mk_fwd, 512, LDS_BYTES) != hipSuccess || per_cu < 1) { fprintf(stderr, "kernel_launch: occupancy query says %d blocks per CU; nothing launched\n", per_cu); (void)hipGetLastError(); grid = -1; return; }
        grid = cus;
    }
    if (grid < 0) return;
    (void)hipMemsetAsync((char*)d_ws + WS_CTL, 0, CTL_ZERO_BYTES, stream);
    Args a{};
    for (int i = 0; i < 11; ++i) a.in[i] = (const float*)d_in[i];
    a.out = (float*)d_out; a.ws = (unsigned char*)d_ws;
#if MK_PER_PHASE
    for (int ph = 0; ph < NPHASE; ++ph) { a.ph_lo = ph; a.ph_hi = ph + 1; hipLaunchKernelGGL(mk_fwd, dim3(grid), dim3(512), LDS_BYTES, stream, a); }
#else
    a.ph_lo = 0; a.ph_hi = NPHASE; hipLaunchKernelGGL(mk_fwd, dim3(grid), dim3(512), LDS_BYTES, stream, a);
#endif
}
```

```cpp
#include <hip/hip_runtime.h>
#include <cstdio>
#include <cstdint>
#include <cmath>
namespace pg8 {
#define PG8_LAS __attribute__((address_space(3)))
typedef unsigned short bf16_t;
typedef short bf16x8 __attribute__((ext_vector_type(8)));
typedef float f32x4 __attribute__((ext_vector_type(4)));
typedef unsigned u32x4 __attribute__((ext_vector_type(4)));
constexpr int BM = 256, BK = 64, HALF = 128, HTB = HALF * BK * 2  , STAGE_BYTES = 8 * HTB, NXCD = 8, WGM = 8;

__host__ __device__ __forceinline__ int lds_byte(int r, int c) { const int st = (r >> 4) * 2 + (c >> 5), rr = r & 15, cc = c & 31, ob = rr * 64 + cc * 2; return st * 1024 + (ob ^ (((ob >> 9) & 1) << 5)); }
__host__ __device__ __forceinline__ void stage_rc(int b, int& R, int& C) { const int st = b / 1024, sb = b % 1024, swz = sb ^ (((sb >> 9) & 1) << 5); R = (st >> 1) * 16 + swz / 64; C = (st & 1) * 32 + (swz % 64) / 2; }
__host__ __device__ __forceinline__ int perm32(int rho) { const int n = rho >> 4, i = rho & 15; return 8 * (i >> 2) + 4 * n + (i & 3); }

struct Unit { int pm, pn; };
struct Gemm { const bf16_t* A; const bf16_t* Bt; int M, N, K; };

struct StaticOrder {
    int nM, nN, nwg, G, c;
    __host__ __device__ void init(int M, int N, int G_, int c_) { nM = M / BM; nN = N / BM; nwg = nM * nN; G = G_; c = c_; }
    __host__ __device__ bool next(int i, Unit& u) const {
        const long L = (long)i * G + c; if (L >= nwg) return false;
        int wgid = (int)L; { const int q = nwg / NXCD, r = nwg % NXCD, xcd = wgid % NXCD, off = wgid / NXCD; wgid = (xcd < r ? xcd * (q + 1) : r * (q + 1) + (xcd - r) * q) + off; }
        const int nig = WGM * nN, gid = wgid / nig, fm = gid * WGM, gsz = (nM - fm) < WGM ? (nM - fm) : WGM;
        u.pm = fm + ((wgid % nig) % gsz); u.pn = (wgid % nig) / gsz; return true;
    }
    __device__ __forceinline__ void a_ready(const Unit&) const {}
    __device__ __forceinline__ void done(const Unit&) const {}
};

__device__ __forceinline__ unsigned cvt_pk_bf16(float lo, float hi) { unsigned r; asm volatile("v_cvt_pk_bf16_f32 %0, %1, %2" : "=v"(r) : "v"(lo), "v"(hi)); return r; }
typedef float f32x2 __attribute__((ext_vector_type(2)));

template <class Epi, class Sched, bool ALIGN_EPI = false, bool SP2 = false>
__device__ __forceinline__ void gemm_phase(PG8_LAS unsigned char* lds, const Gemm g, const Sched& S, const Epi& E) {
    const int tid = threadIdx.x, wid = __builtin_amdgcn_readfirstlane(tid >> 6), lane = tid & 63, wr = wid >> 2, wc = wid & 3, fr = lane & 15, fq = lane >> 4;
    const int K = g.K, nt = K / BK;
    unsigned voffA[2], voffB[2];
#pragma unroll
    for (int i = 0; i < 2; ++i) { int R, C; stage_rc(tid * 16 + i * 8192, R, C); const int Rb = Epi::PERM ? ((R & ~31) + perm32(R & 31)) : R;
        voffA[i] = (unsigned)(R * K + C) * 2u; voffB[i] = (unsigned)(Rb * K + C) * 2u; }
    const size_t kstep = (size_t)(BK * 2);
    const size_t hstep = (size_t)HALF * K * 2;
    const size_t tstep = 2 * hstep;
    const unsigned ldsw = (unsigned)wid * 1024u;
    const int aoff = lds_byte(wr * 64 + fr, fq * 8), boff = lds_byte(wc * 32 + fr, fq * 8);
#define PG8_SA(b, h) (((b) * 2 + (h)) * HTB)
#define PG8_SB(b, h) ((4 + (b) * 2 + (h)) * HTB)
#define PG8_STAGE(bufoff, gbase, voff) do { _Pragma("unroll") for (int _i = 0; _i < 2; ++_i) \
        __builtin_amdgcn_global_load_lds((const unsigned*)((const char*)(gbase) + (voff)[_i]), (PG8_LAS unsigned*)(lds + (bufoff) + ldsw + _i * 8192), 16, 0, 0); } while (0)
#define PG8_LDA(dst, b, h) do { _Pragma("unroll") for (int m = 0; m < 4; ++m) _Pragma("unroll") for (int k = 0; k < 2; ++k) dst[m][k] = *(const PG8_LAS bf16x8*)(lds + PG8_SA(b, h) + aoff + m * 2048 + k * 1024); } while (0)
#define PG8_LDB(dst, b, h) do { _Pragma("unroll") for (int n = 0; n < 2; ++n) _Pragma("unroll") for (int k = 0; k < 2; ++k) dst[n][k] = *(const PG8_LAS bf16x8*)(lds + PG8_SB(b, h) + boff + n * 2048 + k * 1024); } while (0)
#define PG8_MMA(ai, bj, At, Bt) do { __builtin_amdgcn_s_setprio(1); _Pragma("unroll") for (int m = 0; m < 4; ++m) _Pragma("unroll") for (int n = 0; n < 2; ++n) _Pragma("unroll") for (int k = 0; k < 2; ++k) \
        acc[ai][bj][m][n] = __builtin_amdgcn_mfma_f32_16x16x32_bf16(Bt[n][k], At[m][k], acc[ai][bj][m][n], 0, 0, 0); __builtin_amdgcn_s_setprio(0); } while (0)
#define PG8_WAIT_V(n) asm volatile("s_waitcnt vmcnt(" #n ")" ::: "memory")
#define PG8_WAIT_L(n) asm volatile("s_waitcnt lgkmcnt(" #n ")" ::: "memory")
#define PG8_BAR __builtin_amdgcn_s_barrier()
#define PG8_SCHED __builtin_amdgcn_sched_barrier(0)
    Unit cur, nxt; int ui = 0;
    if (!S.next(0, cur)) return;
    f32x4 acc[2][2][4][2];
#pragma unroll
    for (int a = 0; a < 2; ++a)
#pragma unroll
        for (int b = 0; b < 2; ++b)
#pragma unroll
            for (int m = 0; m < 4; ++m)
#pragma unroll
                for (int n = 0; n < 2; ++n) acc[a][b][m][n] = (f32x4){0.f, 0.f, 0.f, 0.f};
    bf16x8 At[4][2], B0[2][2], B1[2][2];
    const char* cA = (const char*)g.A + (size_t)cur.pm * tstep; const char* cB = (const char*)g.Bt + (size_t)cur.pn * tstep;
    S.a_ready(cur);
    if constexpr (SP2) {
        PG8_STAGE(PG8_SB(0, 0), cB, voffB); PG8_STAGE(PG8_SB(0, 1), cB + hstep, voffB); PG8_STAGE(PG8_SA(0, 0), cA, voffA); PG8_STAGE(PG8_SA(0, 1), cA + hstep, voffA);
        E.begin(lds, S, tid);
        if (wr == 1) PG8_BAR;
        PG8_WAIT_V(2); PG8_BAR;
        PG8_STAGE(PG8_SB(1, 0), cB + kstep, voffB); PG8_STAGE(PG8_SA(1, 0), cA + kstep, voffA); PG8_STAGE(PG8_SB(1, 1), cB + hstep + kstep, voffB);
        PG8_WAIT_V(6); PG8_BAR;
    } else {
        PG8_STAGE(PG8_SB(0, 0), cB, voffB); PG8_STAGE(PG8_SA(0, 0), cA, voffA); PG8_STAGE(PG8_SB(0, 1), cB + hstep, voffB); PG8_STAGE(PG8_SA(0, 1), cA + hstep, voffA);
        if (wr == 1) PG8_BAR;
        PG8_WAIT_V(4); PG8_BAR;
        PG8_STAGE(PG8_SB(1, 0), cB + kstep, voffB); PG8_STAGE(PG8_SA(1, 0), cA + kstep, voffA); PG8_STAGE(PG8_SB(1, 1), cB + hstep + kstep, voffB);
        PG8_WAIT_V(6); PG8_BAR;
    }
    for (;;) {
        const bool has_next = S.next(ui + 1, nxt);
        const char* nA = has_next ? (const char*)g.A + (size_t)nxt.pm * tstep : cA; const char* nB = has_next ? (const char*)g.Bt + (size_t)nxt.pn * tstep : cB;
        for (int t = 0; t < nt; t += 2) {
            const bool last = (t == nt - 2);
            const char* a1 = cA + (size_t)(t + 1) * kstep;
            const char* a2 = last ? nA : cA + (size_t)(t + 2) * kstep; const char* b2 = last ? nB : cB + (size_t)(t + 2) * kstep;
            const char* a3 = a2 + kstep; const char* b3 = b2 + kstep;
            if (last && has_next) S.a_ready(nxt);
            if constexpr (SP2) {
            PG8_LDB(B0, 0, 0); PG8_LDB(B1, 0, 1); PG8_SCHED; PG8_LDA(At, 0, 0); PG8_STAGE(PG8_SA(1, 1), a1 + hstep, voffA);
            PG8_WAIT_V(8); PG8_WAIT_L(0); PG8_BAR; PG8_MMA(0, 0, At, B0); PG8_MMA(0, 1, At, B1); PG8_BAR; PG8_SCHED;
            PG8_LDA(At, 0, 1); PG8_STAGE(PG8_SB(0, 0), b2, voffB); PG8_STAGE(PG8_SB(0, 1), b2 + hstep, voffB); PG8_STAGE(PG8_SA(0, 0), a2, voffA);
            PG8_WAIT_V(8); PG8_WAIT_L(0); PG8_BAR; PG8_MMA(1, 0, At, B0); PG8_MMA(1, 1, At, B1); PG8_BAR; PG8_SCHED;
            PG8_LDB(B0, 1, 0); PG8_LDB(B1, 1, 1); PG8_SCHED; PG8_LDA(At, 1, 0); PG8_STAGE(PG8_SA(0, 1), a2 + hstep, voffA);
            PG8_WAIT_V(8); PG8_WAIT_L(0); PG8_BAR; PG8_MMA(0, 0, At, B0); PG8_MMA(0, 1, At, B1); PG8_BAR; PG8_SCHED;
            PG8_LDA(At, 1, 1); PG8_STAGE(PG8_SB(1, 0), b3, voffB); PG8_STAGE(PG8_SB(1, 1), b3 + hstep, voffB); PG8_STAGE(PG8_SA(1, 0), a3, voffA);
            PG8_WAIT_V(8); PG8_WAIT_L(0); PG8_BAR; PG8_MMA(1, 0, At, B0); PG8_MMA(1, 1, At, B1); PG8_BAR; PG8_SCHED;
            } else {
            PG8_LDB(B0, 0, 0); PG8_SCHED; PG8_LDA(At, 0, 0); PG8_STAGE(PG8_SA(1, 1), a1 + hstep, voffA);
            PG8_WAIT_L(8); PG8_BAR; PG8_WAIT_L(0); PG8_MMA(0, 0, At, B0); PG8_BAR; PG8_SCHED;
            PG8_LDB(B1, 0, 1); PG8_STAGE(PG8_SB(0, 0), b2, voffB);
            PG8_BAR; PG8_WAIT_L(0); PG8_MMA(0, 1, At, B1); PG8_BAR;
            PG8_LDA(At, 0, 1); PG8_STAGE(PG8_SA(0, 0), a2, voffA);
            PG8_BAR; PG8_WAIT_L(0); PG8_MMA(1, 0, At, B0); PG8_BAR; PG8_SCHED;
            PG8_STAGE(PG8_SB(0, 1), b2 + hstep, voffB);
            PG8_WAIT_V(6); PG8_BAR; PG8_MMA(1, 1, At, B1); PG8_BAR;
            PG8_LDB(B0, 1, 0); PG8_SCHED; PG8_LDA(At, 1, 0); PG8_STAGE(PG8_SA(0, 1), a2 + hstep, voffA);
            PG8_WAIT_L(8); PG8_BAR; PG8_WAIT_L(0); PG8_MMA(0, 0, At, B0); PG8_BAR; PG8_SCHED;
            PG8_LDB(B1, 1, 1); PG8_STAGE(PG8_SB(1, 0), b3, voffB);
            PG8_BAR; PG8_WAIT_L(0); PG8_MMA(0, 1, At, B1); PG8_BAR;
            PG8_LDA(At, 1, 1); PG8_STAGE(PG8_SA(1, 0), a3, voffA);
            PG8_BAR; PG8_WAIT_L(0); PG8_MMA(1, 0, At, B0); PG8_BAR; PG8_SCHED;
            PG8_STAGE(PG8_SB(1, 1), b3 + hstep, voffB);
            PG8_WAIT_V(6); PG8_BAR; PG8_MMA(1, 1, At, B1); PG8_BAR;
            }
        }
        if constexpr (ALIGN_EPI) { if (wr == 0) PG8_BAR; }
        if constexpr (!Epi::AFTER_DRAIN) { E(acc, cur, wr, wc, fr, fq, ui); S.done(cur); }
        if (!has_next) break;
#pragma unroll
        for (int a = 0; a < 2; ++a)
#pragma unroll
            for (int b = 0; b < 2; ++b)
#pragma unroll
                for (int m = 0; m < 4; ++m)
#pragma unroll
                    for (int n = 0; n < 2; ++n) acc[a][b][m][n] = (f32x4){0.f, 0.f, 0.f, 0.f};
        cur = nxt; cA = nA; cB = nB; ++ui;
        if constexpr (ALIGN_EPI) { if (wr == 1) PG8_BAR; }
    }
    PG8_WAIT_V(0);
    if constexpr (!ALIGN_EPI) { if (wr == 0) PG8_BAR; }
    PG8_BAR;
    if constexpr (Epi::AFTER_DRAIN) { E.fused(acc, cur, wr, wc, fr, fq, lds, wid, lane); S.done(cur); }
#undef PG8_SA
#undef PG8_SB
#undef PG8_STAGE
#undef PG8_LDA
#undef PG8_LDB
#undef PG8_MMA
#undef PG8_WAIT_V
#undef PG8_WAIT_L
#undef PG8_BAR
#undef PG8_SCHED
}
}

constexpr int BATCH = 4, SEQ = 4096, DM = 1024, MROWS = BATCH * SEQ;
constexpr int CE = 2048, CN = 4 * CE;
constexpr int NH = 16, HD = 64, NG = 3, QKVC = 9216, AN = 10240;
constexpr float EPS = 1e-6f, LOG2E = 1.4426950408889634f, QSCALE = 0.125f * LOG2E;
constexpr int NPHASE = 18;

constexpr size_t MiB = 1u << 20;
constexpr size_t WS_CTL = 0, CTL_ZERO_BYTES = 1 * MiB;
constexpr size_t WS_SSQ = 1 * MiB;
constexpr size_t WS_W1 = 2 * MiB, WS_W2 = 18 * MiB, WS_W3 = 22 * MiB, WS_W4 = 42 * MiB;
constexpr size_t WS_LSE = 44 * MiB;
constexpr size_t WS_BIAS = 47 * MiB;
constexpr size_t WS_XB = 48 * MiB;
constexpr size_t WS_QO = 80 * MiB;
constexpr size_t WS_CG = 112 * MiB;
constexpr size_t WS_KA = 176 * MiB, WS_VA = 208 * MiB, WS_KB = 240 * MiB, WS_VB = 272 * MiB;
constexpr size_t WS_Y = WS_KA;
constexpr size_t WS_SIDE = 304 * MiB;
constexpr size_t WS_END = 307 * MiB;
constexpr int CW_TMO = 0, CW_BAR = 4096;

#define GAS __attribute__((address_space(1)))
#define LAS __attribute__((address_space(3)))
typedef unsigned short bf16;
typedef unsigned v4u __attribute__((ext_vector_type(4)));
typedef unsigned v2u __attribute__((ext_vector_type(2)));
typedef float f32x4 __attribute__((ext_vector_type(4)));
typedef short bf16x8 __attribute__((ext_vector_type(8)));
typedef GAS unsigned gu32;
#define RLX_AGENT __ATOMIC_RELAXED, __HIP_MEMORY_SCOPE_AGENT
#define LDS_WAIT() asm volatile("s_waitcnt lgkmcnt(0)" ::: "memory")
#define VM_WAIT() asm volatile("s_waitcnt vmcnt(0)" ::: "memory")
__device__ __forceinline__ unsigned f2bf(float f) { unsigned u = __builtin_bit_cast(unsigned, f); return (u + 0x7fffu + ((u >> 16) & 1u)) >> 16; }
typedef float f32x2_t __attribute__((ext_vector_type(2))); typedef __bf16 bf16x2_t __attribute__((ext_vector_type(2)));
__device__ __forceinline__ unsigned pk2(float lo, float hi) { f32x2_t v = {lo, hi}; bf16x2_t b = __builtin_convertvector(v, bf16x2_t); return __builtin_bit_cast(unsigned, b); }
__device__ __forceinline__ float bf2f(unsigned h) { return __builtin_bit_cast(float, h << 16); }
__device__ __forceinline__ float bflo(unsigned w) { return __builtin_bit_cast(float, w << 16); }
__device__ __forceinline__ float bfhi(unsigned w) { return __builtin_bit_cast(float, w & 0xffff0000u); }
__device__ __forceinline__ float sigmoidf_(float z) { return __builtin_amdgcn_rcpf(1.0f + __builtin_amdgcn_exp2f(-z * LOG2E)); }
__device__ __forceinline__ float row_rs(const float* ssq, int row) {
    const f32x4* p = (const f32x4*)(ssq + (size_t)row * 16);
    const f32x4 s = (p[0] + p[1]) + (p[2] + p[3]);
    return 1.0f / sqrtf(((s.x + s.y) + (s.z + s.w)) * (1.0f / DM) + EPS);
}
__device__ __forceinline__ float wave_sum(float v) {
#pragma unroll
    for (int o = 1; o < 64; o <<= 1) v += __shfl_xor(v, o);
    return v;
}
__device__ __forceinline__ int t5_bucket(int d) {
    if (d < 16) return d;
    int b = 15;
    b += (d >= 16); b += (d >= 22); b += (d >= 30); b += (d >= 40); b += (d >= 54); b += (d >= 73); b += (d >= 99); b += (d >= 134);
    b += (d >= 182); b += (d >= 246); b += (d >= 332); b += (d >= 450); b += (d >= 609); b += (d >= 825); b += (d >= 1117); b += (d >= 1513);
    return b;
}

#define XB_TMO      128
#define XB_XCNT(j)  (256  + 64 * (j))
#define XB_XSUB(j)  (1280 + 64 * (j))
#define XB_XGEN(j)  (2304 + 64 * (j))
#define XB_TOP      3328
#define XB_TOPGEN   3392
#define XCD_BAR_WORDS 3456
#define XB_SPIN_CAP (1u << 18)

__device__ __forceinline__ unsigned xb_ld(unsigned* p)              { return __hip_atomic_load(p, __ATOMIC_RELAXED, __HIP_MEMORY_SCOPE_AGENT); }
__device__ __forceinline__ unsigned xb_add(unsigned* p, unsigned v) { return __hip_atomic_fetch_add(p, v, __ATOMIC_RELAXED, __HIP_MEMORY_SCOPE_AGENT); }
__device__ __forceinline__ unsigned xb_xcc_id() { return (unsigned)__builtin_amdgcn_s_getreg((3 << 11) | 20) & 0xFu; }
#define XB_SPIN(cond, bar) do { unsigned _sp = 0; while (cond) { __builtin_amdgcn_s_sleep(1); \
    if ((++_sp & 255u) == 0u) { if (xb_ld(&(bar)[XB_TMO])) break; if (_sp > XB_SPIN_CAP) { atomicAdd(&(bar)[XB_TMO], 1u); break; } } } } while (0)

struct XcdBarrier {
    unsigned* bar; unsigned x;
    volatile LAS unsigned* st;
};

__device__ __forceinline__ XcdBarrier xcd_barrier_post(unsigned* bar, volatile LAS unsigned* st) {
    XcdBarrier b; b.bar = bar; b.x = xb_xcc_id(); b.st = st;
    if (threadIdx.x == 0) (void)xb_add(&bar[XB_XCNT(b.x)], 1u);
    return b;
}
__device__ __forceinline__ void xcd_barrier_complete(unsigned* bar, unsigned x, unsigned& nloc, unsigned& nx) {
    const unsigned G = gridDim.x * gridDim.y * gridDim.z;
    unsigned sum, cnt, mine, sp = 0u;
    for (;;) {
        sum = 0u; cnt = 0u; mine = 0u;
#pragma unroll
        for (unsigned j = 0; j < 16; ++j) { const unsigned c = xb_ld(&bar[XB_XCNT(j)]); sum += c; cnt += (c > 0u) ? 1u : 0u; mine = (j == x) ? c : mine; }
        if (sum == G) break;
        __builtin_amdgcn_s_sleep(1);
        if ((++sp & 255u) == 0u) { if (xb_ld(&bar[XB_TMO])) break; if (sp > XB_SPIN_CAP) { atomicAdd(&bar[XB_TMO], 1u); break; } }
    }
    nloc = mine > 0u ? mine : 1u; nx = cnt > 0u ? cnt : 1u;
}

__device__ __forceinline__ void xcd_barrier(const XcdBarrier& b) {
    asm volatile("s_waitcnt vmcnt(0)" ::: "memory");
    __syncthreads();
    if (threadIdx.x == 0) {
        unsigned* bar = b.bar;
        __builtin_amdgcn_s_waitcnt(0);
        unsigned nloc = b.st[0], nx = b.st[1];
        if (nloc == 0u) { xcd_barrier_complete(bar, b.x, nloc, nx); b.st[0] = nloc; b.st[1] = nx; }
        const unsigned old = xb_add(&bar[XB_XSUB(b.x)], 1u);
        const unsigned gen = old / nloc;
        if (old + 1u == (gen + 1u) * nloc) {
            __builtin_amdgcn_fence(__ATOMIC_RELEASE, "agent");
            asm volatile("s_waitcnt vmcnt(0)" ::: "memory");
            const unsigned og = xb_add(&bar[XB_TOP], 1u);
            const unsigned tg = og / nx;
            if (og + 1u == (tg + 1u) * nx) xb_add(&bar[XB_TOPGEN], 1u);
            else XB_SPIN(xb_ld(&bar[XB_TOPGEN]) == tg, bar);
            __builtin_amdgcn_fence(__ATOMIC_ACQUIRE, "agent");
            xb_add(&bar[XB_XGEN(b.x)], 1u);
            asm volatile("s_waitcnt vmcnt(0)" ::: "memory");
        } else {
            XB_SPIN(xb_ld(&bar[XB_XGEN(b.x)]) == gen, bar);
            __builtin_amdgcn_fence(__ATOMIC_ACQUIRE, "agent");
            asm volatile("s_waitcnt vmcnt(0)" ::: "memory");
        }
    }
    __syncthreads();
}

#ifndef DUP_EPI
#define DUP_EPI 0
#endif
namespace epi {
using pg8::Unit; using pg8::bf16_t;

__device__ __forceinline__ void rows_rs(const float* ssq, int row0  , int fq, float (&rs)[2][4]) {
    f32x4 pp[2][4];
#pragma unroll
    for (int ai = 0; ai < 2; ++ai)
#pragma unroll
        for (int m = 0; m < 4; ++m) pp[ai][m] = *(const f32x4*)(ssq + (size_t)(row0 + ai * 128 + m * 16) * 16 + 4 * fq);
#pragma unroll
    for (int ai = 0; ai < 2; ++ai)
#pragma unroll
        for (int m = 0; m < 4; ++m) { float t = (pp[ai][m][0] + pp[ai][m][1]) + (pp[ai][m][2] + pp[ai][m][3]); t += __shfl_xor(t, 16); t += __shfl_xor(t, 32); rs[ai][m] = __builtin_amdgcn_rsqf(t * (1.0f / DM) + EPS); }
}
struct ConvIn {
    static constexpr bool PERM = false, AFTER_DRAIN = false, DUP = (DUP_EPI != 0);
    const float* ssq; bf16_t* V; bf16_t* G;
    template <class Sched> __device__ __forceinline__ void begin(LAS unsigned char*, const Sched&, int) const {}
    __device__ __forceinline__ void operator()(const f32x4 (&acc)[2][2][4][2], const Unit& u, int wr, int wc, int fr, int fq, int) const {
        const int ch0 = u.pn * 64 + wc * 16 + 4 * fq;
        float rsv[2][4]; rows_rs(ssq, u.pm * 256 + wr * 64 + fr, fq, rsv);
#pragma unroll
        for (int ai = 0; ai < 2; ++ai)
#pragma unroll
            for (int m = 0; m < 4; ++m) {
                const int row = u.pm * 256 + ai * 128 + wr * 64 + m * 16 + fr;
                const float rs = rsv[ai][m];
                const f32x4 b = acc[ai][0][m][0] * rs, c = acc[ai][0][m][1] * rs, uu = acc[ai][1][m][0] * rs, z = acc[ai][1][m][1] * rs;
                const f32x4 v = c * uu;
                f32x4 g;
#pragma unroll
                for (int i = 0; i < 4; ++i) g[i] = b[i] * z[i] * sigmoidf_(z[i]);
                v2u wv, wg; wv.x = pk2(v[0], v[1]); wv.y = pk2(v[2], v[3]); wg.x = pk2(g[0], g[1]); wg.y = pk2(g[2], g[3]);
                *(v2u*)(V + (size_t)row * CE + ch0) = wv;
                *(v2u*)(G + (size_t)row * CE + ch0) = wg;
            }
    }
};


constexpr int RSTAB_OFF = 152832, GTAB_OFF = 161024;
template <class Sched> __device__ __forceinline__ void fill_rstab(LAS unsigned char* lds, const float* ssq, const Sched& S, int tid) {
    LAS float* tab = (LAS float*)(lds + RSTAB_OFF);
    Unit u;
    for (int i = tid >> 8; i < 8 && S.next(i, u); i += 2) {
        const f32x4* p = (const f32x4*)(ssq + (size_t)(u.pm * 256 + (tid & 255)) * 16);
        const f32x4 s = (p[0] + p[1]) + (p[2] + p[3]);
        tab[i * 256 + (tid & 255)] = __builtin_amdgcn_rsqf(((s[0] + s[1]) + (s[2] + s[3])) * (1.0f / DM) + EPS);
    }
}
__device__ __forceinline__ void tab_rs(LAS unsigned char* lds, int ui, int wr, int fr, float (&rs)[2][4]) {
    const LAS float* tab = (const LAS float*)(lds + RSTAB_OFF) + ui * 256 + wr * 64 + fr;
#pragma unroll
    for (int ai = 0; ai < 2; ++ai)
#pragma unroll
        for (int m = 0; m < 4; ++m) rs[ai][m] = tab[ai * 128 + m * 16];
}
struct ConvFused {
    static constexpr bool PERM = false, AFTER_DRAIN = false, DUP = false;
    const float* ssq; bf16_t* Y; const float* cw; float* side; LAS unsigned char* xch;
    static __device__ __forceinline__ f32x4 unpk(v2u p) { return (f32x4){bflo(p.x), bfhi(p.x), bflo(p.y), bfhi(p.y)}; }
    template <class Sched> __device__ __forceinline__ void begin(LAS unsigned char* lds, const Sched& S, int tid) const { fill_rstab(lds, ssq, S, tid); }
    __device__ __forceinline__ void operator()(const f32x4 (&acc)[2][2][4][2], const Unit& u, int wr, int wc, int fr, int fq, int ui) const {
        const int ch0 = u.pn * 64 + wc * 16 + 4 * fq;
        float rsv[2][4]; tab_rs(xch - 131072, ui, wr, fr, rsv);
        const f32x4 w0 = *(const f32x4*)(cw + ch0), w1 = *(const f32x4*)(cw + CE + ch0), w2 = *(const f32x4*)(cw + 2 * CE + ch0);
        v2u vq[2][4]; f32x4 gt[2][4];
#pragma unroll
        for (int ai = 0; ai < 2; ++ai)
#pragma unroll
            for (int m = 0; m < 4; ++m) {
                const float rs = rsv[ai][m];
                const f32x4 b = acc[ai][0][m][0] * rs, c = acc[ai][0][m][1] * rs, uu = acc[ai][1][m][0] * rs, z = acc[ai][1][m][1] * rs;
                const f32x4 v = c * uu;
                vq[ai][m].x = pk2(v[0], v[1]); vq[ai][m].y = pk2(v[2], v[3]);
#pragma unroll
                for (int i = 0; i < 4; ++i) gt[ai][m][i] = b[i] * z[i] * sigmoidf_(z[i]);
            }
        LAS unsigned char* my = xch + (wr * 4 + wc) * 2720 + fq * 8;
        LAS unsigned char* other = xch + ((1 - wr) * 4 + wc) * 2720 + fq * 8;
        const bool seq_start = (u.pm & 15) == 0;
        if (fr >= 14) {
            const int hr = fr - 14;
            *(LAS v2u*)(other + ((wr == 0 ? 0 : 66) + hr) * 40) = vq[0][3];
            if (wr == 0) *(LAS v2u*)(other + (66 + hr) * 40) = vq[1][3];
            else *(f32x4*)(side + ((size_t)u.pm * 6 + 4 + hr) * CE + ch0) = unpk(vq[1][3]);
        }
        if (wr == 0 && fr < 2) *(LAS v2u*)(my + fr * 40) = (v2u){0u, 0u};
#pragma unroll
        for (int m = 0; m < 4; ++m) *(LAS v2u*)(my + (2 + 16 * m + fr) * 40) = vq[0][m];
        asm volatile("s_waitcnt lgkmcnt(0)\n\ts_barrier" ::: "memory");
#pragma unroll
        for (int ai = 0; ai < 2; ++ai) {
            if (ai == 1) {
#pragma unroll
                for (int m = 0; m < 4; ++m) *(LAS v2u*)(my + (2 + 16 * m + fr) * 40) = vq[1][m];
                asm volatile("s_waitcnt lgkmcnt(0)" ::: "memory");
            }
#pragma unroll
            for (int m = 0; m < 4; ++m) {
                const int k = 16 * m + fr;
                int r1 = k + 1, r2 = k;
                if (ai == 1) { if (k < 1) r1 = 67; if (k < 2) r2 = 66 + k; }
                const f32x4 p1 = unpk(*(const LAS v2u*)(my + r1 * 40)), p2 = unpk(*(const LAS v2u*)(my + r2 * 40)), v = unpk(vq[ai][m]);
#ifdef DBG_NOPREV
                const f32x4 cv = w2 * v + (w1 * p1 + w0 * p2) * 0.0f;
#else
                const f32x4 cv = w2 * v + w1 * p1 + w0 * p2;
#endif
#ifdef DBG_Y0
                const f32x4 y = gt[ai][m] * cv * 0.0f;
#else
                const f32x4 y = gt[ai][m] * cv;
#endif
                const int row = u.pm * 256 + ai * 128 + wr * 64 + k;
                v2u wy; wy.x = pk2(y[0], y[1]); wy.y = pk2(y[2], y[3]);
                *(v2u*)(Y + (size_t)row * CE + ch0) = wy;
                if (ai == 0 && m == 0 && wr == 0 && fr < 2 && !seq_start) {
                    *(f32x4*)(side + ((size_t)u.pm * 6 + fr) * CE + ch0) = gt[0][0];
                    *(f32x4*)(side + ((size_t)u.pm * 6 + 2 + fr) * CE + ch0) = cv;
                }
            }
        }
    }
};
struct Resid {
    static constexpr bool PERM = false, AFTER_DRAIN = false, DUP = false;
    const float* xin; float* xout; bf16_t* xb; float* ssq;
    template <class Sched> __device__ __forceinline__ void begin(LAS unsigned char*, const Sched&, int) const {}
    __device__ __forceinline__ void operator()(const f32x4 (&acc)[2][2][4][2], const Unit& u, int wr, int wc, int fr, int fq, int) const {
        const int col0 = u.pn * 256 + wc * 32 + 4 * fq;
        const size_t off0 = (size_t)(u.pm * 256 + wr * 64 + fr) * DM + col0;
        f32x4 pre[4][2][2];
#pragma unroll
        for (int i = 0; i < 4; ++i)
#pragma unroll
            for (int bj = 0; bj < 2; ++bj)
#pragma unroll
                for (int n = 0; n < 2; ++n) pre[i][bj][n] = *(const f32x4*)(xin + off0 + (size_t)(16 * i) * DM + bj * 128 + n * 16);
#pragma unroll
        for (int i = 0; i < 8; ++i) {
            const int ai = i >> 2, m = i & 3;
            const size_t off = off0 + (size_t)(ai * 128 + m * 16) * DM;
            float ss = 0.f; f32x4 xn[2][2];
#pragma unroll
            for (int bj = 0; bj < 2; ++bj)
#pragma unroll
                for (int n = 0; n < 2; ++n) { xn[bj][n] = pre[i & 3][bj][n] + acc[ai][bj][m][n]; const f32x4 t = xn[bj][n]; ss += (t[0] * t[0] + t[1] * t[1]) + (t[2] * t[2] + t[3] * t[3]); }
            if (i < 4) {
#pragma unroll
                for (int bj = 0; bj < 2; ++bj)
#pragma unroll
                    for (int n = 0; n < 2; ++n) pre[i & 3][bj][n] = *(const f32x4*)(xin + off + (size_t)128 * DM + bj * 128 + n * 16);
            }
#pragma unroll
            for (int bj = 0; bj < 2; ++bj)
#pragma unroll
                for (int n = 0; n < 2; ++n) {
                    *(f32x4*)(xout + off + bj * 128 + n * 16) = xn[bj][n];
                    v2u w; w.x = pk2(xn[bj][n][0], xn[bj][n][1]); w.y = pk2(xn[bj][n][2], xn[bj][n][3]);
                    *(v2u*)(xb + off + bj * 128 + n * 16) = w;
                }
            ss += __shfl_xor(ss, 16); ss += __shfl_xor(ss, 32);
            if (fq == 0) ssq[(size_t)(u.pm * 256 + ai * 128 + wr * 64 + m * 16 + fr) * 16 + u.pn * 4 + wc] = ss;
        }
    }
};
template <int MODE> struct ResidB {
    static constexpr bool PERM = false, AFTER_DRAIN = false, DUP = false;
    const float* xin; float* xout; bf16_t* xb; float* ssq;
    template <class Sched> __device__ __forceinline__ void begin(LAS unsigned char*, const Sched&, int) const {}
    __device__ __forceinline__ void operator()(const f32x4 (&acc)[2][2][4][2], const Unit& u, int wr, int wc, int fr, int fq, int) const {
        const int col0 = u.pn * 256 + wc * 32 + 4 * fq;
        const size_t off0 = (size_t)(u.pm * 256 + wr * 64 + fr) * DM + col0;
        if constexpr (MODE == 0) {
            f32x4 pre[4][2][2];
#pragma unroll
            for (int i = 0; i < 4; ++i)
#pragma unroll
                for (int bj = 0; bj < 2; ++bj)
#pragma unroll
                    for (int n = 0; n < 2; ++n) pre[i][bj][n] = *(const f32x4*)(xin + off0 + (size_t)(16 * i) * DM + bj * 128 + n * 16);
#pragma unroll
            for (int i = 0; i < 8; ++i) {
                const int ai = i >> 2, m = i & 3;
                const size_t off = off0 + (size_t)(ai * 128 + m * 16) * DM;
                float ss = 0.f; f32x4 xn[2][2];
#pragma unroll
                for (int bj = 0; bj < 2; ++bj)
#pragma unroll
                    for (int n = 0; n < 2; ++n) { xn[bj][n] = pre[i & 3][bj][n] + acc[ai][bj][m][n]; const f32x4 t = xn[bj][n]; ss += (t[0] * t[0] + t[1] * t[1]) + (t[2] * t[2] + t[3] * t[3]); }
                if (i < 4) {
#pragma unroll
                    for (int bj = 0; bj < 2; ++bj)
#pragma unroll
                        for (int n = 0; n < 2; ++n) pre[i & 3][bj][n] = *(const f32x4*)(xin + off + (size_t)128 * DM + bj * 128 + n * 16);
                }
#pragma unroll
                for (int bj = 0; bj < 2; ++bj)
#pragma unroll
                    for (int n = 0; n < 2; ++n) { v2u w; w.x = pk2(xn[bj][n][0], xn[bj][n][1]); w.y = pk2(xn[bj][n][2], xn[bj][n][3]); *(v2u*)(xb + off + bj * 128 + n * 16) = w; }
                ss += __shfl_xor(ss, 16); ss += __shfl_xor(ss, 32);
                if (fq == 0) ssq[(size_t)(u.pm * 256 + ai * 128 + wr * 64 + m * 16 + fr) * 16 + u.pn * 4 + wc] = ss;
            }
        } else {
            v2u pre[8][2][2];
#pragma unroll
            for (int i = 0; i < 8; ++i)
#pragma unroll
                for (int bj = 0; bj < 2; ++bj)
#pragma unroll
                    for (int n = 0; n < 2; ++n) pre[i][bj][n] = *(const v2u*)(xb + off0 + (size_t)((i >> 2) * 128 + (i & 3) * 16) * DM + bj * 128 + n * 16);
#pragma unroll
            for (int i = 0; i < 8; ++i) {
                const int ai = i >> 2, m = i & 3;
                const size_t off = off0 + (size_t)(ai * 128 + m * 16) * DM;
                float ss = 0.f;
#pragma unroll
                for (int bj = 0; bj < 2; ++bj)
#pragma unroll
                    for (int n = 0; n < 2; ++n) {
                        const v2u p = pre[i][bj][n];
                        const f32x4 t = (f32x4){bflo(p.x), bfhi(p.x), bflo(p.y), bfhi(p.y)} + acc[ai][bj][m][n];
                        if constexpr (MODE == 2) { *(f32x4*)(xout + off + bj * 128 + n * 16) = t; }
                        else { ss += (t[0] * t[0] + t[1] * t[1]) + (t[2] * t[2] + t[3] * t[3]); v2u w; w.x = pk2(t[0], t[1]); w.y = pk2(t[2], t[3]); *(v2u*)(xb + off + bj * 128 + n * 16) = w; }
                    }
                if constexpr (MODE != 2) {
                    ss += __shfl_xor(ss, 16); ss += __shfl_xor(ss, 32);
                    if (fq == 0) ssq[(size_t)(u.pm * 256 + ai * 128 + wr * 64 + m * 16 + fr) * 16 + u.pn * 4 + wc] = ss;
                }
            }
        }
    }
};
struct QKV {
    static constexpr bool PERM = true, AFTER_DRAIN = false, DUP = (DUP_EPI != 0);
    const float* ssq; bf16_t* Q; bf16_t* K; bf16_t* Vv; const float* qg; const float* kg; LAS unsigned char* lds0;
    template <class Sched> __device__ __forceinline__ void begin(LAS unsigned char* lds, const Sched& S, int tid) const {
        fill_rstab(lds, ssq, S, tid);
        if (tid < 128) ((LAS float*)(lds + GTAB_OFF))[tid] = tid < 64 ? qg[tid] * QSCALE : kg[tid - 64];
    }
    __device__ __forceinline__ void operator()(const f32x4 (&acc)[2][2][4][2], const Unit& u, int wr, int wc, int fr, int fq, int ui) const {
        const int which = u.pn >> 2, h = (u.pn & 3) * 4 + wc;
        bf16_t* base = Q + (ptrdiff_t)(which == 1) * (K - Q) + (ptrdiff_t)(which == 2) * (Vv - Q);
        const LAS float* gp = (const LAS float*)(lds0 + GTAB_OFF) + (which == 1 ? 64 : 0); const float gsc = 1.0f; const bool nrm = which < 2;
        const f32x4 g00 = *(const LAS f32x4*)(gp + 8 * fq), g01 = *(const LAS f32x4*)(gp + 8 * fq + 4), g10 = *(const LAS f32x4*)(gp + 32 + 8 * fq), g11 = *(const LAS f32x4*)(gp + 32 + 8 * fq + 4);
        float rsv[2][4]; tab_rs(lds0, ui, wr, fr, rsv);
#pragma unroll
        for (int ai = 0; ai < 2; ++ai)
#pragma unroll
            for (int m = 0; m < 4; ++m) {
                const int row = u.pm * 256 + ai * 128 + wr * 64 + m * 16 + fr;
                const float rs = rsv[ai][m];
                f32x4 v[2][2]; float ss = 0.f;
#pragma unroll
                for (int bj = 0; bj < 2; ++bj)
#pragma unroll
                    for (int n = 0; n < 2; ++n) { v[bj][n] = acc[ai][bj][m][n] * rs; const f32x4 t = v[bj][n]; ss += (t[0] * t[0] + t[1] * t[1]) + (t[2] * t[2] + t[3] * t[3]); }
                ss += __shfl_xor(ss, 16); ss += __shfl_xor(ss, 32);
                const float rn = gsc * __builtin_amdgcn_rsqf(ss * (1.0f / HD) + EPS);
#pragma unroll
                for (int bj = 0; bj < 2; ++bj) {
                    f32x4 a = v[bj][0], b = v[bj][1];
                    if (nrm) { a = a * (bj == 0 ? g00 : g10) * rn; b = b * (bj == 0 ? g01 : g11) * rn; }
                    v4u w; w.x = pk2(a[0], a[1]); w.y = pk2(a[2], a[3]); w.z = pk2(b[0], b[1]); w.w = pk2(b[2], b[3]);
                    *(v4u*)(base + (size_t)row * DM + h * HD + 32 * bj + 8 * fq) = w;
                }
            }
    }
};
struct ZMerge {
    static constexpr bool PERM = true, AFTER_DRAIN = false, DUP = false;
    const float* ssq; const bf16_t* O0; const bf16_t* O1; const bf16_t* O2; const float* lse; bf16_t* Y;
    struct RowIn { v4u a[2], b[2], c[2]; f32x4 sq; float l0, l1, l2; };
    __device__ __forceinline__ void load_row(RowIn& r, int row, int h, int fq) const {
        const size_t off = (size_t)row * DM + h * HD + 8 * fq;
        r.sq = *(const f32x4*)(ssq + (size_t)row * 16 + 4 * fq);
        r.l0 = lse[((size_t)0 * MROWS + row) * 16 + h]; r.l1 = lse[((size_t)1 * MROWS + row) * 16 + h]; r.l2 = lse[((size_t)2 * MROWS + row) * 16 + h];
#pragma unroll
        for (int bj = 0; bj < 2; ++bj) { r.a[bj] = *(const v4u*)(O0 + off + 32 * bj); r.b[bj] = *(const v4u*)(O1 + off + 32 * bj); r.c[bj] = *(const v4u*)(O2 + off + 32 * bj); }
    }
    template <class Sched> __device__ __forceinline__ void begin(LAS unsigned char*, const Sched&, int) const {}
    __device__ __forceinline__ void operator()(const f32x4 (&acc)[2][2][4][2], const Unit& u, int wr, int wc, int fr, int fq, int) const {
        const int h = u.pn * 4 + wc, row0 = u.pm * 256 + wr * 64 + fr;
        RowIn in[2];
        load_row(in[0], row0, h, fq);
#pragma unroll
        for (int i = 0; i < 8; ++i) {
            const int ai = i >> 2, m = i & 3, row = row0 + ai * 128 + m * 16;
            if (i + 1 < 8) load_row(in[(i + 1) & 1], row0 + ((i + 1) >> 2) * 128 + ((i + 1) & 3) * 16, h, fq);
            const RowIn& r = in[i & 1];
            float tq = (r.sq[0] + r.sq[1]) + (r.sq[2] + r.sq[3]); tq += __shfl_xor(tq, 16); tq += __shfl_xor(tq, 32);
            const float rs = __builtin_amdgcn_rsqf(tq * (1.0f / DM) + EPS);
            const float mx = fmaxf(r.l0, fmaxf(r.l1, r.l2));
            float w0 = __builtin_amdgcn_exp2f(r.l0 - mx), w1 = __builtin_amdgcn_exp2f(r.l1 - mx), w2 = __builtin_amdgcn_exp2f(r.l2 - mx);
            const float inv = __builtin_amdgcn_rcpf(w0 + w1 + w2); w0 *= inv; w1 *= inv; w2 *= inv;
#pragma unroll
            for (int bj = 0; bj < 2; ++bj) {
                const v4u a = r.a[bj], b = r.b[bj], c = r.c[bj];
                float o[8];
#pragma unroll
                for (int k = 0; k < 4; ++k) { o[2 * k] = w0 * bflo(a[k]) + w1 * bflo(b[k]) + w2 * bflo(c[k]); o[2 * k + 1] = w0 * bfhi(a[k]) + w1 * bfhi(b[k]) + w2 * bfhi(c[k]); }
                const f32x4 z0 = acc[ai][bj][m][0] * rs, z1 = acc[ai][bj][m][1] * rs;
                float y[8];
#pragma unroll
                for (int k = 0; k < 4; ++k) { y[k] = o[k] * z0[k] * sigmoidf_(z0[k]); y[4 + k] = o[4 + k] * z1[k] * sigmoidf_(z1[k]); }
                v4u w; w.x = pk2(y[0], y[1]); w.y = pk2(y[2], y[3]); w.z = pk2(y[4], y[5]); w.w = pk2(y[6], y[7]);
                *(v4u*)(Y + (size_t)row * DM + h * HD + 32 * bj + 8 * fq) = w;
            }
        }
    }
};
}

template <int MODE> __device__ __forceinline__ int wt_dest_row(int n) {
    if (MODE == 1) { const int type = n >> 11, e = n & 2047, pn = e >> 6, el = e & 63; return 256 * pn + 128 * (type >> 1) + 32 * (el >> 4) + 16 * (type & 1) + (el & 15); }
    if (MODE == 3) { const int blk = n >> 10, r = n & 1023, h = r >> 6, d = r & 63; return blk * 1024 + 256 * (h >> 2) + 128 * (d >> 5) + 32 * (h & 3) + (d & 31); }
    return n;
}
template <int MODE> __device__ __forceinline__ void p0_transpose_item(const float* W, int K, int N, const float* scale, bf16* WT, LAS float* scr  , int item, int lane) {
    const int nblk = N / 64, kb = item / nblk, nb = item % nblk, k0 = 64 * kb, n0 = 64 * nb;
    const int kr = lane >> 4, c4 = lane & 15;
    f32x4 v[16];
#pragma unroll
    for (int i = 0; i < 16; ++i) v[i] = *(const GAS f32x4*)(W + (size_t)(k0 + 4 * i + kr) * N + n0 + 4 * c4);
#pragma unroll
    for (int i = 0; i < 16; ++i) { const float s = scale ? scale[k0 + 4 * i + kr] : 1.0f; LAS float* d = scr + (4 * i + kr) * 65 + 4 * c4;
        d[0] = v[i][0] * s; d[1] = v[i][1] * s; d[2] = v[i][2] * s; d[3] = v[i][3] * s; }
    LDS_WAIT(); asm volatile("" ::: "memory");
    const int c = lane & 7, nl = lane >> 3;
#pragma unroll
    for (int j = 0; j < 8; ++j) { const int n = nl + 8 * j; const LAS float* s = scr + (8 * c) * 65 + n;
        v4u o; o.x = pk2(s[0 * 65], s[1 * 65]); o.y = pk2(s[2 * 65], s[3 * 65]); o.z = pk2(s[4 * 65], s[5 * 65]); o.w = pk2(s[6 * 65], s[7 * 65]);
        *(GAS v4u*)(WT + (size_t)wt_dest_row<MODE>(n0 + n) * K + k0 + 8 * c) = o; }
    LDS_WAIT(); asm volatile("" ::: "memory");
}
struct Ptrs {
    const float *x, *conv_norm, *conv_w_in, *conv_w, *conv_w_out, *attn_norm, *attn_w_in, *q_gain, *k_gain, *attn_w_out, *rel_bias;
    float* out; unsigned char* ws;
};
__device__ __forceinline__ void p0_weights(const Ptrs& P, int j, LAS unsigned char* lds, int vcu, int G, int wave, int lane) {
    LAS float* scr = (LAS float*)(lds + wave * 16640);
    const int gw = vcu * 8 + wave, NGW = G * 8;
    bf16* W1 = (bf16*)(P.ws + WS_W1); bf16* W2 = (bf16*)(P.ws + WS_W2); bf16* W3 = (bf16*)(P.ws + WS_W3); bf16* W4 = (bf16*)(P.ws + WS_W4);
    constexpr int I1 = (DM / 64) * (CN / 64), I2 = (CE / 64) * (DM / 64), I3 = (DM / 64) * (AN / 64), I4 = (DM / 64) * (DM / 64), IL = I1 + I2 + I3 + I4;
    for (int it = gw; it < IL; it += NGW) {
        int r = it;
        if (r < I1) { p0_transpose_item<1>(P.conv_w_in + (size_t)j * DM * CN, DM, CN, P.conv_norm + j * DM, W1, scr, r, lane); continue; } r -= I1;
        if (r < I2) { p0_transpose_item<0>(P.conv_w_out + (size_t)j * CE * DM, CE, DM, nullptr, W2, scr, r, lane); continue; } r -= I2;
        if (r < I3) { p0_transpose_item<3>(P.attn_w_in + (size_t)j * DM * AN, DM, AN, P.attn_norm + j * DM, W3, scr, r, lane); continue; } r -= I3;
        p0_transpose_item<0>(P.attn_w_out + (size_t)j * DM * DM, DM, DM, nullptr, W4, scr, r, lane);
    }
}
__device__ __forceinline__ void p0_prologue(const Ptrs& P, LAS unsigned char* lds, int vcu, int G, int wave, int lane, int tid) {
    p0_weights(P, 0, lds, vcu, G, wave, lane);
    const int gw = vcu * 8 + wave, NGW = G * 8;
    bf16* XB = (bf16*)(P.ws + WS_XB); float* SSQ = (float*)(P.ws + WS_SSQ);
    for (int m = 2 * gw; m < MROWS; m += 2 * NGW) {
        const GAS f32x4* xr = (const GAS f32x4*)(P.x + (size_t)m * DM) + lane;
        GAS v2u* o8 = (GAS v2u*)(XB + (size_t)m * DM) + lane;
        f32x4 v[8];
#pragma unroll
        for (int jj = 0; jj < 8; ++jj) v[jj] = xr[64 * jj];
        float s0 = 0.f, s1 = 0.f;
#pragma unroll
        for (int jj = 0; jj < 8; ++jj) { const f32x4 t = v[jj]; const float q = (t.x * t.x + t.y * t.y) + (t.z * t.z + t.w * t.w); if (jj < 4) s0 += q; else s1 += q;
            v2u w; w.x = pk2(t.x, t.y); w.y = pk2(t.z, t.w); o8[64 * jj] = w; }
        s0 = wave_sum(s0); s1 = wave_sum(s1);
        if (lane < 32) SSQ[(size_t)m * 16 + lane] = lane == 0 ? s0 : (lane == 16 ? s1 : 0.f);
    }
    float* BT = (float*)(P.ws + WS_BIAS);
    for (int i = vcu * 512 + tid; i < NG * NH * 132; i += G * 512) {
        const int g = i / (NH * 132), r = i % (NH * 132), h = r / 132, st = r % 132;
        const int dil = g == 0 ? 1 : (g == 1 ? 4 : 16);
        BT[i] = st <= 128 ? P.rel_bias[t5_bucket(st * dil) * (NG * NH) + g * NH + h] * LOG2E : 0.f;
    }
}
__device__ __forceinline__ void conv_fixup(bf16* Y, const float* side, const float* cw, int pm, int tid) {
    if ((pm & 15) == 0) return;
    const int ch = 4 * tid;
    const f32x4 g0 = *(const f32x4*)(side + ((size_t)pm * 6 + 0) * CE + ch), g1 = *(const f32x4*)(side + ((size_t)pm * 6 + 1) * CE + ch);
    const f32x4 c0 = *(const f32x4*)(side + ((size_t)pm * 6 + 2) * CE + ch), c1 = *(const f32x4*)(side + ((size_t)pm * 6 + 3) * CE + ch);
    const f32x4 va = *(const f32x4*)(side + ((size_t)(pm - 1) * 6 + 4) * CE + ch), vb = *(const f32x4*)(side + ((size_t)(pm - 1) * 6 + 5) * CE + ch);
    const f32x4 w0 = *(const f32x4*)(cw + ch), w1 = *(const f32x4*)(cw + CE + ch);
    const f32x4 y0 = g0 * (c0 + w1 * vb + w0 * va), y1 = g1 * (c1 + w0 * vb);
    v2u a, b; a.x = pk2(y0[0], y0[1]); a.y = pk2(y0[2], y0[3]); b.x = pk2(y1[0], y1[1]); b.y = pk2(y1[2], y1[3]);
    *(v2u*)(Y + (size_t)(pm * 256) * CE + ch) = a; *(v2u*)(Y + (size_t)(pm * 256 + 1) * CE + ch) = b;
}

namespace attn {
typedef float f32x16 __attribute__((ext_vector_type(16)));
typedef short s16x4 __attribute__((ext_vector_type(4)));
typedef short v4i16_t __attribute__((ext_vector_type(4)));
constexpr int L_K = 0, L_V = 49152, L_B = 98304, L_O = 118784, L_END = 151552, L_WS = 161536 + 256;
static_assert(L_O + 8 * 4096 == L_END && L_B + 5 * 4096 == L_O, "attention LDS map");
__device__ __forceinline__ int crow(int r, int hi) { return (r & 3) + 8 * (r >> 2) + 4 * hi; }
__device__ __forceinline__ s16x4 vtr(LAS const unsigned char* p) { return __builtin_bit_cast(s16x4, __builtin_amdgcn_ds_read_tr16_b64_v4i16((LAS v4i16_t*)p)); }
__device__ __forceinline__ float swapmax(float m) { auto rr = __builtin_amdgcn_permlane32_swap(__float_as_uint(m), __float_as_uint(m), false, false); return fmaxf(__uint_as_float(rr[0]), __uint_as_float(rr[1])); }
__device__ __forceinline__ float swapsum(float m) { auto rr = __builtin_amdgcn_permlane32_swap(__float_as_uint(m), __float_as_uint(m), false, false); return __uint_as_float(rr[0]) + __uint_as_float(rr[1]); }

#define ATT_BAR() asm volatile("s_waitcnt lgkmcnt(0)\n\ts_barrier" ::: "memory")
__device__ __forceinline__ void glds16(const void* gsrc, unsigned lds_dst) { unsigned keep;
    asm volatile("s_mov_b32 %0, m0\n\ts_mov_b32 m0, %2\n\ts_nop 0\n\tglobal_load_lds_dwordx4 %1, off\n\ts_mov_b32 m0, %0" : "=&s"(keep) : "v"(gsrc), "s"(lds_dst) : "memory"); }
template <int DIL> struct Job {
    int bh, c, n0, h; size_t rowb;
    __device__ __forceinline__ void decode(int id) { constexpr int CPC = (SEQ / DIL) / 256; bh = id >> 4; const int sub = id & 15; c = sub / CPC; n0 = (sub % CPC) * 256; h = bh & 15; rowb = (size_t)(bh >> 4) * SEQ; }
};
template <int DIL, bool ISV> __device__ __forceinline__ void issue_kv(LAS unsigned char* lds, const bf16* src, const Job<DIL>& J, int w, int lane) {
#pragma unroll
    for (int i = 0; i < 6; ++i) {
        const int kb = w * 6 + i, row = kb * 8 + (lane >> 3), pc = lane & 7;
        int pos = J.n0 - 128 + row; pos = pos < 0 ? 0 : pos;
        const size_t ro = (J.rowb + (size_t)pos * DIL + J.c) * DM + J.h * HD;
        const int sw = ISV ? ((((pc >> 2) ^ ((row >> 1) & 1)) * 32) + (pc & 3) * 8) : ((pc ^ ((row >> 1) & 7)) * 8);
        glds16(src + ro + sw, (unsigned)__builtin_amdgcn_readfirstlane((int)((unsigned)(uintptr_t)lds + (ISV ? L_V : L_K) + kb * 1024)));
    }
}
__device__ __forceinline__ void ld16_asm(bf16x8& dst, const bf16* p) { asm volatile("global_load_dwordx4 %0, %1, off" : "=v"(dst) : "v"(p) : "memory"); }

template <int DIL> __device__ __forceinline__ void phase(LAS unsigned char* lds, const bf16* QO, bf16* OUT, const bf16* Kg, const bf16* Vg, const float* biasT  , float* lse  , int vcu, int G) {
    const int tid = threadIdx.x, lane = tid & 63, r32 = lane & 31, hi = lane >> 5;
    const int w = __builtin_amdgcn_readfirstlane(tid >> 6);
    constexpr int NJS = BATCH * NH * 16;
    int id = vcu * 4;
    if (id >= NJS) return;
    Job<DIL> J; J.decode(id);
    bf16x8 q0, q1, q2, q3;
    issue_kv<DIL, false>(lds, Kg, J, w, lane);
    { const bf16* qp = QO + (J.rowb + (size_t)(J.n0 + 32 * w + r32) * DIL + J.c) * DM + J.h * HD + hi * 8; ld16_asm(q0, qp); ld16_asm(q1, qp + 16); ld16_asm(q2, qp + 32); ld16_asm(q3, qp + 48); }
    issue_kv<DIL, true>(lds, Vg, J, w, lane);
    int cur_bh = -1; bool first = true;
    for (;;) {
        const int nid = id + (((id & 3) == 3) ? (G * 4 - 3) : 1);
        const bool has_next = nid < NJS;
        Job<DIL> JN; JN.decode(has_next ? nid : id);
        if (J.bh != cur_bh) {
            cur_bh = J.bh;
#pragma unroll
            for (int i = 0; i < 10; ++i) {
                const int e = tid + 512 * i, j = e >> 10, rem = e & 1023, rg = rem >> 8, ln = (rem & 255) >> 2, i4 = rem & 3;
                const int r = 4 * rg + i4, a = ln & 31, hh = ln >> 5, kk = 32 * j + crow(r, hh), step = 128 + a - kk;
                float val = -INFINITY;
                if (step >= 0 && step <= 128) val = biasT[J.h * 132 + step];
                ((LAS float*)(lds + L_B))[e] = val;
            }
        }
        if (first) { first = false; asm volatile("s_waitcnt vmcnt(6)" : "+v"(q0), "+v"(q1), "+v"(q2), "+v"(q3) :: "memory"); }
        ATT_BAR();
        const int n0 = J.n0, h = J.h, c = J.c; const size_t rowb = J.rowb;
        const size_t qrow = rowb + (size_t)(n0 + 32 * w + r32) * DIL + c;
        const int jstart = (n0 == 0 && w < 4) ? 4 - w : 0;
        f32x16 S[5];
#pragma unroll
        for (int j = 0; j < 5; ++j) {
            if (j < jstart) {
#pragma unroll
                for (int r = 0; r < 16; ++r) S[j][r] = -INFINITY;
            } else {
                f32x16 cinit;
#pragma unroll
                for (int rg = 0; rg < 4; ++rg) { const f32x4 t = *(const LAS f32x4*)(lds + L_B + j * 4096 + rg * 1024 + lane * 16); cinit[4 * rg] = t[0]; cinit[4 * rg + 1] = t[1]; cinit[4 * rg + 2] = t[2]; cinit[4 * rg + 3] = t[3]; }
#pragma unroll
                for (int d0 = 0; d0 < 4; ++d0) {
                    const bf16x8 kf = *(const LAS bf16x8*)(lds + L_K + (32 * w + 32 * j + r32) * 128 + (((2 * d0 + hi) ^ ((r32 >> 1) & 7)) * 16));
                    cinit = __builtin_amdgcn_mfma_f32_32x32x16_bf16(kf, d0 == 0 ? q0 : (d0 == 1 ? q1 : (d0 == 2 ? q2 : q3)), cinit, 0, 0, 0);
                }
                S[j] = cinit;
            }
        }
        ATT_BAR();
        bf16x8 n0q, n1q, n2q, n3q;
        if (has_next) {
            issue_kv<DIL, false>(lds, Kg, JN, w, lane);
            const bf16* qp = QO + (JN.rowb + (size_t)(JN.n0 + 32 * w + r32) * DIL + JN.c) * DM + JN.h * HD + hi * 8; ld16_asm(n0q, qp); ld16_asm(n1q, qp + 16); ld16_asm(n2q, qp + 32); ld16_asm(n3q, qp + 48);
        }
        float m = -INFINITY;
#pragma unroll
        for (int j = 0; j < 5; ++j)
#pragma unroll
            for (int r = 0; r < 16; ++r) m = fmaxf(m, S[j][r]);
        m = swapmax(m);
        float lsum = 0.f;
#pragma unroll
        for (int j = 0; j < 5; ++j)
#pragma unroll
            for (int r = 0; r < 16; ++r) { const float p = __builtin_amdgcn_exp2f(S[j][r] - m); S[j][r] = p; lsum += p; }
        lsum = swapsum(lsum);
        if (has_next) asm volatile("s_waitcnt vmcnt(10)" ::: "memory"); else asm volatile("s_waitcnt vmcnt(0)" ::: "memory");
        ATT_BAR();
        f32x16 o[2];
#pragma unroll
        for (int r = 0; r < 16; ++r) { o[0][r] = 0.f; o[1][r] = 0.f; }
        const int vq = (lane & 15) >> 2, vx = (vq >> 1) & 1;
        const LAS unsigned char* vrow = lds + L_V + (32 * w + 4 * hi + vq) * 128 + ((lane >> 4) & 1) * 32 + (lane & 3) * 8;
        const LAS unsigned char* vbh[2] = {vrow + vx * 64, vrow + (1 - vx) * 64};
#pragma unroll
        for (int j = 0; j < 5; ++j)
#pragma unroll
            for (int s = 0; s < 2; ++s) {
                v4u pw; pw.x = pk2(S[j][8 * s], S[j][8 * s + 1]); pw.y = pk2(S[j][8 * s + 2], S[j][8 * s + 3]); pw.z = pk2(S[j][8 * s + 4], S[j][8 * s + 5]); pw.w = pk2(S[j][8 * s + 6], S[j][8 * s + 7]);
                const bf16x8 pa = __builtin_bit_cast(bf16x8, pw);
#pragma unroll
                for (int d0 = 0; d0 < 2; ++d0) {
                    const s16x4 lo = vtr(vbh[d0] + (32 * j + 16 * s) * 128), hh = vtr(vbh[d0] + (32 * j + 16 * s + 8) * 128);
                    const bf16x8 vf = (bf16x8){lo[0], lo[1], lo[2], lo[3], hh[0], hh[1], hh[2], hh[3]};
                    o[d0] = __builtin_amdgcn_mfma_f32_32x32x16_bf16(pa, vf, o[d0], 0, 0, 0);
                }
            }
        ATT_BAR();
        if (has_next) issue_kv<DIL, true>(lds, Vg, JN, w, lane);
        LAS float* wsf = (LAS float*)(lds + L_WS) + w * 64;
        if (hi == 0) { wsf[r32] = lsum; lse[qrow * 16 + h] = m + log2f(lsum); }
        asm volatile("s_waitcnt lgkmcnt(0)" ::: "memory");
        float rli[16];
#pragma unroll
        for (int r = 0; r < 16; ++r) rli[r] = __builtin_amdgcn_rcpf(wsf[crow(r, hi)]);
        LAS bf16* stg = (LAS bf16*)(lds + L_O) + w * 2048;
#pragma unroll
        for (int r = 0; r < 16; ++r) { const int orow = crow(r, hi);
#pragma unroll
            for (int d0 = 0; d0 < 2; ++d0) stg[orow * 64 + d0 * 32 + r32] = (bf16)(pk2(o[d0][r] * rli[r], 0.f) & 0xffffu); }
        asm volatile("s_waitcnt lgkmcnt(0)" ::: "memory");
#pragma unroll
        for (int i = 0; i < 4; ++i) { const int row = i * 8 + (lane >> 3), ch = lane & 7; const v4u v = *(const LAS v4u*)(stg + row * 64 + ch * 8);
            *(v4u*)(OUT + (rowb + (size_t)(n0 + 32 * w + row) * DIL + c) * DM + h * HD + ch * 8) = v; }
        if (!has_next) break;
        asm volatile("s_waitcnt vmcnt(6)" : "+v"(n0q), "+v"(n1q), "+v"(n2q), "+v"(n3q) :: "memory");
        id = nid; J = JN; q0 = n0q; q1 = n1q; q2 = n2q; q3 = n3q;
    }
    asm volatile("s_waitcnt vmcnt(0) lgkmcnt(0)\n\ts_barrier" ::: "memory");
}
#undef ATT_BAR
}

#ifndef PARITY_SPLIT
#define PARITY_SPLIT 1
#endif
#ifndef DUP_BAR
#define DUP_BAR 0
#endif
constexpr int LDS_BYTES = 163840;
constexpr int XCH_OFF = 131072;
constexpr int MISC_OFF = 161536;
struct Args { const float* in[11]; float* out; unsigned char* ws; int ph_lo, ph_hi; };

enum PhaseKind { PK_P0A, PK_P0B, PK_C1, PK_C3, PK_A1, PK_A1A2, PK_A2, PK_A3, PK_A4 };
struct PhaseDesc { int kind, j, g; };
__host__ __device__ constexpr PhaseDesc phase_desc(int ph) {
    if (ph == 0) return {PK_P0A, 0, 0};
    if (ph == 9) return {PK_P0B, 1, 0};
    const int j = ph >= 10 ? 1 : 0, s = ph - (j ? 10 : 1);
    switch (s) {
        case 0: return {PK_C1, j, 0};
        case 1: return {PK_C3, j, 0};
        case 2: return {PK_A1, j, 0};
        case 3: return {PK_A1A2, j, 0};
        case 4: return {PK_A1A2, j, 1};
        case 5: return {PK_A2, j, 2};
        case 6: return {PK_A3, j, 0};
        default: return {PK_A4, j, 0};
    }
}
__device__ __forceinline__ size_t kbuf_off(int g) { return g == 1 ? WS_KB : WS_KA; }
__device__ __forceinline__ size_t vbuf_off(int g) { return g == 1 ? WS_VB : WS_VA; }

template <int J, int G1> __device__ __forceinline__ void run_qkv_gemm(const Args& args, LAS unsigned char* lds, int G, int bx) {
    unsigned char* ws = args.ws;
    bf16* XB = (bf16*)(ws + WS_XB); float* SSQ = (float*)(ws + WS_SSQ);
    bf16* QO = (bf16*)(ws + WS_QO) + (size_t)G1 * MROWS * DM;
    pg8::Gemm gm{XB, (const bf16*)(ws + WS_W3) + (size_t)G1 * 3072 * DM, MROWS, 3072, DM}; pg8::StaticOrder S; S.init(MROWS, 3072, G, bx);
    epi::QKV E{SSQ, QO, (bf16*)(ws + kbuf_off(G1)), (bf16*)(ws + vbuf_off(G1)), args.in[7] + (J * NG + G1) * HD, args.in[8] + (J * NG + G1) * HD, lds};
    pg8::gemm_phase<epi::QKV, pg8::StaticOrder, true, true>(lds, gm, S, E);
}
template <int G0> __device__ __forceinline__ void run_attn(const Args& args, LAS unsigned char* lds, int vcu, int G) {
    unsigned char* ws = args.ws;
    constexpr int dil = G0 == 0 ? 1 : (G0 == 1 ? 4 : 16);
    bf16* QO = (bf16*)(ws + WS_QO) + (size_t)G0 * MROWS * DM;
    attn::phase<dil>(lds, QO, QO, (const bf16*)(ws + kbuf_off(G0)), (const bf16*)(ws + vbuf_off(G0)), (const float*)(ws + WS_BIAS) + G0 * NH * 132, (float*)(ws + WS_LSE) + (size_t)G0 * MROWS * 16, vcu, G);
}

template <int PH> __device__ __forceinline__ void run_phase(const Args& args, LAS unsigned char* lds) {
    constexpr PhaseDesc D = phase_desc(PH);
    constexpr int j = D.j;
    const int tid = threadIdx.x, lane = tid & 63, wave = __builtin_amdgcn_readfirstlane(tid >> 6);
    const int G = gridDim.x, bx = blockIdx.x, vcu = (G % 8 == 0) ? (bx % 8) * (G / 8) + bx / 8 : bx;
    unsigned char* ws = args.ws;
    float* SSQ = (float*)(ws + WS_SSQ); bf16* XB = (bf16*)(ws + WS_XB);
    (void)lane; (void)wave; (void)SSQ; (void)XB; (void)vcu;
    if constexpr (D.kind == PK_P0A || D.kind == PK_P0B) {
        Ptrs P;
        P.x = args.in[0]; P.conv_norm = args.in[1]; P.conv_w_in = args.in[2]; P.conv_w = args.in[3]; P.conv_w_out = args.in[4]; P.attn_norm = args.in[5];
        P.attn_w_in = args.in[6]; P.q_gain = args.in[7]; P.k_gain = args.in[8]; P.attn_w_out = args.in[9]; P.rel_bias = args.in[10]; P.out = args.out; P.ws = args.ws;
        if constexpr (D.kind == PK_P0A) p0_prologue(P, lds, vcu, G, wave, lane, tid);
        else p0_weights(P, 1, lds, vcu, G, wave, lane);
    } else if constexpr (D.kind == PK_C1) {
        pg8::Gemm g{XB, (const bf16*)(ws + WS_W1), MROWS, CN, DM}; pg8::StaticOrder S; S.init(MROWS, CN, G, bx);
        epi::ConvFused E{SSQ, (bf16*)(ws + WS_CG), args.in[3] + (size_t)j * 3 * CE, (float*)(ws + WS_SIDE), lds + XCH_OFF};
        pg8::gemm_phase<epi::ConvFused, pg8::StaticOrder, true, true>(lds, g, S, E);
    } else if constexpr (D.kind == PK_C3 || D.kind == PK_A4) {
        constexpr bool C3 = D.kind == PK_C3; constexpr int K = C3 ? CE : DM;
        const bf16* A = (const bf16*)(ws + (C3 ? WS_CG : WS_Y));
        pg8::Gemm g{A, (const bf16*)(ws + (C3 ? WS_W2 : WS_W4)), MROWS, DM, K}; pg8::StaticOrder S; S.init(MROWS, DM, G, bx);
        if constexpr (C3) { pg8::Unit fu; for (int i = 0; S.next(i, fu); ++i) conv_fixup((bf16*)(ws + WS_CG), (const float*)(ws + WS_SIDE), args.in[3] + (size_t)j * 3 * CE, fu.pm, tid);
            asm volatile("s_waitcnt vmcnt(0)" ::: "memory"); __syncthreads(); }
        constexpr int RMODE = (j == 0 && C3) ? 0 : ((j == 1 && !C3) ? 2 : 1);
        epi::ResidB<RMODE> E{args.in[0], args.out, XB, SSQ};
        pg8::gemm_phase<epi::ResidB<RMODE>, pg8::StaticOrder, false, true>(lds, g, S, E);
    } else if constexpr (D.kind == PK_A1) {
        run_qkv_gemm<j, 0>(args, lds, G, bx);
    } else if constexpr (D.kind == PK_A1A2) {
#if PARITY_SPLIT
        const bool attn_first = ((bx >> 3) & 1) != 0;
#else
        const bool attn_first = false;
#endif
        if (attn_first) { run_attn<D.g>(args, lds, vcu, G); run_qkv_gemm<j, D.g + 1>(args, lds, G, bx); }
        else            { run_qkv_gemm<j, D.g + 1>(args, lds, G, bx); run_attn<D.g>(args, lds, vcu, G); }
    } else if constexpr (D.kind == PK_A2) {
        run_attn<D.g>(args, lds, vcu, G);
    } else if constexpr (D.kind == PK_A3) {
        const bf16* O0 = (const bf16*)(ws + WS_QO); const bf16* O1 = O0 + (size_t)MROWS * DM; const bf16* O2 = O1 + (size_t)MROWS * DM;
        pg8::Gemm g{XB, (const bf16*)(ws + WS_W3) + (size_t)QKVC * DM, MROWS, DM, DM}; pg8::StaticOrder S; S.init(MROWS, DM, G, bx);
        epi::ZMerge E{SSQ, O0, O1, O2, (const float*)(ws + WS_LSE), (bf16*)(ws + WS_Y)};
        pg8::gemm_phase<epi::ZMerge, pg8::StaticOrder, false, true>(lds, g, S, E);
    }
}

__global__ void __launch_bounds__(512, 2) mk_fwd(Args args) {
    extern __shared__ __attribute__((aligned(16))) unsigned char lds_raw[];
    LAS unsigned char* lds = (LAS unsigned char*)lds_raw;
    volatile LAS unsigned* MISC = (volatile LAS unsigned*)(lds + MISC_OFF);
    for (int u = threadIdx.x; u < (LDS_BYTES - MISC_OFF) / 4; u += 512) ((LAS unsigned*)(lds + MISC_OFF))[u] = 0u;
    __syncthreads();
    gu32* ctl = (gu32*)(args.ws + WS_CTL);
    XcdBarrier bar; bar.bar = (unsigned*)(ctl + CW_BAR); bar.x = 0; bar.st = nullptr;
    const int lo = args.ph_lo, hi = args.ph_hi;
    if (hi - lo > 1) bar = xcd_barrier_post((unsigned*)(ctl + CW_BAR), MISC + 8);
#if DUP_BAR
#define RUN(k) if (lo <= (k) && (k) < hi) { run_phase<(k)>(args, lds); if ((k) + 1 < hi) { xcd_barrier(bar); xcd_barrier(bar); } }
#else
#define RUN(k) if (lo <= (k) && (k) < hi) { run_phase<(k)>(args, lds); if ((k) + 1 < hi) xcd_barrier(bar); }
#endif
    RUN(0) RUN(1) RUN(2) RUN(3) RUN(4) RUN(5) RUN(6) RUN(7) RUN(8) RUN(9) RUN(10) RUN(11) RUN(12) RUN(13) RUN(14) RUN(15) RUN(16) RUN(17)
#undef RUN
}

extern "C" void kernel_launch(void* const* d_in, const int* in_sizes, int n_in, void* d_out, int out_size, void* d_ws, size_t ws_size, hipStream_t stream) {
    static int grid = 0;
    if (grid == 0) {
        if (n_in != 11 || in_sizes[0] != MROWS * DM || out_size != MROWS * DM || ws_size < WS_END) { fprintf(stderr, "kernel_launch: unexpected shapes (n_in %d, ws %zu); nothing launched\n", n_in, ws_size); grid = -1; return; }
        int dev = 0, cus = 0, per_cu = 0;
        if (hipGetDevice(&dev) != hipSuccess || hipDeviceGetAttribute(&cus, hipDeviceAttributeMultiprocessorCount, dev) != hipSuccess) { grid = -1; return; }
        if (hipFuncSetAttribute((const void*)mk_fwd, hipFuncAttributeMaxDynamicSharedMemorySize, LDS_BYTES) != hipSuccess) { fprintf(stderr, "kernel_launch: hipFuncSetAttribute failed\n"); grid = -1; return; }
        if (hipOccupancyMaxActiveBlocksPerMultiprocessor(&per_cu, (const void*)mk_fwd, 512, LDS_BYTES) != hipSuccess || per_cu < 1) { fprintf(stderr, "kernel_launch: occupancy query says %d blocks per CU; nothing launched\n", per_cu); (void)hipGetLastError(); grid = -1; return; }
        grid = cus;
    }
    if (grid < 0) return;
    (void)hipMemsetAsync((char*)d_ws + WS_CTL, 0, CTL_ZERO_BYTES, stream);
    Args a{};
    for (int i = 0; i < 11; ++i) a.in[i] = (const float*)d_in[i];
    a.out = (float*)d_out; a.ws = (unsigned char*)d_ws;
    a.ph_lo = 0; a.ph_hi = NPHASE; hipLaunchKernelGGL(mk_fwd, dim3(grid), dim3(512), LDS_BYTES, stream, a);
}
```

```cpp
#include <hip/hip_runtime.h>
#include <cstdio>
#include <cstdint>
#include <cmath>
namespace pg8 {
#define PG8_LAS __attribute__((address_space(3)))
typedef unsigned short bf16_t;
typedef short bf16x8 __attribute__((ext_vector_type(8)));
typedef float f32x4 __attribute__((ext_vector_type(4)));
typedef unsigned u32x4 __attribute__((ext_vector_type(4)));
constexpr int BM = 256, BK = 64, HALF = 128, HTB = HALF * BK * 2  , STAGE_BYTES = 8 * HTB, NXCD = 8, WGM = 8;

__host__ __device__ __forceinline__ int lds_byte(int r, int c) { const int st = (r >> 4) * 2 + (c >> 5), rr = r & 15, cc = c & 31, ob = rr * 64 + cc * 2; return st * 1024 + (ob ^ (((ob >> 9) & 1) << 5)); }
__host__ __device__ __forceinline__ void stage_rc(int b, int& R, int& C) { const int st = b / 1024, sb = b % 1024, swz = sb ^ (((sb >> 9) & 1) << 5); R = (st >> 1) * 16 + swz / 64; C = (st & 1) * 32 + (swz % 64) / 2; }
__host__ __device__ __forceinline__ int perm32(int rho) { const int n = rho >> 4, i = rho & 15; return 8 * (i >> 2) + 4 * n + (i & 3); }

struct Unit { int pm, pn; };
struct Gemm { const bf16_t* A; const bf16_t* Bt; int M, N, K; };

struct StaticOrder {
    int nM, nN, nwg, G, c;
    __host__ __device__ void init(int M, int N, int G_, int c_) { nM = M / BM; nN = N / BM; nwg = nM * nN; G = G_; c = c_; }
    __host__ __device__ bool next(int i, Unit& u) const {
        const long L = (long)i * G + c; if (L >= nwg) return false;
        int wgid = (int)L; { const int q = nwg / NXCD, r = nwg % NXCD, xcd = wgid % NXCD, off = wgid / NXCD; wgid = (xcd < r ? xcd * (q + 1) : r * (q + 1) + (xcd - r) * q) + off; }
        const int nig = WGM * nN, gid = wgid / nig, fm = gid * WGM, gsz = (nM - fm) < WGM ? (nM - fm) : WGM;
        u.pm = fm + ((wgid % nig) % gsz); u.pn = (wgid % nig) / gsz; return true;
    }
    __device__ __forceinline__ void a_ready(const Unit&) const {}
    __device__ __forceinline__ void done(const Unit&) const {}
};

__device__ __forceinline__ unsigned cvt_pk_bf16(float lo, float hi) { unsigned r; asm volatile("v_cvt_pk_bf16_f32 %0, %1, %2" : "=v"(r) : "v"(lo), "v"(hi)); return r; }
typedef float f32x2 __attribute__((ext_vector_type(2)));

template <class Epi, class Sched, bool ALIGN_EPI = false, bool SP2 = false>
__device__ __forceinline__ void gemm_phase(PG8_LAS unsigned char* lds, const Gemm g, const Sched& S, const Epi& E) {
    const int tid = threadIdx.x, wid = __builtin_amdgcn_readfirstlane(tid >> 6), lane = tid & 63, wr = wid >> 2, wc = wid & 3, fr = lane & 15, fq = lane >> 4;
    const int K = g.K, nt = K / BK;
    unsigned voffA[2], voffB[2];
#pragma unroll
    for (int i = 0; i < 2; ++i) { int R, C; stage_rc(tid * 16 + i * 8192, R, C); const int Rb = Epi::PERM ? ((R & ~31) + perm32(R & 31)) : R;
        voffA[i] = (unsigned)(R * K + C) * 2u; voffB[i] = (unsigned)(Rb * K + C) * 2u; }
    const size_t kstep = (size_t)(BK * 2);
    const size_t hstep = (size_t)HALF * K * 2;
    const size_t tstep = 2 * hstep;
    const unsigned ldsw = (unsigned)wid * 1024u;
    const int aoff = lds_byte(wr * 64 + fr, fq * 8), boff = lds_byte(wc * 32 + fr, fq * 8);
#define PG8_SA(b, h) (((b) * 2 + (h)) * HTB)
#define PG8_SB(b, h) ((4 + (b) * 2 + (h)) * HTB)
#define PG8_STAGE(bufoff, gbase, voff) do { _Pragma("unroll") for (int _i = 0; _i < 2; ++_i) \
        __builtin_amdgcn_global_load_lds((const unsigned*)((const char*)(gbase) + (voff)[_i]), (PG8_LAS unsigned*)(lds + (bufoff) + ldsw + _i * 8192), 16, 0, 0); } while (0)
#define PG8_LDA(dst, b, h) do { _Pragma("unroll") for (int m = 0; m < 4; ++m) _Pragma("unroll") for (int k = 0; k < 2; ++k) dst[m][k] = *(const PG8_LAS bf16x8*)(lds + PG8_SA(b, h) + aoff + m * 2048 + k * 1024); } while (0)
#define PG8_LDB(dst, b, h) do { _Pragma("unroll") for (int n = 0; n < 2; ++n) _Pragma("unroll") for (int k = 0; k < 2; ++k) dst[n][k] = *(const PG8_LAS bf16x8*)(lds + PG8_SB(b, h) + boff + n * 2048 + k * 1024); } while (0)
#define PG8_MMA(ai, bj, At, Bt) do { __builtin_amdgcn_s_setprio(1); _Pragma("unroll") for (int m = 0; m < 4; ++m) _Pragma("unroll") for (int n = 0; n < 2; ++n) _Pragma("unroll") for (int k = 0; k < 2; ++k) \
        acc[ai][bj][m][n] = __builtin_amdgcn_mfma_f32_16x16x32_bf16(Bt[n][k], At[m][k], acc[ai][bj][m][n], 0, 0, 0); __builtin_amdgcn_s_setprio(0); } while (0)
#define PG8_WAIT_V(n) asm volatile("s_waitcnt vmcnt(" #n ")" ::: "memory")
#define PG8_WAIT_L(n) asm volatile("s_waitcnt lgkmcnt(" #n ")" ::: "memory")
#define PG8_BAR __builtin_amdgcn_s_barrier()
#define PG8_SCHED __builtin_amdgcn_sched_barrier(0)
    Unit cur, nxt; int ui = 0;
    if (!S.next(0, cur)) return;
    f32x4 acc[2][2][4][2];
#pragma unroll
    for (int a = 0; a < 2; ++a)
#pragma unroll
        for (int b = 0; b < 2; ++b)
#pragma unroll
            for (int m = 0; m < 4; ++m)
#pragma unroll
                for (int n = 0; n < 2; ++n) acc[a][b][m][n] = (f32x4){0.f, 0.f, 0.f, 0.f};
    bf16x8 At[4][2], B0[2][2], B1[2][2];
    const char* cA = (const char*)g.A + (size_t)cur.pm * tstep; const char* cB = (const char*)g.Bt + (size_t)cur.pn * tstep;
    S.a_ready(cur);
    if constexpr (SP2) {
        PG8_STAGE(PG8_SB(0, 0), cB, voffB); PG8_STAGE(PG8_SB(0, 1), cB + hstep, voffB); PG8_STAGE(PG8_SA(0, 0), cA, voffA); PG8_STAGE(PG8_SA(0, 1), cA + hstep, voffA);
        E.begin(lds, S, tid);
        if (wr == 1) PG8_BAR;
        PG8_WAIT_V(2); PG8_BAR;
        PG8_STAGE(PG8_SB(1, 0), cB + kstep, voffB); PG8_STAGE(PG8_SA(1, 0), cA + kstep, voffA); PG8_STAGE(PG8_SB(1, 1), cB + hstep + kstep, voffB);
        PG8_WAIT_V(6); PG8_BAR;
    } else {
        PG8_STAGE(PG8_SB(0, 0), cB, voffB); PG8_STAGE(PG8_SA(0, 0), cA, voffA); PG8_STAGE(PG8_SB(0, 1), cB + hstep, voffB); PG8_STAGE(PG8_SA(0, 1), cA + hstep, voffA);
        E.begin(lds, S, tid);
        if (wr == 1) PG8_BAR;
        PG8_WAIT_V(4); PG8_BAR;
        PG8_STAGE(PG8_SB(1, 0), cB + kstep, voffB); PG8_STAGE(PG8_SA(1, 0), cA + kstep, voffA); PG8_STAGE(PG8_SB(1, 1), cB + hstep + kstep, voffB);
        PG8_WAIT_V(6); PG8_BAR;
    }
    for (;;) {
        const bool has_next = S.next(ui + 1, nxt);
        const char* nA = has_next ? (const char*)g.A + (size_t)nxt.pm * tstep : cA; const char* nB = has_next ? (const char*)g.Bt + (size_t)nxt.pn * tstep : cB;
        for (int t = 0; t < nt; t += 2) {
            const bool last = (t == nt - 2);
            const char* a1 = cA + (size_t)(t + 1) * kstep;
            const char* a2 = last ? nA : cA + (size_t)(t + 2) * kstep; const char* b2 = last ? nB : cB + (size_t)(t + 2) * kstep;
            const char* a3 = a2 + kstep; const char* b3 = b2 + kstep;
            if (last && has_next) S.a_ready(nxt);
            if constexpr (SP2) {
            PG8_LDB(B0, 0, 0); PG8_LDB(B1, 0, 1); PG8_SCHED; PG8_LDA(At, 0, 0); PG8_STAGE(PG8_SA(1, 1), a1 + hstep, voffA);
            PG8_WAIT_V(8); PG8_WAIT_L(0); PG8_BAR; PG8_MMA(0, 0, At, B0); PG8_MMA(0, 1, At, B1); PG8_BAR; PG8_SCHED;
            PG8_LDA(At, 0, 1); PG8_STAGE(PG8_SB(0, 0), b2, voffB); PG8_STAGE(PG8_SB(0, 1), b2 + hstep, voffB); PG8_STAGE(PG8_SA(0, 0), a2, voffA);
            PG8_WAIT_V(8); PG8_WAIT_L(0); PG8_BAR; PG8_MMA(1, 0, At, B0); PG8_MMA(1, 1, At, B1); PG8_BAR; PG8_SCHED;
            PG8_LDB(B0, 1, 0); PG8_LDB(B1, 1, 1); PG8_SCHED; PG8_LDA(At, 1, 0); PG8_STAGE(PG8_SA(0, 1), a2 + hstep, voffA);
            PG8_WAIT_V(8); PG8_WAIT_L(0); PG8_BAR; PG8_MMA(0, 0, At, B0); PG8_MMA(0, 1, At, B1); PG8_BAR; PG8_SCHED;
            PG8_LDA(At, 1, 1); PG8_STAGE(PG8_SB(1, 0), b3, voffB); PG8_STAGE(PG8_SB(1, 1), b3 + hstep, voffB); PG8_STAGE(PG8_SA(1, 0), a3, voffA);
            PG8_WAIT_V(8); PG8_WAIT_L(0); PG8_BAR; PG8_MMA(1, 0, At, B0); PG8_MMA(1, 1, At, B1); PG8_BAR; PG8_SCHED;
            } else {
            PG8_LDB(B0, 0, 0); PG8_SCHED; PG8_LDA(At, 0, 0); PG8_STAGE(PG8_SA(1, 1), a1 + hstep, voffA);
            PG8_WAIT_L(8); PG8_BAR; PG8_WAIT_L(0); PG8_MMA(0, 0, At, B0); PG8_BAR; PG8_SCHED;
            PG8_LDB(B1, 0, 1); PG8_STAGE(PG8_SB(0, 0), b2, voffB);
            PG8_BAR; PG8_WAIT_L(0); PG8_MMA(0, 1, At, B1); PG8_BAR;
            PG8_LDA(At, 0, 1); PG8_STAGE(PG8_SA(0, 0), a2, voffA);
            PG8_BAR; PG8_WAIT_L(0); PG8_MMA(1, 0, At, B0); PG8_BAR; PG8_SCHED;
            PG8_STAGE(PG8_SB(0, 1), b2 + hstep, voffB);
            PG8_WAIT_V(6); PG8_BAR; PG8_MMA(1, 1, At, B1); PG8_BAR;
            PG8_LDB(B0, 1, 0); PG8_SCHED; PG8_LDA(At, 1, 0); PG8_STAGE(PG8_SA(0, 1), a2 + hstep, voffA);
            PG8_WAIT_L(8); PG8_BAR; PG8_WAIT_L(0); PG8_MMA(0, 0, At, B0); PG8_BAR; PG8_SCHED;
            PG8_LDB(B1, 1, 1); PG8_STAGE(PG8_SB(1, 0), b3, voffB);
            PG8_BAR; PG8_WAIT_L(0); PG8_MMA(0, 1, At, B1); PG8_BAR;
            PG8_LDA(At, 1, 1); PG8_STAGE(PG8_SA(1, 0), a3, voffA);
            PG8_BAR; PG8_WAIT_L(0); PG8_MMA(1, 0, At, B0); PG8_BAR; PG8_SCHED;
            PG8_STAGE(PG8_SB(1, 1), b3 + hstep, voffB);
            PG8_WAIT_V(6); PG8_BAR; PG8_MMA(1, 1, At, B1); PG8_BAR;
            }
        }
        if constexpr (ALIGN_EPI) { if (wr == 0) PG8_BAR; }
        if constexpr (!Epi::AFTER_DRAIN) { E(acc, cur, wr, wc, fr, fq, ui); S.done(cur); }
        if (!has_next) break;
#pragma unroll
        for (int a = 0; a < 2; ++a)
#pragma unroll
            for (int b = 0; b < 2; ++b)
#pragma unroll
                for (int m = 0; m < 4; ++m)
#pragma unroll
                    for (int n = 0; n < 2; ++n) acc[a][b][m][n] = (f32x4){0.f, 0.f, 0.f, 0.f};
        cur = nxt; cA = nA; cB = nB; ++ui;
        if constexpr (ALIGN_EPI) { if (wr == 1) PG8_BAR; }
    }
    PG8_WAIT_V(0);
    if constexpr (!ALIGN_EPI) { if (wr == 0) PG8_BAR; }
    PG8_BAR;
    if constexpr (Epi::AFTER_DRAIN) { E.fused(acc, cur, wr, wc, fr, fq, lds, wid, lane); S.done(cur); }
#undef PG8_SA
#undef PG8_SB
#undef PG8_STAGE
#undef PG8_LDA
#undef PG8_LDB
#undef PG8_MMA
#undef PG8_WAIT_V
#undef PG8_WAIT_L
#undef PG8_BAR
#undef PG8_SCHED
}
}

constexpr int BATCH = 4, SEQ = 4096, DM = 1024, MROWS = BATCH * SEQ;
constexpr int CE = 2048, CN = 4 * CE;
constexpr int NH = 16, HD = 64, NG = 3, QKVC = 9216, AN = 10240;
constexpr float EPS = 1e-6f, LOG2E = 1.4426950408889634f, QSCALE = 0.125f * LOG2E;
constexpr int NPHASE = 18;

constexpr size_t MiB = 1u << 20;
constexpr size_t WS_CTL = 0, CTL_ZERO_BYTES = 1 * MiB;
constexpr size_t WS_SSQ = 1 * MiB;
constexpr size_t WS_W1 = 2 * MiB, WS_W2 = 18 * MiB, WS_W3 = 22 * MiB, WS_W4 = 42 * MiB;
constexpr size_t WS_LSE = 44 * MiB;
constexpr size_t WS_BIAS = 47 * MiB;
constexpr size_t WS_XB = 48 * MiB;
constexpr size_t WS_QO = 80 * MiB;
constexpr size_t WS_CG = 112 * MiB;
constexpr size_t WS_KA = 176 * MiB, WS_VA = 208 * MiB, WS_KB = 240 * MiB, WS_VB = 272 * MiB;
constexpr size_t WS_Y = WS_KA;
constexpr size_t WS_SIDE = 304 * MiB;
constexpr size_t WS_END = 307 * MiB;
constexpr int CW_TMO = 0, CW_BAR = 4096;

#define GAS __attribute__((address_space(1)))
#define LAS __attribute__((address_space(3)))
typedef unsigned short bf16;
typedef unsigned v4u __attribute__((ext_vector_type(4)));
typedef unsigned v2u __attribute__((ext_vector_type(2)));
typedef float f32x4 __attribute__((ext_vector_type(4)));
typedef short bf16x8 __attribute__((ext_vector_type(8)));
typedef GAS unsigned gu32;
#define RLX_AGENT __ATOMIC_RELAXED, __HIP_MEMORY_SCOPE_AGENT
#define LDS_WAIT() asm volatile("s_waitcnt lgkmcnt(0)" ::: "memory")
#define VM_WAIT() asm volatile("s_waitcnt vmcnt(0)" ::: "memory")
__device__ __forceinline__ unsigned f2bf(float f) { unsigned u = __builtin_bit_cast(unsigned, f); return (u + 0x7fffu + ((u >> 16) & 1u)) >> 16; }
typedef float f32x2_t __attribute__((ext_vector_type(2))); typedef __bf16 bf16x2_t __attribute__((ext_vector_type(2)));
__device__ __forceinline__ unsigned pk2(float lo, float hi) { f32x2_t v = {lo, hi}; bf16x2_t b = __builtin_convertvector(v, bf16x2_t); return __builtin_bit_cast(unsigned, b); }
__device__ __forceinline__ float bf2f(unsigned h) { return __builtin_bit_cast(float, h << 16); }
__device__ __forceinline__ float bflo(unsigned w) { return __builtin_bit_cast(float, w << 16); }
__device__ __forceinline__ float bfhi(unsigned w) { return __builtin_bit_cast(float, w & 0xffff0000u); }
__device__ __forceinline__ float sigmoidf_(float z) { return __builtin_amdgcn_rcpf(1.0f + __builtin_amdgcn_exp2f(-z * LOG2E)); }
__device__ __forceinline__ float row_rs(const float* ssq, int row) {
    const f32x4* p = (const f32x4*)(ssq + (size_t)row * 16);
    const f32x4 s = (p[0] + p[1]) + (p[2] + p[3]);
    return 1.0f / sqrtf(((s.x + s.y) + (s.z + s.w)) * (1.0f / DM) + EPS);
}
__device__ __forceinline__ float wave_sum(float v) {
#pragma unroll
    for (int o = 1; o < 64; o <<= 1) v += __shfl_xor(v, o);
    return v;
}
__device__ __forceinline__ int t5_bucket(int d) {
    if (d < 16) return d;
    int b = 15;
    b += (d >= 16); b += (d >= 22); b += (d >= 30); b += (d >= 40); b += (d >= 54); b += (d >= 73); b += (d >= 99); b += (d >= 134);
    b += (d >= 182); b += (d >= 246); b += (d >= 332); b += (d >= 450); b += (d >= 609); b += (d >= 825); b += (d >= 1117); b += (d >= 1513);
    return b;
}

#define XB_TMO      128
#define XB_XCNT(j)  (256  + 64 * (j))
#define XB_XSUB(j)  (1280 + 64 * (j))
#define XB_XGEN(j)  (2304 + 64 * (j))
#define XB_TOP      3328
#define XB_TOPGEN   3392
#define XCD_BAR_WORDS 3456
#define XB_SPIN_CAP (1u << 18)

__device__ __forceinline__ unsigned xb_ld(unsigned* p)              { return __hip_atomic_load(p, __ATOMIC_RELAXED, __HIP_MEMORY_SCOPE_AGENT); }
__device__ __forceinline__ unsigned xb_add(unsigned* p, unsigned v) { return __hip_atomic_fetch_add(p, v, __ATOMIC_RELAXED, __HIP_MEMORY_SCOPE_AGENT); }
__device__ __forceinline__ unsigned xb_xcc_id() { return (unsigned)__builtin_amdgcn_s_getreg((3 << 11) | 20) & 0xFu; }
#define XB_SPIN(cond, bar) do { unsigned _sp = 0; while (cond) { __builtin_amdgcn_s_sleep(1); \
    if ((++_sp & 255u) == 0u) { if (xb_ld(&(bar)[XB_TMO])) break; if (_sp > XB_SPIN_CAP) { atomicAdd(&(bar)[XB_TMO], 1u); break; } } } } while (0)

struct XcdBarrier {
    unsigned* bar; unsigned x;
    volatile LAS unsigned* st;
};

__device__ __forceinline__ XcdBarrier xcd_barrier_post(unsigned* bar, volatile LAS unsigned* st) {
    XcdBarrier b; b.bar = bar; b.x = xb_xcc_id(); b.st = st;
    if (threadIdx.x == 0) (void)xb_add(&bar[XB_XCNT(b.x)], 1u);
    return b;
}
__device__ __forceinline__ void xcd_barrier_complete(unsigned* bar, unsigned x, unsigned& nloc, unsigned& nx) {
    const unsigned G = gridDim.x * gridDim.y * gridDim.z;
    unsigned sum, cnt, mine, sp = 0u;
    for (;;) {
        sum = 0u; cnt = 0u; mine = 0u;
#pragma unroll
        for (unsigned j = 0; j < 16; ++j) { const unsigned c = xb_ld(&bar[XB_XCNT(j)]); sum += c; cnt += (c > 0u) ? 1u : 0u; mine = (j == x) ? c : mine; }
        if (sum == G) break;
        __builtin_amdgcn_s_sleep(1);
        if ((++sp & 255u) == 0u) { if (xb_ld(&bar[XB_TMO])) break; if (sp > XB_SPIN_CAP) { atomicAdd(&bar[XB_TMO], 1u); break; } }
    }
    nloc = mine > 0u ? mine : 1u; nx = cnt > 0u ? cnt : 1u;
}

__device__ __forceinline__ void xcd_barrier(const XcdBarrier& b) {
    asm volatile("s_waitcnt vmcnt(0)" ::: "memory");
    __syncthreads();
    if (threadIdx.x == 0) {
        unsigned* bar = b.bar;
        __builtin_amdgcn_s_waitcnt(0);
        unsigned nloc = b.st[0], nx = b.st[1];
        if (nloc == 0u) { xcd_barrier_complete(bar, b.x, nloc, nx); b.st[0] = nloc; b.st[1] = nx; }
        const unsigned old = xb_add(&bar[XB_XSUB(b.x)], 1u);
        const unsigned gen = old / nloc;
        if (old + 1u == (gen + 1u) * nloc) {
            __builtin_amdgcn_fence(__ATOMIC_RELEASE, "agent");
            asm volatile("s_waitcnt vmcnt(0)" ::: "memory");
            const unsigned og = xb_add(&bar[XB_TOP], 1u);
            const unsigned tg = og / nx;
            if (og + 1u == (tg + 1u) * nx) xb_add(&bar[XB_TOPGEN], 1u);
            else XB_SPIN(xb_ld(&bar[XB_TOPGEN]) == tg, bar);
            __builtin_amdgcn_fence(__ATOMIC_ACQUIRE, "agent");
            xb_add(&bar[XB_XGEN(b.x)], 1u);
            asm volatile("s_waitcnt vmcnt(0)" ::: "memory");
        } else {
            XB_SPIN(xb_ld(&bar[XB_XGEN(b.x)]) == gen, bar);
            __builtin_amdgcn_fence(__ATOMIC_ACQUIRE, "agent");
            asm volatile("s_waitcnt vmcnt(0)" ::: "memory");
        }
    }
    __syncthreads();
}

#ifndef DUP_EPI
#define DUP_EPI 0
#endif
namespace epi {
using pg8::Unit; using pg8::bf16_t;

__device__ __forceinline__ void rows_rs(const float* ssq, int row0  , int fq, float (&rs)[2][4]) {
    f32x4 pp[2][4];
#pragma unroll
    for (int ai = 0; ai < 2; ++ai)
#pragma unroll
        for (int m = 0; m < 4; ++m) pp[ai][m] = *(const f32x4*)(ssq + (size_t)(row0 + ai * 128 + m * 16) * 16 + 4 * fq);
#pragma unroll
    for (int ai = 0; ai < 2; ++ai)
#pragma unroll
        for (int m = 0; m < 4; ++m) { float t = (pp[ai][m][0] + pp[ai][m][1]) + (pp[ai][m][2] + pp[ai][m][3]); t += __shfl_xor(t, 16); t += __shfl_xor(t, 32); rs[ai][m] = __builtin_amdgcn_rsqf(t * (1.0f / DM) + EPS); }
}
struct ConvIn {
    static constexpr bool PERM = false, AFTER_DRAIN = false, DUP = (DUP_EPI != 0);
    const float* ssq; bf16_t* V; bf16_t* G;
    template <class Sched> __device__ __forceinline__ void begin(LAS unsigned char*, const Sched&, int) const {}
    __device__ __forceinline__ void operator()(const f32x4 (&acc)[2][2][4][2], const Unit& u, int wr, int wc, int fr, int fq, int) const {
        const int ch0 = u.pn * 64 + wc * 16 + 4 * fq;
        float rsv[2][4]; rows_rs(ssq, u.pm * 256 + wr * 64 + fr, fq, rsv);
#pragma unroll
        for (int ai = 0; ai < 2; ++ai)
#pragma unroll
            for (int m = 0; m < 4; ++m) {
                const int row = u.pm * 256 + ai * 128 + wr * 64 + m * 16 + fr;
                const float rs = rsv[ai][m];
                const f32x4 b = acc[ai][0][m][0] * rs, c = acc[ai][0][m][1] * rs, uu = acc[ai][1][m][0] * rs, z = acc[ai][1][m][1] * rs;
                const f32x4 v = c * uu;
                f32x4 g;
#pragma unroll
                for (int i = 0; i < 4; ++i) g[i] = b[i] * z[i] * sigmoidf_(z[i]);
                v2u wv, wg; wv.x = pk2(v[0], v[1]); wv.y = pk2(v[2], v[3]); wg.x = pk2(g[0], g[1]); wg.y = pk2(g[2], g[3]);
                *(v2u*)(V + (size_t)row * CE + ch0) = wv;
                *(v2u*)(G + (size_t)row * CE + ch0) = wg;
            }
    }
};


constexpr int RSTAB_OFF = 152832, GTAB_OFF = 161024;
template <class Sched> __device__ __forceinline__ void fill_rstab(LAS unsigned char* lds, const float* ssq, const Sched& S, int tid) {
    LAS float* tab = (LAS float*)(lds + RSTAB_OFF);
    Unit u;
    for (int i = tid >> 8; i < 8 && S.next(i, u); i += 2) {
        const f32x4* p = (const f32x4*)(ssq + (size_t)(u.pm * 256 + (tid & 255)) * 16);
        const f32x4 s = (p[0] + p[1]) + (p[2] + p[3]);
        tab[i * 256 + (tid & 255)] = __builtin_amdgcn_rsqf(((s[0] + s[1]) + (s[2] + s[3])) * (1.0f / DM) + EPS);
    }
}
__device__ __forceinline__ void tab_rs(LAS unsigned char* lds, int ui, int wr, int fr, float (&rs)[2][4]) {
    const LAS float* tab = (const LAS float*)(lds + RSTAB_OFF) + ui * 256 + wr * 64 + fr;
#pragma unroll
    for (int ai = 0; ai < 2; ++ai)
#pragma unroll
        for (int m = 0; m < 4; ++m) rs[ai][m] = tab[ai * 128 + m * 16];
}
struct ConvFused {
    static constexpr bool PERM = false, AFTER_DRAIN = false, DUP = false;
    const float* ssq; bf16_t* Y; const float* cw; float* side; LAS unsigned char* xch;
    static __device__ __forceinline__ f32x4 unpk(v2u p) { return (f32x4){bflo(p.x), bfhi(p.x), bflo(p.y), bfhi(p.y)}; }
    template <class Sched> __device__ __forceinline__ void begin(LAS unsigned char* lds, const Sched& S, int tid) const { fill_rstab(lds, ssq, S, tid); }
    __device__ __forceinline__ void operator()(const f32x4 (&acc)[2][2][4][2], const Unit& u, int wr, int wc, int fr, int fq, int ui) const {
        const int ch0 = u.pn * 64 + wc * 16 + 4 * fq;
        float rsv[2][4]; tab_rs(xch - 131072, ui, wr, fr, rsv);
        const f32x4 w0 = *(const f32x4*)(cw + ch0), w1 = *(const f32x4*)(cw + CE + ch0), w2 = *(const f32x4*)(cw + 2 * CE + ch0);
        v2u vq[2][4]; f32x4 gt[2][4];
#pragma unroll
        for (int ai = 0; ai < 2; ++ai)
#pragma unroll
            for (int m = 0; m < 4; ++m) {
                const float rs = rsv[ai][m];
                const f32x4 b = acc[ai][0][m][0] * rs, c = acc[ai][0][m][1] * rs, uu = acc[ai][1][m][0] * rs, z = acc[ai][1][m][1] * rs;
                const f32x4 v = c * uu;
                vq[ai][m].x = pk2(v[0], v[1]); vq[ai][m].y = pk2(v[2], v[3]);
#pragma unroll
                for (int i = 0; i < 4; ++i) gt[ai][m][i] = b[i] * z[i] * sigmoidf_(z[i]);
            }
        LAS unsigned char* my = xch + (wr * 4 + wc) * 2720 + fq * 8;
        LAS unsigned char* other = xch + ((1 - wr) * 4 + wc) * 2720 + fq * 8;
        const bool seq_start = (u.pm & 15) == 0;
        if (fr >= 14) {
            const int hr = fr - 14;
            *(LAS v2u*)(other + ((wr == 0 ? 0 : 66) + hr) * 40) = vq[0][3];
            if (wr == 0) *(LAS v2u*)(other + (66 + hr) * 40) = vq[1][3];
            else *(f32x4*)(side + ((size_t)u.pm * 6 + 4 + hr) * CE + ch0) = unpk(vq[1][3]);
        }
        if (wr == 0 && fr < 2) *(LAS v2u*)(my + fr * 40) = (v2u){0u, 0u};
#pragma unroll
        for (int m = 0; m < 4; ++m) *(LAS v2u*)(my + (2 + 16 * m + fr) * 40) = vq[0][m];
        asm volatile("s_waitcnt lgkmcnt(0)\n\ts_barrier" ::: "memory");
#pragma unroll
        for (int ai = 0; ai < 2; ++ai) {
            if (ai == 1) {
#pragma unroll
                for (int m = 0; m < 4; ++m) *(LAS v2u*)(my + (2 + 16 * m + fr) * 40) = vq[1][m];
                asm volatile("s_waitcnt lgkmcnt(0)" ::: "memory");
            }
#pragma unroll
            for (int m = 0; m < 4; ++m) {
                const int k = 16 * m + fr;
                int r1 = k + 1, r2 = k;
                if (ai == 1) { if (k < 1) r1 = 67; if (k < 2) r2 = 66 + k; }
                const f32x4 p1 = unpk(*(const LAS v2u*)(my + r1 * 40)), p2 = unpk(*(const LAS v2u*)(my + r2 * 40)), v = unpk(vq[ai][m]);
#ifdef DBG_NOPREV
                const f32x4 cv = w2 * v + (w1 * p1 + w0 * p2) * 0.0f;
#else
                const f32x4 cv = w2 * v + w1 * p1 + w0 * p2;
#endif
#ifdef DBG_Y0
                const f32x4 y = gt[ai][m] * cv * 0.0f;
#else
                const f32x4 y = gt[ai][m] * cv;
#endif
                const int row = u.pm * 256 + ai * 128 + wr * 64 + k;
                v2u wy; wy.x = pk2(y[0], y[1]); wy.y = pk2(y[2], y[3]);
                *(v2u*)(Y + (size_t)row * CE + ch0) = wy;
                if (ai == 0 && m == 0 && wr == 0 && fr < 2 && !seq_start) {
                    *(f32x4*)(side + ((size_t)u.pm * 6 + fr) * CE + ch0) = gt[0][0];
                    *(f32x4*)(side + ((size_t)u.pm * 6 + 2 + fr) * CE + ch0) = cv;
                }
            }
        }
    }
};
struct Resid {
    static constexpr bool PERM = false, AFTER_DRAIN = false, DUP = false;
    const float* xin; float* xout; bf16_t* xb; float* ssq;
    template <class Sched> __device__ __forceinline__ void begin(LAS unsigned char*, const Sched&, int) const {}
    __device__ __forceinline__ void operator()(const f32x4 (&acc)[2][2][4][2], const Unit& u, int wr, int wc, int fr, int fq, int) const {
        const int col0 = u.pn * 256 + wc * 32 + 4 * fq;
        const size_t off0 = (size_t)(u.pm * 256 + wr * 64 + fr) * DM + col0;
        f32x4 pre[4][2][2];
#pragma unroll
        for (int i = 0; i < 4; ++i)
#pragma unroll
            for (int bj = 0; bj < 2; ++bj)
#pragma unroll
                for (int n = 0; n < 2; ++n) pre[i][bj][n] = *(const f32x4*)(xin + off0 + (size_t)(16 * i) * DM + bj * 128 + n * 16);
#pragma unroll
        for (int i = 0; i < 8; ++i) {
            const int ai = i >> 2, m = i & 3;
            const size_t off = off0 + (size_t)(ai * 128 + m * 16) * DM;
            float ss = 0.f; f32x4 xn[2][2];
#pragma unroll
            for (int bj = 0; bj < 2; ++bj)
#pragma unroll
                for (int n = 0; n < 2; ++n) { xn[bj][n] = pre[i & 3][bj][n] + acc[ai][bj][m][n]; const f32x4 t = xn[bj][n]; ss += (t[0] * t[0] + t[1] * t[1]) + (t[2] * t[2] + t[3] * t[3]); }
            if (i < 4) {
#pragma unroll
                for (int bj = 0; bj < 2; ++bj)
#pragma unroll
                    for (int n = 0; n < 2; ++n) pre[i & 3][bj][n] = *(const f32x4*)(xin + off + (size_t)128 * DM + bj * 128 + n * 16);
            }
#pragma unroll
            for (int bj = 0; bj < 2; ++bj)
#pragma unroll
                for (int n = 0; n < 2; ++n) {
                    *(f32x4*)(xout + off + bj * 128 + n * 16) = xn[bj][n];
                    v2u w; w.x = pk2(xn[bj][n][0], xn[bj][n][1]); w.y = pk2(xn[bj][n][2], xn[bj][n][3]);
                    *(v2u*)(xb + off + bj * 128 + n * 16) = w;
                }
            ss += __shfl_xor(ss, 16); ss += __shfl_xor(ss, 32);
            if (fq == 0) ssq[(size_t)(u.pm * 256 + ai * 128 + wr * 64 + m * 16 + fr) * 16 + u.pn * 4 + wc] = ss;
        }
    }
};
template <int MODE> struct ResidB {
    static constexpr bool PERM = false, AFTER_DRAIN = false, DUP = false;
    const float* xin; float* xout; bf16_t* xb; float* ssq; bf16_t* xbw;
    template <class Sched> __device__ __forceinline__ void begin(LAS unsigned char*, const Sched&, int) const {}
    __device__ __forceinline__ void operator()(const f32x4 (&acc)[2][2][4][2], const Unit& u, int wr, int wc, int fr, int fq, int) const {
        const int col0 = u.pn * 256 + wc * 32 + 4 * fq;
        const size_t off0 = (size_t)(u.pm * 256 + wr * 64 + fr) * DM + col0;
        if constexpr (MODE == 0) {
            f32x4 pre[4][2][2];
#pragma unroll
            for (int i = 0; i < 4; ++i)
#pragma unroll
                for (int bj = 0; bj < 2; ++bj)
#pragma unroll
                    for (int n = 0; n < 2; ++n) pre[i][bj][n] = *(const f32x4*)(xin + off0 + (size_t)(16 * i) * DM + bj * 128 + n * 16);
#pragma unroll
            for (int i = 0; i < 8; ++i) {
                const int ai = i >> 2, m = i & 3;
                const size_t off = off0 + (size_t)(ai * 128 + m * 16) * DM;
                float ss = 0.f; f32x4 xn[2][2];
#pragma unroll
                for (int bj = 0; bj < 2; ++bj)
#pragma unroll
                    for (int n = 0; n < 2; ++n) { xn[bj][n] = pre[i & 3][bj][n] + acc[ai][bj][m][n]; const f32x4 t = xn[bj][n]; ss += (t[0] * t[0] + t[1] * t[1]) + (t[2] * t[2] + t[3] * t[3]); }
                if (i < 4) {
#pragma unroll
                    for (int bj = 0; bj < 2; ++bj)
#pragma unroll
                        for (int n = 0; n < 2; ++n) pre[i & 3][bj][n] = *(const f32x4*)(xin + off + (size_t)128 * DM + bj * 128 + n * 16);
                }
#pragma unroll
                for (int bj = 0; bj < 2; ++bj)
#pragma unroll
                    for (int n = 0; n < 2; ++n) { v2u w; w.x = pk2(xn[bj][n][0], xn[bj][n][1]); w.y = pk2(xn[bj][n][2], xn[bj][n][3]); *(v2u*)(xbw + off + bj * 128 + n * 16) = w; }
                ss += __shfl_xor(ss, 16); ss += __shfl_xor(ss, 32);
                if (fq == 0) ssq[(size_t)(u.pm * 256 + ai * 128 + wr * 64 + m * 16 + fr) * 16 + u.pn * 4 + wc] = ss;
            }
        } else {
            v2u pre[8][2][2];
#pragma unroll
            for (int i = 0; i < 8; ++i)
#pragma unroll
                for (int bj = 0; bj < 2; ++bj)
#pragma unroll
                    for (int n = 0; n < 2; ++n) pre[i][bj][n] = *(const v2u*)(xb + off0 + (size_t)((i >> 2) * 128 + (i & 3) * 16) * DM + bj * 128 + n * 16);
#pragma unroll
            for (int i = 0; i < 8; ++i) {
                const int ai = i >> 2, m = i & 3;
                const size_t off = off0 + (size_t)(ai * 128 + m * 16) * DM;
                float ss = 0.f;
#pragma unroll
                for (int bj = 0; bj < 2; ++bj)
#pragma unroll
                    for (int n = 0; n < 2; ++n) {
                        const v2u p = pre[i][bj][n];
                        const f32x4 t = (f32x4){bflo(p.x), bfhi(p.x), bflo(p.y), bfhi(p.y)} + acc[ai][bj][m][n];
                        if constexpr (MODE == 2) { *(f32x4*)(xout + off + bj * 128 + n * 16) = t; }
                        else { ss += (t[0] * t[0] + t[1] * t[1]) + (t[2] * t[2] + t[3] * t[3]); v2u w; w.x = pk2(t[0], t[1]); w.y = pk2(t[2], t[3]); *(v2u*)(xbw + off + bj * 128 + n * 16) = w; }
                    }
                if constexpr (MODE != 2) {
                    ss += __shfl_xor(ss, 16); ss += __shfl_xor(ss, 32);
                    if (fq == 0) ssq[(size_t)(u.pm * 256 + ai * 128 + wr * 64 + m * 16 + fr) * 16 + u.pn * 4 + wc] = ss;
                }
            }
        }
    }
};
struct QKV {
    static constexpr bool PERM = true, AFTER_DRAIN = false, DUP = (DUP_EPI != 0);
    const float* ssq; bf16_t* Q; bf16_t* K; bf16_t* Vv; const float* qg; const float* kg; LAS unsigned char* lds0;
    template <class Sched> __device__ __forceinline__ void begin(LAS unsigned char* lds, const Sched& S, int tid) const {
        fill_rstab(lds, ssq, S, tid);
        if (tid < 128) ((LAS float*)(lds + GTAB_OFF))[tid] = tid < 64 ? qg[tid] * QSCALE : kg[tid - 64];
    }
    __device__ __forceinline__ void operator()(const f32x4 (&acc)[2][2][4][2], const Unit& u, int wr, int wc, int fr, int fq, int ui) const {
        const int which = u.pn >> 2, h = (u.pn & 3) * 4 + wc;
        bf16_t* base = Q + (ptrdiff_t)(which == 1) * (K - Q) + (ptrdiff_t)(which == 2) * (Vv - Q);
        const LAS float* gp = (const LAS float*)(lds0 + GTAB_OFF) + (which == 1 ? 64 : 0); const float gsc = 1.0f; const bool nrm = which < 2;
        const f32x4 g00 = *(const LAS f32x4*)(gp + 8 * fq), g01 = *(const LAS f32x4*)(gp + 8 * fq + 4), g10 = *(const LAS f32x4*)(gp + 32 + 8 * fq), g11 = *(const LAS f32x4*)(gp + 32 + 8 * fq + 4);
        float rsv[2][4]; tab_rs(lds0, ui, wr, fr, rsv);
#pragma unroll
        for (int ai = 0; ai < 2; ++ai)
#pragma unroll
            for (int m = 0; m < 4; ++m) {
                const int row = u.pm * 256 + ai * 128 + wr * 64 + m * 16 + fr;
                const float rs = rsv[ai][m];
                f32x4 v[2][2]; float ss = 0.f;
#pragma unroll
                for (int bj = 0; bj < 2; ++bj)
#pragma unroll
                    for (int n = 0; n < 2; ++n) { v[bj][n] = acc[ai][bj][m][n] * rs; const f32x4 t = v[bj][n]; ss += (t[0] * t[0] + t[1] * t[1]) + (t[2] * t[2] + t[3] * t[3]); }
                ss += __shfl_xor(ss, 16); ss += __shfl_xor(ss, 32);
                const float rn = gsc * __builtin_amdgcn_rsqf(ss * (1.0f / HD) + EPS);
#pragma unroll
                for (int bj = 0; bj < 2; ++bj) {
                    f32x4 a = v[bj][0], b = v[bj][1];
                    if (nrm) { a = a * (bj == 0 ? g00 : g10) * rn; b = b * (bj == 0 ? g01 : g11) * rn; }
                    v4u w; w.x = pk2(a[0], a[1]); w.y = pk2(a[2], a[3]); w.z = pk2(b[0], b[1]); w.w = pk2(b[2], b[3]);
                    *(v4u*)(base + (size_t)row * DM + h * HD + 32 * bj + 8 * fq) = w;
                }
            }
    }
};
struct ZMerge {
    static constexpr bool PERM = true, AFTER_DRAIN = false, DUP = false;
    const float* ssq; const bf16_t* O0; const bf16_t* O1; const bf16_t* O2; const float* lse; bf16_t* Y; LAS unsigned char* lds0;
    struct RowIn { v4u a[2], b[2], c[2]; float l0, l1, l2; };
    __device__ __forceinline__ void load_row(RowIn& r, int row, int h, int fq) const {
        const size_t off = (size_t)row * DM + h * HD + 8 * fq;
        r.l0 = lse[((size_t)0 * MROWS + row) * 16 + h]; r.l1 = lse[((size_t)1 * MROWS + row) * 16 + h]; r.l2 = lse[((size_t)2 * MROWS + row) * 16 + h];
#pragma unroll
        for (int bj = 0; bj < 2; ++bj) { r.a[bj] = *(const v4u*)(O0 + off + 32 * bj); r.b[bj] = *(const v4u*)(O1 + off + 32 * bj); r.c[bj] = *(const v4u*)(O2 + off + 32 * bj); }
    }
    template <class Sched> __device__ __forceinline__ void begin(LAS unsigned char* lds, const Sched& S, int tid) const { fill_rstab(lds, ssq, S, tid); }
    __device__ __forceinline__ void operator()(const f32x4 (&acc)[2][2][4][2], const Unit& u, int wr, int wc, int fr, int fq, int ui) const {
        const int h = u.pn * 4 + wc, row0 = u.pm * 256 + wr * 64 + fr;
        RowIn in[2];
        load_row(in[0], row0, h, fq);
        float rsv[2][4]; tab_rs(lds0, ui, wr, fr, rsv);
#pragma unroll
        for (int i = 0; i < 8; ++i) {
            const int ai = i >> 2, m = i & 3, row = row0 + ai * 128 + m * 16;
            if (i + 1 < 8) load_row(in[(i + 1) & 1], row0 + ((i + 1) >> 2) * 128 + ((i + 1) & 3) * 16, h, fq);
            const RowIn& r = in[i & 1];
            const float rs = rsv[ai][m];
            const float mx = fmaxf(r.l0, fmaxf(r.l1, r.l2));
            float w0 = __builtin_amdgcn_exp2f(r.l0 - mx), w1 = __builtin_amdgcn_exp2f(r.l1 - mx), w2 = __builtin_amdgcn_exp2f(r.l2 - mx);
            const float inv = __builtin_amdgcn_rcpf(w0 + w1 + w2); w0 *= inv; w1 *= inv; w2 *= inv;
#pragma unroll
            for (int bj = 0; bj < 2; ++bj) {
                const v4u a = r.a[bj], b = r.b[bj], c = r.c[bj];
                float o[8];
#pragma unroll
                for (int k = 0; k < 4; ++k) { o[2 * k] = w0 * bflo(a[k]) + w1 * bflo(b[k]) + w2 * bflo(c[k]); o[2 * k + 1] = w0 * bfhi(a[k]) + w1 * bfhi(b[k]) + w2 * bfhi(c[k]); }
                const f32x4 z0 = acc[ai][bj][m][0] * rs, z1 = acc[ai][bj][m][1] * rs;
                float y[8];
#pragma unroll
                for (int k = 0; k < 4; ++k) { y[k] = o[k] * z0[k] * sigmoidf_(z0[k]); y[4 + k] = o[4 + k] * z1[k] * sigmoidf_(z1[k]); }
                v4u w; w.x = pk2(y[0], y[1]); w.y = pk2(y[2], y[3]); w.z = pk2(y[4], y[5]); w.w = pk2(y[6], y[7]);
                *(v4u*)(Y + (size_t)row * DM + h * HD + 32 * bj + 8 * fq) = w;
            }
        }
    }
};
}

template <int MODE> __device__ __forceinline__ int wt_dest_row(int n) {
    if (MODE == 1) { const int type = n >> 11, e = n & 2047, pn = e >> 6, el = e & 63; return 256 * pn + 128 * (type >> 1) + 32 * (el >> 4) + 16 * (type & 1) + (el & 15); }
    if (MODE == 3) { const int blk = n >> 10, r = n & 1023, h = r >> 6, d = r & 63; return blk * 1024 + 256 * (h >> 2) + 128 * (d >> 5) + 32 * (h & 3) + (d & 31); }
    return n;
}
template <int MODE> __device__ __forceinline__ void p0_transpose_item(const float* W, int K, int N, const float* scale, bf16* WT, LAS float* scr  , int item, int lane) {
    const int nblk = N / 64, kb = item / nblk, nb = item % nblk, k0 = 64 * kb, n0 = 64 * nb;
    const int kr = lane >> 4, c4 = lane & 15;
    f32x4 v[16];
#pragma unroll
    for (int i = 0; i < 16; ++i) v[i] = *(const GAS f32x4*)(W + (size_t)(k0 + 4 * i + kr) * N + n0 + 4 * c4);
#pragma unroll
    for (int i = 0; i < 16; ++i) { const float s = scale ? scale[k0 + 4 * i + kr] : 1.0f; LAS float* d = scr + (4 * i + kr) * 65 + 4 * c4;
        d[0] = v[i][0] * s; d[1] = v[i][1] * s; d[2] = v[i][2] * s; d[3] = v[i][3] * s; }
    LDS_WAIT(); asm volatile("" ::: "memory");
    const int c = lane & 7, nl = lane >> 3;
#pragma unroll
    for (int j = 0; j < 8; ++j) { const int n = nl + 8 * j; const LAS float* s = scr + (8 * c) * 65 + n;
        v4u o; o.x = pk2(s[0 * 65], s[1 * 65]); o.y = pk2(s[2 * 65], s[3 * 65]); o.z = pk2(s[4 * 65], s[5 * 65]); o.w = pk2(s[6 * 65], s[7 * 65]);
        *(GAS v4u*)(WT + (size_t)wt_dest_row<MODE>(n0 + n) * K + k0 + 8 * c) = o; }
    LDS_WAIT(); asm volatile("" ::: "memory");
}
struct Ptrs {
    const float *x, *conv_norm, *conv_w_in, *conv_w, *conv_w_out, *attn_norm, *attn_w_in, *q_gain, *k_gain, *attn_w_out, *rel_bias;
    float* out; unsigned char* ws;
};
__device__ __forceinline__ void p0_weights(const Ptrs& P, int j, LAS unsigned char* lds, int vcu, int G, int wave, int lane) {
    LAS float* scr = (LAS float*)(lds + wave * 16640);
    const int gw = vcu * 8 + wave, NGW = G * 8;
    bf16* W1 = (bf16*)(P.ws + WS_W1); bf16* W2 = (bf16*)(P.ws + WS_W2); bf16* W3 = (bf16*)(P.ws + WS_W3); bf16* W4 = (bf16*)(P.ws + WS_W4);
    constexpr int I1 = (DM / 64) * (CN / 64), I2 = (CE / 64) * (DM / 64), I3 = (DM / 64) * (AN / 64), I4 = (DM / 64) * (DM / 64), IL = I1 + I2 + I3 + I4;
    for (int it = gw; it < IL; it += NGW) {
        int r = it;
        if (r < I1) { p0_transpose_item<1>(P.conv_w_in + (size_t)j * DM * CN, DM, CN, P.conv_norm + j * DM, W1, scr, r, lane); continue; } r -= I1;
        if (r < I2) { p0_transpose_item<0>(P.conv_w_out + (size_t)j * CE * DM, CE, DM, nullptr, W2, scr, r, lane); continue; } r -= I2;
        if (r < I3) { p0_transpose_item<3>(P.attn_w_in + (size_t)j * DM * AN, DM, AN, P.attn_norm + j * DM, W3, scr, r, lane); continue; } r -= I3;
        p0_transpose_item<0>(P.attn_w_out + (size_t)j * DM * DM, DM, DM, nullptr, W4, scr, r, lane);
    }
}
__device__ __forceinline__ void p0_prologue(const Ptrs& P, LAS unsigned char* lds, int vcu, int G, int wave, int lane, int tid) {
    p0_weights(P, 0, lds, vcu, G, wave, lane);
    const int gw = vcu * 8 + wave, NGW = G * 8;
    bf16* XB = (bf16*)(P.ws + WS_XB); float* SSQ = (float*)(P.ws + WS_SSQ);
    for (int m = 2 * gw; m < MROWS; m += 2 * NGW) {
        const GAS f32x4* xr = (const GAS f32x4*)(P.x + (size_t)m * DM) + lane;
        GAS v2u* o8 = (GAS v2u*)(XB + (size_t)m * DM) + lane;
        f32x4 v[8];
#pragma unroll
        for (int jj = 0; jj < 8; ++jj) v[jj] = xr[64 * jj];
        float s0 = 0.f, s1 = 0.f;
#pragma unroll
        for (int jj = 0; jj < 8; ++jj) { const f32x4 t = v[jj]; const float q = (t.x * t.x + t.y * t.y) + (t.z * t.z + t.w * t.w); if (jj < 4) s0 += q; else s1 += q;
            v2u w; w.x = pk2(t.x, t.y); w.y = pk2(t.z, t.w); o8[64 * jj] = w; }
        s0 = wave_sum(s0); s1 = wave_sum(s1);
        if (lane < 32) SSQ[(size_t)m * 16 + lane] = lane == 0 ? s0 : (lane == 16 ? s1 : 0.f);
    }
    float* BT = (float*)(P.ws + WS_BIAS);
    for (int i = vcu * 512 + tid; i < NG * NH * 132; i += G * 512) {
        const int g = i / (NH * 132), r = i % (NH * 132), h = r / 132, st = r % 132;
        const int dil = g == 0 ? 1 : (g == 1 ? 4 : 16);
        BT[i] = st <= 128 ? P.rel_bias[t5_bucket(st * dil) * (NG * NH) + g * NH + h] * LOG2E : 0.f;
    }
}
__device__ __forceinline__ void conv_fixup(bf16* Y, const float* side, const float* cw, int pm, int tid) {
    if ((pm & 15) == 0) return;
    const int ch = 4 * tid;
    const f32x4 g0 = *(const f32x4*)(side + ((size_t)pm * 6 + 0) * CE + ch), g1 = *(const f32x4*)(side + ((size_t)pm * 6 + 1) * CE + ch);
    const f32x4 c0 = *(const f32x4*)(side + ((size_t)pm * 6 + 2) * CE + ch), c1 = *(const f32x4*)(side + ((size_t)pm * 6 + 3) * CE + ch);
    const f32x4 va = *(const f32x4*)(side + ((size_t)(pm - 1) * 6 + 4) * CE + ch), vb = *(const f32x4*)(side + ((size_t)(pm - 1) * 6 + 5) * CE + ch);
    const f32x4 w0 = *(const f32x4*)(cw + ch), w1 = *(const f32x4*)(cw + CE + ch);
    const f32x4 y0 = g0 * (c0 + w1 * vb + w0 * va), y1 = g1 * (c1 + w0 * vb);
    v2u a, b; a.x = pk2(y0[0], y0[1]); a.y = pk2(y0[2], y0[3]); b.x = pk2(y1[0], y1[1]); b.y = pk2(y1[2], y1[3]);
    *(v2u*)(Y + (size_t)(pm * 256) * CE + ch) = a; *(v2u*)(Y + (size_t)(pm * 256 + 1) * CE + ch) = b;
}

namespace attn {
typedef float f32x16 __attribute__((ext_vector_type(16)));
typedef short s16x4 __attribute__((ext_vector_type(4)));
typedef short v4i16_t __attribute__((ext_vector_type(4)));
constexpr int L_K = 0, L_V = 49152, L_B = 98304, L_O = 118784, L_END = 151552, L_WS = 161536 + 256;
static_assert(L_O + 8 * 4096 == L_END && L_B + 5 * 4096 == L_O, "attention LDS map");
__device__ __forceinline__ int crow(int r, int hi) { return (r & 3) + 8 * (r >> 2) + 4 * hi; }
__device__ __forceinline__ s16x4 vtr(LAS const unsigned char* p) { return __builtin_bit_cast(s16x4, __builtin_amdgcn_ds_read_tr16_b64_v4i16((LAS v4i16_t*)p)); }
__device__ __forceinline__ float swapmax(float m) { auto rr = __builtin_amdgcn_permlane32_swap(__float_as_uint(m), __float_as_uint(m), false, false); return fmaxf(__uint_as_float(rr[0]), __uint_as_float(rr[1])); }
__device__ __forceinline__ float swapsum(float m) { auto rr = __builtin_amdgcn_permlane32_swap(__float_as_uint(m), __float_as_uint(m), false, false); return __uint_as_float(rr[0]) + __uint_as_float(rr[1]); }

#define ATT_BAR() asm volatile("s_waitcnt lgkmcnt(0)\n\ts_barrier" ::: "memory")
__device__ __forceinline__ void glds16(const void* gsrc, unsigned lds_dst) { unsigned keep;
    asm volatile("s_mov_b32 %0, m0\n\ts_mov_b32 m0, %2\n\ts_nop 0\n\tglobal_load_lds_dwordx4 %1, off\n\ts_mov_b32 m0, %0" : "=&s"(keep) : "v"(gsrc), "s"(lds_dst) : "memory"); }
template <int DIL> struct Job {
    int bh, c, n0, h; size_t rowb;
    __device__ __forceinline__ void decode(int id) { constexpr int CPC = (SEQ / DIL) / 256; bh = id >> 4; const int sub = id & 15; c = sub / CPC; n0 = (sub % CPC) * 256; h = bh & 15; rowb = (size_t)(bh >> 4) * SEQ; }
};
template <int DIL, bool ISV> __device__ __forceinline__ void issue_kv(LAS unsigned char* lds, const bf16* src, const Job<DIL>& J, int w, int lane) {
#pragma unroll
    for (int i = 0; i < 6; ++i) {
        const int kb = w * 6 + i, row = kb * 8 + (lane >> 3), pc = lane & 7;
        int pos = J.n0 - 128 + row; pos = pos < 0 ? 0 : pos;
        const size_t ro = (J.rowb + (size_t)pos * DIL + J.c) * DM + J.h * HD;
        const int sw = ISV ? ((((pc >> 2) ^ ((row >> 1) & 1)) * 32) + (pc & 3) * 8) : ((pc ^ ((row >> 1) & 7)) * 8);
        glds16(src + ro + sw, (unsigned)__builtin_amdgcn_readfirstlane((int)((unsigned)(uintptr_t)lds + (ISV ? L_V : L_K) + kb * 1024)));
    }
}
__device__ __forceinline__ void ld16_asm(bf16x8& dst, const bf16* p) { asm volatile("global_load_dwordx4 %0, %1, off" : "=v"(dst) : "v"(p) : "memory"); }

template <int DIL> __device__ __forceinline__ void phase(LAS unsigned char* lds, const bf16* QO, bf16* OUT, const bf16* Kg, const bf16* Vg, const float* biasT  , float* lse  , int vcu, int G) {
    const int tid = threadIdx.x, lane = tid & 63, r32 = lane & 31, hi = lane >> 5;
    const int w = __builtin_amdgcn_readfirstlane(tid >> 6);
    constexpr int NJS = BATCH * NH * 16;
    int id = vcu * 4;
    if (id >= NJS) return;
    Job<DIL> J; J.decode(id);
    bf16x8 q0, q1, q2, q3;
    issue_kv<DIL, false>(lds, Kg, J, w, lane);
    { const bf16* qp = QO + (J.rowb + (size_t)(J.n0 + 32 * w + r32) * DIL + J.c) * DM + J.h * HD + hi * 8; ld16_asm(q0, qp); ld16_asm(q1, qp + 16); ld16_asm(q2, qp + 32); ld16_asm(q3, qp + 48); }
    issue_kv<DIL, true>(lds, Vg, J, w, lane);
    int cur_bh = -1; bool first = true;
    for (;;) {
        const int nid = id + (((id & 3) == 3) ? (G * 4 - 3) : 1);
        const bool has_next = nid < NJS;
        Job<DIL> JN; JN.decode(has_next ? nid : id);
        if (J.bh != cur_bh) {
            cur_bh = J.bh;
#pragma unroll
            for (int i = 0; i < 10; ++i) {
                const int e = tid + 512 * i, j = e >> 10, rem = e & 1023, rg = rem >> 8, ln = (rem & 255) >> 2, i4 = rem & 3;
                const int r = 4 * rg + i4, a = ln & 31, hh = ln >> 5, kk = 32 * j + crow(r, hh), step = 128 + a - kk;
                float val = -INFINITY;
                if (step >= 0 && step <= 128) val = biasT[J.h * 132 + step];
                ((LAS float*)(lds + L_B))[e] = val;
            }
        }
        if (first) { first = false; asm volatile("s_waitcnt vmcnt(6)" : "+v"(q0), "+v"(q1), "+v"(q2), "+v"(q3) :: "memory"); }
        ATT_BAR();
        const int n0 = J.n0, h = J.h, c = J.c; const size_t rowb = J.rowb;
        const size_t qrow = rowb + (size_t)(n0 + 32 * w + r32) * DIL + c;
        const int jstart = (n0 == 0 && w < 4) ? 4 - w : 0;
        f32x16 S[5];
#pragma unroll
        for (int j = 0; j < 5; ++j) {
            if (j < jstart) {
#pragma unroll
                for (int r = 0; r < 16; ++r) S[j][r] = -INFINITY;
            } else {
                f32x16 cinit;
#pragma unroll
                for (int rg = 0; rg < 4; ++rg) { const f32x4 t = *(const LAS f32x4*)(lds + L_B + j * 4096 + rg * 1024 + lane * 16); cinit[4 * rg] = t[0]; cinit[4 * rg + 1] = t[1]; cinit[4 * rg + 2] = t[2]; cinit[4 * rg + 3] = t[3]; }
#pragma unroll
                for (int d0 = 0; d0 < 4; ++d0) {
                    const bf16x8 kf = *(const LAS bf16x8*)(lds + L_K + (32 * w + 32 * j + r32) * 128 + (((2 * d0 + hi) ^ ((r32 >> 1) & 7)) * 16));
                    cinit = __builtin_amdgcn_mfma_f32_32x32x16_bf16(kf, d0 == 0 ? q0 : (d0 == 1 ? q1 : (d0 == 2 ? q2 : q3)), cinit, 0, 0, 0);
                }
                S[j] = cinit;
            }
        }
        ATT_BAR();
        bf16x8 n0q, n1q, n2q, n3q;
        if (has_next) {
            issue_kv<DIL, false>(lds, Kg, JN, w, lane);
            const bf16* qp = QO + (JN.rowb + (size_t)(JN.n0 + 32 * w + r32) * DIL + JN.c) * DM + JN.h * HD + hi * 8; ld16_asm(n0q, qp); ld16_asm(n1q, qp + 16); ld16_asm(n2q, qp + 32); ld16_asm(n3q, qp + 48);
        }
        float m = -INFINITY;
#pragma unroll
        for (int j = 0; j < 5; ++j)
#pragma unroll
            for (int r = 0; r < 16; ++r) m = fmaxf(m, S[j][r]);
        m = swapmax(m);
        float lsum = 0.f;
#pragma unroll
        for (int j = 0; j < 5; ++j)
#pragma unroll
            for (int r = 0; r < 16; ++r) { const float p = __builtin_amdgcn_exp2f(S[j][r] - m); S[j][r] = p; lsum += p; }
        lsum = swapsum(lsum);
        if (has_next) asm volatile("s_waitcnt vmcnt(10)" ::: "memory"); else asm volatile("s_waitcnt vmcnt(0)" ::: "memory");
        ATT_BAR();
        f32x16 o[2];
#pragma unroll
        for (int r = 0; r < 16; ++r) { o[0][r] = 0.f; o[1][r] = 0.f; }
        const int vq = (lane & 15) >> 2, vx = (vq >> 1) & 1;
        const LAS unsigned char* vrow = lds + L_V + (32 * w + 4 * hi + vq) * 128 + ((lane >> 4) & 1) * 32 + (lane & 3) * 8;
        const LAS unsigned char* vbh[2] = {vrow + vx * 64, vrow + (1 - vx) * 64};
#pragma unroll
        for (int j = 0; j < 5; ++j)
#pragma unroll
            for (int s = 0; s < 2; ++s) {
                v4u pw; pw.x = pk2(S[j][8 * s], S[j][8 * s + 1]); pw.y = pk2(S[j][8 * s + 2], S[j][8 * s + 3]); pw.z = pk2(S[j][8 * s + 4], S[j][8 * s + 5]); pw.w = pk2(S[j][8 * s + 6], S[j][8 * s + 7]);
                const bf16x8 pa = __builtin_bit_cast(bf16x8, pw);
#pragma unroll
                for (int d0 = 0; d0 < 2; ++d0) {
                    const s16x4 lo = vtr(vbh[d0] + (32 * j + 16 * s) * 128), hh = vtr(vbh[d0] + (32 * j + 16 * s + 8) * 128);
                    const bf16x8 vf = (bf16x8){lo[0], lo[1], lo[2], lo[3], hh[0], hh[1], hh[2], hh[3]};
                    o[d0] = __builtin_amdgcn_mfma_f32_32x32x16_bf16(pa, vf, o[d0], 0, 0, 0);
                }
            }
        ATT_BAR();
        if (has_next) issue_kv<DIL, true>(lds, Vg, JN, w, lane);
        LAS float* wsf = (LAS float*)(lds + L_WS) + w * 64;
        if (hi == 0) { wsf[r32] = lsum; lse[qrow * 16 + h] = m + log2f(lsum); }
        asm volatile("s_waitcnt lgkmcnt(0)" ::: "memory");
        float rli[16];
#pragma unroll
        for (int r = 0; r < 16; ++r) rli[r] = __builtin_amdgcn_rcpf(wsf[crow(r, hi)]);
        LAS bf16* stg = (LAS bf16*)(lds + L_O) + w * 2048;
#pragma unroll
        for (int r = 0; r < 16; ++r) { const int orow = crow(r, hi);
#pragma unroll
            for (int d0 = 0; d0 < 2; ++d0) stg[orow * 64 + d0 * 32 + r32] = (bf16)(pk2(o[d0][r] * rli[r], 0.f) & 0xffffu); }
        asm volatile("s_waitcnt lgkmcnt(0)" ::: "memory");
#pragma unroll
        for (int i = 0; i < 4; ++i) { const int row = i * 8 + (lane >> 3), ch = lane & 7; const v4u v = *(const LAS v4u*)(stg + row * 64 + ch * 8);
            *(v4u*)(OUT + (rowb + (size_t)(n0 + 32 * w + row) * DIL + c) * DM + h * HD + ch * 8) = v; }
        if (!has_next) break;
        asm volatile("s_waitcnt vmcnt(6)" : "+v"(n0q), "+v"(n1q), "+v"(n2q), "+v"(n3q) :: "memory");
        id = nid; J = JN; q0 = n0q; q1 = n1q; q2 = n2q; q3 = n3q;
    }
    asm volatile("s_waitcnt vmcnt(0) lgkmcnt(0)\n\ts_barrier" ::: "memory");
}
#undef ATT_BAR
}

#ifndef PARITY_SPLIT
#define PARITY_SPLIT 1
#endif
#ifndef GEMM_SP2
#define GEMM_SP2 true
#endif
#ifndef GEMM_ALIGN
#define GEMM_ALIGN true
#endif
#ifndef DUP_RES
#define DUP_RES 0
#endif
#ifndef DUP_BAR
#define DUP_BAR 0
#endif
constexpr int LDS_BYTES = 163840;
constexpr int XCH_OFF = 131072;
constexpr int MISC_OFF = 161536;
struct Args { const float* in[11]; float* out; unsigned char* ws; int ph_lo, ph_hi; };

enum PhaseKind { PK_P0A, PK_P0B, PK_C1, PK_C3, PK_A1, PK_A1A2, PK_A2, PK_A3, PK_A4 };
struct PhaseDesc { int kind, j, g; };
__host__ __device__ constexpr PhaseDesc phase_desc(int ph) {
    if (ph == 0) return {PK_P0A, 0, 0};
    if (ph == 9) return {PK_P0B, 1, 0};
    const int j = ph >= 10 ? 1 : 0, s = ph - (j ? 10 : 1);
    switch (s) {
        case 0: return {PK_C1, j, 0};
        case 1: return {PK_C3, j, 0};
        case 2: return {PK_A1, j, 0};
        case 3: return {PK_A1A2, j, 0};
        case 4: return {PK_A1A2, j, 1};
        case 5: return {PK_A2, j, 2};
        case 6: return {PK_A3, j, 0};
        default: return {PK_A4, j, 0};
    }
}
__device__ __forceinline__ size_t kbuf_off(int g) { return g == 1 ? WS_KB : WS_KA; }
__device__ __forceinline__ size_t vbuf_off(int g) { return g == 1 ? WS_VB : WS_VA; }

template <int J, int G1> __device__ __forceinline__ void run_qkv_gemm(const Args& args, LAS unsigned char* lds, int G, int bx) {
    unsigned char* ws = args.ws;
    bf16* XB = (bf16*)(ws + WS_XB); float* SSQ = (float*)(ws + WS_SSQ);
    bf16* QO = (bf16*)(ws + WS_QO) + (size_t)G1 * MROWS * DM;
    pg8::Gemm gm{XB, (const bf16*)(ws + WS_W3) + (size_t)G1 * 3072 * DM, MROWS, 3072, DM}; pg8::StaticOrder S; S.init(MROWS, 3072, G, bx);
    epi::QKV E{SSQ, QO, (bf16*)(ws + kbuf_off(G1)), (bf16*)(ws + vbuf_off(G1)), args.in[7] + (J * NG + G1) * HD, args.in[8] + (J * NG + G1) * HD, lds};
    pg8::gemm_phase<epi::QKV, pg8::StaticOrder, GEMM_ALIGN, GEMM_SP2>(lds, gm, S, E);
}
template <int G0> __device__ __forceinline__ void run_attn(const Args& args, LAS unsigned char* lds, int vcu, int G) {
    unsigned char* ws = args.ws;
    constexpr int dil = G0 == 0 ? 1 : (G0 == 1 ? 4 : 16);
    bf16* QO = (bf16*)(ws + WS_QO) + (size_t)G0 * MROWS * DM;
    attn::phase<dil>(lds, QO, QO, (const bf16*)(ws + kbuf_off(G0)), (const bf16*)(ws + vbuf_off(G0)), (const float*)(ws + WS_BIAS) + G0 * NH * 132, (float*)(ws + WS_LSE) + (size_t)G0 * MROWS * 16, vcu, G);
}

template <int PH> __device__ __forceinline__ void run_phase(const Args& args, LAS unsigned char* lds) {
    constexpr PhaseDesc D = phase_desc(PH);
    constexpr int j = D.j;
    const int tid = threadIdx.x, lane = tid & 63, wave = __builtin_amdgcn_readfirstlane(tid >> 6);
    const int G = gridDim.x, bx = blockIdx.x, vcu = (G % 8 == 0) ? (bx % 8) * (G / 8) + bx / 8 : bx;
    unsigned char* ws = args.ws;
    float* SSQ = (float*)(ws + WS_SSQ); bf16* XB = (bf16*)(ws + WS_XB);
    (void)lane; (void)wave; (void)SSQ; (void)XB; (void)vcu;
    if constexpr (D.kind == PK_P0A || D.kind == PK_P0B) {
        Ptrs P;
        P.x = args.in[0]; P.conv_norm = args.in[1]; P.conv_w_in = args.in[2]; P.conv_w = args.in[3]; P.conv_w_out = args.in[4]; P.attn_norm = args.in[5];
        P.attn_w_in = args.in[6]; P.q_gain = args.in[7]; P.k_gain = args.in[8]; P.attn_w_out = args.in[9]; P.rel_bias = args.in[10]; P.out = args.out; P.ws = args.ws;
        if constexpr (D.kind == PK_P0A) p0_prologue(P, lds, vcu, G, wave, lane, tid);
        else p0_weights(P, 1, lds, vcu, G, wave, lane);
    } else if constexpr (D.kind == PK_C1) {
        pg8::Gemm g{XB, (const bf16*)(ws + WS_W1), MROWS, CN, DM}; pg8::StaticOrder S; S.init(MROWS, CN, G, bx);
        epi::ConvFused E{SSQ, (bf16*)(ws + WS_CG), args.in[3] + (size_t)j * 3 * CE, (float*)(ws + WS_SIDE), lds + XCH_OFF};
        pg8::gemm_phase<epi::ConvFused, pg8::StaticOrder, true, GEMM_SP2>(lds, g, S, E);
    } else if constexpr (D.kind == PK_C3 || D.kind == PK_A4) {
        constexpr bool C3 = D.kind == PK_C3; constexpr int K = C3 ? CE : DM;
        const bf16* A = (const bf16*)(ws + (C3 ? WS_CG : WS_Y));
        pg8::Gemm g{A, (const bf16*)(ws + (C3 ? WS_W2 : WS_W4)), MROWS, DM, K}; pg8::StaticOrder S; S.init(MROWS, DM, G, bx);
        if constexpr (C3) { pg8::Unit fu; for (int i = 0; S.next(i, fu); ++i) conv_fixup((bf16*)(ws + WS_CG), (const float*)(ws + WS_SIDE), args.in[3] + (size_t)j * 3 * CE, fu.pm, tid);
            asm volatile("s_waitcnt vmcnt(0)" ::: "memory"); __syncthreads(); }
        constexpr int RMODE = (j == 0 && C3) ? 0 : ((j == 1 && !C3) ? 2 : 1);
#if DUP_RES
        if constexpr (RMODE == 1 && (DUP_RES == 1) == C3) { epi::ResidB<RMODE> E2{args.in[0], args.out, XB, SSQ, (bf16*)(ws + WS_VB)}; pg8::gemm_phase<epi::ResidB<RMODE>, pg8::StaticOrder, false, true>(lds, g, S, E2); }
#endif
        epi::ResidB<RMODE> E{args.in[0], args.out, XB, SSQ, XB};
        pg8::gemm_phase<epi::ResidB<RMODE>, pg8::StaticOrder, false, true>(lds, g, S, E);
    } else if constexpr (D.kind == PK_A1) {
        run_qkv_gemm<j, 0>(args, lds, G, bx);
    } else if constexpr (D.kind == PK_A1A2) {
#if PARITY_SPLIT
        const bool attn_first = ((bx >> 3) & 1) != 0;
#else
        const bool attn_first = false;
#endif
        if (attn_first) { run_attn<D.g>(args, lds, vcu, G); run_qkv_gemm<j, D.g + 1>(args, lds, G, bx); }
        else            { run_qkv_gemm<j, D.g + 1>(args, lds, G, bx); run_attn<D.g>(args, lds, vcu, G); }
    } else if constexpr (D.kind == PK_A2) {
        run_attn<D.g>(args, lds, vcu, G);
    } else if constexpr (D.kind == PK_A3) {
        const bf16* O0 = (const bf16*)(ws + WS_QO); const bf16* O1 = O0 + (size_t)MROWS * DM; const bf16* O2 = O1 + (size_t)MROWS * DM;
        pg8::Gemm g{XB, (const bf16*)(ws + WS_W3) + (size_t)QKVC * DM, MROWS, DM, DM}; pg8::StaticOrder S; S.init(MROWS, DM, G, bx);
        epi::ZMerge E{SSQ, O0, O1, O2, (const float*)(ws + WS_LSE), (bf16*)(ws + WS_Y), lds};
        pg8::gemm_phase<epi::ZMerge, pg8::StaticOrder, false, true>(lds, g, S, E);
    }
}

__global__ void __launch_bounds__(512, 2) mk_fwd(Args args) {
    extern __shared__ __attribute__((aligned(16))) unsigned char lds_raw[];
    LAS unsigned char* lds = (LAS unsigned char*)lds_raw;
    volatile LAS unsigned* MISC = (volatile LAS unsigned*)(lds + MISC_OFF);
    for (int u = threadIdx.x; u < (LDS_BYTES - MISC_OFF) / 4; u += 512) ((LAS unsigned*)(lds + MISC_OFF))[u] = 0u;
    __syncthreads();
    gu32* ctl = (gu32*)(args.ws + WS_CTL);
    XcdBarrier bar; bar.bar = (unsigned*)(ctl + CW_BAR); bar.x = 0; bar.st = nullptr;
    const int lo = args.ph_lo, hi = args.ph_hi;
    if (hi - lo > 1) bar = xcd_barrier_post((unsigned*)(ctl + CW_BAR), MISC + 8);
#if DUP_BAR
#define RUN(k) if (lo <= (k) && (k) < hi) { run_phase<(k)>(args, lds); if ((k) + 1 < hi) { xcd_barrier(bar); xcd_barrier(bar); } }
#else
#define RUN(k) if (lo <= (k) && (k) < hi) { run_phase<(k)>(args, lds); if ((k) + 1 < hi) xcd_barrier(bar); }
#endif
    RUN(0) RUN(1) RUN(2) RUN(3) RUN(4) RUN(5) RUN(6) RUN(7) RUN(8) RUN(9) RUN(10) RUN(11) RUN(12) RUN(13) RUN(14) RUN(15) RUN(16) RUN(17)
#undef RUN
}

extern "C" void kernel_launch(void* const* d_in, const int* in_sizes, int n_in, void* d_out, int out_size, void* d_ws, size_t ws_size, hipStream_t stream) {
    static int grid = 0;
    if (grid == 0) {
        if (n_in != 11 || in_sizes[0] != MROWS * DM || out_size != MROWS * DM || ws_size < WS_END) { fprintf(stderr, "kernel_launch: unexpected shapes (n_in %d, ws %zu); nothing launched\n", n_in, ws_size); grid = -1; return; }
        int dev = 0, cus = 0, per_cu = 0;
        if (hipGetDevice(&dev) != hipSuccess || hipDeviceGetAttribute(&cus, hipDeviceAttributeMultiprocessorCount, dev) != hipSuccess) { grid = -1; return; }
        if (hipFuncSetAttribute((const void*)mk_fwd, hipFuncAttributeMaxDynamicSharedMemorySize, LDS_BYTES) != hipSuccess) { fprintf(stderr, "kernel_launch: hipFuncSetAttribute failed\n"); grid = -1; return; }
        if (hipOccupancyMaxActiveBlocksPerMultiprocessor(&per_cu, (const void*)mk_fwd, 512, LDS_BYTES) != hipSuccess || per_cu < 1) { fprintf(stderr, "kernel_launch: occupancy query says %d blocks per CU; nothing launched\n", per_cu); (void)hipGetLastError(); grid = -1; return; }
        grid = cus;
    }
    if (grid < 0) return;
    (void)hipMemsetAsync((char*)d_ws + WS_CTL, 0, CTL_ZERO_BYTES, stream);
    Args a{};
    for (int i = 0; i < 11; ++i) a.in[i] = (const float*)d_in[i];
    a.out = (float*)d_out; a.ws = (unsigned char*)d_ws;
    a.ph_lo = 0; a.ph_hi = NPHASE; hipLaunchKernelGGL(mk_fwd, dim3(grid), dim3(512), LDS_BYTES, stream, a);
}
```

```cpp
#include <hip/hip_runtime.h>
#include <cstdio>
#include <cstdint>
#include <cmath>
namespace pg8 {
#define PG8_LAS __attribute__((address_space(3)))
typedef unsigned short bf16_t;
typedef short bf16x8 __attribute__((ext_vector_type(8)));
typedef float f32x4 __attribute__((ext_vector_type(4)));
typedef unsigned u32x4 __attribute__((ext_vector_type(4)));
constexpr int BM = 256, BK = 64, HALF = 128, HTB = HALF * BK * 2  , STAGE_BYTES = 8 * HTB, NXCD = 8, WGM = 8;

__host__ __device__ __forceinline__ int lds_byte(int r, int c) { const int st = (r >> 4) * 2 + (c >> 5), rr = r & 15, cc = c & 31, ob = rr * 64 + cc * 2; return st * 1024 + (ob ^ (((ob >> 9) & 1) << 5)); }
__host__ __device__ __forceinline__ void stage_rc(int b, int& R, int& C) { const int st = b / 1024, sb = b % 1024, swz = sb ^ (((sb >> 9) & 1) << 5); R = (st >> 1) * 16 + swz / 64; C = (st & 1) * 32 + (swz % 64) / 2; }
__host__ __device__ __forceinline__ int perm32(int rho) { const int n = rho >> 4, i = rho & 15; return 8 * (i >> 2) + 4 * n + (i & 3); }

struct Unit { int pm, pn; };
struct Gemm { const bf16_t* A; const bf16_t* Bt; int M, N, K; };

struct StaticOrder {
    int nM, nN, nwg, G, c;
    __host__ __device__ void init(int M, int N, int G_, int c_) { nM = M / BM; nN = N / BM; nwg = nM * nN; G = G_; c = c_; }
    __host__ __device__ bool next(int i, Unit& u) const {
        const long L = (long)i * G + c; if (L >= nwg) return false;
        int wgid = (int)L; { const int q = nwg / NXCD, r = nwg % NXCD, xcd = wgid % NXCD, off = wgid / NXCD; wgid = (xcd < r ? xcd * (q + 1) : r * (q + 1) + (xcd - r) * q) + off; }
        const int nig = WGM * nN, gid = wgid / nig, fm = gid * WGM, gsz = (nM - fm) < WGM ? (nM - fm) : WGM;
        u.pm = fm + ((wgid % nig) % gsz); u.pn = (wgid % nig) / gsz; return true;
    }
    __device__ __forceinline__ void a_ready(const Unit&) const {}
    __device__ __forceinline__ void done(const Unit&) const {}
};

__device__ __forceinline__ unsigned cvt_pk_bf16(float lo, float hi) { unsigned r; asm volatile("v_cvt_pk_bf16_f32 %0, %1, %2" : "=v"(r) : "v"(lo), "v"(hi)); return r; }
typedef float f32x2 __attribute__((ext_vector_type(2)));

template <class Epi, class Sched, bool ALIGN_EPI = false, bool SP2 = false>
__device__ __forceinline__ void gemm_phase(PG8_LAS unsigned char* lds, const Gemm g, const Sched& S, const Epi& E) {
    const int tid = threadIdx.x, wid = __builtin_amdgcn_readfirstlane(tid >> 6), lane = tid & 63, wr = wid >> 2, wc = wid & 3, fr = lane & 15, fq = lane >> 4;
    const int K = g.K, nt = K / BK;
    unsigned voffA[2], voffB[2];
#pragma unroll
    for (int i = 0; i < 2; ++i) { int R, C; stage_rc(tid * 16 + i * 8192, R, C); const int Rb = Epi::PERM ? ((R & ~31) + perm32(R & 31)) : R;
        voffA[i] = (unsigned)(R * K + C) * 2u; voffB[i] = (unsigned)(Rb * K + C) * 2u; }
    const size_t kstep = (size_t)(BK * 2);
    const size_t hstep = (size_t)HALF * K * 2;
    const size_t tstep = 2 * hstep;
    const unsigned ldsw = (unsigned)wid * 1024u;
    const int aoff = lds_byte(wr * 64 + fr, fq * 8), boff = lds_byte(wc * 32 + fr, fq * 8);
#define PG8_SA(b, h) (((b) * 2 + (h)) * HTB)
#define PG8_SB(b, h) ((4 + (b) * 2 + (h)) * HTB)
#define PG8_STAGE(bufoff, gbase, voff) do { _Pragma("unroll") for (int _i = 0; _i < 2; ++_i) \
        __builtin_amdgcn_global_load_lds((const unsigned*)((const char*)(gbase) + (voff)[_i]), (PG8_LAS unsigned*)(lds + (bufoff) + ldsw + _i * 8192), 16, 0, 0); } while (0)
#define PG8_LDA(dst, b, h) do { _Pragma("unroll") for (int m = 0; m < 4; ++m) _Pragma("unroll") for (int k = 0; k < 2; ++k) dst[m][k] = *(const PG8_LAS bf16x8*)(lds + PG8_SA(b, h) + aoff + m * 2048 + k * 1024); } while (0)
#define PG8_LDB(dst, b, h) do { _Pragma("unroll") for (int n = 0; n < 2; ++n) _Pragma("unroll") for (int k = 0; k < 2; ++k) dst[n][k] = *(const PG8_LAS bf16x8*)(lds + PG8_SB(b, h) + boff + n * 2048 + k * 1024); } while (0)
#define PG8_MMA(ai, bj, At, Bt) do { __builtin_amdgcn_s_setprio(1); _Pragma("unroll") for (int m = 0; m < 4; ++m) _Pragma("unroll") for (int n = 0; n < 2; ++n) _Pragma("unroll") for (int k = 0; k < 2; ++k) \
        acc[ai][bj][m][n] = __builtin_amdgcn_mfma_f32_16x16x32_bf16(Bt[n][k], At[m][k], acc[ai][bj][m][n], 0, 0, 0); __builtin_amdgcn_s_setprio(0); } while (0)
#define PG8_WAIT_V(n) asm volatile("s_waitcnt vmcnt(" #n ")" ::: "memory")
#define PG8_WAIT_L(n) asm volatile("s_waitcnt lgkmcnt(" #n ")" ::: "memory")
#define PG8_BAR __builtin_amdgcn_s_barrier()
#define PG8_SCHED __builtin_amdgcn_sched_barrier(0)
    Unit cur, nxt; int ui = 0;
    if (!S.next(0, cur)) return;
    f32x4 acc[2][2][4][2];
#pragma unroll
    for (int a = 0; a < 2; ++a)
#pragma unroll
        for (int b = 0; b < 2; ++b)
#pragma unroll
            for (int m = 0; m < 4; ++m)
#pragma unroll
                for (int n = 0; n < 2; ++n) acc[a][b][m][n] = (f32x4){0.f, 0.f, 0.f, 0.f};
    bf16x8 At[4][2], B0[2][2], B1[2][2];
    const char* cA = (const char*)g.A + (size_t)cur.pm * tstep; const char* cB = (const char*)g.Bt + (size_t)cur.pn * tstep;
    S.a_ready(cur);
    if constexpr (SP2) {
        PG8_STAGE(PG8_SB(0, 0), cB, voffB); PG8_STAGE(PG8_SB(0, 1), cB + hstep, voffB); PG8_STAGE(PG8_SA(0, 0), cA, voffA); PG8_STAGE(PG8_SA(0, 1), cA + hstep, voffA);
        E.begin(lds, S, tid);
        if (wr == 1) PG8_BAR;
        PG8_WAIT_V(2); PG8_BAR;
        PG8_STAGE(PG8_SB(1, 0), cB + kstep, voffB); PG8_STAGE(PG8_SA(1, 0), cA + kstep, voffA); PG8_STAGE(PG8_SB(1, 1), cB + hstep + kstep, voffB);
        PG8_WAIT_V(6); PG8_BAR;
    } else {
        PG8_STAGE(PG8_SB(0, 0), cB, voffB); PG8_STAGE(PG8_SA(0, 0), cA, voffA); PG8_STAGE(PG8_SB(0, 1), cB + hstep, voffB); PG8_STAGE(PG8_SA(0, 1), cA + hstep, voffA);
        E.begin(lds, S, tid);
        if (wr == 1) PG8_BAR;
        PG8_WAIT_V(4); PG8_BAR;
        PG8_STAGE(PG8_SB(1, 0), cB + kstep, voffB); PG8_STAGE(PG8_SA(1, 0), cA + kstep, voffA); PG8_STAGE(PG8_SB(1, 1), cB + hstep + kstep, voffB);
        PG8_WAIT_V(6); PG8_BAR;
    }
    for (;;) {
        const bool has_next = S.next(ui + 1, nxt);
        const char* nA = has_next ? (const char*)g.A + (size_t)nxt.pm * tstep : cA; const char* nB = has_next ? (const char*)g.Bt + (size_t)nxt.pn * tstep : cB;
        for (int t = 0; t < nt; t += 2) {
            const bool last = (t == nt - 2);
            const char* a1 = cA + (size_t)(t + 1) * kstep;
            const char* a2 = last ? nA : cA + (size_t)(t + 2) * kstep; const char* b2 = last ? nB : cB + (size_t)(t + 2) * kstep;
            const char* a3 = a2 + kstep; const char* b3 = b2 + kstep;
            if (last && has_next) S.a_ready(nxt);
            if constexpr (SP2) {
            PG8_LDB(B0, 0, 0); PG8_LDB(B1, 0, 1); PG8_SCHED; PG8_LDA(At, 0, 0); PG8_STAGE(PG8_SA(1, 1), a1 + hstep, voffA);
            PG8_WAIT_V(8); PG8_WAIT_L(0); PG8_BAR; PG8_MMA(0, 0, At, B0); PG8_MMA(0, 1, At, B1); PG8_BAR; PG8_SCHED;
            PG8_LDA(At, 0, 1); PG8_STAGE(PG8_SB(0, 0), b2, voffB); PG8_STAGE(PG8_SB(0, 1), b2 + hstep, voffB); PG8_STAGE(PG8_SA(0, 0), a2, voffA);
            PG8_WAIT_V(8); PG8_WAIT_L(0); PG8_BAR; PG8_MMA(1, 0, At, B0); PG8_MMA(1, 1, At, B1); PG8_BAR; PG8_SCHED;
            PG8_LDB(B0, 1, 0); PG8_LDB(B1, 1, 1); PG8_SCHED; PG8_LDA(At, 1, 0); PG8_STAGE(PG8_SA(0, 1), a2 + hstep, voffA);
            PG8_WAIT_V(8); PG8_WAIT_L(0); PG8_BAR; PG8_MMA(0, 0, At, B0); PG8_MMA(0, 1, At, B1); PG8_BAR; PG8_SCHED;
            PG8_LDA(At, 1, 1); PG8_STAGE(PG8_SB(1, 0), b3, voffB); PG8_STAGE(PG8_SB(1, 1), b3 + hstep, voffB); PG8_STAGE(PG8_SA(1, 0), a3, voffA);
            PG8_WAIT_V(8); PG8_WAIT_L(0); PG8_BAR; PG8_MMA(1, 0, At, B0); PG8_MMA(1, 1, At, B1); PG8_BAR; PG8_SCHED;
            } else {
            PG8_LDB(B0, 0, 0); PG8_SCHED; PG8_LDA(At, 0, 0); PG8_STAGE(PG8_SA(1, 1), a1 + hstep, voffA);
            PG8_WAIT_L(8); PG8_BAR; PG8_WAIT_L(0); PG8_MMA(0, 0, At, B0); PG8_BAR; PG8_SCHED;
            PG8_LDB(B1, 0, 1); PG8_STAGE(PG8_SB(0, 0), b2, voffB);
            PG8_BAR; PG8_WAIT_L(0); PG8_MMA(0, 1, At, B1); PG8_BAR;
            PG8_LDA(At, 0, 1); PG8_STAGE(PG8_SA(0, 0), a2, voffA);
            PG8_BAR; PG8_WAIT_L(0); PG8_MMA(1, 0, At, B0); PG8_BAR; PG8_SCHED;
            PG8_STAGE(PG8_SB(0, 1), b2 + hstep, voffB);
            PG8_WAIT_V(6); PG8_BAR; PG8_MMA(1, 1, At, B1); PG8_BAR;
            PG8_LDB(B0, 1, 0); PG8_SCHED; PG8_LDA(At, 1, 0); PG8_STAGE(PG8_SA(0, 1), a2 + hstep, voffA);
            PG8_WAIT_L(8); PG8_BAR; PG8_WAIT_L(0); PG8_MMA(0, 0, At, B0); PG8_BAR; PG8_SCHED;
            PG8_LDB(B1, 1, 1); PG8_STAGE(PG8_SB(1, 0), b3, voffB);
            PG8_BAR; PG8_WAIT_L(0); PG8_MMA(0, 1, At, B1); PG8_BAR;
            PG8_LDA(At, 1, 1); PG8_STAGE(PG8_SA(1, 0), a3, voffA);
            PG8_BAR; PG8_WAIT_L(0); PG8_MMA(1, 0, At, B0); PG8_BAR; PG8_SCHED;
            PG8_STAGE(PG8_SB(1, 1), b3 + hstep, voffB);
            PG8_WAIT_V(6); PG8_BAR; PG8_MMA(1, 1, At, B1); PG8_BAR;
            }
        }
        if constexpr (ALIGN_EPI) { if (wr == 0) PG8_BAR; }
        if constexpr (!Epi::AFTER_DRAIN) { E(acc, cur, wr, wc, fr, fq, ui); if constexpr (Epi::DUP) { asm volatile("" ::: "memory"); if (E.scratch) { Epi E2 = E; E2.set_probe(); E2(acc, cur, wr, wc, fr, fq, ui); } } S.done(cur); }
        if (!has_next) break;
#pragma unroll
        for (int a = 0; a < 2; ++a)
#pragma unroll
            for (int b = 0; b < 2; ++b)
#pragma unroll
                for (int m = 0; m < 4; ++m)
#pragma unroll
                    for (int n = 0; n < 2; ++n) acc[a][b][m][n] = (f32x4){0.f, 0.f, 0.f, 0.f};
        cur = nxt; cA = nA; cB = nB; ++ui;
        if constexpr (ALIGN_EPI) { if (wr == 1) PG8_BAR; }
    }
    PG8_WAIT_V(0);
    if constexpr (!ALIGN_EPI) { if (wr == 0) PG8_BAR; }
    PG8_BAR;
    if constexpr (Epi::AFTER_DRAIN) { E.fused(acc, cur, wr, wc, fr, fq, lds, wid, lane); S.done(cur); }
#undef PG8_SA
#undef PG8_SB
#undef PG8_STAGE
#undef PG8_LDA
#undef PG8_LDB
#undef PG8_MMA
#undef PG8_WAIT_V
#undef PG8_WAIT_L
#undef PG8_BAR
#undef PG8_SCHED
}
}

constexpr int BATCH = 4, SEQ = 4096, DM = 1024, MROWS = BATCH * SEQ;
constexpr int CE = 2048, CN = 4 * CE;
constexpr int NH = 16, HD = 64, NG = 3, QKVC = 9216, AN = 10240;
constexpr float EPS = 1e-6f, LOG2E = 1.4426950408889634f, QSCALE = 0.125f * LOG2E;
constexpr int NPHASE = 17;

constexpr size_t MiB = 1u << 20;
constexpr size_t WS_CTL = 0, CTL_ZERO_BYTES = 32768;
constexpr size_t WS_SSQ = 1 * MiB;
constexpr size_t WS_W1 = 2 * MiB, WS_W2 = 18 * MiB, WS_W3 = 22 * MiB, WS_W4 = 42 * MiB;
constexpr size_t WS_LSE = 44 * MiB;
constexpr size_t WS_BIAS = 47 * MiB;
constexpr size_t WS_XB = 48 * MiB;
constexpr size_t WS_QO = 80 * MiB;
constexpr size_t WS_CG = 112 * MiB;
constexpr size_t WS_KA = 176 * MiB, WS_VA = 208 * MiB, WS_KB = 240 * MiB, WS_VB = 272 * MiB;
constexpr size_t WS_Y = WS_KA;
constexpr size_t WS_SIDE = 304 * MiB;
constexpr size_t WS_END = 307 * MiB;
constexpr int CW_TMO = 0, CW_BAR = 4096;

#define GAS __attribute__((address_space(1)))
#define LAS __attribute__((address_space(3)))
typedef unsigned short bf16;
typedef unsigned v4u __attribute__((ext_vector_type(4)));
typedef unsigned v2u __attribute__((ext_vector_type(2)));
typedef float f32x4 __attribute__((ext_vector_type(4)));
typedef short bf16x8 __attribute__((ext_vector_type(8)));
typedef GAS unsigned gu32;
#define RLX_AGENT __ATOMIC_RELAXED, __HIP_MEMORY_SCOPE_AGENT
#define LDS_WAIT() asm volatile("s_waitcnt lgkmcnt(0)" ::: "memory")
#define VM_WAIT() asm volatile("s_waitcnt vmcnt(0)" ::: "memory")
__device__ __forceinline__ unsigned f2bf(float f) { unsigned u = __builtin_bit_cast(unsigned, f); return (u + 0x7fffu + ((u >> 16) & 1u)) >> 16; }
typedef float f32x2_t __attribute__((ext_vector_type(2))); typedef __bf16 bf16x2_t __attribute__((ext_vector_type(2)));
__device__ __forceinline__ unsigned pk2(float lo, float hi) { f32x2_t v = {lo, hi}; bf16x2_t b = __builtin_convertvector(v, bf16x2_t); return __builtin_bit_cast(unsigned, b); }
#ifndef ST_WT
#define ST_WT 0
#endif
#ifndef ST_NT
#define ST_NT 0
#endif
__device__ __forceinline__ void st16(void* p, v4u v) {
#if ST_WT
    asm volatile("global_store_dwordx4 %0, %1, off sc1\n\ts_nop 1" :: "v"(p), "v"(v) : "memory");
#elif ST_NT
    __builtin_nontemporal_store(v, (v4u*)p);
#else
    *(v4u*)p = v;
#endif
}
__device__ __forceinline__ size_t hm_row(int row  , int h, int sh) {
    const int b = row >> 12, t = row & 4095, p = ((t & ((1 << sh) - 1)) << (12 - sh)) | (t >> sh);
    return ((size_t)((b * 16 + h) * 4096 + p)) * 64;
}
__device__ __forceinline__ float bf2f(unsigned h) { return __builtin_bit_cast(float, h << 16); }
__device__ __forceinline__ float bflo(unsigned w) { return __builtin_bit_cast(float, w << 16); }
__device__ __forceinline__ float bfhi(unsigned w) { return __builtin_bit_cast(float, w & 0xffff0000u); }
__device__ __forceinline__ float sigmoidf_(float z) { return __builtin_amdgcn_rcpf(1.0f + __builtin_amdgcn_exp2f(-z * LOG2E)); }
__device__ __forceinline__ float row_rs(const float* ssq, int row) {
    const f32x4* p = (const f32x4*)(ssq + (size_t)row * 16);
    const f32x4 s = (p[0] + p[1]) + (p[2] + p[3]);
    return 1.0f / sqrtf(((s.x + s.y) + (s.z + s.w)) * (1.0f / DM) + EPS);
}
__device__ __forceinline__ float wave_sum(float v) {
#pragma unroll
    for (int o = 1; o < 64; o <<= 1) v += __shfl_xor(v, o);
    return v;
}
__device__ __forceinline__ int t5_bucket(int d) {
    if (d < 16) return d;
    int b = 15;
    b += (d >= 16); b += (d >= 22); b += (d >= 30); b += (d >= 40); b += (d >= 54); b += (d >= 73); b += (d >= 99); b += (d >= 134);
    b += (d >= 182); b += (d >= 246); b += (d >= 332); b += (d >= 450); b += (d >= 609); b += (d >= 825); b += (d >= 1117); b += (d >= 1513);
    return b;
}

#define XB_TMO      128
#define XB_XCNT(j)  (256  + 64 * (j))
#define XB_XSUB(j)  (1280 + 64 * (j))
#define XB_XGEN(j)  (2304 + 64 * (j))
#define XB_TOP      3328
#define XB_TOPGEN   3392
#define XCD_BAR_WORDS 3456
#define XB_SPIN_CAP (1u << 18)
#ifndef XB_SLEEP
#define XB_SLEEP 0
#endif

__device__ __forceinline__ unsigned xb_ld(unsigned* p)              { return __hip_atomic_load(p, __ATOMIC_RELAXED, __HIP_MEMORY_SCOPE_AGENT); }
__device__ __forceinline__ unsigned xb_add(unsigned* p, unsigned v) { return __hip_atomic_fetch_add(p, v, __ATOMIC_RELAXED, __HIP_MEMORY_SCOPE_AGENT); }
__device__ __forceinline__ unsigned xb_xcc_id() { return (unsigned)__builtin_amdgcn_s_getreg((3 << 11) | 20) & 0xFu; }
#define XB_SPIN(cond, bar) do { unsigned _sp = 0; while (cond) { __builtin_amdgcn_s_sleep(XB_SLEEP); \
    if ((++_sp & 255u) == 0u) { if (xb_ld(&(bar)[XB_TMO])) break; if (_sp > XB_SPIN_CAP) { atomicAdd(&(bar)[XB_TMO], 1u); break; } } } } while (0)

struct XcdBarrier {
    unsigned* bar; unsigned x;
    volatile LAS unsigned* st;
};

__device__ __forceinline__ XcdBarrier xcd_barrier_post(unsigned* bar, volatile LAS unsigned* st) {
    XcdBarrier b; b.bar = bar; b.x = xb_xcc_id(); b.st = st;
    if (threadIdx.x == 0) (void)xb_add(&bar[XB_XCNT(b.x)], 1u);
    return b;
}
__device__ __forceinline__ void xcd_barrier_complete(unsigned* bar, unsigned x, unsigned& nloc, unsigned& nx) {
    const unsigned G = gridDim.x * gridDim.y * gridDim.z;
    unsigned sum, cnt, mine, sp = 0u;
    for (;;) {
        sum = 0u; cnt = 0u; mine = 0u;
#pragma unroll
        for (unsigned j = 0; j < 16; ++j) { const unsigned c = xb_ld(&bar[XB_XCNT(j)]); sum += c; cnt += (c > 0u) ? 1u : 0u; mine = (j == x) ? c : mine; }
        if (sum == G) break;
        __builtin_amdgcn_s_sleep(1);
        if ((++sp & 255u) == 0u) { if (xb_ld(&bar[XB_TMO])) break; if (sp > XB_SPIN_CAP) { atomicAdd(&bar[XB_TMO], 1u); break; } }
    }
    nloc = mine > 0u ? mine : 1u; nx = cnt > 0u ? cnt : 1u;
}

__device__ __forceinline__ void xcd_barrier(const XcdBarrier& b) {
    asm volatile("s_waitcnt vmcnt(0)" ::: "memory");
    __syncthreads();
    if (threadIdx.x == 0) {
        unsigned* bar = b.bar;
        __builtin_amdgcn_s_waitcnt(0);
        unsigned nloc = b.st[0], nx = b.st[1];
        if (nloc == 0u) { xcd_barrier_complete(bar, b.x, nloc, nx); b.st[0] = nloc; b.st[1] = nx; }
        const unsigned old = xb_add(&bar[XB_XSUB(b.x)], 1u);
        const unsigned gen = old / nloc;
        if (old + 1u == (gen + 1u) * nloc) {
            __builtin_amdgcn_fence(__ATOMIC_RELEASE, "agent");
            asm volatile("s_waitcnt vmcnt(0)" ::: "memory");
            const unsigned og = xb_add(&bar[XB_TOP], 1u);
            const unsigned tg = og / nx;
            if (og + 1u == (tg + 1u) * nx) xb_add(&bar[XB_TOPGEN], 1u);
            else XB_SPIN(xb_ld(&bar[XB_TOPGEN]) == tg, bar);
            __builtin_amdgcn_fence(__ATOMIC_ACQUIRE, "agent");
            xb_add(&bar[XB_XGEN(b.x)], 1u);
            asm volatile("s_waitcnt vmcnt(0)" ::: "memory");
        } else {
            XB_SPIN(xb_ld(&bar[XB_XGEN(b.x)]) == gen, bar);
            __builtin_amdgcn_fence(__ATOMIC_ACQUIRE, "agent");
            asm volatile("s_waitcnt vmcnt(0)" ::: "memory");
        }
    }
    __syncthreads();
}

#ifndef EP_NT
#define EP_NT 0
#endif
#if EP_NT
#define EP_LD(p) __builtin_nontemporal_load(p)
#else
#define EP_LD(p) (*(p))
#endif
#ifndef DUP_EPI
#define DUP_EPI 0
#endif
namespace epi {
using pg8::Unit; using pg8::bf16_t;

__device__ __forceinline__ void rows_rs(const float* ssq, int row0  , int fq, float (&rs)[2][4]) {
    f32x4 pp[2][4];
#pragma unroll
    for (int ai = 0; ai < 2; ++ai)
#pragma unroll
        for (int m = 0; m < 4; ++m) pp[ai][m] = *(const f32x4*)(ssq + (size_t)(row0 + ai * 128 + m * 16) * 16 + 4 * fq);
#pragma unroll
    for (int ai = 0; ai < 2; ++ai)
#pragma unroll
        for (int m = 0; m < 4; ++m) { float t = (pp[ai][m][0] + pp[ai][m][1]) + (pp[ai][m][2] + pp[ai][m][3]); t += __shfl_xor(t, 16); t += __shfl_xor(t, 32); rs[ai][m] = __builtin_amdgcn_rsqf(t * (1.0f / DM) + EPS); }
}
struct ConvIn {
    static constexpr bool PERM = false, AFTER_DRAIN = false, DUP = (DUP_EPI != 0);
    const float* ssq; bf16_t* V; bf16_t* G;
    template <class Sched> __device__ __forceinline__ void begin(LAS unsigned char*, const Sched&, int) const {}
    __device__ __forceinline__ void operator()(const f32x4 (&acc)[2][2][4][2], const Unit& u, int wr, int wc, int fr, int fq, int) const {
        const int ch0 = u.pn * 64 + wc * 16 + 4 * fq;
        float rsv[2][4]; rows_rs(ssq, u.pm * 256 + wr * 64 + fr, fq, rsv);
#pragma unroll
        for (int ai = 0; ai < 2; ++ai)
#pragma unroll
            for (int m = 0; m < 4; ++m) {
                const int row = u.pm * 256 + ai * 128 + wr * 64 + m * 16 + fr;
                const float rs = rsv[ai][m];
                const f32x4 b = acc[ai][0][m][0] * rs, c = acc[ai][0][m][1] * rs, uu = acc[ai][1][m][0] * rs, z = acc[ai][1][m][1] * rs;
                const f32x4 v = c * uu;
                f32x4 g;
#pragma unroll
                for (int i = 0; i < 4; ++i) g[i] = b[i] * z[i] * sigmoidf_(z[i]);
                v2u wv, wg; wv.x = pk2(v[0], v[1]); wv.y = pk2(v[2], v[3]); wg.x = pk2(g[0], g[1]); wg.y = pk2(g[2], g[3]);
                *(v2u*)(V + (size_t)row * CE + ch0) = wv;
                *(v2u*)(G + (size_t)row * CE + ch0) = wg;
            }
    }
};


constexpr int RSTAB_OFF = 152832, GTAB_OFF = 161024;
template <class Sched> __device__ __forceinline__ void fill_rstab(LAS unsigned char* lds, const float* ssq, const Sched& S, int tid) {
    LAS float* tab = (LAS float*)(lds + RSTAB_OFF);
    Unit u;
    for (int i = tid >> 8; i < 8 && S.next(i, u); i += 2) {
        const f32x4* p = (const f32x4*)(ssq + (size_t)(u.pm * 256 + (tid & 255)) * 16);
        const f32x4 s = (p[0] + p[1]) + (p[2] + p[3]);
        tab[i * 256 + (tid & 255)] = __builtin_amdgcn_rsqf(((s[0] + s[1]) + (s[2] + s[3])) * (1.0f / DM) + EPS);
    }
}
__device__ __forceinline__ void tab_rs(LAS unsigned char* lds, int ui, int wr, int fr, float (&rs)[2][4]) {
    const LAS float* tab = (const LAS float*)(lds + RSTAB_OFF) + ui * 256 + wr * 64 + fr;
#pragma unroll
    for (int ai = 0; ai < 2; ++ai)
#pragma unroll
        for (int m = 0; m < 4; ++m) rs[ai][m] = tab[ai * 128 + m * 16];
}
struct ConvFused {
    static constexpr bool PERM = false, AFTER_DRAIN = false, DUP = false;
    const float* ssq; bf16_t* Y; const float* cw; float* side; LAS unsigned char* xch;
    static __device__ __forceinline__ f32x4 unpk(v2u p) { return (f32x4){bflo(p.x), bfhi(p.x), bflo(p.y), bfhi(p.y)}; }
    template <class Sched> __device__ __forceinline__ void begin(LAS unsigned char* lds, const Sched& S, int tid) const { fill_rstab(lds, ssq, S, tid); }
    __device__ __forceinline__ void operator()(const f32x4 (&acc)[2][2][4][2], const Unit& u, int wr, int wc, int fr, int fq, int ui) const {
        const int ch0 = u.pn * 64 + wc * 16 + 4 * fq;
        float rsv[2][4]; tab_rs(xch - 131072, ui, wr, fr, rsv);
        const f32x4 w0 = *(const f32x4*)(cw + ch0), w1 = *(const f32x4*)(cw + CE + ch0), w2 = *(const f32x4*)(cw + 2 * CE + ch0);
        v2u vq[2][4]; f32x4 gt[2][4];
#pragma unroll
        for (int ai = 0; ai < 2; ++ai)
#pragma unroll
            for (int m = 0; m < 4; ++m) {
                const float rs = rsv[ai][m];
                const f32x4 b = acc[ai][0][m][0] * rs, c = acc[ai][0][m][1] * rs, uu = acc[ai][1][m][0] * rs, z = acc[ai][1][m][1] * rs;
                const f32x4 v = c * uu;
                vq[ai][m].x = pk2(v[0], v[1]); vq[ai][m].y = pk2(v[2], v[3]);
#pragma unroll
                for (int i = 0; i < 4; ++i) gt[ai][m][i] = b[i] * z[i] * sigmoidf_(z[i]);
            }
        LAS unsigned char* my = xch + (wr * 4 + wc) * 2720 + fq * 8;
        LAS unsigned char* other = xch + ((1 - wr) * 4 + wc) * 2720 + fq * 8;
        const bool seq_start = (u.pm & 15) == 0;
        if (fr >= 14) {
            const int hr = fr - 14;
            *(LAS v2u*)(other + ((wr == 0 ? 0 : 66) + hr) * 40) = vq[0][3];
            if (wr == 0) *(LAS v2u*)(other + (66 + hr) * 40) = vq[1][3];
            else *(f32x4*)(side + ((size_t)u.pm * 6 + 4 + hr) * CE + ch0) = unpk(vq[1][3]);
        }
        if (wr == 0 && fr < 2) *(LAS v2u*)(my + fr * 40) = (v2u){0u, 0u};
#pragma unroll
        for (int m = 0; m < 4; ++m) *(LAS v2u*)(my + (2 + 16 * m + fr) * 40) = vq[0][m];
        asm volatile("s_waitcnt lgkmcnt(0)\n\ts_barrier" ::: "memory");
        v2u q1[2][4], q2[2][4];
#pragma unroll
        for (int m = 0; m < 4; ++m) { const int k = 16 * m + fr; q1[0][m] = *(const LAS v2u*)(my + (k + 1) * 40); q2[0][m] = *(const LAS v2u*)(my + k * 40); }
        asm volatile("" ::: "memory");
#pragma unroll
        for (int m = 0; m < 4; ++m) *(LAS v2u*)(my + (2 + 16 * m + fr) * 40) = vq[1][m];
        asm volatile("s_waitcnt lgkmcnt(0)" ::: "memory");
#pragma unroll
        for (int m = 0; m < 4; ++m) { const int k = 16 * m + fr; int r1 = k + 1, r2 = k; if (k < 1) r1 = 67; if (k < 2) r2 = 66 + k;
            q1[1][m] = *(const LAS v2u*)(my + r1 * 40); q2[1][m] = *(const LAS v2u*)(my + r2 * 40); }
#pragma unroll
        for (int ai = 0; ai < 2; ++ai)
#pragma unroll
            for (int m = 0; m < 4; ++m) {
                const int k = 16 * m + fr;
                const f32x4 p1 = unpk(q1[ai][m]), p2 = unpk(q2[ai][m]), v = unpk(vq[ai][m]);
                const f32x4 cv = w2 * v + w1 * p1 + w0 * p2;
                const f32x4 y = gt[ai][m] * cv;
                const int row = u.pm * 256 + ai * 128 + wr * 64 + k;
                v2u wy; wy.x = pk2(y[0], y[1]); wy.y = pk2(y[2], y[3]);
                *(v2u*)(Y + (size_t)row * CE + ch0) = wy;
                if (ai == 0 && m == 0 && wr == 0 && fr < 2 && !seq_start) {
                    *(f32x4*)(side + ((size_t)u.pm * 6 + fr) * CE + ch0) = gt[0][0];
                    *(f32x4*)(side + ((size_t)u.pm * 6 + 2 + fr) * CE + ch0) = cv;
                }
            }
    }
};
struct Resid {
    static constexpr bool PERM = false, AFTER_DRAIN = false, DUP = false;
    const float* xin; float* xout; bf16_t* xb; float* ssq;
    template <class Sched> __device__ __forceinline__ void begin(LAS unsigned char*, const Sched&, int) const {}
    __device__ __forceinline__ void operator()(const f32x4 (&acc)[2][2][4][2], const Unit& u, int wr, int wc, int fr, int fq, int) const {
        const int col0 = u.pn * 256 + wc * 32 + 4 * fq;
        const size_t off0 = (size_t)(u.pm * 256 + wr * 64 + fr) * DM + col0;
        f32x4 pre[4][2][2];
#pragma unroll
        for (int i = 0; i < 4; ++i)
#pragma unroll
            for (int bj = 0; bj < 2; ++bj)
#pragma unroll
                for (int n = 0; n < 2; ++n) pre[i][bj][n] = *(const f32x4*)(xin + off0 + (size_t)(16 * i) * DM + bj * 128 + n * 16);
#pragma unroll
        for (int i = 0; i < 8; ++i) {
            const int ai = i >> 2, m = i & 3;
            const size_t off = off0 + (size_t)(ai * 128 + m * 16) * DM;
            float ss = 0.f; f32x4 xn[2][2];
#pragma unroll
            for (int bj = 0; bj < 2; ++bj)
#pragma unroll
                for (int n = 0; n < 2; ++n) { xn[bj][n] = pre[i & 3][bj][n] + acc[ai][bj][m][n]; const f32x4 t = xn[bj][n]; ss += (t[0] * t[0] + t[1] * t[1]) + (t[2] * t[2] + t[3] * t[3]); }
            if (i < 4) {
#pragma unroll
                for (int bj = 0; bj < 2; ++bj)
#pragma unroll
                    for (int n = 0; n < 2; ++n) pre[i & 3][bj][n] = *(const f32x4*)(xin + off + (size_t)128 * DM + bj * 128 + n * 16);
            }
#pragma unroll
            for (int bj = 0; bj < 2; ++bj)
#pragma unroll
                for (int n = 0; n < 2; ++n) {
                    *(f32x4*)(xout + off + bj * 128 + n * 16) = xn[bj][n];
                    v2u w; w.x = pk2(xn[bj][n][0], xn[bj][n][1]); w.y = pk2(xn[bj][n][2], xn[bj][n][3]);
                    *(v2u*)(xb + off + bj * 128 + n * 16) = w;
                }
            ss += __shfl_xor(ss, 16); ss += __shfl_xor(ss, 32);
            if (fq == 0) ssq[(size_t)(u.pm * 256 + ai * 128 + wr * 64 + m * 16 + fr) * 16 + u.pn * 4 + wc] = ss;
        }
    }
};
template <int MODE> struct ResidB {
    static constexpr bool PERM = false, AFTER_DRAIN = false, DUP = false;
    const float* xin; float* xout; bf16_t* xb; float* ssq; bf16_t* xbw;
    template <class Sched> __device__ __forceinline__ void begin(LAS unsigned char*, const Sched&, int) const {}
    __device__ __forceinline__ void operator()(const f32x4 (&acc)[2][2][4][2], const Unit& u, int wr, int wc, int fr, int fq, int) const {
        const int col0 = u.pn * 256 + wc * 32 + 4 * fq;
        const size_t off0 = (size_t)(u.pm * 256 + wr * 64 + fr) * DM + col0;
        if constexpr (MODE == 0) {
            f32x4 pre[4][2][2];
#pragma unroll
            for (int i = 0; i < 4; ++i)
#pragma unroll
                for (int bj = 0; bj < 2; ++bj)
#pragma unroll
                    for (int n = 0; n < 2; ++n) pre[i][bj][n] = *(const f32x4*)(xin + off0 + (size_t)(16 * i) * DM + bj * 128 + n * 16);
#pragma unroll
            for (int i = 0; i < 8; ++i) {
                const int ai = i >> 2, m = i & 3;
                const size_t off = off0 + (size_t)(ai * 128 + m * 16) * DM;
                float ss = 0.f; f32x4 xn[2][2];
#pragma unroll
                for (int bj = 0; bj < 2; ++bj)
#pragma unroll
                    for (int n = 0; n < 2; ++n) { xn[bj][n] = pre[i & 3][bj][n] + acc[ai][bj][m][n]; const f32x4 t = xn[bj][n]; ss += (t[0] * t[0] + t[1] * t[1]) + (t[2] * t[2] + t[3] * t[3]); }
                if (i < 4) {
#pragma unroll
                    for (int bj = 0; bj < 2; ++bj)
#pragma unroll
                        for (int n = 0; n < 2; ++n) pre[i & 3][bj][n] = *(const f32x4*)(xin + off + (size_t)128 * DM + bj * 128 + n * 16);
                }
#pragma unroll
                for (int bj = 0; bj < 2; ++bj)
#pragma unroll
                    for (int n = 0; n < 2; ++n) { v2u w; w.x = pk2(xn[bj][n][0], xn[bj][n][1]); w.y = pk2(xn[bj][n][2], xn[bj][n][3]); *(v2u*)(xbw + off + bj * 128 + n * 16) = w; }
                ss += __shfl_xor(ss, 16); ss += __shfl_xor(ss, 32);
                if (fq == 0) ssq[(size_t)(u.pm * 256 + ai * 128 + wr * 64 + m * 16 + fr) * 16 + u.pn * 4 + wc] = ss;
            }
        } else {
            v2u pre[8][2][2];
#pragma unroll
            for (int i = 0; i < 8; ++i)
#pragma unroll
                for (int bj = 0; bj < 2; ++bj)
#pragma unroll
                    for (int n = 0; n < 2; ++n) pre[i][bj][n] = EP_LD((const v2u*)(xb + off0 + (size_t)((i >> 2) * 128 + (i & 3) * 16) * DM + bj * 128 + n * 16));
#pragma unroll
            for (int i = 0; i < 8; ++i) {
                const int ai = i >> 2, m = i & 3;
                const size_t off = off0 + (size_t)(ai * 128 + m * 16) * DM;
                float ss = 0.f;
#pragma unroll
                for (int bj = 0; bj < 2; ++bj)
#pragma unroll
                    for (int n = 0; n < 2; ++n) {
                        const v2u p = pre[i][bj][n];
                        const f32x4 t = (f32x4){bflo(p.x), bfhi(p.x), bflo(p.y), bfhi(p.y)} + acc[ai][bj][m][n];
                        if constexpr (MODE == 2) { *(f32x4*)(xout + off + bj * 128 + n * 16) = t; }
                        else { ss += (t[0] * t[0] + t[1] * t[1]) + (t[2] * t[2] + t[3] * t[3]); v2u w; w.x = pk2(t[0], t[1]); w.y = pk2(t[2], t[3]); *(v2u*)(xbw + off + bj * 128 + n * 16) = w; }
                    }
                if constexpr (MODE != 2) {
                    ss += __shfl_xor(ss, 16); ss += __shfl_xor(ss, 32);
                    if (fq == 0) ssq[(size_t)(u.pm * 256 + ai * 128 + wr * 64 + m * 16 + fr) * 16 + u.pn * 4 + wc] = ss;
                }
            }
        }
    }
};
struct QKV {
    static constexpr bool PERM = true, AFTER_DRAIN = false, DUP = (DUP_EPI != 0);
    const float* ssq; bf16_t* Q; bf16_t* K; bf16_t* Vv; const float* qg; const float* kg; LAS unsigned char* lds0; int sh; bf16_t* scratch = nullptr; bool probe = false;
    __device__ __forceinline__ void set_probe() { probe = true; }
    template <class Sched> __device__ __forceinline__ void begin(LAS unsigned char* lds, const Sched& S, int tid) const {
        fill_rstab(lds, ssq, S, tid);
        if (tid < 128) ((LAS float*)(lds + GTAB_OFF))[tid] = tid < 64 ? qg[tid] * QSCALE : kg[tid - 64];
    }
    __device__ __forceinline__ void operator()(const f32x4 (&acc)[2][2][4][2], const Unit& u, int wr, int wc, int fr, int fq, int ui) const {
        const int which = u.pn >> 2, h = (u.pn & 3) * 4 + wc;
        bf16_t* base = Q + (ptrdiff_t)(which == 1) * (K - Q) + (ptrdiff_t)(which == 2) * (Vv - Q);
        const LAS float* gp = (const LAS float*)(lds0 + GTAB_OFF) + (which == 1 ? 64 : 0); const float gsc = 1.0f; const bool nrm = which < 2;
        const f32x4 g00 = *(const LAS f32x4*)(gp + 8 * fq), g01 = *(const LAS f32x4*)(gp + 8 * fq + 4), g10 = *(const LAS f32x4*)(gp + 32 + 8 * fq), g11 = *(const LAS f32x4*)(gp + 32 + 8 * fq + 4);
        float rsv[2][4]; tab_rs(lds0, ui, wr, fr, rsv);
#pragma unroll
        for (int ai = 0; ai < 2; ++ai)
#pragma unroll
            for (int m = 0; m < 4; ++m) {
                const int row = u.pm * 256 + ai * 128 + wr * 64 + m * 16 + fr;
                const float rs = rsv[ai][m];
                f32x4 v[2][2]; float ss = 0.f;
#pragma unroll
                for (int bj = 0; bj < 2; ++bj)
#pragma unroll
                    for (int n = 0; n < 2; ++n) { v[bj][n] = acc[ai][bj][m][n] * rs; const f32x4 t = v[bj][n]; ss += (t[0] * t[0] + t[1] * t[1]) + (t[2] * t[2] + t[3] * t[3]); }
                ss += __shfl_xor(ss, 16); ss += __shfl_xor(ss, 32);
                const float rn = gsc * __builtin_amdgcn_rsqf(ss * (1.0f / HD) + EPS);
#pragma unroll
                for (int bj = 0; bj < 2; ++bj) {
                    f32x4 a = v[bj][0], b = v[bj][1];
                    if (nrm) { a = a * (bj == 0 ? g00 : g10) * rn; b = b * (bj == 0 ? g01 : g11) * rn; }
                    v4u w; w.x = pk2(a[0], a[1]); w.y = pk2(a[2], a[3]); w.z = pk2(b[0], b[1]); w.w = pk2(b[2], b[3]);
                    #if DUP_EPI == 2
                    if (probe) st16(scratch + (size_t)blockIdx.x * 65536 + (size_t)(row & 255) * 256 + (h & 3) * 64 + 32 * bj + 8 * fq, w); else
#endif
                    st16(base + hm_row(row, h, sh) + 32 * bj + 8 * fq, w);
                }
            }
    }
};
struct ZMerge {
    static constexpr bool PERM = true, AFTER_DRAIN = false, DUP = false;
    const float* ssq; const bf16_t* O0; const bf16_t* O1; const bf16_t* O2; const float* lse; bf16_t* Y; LAS unsigned char* lds0;
    struct RowIn { v4u a[2], b[2], c[2]; float l0, l1, l2; };
    __device__ __forceinline__ void load_row(RowIn& r, int row, int h, int fq) const {
        const size_t off0 = hm_row(row, h, 0) + 8 * fq, off1 = hm_row(row, h, 2) + 8 * fq, off2 = hm_row(row, h, 4) + 8 * fq;
        r.l0 = lse[((size_t)0 * MROWS + row) * 16 + h]; r.l1 = lse[((size_t)1 * MROWS + row) * 16 + h]; r.l2 = lse[((size_t)2 * MROWS + row) * 16 + h];
#pragma unroll
        for (int bj = 0; bj < 2; ++bj) { r.a[bj] = EP_LD((const v4u*)(O0 + off0 + 32 * bj)); r.b[bj] = EP_LD((const v4u*)(O1 + off1 + 32 * bj)); r.c[bj] = EP_LD((const v4u*)(O2 + off2 + 32 * bj)); }
    }
    template <class Sched> __device__ __forceinline__ void begin(LAS unsigned char* lds, const Sched& S, int tid) const { fill_rstab(lds, ssq, S, tid); }
    __device__ __forceinline__ void operator()(const f32x4 (&acc)[2][2][4][2], const Unit& u, int wr, int wc, int fr, int fq, int ui) const {
        const int h = u.pn * 4 + wc, row0 = u.pm * 256 + wr * 64 + fr;
        RowIn in[4];
        load_row(in[0], row0, h, fq); load_row(in[1], row0 + 16, h, fq);
        float rsv[2][4]; tab_rs(lds0, ui, wr, fr, rsv);
        v4u szp[2][4][2];
#pragma unroll
        for (int ai = 0; ai < 2; ++ai)
#pragma unroll
            for (int m = 0; m < 4; ++m)
#pragma unroll
                for (int bj = 0; bj < 2; ++bj) {
                    const f32x4 z0 = acc[ai][bj][m][0] * rsv[ai][m], z1 = acc[ai][bj][m][1] * rsv[ai][m];
                    float s[8];
#pragma unroll
                    for (int k = 0; k < 4; ++k) { s[k] = z0[k] * sigmoidf_(z0[k]); s[4 + k] = z1[k] * sigmoidf_(z1[k]); }
                    szp[ai][m][bj] = (v4u){pk2(s[0], s[1]), pk2(s[2], s[3]), pk2(s[4], s[5]), pk2(s[6], s[7])};
                }
        load_row(in[2], row0 + 32, h, fq); load_row(in[3], row0 + 48, h, fq);
#pragma unroll
        for (int i = 0; i < 8; ++i) {
            const int ai = i >> 2, m = i & 3, row = row0 + ai * 128 + m * 16;
            const RowIn& r = in[i & 3];
            const float mx = fmaxf(r.l0, fmaxf(r.l1, r.l2));
            float w0 = __builtin_amdgcn_exp2f(r.l0 - mx), w1 = __builtin_amdgcn_exp2f(r.l1 - mx), w2 = __builtin_amdgcn_exp2f(r.l2 - mx);
            const float inv = __builtin_amdgcn_rcpf(w0 + w1 + w2); w0 *= inv; w1 *= inv; w2 *= inv;
#pragma unroll
            for (int bj = 0; bj < 2; ++bj) {
                const v4u a = r.a[bj], b = r.b[bj], c = r.c[bj], sp = szp[ai][m][bj];
                v4u w;
#pragma unroll
                for (int k = 0; k < 4; ++k) {
                    const float ol = w0 * bflo(a[k]) + w1 * bflo(b[k]) + w2 * bflo(c[k]), oh = w0 * bfhi(a[k]) + w1 * bfhi(b[k]) + w2 * bfhi(c[k]);
                    w[k] = pk2(ol * bflo(sp[k]), oh * bfhi(sp[k]));
                }
                st16(Y + (size_t)row * DM + h * HD + 32 * bj + 8 * fq, w);
            }
            if (i + 4 < 8) load_row(in[i & 3], row0 + 128 + m * 16, h, fq);
        }
    }
};
}

#ifndef P0_NT
#define P0_NT 0
#endif
#if P0_NT
#define P0_LD(p) __builtin_nontemporal_load(p)
#else
#define P0_LD(p) (*(p))
#endif
template <int MODE> __device__ __forceinline__ int wt_dest_row(int n) {
    if (MODE == 1) { const int type = n >> 11, e = n & 2047, pn = e >> 6, el = e & 63; return 256 * pn + 128 * (type >> 1) + 32 * (el >> 4) + 16 * (type & 1) + (el & 15); }
    if (MODE == 3) { const int blk = n >> 10, r = n & 1023, h = r >> 6, d = r & 63; return blk * 1024 + 256 * (h >> 2) + 128 * (d >> 5) + 32 * (h & 3) + (d & 31); }
    return n;
}
template <int MODE> __device__ __forceinline__ void p0_transpose_item(const float* W, int K, int N, const float* scale, bf16* WT, LAS float* scr  , int item, int lane) {
    const int nblk = N / 64, kb = item / nblk, nb = item % nblk, k0 = 64 * kb, n0 = 64 * nb;
    const int kr = lane >> 4, c4 = lane & 15;
    f32x4 v[16];
#pragma unroll
    for (int i = 0; i < 16; ++i) v[i] = P0_LD((const GAS f32x4*)(W + (size_t)(k0 + 4 * i + kr) * N + n0 + 4 * c4));
#pragma unroll
    for (int i = 0; i < 16; ++i) { const float s = scale ? scale[k0 + 4 * i + kr] : 1.0f; LAS float* d = scr + (4 * i + kr) * 65 + 4 * c4;
        d[0] = v[i][0] * s; d[1] = v[i][1] * s; d[2] = v[i][2] * s; d[3] = v[i][3] * s; }
    LDS_WAIT(); asm volatile("" ::: "memory");
    const int c = lane & 7, nl = lane >> 3;
#pragma unroll
    for (int j = 0; j < 8; ++j) { const int n = nl + 8 * j; const LAS float* s = scr + (8 * c) * 65 + n;
        v4u o; o.x = pk2(s[0 * 65], s[1 * 65]); o.y = pk2(s[2 * 65], s[3 * 65]); o.z = pk2(s[4 * 65], s[5 * 65]); o.w = pk2(s[6 * 65], s[7 * 65]);
        *(GAS v4u*)(WT + (size_t)wt_dest_row<MODE>(n0 + n) * K + k0 + 8 * c) = o; }
    LDS_WAIT(); asm volatile("" ::: "memory");
}
struct Ptrs {
    const float *x, *conv_norm, *conv_w_in, *conv_w, *conv_w_out, *attn_norm, *attn_w_in, *q_gain, *k_gain, *attn_w_out, *rel_bias;
    float* out; unsigned char* ws;
};
template <int PART> __device__ __forceinline__ void p0_weights(const Ptrs& P, int j, LAS unsigned char* lds, int vcu, int G, int wave, int lane) {
    LAS float* scr = (LAS float*)(lds + wave * 16640);
    const int gw = vcu * 8 + wave, NGW = G * 8;
    bf16* W1 = (bf16*)(P.ws + WS_W1); bf16* W2 = (bf16*)(P.ws + WS_W2); bf16* W3 = (bf16*)(P.ws + WS_W3); bf16* W4 = (bf16*)(P.ws + WS_W4);
    constexpr int I1 = (DM / 64) * (CN / 64), I2 = (CE / 64) * (DM / 64), I3 = (DM / 64) * (AN / 64), I4 = (DM / 64) * (DM / 64);
    if constexpr (PART == 0) {
        for (int it = gw; it < I1; it += NGW) p0_transpose_item<1>(P.conv_w_in + (size_t)j * DM * CN, DM, CN, P.conv_norm + j * DM, W1, scr, it, lane);
    } else {
        for (int it = gw; it < I2 + I3 + I4; it += NGW) {
            int r = it;
            if (r < I2) { p0_transpose_item<0>(P.conv_w_out + (size_t)j * CE * DM, CE, DM, nullptr, W2, scr, r, lane); continue; } r -= I2;
            if (r < I3) { p0_transpose_item<3>(P.attn_w_in + (size_t)j * DM * AN, DM, AN, P.attn_norm + j * DM, W3, scr, r, lane); continue; } r -= I3;
            p0_transpose_item<0>(P.attn_w_out + (size_t)j * DM * DM, DM, DM, nullptr, W4, scr, r, lane);
        }
    }
}
__device__ __forceinline__ void p0_prologue(const Ptrs& P, LAS unsigned char* lds, int vcu, int G, int wave, int lane, int tid) {
    p0_weights<0>(P, 0, lds, vcu, G, wave, lane);
    const int gw = vcu * 8 + wave, NGW = G * 8;
    bf16* XB = (bf16*)(P.ws + WS_XB); float* SSQ = (float*)(P.ws + WS_SSQ);
    for (int m = 2 * gw; m < MROWS; m += 2 * NGW) {
        const GAS f32x4* xr = (const GAS f32x4*)(P.x + (size_t)m * DM) + lane;
        GAS v2u* o8 = (GAS v2u*)(XB + (size_t)m * DM) + lane;
        f32x4 v[8];
#pragma unroll
        for (int jj = 0; jj < 8; ++jj) v[jj] = P0_LD(xr + 64 * jj);
        float s0 = 0.f, s1 = 0.f;
#pragma unroll
        for (int jj = 0; jj < 8; ++jj) { const f32x4 t = v[jj]; const float q = (t.x * t.x + t.y * t.y) + (t.z * t.z + t.w * t.w); if (jj < 4) s0 += q; else s1 += q;
            v2u w; w.x = pk2(t.x, t.y); w.y = pk2(t.z, t.w); o8[64 * jj] = w; }
        s0 = wave_sum(s0); s1 = wave_sum(s1);
        if (lane < 32) SSQ[(size_t)m * 16 + lane] = lane == 0 ? s0 : (lane == 16 ? s1 : 0.f);
    }
    float* BT = (float*)(P.ws + WS_BIAS);
    for (int i = vcu * 512 + tid; i < NG * NH * 132; i += G * 512) {
        const int g = i / (NH * 132), r = i % (NH * 132), h = r / 132, st = r % 132;
        const int dil = g == 0 ? 1 : (g == 1 ? 4 : 16);
        BT[i] = st <= 128 ? P.rel_bias[t5_bucket(st * dil) * (NG * NH) + g * NH + h] * LOG2E : 0.f;
    }
}
__device__ __forceinline__ void conv_fixup(bf16* Y, const float* side, const float* cw, int pm, int tid) {
    if ((pm & 15) == 0) return;
    const int ch = 4 * tid;
    const f32x4 g0 = *(const f32x4*)(side + ((size_t)pm * 6 + 0) * CE + ch), g1 = *(const f32x4*)(side + ((size_t)pm * 6 + 1) * CE + ch);
    const f32x4 c0 = *(const f32x4*)(side + ((size_t)pm * 6 + 2) * CE + ch), c1 = *(const f32x4*)(side + ((size_t)pm * 6 + 3) * CE + ch);
    const f32x4 va = *(const f32x4*)(side + ((size_t)(pm - 1) * 6 + 4) * CE + ch), vb = *(const f32x4*)(side + ((size_t)(pm - 1) * 6 + 5) * CE + ch);
    const f32x4 w0 = *(const f32x4*)(cw + ch), w1 = *(const f32x4*)(cw + CE + ch);
    const f32x4 y0 = g0 * (c0 + w1 * vb + w0 * va), y1 = g1 * (c1 + w0 * vb);
    v2u a, b; a.x = pk2(y0[0], y0[1]); a.y = pk2(y0[2], y0[3]); b.x = pk2(y1[0], y1[1]); b.y = pk2(y1[2], y1[3]);
    *(v2u*)(Y + (size_t)(pm * 256) * CE + ch) = a; *(v2u*)(Y + (size_t)(pm * 256 + 1) * CE + ch) = b;
}

namespace attn {
typedef float f32x16 __attribute__((ext_vector_type(16)));
typedef short s16x4 __attribute__((ext_vector_type(4)));
typedef short v4i16_t __attribute__((ext_vector_type(4)));
constexpr int L_K0 = 0, L_KSZ = 49152, L_V = 98304, L_T = 147456, L_END = 148480, L_WS = 161536 + 256;
__device__ __forceinline__ int crow(int r, int hi) { return (r & 3) + 8 * (r >> 2) + 4 * hi; }
__device__ __forceinline__ s16x4 vtr(LAS const unsigned char* p) { return __builtin_bit_cast(s16x4, __builtin_amdgcn_ds_read_tr16_b64_v4i16((LAS v4i16_t*)p)); }
__device__ __forceinline__ float swapmax(float m) { auto rr = __builtin_amdgcn_permlane32_swap(__float_as_uint(m), __float_as_uint(m), false, false); return fmaxf(__uint_as_float(rr[0]), __uint_as_float(rr[1])); }
__device__ __forceinline__ float swapsum(float m) { auto rr = __builtin_amdgcn_permlane32_swap(__float_as_uint(m), __float_as_uint(m), false, false); return __uint_as_float(rr[0]) + __uint_as_float(rr[1]); }
#define ATT_BAR() asm volatile("s_waitcnt lgkmcnt(0)\n\ts_barrier" ::: "memory")
__device__ __forceinline__ void glds16(const void* gsrc, unsigned lds_dst) { unsigned keep;
    asm volatile("s_mov_b32 %0, m0\n\ts_mov_b32 m0, %2\n\ts_nop 0\n\tglobal_load_lds_dwordx4 %1, off nt\n\ts_mov_b32 m0, %0" : "=&s"(keep) : "v"(gsrc), "s"(lds_dst) : "memory"); }
template <int DIL> struct Job {
    int bh, c, n0, h; size_t rowb, base;
    __device__ __forceinline__ void decode(int id) { constexpr int CPC = (SEQ / DIL) / 256; bh = id >> 4; const int sub = id & 15; c = sub / CPC; n0 = (sub % CPC) * 256; h = bh & 15; rowb = (size_t)(bh >> 4) * SEQ;
        base = ((size_t)bh * SEQ + (size_t)c * (SEQ / DIL)) * HD; }
};
template <int DIL, bool ISV> __device__ __forceinline__ void issue_kv(LAS unsigned char* lds, int dst_off, const bf16* src, const Job<DIL>& J, int w, int lane) {
#pragma unroll
    for (int i = 0; i < 6; ++i) {
        const int kb = w * 6 + i, row = kb * 8 + (lane >> 3), pc = lane & 7;
        int pos = J.n0 - 128 + row; pos = pos < 0 ? 0 : pos;
        const size_t ro = J.base + (size_t)pos * HD;
        const int sw = ISV ? ((((pc >> 2) ^ ((row >> 1) & 1)) * 32) + (pc & 3) * 8) : ((pc ^ ((row >> 1) & 7)) * 8);
        glds16(src + ro + sw, (unsigned)__builtin_amdgcn_readfirstlane((int)((unsigned)(uintptr_t)lds + dst_off + kb * 1024)));
    }
}
__device__ __forceinline__ void ld16_asm(bf16x8& dst, const bf16* p) { asm volatile("global_load_dwordx4 %0, %1, off" : "=v"(dst) : "v"(p) : "memory"); }

template <int DIL> __device__ __forceinline__ void phase(LAS unsigned char* lds, const bf16* QO, bf16* OUT, const bf16* Kg, const bf16* Vg, const float* biasT  , float* lse  , int vcu, int G, int jlo = 0, int jhi = 4) {
    const int tid = threadIdx.x, lane = tid & 63, r32 = lane & 31, hi = lane >> 5;
    const int w = __builtin_amdgcn_readfirstlane(tid >> 6);
    constexpr int NJS = BATCH * NH * 16;
    int id = vcu * 4 + jlo;
    if (id >= NJS || jlo >= jhi) return;
    Job<DIL> J; J.decode(id);
    bf16x8 q0, q1, q2, q3;
    int kcur = L_K0;
    issue_kv<DIL, false>(lds, kcur, Kg, J, w, lane);
    { const bf16* qp = QO + J.base + (size_t)(J.n0 + 32 * w + r32) * HD + hi * 8; ld16_asm(q0, qp); ld16_asm(q1, qp + 16); ld16_asm(q2, qp + 32); ld16_asm(q3, qp + 48); }
    issue_kv<DIL, true>(lds, L_V, Vg, J, w, lane);
    int cur_bh = -1; bool first = true;
    for (;;) {
        const int nid = id + (((id & 3) == jhi - 1) ? (G * 4 - (jhi - 1 - jlo)) : 1);
        const bool has_next = nid < NJS;
        Job<DIL> JN; JN.decode(has_next ? nid : id);
        if (J.bh != cur_bh) {
            cur_bh = J.bh;
            if (tid < 192) { const int step = tid - 32; ((LAS float*)(lds + L_T))[tid] = (step >= 0 && step <= 128) ? biasT[J.h * 132 + step] : -INFINITY; }
        }
        if (first) { first = false; asm volatile("s_waitcnt vmcnt(6)" : "+v"(q0), "+v"(q1), "+v"(q2), "+v"(q3) :: "memory"); }
        ATT_BAR();
        const int knext = kcur ^ L_KSZ;
        bf16x8 n0q, n1q, n2q, n3q;
        if (has_next) {
            issue_kv<DIL, false>(lds, knext, Kg, JN, w, lane);
            const bf16* qp = QO + JN.base + (size_t)(JN.n0 + 32 * w + r32) * HD + hi * 8; ld16_asm(n0q, qp); ld16_asm(n1q, qp + 16); ld16_asm(n2q, qp + 32); ld16_asm(n3q, qp + 48);
        }
        const int n0 = J.n0, h = J.h, c = J.c; const size_t rowb = J.rowb, jbase = J.base;
        const size_t qrow = rowb + (size_t)(n0 + 32 * w + r32) * DIL + c;
        const int jstart = (n0 == 0 && w < 4) ? 4 - w : 0;
        const LAS float* tp = (const LAS float*)(lds + L_T) + (5 + r32 - 4 * hi);
        const LAS unsigned char* kp = lds + kcur + (32 * w + r32) * 128;
        f32x16 S[5];
#pragma unroll
        for (int j = 0; j < 5; ++j) {
            if (j < jstart) {
#pragma unroll
                for (int r = 0; r < 16; ++r) S[j][r] = -INFINITY;
            } else {
                f32x16 cinit;
#pragma unroll
                for (int r = 0; r < 16; ++r) cinit[r] = tp[155 - 32 * j - (r & 3) - 8 * (r >> 2)];
#pragma unroll
                for (int d0 = 0; d0 < 4; ++d0) {
                    const bf16x8 kf = *(const LAS bf16x8*)(kp + 32 * j * 128 + (((2 * d0 + hi) ^ ((r32 >> 1) & 7)) * 16));
                    cinit = __builtin_amdgcn_mfma_f32_32x32x16_bf16(kf, d0 == 0 ? q0 : (d0 == 1 ? q1 : (d0 == 2 ? q2 : q3)), cinit, 0, 0, 0);
                }
                S[j] = cinit;
            }
        }
        float m = -INFINITY;
#pragma unroll
        for (int j = 0; j < 5; ++j)
#pragma unroll
            for (int r = 0; r < 16; ++r) m = fmaxf(m, S[j][r]);
        m = swapmax(m);
        float lsum = 0.f;
#pragma unroll
        for (int j = 0; j < 5; ++j)
#pragma unroll
            for (int r = 0; r < 16; ++r) { const float p = __builtin_amdgcn_exp2f(S[j][r] - m); S[j][r] = p; lsum += p; }
        lsum = swapsum(lsum);
        if (has_next) asm volatile("s_waitcnt vmcnt(10)" ::: "memory"); else asm volatile("s_waitcnt vmcnt(0)" ::: "memory");
        ATT_BAR();
        f32x16 o[2];
#pragma unroll
        for (int r = 0; r < 16; ++r) { o[0][r] = 0.f; o[1][r] = 0.f; }
        const int vq = (lane & 15) >> 2, vx = (vq >> 1) & 1;
        const LAS unsigned char* vrow = lds + L_V + (32 * w + 4 * hi + vq) * 128 + ((lane >> 4) & 1) * 32 + (lane & 3) * 8;
        const LAS unsigned char* vbh[2] = {vrow + vx * 64, vrow + (1 - vx) * 64};
#pragma unroll
        for (int j = 0; j < 5; ++j)
#pragma unroll
            for (int s = 0; s < 2; ++s) {
                v4u pw; pw.x = pk2(S[j][8 * s], S[j][8 * s + 1]); pw.y = pk2(S[j][8 * s + 2], S[j][8 * s + 3]); pw.z = pk2(S[j][8 * s + 4], S[j][8 * s + 5]); pw.w = pk2(S[j][8 * s + 6], S[j][8 * s + 7]);
                const bf16x8 pa = __builtin_bit_cast(bf16x8, pw);
#pragma unroll
                for (int d0 = 0; d0 < 2; ++d0) {
                    const s16x4 lo = vtr(vbh[d0] + (32 * j + 16 * s) * 128), hh = vtr(vbh[d0] + (32 * j + 16 * s + 8) * 128);
                    const bf16x8 vf = (bf16x8){lo[0], lo[1], lo[2], lo[3], hh[0], hh[1], hh[2], hh[3]};
                    o[d0] = __builtin_amdgcn_mfma_f32_32x32x16_bf16(pa, vf, o[d0], 0, 0, 0);
                }
            }
        ATT_BAR();
        if (has_next) issue_kv<DIL, true>(lds, L_V, Vg, JN, w, lane);
        LAS float* wsf = (LAS float*)(lds + L_WS) + w * 64;
        if (hi == 0) { wsf[r32] = lsum; lse[qrow * 16 + h] = m + log2f(lsum); }
        asm volatile("s_waitcnt lgkmcnt(0)" ::: "memory");
        float rli[16];
#pragma unroll
        for (int r = 0; r < 16; ++r) rli[r] = __builtin_amdgcn_rcpf(wsf[crow(r, hi)]);
        LAS bf16* stg = (LAS bf16*)(lds + kcur) + w * 2048;
#pragma unroll
        for (int r = 0; r < 16; ++r) { const int orow = crow(r, hi);
#pragma unroll
            for (int d0 = 0; d0 < 2; ++d0) stg[orow * 64 + d0 * 32 + r32] = (bf16)(pk2(o[d0][r] * rli[r], 0.f) & 0xffffu); }
        asm volatile("s_waitcnt lgkmcnt(0)" ::: "memory");
#pragma unroll
        for (int i = 0; i < 4; ++i) { const int row = i * 8 + (lane >> 3), ch = lane & 7; const v4u v = *(const LAS v4u*)(stg + row * 64 + ch * 8);
            st16(OUT + jbase + (size_t)(n0 + 32 * w + row) * HD + ch * 8, v); }
        if (!has_next) break;
        asm volatile("s_waitcnt vmcnt(6)" : "+v"(n0q), "+v"(n1q), "+v"(n2q), "+v"(n3q) :: "memory");
        id = nid; J = JN; q0 = n0q; q1 = n1q; q2 = n2q; q3 = n3q; kcur = knext;
    }
    asm volatile("s_waitcnt vmcnt(0) lgkmcnt(0)\n\ts_barrier" ::: "memory");
}
#undef ATT_BAR
}

#ifndef PARITY_SPLIT
#define PARITY_SPLIT 1
#endif
#ifndef GEMM_SP2
#define GEMM_SP2 true
#endif
#ifndef GEMM_ALIGN
#define GEMM_ALIGN true
#endif
#ifndef DUP_RES
#define DUP_RES 0
#endif
#ifndef DUP_A2
#define DUP_A2 0
#endif
#ifndef DUP_A3
#define DUP_A3 0
#endif
#ifndef ATT_SPLIT
#define ATT_SPLIT 4
#endif
#ifndef DUP_EPI
#define DUP_EPI 0
#endif
#ifndef PARITY_EXPR
#define PARITY_EXPR ((bx & 1) != 0)
#endif
#ifndef ONE_ALIGN
#define ONE_ALIGN false
#endif
#ifndef DUP_BAR
#define DUP_BAR 0
#endif
constexpr int LDS_BYTES = 163840;
constexpr int XCH_OFF = 131072;
constexpr int MISC_OFF = 161536;
struct Args { const float* in[11]; float* out; unsigned char* ws; int ph_lo, ph_hi; };

enum PhaseKind { PK_P0A, PK_P0B, PK_C1, PK_C3, PK_A1, PK_A1A2, PK_A2, PK_A3, PK_A4 };
struct PhaseDesc { int kind, j, g; };
__host__ __device__ constexpr PhaseDesc phase_desc(int ph) {
    if (ph == 0) return {PK_P0A, 0, 0};
    const int j = ph >= 9 ? 1 : 0, s = ph - (j ? 9 : 1);
    switch (s) {
        case 0: return {PK_C1, j, 0};
        case 1: return {PK_C3, j, 0};
        case 2: return {PK_A1, j, 0};
        case 3: return {PK_A1A2, j, 0};
        case 4: return {PK_A1A2, j, 1};
        case 5: return {PK_A2, j, 2};
        case 6: return {PK_A3, j, 0};
        default: return {PK_A4, j, 0};
    }
}
__device__ __forceinline__ size_t kbuf_off(int g) { return g == 1 ? WS_KB : WS_KA; }
__device__ __forceinline__ size_t vbuf_off(int g) { return g == 1 ? WS_VB : WS_VA; }

template <int J, int G1> __device__ __forceinline__ void run_qkv_gemm(const Args& args, LAS unsigned char* lds, int G, int bx) {
    unsigned char* ws = args.ws;
    bf16* XB = (bf16*)(ws + WS_XB); float* SSQ = (float*)(ws + WS_SSQ);
    bf16* QO = (bf16*)(ws + WS_QO) + (size_t)G1 * MROWS * DM;
    pg8::Gemm gm{XB, (const bf16*)(ws + WS_W3) + (size_t)G1 * 3072 * DM, MROWS, 3072, DM}; pg8::StaticOrder S; S.init(MROWS, 3072, G, bx);
    epi::QKV E{SSQ, QO, (bf16*)(ws + kbuf_off(G1)), (bf16*)(ws + vbuf_off(G1)), args.in[7] + (J * NG + G1) * HD, args.in[8] + (J * NG + G1) * HD, lds, 2 * G1, (DUP_EPI != 0 && G1 == 0) ? (bf16*)(ws + WS_QO) + (size_t)2 * MROWS * DM : nullptr};
    pg8::gemm_phase<epi::QKV, pg8::StaticOrder, GEMM_ALIGN, GEMM_SP2>(lds, gm, S, E);
}
template <int G0> __device__ __forceinline__ void run_attn(const Args& args, LAS unsigned char* lds, int vcu, int G, int jlo = 0, int jhi = 4) {
    unsigned char* ws = args.ws;
    constexpr int dil = G0 == 0 ? 1 : (G0 == 1 ? 4 : 16);
    bf16* QO = (bf16*)(ws + WS_QO) + (size_t)G0 * MROWS * DM;
    attn::phase<dil>(lds, QO, QO, (const bf16*)(ws + kbuf_off(G0)), (const bf16*)(ws + vbuf_off(G0)), (const float*)(ws + WS_BIAS) + G0 * NH * 132, (float*)(ws + WS_LSE) + (size_t)G0 * MROWS * 16, vcu, G, jlo, jhi);
}

template <int PH> __device__ __forceinline__ void run_phase(const Args& args, LAS unsigned char* lds) {
    constexpr PhaseDesc D = phase_desc(PH);
    constexpr int j = D.j;
    const int tid = threadIdx.x, lane = tid & 63, wave = __builtin_amdgcn_readfirstlane(tid >> 6);
    const int G = gridDim.x, bx = blockIdx.x, vcu = (G % 8 == 0) ? (bx % 8) * (G / 8) + bx / 8 : bx;
    unsigned char* ws = args.ws;
    float* SSQ = (float*)(ws + WS_SSQ); bf16* XB = (bf16*)(ws + WS_XB);
    (void)lane; (void)wave; (void)SSQ; (void)XB; (void)vcu;
    if constexpr (D.kind == PK_P0A || D.kind == PK_P0B) {
        Ptrs P;
        P.x = args.in[0]; P.conv_norm = args.in[1]; P.conv_w_in = args.in[2]; P.conv_w = args.in[3]; P.conv_w_out = args.in[4]; P.attn_norm = args.in[5];
        P.attn_w_in = args.in[6]; P.q_gain = args.in[7]; P.k_gain = args.in[8]; P.attn_w_out = args.in[9]; P.rel_bias = args.in[10]; P.out = args.out; P.ws = args.ws;
        if constexpr (D.kind == PK_P0A) p0_prologue(P, lds, vcu, G, wave, lane, tid);
        else p0_weights<0>(P, 1, lds, vcu, G, wave, lane);
    } else if constexpr (D.kind == PK_C1) {
        Ptrs P;
        P.x = args.in[0]; P.conv_norm = args.in[1]; P.conv_w_in = args.in[2]; P.conv_w = args.in[3]; P.conv_w_out = args.in[4]; P.attn_norm = args.in[5];
        P.attn_w_in = args.in[6]; P.q_gain = args.in[7]; P.k_gain = args.in[8]; P.attn_w_out = args.in[9]; P.rel_bias = args.in[10]; P.out = args.out; P.ws = args.ws;
        const bool conv_first = PARITY_EXPR;
        if (conv_first) { p0_weights<1>(P, j, lds, vcu, G, wave, lane); __syncthreads(); }
        pg8::Gemm g{XB, (const bf16*)(ws + WS_W1), MROWS, CN, DM}; pg8::StaticOrder S; S.init(MROWS, CN, G, bx);
        epi::ConvFused E{SSQ, (bf16*)(ws + WS_CG), args.in[3] + (size_t)j * 3 * CE, (float*)(ws + WS_SIDE), lds + XCH_OFF};
        pg8::gemm_phase<epi::ConvFused, pg8::StaticOrder, true, GEMM_SP2>(lds, g, S, E);
        if (!conv_first) p0_weights<1>(P, j, lds, vcu, G, wave, lane);
    } else if constexpr (D.kind == PK_C3 || D.kind == PK_A4) {
        constexpr bool C3 = D.kind == PK_C3; constexpr int K = C3 ? CE : DM;
        const bf16* A = (const bf16*)(ws + (C3 ? WS_CG : WS_Y));
        pg8::Gemm g{A, (const bf16*)(ws + (C3 ? WS_W2 : WS_W4)), MROWS, DM, K}; pg8::StaticOrder S; S.init(MROWS, DM, G, bx);
        if constexpr (C3) { pg8::Unit fu; for (int i = 0; S.next(i, fu); ++i) conv_fixup((bf16*)(ws + WS_CG), (const float*)(ws + WS_SIDE), args.in[3] + (size_t)j * 3 * CE, fu.pm, tid);
            asm volatile("s_waitcnt vmcnt(0)" ::: "memory"); __syncthreads(); }
        constexpr int RMODE = (j == 0 && C3) ? 0 : ((j == 1 && !C3) ? 2 : 1);
#if DUP_RES
        if constexpr (RMODE == 1 && (DUP_RES == 1) == C3) { epi::ResidB<RMODE> E2{args.in[0], args.out, XB, SSQ, (bf16*)(ws + WS_VB)}; pg8::gemm_phase<epi::ResidB<RMODE>, pg8::StaticOrder, false, true>(lds, g, S, E2); }
#endif
        epi::ResidB<RMODE> E{args.in[0], args.out, XB, SSQ, XB};
        pg8::gemm_phase<epi::ResidB<RMODE>, pg8::StaticOrder, ONE_ALIGN, true>(lds, g, S, E);
    } else if constexpr (D.kind == PK_A1) {
        if constexpr (j == 0) {
            Ptrs P;
            P.x = args.in[0]; P.conv_norm = args.in[1]; P.conv_w_in = args.in[2]; P.conv_w = args.in[3]; P.conv_w_out = args.in[4]; P.attn_norm = args.in[5];
            P.attn_w_in = args.in[6]; P.q_gain = args.in[7]; P.k_gain = args.in[8]; P.attn_w_out = args.in[9]; P.rel_bias = args.in[10]; P.out = args.out; P.ws = args.ws;
            const bool conv_first = PARITY_EXPR;
            if (conv_first) { p0_weights<0>(P, 1, lds, vcu, G, wave, lane); __syncthreads(); }
            run_qkv_gemm<j, 0>(args, lds, G, bx);
            if (!conv_first) p0_weights<0>(P, 1, lds, vcu, G, wave, lane);
        } else run_qkv_gemm<j, 0>(args, lds, G, bx);
    } else if constexpr (D.kind == PK_A1A2) {
#if PARITY_SPLIT
        const bool attn_first = PARITY_EXPR;
#else
        const bool attn_first = false;
#endif
        if (attn_first) { run_attn<D.g>(args, lds, vcu, G, 0, ATT_SPLIT); run_qkv_gemm<j, D.g + 1>(args, lds, G, bx); run_attn<D.g>(args, lds, vcu, G, ATT_SPLIT, 4); }
        else            { run_qkv_gemm<j, D.g + 1>(args, lds, G, bx); run_attn<D.g>(args, lds, vcu, G); }
    } else if constexpr (D.kind == PK_A2) {
#if DUP_A2
        { constexpr int dil = 16; bf16* QO = (bf16*)(ws + WS_QO) + (size_t)2 * MROWS * DM;
          attn::phase<dil>(lds, QO, (bf16*)(ws + WS_VB), (const bf16*)(ws + kbuf_off(2)), (const bf16*)(ws + vbuf_off(2)), (const float*)(ws + WS_BIAS) + 2 * NH * 132, (float*)(ws + WS_LSE) + (size_t)2 * MROWS * 16, vcu, G); }
#endif
        run_attn<D.g>(args, lds, vcu, G);
    } else if constexpr (D.kind == PK_A3) {
        const bf16* O0 = (const bf16*)(ws + WS_QO); const bf16* O1 = O0 + (size_t)MROWS * DM; const bf16* O2 = O1 + (size_t)MROWS * DM;
        pg8::Gemm g{XB, (const bf16*)(ws + WS_W3) + (size_t)QKVC * DM, MROWS, DM, DM}; pg8::StaticOrder S; S.init(MROWS, DM, G, bx);
        epi::ZMerge E{SSQ, O0, O1, O2, (const float*)(ws + WS_LSE), (bf16*)(ws + WS_Y), lds};
#if DUP_A3
        pg8::gemm_phase<epi::ZMerge, pg8::StaticOrder, false, true>(lds, g, S, E);
#endif
        pg8::gemm_phase<epi::ZMerge, pg8::StaticOrder, ONE_ALIGN, true>(lds, g, S, E);
    }
}

__global__ void __launch_bounds__(512, 2) mk_fwd(Args args) {
    extern __shared__ __attribute__((aligned(16))) unsigned char lds_raw[];
    LAS unsigned char* lds = (LAS unsigned char*)lds_raw;
    volatile LAS unsigned* MISC = (volatile LAS unsigned*)(lds + MISC_OFF);
    for (int u = threadIdx.x; u < (LDS_BYTES - MISC_OFF) / 4; u += 512) ((LAS unsigned*)(lds + MISC_OFF))[u] = 0u;
    __syncthreads();
    gu32* ctl = (gu32*)(args.ws + WS_CTL);
    XcdBarrier bar; bar.bar = (unsigned*)(ctl + CW_BAR); bar.x = 0; bar.st = nullptr;
    const int lo = args.ph_lo, hi = args.ph_hi;
    if (hi - lo > 1) bar = xcd_barrier_post((unsigned*)(ctl + CW_BAR), MISC + 8);
#if DUP_BAR
#define RUN(k) if (lo <= (k) && (k) < hi) { run_phase<(k)>(args, lds); if ((k) + 1 < hi) { xcd_barrier(bar); xcd_barrier(bar); } }
#else
#define RUN(k) if (lo <= (k) && (k) < hi) { run_phase<(k)>(args, lds); if ((k) + 1 < hi) xcd_barrier(bar); }
#endif
    RUN(0) RUN(1) RUN(2) RUN(3) RUN(4) RUN(5) RUN(6) RUN(7) RUN(8) RUN(9) RUN(10) RUN(11) RUN(12) RUN(13) RUN(14) RUN(15) RUN(16)
#undef RUN
}

extern "C" void kernel_launch(void* const* d_in, const int* in_sizes, int n_in, void* d_out, int out_size, void* d_ws, size_t ws_size, hipStream_t stream) {
    static int grid = 0;
    if (grid == 0) {
        if (n_in != 11 || in_sizes[0] != MROWS * DM || out_size != MROWS * DM || ws_size < WS_END) { fprintf(stderr, "kernel_launch: unexpected shapes (n_in %d, ws %zu); nothing launched\n", n_in, ws_size); grid = -1; return; }
        int dev = 0, cus = 0, per_cu = 0;
        if (hipGetDevice(&dev) != hipSuccess || hipDeviceGetAttribute(&cus, hipDeviceAttributeMultiprocessorCount, dev) != hipSuccess) { grid = -1; return; }
        if (hipFuncSetAttribute((const void*)mk_fwd, hipFuncAttributeMaxDynamicSharedMemorySize, LDS_BYTES) != hipSuccess) { fprintf(stderr, "kernel_launch: hipFuncSetAttribute failed\n"); grid = -1; return; }
        if (hipOccupancyMaxActiveBlocksPerMultiprocessor(&per_cu, (const void*)mk_fwd, 512, LDS_BYTES) != hipSuccess || per_cu < 1) { fprintf(stderr, "kernel_launch: occupancy query says %d blocks per CU; nothing launched\n", per_cu); (void)hipGetLastError(); grid = -1; return; }
        if (cus < 256) { fprintf(stderr, "kernel_launch: built for >= 256 CUs (per-phase LDS tables hold 8 units per workgroup); %d found; nothing launched\n", cus); grid = -1; return; }
        grid = cus;
    }
    if (grid < 0) return;
    (void)hipMemsetAsync((char*)d_ws + WS_CTL, 0, CTL_ZERO_BYTES, stream);
    Args a{};
    for (int i = 0; i < 11; ++i) a.in[i] = (const float*)d_in[i];
    a.out = (float*)d_out; a.ws = (unsigned char*)d_ws;
    a.ph_lo = 0; a.ph_hi = NPHASE; hipLaunchKernelGGL(mk_fwd, dim3(grid), dim3(512), LDS_BYTES, stream, a);
}
```

```cpp
#include <hip/hip_runtime.h>
#include <cstdio>
#include <cstdint>
#include <cmath>
namespace pg8 {
#define PG8_LAS __attribute__((address_space(3)))
typedef unsigned short bf16_t;
typedef short bf16x8 __attribute__((ext_vector_type(8)));
typedef float f32x4 __attribute__((ext_vector_type(4)));
typedef unsigned u32x4 __attribute__((ext_vector_type(4)));
constexpr int BM = 256, BK = 64, HALF = 128, HTB = HALF * BK * 2  , STAGE_BYTES = 8 * HTB, NXCD = 8, WGM = 8;

__host__ __device__ __forceinline__ int lds_byte(int r, int c) { const int st = (r >> 4) * 2 + (c >> 5), rr = r & 15, cc = c & 31, ob = rr * 64 + cc * 2; return st * 1024 + (ob ^ (((ob >> 9) & 1) << 5)); }
__host__ __device__ __forceinline__ void stage_rc(int b, int& R, int& C) { const int st = b / 1024, sb = b % 1024, swz = sb ^ (((sb >> 9) & 1) << 5); R = (st >> 1) * 16 + swz / 64; C = (st & 1) * 32 + (swz % 64) / 2; }
__host__ __device__ __forceinline__ int perm32(int rho) { const int n = rho >> 4, i = rho & 15; return 8 * (i >> 2) + 4 * n + (i & 3); }

struct Unit { int pm, pn; };
struct Gemm { const bf16_t* A; const bf16_t* Bt; int M, N, K; };

struct StaticOrder {
    int nM, nN, nwg, G, c;
    __host__ __device__ void init(int M, int N, int G_, int c_) { nM = M / BM; nN = N / BM; nwg = nM * nN; G = G_; c = c_; }
    __host__ __device__ bool next(int i, Unit& u) const {
        const long L = (long)i * G + c; if (L >= nwg) return false;
        int wgid = (int)L; { const int q = nwg / NXCD, r = nwg % NXCD, xcd = wgid % NXCD, off = wgid / NXCD; wgid = (xcd < r ? xcd * (q + 1) : r * (q + 1) + (xcd - r) * q) + off; }
        const int nig = WGM * nN, gid = wgid / nig, fm = gid * WGM, gsz = (nM - fm) < WGM ? (nM - fm) : WGM;
        u.pm = fm + ((wgid % nig) % gsz); u.pn = (wgid % nig) / gsz; return true;
    }
    __device__ __forceinline__ void a_ready(const Unit&) const {}
    __device__ __forceinline__ void done(const Unit&) const {}
};

__device__ __forceinline__ unsigned cvt_pk_bf16(float lo, float hi) { unsigned r; asm volatile("v_cvt_pk_bf16_f32 %0, %1, %2" : "=v"(r) : "v"(lo), "v"(hi)); return r; }
typedef float f32x2 __attribute__((ext_vector_type(2)));

template <class Epi, class Sched, bool ALIGN_EPI = false, bool SP2 = false>
__device__ __forceinline__ void gemm_phase(PG8_LAS unsigned char* lds, const Gemm g, const Sched& S, const Epi& E) {
    const int tid = threadIdx.x, wid = __builtin_amdgcn_readfirstlane(tid >> 6), lane = tid & 63, wr = wid >> 2, wc = wid & 3, fr = lane & 15, fq = lane >> 4;
    const int K = g.K, nt = K / BK;
    unsigned voffA[2], voffB[2];
#pragma unroll
    for (int i = 0; i < 2; ++i) { int R, C; stage_rc(tid * 16 + i * 8192, R, C); const int Rb = Epi::PERM ? ((R & ~31) + perm32(R & 31)) : R;
        voffA[i] = (unsigned)(R * K + C) * 2u; voffB[i] = (unsigned)(Rb * K + C) * 2u; }
    const size_t kstep = (size_t)(BK * 2);
    const size_t hstep = (size_t)HALF * K * 2;
    const size_t tstep = 2 * hstep;
    const unsigned ldsw = (unsigned)wid * 1024u;
    const int aoff = lds_byte(wr * 64 + fr, fq * 8), boff = lds_byte(wc * 32 + fr, fq * 8);
#define PG8_SA(b, h) (((b) * 2 + (h)) * HTB)
#define PG8_SB(b, h) ((4 + (b) * 2 + (h)) * HTB)
#define PG8_STAGE(bufoff, gbase, voff) do { _Pragma("unroll") for (int _i = 0; _i < 2; ++_i) \
        __builtin_amdgcn_global_load_lds((const unsigned*)((const char*)(gbase) + (voff)[_i]), (PG8_LAS unsigned*)(lds + (bufoff) + ldsw + _i * 8192), 16, 0, 0); } while (0)
#define PG8_LDA(dst, b, h) do { _Pragma("unroll") for (int m = 0; m < 4; ++m) _Pragma("unroll") for (int k = 0; k < 2; ++k) dst[m][k] = *(const PG8_LAS bf16x8*)(lds + PG8_SA(b, h) + aoff + m * 2048 + k * 1024); } while (0)
#define PG8_LDB(dst, b, h) do { _Pragma("unroll") for (int n = 0; n < 2; ++n) _Pragma("unroll") for (int k = 0; k < 2; ++k) dst[n][k] = *(const PG8_LAS bf16x8*)(lds + PG8_SB(b, h) + boff + n * 2048 + k * 1024); } while (0)
#define PG8_MMA(ai, bj, At, Bt) do { __builtin_amdgcn_s_setprio(1); _Pragma("unroll") for (int m = 0; m < 4; ++m) _Pragma("unroll") for (int n = 0; n < 2; ++n) _Pragma("unroll") for (int k = 0; k < 2; ++k) \
        acc[ai][bj][m][n] = __builtin_amdgcn_mfma_f32_16x16x32_bf16(Bt[n][k], At[m][k], acc[ai][bj][m][n], 0, 0, 0); __builtin_amdgcn_s_setprio(0); } while (0)
#define PG8_WAIT_V(n) asm volatile("s_waitcnt vmcnt(" #n ")" ::: "memory")
#define PG8_WAIT_L(n) asm volatile("s_waitcnt lgkmcnt(" #n ")" ::: "memory")
#define PG8_BAR __builtin_amdgcn_s_barrier()
#define PG8_SCHED __builtin_amdgcn_sched_barrier(0)
    Unit cur, nxt; int ui = 0;
    if (!S.next(0, cur)) return;
    f32x4 acc[2][2][4][2];
#pragma unroll
    for (int a = 0; a < 2; ++a)
#pragma unroll
        for (int b = 0; b < 2; ++b)
#pragma unroll
            for (int m = 0; m < 4; ++m)
#pragma unroll
                for (int n = 0; n < 2; ++n) acc[a][b][m][n] = (f32x4){0.f, 0.f, 0.f, 0.f};
    bf16x8 At[4][2], B0[2][2], B1[2][2];
    const char* cA = (const char*)g.A + (size_t)cur.pm * tstep; const char* cB = (const char*)g.Bt + (size_t)cur.pn * tstep;
    S.a_ready(cur);
    if constexpr (SP2) {
        PG8_STAGE(PG8_SB(0, 0), cB, voffB); PG8_STAGE(PG8_SB(0, 1), cB + hstep, voffB); PG8_STAGE(PG8_SA(0, 0), cA, voffA); PG8_STAGE(PG8_SA(0, 1), cA + hstep, voffA);
        E.begin(lds, S, tid);
        if (wr == 1) PG8_BAR;
        PG8_WAIT_V(2); PG8_BAR;
        PG8_STAGE(PG8_SB(1, 0), cB + kstep, voffB); PG8_STAGE(PG8_SA(1, 0), cA + kstep, voffA); PG8_STAGE(PG8_SB(1, 1), cB + hstep + kstep, voffB);
        PG8_WAIT_V(6); PG8_BAR;
    } else {
        PG8_STAGE(PG8_SB(0, 0), cB, voffB); PG8_STAGE(PG8_SA(0, 0), cA, voffA); PG8_STAGE(PG8_SB(0, 1), cB + hstep, voffB); PG8_STAGE(PG8_SA(0, 1), cA + hstep, voffA);
        E.begin(lds, S, tid);
        if (wr == 1) PG8_BAR;
        PG8_WAIT_V(4); PG8_BAR;
        PG8_STAGE(PG8_SB(1, 0), cB + kstep, voffB); PG8_STAGE(PG8_SA(1, 0), cA + kstep, voffA); PG8_STAGE(PG8_SB(1, 1), cB + hstep + kstep, voffB);
        PG8_WAIT_V(6); PG8_BAR;
    }
    for (;;) {
        const bool has_next = S.next(ui + 1, nxt);
        const char* nA = has_next ? (const char*)g.A + (size_t)nxt.pm * tstep : cA; const char* nB = has_next ? (const char*)g.Bt + (size_t)nxt.pn * tstep : cB;
        for (int t = 0; t < nt; t += 2) {
            const bool last = (t == nt - 2);
            const char* a1 = cA + (size_t)(t + 1) * kstep;
            const char* a2 = last ? nA : cA + (size_t)(t + 2) * kstep; const char* b2 = last ? nB : cB + (size_t)(t + 2) * kstep;
            const char* a3 = a2 + kstep; const char* b3 = b2 + kstep;
            if (last && has_next) S.a_ready(nxt);
            if constexpr (SP2) {
            PG8_LDB(B0, 0, 0); PG8_LDB(B1, 0, 1); PG8_SCHED; PG8_LDA(At, 0, 0); PG8_STAGE(PG8_SA(1, 1), a1 + hstep, voffA);
            PG8_WAIT_V(8); PG8_WAIT_L(0); PG8_BAR; PG8_MMA(0, 0, At, B0); PG8_MMA(0, 1, At, B1); PG8_BAR; PG8_SCHED;
            PG8_LDA(At, 0, 1); PG8_STAGE(PG8_SB(0, 0), b2, voffB); PG8_STAGE(PG8_SB(0, 1), b2 + hstep, voffB); PG8_STAGE(PG8_SA(0, 0), a2, voffA);
            PG8_WAIT_V(8); PG8_WAIT_L(0); PG8_BAR; PG8_MMA(1, 0, At, B0); PG8_MMA(1, 1, At, B1); PG8_BAR; PG8_SCHED;
            PG8_LDB(B0, 1, 0); PG8_LDB(B1, 1, 1); PG8_SCHED; PG8_LDA(At, 1, 0); PG8_STAGE(PG8_SA(0, 1), a2 + hstep, voffA);
            PG8_WAIT_V(8); PG8_WAIT_L(0); PG8_BAR; PG8_MMA(0, 0, At, B0); PG8_MMA(0, 1, At, B1); PG8_BAR; PG8_SCHED;
            PG8_LDA(At, 1, 1); PG8_STAGE(PG8_SB(1, 0), b3, voffB); PG8_STAGE(PG8_SB(1, 1), b3 + hstep, voffB); PG8_STAGE(PG8_SA(1, 0), a3, voffA);
            PG8_WAIT_V(8); PG8_WAIT_L(0); PG8_BAR; PG8_MMA(1, 0, At, B0); PG8_MMA(1, 1, At, B1); PG8_BAR; PG8_SCHED;
            } else {
            PG8_LDB(B0, 0, 0); PG8_SCHED; PG8_LDA(At, 0, 0); PG8_STAGE(PG8_SA(1, 1), a1 + hstep, voffA);
            PG8_WAIT_L(8); PG8_BAR; PG8_WAIT_L(0); PG8_MMA(0, 0, At, B0); PG8_BAR; PG8_SCHED;
            PG8_LDB(B1, 0, 1); PG8_STAGE(PG8_SB(0, 0), b2, voffB);
            PG8_BAR; PG8_WAIT_L(0); PG8_MMA(0, 1, At, B1); PG8_BAR;
            PG8_LDA(At, 0, 1); PG8_STAGE(PG8_SA(0, 0), a2, voffA);
            PG8_BAR; PG8_WAIT_L(0); PG8_MMA(1, 0, At, B0); PG8_BAR; PG8_SCHED;
            PG8_STAGE(PG8_SB(0, 1), b2 + hstep, voffB);
            PG8_WAIT_V(6); PG8_BAR; PG8_MMA(1, 1, At, B1); PG8_BAR;
            PG8_LDB(B0, 1, 0); PG8_SCHED; PG8_LDA(At, 1, 0); PG8_STAGE(PG8_SA(0, 1), a2 + hstep, voffA);
            PG8_WAIT_L(8); PG8_BAR; PG8_WAIT_L(0); PG8_MMA(0, 0, At, B0); PG8_BAR; PG8_SCHED;
            PG8_LDB(B1, 1, 1); PG8_STAGE(PG8_SB(1, 0), b3, voffB);
            PG8_BAR; PG8_WAIT_L(0); PG8_MMA(0, 1, At, B1); PG8_BAR;
            PG8_LDA(At, 1, 1); PG8_STAGE(PG8_SA(1, 0), a3, voffA);
            PG8_BAR; PG8_WAIT_L(0); PG8_MMA(1, 0, At, B0); PG8_BAR; PG8_SCHED;
            PG8_STAGE(PG8_SB(1, 1), b3 + hstep, voffB);
            PG8_WAIT_V(6); PG8_BAR; PG8_MMA(1, 1, At, B1); PG8_BAR;
            }
        }
        if constexpr (ALIGN_EPI) { if (wr == 0) PG8_BAR; }
        if constexpr (!Epi::AFTER_DRAIN) { E(acc, cur, wr, wc, fr, fq, ui); if constexpr (Epi::DUP) { asm volatile("" ::: "memory"); if (E.scratch) { Epi E2 = E; E2.set_probe(); E2(acc, cur, wr, wc, fr, fq, ui); } } S.done(cur); }
        if (!has_next) break;
#pragma unroll
        for (int a = 0; a < 2; ++a)
#pragma unroll
            for (int b = 0; b < 2; ++b)
#pragma unroll
                for (int m = 0; m < 4; ++m)
#pragma unroll
                    for (int n = 0; n < 2; ++n) acc[a][b][m][n] = (f32x4){0.f, 0.f, 0.f, 0.f};
        cur = nxt; cA = nA; cB = nB; ++ui;
        if constexpr (ALIGN_EPI) { if (wr == 1) PG8_BAR; }
    }
    PG8_WAIT_V(0);
    if constexpr (!ALIGN_EPI) { if (wr == 0) PG8_BAR; }
    PG8_BAR;
    if constexpr (Epi::AFTER_DRAIN) { E.fused(acc, cur, wr, wc, fr, fq, lds, wid, lane); S.done(cur); }
#undef PG8_SA
#undef PG8_SB
#undef PG8_STAGE
#undef PG8_LDA
#undef PG8_LDB
#undef PG8_MMA
#undef PG8_WAIT_V
#undef PG8_WAIT_L
#undef PG8_BAR
#undef PG8_SCHED
}
}

constexpr int BATCH = 4, SEQ = 4096, DM = 1024, MROWS = BATCH * SEQ;
constexpr int CE = 2048, CN = 4 * CE;
constexpr int NH = 16, HD = 64, NG = 3, QKVC = 9216, AN = 10240;
constexpr float EPS = 1e-6f, LOG2E = 1.4426950408889634f, QSCALE = 0.125f * LOG2E;
constexpr int NPHASE = 17;

constexpr size_t MiB = 1u << 20;
constexpr size_t WS_CTL = 0, CTL_ZERO_BYTES = 32768;
constexpr size_t WS_SSQ = 1 * MiB;
constexpr size_t WS_W1 = 2 * MiB, WS_W2 = 18 * MiB, WS_W3 = 22 * MiB, WS_W4 = 42 * MiB;
constexpr size_t WS_LSE = 44 * MiB;
constexpr size_t WS_BIAS = 47 * MiB;
constexpr size_t WS_XB = 48 * MiB;
constexpr size_t WS_QO = 80 * MiB;
constexpr size_t WS_CG = 112 * MiB;
constexpr size_t WS_KA = 176 * MiB, WS_VA = 208 * MiB, WS_KB = 240 * MiB, WS_VB = 272 * MiB;
constexpr size_t WS_Y = WS_KA;
constexpr size_t WS_SIDE = 304 * MiB;
constexpr size_t WS_END = 307 * MiB;
constexpr int CW_TMO = 0, CW_BAR = 4096;

#define GAS __attribute__((address_space(1)))
#define LAS __attribute__((address_space(3)))
typedef unsigned short bf16;
typedef unsigned v4u __attribute__((ext_vector_type(4)));
typedef unsigned v2u __attribute__((ext_vector_type(2)));
typedef float f32x4 __attribute__((ext_vector_type(4)));
typedef short bf16x8 __attribute__((ext_vector_type(8)));
typedef GAS unsigned gu32;
#define RLX_AGENT __ATOMIC_RELAXED, __HIP_MEMORY_SCOPE_AGENT
#define LDS_WAIT() asm volatile("s_waitcnt lgkmcnt(0)" ::: "memory")
#define VM_WAIT() asm volatile("s_waitcnt vmcnt(0)" ::: "memory")
__device__ __forceinline__ unsigned f2bf(float f) { unsigned u = __builtin_bit_cast(unsigned, f); return (u + 0x7fffu + ((u >> 16) & 1u)) >> 16; }
typedef float f32x2_t __attribute__((ext_vector_type(2))); typedef __bf16 bf16x2_t __attribute__((ext_vector_type(2)));
__device__ __forceinline__ unsigned pk2(float lo, float hi) { f32x2_t v = {lo, hi}; bf16x2_t b = __builtin_convertvector(v, bf16x2_t); return __builtin_bit_cast(unsigned, b); }
#ifndef ST_WT
#define ST_WT 0
#endif
#ifndef ST_NT
#define ST_NT 0
#endif
__device__ __forceinline__ void st16(void* p, v4u v) {
#if ST_WT
    asm volatile("global_store_dwordx4 %0, %1, off sc1\n\ts_nop 1" :: "v"(p), "v"(v) : "memory");
#elif ST_NT
    __builtin_nontemporal_store(v, (v4u*)p);
#else
    *(v4u*)p = v;
#endif
}
__device__ __forceinline__ size_t hm_row(int row  , int h, int sh) {
    const int b = row >> 12, t = row & 4095, p = ((t & ((1 << sh) - 1)) << (12 - sh)) | (t >> sh);
    return ((size_t)((b * 16 + h) * 4096 + p)) * 64;
}
__device__ __forceinline__ float bf2f(unsigned h) { return __builtin_bit_cast(float, h << 16); }
__device__ __forceinline__ float bflo(unsigned w) { return __builtin_bit_cast(float, w << 16); }
__device__ __forceinline__ float bfhi(unsigned w) { return __builtin_bit_cast(float, w & 0xffff0000u); }
__device__ __forceinline__ float sigmoidf_(float z) { return __builtin_amdgcn_rcpf(1.0f + __builtin_amdgcn_exp2f(-z * LOG2E)); }
__device__ __forceinline__ float row_rs(const float* ssq, int row) {
    const f32x4* p = (const f32x4*)(ssq + (size_t)row * 16);
    const f32x4 s = (p[0] + p[1]) + (p[2] + p[3]);
    return 1.0f / sqrtf(((s.x + s.y) + (s.z + s.w)) * (1.0f / DM) + EPS);
}
__device__ __forceinline__ float wave_sum(float v) {
#pragma unroll
    for (int o = 1; o < 64; o <<= 1) v += __shfl_xor(v, o);
    return v;
}
__device__ __forceinline__ int t5_bucket(int d) {
    if (d < 16) return d;
    int b = 15;
    b += (d >= 16); b += (d >= 22); b += (d >= 30); b += (d >= 40); b += (d >= 54); b += (d >= 73); b += (d >= 99); b += (d >= 134);
    b += (d >= 182); b += (d >= 246); b += (d >= 332); b += (d >= 450); b += (d >= 609); b += (d >= 825); b += (d >= 1117); b += (d >= 1513);
    return b;
}

#define XB_TMO      128
#define XB_XCNT(j)  (256  + 64 * (j))
#define XB_XSUB(j)  (1280 + 64 * (j))
#define XB_XGEN(j)  (2304 + 64 * (j))
#define XB_TOP      3328
#define XB_TOPGEN   3392
#define XCD_BAR_WORDS 3456
#define XB_SPIN_CAP (1u << 18)
#ifndef XB_SLEEP
#define XB_SLEEP 0
#endif

__device__ __forceinline__ unsigned xb_ld(unsigned* p)              { return __hip_atomic_load(p, __ATOMIC_RELAXED, __HIP_MEMORY_SCOPE_AGENT); }
__device__ __forceinline__ unsigned xb_add(unsigned* p, unsigned v) { return __hip_atomic_fetch_add(p, v, __ATOMIC_RELAXED, __HIP_MEMORY_SCOPE_AGENT); }
__device__ __forceinline__ unsigned xb_xcc_id() { return (unsigned)__builtin_amdgcn_s_getreg((3 << 11) | 20) & 0xFu; }
#define XB_SPIN(cond, bar) do { unsigned _sp = 0; while (cond) { __builtin_amdgcn_s_sleep(XB_SLEEP); \
    if ((++_sp & 255u) == 0u) { if (xb_ld(&(bar)[XB_TMO])) break; if (_sp > XB_SPIN_CAP) { atomicAdd(&(bar)[XB_TMO], 1u); break; } } } } while (0)

struct XcdBarrier {
    unsigned* bar; unsigned x;
    volatile LAS unsigned* st;
};

__device__ __forceinline__ XcdBarrier xcd_barrier_post(unsigned* bar, volatile LAS unsigned* st) {
    XcdBarrier b; b.bar = bar; b.x = xb_xcc_id(); b.st = st;
    if (threadIdx.x == 0) (void)xb_add(&bar[XB_XCNT(b.x)], 1u);
    return b;
}
__device__ __forceinline__ void xcd_barrier_complete(unsigned* bar, unsigned x, unsigned& nloc, unsigned& nx) {
    const unsigned G = gridDim.x * gridDim.y * gridDim.z;
    unsigned sum, cnt, mine, sp = 0u;
    for (;;) {
        sum = 0u; cnt = 0u; mine = 0u;
#pragma unroll
        for (unsigned j = 0; j < 16; ++j) { const unsigned c = xb_ld(&bar[XB_XCNT(j)]); sum += c; cnt += (c > 0u) ? 1u : 0u; mine = (j == x) ? c : mine; }
        if (sum == G) break;
        __builtin_amdgcn_s_sleep(1);
        if ((++sp & 255u) == 0u) { if (xb_ld(&bar[XB_TMO])) break; if (sp > XB_SPIN_CAP) { atomicAdd(&bar[XB_TMO], 1u); break; } }
    }
    nloc = mine > 0u ? mine : 1u; nx = cnt > 0u ? cnt : 1u;
}

__device__ __forceinline__ void xcd_barrier(const XcdBarrier& b) {
    asm volatile("s_waitcnt vmcnt(0)" ::: "memory");
    __syncthreads();
    if (threadIdx.x == 0) {
        unsigned* bar = b.bar;
        __builtin_amdgcn_s_waitcnt(0);
        unsigned nloc = b.st[0], nx = b.st[1];
        if (nloc == 0u) { xcd_barrier_complete(bar, b.x, nloc, nx); b.st[0] = nloc; b.st[1] = nx; }
        const unsigned old = xb_add(&bar[XB_XSUB(b.x)], 1u);
        const unsigned gen = old / nloc;
        if (old + 1u == (gen + 1u) * nloc) {
            __builtin_amdgcn_fence(__ATOMIC_RELEASE, "agent");
            asm volatile("s_waitcnt vmcnt(0)" ::: "memory");
            const unsigned og = xb_add(&bar[XB_TOP], 1u);
            const unsigned tg = og / nx;
            if (og + 1u == (tg + 1u) * nx) xb_add(&bar[XB_TOPGEN], 1u);
            else XB_SPIN(xb_ld(&bar[XB_TOPGEN]) == tg, bar);
            __builtin_amdgcn_fence(__ATOMIC_ACQUIRE, "agent");
            xb_add(&bar[XB_XGEN(b.x)], 1u);
            asm volatile("s_waitcnt vmcnt(0)" ::: "memory");
        } else {
            XB_SPIN(xb_ld(&bar[XB_XGEN(b.x)]) == gen, bar);
            __builtin_amdgcn_fence(__ATOMIC_ACQUIRE, "agent");
            asm volatile("s_waitcnt vmcnt(0)" ::: "memory");
        }
    }
    __syncthreads();
}

#ifndef EP_NT
#define EP_NT 0
#endif
#if EP_NT
#define EP_LD(p) __builtin_nontemporal_load(p)
#else
#define EP_LD(p) (*(p))
#endif
#ifndef DUP_EPI
#define DUP_EPI 0
#endif
namespace epi {
using pg8::Unit; using pg8::bf16_t;

__device__ __forceinline__ void rows_rs(const float* ssq, int row0  , int fq, float (&rs)[2][4]) {
    f32x4 pp[2][4];
#pragma unroll
    for (int ai = 0; ai < 2; ++ai)
#pragma unroll
        for (int m = 0; m < 4; ++m) pp[ai][m] = *(const f32x4*)(ssq + (size_t)(row0 + ai * 128 + m * 16) * 16 + 4 * fq);
#pragma unroll
    for (int ai = 0; ai < 2; ++ai)
#pragma unroll
        for (int m = 0; m < 4; ++m) { float t = (pp[ai][m][0] + pp[ai][m][1]) + (pp[ai][m][2] + pp[ai][m][3]); t += __shfl_xor(t, 16); t += __shfl_xor(t, 32); rs[ai][m] = __builtin_amdgcn_rsqf(t * (1.0f / DM) + EPS); }
}
struct ConvIn {
    static constexpr bool PERM = false, AFTER_DRAIN = false, DUP = (DUP_EPI != 0);
    const float* ssq; bf16_t* V; bf16_t* G;
    template <class Sched> __device__ __forceinline__ void begin(LAS unsigned char*, const Sched&, int) const {}
    __device__ __forceinline__ void operator()(const f32x4 (&acc)[2][2][4][2], const Unit& u, int wr, int wc, int fr, int fq, int) const {
        const int ch0 = u.pn * 64 + wc * 16 + 4 * fq;
        float rsv[2][4]; rows_rs(ssq, u.pm * 256 + wr * 64 + fr, fq, rsv);
#pragma unroll
        for (int ai = 0; ai < 2; ++ai)
#pragma unroll
            for (int m = 0; m < 4; ++m) {
                const int row = u.pm * 256 + ai * 128 + wr * 64 + m * 16 + fr;
                const float rs = rsv[ai][m];
                const f32x4 b = acc[ai][0][m][0] * rs, c = acc[ai][0][m][1] * rs, uu = acc[ai][1][m][0] * rs, z = acc[ai][1][m][1] * rs;
                const f32x4 v = c * uu;
                f32x4 g;
#pragma unroll
                for (int i = 0; i < 4; ++i) g[i] = b[i] * z[i] * sigmoidf_(z[i]);
                v2u wv, wg; wv.x = pk2(v[0], v[1]); wv.y = pk2(v[2], v[3]); wg.x = pk2(g[0], g[1]); wg.y = pk2(g[2], g[3]);
                *(v2u*)(V + (size_t)row * CE + ch0) = wv;
                *(v2u*)(G + (size_t)row * CE + ch0) = wg;
            }
    }
};


constexpr int RSTAB_OFF = 152832, GTAB_OFF = 161024;
template <class Sched> __device__ __forceinline__ void fill_rstab(LAS unsigned char* lds, const float* ssq, const Sched& S, int tid) {
    LAS float* tab = (LAS float*)(lds + RSTAB_OFF);
    Unit u;
    for (int i = tid >> 8; i < 8 && S.next(i, u); i += 2) {
        const f32x4* p = (const f32x4*)(ssq + (size_t)(u.pm * 256 + (tid & 255)) * 16);
        const f32x4 s = (p[0] + p[1]) + (p[2] + p[3]);
        tab[i * 256 + (tid & 255)] = __builtin_amdgcn_rsqf(((s[0] + s[1]) + (s[2] + s[3])) * (1.0f / DM) + EPS);
    }
}
__device__ __forceinline__ void tab_rs(LAS unsigned char* lds, int ui, int wr, int fr, float (&rs)[2][4]) {
    const LAS float* tab = (const LAS float*)(lds + RSTAB_OFF) + ui * 256 + wr * 64 + fr;
#pragma unroll
    for (int ai = 0; ai < 2; ++ai)
#pragma unroll
        for (int m = 0; m < 4; ++m) rs[ai][m] = tab[ai * 128 + m * 16];
}
struct ConvFused {
    static constexpr bool PERM = false, AFTER_DRAIN = false, DUP = false;
    const float* ssq; bf16_t* Y; const float* cw; float* side; LAS unsigned char* xch;
    static __device__ __forceinline__ f32x4 unpk(v2u p) { return (f32x4){bflo(p.x), bfhi(p.x), bflo(p.y), bfhi(p.y)}; }
    template <class Sched> __device__ __forceinline__ void begin(LAS unsigned char* lds, const Sched& S, int tid) const { fill_rstab(lds, ssq, S, tid); }
    __device__ __forceinline__ void operator()(const f32x4 (&acc)[2][2][4][2], const Unit& u, int wr, int wc, int fr, int fq, int ui) const {
        const int ch0 = u.pn * 64 + wc * 16 + 4 * fq;
        float rsv[2][4]; tab_rs(xch - 131072, ui, wr, fr, rsv);
        const f32x4 w0 = *(const f32x4*)(cw + ch0), w1 = *(const f32x4*)(cw + CE + ch0), w2 = *(const f32x4*)(cw + 2 * CE + ch0);
        v2u vq[2][4]; f32x4 gt[2][4];
#pragma unroll
        for (int ai = 0; ai < 2; ++ai)
#pragma unroll
            for (int m = 0; m < 4; ++m) {
                const float rs = rsv[ai][m];
                const f32x4 b = acc[ai][0][m][0] * rs, c = acc[ai][0][m][1] * rs, uu = acc[ai][1][m][0] * rs, z = acc[ai][1][m][1] * rs;
                const f32x4 v = c * uu;
                vq[ai][m].x = pk2(v[0], v[1]); vq[ai][m].y = pk2(v[2], v[3]);
#pragma unroll
                for (int i = 0; i < 4; ++i) gt[ai][m][i] = b[i] * z[i] * sigmoidf_(z[i]);
            }
        LAS unsigned char* my = xch + (wr * 4 + wc) * 2720 + fq * 8;
        LAS unsigned char* other = xch + ((1 - wr) * 4 + wc) * 2720 + fq * 8;
        const bool seq_start = (u.pm & 15) == 0;
        if (fr >= 14) {
            const int hr = fr - 14;
            *(LAS v2u*)(other + ((wr == 0 ? 0 : 66) + hr) * 40) = vq[0][3];
            if (wr == 0) *(LAS v2u*)(other + (66 + hr) * 40) = vq[1][3];
            else *(f32x4*)(side + ((size_t)u.pm * 6 + 4 + hr) * CE + ch0) = unpk(vq[1][3]);
        }
        if (wr == 0 && fr < 2) *(LAS v2u*)(my + fr * 40) = (v2u){0u, 0u};
#pragma unroll
        for (int m = 0; m < 4; ++m) *(LAS v2u*)(my + (2 + 16 * m + fr) * 40) = vq[0][m];
        asm volatile("s_waitcnt lgkmcnt(0)\n\ts_barrier" ::: "memory");
        v2u q1[2][4], q2[2][4];
#pragma unroll
        for (int m = 0; m < 4; ++m) { const int k = 16 * m + fr; q1[0][m] = *(const LAS v2u*)(my + (k + 1) * 40); q2[0][m] = *(const LAS v2u*)(my + k * 40); }
        asm volatile("" ::: "memory");
#pragma unroll
        for (int m = 0; m < 4; ++m) *(LAS v2u*)(my + (2 + 16 * m + fr) * 40) = vq[1][m];
        asm volatile("s_waitcnt lgkmcnt(0)" ::: "memory");
#pragma unroll
        for (int m = 0; m < 4; ++m) { const int k = 16 * m + fr; int r1 = k + 1, r2 = k; if (k < 1) r1 = 67; if (k < 2) r2 = 66 + k;
            q1[1][m] = *(const LAS v2u*)(my + r1 * 40); q2[1][m] = *(const LAS v2u*)(my + r2 * 40); }
#pragma unroll
        for (int ai = 0; ai < 2; ++ai)
#pragma unroll
            for (int m = 0; m < 4; ++m) {
                const int k = 16 * m + fr;
                const f32x4 p1 = unpk(q1[ai][m]), p2 = unpk(q2[ai][m]), v = unpk(vq[ai][m]);
                const f32x4 cv = w2 * v + w1 * p1 + w0 * p2;
                const f32x4 y = gt[ai][m] * cv;
                const int row = u.pm * 256 + ai * 128 + wr * 64 + k;
                v2u wy; wy.x = pk2(y[0], y[1]); wy.y = pk2(y[2], y[3]);
                *(v2u*)(Y + (size_t)row * CE + ch0) = wy;
                if (ai == 0 && m == 0 && wr == 0 && fr < 2 && !seq_start) {
                    *(f32x4*)(side + ((size_t)u.pm * 6 + fr) * CE + ch0) = gt[0][0];
                    *(f32x4*)(side + ((size_t)u.pm * 6 + 2 + fr) * CE + ch0) = cv;
                }
            }
    }
};
struct Resid {
    static constexpr bool PERM = false, AFTER_DRAIN = false, DUP = false;
    const float* xin; float* xout; bf16_t* xb; float* ssq;
    template <class Sched> __device__ __forceinline__ void begin(LAS unsigned char*, const Sched&, int) const {}
    __device__ __forceinline__ void operator()(const f32x4 (&acc)[2][2][4][2], const Unit& u, int wr, int wc, int fr, int fq, int) const {
        const int col0 = u.pn * 256 + wc * 32 + 4 * fq;
        const size_t off0 = (size_t)(u.pm * 256 + wr * 64 + fr) * DM + col0;
        f32x4 pre[4][2][2];
#pragma unroll
        for (int i = 0; i < 4; ++i)
#pragma unroll
            for (int bj = 0; bj < 2; ++bj)
#pragma unroll
                for (int n = 0; n < 2; ++n) pre[i][bj][n] = *(const f32x4*)(xin + off0 + (size_t)(16 * i) * DM + bj * 128 + n * 16);
#pragma unroll
        for (int i = 0; i < 8; ++i) {
            const int ai = i >> 2, m = i & 3;
            const size_t off = off0 + (size_t)(ai * 128 + m * 16) * DM;
            float ss = 0.f; f32x4 xn[2][2];
#pragma unroll
            for (int bj = 0; bj < 2; ++bj)
#pragma unroll
                for (int n = 0; n < 2; ++n) { xn[bj][n] = pre[i & 3][bj][n] + acc[ai][bj][m][n]; const f32x4 t = xn[bj][n]; ss += (t[0] * t[0] + t[1] * t[1]) + (t[2] * t[2] + t[3] * t[3]); }
            if (i < 4) {
#pragma unroll
                for (int bj = 0; bj < 2; ++bj)
#pragma unroll
                    for (int n = 0; n < 2; ++n) pre[i & 3][bj][n] = *(const f32x4*)(xin + off + (size_t)128 * DM + bj * 128 + n * 16);
            }
#pragma unroll
            for (int bj = 0; bj < 2; ++bj)
#pragma unroll
                for (int n = 0; n < 2; ++n) {
                    *(f32x4*)(xout + off + bj * 128 + n * 16) = xn[bj][n];
                    v2u w; w.x = pk2(xn[bj][n][0], xn[bj][n][1]); w.y = pk2(xn[bj][n][2], xn[bj][n][3]);
                    *(v2u*)(xb + off + bj * 128 + n * 16) = w;
                }
            ss += __shfl_xor(ss, 16); ss += __shfl_xor(ss, 32);
            if (fq == 0) ssq[(size_t)(u.pm * 256 + ai * 128 + wr * 64 + m * 16 + fr) * 16 + u.pn * 4 + wc] = ss;
        }
    }
};
template <int MODE> struct ResidB {
    static constexpr bool PERM = false, AFTER_DRAIN = false, DUP = false;
    const float* xin; float* xout; bf16_t* xb; float* ssq; bf16_t* xbw;
    template <class Sched> __device__ __forceinline__ void begin(LAS unsigned char*, const Sched&, int) const {}
    __device__ __forceinline__ void operator()(const f32x4 (&acc)[2][2][4][2], const Unit& u, int wr, int wc, int fr, int fq, int) const {
        const int col0 = u.pn * 256 + wc * 32 + 4 * fq;
        const size_t off0 = (size_t)(u.pm * 256 + wr * 64 + fr) * DM + col0;
        if constexpr (MODE == 0) {
            f32x4 pre[4][2][2];
#pragma unroll
            for (int i = 0; i < 4; ++i)
#pragma unroll
                for (int bj = 0; bj < 2; ++bj)
#pragma unroll
                    for (int n = 0; n < 2; ++n) pre[i][bj][n] = *(const f32x4*)(xin + off0 + (size_t)(16 * i) * DM + bj * 128 + n * 16);
#pragma unroll
            for (int i = 0; i < 8; ++i) {
                const int ai = i >> 2, m = i & 3;
                const size_t off = off0 + (size_t)(ai * 128 + m * 16) * DM;
                float ss = 0.f; f32x4 xn[2][2];
#pragma unroll
                for (int bj = 0; bj < 2; ++bj)
#pragma unroll
                    for (int n = 0; n < 2; ++n) { xn[bj][n] = pre[i & 3][bj][n] + acc[ai][bj][m][n]; const f32x4 t = xn[bj][n]; ss += (t[0] * t[0] + t[1] * t[1]) + (t[2] * t[2] + t[3] * t[3]); }
                if (i < 4) {
#pragma unroll
                    for (int bj = 0; bj < 2; ++bj)
#pragma unroll
                        for (int n = 0; n < 2; ++n) pre[i & 3][bj][n] = *(const f32x4*)(xin + off + (size_t)128 * DM + bj * 128 + n * 16);
                }
#pragma unroll
                for (int bj = 0; bj < 2; ++bj)
#pragma unroll
                    for (int n = 0; n < 2; ++n) { v2u w; w.x = pk2(xn[bj][n][0], xn[bj][n][1]); w.y = pk2(xn[bj][n][2], xn[bj][n][3]); *(v2u*)(xbw + off + bj * 128 + n * 16) = w; }
                ss += __shfl_xor(ss, 16); ss += __shfl_xor(ss, 32);
                if (fq == 0) ssq[(size_t)(u.pm * 256 + ai * 128 + wr * 64 + m * 16 + fr) * 16 + u.pn * 4 + wc] = ss;
            }
        } else {
            v2u pre[8][2][2];
#pragma unroll
            for (int i = 0; i < 8; ++i)
#pragma unroll
                for (int bj = 0; bj < 2; ++bj)
#pragma unroll
                    for (int n = 0; n < 2; ++n) pre[i][bj][n] = EP_LD((const v2u*)(xb + off0 + (size_t)((i >> 2) * 128 + (i & 3) * 16) * DM + bj * 128 + n * 16));
#pragma unroll
            for (int i = 0; i < 8; ++i) {
                const int ai = i >> 2, m = i & 3;
                const size_t off = off0 + (size_t)(ai * 128 + m * 16) * DM;
                float ss = 0.f;
#pragma unroll
                for (int bj = 0; bj < 2; ++bj)
#pragma unroll
                    for (int n = 0; n < 2; ++n) {
                        const v2u p = pre[i][bj][n];
                        const f32x4 t = (f32x4){bflo(p.x), bfhi(p.x), bflo(p.y), bfhi(p.y)} + acc[ai][bj][m][n];
                        if constexpr (MODE == 2) { *(f32x4*)(xout + off + bj * 128 + n * 16) = t; }
                        else { ss += (t[0] * t[0] + t[1] * t[1]) + (t[2] * t[2] + t[3] * t[3]); v2u w; w.x = pk2(t[0], t[1]); w.y = pk2(t[2], t[3]); *(v2u*)(xbw + off + bj * 128 + n * 16) = w; }
                    }
                if constexpr (MODE != 2) {
                    ss += __shfl_xor(ss, 16); ss += __shfl_xor(ss, 32);
                    if (fq == 0) ssq[(size_t)(u.pm * 256 + ai * 128 + wr * 64 + m * 16 + fr) * 16 + u.pn * 4 + wc] = ss;
                }
            }
        }
    }
};
struct QKV {
    static constexpr bool PERM = true, AFTER_DRAIN = false, DUP = (DUP_EPI != 0);
    const float* ssq; bf16_t* Q; bf16_t* K; bf16_t* Vv; const float* qg; const float* kg; LAS unsigned char* lds0; int sh; bf16_t* scratch = nullptr; bool probe = false;
    __device__ __forceinline__ void set_probe() { probe = true; }
    template <class Sched> __device__ __forceinline__ void begin(LAS unsigned char* lds, const Sched& S, int tid) const {
        fill_rstab(lds, ssq, S, tid);
        if (tid < 64) ((LAS float*)(lds + GTAB_OFF))[tid] = qg[tid] * kg[tid] * QSCALE;
    }
    __device__ __forceinline__ void operator()(const f32x4 (&acc)[2][2][4][2], const Unit& u, int wr, int wc, int fr, int fq, int ui) const {
        const int which = u.pn >> 2, h = (u.pn & 3) * 4 + wc;
        bf16_t* base = Q + (ptrdiff_t)(which == 1) * (K - Q) + (ptrdiff_t)(which == 2) * (Vv - Q);
        const LAS float* gp = (const LAS float*)(lds0 + GTAB_OFF);
        const f32x4 g00 = *(const LAS f32x4*)(gp + 8 * fq), g01 = *(const LAS f32x4*)(gp + 8 * fq + 4), g10 = *(const LAS f32x4*)(gp + 32 + 8 * fq), g11 = *(const LAS f32x4*)(gp + 32 + 8 * fq + 4);
        float rsv[2][4]; tab_rs(lds0, ui, wr, fr, rsv);
#pragma unroll
        for (int ai = 0; ai < 2; ++ai)
#pragma unroll
            for (int m = 0; m < 4; ++m) {
                const int row = u.pm * 256 + ai * 128 + wr * 64 + m * 16 + fr;
                const float rs = rsv[ai][m];
                float sc = rs;
                if (which < 2) {
                    f32x4 sq = acc[ai][0][m][0] * acc[ai][0][m][0];
                    sq = __builtin_elementwise_fma(acc[ai][0][m][1], acc[ai][0][m][1], sq); sq = __builtin_elementwise_fma(acc[ai][1][m][0], acc[ai][1][m][0], sq); sq = __builtin_elementwise_fma(acc[ai][1][m][1], acc[ai][1][m][1], sq);
                    float ss = (sq[0] + sq[1]) + (sq[2] + sq[3]);
                    ss += __shfl_xor(ss, 16); ss += __shfl_xor(ss, 32);
                    sc = rs * __builtin_amdgcn_rsqf(ss * (rs * rs * (1.0f / HD)) + EPS);
                }
#pragma unroll
                for (int bj = 0; bj < 2; ++bj) {
                    f32x4 a = acc[ai][bj][m][0] * sc, b = acc[ai][bj][m][1] * sc;
                    if (which == 0) { a = a * (bj == 0 ? g00 : g10); b = b * (bj == 0 ? g01 : g11); }
                    v4u w; w.x = pk2(a[0], a[1]); w.y = pk2(a[2], a[3]); w.z = pk2(b[0], b[1]); w.w = pk2(b[2], b[3]);
                    st16(base + hm_row(row, h, sh) + 32 * bj + 8 * fq, w);
                }
            }
    }
};
struct ZMerge {
    static constexpr bool PERM = true, AFTER_DRAIN = false, DUP = false;
    const float* ssq; const bf16_t* O0; const bf16_t* O1; const bf16_t* O2; const float* lse; bf16_t* Y; LAS unsigned char* lds0;
    struct RowIn { v4u a[2], b[2], c[2]; float l0, l1, l2; };
    __device__ __forceinline__ void load_row(RowIn& r, int row, int h, int fq) const {
        const size_t off0 = hm_row(row, h, 0) + 8 * fq, off1 = hm_row(row, h, 2) + 8 * fq, off2 = hm_row(row, h, 4) + 8 * fq;
        r.l0 = lse[((size_t)0 * MROWS + row) * 16 + h]; r.l1 = lse[((size_t)1 * MROWS + row) * 16 + h]; r.l2 = lse[((size_t)2 * MROWS + row) * 16 + h];
#pragma unroll
        for (int bj = 0; bj < 2; ++bj) { r.a[bj] = EP_LD((const v4u*)(O0 + off0 + 32 * bj)); r.b[bj] = EP_LD((const v4u*)(O1 + off1 + 32 * bj)); r.c[bj] = EP_LD((const v4u*)(O2 + off2 + 32 * bj)); }
    }
    template <class Sched> __device__ __forceinline__ void begin(LAS unsigned char* lds, const Sched& S, int tid) const { fill_rstab(lds, ssq, S, tid); }
    __device__ __forceinline__ void operator()(const f32x4 (&acc)[2][2][4][2], const Unit& u, int wr, int wc, int fr, int fq, int ui) const {
        const int h = u.pn * 4 + wc, row0 = u.pm * 256 + wr * 64 + fr;
        RowIn in[4];
        load_row(in[0], row0, h, fq); load_row(in[1], row0 + 16, h, fq);
        float rsv[2][4]; tab_rs(lds0, ui, wr, fr, rsv);
        v4u szp[2][4][2];
#pragma unroll
        for (int ai = 0; ai < 2; ++ai)
#pragma unroll
            for (int m = 0; m < 4; ++m)
#pragma unroll
                for (int bj = 0; bj < 2; ++bj) {
                    const f32x4 z0 = acc[ai][bj][m][0] * rsv[ai][m], z1 = acc[ai][bj][m][1] * rsv[ai][m];
                    float s[8];
#pragma unroll
                    for (int k = 0; k < 4; ++k) { s[k] = z0[k] * sigmoidf_(z0[k]); s[4 + k] = z1[k] * sigmoidf_(z1[k]); }
                    szp[ai][m][bj] = (v4u){pk2(s[0], s[1]), pk2(s[2], s[3]), pk2(s[4], s[5]), pk2(s[6], s[7])};
                }
        load_row(in[2], row0 + 32, h, fq); load_row(in[3], row0 + 48, h, fq);
#pragma unroll
        for (int i = 0; i < 8; ++i) {
            const int ai = i >> 2, m = i & 3, row = row0 + ai * 128 + m * 16;
            const RowIn& r = in[i & 3];
            const float mx = fmaxf(r.l0, fmaxf(r.l1, r.l2));
            float w0 = __builtin_amdgcn_exp2f(r.l0 - mx), w1 = __builtin_amdgcn_exp2f(r.l1 - mx), w2 = __builtin_amdgcn_exp2f(r.l2 - mx);
            const float inv = __builtin_amdgcn_rcpf(w0 + w1 + w2); w0 *= inv; w1 *= inv; w2 *= inv;
#pragma unroll
            for (int bj = 0; bj < 2; ++bj) {
                const v4u a = r.a[bj], b = r.b[bj], c = r.c[bj], sp = szp[ai][m][bj];
                v4u w;
#pragma unroll
                for (int k = 0; k < 4; ++k) {
                    const float ol = w0 * bflo(a[k]) + w1 * bflo(b[k]) + w2 * bflo(c[k]), oh = w0 * bfhi(a[k]) + w1 * bfhi(b[k]) + w2 * bfhi(c[k]);
                    w[k] = pk2(ol * bflo(sp[k]), oh * bfhi(sp[k]));
                }
                st16(Y + (size_t)row * DM + h * HD + 32 * bj + 8 * fq, w);
            }
            if (i + 4 < 8) load_row(in[i & 3], row0 + 128 + m * 16, h, fq);
        }
    }
};
}

#ifndef P0_NT
#define P0_NT 0
#endif
#if P0_NT
#define P0_LD(p) __builtin_nontemporal_load(p)
#else
#define P0_LD(p) (*(p))
#endif
template <int MODE> __device__ __forceinline__ int wt_dest_row(int n) {
    if (MODE == 1) { const int type = n >> 11, e = n & 2047, pn = e >> 6, el = e & 63; return 256 * pn + 128 * (type >> 1) + 32 * (el >> 4) + 16 * (type & 1) + (el & 15); }
    if (MODE == 3) { const int blk = n >> 10, r = n & 1023, h = r >> 6, d = r & 63; return blk * 1024 + 256 * (h >> 2) + 128 * (d >> 5) + 32 * (h & 3) + (d & 31); }
    return n;
}
template <int MODE> __device__ __forceinline__ void p0_transpose_item(const float* W, int K, int N, const float* scale, bf16* WT, LAS float* scr  , int item, int lane) {
    const int nblk = N / 64, kb = item / nblk, nb = item % nblk, k0 = 64 * kb, n0 = 64 * nb;
    const int kr = lane >> 4, c4 = lane & 15;
    f32x4 v[16];
#pragma unroll
    for (int i = 0; i < 16; ++i) v[i] = P0_LD((const GAS f32x4*)(W + (size_t)(k0 + 4 * i + kr) * N + n0 + 4 * c4));
#pragma unroll
    for (int i = 0; i < 16; ++i) { const float s = scale ? scale[k0 + 4 * i + kr] : 1.0f; LAS float* d = scr + (4 * i + kr) * 65 + 4 * c4;
        d[0] = v[i][0] * s; d[1] = v[i][1] * s; d[2] = v[i][2] * s; d[3] = v[i][3] * s; }
    LDS_WAIT(); asm volatile("" ::: "memory");
    const int c = lane & 7, nl = lane >> 3;
#pragma unroll
    for (int j = 0; j < 8; ++j) { const int n = nl + 8 * j; const LAS float* s = scr + (8 * c) * 65 + n;
        v4u o; o.x = pk2(s[0 * 65], s[1 * 65]); o.y = pk2(s[2 * 65], s[3 * 65]); o.z = pk2(s[4 * 65], s[5 * 65]); o.w = pk2(s[6 * 65], s[7 * 65]);
        *(GAS v4u*)(WT + (size_t)wt_dest_row<MODE>(n0 + n) * K + k0 + 8 * c) = o; }
    LDS_WAIT(); asm volatile("" ::: "memory");
}
struct Ptrs {
    const float *x, *conv_norm, *conv_w_in, *conv_w, *conv_w_out, *attn_norm, *attn_w_in, *q_gain, *k_gain, *attn_w_out, *rel_bias;
    float* out; unsigned char* ws;
};
template <int PART> __device__ __forceinline__ void p0_weights(const Ptrs& P, int j, LAS unsigned char* lds, int vcu, int G, int wave, int lane) {
    LAS float* scr = (LAS float*)(lds + wave * 16640);
    const int gw = vcu * 8 + wave, NGW = G * 8;
    bf16* W1 = (bf16*)(P.ws + WS_W1); bf16* W2 = (bf16*)(P.ws + WS_W2); bf16* W3 = (bf16*)(P.ws + WS_W3); bf16* W4 = (bf16*)(P.ws + WS_W4);
    constexpr int I1 = (DM / 64) * (CN / 64), I2 = (CE / 64) * (DM / 64), I3 = (DM / 64) * (AN / 64), I4 = (DM / 64) * (DM / 64);
    if constexpr (PART == 0) {
        for (int it = gw; it < I1; it += NGW) p0_transpose_item<1>(P.conv_w_in + (size_t)j * DM * CN, DM, CN, P.conv_norm + j * DM, W1, scr, it, lane);
    } else {
        for (int it = gw; it < I2 + I3 + I4; it += NGW) {
            int r = it;
            if (r < I2) { p0_transpose_item<0>(P.conv_w_out + (size_t)j * CE * DM, CE, DM, nullptr, W2, scr, r, lane); continue; } r -= I2;
            if (r < I3) { p0_transpose_item<3>(P.attn_w_in + (size_t)j * DM * AN, DM, AN, P.attn_norm + j * DM, W3, scr, r, lane); continue; } r -= I3;
            p0_transpose_item<0>(P.attn_w_out + (size_t)j * DM * DM, DM, DM, nullptr, W4, scr, r, lane);
        }
    }
}
__device__ __forceinline__ void p0_prologue(const Ptrs& P, LAS unsigned char* lds, int vcu, int G, int wave, int lane, int tid) {
    p0_weights<0>(P, 0, lds, vcu, G, wave, lane);
    const int gw = vcu * 8 + wave, NGW = G * 8;
    bf16* XB = (bf16*)(P.ws + WS_XB); float* SSQ = (float*)(P.ws + WS_SSQ);
    for (int m = 2 * gw; m < MROWS; m += 2 * NGW) {
        const GAS f32x4* xr = (const GAS f32x4*)(P.x + (size_t)m * DM) + lane;
        GAS v2u* o8 = (GAS v2u*)(XB + (size_t)m * DM) + lane;
        f32x4 v[8];
#pragma unroll
        for (int jj = 0; jj < 8; ++jj) v[jj] = P0_LD(xr + 64 * jj);
        float s0 = 0.f, s1 = 0.f;
#pragma unroll
        for (int jj = 0; jj < 8; ++jj) { const f32x4 t = v[jj]; const float q = (t.x * t.x + t.y * t.y) + (t.z * t.z + t.w * t.w); if (jj < 4) s0 += q; else s1 += q;
            v2u w; w.x = pk2(t.x, t.y); w.y = pk2(t.z, t.w); o8[64 * jj] = w; }
        s0 = wave_sum(s0); s1 = wave_sum(s1);
        if (lane < 32) SSQ[(size_t)m * 16 + lane] = lane == 0 ? s0 : (lane == 16 ? s1 : 0.f);
    }
    float* BT = (float*)(P.ws + WS_BIAS);
    for (int i = vcu * 512 + tid; i < NG * NH * 132; i += G * 512) {
        const int g = i / (NH * 132), r = i % (NH * 132), h = r / 132, st = r % 132;
        const int dil = g == 0 ? 1 : (g == 1 ? 4 : 16);
        BT[i] = st <= 128 ? P.rel_bias[t5_bucket(st * dil) * (NG * NH) + g * NH + h] * LOG2E : 0.f;
    }
}
__device__ __forceinline__ void conv_fixup(bf16* Y, const float* side, const float* cw, int pm, int tid) {
    if ((pm & 15) == 0) return;
    const int ch = 4 * tid;
    const f32x4 g0 = *(const f32x4*)(side + ((size_t)pm * 6 + 0) * CE + ch), g1 = *(const f32x4*)(side + ((size_t)pm * 6 + 1) * CE + ch);
    const f32x4 c0 = *(const f32x4*)(side + ((size_t)pm * 6 + 2) * CE + ch), c1 = *(const f32x4*)(side + ((size_t)pm * 6 + 3) * CE + ch);
    const f32x4 va = *(const f32x4*)(side + ((size_t)(pm - 1) * 6 + 4) * CE + ch), vb = *(const f32x4*)(side + ((size_t)(pm - 1) * 6 + 5) * CE + ch);
    const f32x4 w0 = *(const f32x4*)(cw + ch), w1 = *(const f32x4*)(cw + CE + ch);
    const f32x4 y0 = g0 * (c0 + w1 * vb + w0 * va), y1 = g1 * (c1 + w0 * vb);
    v2u a, b; a.x = pk2(y0[0], y0[1]); a.y = pk2(y0[2], y0[3]); b.x = pk2(y1[0], y1[1]); b.y = pk2(y1[2], y1[3]);
    *(v2u*)(Y + (size_t)(pm * 256) * CE + ch) = a; *(v2u*)(Y + (size_t)(pm * 256 + 1) * CE + ch) = b;
}

namespace attn {
typedef float f32x16 __attribute__((ext_vector_type(16)));
typedef short s16x4 __attribute__((ext_vector_type(4)));
typedef short v4i16_t __attribute__((ext_vector_type(4)));
constexpr int L_K = 0, L_V0 = 49152, L_VSZ = 49152, L_T = 147456, L_END = 148480;
__device__ __forceinline__ int crow(int r, int hi) { return (r & 3) + 8 * (r >> 2) + 4 * hi; }
__device__ __forceinline__ s16x4 vtr(LAS const unsigned char* p) { return __builtin_bit_cast(s16x4, __builtin_amdgcn_ds_read_tr16_b64_v4i16((LAS v4i16_t*)p)); }
__device__ __forceinline__ float swapmax(float m) { auto rr = __builtin_amdgcn_permlane32_swap(__float_as_uint(m), __float_as_uint(m), false, false); return fmaxf(__uint_as_float(rr[0]), __uint_as_float(rr[1])); }
__device__ __forceinline__ float swapsum(float m) { auto rr = __builtin_amdgcn_permlane32_swap(__float_as_uint(m), __float_as_uint(m), false, false); return __uint_as_float(rr[0]) + __uint_as_float(rr[1]); }
#define ATT_BAR() asm volatile("s_waitcnt lgkmcnt(0)\n\ts_barrier" ::: "memory")
template <int DIL> struct Job {
    int bh, c, n0, h; size_t rowb, base;
    __device__ __forceinline__ void decode(int id) { constexpr int CPC = (SEQ / DIL) / 256; bh = id >> 4; const int sub = id & 15; c = sub / CPC; n0 = (sub % CPC) * 256; h = bh & 15; rowb = (size_t)(bh >> 4) * SEQ;
        base = ((size_t)bh * SEQ + (size_t)c * (SEQ / DIL)) * HD; }
};
__device__ __forceinline__ void glds16s(unsigned voff, const void* sbase, unsigned lds_dst) { unsigned keep;
    asm volatile("s_mov_b32 %0, m0\n\ts_mov_b32 m0, %2\n\ts_nop 0\n\tglobal_load_lds_dwordx4 %1, %3 nt\n\ts_mov_b32 m0, %0" : "=&s"(keep) : "v"(voff), "s"(lds_dst), "s"(sbase) : "memory"); }
template <int DIL, bool ISV> __device__ __forceinline__ void issue_kv(LAS unsigned char* lds, int dst_off, const bf16* src, const Job<DIL>& J, int w, int lane) {
    const int r8 = lane >> 3, pc = lane & 7;
    const bf16* sbase = src + J.base;
    const int pos0 = J.n0 - 128 + w * 48 + r8;
    const int swE = ISV ? ((((pc >> 2) ^ ((r8 >> 1) & 1)) * 64) + (pc & 3) * 16) : ((pc ^ (r8 >> 1)) * 16);
    const int swO = ISV ? swE : ((pc ^ (4 + (r8 >> 1))) * 16);
#pragma unroll
    for (int i = 0; i < 6; ++i) {
        int pos = pos0 + 8 * i; pos = pos < 0 ? 0 : pos;
        const unsigned voff = (unsigned)(pos * 128 + ((i & 1) ? swO : swE));
        glds16s(voff, sbase, (unsigned)__builtin_amdgcn_readfirstlane((int)((unsigned)(uintptr_t)lds + dst_off + (w * 6 + i) * 1024)));
    }
}
__device__ __forceinline__ void ld16_asm(bf16x8& dst, const bf16* p) { asm volatile("global_load_dwordx4 %0, %1, off" : "=v"(dst) : "v"(p) : "memory"); }

template <int DIL> __device__ __forceinline__ void phase(LAS unsigned char* lds, const bf16* QO, bf16* OUT, const bf16* Kg, const bf16* Vg, const float* biasT  , float* lse  , int vcu, int G, int jlo = 0, int jhi = 4) {
    const int tid = threadIdx.x, lane = tid & 63, r32 = lane & 31, hi = lane >> 5;
    const int w = __builtin_amdgcn_readfirstlane(tid >> 6);
    constexpr int NJS = BATCH * NH * 16;
    int id = vcu * 4 + jlo;
    if (id >= NJS || jlo >= jhi) return;
    Job<DIL> J; J.decode(id);
    bf16x8 q0, q1, q2, q3;
    int vcur = L_V0;
    issue_kv<DIL, false>(lds, L_K, Kg, J, w, lane);
    { const bf16* qp = QO + J.base + (size_t)(J.n0 + 32 * w + r32) * HD + hi * 8; ld16_asm(q0, qp); ld16_asm(q1, qp + 16); ld16_asm(q2, qp + 32); ld16_asm(q3, qp + 48); }
    issue_kv<DIL, true>(lds, vcur, Vg, J, w, lane);
    asm volatile("s_waitcnt vmcnt(0)" : "+v"(q0), "+v"(q1), "+v"(q2), "+v"(q3) :: "memory");
    int cur_bh = -1;
    for (;;) {
        const int nid = id + (((id & 3) == jhi - 1) ? (G * 4 - (jhi - 1 - jlo)) : 1);
        const bool has_next = nid < NJS;
        if (J.bh != cur_bh) {
            cur_bh = J.bh;
            if (tid < 192) { const int step = tid - 32; ((LAS float*)(lds + L_T))[tid] = (step >= 0 && step <= 128) ? biasT[J.h * 132 + step] : -INFINITY; }
        }
        ATT_BAR();
        const int vnext = vcur == L_V0 ? L_V0 + L_VSZ : L_V0;
        if (has_next) { Job<DIL> JN; JN.decode(nid); issue_kv<DIL, true>(lds, vnext, Vg, JN, w, lane); }
        const int n0 = J.n0, h = J.h, c = J.c; const size_t rowb = J.rowb, jbase = J.base;
        const size_t qrow = rowb + (size_t)(n0 + 32 * w + r32) * DIL + c;
        const int jstart = (n0 == 0 && w < 4) ? 4 - w : 0;
        const LAS float* tp = (const LAS float*)(lds + L_T) + (5 + r32 - 4 * hi);
        const LAS unsigned char* kp = lds + L_K + (32 * w + r32) * 128;
        f32x16 S[5];
#pragma unroll
        for (int j = 0; j < 5; ++j) {
            if (j < jstart) {
#pragma unroll
                for (int r = 0; r < 16; ++r) S[j][r] = -INFINITY;
            } else {
                f32x16 cinit;
#pragma unroll
                for (int r = 0; r < 16; ++r) cinit[r] = tp[155 - 32 * j - (r & 3) - 8 * (r >> 2)];
#pragma unroll
                for (int d0 = 0; d0 < 4; ++d0) {
                    const bf16x8 kf = *(const LAS bf16x8*)(kp + 32 * j * 128 + (((2 * d0 + hi) ^ ((r32 >> 1) & 7)) * 16));
                    cinit = __builtin_amdgcn_mfma_f32_32x32x16_bf16(kf, d0 == 0 ? q0 : (d0 == 1 ? q1 : (d0 == 2 ? q2 : q3)), cinit, 0, 0, 0);
                }
                S[j] = cinit;
            }
        }
        float m = -INFINITY;
#pragma unroll
        for (int j = 0; j < 5; ++j)
#pragma unroll
            for (int r = 0; r < 16; ++r) m = fmaxf(m, S[j][r]);
        m = swapmax(m);
        ATT_BAR();
        bf16x8 n0q, n1q, n2q, n3q;
        if (has_next) {
            Job<DIL> JN; JN.decode(nid);
            issue_kv<DIL, false>(lds, L_K, Kg, JN, w, lane);
            const bf16* qp = QO + JN.base + (size_t)(JN.n0 + 32 * w + r32) * HD + hi * 8; ld16_asm(n0q, qp); ld16_asm(n1q, qp + 16); ld16_asm(n2q, qp + 32); ld16_asm(n3q, qp + 48);
        }
        f32x16 o0, o1;
        const int vq = (lane & 15) >> 2, vx = (vq >> 1) & 1;
        const LAS unsigned char* vrow = lds + vcur + (32 * w + 4 * hi + vq) * 128 + ((lane >> 4) & 1) * 32 + (lane & 3) * 8;
        const LAS unsigned char* vb0 = vrow + vx * 64; const LAS unsigned char* vb1 = vrow + (1 - vx) * 64;
        float lsum = 0.f;
#define ATT_EXPQ(J_, Q_) do { _Pragma("unroll") for (int r_ = 4 * (Q_); r_ < 4 * (Q_) + 4; ++r_) { const float p_ = __builtin_amdgcn_exp2f(S[J_][r_] - m); S[J_][r_] = p_; lsum += p_; } } while (0)
        ATT_EXPQ(0, 0); ATT_EXPQ(0, 1); ATT_EXPQ(0, 2); ATT_EXPQ(0, 3);
#pragma unroll
        for (int j = 0; j < 5; ++j) {
            v4u pw0, pw1;
            pw0.x = pk2(S[j][0], S[j][1]); pw0.y = pk2(S[j][2], S[j][3]); pw0.z = pk2(S[j][4], S[j][5]); pw0.w = pk2(S[j][6], S[j][7]);
            pw1.x = pk2(S[j][8], S[j][9]); pw1.y = pk2(S[j][10], S[j][11]); pw1.z = pk2(S[j][12], S[j][13]); pw1.w = pk2(S[j][14], S[j][15]);
            const bf16x8 pa0 = __builtin_bit_cast(bf16x8, pw0), pa1 = __builtin_bit_cast(bf16x8, pw1);
#pragma unroll
            for (int q4 = 0; q4 < 4; ++q4) {
                const int s = q4 >> 1, d0 = q4 & 1;
                const LAS unsigned char* vb = d0 == 0 ? vb0 : vb1;
                const s16x4 lo = vtr(vb + (32 * j + 16 * s) * 128), hh = vtr(vb + (32 * j + 16 * s + 8) * 128);
                const bf16x8 vf = (bf16x8){lo[0], lo[1], lo[2], lo[3], hh[0], hh[1], hh[2], hh[3]};
                const f32x16 zz = (f32x16){0.f, 0.f, 0.f, 0.f, 0.f, 0.f, 0.f, 0.f, 0.f, 0.f, 0.f, 0.f, 0.f, 0.f, 0.f, 0.f};
                if (d0 == 0) o0 = __builtin_amdgcn_mfma_f32_32x32x16_bf16(vf, s == 0 ? pa0 : pa1, (j == 0 && s == 0) ? zz : o0, 0, 0, 0);
                else         o1 = __builtin_amdgcn_mfma_f32_32x32x16_bf16(vf, s == 0 ? pa0 : pa1, (j == 0 && s == 0) ? zz : o1, 0, 0, 0);
                if (j < 4) ATT_EXPQ((j < 4 ? j + 1 : 4), q4);
            }
        }
#undef ATT_EXPQ
        lsum = swapsum(lsum);
        ATT_BAR();
        const float inv = __builtin_amdgcn_rcpf(lsum);
        LAS unsigned char* stg = lds + vcur + w * 4096;
#pragma unroll
        for (int d0 = 0; d0 < 2; ++d0)
#pragma unroll
            for (int g4 = 0; g4 < 4; ++g4) {
                const f32x16 od = d0 == 0 ? o0 : o1;
                v2u pk; pk.x = pk2(od[4 * g4] * inv, od[4 * g4 + 1] * inv); pk.y = pk2(od[4 * g4 + 2] * inv, od[4 * g4 + 3] * inv);
                *(LAS v2u*)(stg + r32 * 128 + (((4 * d0 + g4) ^ (r32 & 7)) * 16) + hi * 8) = pk;
            }
        asm volatile("s_waitcnt lgkmcnt(0)" ::: "memory");
        if (has_next) asm volatile("s_waitcnt vmcnt(0)" : "+v"(n0q), "+v"(n1q), "+v"(n2q), "+v"(n3q) :: "memory");
#pragma unroll
        for (int i = 0; i < 4; ++i) { const int row = i * 8 + (lane >> 3), ch = lane & 7; const v4u v = *(const LAS v4u*)(stg + row * 128 + ((ch ^ (row & 7)) * 16));
            st16(OUT + jbase + (size_t)(n0 + 32 * w + row) * HD + ch * 8, v); }
        if (hi == 0) lse[qrow * 16 + h] = m + log2f(lsum);
        if (!has_next) break;
        id = nid; J.decode(nid); q0 = n0q; q1 = n1q; q2 = n2q; q3 = n3q; vcur = vnext;
    }
    asm volatile("s_waitcnt vmcnt(0) lgkmcnt(0)\n\ts_barrier" ::: "memory");
}
#undef ATT_BAR
}

#ifndef PARITY_SPLIT
#define PARITY_SPLIT 1
#endif
#ifndef GEMM_SP2
#define GEMM_SP2 true
#endif
#ifndef GEMM_ALIGN
#define GEMM_ALIGN true
#endif
#ifndef DUP_RES
#define DUP_RES 0
#endif
#ifndef DUP_A2
#define DUP_A2 0
#endif
#ifndef DUP_A3
#define DUP_A3 0
#endif
#ifndef ATT_SPLIT
#define ATT_SPLIT 4
#endif
#ifndef DUP_EPI
#define DUP_EPI 0
#endif
#ifndef PARITY_EXPR
#define PARITY_EXPR ((bx & 1) != 0)
#endif
#ifndef ONE_ALIGN
#define ONE_ALIGN false
#endif
#ifndef DUP_BAR
#define DUP_BAR 0
#endif
constexpr int LDS_BYTES = 163840;
constexpr int XCH_OFF = 131072;
constexpr int MISC_OFF = 161536;
struct Args { const float* in[11]; float* out; unsigned char* ws; int ph_lo, ph_hi; };

enum PhaseKind { PK_P0A, PK_P0B, PK_C1, PK_C3, PK_A1, PK_A1A2, PK_A2, PK_A3, PK_A4 };
struct PhaseDesc { int kind, j, g; };
__host__ __device__ constexpr PhaseDesc phase_desc(int ph) {
    if (ph == 0) return {PK_P0A, 0, 0};
    const int j = ph >= 9 ? 1 : 0, s = ph - (j ? 9 : 1);
    switch (s) {
        case 0: return {PK_C1, j, 0};
        case 1: return {PK_C3, j, 0};
        case 2: return {PK_A1, j, 0};
        case 3: return {PK_A1A2, j, 0};
        case 4: return {PK_A1A2, j, 1};
        case 5: return {PK_A2, j, 2};
        case 6: return {PK_A3, j, 0};
        default: return {PK_A4, j, 0};
    }
}
__device__ __forceinline__ size_t kbuf_off(int g) { return g == 1 ? WS_KB : WS_KA; }
__device__ __forceinline__ size_t vbuf_off(int g) { return g == 1 ? WS_VB : WS_VA; }

template <int J, int G1> __device__ __forceinline__ void run_qkv_gemm(const Args& args, LAS unsigned char* lds, int G, int bx) {
    unsigned char* ws = args.ws;
    bf16* XB = (bf16*)(ws + WS_XB); float* SSQ = (float*)(ws + WS_SSQ);
    bf16* QO = (bf16*)(ws + WS_QO) + (size_t)G1 * MROWS * DM;
    pg8::Gemm gm{XB, (const bf16*)(ws + WS_W3) + (size_t)G1 * 3072 * DM, MROWS, 3072, DM}; pg8::StaticOrder S; S.init(MROWS, 3072, G, bx);
    epi::QKV E{SSQ, QO, (bf16*)(ws + kbuf_off(G1)), (bf16*)(ws + vbuf_off(G1)), args.in[7] + (J * NG + G1) * HD, args.in[8] + (J * NG + G1) * HD, lds, 2 * G1, (DUP_EPI != 0 && G1 == 0) ? (bf16*)(ws + WS_QO) + (size_t)2 * MROWS * DM : nullptr};
    pg8::gemm_phase<epi::QKV, pg8::StaticOrder, GEMM_ALIGN, GEMM_SP2>(lds, gm, S, E);
}
template <int G0> __device__ __forceinline__ void run_attn(const Args& args, LAS unsigned char* lds, int vcu, int G, int jlo = 0, int jhi = 4) {
    unsigned char* ws = args.ws;
    constexpr int dil = G0 == 0 ? 1 : (G0 == 1 ? 4 : 16);
    bf16* QO = (bf16*)(ws + WS_QO) + (size_t)G0 * MROWS * DM;
    attn::phase<dil>(lds, QO, QO, (const bf16*)(ws + kbuf_off(G0)), (const bf16*)(ws + vbuf_off(G0)), (const float*)(ws + WS_BIAS) + G0 * NH * 132, (float*)(ws + WS_LSE) + (size_t)G0 * MROWS * 16, vcu, G, jlo, jhi);
}

template <int PH> __device__ __forceinline__ void run_phase(const Args& args, LAS unsigned char* lds) {
    constexpr PhaseDesc D = phase_desc(PH);
    constexpr int j = D.j;
    const int tid = threadIdx.x, lane = tid & 63, wave = __builtin_amdgcn_readfirstlane(tid >> 6);
    const int G = gridDim.x, bx = blockIdx.x, vcu = (G % 8 == 0) ? (bx % 8) * (G / 8) + bx / 8 : bx;
    unsigned char* ws = args.ws;
    float* SSQ = (float*)(ws + WS_SSQ); bf16* XB = (bf16*)(ws + WS_XB);
    (void)lane; (void)wave; (void)SSQ; (void)XB; (void)vcu;
    if constexpr (D.kind == PK_P0A || D.kind == PK_P0B) {
        Ptrs P;
        P.x = args.in[0]; P.conv_norm = args.in[1]; P.conv_w_in = args.in[2]; P.conv_w = args.in[3]; P.conv_w_out = args.in[4]; P.attn_norm = args.in[5];
        P.attn_w_in = args.in[6]; P.q_gain = args.in[7]; P.k_gain = args.in[8]; P.attn_w_out = args.in[9]; P.rel_bias = args.in[10]; P.out = args.out; P.ws = args.ws;
        if constexpr (D.kind == PK_P0A) p0_prologue(P, lds, vcu, G, wave, lane, tid);
        else p0_weights<0>(P, 1, lds, vcu, G, wave, lane);
    } else if constexpr (D.kind == PK_C1) {
        Ptrs P;
        P.x = args.in[0]; P.conv_norm = args.in[1]; P.conv_w_in = args.in[2]; P.conv_w = args.in[3]; P.conv_w_out = args.in[4]; P.attn_norm = args.in[5];
        P.attn_w_in = args.in[6]; P.q_gain = args.in[7]; P.k_gain = args.in[8]; P.attn_w_out = args.in[9]; P.rel_bias = args.in[10]; P.out = args.out; P.ws = args.ws;
        const bool conv_first = PARITY_EXPR;
        if (conv_first) { p0_weights<1>(P, j, lds, vcu, G, wave, lane); __syncthreads(); }
        pg8::Gemm g{XB, (const bf16*)(ws + WS_W1), MROWS, CN, DM}; pg8::StaticOrder S; S.init(MROWS, CN, G, bx);
        epi::ConvFused E{SSQ, (bf16*)(ws + WS_CG), args.in[3] + (size_t)j * 3 * CE, (float*)(ws + WS_SIDE), lds + XCH_OFF};
        pg8::gemm_phase<epi::ConvFused, pg8::StaticOrder, true, GEMM_SP2>(lds, g, S, E);
        if (!conv_first) p0_weights<1>(P, j, lds, vcu, G, wave, lane);
    } else if constexpr (D.kind == PK_C3 || D.kind == PK_A4) {
        constexpr bool C3 = D.kind == PK_C3; constexpr int K = C3 ? CE : DM;
        const bf16* A = (const bf16*)(ws + (C3 ? WS_CG : WS_Y));
        pg8::Gemm g{A, (const bf16*)(ws + (C3 ? WS_W2 : WS_W4)), MROWS, DM, K}; pg8::StaticOrder S; S.init(MROWS, DM, G, bx);
        if constexpr (C3) { pg8::Unit fu; for (int i = 0; S.next(i, fu); ++i) conv_fixup((bf16*)(ws + WS_CG), (const float*)(ws + WS_SIDE), args.in[3] + (size_t)j * 3 * CE, fu.pm, tid);
            asm volatile("s_waitcnt vmcnt(0)" ::: "memory"); __syncthreads(); }
        constexpr int RMODE = (j == 0 && C3) ? 0 : ((j == 1 && !C3) ? 2 : 1);
#if DUP_RES
        if constexpr (RMODE == 1 && (DUP_RES == 1) == C3) { epi::ResidB<RMODE> E2{args.in[0], args.out, XB, SSQ, (bf16*)(ws + WS_VB)}; pg8::gemm_phase<epi::ResidB<RMODE>, pg8::StaticOrder, false, true>(lds, g, S, E2); }
#endif
        epi::ResidB<RMODE> E{args.in[0], args.out, XB, SSQ, XB};
        pg8::gemm_phase<epi::ResidB<RMODE>, pg8::StaticOrder, ONE_ALIGN, true>(lds, g, S, E);
    } else if constexpr (D.kind == PK_A1) {
        if constexpr (j == 0) {
            Ptrs P;
            P.x = args.in[0]; P.conv_norm = args.in[1]; P.conv_w_in = args.in[2]; P.conv_w = args.in[3]; P.conv_w_out = args.in[4]; P.attn_norm = args.in[5];
            P.attn_w_in = args.in[6]; P.q_gain = args.in[7]; P.k_gain = args.in[8]; P.attn_w_out = args.in[9]; P.rel_bias = args.in[10]; P.out = args.out; P.ws = args.ws;
            const bool conv_first = PARITY_EXPR;
            if (conv_first) { p0_weights<0>(P, 1, lds, vcu, G, wave, lane); __syncthreads(); }
            run_qkv_gemm<j, 0>(args, lds, G, bx);
            if (!conv_first) p0_weights<0>(P, 1, lds, vcu, G, wave, lane);
        } else run_qkv_gemm<j, 0>(args, lds, G, bx);
    } else if constexpr (D.kind == PK_A1A2) {
#if PARITY_SPLIT
        const bool attn_first = PARITY_EXPR;
#else
        const bool attn_first = false;
#endif
        if (attn_first) { run_attn<D.g>(args, lds, vcu, G, 0, ATT_SPLIT); run_qkv_gemm<j, D.g + 1>(args, lds, G, bx); run_attn<D.g>(args, lds, vcu, G, ATT_SPLIT, 4); }
        else            { run_qkv_gemm<j, D.g + 1>(args, lds, G, bx); run_attn<D.g>(args, lds, vcu, G); }
    } else if constexpr (D.kind == PK_A2) {
#if DUP_A2
        { constexpr int dil = 16; bf16* QO = (bf16*)(ws + WS_QO) + (size_t)2 * MROWS * DM;
          attn::phase<dil>(lds, QO, (bf16*)(ws + WS_VB), (const bf16*)(ws + kbuf_off(2)), (const bf16*)(ws + vbuf_off(2)), (const float*)(ws + WS_BIAS) + 2 * NH * 132, (float*)(ws + WS_LSE) + (size_t)2 * MROWS * 16, vcu, G); }
#endif
        run_attn<D.g>(args, lds, vcu, G);
    } else if constexpr (D.kind == PK_A3) {
        const bf16* O0 = (const bf16*)(ws + WS_QO); const bf16* O1 = O0 + (size_t)MROWS * DM; const bf16* O2 = O1 + (size_t)MROWS * DM;
        pg8::Gemm g{XB, (const bf16*)(ws + WS_W3) + (size_t)QKVC * DM, MROWS, DM, DM}; pg8::StaticOrder S; S.init(MROWS, DM, G, bx);
        epi::ZMerge E{SSQ, O0, O1, O2, (const float*)(ws + WS_LSE), (bf16*)(ws + WS_Y), lds};
#if DUP_A3
        pg8::gemm_phase<epi::ZMerge, pg8::StaticOrder, false, true>(lds, g, S, E);
#endif
        pg8::gemm_phase<epi::ZMerge, pg8::StaticOrder, ONE_ALIGN, true>(lds, g, S, E);
    }
}

__global__ void __launch_bounds__(512, 2) mk_fwd(Args args) {
    extern __shared__ __attribute__((aligned(16))) unsigned char lds_raw[];
    LAS unsigned char* lds = (LAS unsigned char*)lds_raw;
    volatile LAS unsigned* MISC = (volatile LAS unsigned*)(lds + MISC_OFF);
    for (int u = threadIdx.x; u < (LDS_BYTES - MISC_OFF) / 4; u += 512) ((LAS unsigned*)(lds + MISC_OFF))[u] = 0u;
    __syncthreads();
    gu32* ctl = (gu32*)(args.ws + WS_CTL);
    XcdBarrier bar; bar.bar = (unsigned*)(ctl + CW_BAR); bar.x = 0; bar.st = nullptr;
    const int lo = args.ph_lo, hi = args.ph_hi;
    if (hi - lo > 1) bar = xcd_barrier_post((unsigned*)(ctl + CW_BAR), MISC + 8);
#if DUP_BAR
#define RUN(k) if (lo <= (k) && (k) < hi) { run_phase<(k)>(args, lds); if ((k) + 1 < hi) { xcd_barrier(bar); xcd_barrier(bar); } }
#else
#define RUN(k) if (lo <= (k) && (k) < hi) { run_phase<(k)>(args, lds); if ((k) + 1 < hi) xcd_barrier(bar); }
#endif
    RUN(0) RUN(1) RUN(2) RUN(3) RUN(4) RUN(5) RUN(6) RUN(7) RUN(8) RUN(9) RUN(10) RUN(11) RUN(12) RUN(13) RUN(14) RUN(15) RUN(16)
#undef RUN
}

extern "C" void kernel_launch(void* const* d_in, const int* in_sizes, int n_in, void* d_out, int out_size, void* d_ws, size_t ws_size, hipStream_t stream) {
    static int grid = 0;
    if (grid == 0) {
        if (n_in != 11 || in_sizes[0] != MROWS * DM || out_size != MROWS * DM || ws_size < WS_END) { fprintf(stderr, "kernel_launch: unexpected shapes (n_in %d, ws %zu); nothing launched\n", n_in, ws_size); grid = -1; return; }
        int dev = 0, cus = 0, per_cu = 0;
        if (hipGetDevice(&dev) != hipSuccess || hipDeviceGetAttribute(&cus, hipDeviceAttributeMultiprocessorCount, dev) != hipSuccess) { grid = -1; return; }
        if (hipFuncSetAttribute((const void*)mk_fwd, hipFuncAttributeMaxDynamicSharedMemorySize, LDS_BYTES) != hipSuccess) { fprintf(stderr, "kernel_launch: hipFuncSetAttribute failed\n"); grid = -1; return; }
        if (hipOccupancyMaxActiveBlocksPerMultiprocessor(&per_cu, (const void*)mk_fwd, 512, LDS_BYTES) != hipSuccess || per_cu < 1) { fprintf(stderr, "kernel_launch: occupancy query says %d blocks per CU; nothing launched\n", per_cu); (void)hipGetLastError(); grid = -1; return; }
        if (cus < 256) { fprintf(stderr, "kernel_launch: built for >= 256 CUs (per-phase LDS tables hold 8 units per workgroup); %d found; nothing launched\n", cus); grid = -1; return; }
        grid = cus;
    }
    if (grid < 0) return;
    (void)hipMemsetAsync((char*)d_ws + WS_CTL, 0, CTL_ZERO_BYTES, stream);
    Args a{};
    for (int i = 0; i < 11; ++i) a.in[i] = (const float*)d_in[i];
    a.out = (float*)d_out; a.ws = (unsigned char*)d_ws;
    a.ph_lo = 0; a.ph_hi = NPHASE; hipLaunchKernelGGL(mk_fwd, dim3(grid), dim3(512), LDS_BYTES, stream, a);
}
```

```cpp
#include <hip/hip_runtime.h>
#include <cstdio>
#include <cstdint>
#include <cmath>
#define PARITY_EXPR (bx>-1)
#define CONV_PARITY_EXPR ((bx&1)>0)
namespace pg8 {
#define PG8_LAS __attribute__((address_space(3)))
typedef unsigned short bf16_t;
typedef short bf16x8 __attribute__((ext_vector_type(8)));
typedef float f32x4 __attribute__((ext_vector_type(4)));
typedef unsigned u32x4 __attribute__((ext_vector_type(4)));
constexpr int BM = 256, BK = 64, HALF = 128, HTB = HALF * BK * 2  , STAGE_BYTES = 8 * HTB, NXCD = 8, WGM = 8;

__host__ __device__ __forceinline__ int lds_byte(int r, int c) { const int st = (r >> 4) * 2 + (c >> 5), rr = r & 15, cc = c & 31, ob = rr * 64 + cc * 2; return st * 1024 + (ob ^ (((ob >> 9) & 1) << 5)); }
__host__ __device__ __forceinline__ void stage_rc(int b, int& R, int& C) { const int st = b / 1024, sb = b % 1024, swz = sb ^ (((sb >> 9) & 1) << 5); R = (st >> 1) * 16 + swz / 64; C = (st & 1) * 32 + (swz % 64) / 2; }
__host__ __device__ __forceinline__ int perm32(int rho) { const int n = rho >> 4, i = rho & 15; return 8 * (i >> 2) + 4 * n + (i & 3); }

struct Unit { int pm, pn; };
struct Gemm { const bf16_t* A; const bf16_t* Bt; int M, N, K; };

struct StaticOrder {
    int nM, nN, nwg, G, c;
    __host__ __device__ void init(int M, int N, int G_, int c_) { nM = M / BM; nN = N / BM; nwg = nM * nN; G = G_; c = c_; }
    __host__ __device__ bool next(int i, Unit& u) const {
        const long L = (long)i * G + c; if (L >= nwg) return false;
        int wgid = (int)L; { const int q = nwg / NXCD, r = nwg % NXCD, xcd = wgid % NXCD, off = wgid / NXCD; wgid = (xcd < r ? xcd * (q + 1) : r * (q + 1) + (xcd - r) * q) + off; }
        const int nig = WGM * nN, gid = wgid / nig, fm = gid * WGM, gsz = (nM - fm) < WGM ? (nM - fm) : WGM;
        u.pm = fm + ((wgid % nig) % gsz); u.pn = (wgid % nig) / gsz; return true;
    }
    __device__ __forceinline__ void a_ready(const Unit&) const {}
    __device__ __forceinline__ void done(const Unit&) const {}
};

__device__ __forceinline__ unsigned cvt_pk_bf16(float lo, float hi) { unsigned r; asm volatile("v_cvt_pk_bf16_f32 %0, %1, %2" : "=v"(r) : "v"(lo), "v"(hi)); return r; }
typedef float f32x2 __attribute__((ext_vector_type(2)));

typedef float f32x2z __attribute__((ext_vector_type(2)));
template <class Epi, class Sched, bool ALIGN_EPI = false, bool SP2 = false>
__device__ __forceinline__ void gemm_phase(PG8_LAS unsigned char* lds, const Gemm g, const Sched& S, const Epi& E) {
    const int tid = threadIdx.x, wid = __builtin_amdgcn_readfirstlane(tid >> 6), lane = tid & 63, wr = wid >> 2, wc = wid & 3, fr = lane & 15, fq = lane >> 4;
    const int K = g.K, nt = K / BK;
    unsigned voffA[2], voffB[2];
#pragma unroll
    for (int i = 0; i < 2; ++i) { int R, C; stage_rc(tid * 16 + i * 8192, R, C); const int Rb = Epi::PERM ? ((R & ~31) + perm32(R & 31)) : R;
        voffA[i] = (unsigned)(R * K + C) * 2u; voffB[i] = (unsigned)(Rb * K + C) * 2u; }
    const size_t kstep = (size_t)(BK * 2);
    const size_t hstep = (size_t)HALF * K * 2;
    const size_t tstep = 2 * hstep;
    const unsigned ldsw = (unsigned)wid * 1024u;
    const int aoff = lds_byte(wr * 64 + fr, fq * 8), boff = lds_byte(wc * 32 + fr, fq * 8);
#define PG8_SA(b, h) (((b) * 2 + (h)) * HTB)
#define PG8_SB(b, h) ((4 + (b) * 2 + (h)) * HTB)
#define PG8_STAGE(bufoff, gbase, voff) do { _Pragma("unroll") for (int _i = 0; _i < 2; ++_i) \
        __builtin_amdgcn_global_load_lds((const unsigned*)((const char*)(gbase) + (voff)[_i]), (PG8_LAS unsigned*)(lds + (bufoff) + ldsw + _i * 8192), 16, 0, 0); } while (0)
#define PG8_LDA(dst, b, h) do { _Pragma("unroll") for (int m = 0; m < 4; ++m) _Pragma("unroll") for (int k = 0; k < 2; ++k) dst[m][k] = *(const PG8_LAS bf16x8*)(lds + PG8_SA(b, h) + aoff + m * 2048 + k * 1024); } while (0)
#define PG8_LDB(dst, b, h) do { _Pragma("unroll") for (int n = 0; n < 2; ++n) _Pragma("unroll") for (int k = 0; k < 2; ++k) dst[n][k] = *(const PG8_LAS bf16x8*)(lds + PG8_SB(b, h) + boff + n * 2048 + k * 1024); } while (0)
#define PG8_MMA(ai, bj, At, Bt) do { __builtin_amdgcn_s_setprio(1); _Pragma("unroll") for (int m = 0; m < 4; ++m) _Pragma("unroll") for (int n = 0; n < 2; ++n) _Pragma("unroll") for (int k = 0; k < 2; ++k) \
        acc[ai][bj][m][n] = __builtin_amdgcn_mfma_f32_16x16x32_bf16(Bt[n][k], At[m][k], acc[ai][bj][m][n], 0, 0, 0); __builtin_amdgcn_s_setprio(0); } while (0)
#define PG8_ZERO4(x) do { f32x2z _lo, _hi; asm volatile("v_pk_mov_b32 %0, 0, 0" : "=v"(_lo)); asm volatile("v_pk_mov_b32 %0, 0, 0" : "=v"(_hi)); (x) = (f32x4){_lo[0], _lo[1], _hi[0], _hi[1]}; } while (0)
#define PG8_WAIT_V(n) asm volatile("s_waitcnt vmcnt(" #n ")" ::: "memory")
#define PG8_WAIT_L(n) asm volatile("s_waitcnt lgkmcnt(" #n ")" ::: "memory")
#define PG8_BAR __builtin_amdgcn_s_barrier()
#define PG8_SCHED __builtin_amdgcn_sched_barrier(0)
    Unit cur, nxt; int ui = 0;
    if (!S.next(0, cur)) return;
    f32x4 acc[2][2][4][2];
    bf16x8 At[4][2], B0[2][2], B1[2][2];
    const char* cA = (const char*)g.A + (size_t)cur.pm * tstep; const char* cB = (const char*)g.Bt + (size_t)cur.pn * tstep;
    S.a_ready(cur);
    if constexpr (SP2) {
        PG8_STAGE(PG8_SB(0, 0), cB, voffB); PG8_STAGE(PG8_SB(0, 1), cB + hstep, voffB); PG8_STAGE(PG8_SA(0, 0), cA, voffA); PG8_STAGE(PG8_SA(0, 1), cA + hstep, voffA);
        E.begin(lds, S, tid);
        if (wr == 1) PG8_BAR;
        PG8_WAIT_V(2); PG8_BAR;
        PG8_STAGE(PG8_SB(1, 0), cB + kstep, voffB); PG8_STAGE(PG8_SA(1, 0), cA + kstep, voffA); PG8_STAGE(PG8_SB(1, 1), cB + hstep + kstep, voffB);
        PG8_WAIT_V(6); PG8_BAR;
    } else {
        PG8_STAGE(PG8_SB(0, 0), cB, voffB); PG8_STAGE(PG8_SA(0, 0), cA, voffA); PG8_STAGE(PG8_SB(0, 1), cB + hstep, voffB); PG8_STAGE(PG8_SA(0, 1), cA + hstep, voffA);
        E.begin(lds, S, tid);
        if (wr == 1) PG8_BAR;
        PG8_WAIT_V(4); PG8_BAR;
        PG8_STAGE(PG8_SB(1, 0), cB + kstep, voffB); PG8_STAGE(PG8_SA(1, 0), cA + kstep, voffA); PG8_STAGE(PG8_SB(1, 1), cB + hstep + kstep, voffB);
        PG8_WAIT_V(6); PG8_BAR;
    }
#pragma unroll
    for (int a = 0; a < 2; ++a)
#pragma unroll
        for (int b = 0; b < 2; ++b)
#pragma unroll
            for (int m = 0; m < 4; ++m)
#pragma unroll
                for (int n = 0; n < 2; ++n) PG8_ZERO4(acc[a][b][m][n]);
    for (;;) {
        const bool has_next = S.next(ui + 1, nxt);
        const char* nA = has_next ? (const char*)g.A + (size_t)nxt.pm * tstep : cA; const char* nB = has_next ? (const char*)g.Bt + (size_t)nxt.pn * tstep : cB;
        for (int t = 0; t < nt; t += 2) {
            const bool last = (t == nt - 2);
            const char* a1 = cA + (size_t)(t + 1) * kstep;
            const char* a2 = last ? nA : cA + (size_t)(t + 2) * kstep; const char* b2 = last ? nB : cB + (size_t)(t + 2) * kstep;
            const char* a3 = a2 + kstep; const char* b3 = b2 + kstep;
            if (last && has_next) S.a_ready(nxt);
            if constexpr (SP2) {
            PG8_LDB(B0, 0, 0); PG8_LDB(B1, 0, 1); PG8_SCHED; PG8_LDA(At, 0, 0); PG8_STAGE(PG8_SA(1, 1), a1 + hstep, voffA);
            PG8_WAIT_V(8); PG8_WAIT_L(0); PG8_BAR; PG8_MMA(0, 0, At, B0); PG8_MMA(0, 1, At, B1); PG8_BAR; PG8_SCHED;
            PG8_LDA(At, 0, 1); PG8_STAGE(PG8_SB(0, 0), b2, voffB); PG8_STAGE(PG8_SB(0, 1), b2 + hstep, voffB); PG8_STAGE(PG8_SA(0, 0), a2, voffA);
            PG8_WAIT_V(8); PG8_WAIT_L(0); PG8_BAR; PG8_MMA(1, 0, At, B0); PG8_MMA(1, 1, At, B1); PG8_BAR; PG8_SCHED;
            PG8_LDB(B0, 1, 0); PG8_LDB(B1, 1, 1); PG8_SCHED; PG8_LDA(At, 1, 0); PG8_STAGE(PG8_SA(0, 1), a2 + hstep, voffA);
            PG8_WAIT_V(8); PG8_WAIT_L(0); PG8_BAR; PG8_MMA(0, 0, At, B0); PG8_MMA(0, 1, At, B1); PG8_BAR; PG8_SCHED;
            PG8_LDA(At, 1, 1); PG8_STAGE(PG8_SB(1, 0), b3, voffB); PG8_STAGE(PG8_SB(1, 1), b3 + hstep, voffB); PG8_STAGE(PG8_SA(1, 0), a3, voffA);
            PG8_WAIT_V(8); PG8_WAIT_L(0); PG8_BAR; PG8_MMA(1, 0, At, B0); PG8_MMA(1, 1, At, B1); PG8_BAR; PG8_SCHED;
            } else {
            PG8_LDB(B0, 0, 0); PG8_SCHED; PG8_LDA(At, 0, 0); PG8_STAGE(PG8_SA(1, 1), a1 + hstep, voffA);
            PG8_WAIT_L(8); PG8_BAR; PG8_WAIT_L(0); PG8_MMA(0, 0, At, B0); PG8_BAR; PG8_SCHED;
            PG8_LDB(B1, 0, 1); PG8_STAGE(PG8_SB(0, 0), b2, voffB);
            PG8_BAR; PG8_WAIT_L(0); PG8_MMA(0, 1, At, B1); PG8_BAR;
            PG8_LDA(At, 0, 1); PG8_STAGE(PG8_SA(0, 0), a2, voffA);
            PG8_BAR; PG8_WAIT_L(0); PG8_MMA(1, 0, At, B0); PG8_BAR; PG8_SCHED;
            PG8_STAGE(PG8_SB(0, 1), b2 + hstep, voffB);
            PG8_WAIT_V(6); PG8_BAR; PG8_MMA(1, 1, At, B1); PG8_BAR;
            PG8_LDB(B0, 1, 0); PG8_SCHED; PG8_LDA(At, 1, 0); PG8_STAGE(PG8_SA(0, 1), a2 + hstep, voffA);
            PG8_WAIT_L(8); PG8_BAR; PG8_WAIT_L(0); PG8_MMA(0, 0, At, B0); PG8_BAR; PG8_SCHED;
            PG8_LDB(B1, 1, 1); PG8_STAGE(PG8_SB(1, 0), b3, voffB);
            PG8_BAR; PG8_WAIT_L(0); PG8_MMA(0, 1, At, B1); PG8_BAR;
            PG8_LDA(At, 1, 1); PG8_STAGE(PG8_SA(1, 0), a3, voffA);
            PG8_BAR; PG8_WAIT_L(0); PG8_MMA(1, 0, At, B0); PG8_BAR; PG8_SCHED;
            PG8_STAGE(PG8_SB(1, 1), b3 + hstep, voffB);
            PG8_WAIT_V(6); PG8_BAR; PG8_MMA(1, 1, At, B1); PG8_BAR;
            }
        }
        if constexpr (ALIGN_EPI) { if (wr == 0) PG8_BAR; }
        if constexpr (!Epi::AFTER_DRAIN) { E(acc, cur, wr, wc, fr, fq, ui); if constexpr (Epi::DUP) { asm volatile("" ::: "memory"); if (E.scratch) { Epi E2 = E; E2.set_probe(); E2(acc, cur, wr, wc, fr, fq, ui); } } S.done(cur); }
        if (!has_next) break;
#pragma unroll
        for (int a = 0; a < 2; ++a)
#pragma unroll
            for (int b = 0; b < 2; ++b)
#pragma unroll
                for (int m = 0; m < 4; ++m)
#pragma unroll
                    for (int n = 0; n < 2; ++n) PG8_ZERO4(acc[a][b][m][n]);
        cur = nxt; cA = nA; cB = nB; ++ui;
        if constexpr (ALIGN_EPI) { if (wr == 1) PG8_BAR; }
    }
    PG8_WAIT_V(0);
    if constexpr (!ALIGN_EPI) { if (wr == 0) PG8_BAR; }
    PG8_BAR;
    if constexpr (Epi::AFTER_DRAIN) { E.fused(acc, cur, wr, wc, fr, fq, lds, wid, lane); S.done(cur); }
#undef PG8_SA
#undef PG8_SB
#undef PG8_STAGE
#undef PG8_LDA
#undef PG8_LDB
#undef PG8_MMA
#undef PG8_ZERO4
#undef PG8_WAIT_V
#undef PG8_WAIT_L
#undef PG8_BAR
#undef PG8_SCHED
}
}

constexpr int BATCH = 4, SEQ = 4096, DM = 1024, MROWS = BATCH * SEQ;
constexpr int CE = 2048, CN = 4 * CE;
constexpr int NH = 16, HD = 64, NG = 3, QKVC = 9216, AN = 10240;
constexpr float EPS = 1e-6f, LOG2E = 1.4426950408889634f, QSCALE = 0.125f * LOG2E;
constexpr int NPHASE = 17;

constexpr size_t MiB = 1u << 20;
constexpr size_t WS_CTL = 0, CTL_ZERO_BYTES = 65536;
constexpr size_t WS_SSQ = 1 * MiB;
constexpr size_t WS_W1 = 2 * MiB, WS_W2 = 18 * MiB, WS_W3 = 22 * MiB, WS_W4 = 42 * MiB;
constexpr size_t WS_LSE = 44 * MiB;
constexpr size_t WS_BIAS = 47 * MiB;
constexpr size_t WS_XB = 48 * MiB;
constexpr size_t WS_QO = 80 * MiB;
constexpr size_t WS_CG = 112 * MiB;
constexpr size_t WS_KA = 176 * MiB, WS_VA = 208 * MiB, WS_KB = 240 * MiB, WS_VB = 272 * MiB;
constexpr size_t WS_Y = WS_KA;
constexpr size_t WS_SIDE = 304 * MiB;
constexpr size_t WS_END = 307 * MiB;
constexpr int CW_TMO = 0, CW_BAR = 4096;

#define GAS __attribute__((address_space(1)))
#define LAS __attribute__((address_space(3)))
typedef unsigned short bf16;
typedef unsigned v4u __attribute__((ext_vector_type(4)));
typedef unsigned v2u __attribute__((ext_vector_type(2)));
typedef float f32x4 __attribute__((ext_vector_type(4)));
typedef short bf16x8 __attribute__((ext_vector_type(8)));
typedef GAS unsigned gu32;
#define RLX_AGENT __ATOMIC_RELAXED, __HIP_MEMORY_SCOPE_AGENT
#define LDS_WAIT() asm volatile("s_waitcnt lgkmcnt(0)" ::: "memory")
#define VM_WAIT() asm volatile("s_waitcnt vmcnt(0)" ::: "memory")
__device__ __forceinline__ unsigned f2bf(float f) { unsigned u = __builtin_bit_cast(unsigned, f); return (u + 0x7fffu + ((u >> 16) & 1u)) >> 16; }
typedef float f32x2_t __attribute__((ext_vector_type(2))); typedef __bf16 bf16x2_t __attribute__((ext_vector_type(2)));
__device__ __forceinline__ unsigned pk2(float lo, float hi) { f32x2_t v = {lo, hi}; bf16x2_t b = __builtin_convertvector(v, bf16x2_t); return __builtin_bit_cast(unsigned, b); }
#ifndef ST_WT
#define ST_WT 0
#endif
#ifndef ST_NT
#define ST_NT 0
#endif
#ifndef XSUM_SWAP
#define XSUM_SWAP 1
#endif
__device__ __forceinline__ float xsum_fq(float t) {
#if XSUM_SWAP
    auto a = __builtin_amdgcn_permlane16_swap(__float_as_uint(t), __float_as_uint(t), false, false); t = __uint_as_float(a[0]) + __uint_as_float(a[1]);
    auto b = __builtin_amdgcn_permlane32_swap(__float_as_uint(t), __float_as_uint(t), false, false); return __uint_as_float(b[0]) + __uint_as_float(b[1]);
#else
    t += __shfl_xor(t, 16); t += __shfl_xor(t, 32); return t;
#endif
}
__device__ __forceinline__ void st16(void* p, v4u v) {
#if ST_WT
    asm volatile("global_store_dwordx4 %0, %1, off sc1\n\ts_nop 1" :: "v"(p), "v"(v) : "memory");
#elif ST_NT
    __builtin_nontemporal_store(v, (v4u*)p);
#else
    *(v4u*)p = v;
#endif
}
__device__ __forceinline__ size_t hm_row(int row  , int h, int sh) {
    const int b = row >> 12, t = row & 4095, p = ((t & ((1 << sh) - 1)) << (12 - sh)) | (t >> sh);
    return ((size_t)((b * 16 + h) * 4096 + p)) * 64;
}
__device__ __forceinline__ float bf2f(unsigned h) { return __builtin_bit_cast(float, h << 16); }
__device__ __forceinline__ float bflo(unsigned w) { return __builtin_bit_cast(float, w << 16); }
__device__ __forceinline__ float bfhi(unsigned w) { return __builtin_bit_cast(float, w & 0xffff0000u); }
__device__ __forceinline__ float sigmoidf_(float z) { return __builtin_amdgcn_rcpf(1.0f + __builtin_amdgcn_exp2f(-z * LOG2E)); }
typedef float f32x4_sig __attribute__((ext_vector_type(4)));
__device__ __forceinline__ f32x4_sig sigmoid4(f32x4_sig z) {
    const f32x4_sig a = z * (-LOG2E);
    f32x4_sig e; e[0] = __builtin_amdgcn_exp2f(a[0]); e[1] = __builtin_amdgcn_exp2f(a[1]); e[2] = __builtin_amdgcn_exp2f(a[2]); e[3] = __builtin_amdgcn_exp2f(a[3]);
    const f32x4_sig d = e + 1.0f;
    f32x4_sig r; r[0] = __builtin_amdgcn_rcpf(d[0]); r[1] = __builtin_amdgcn_rcpf(d[1]); r[2] = __builtin_amdgcn_rcpf(d[2]); r[3] = __builtin_amdgcn_rcpf(d[3]);
    return r;
}
__device__ __forceinline__ float row_rs(const float* ssq, int row) {
    const f32x4* p = (const f32x4*)(ssq + (size_t)row * 16);
    const f32x4 s = (p[0] + p[1]) + (p[2] + p[3]);
    return 1.0f / sqrtf(((s.x + s.y) + (s.z + s.w)) * (1.0f / DM) + EPS);
}
__device__ __forceinline__ float wave_sum(float v) {
#pragma unroll
    for (int o = 1; o < 64; o <<= 1) v += __shfl_xor(v, o);
    return v;
}
__device__ __forceinline__ int t5_bucket(int d) {
    if (d < 16) return d;
    int b = 15;
    b += (d >= 16); b += (d >= 22); b += (d >= 30); b += (d >= 40); b += (d >= 54); b += (d >= 73); b += (d >= 99); b += (d >= 134);
    b += (d >= 182); b += (d >= 246); b += (d >= 332); b += (d >= 450); b += (d >= 609); b += (d >= 825); b += (d >= 1117); b += (d >= 1513);
    return b;
}

#define XB_TMO      128
#define XB_XCNT(j)  (256  + 64 * (j))
#define XB_XSUB(j)  (1280 + 64 * (j))
#define XB_XGEN(j)  (2304 + 64 * (j))
#define XB_TOP      3328
#define XB_TOPGEN   3392
#define XB_LSUB(j)  (3456 + 64 * (j))
#define XB_LGEN(j)  (4480 + 64 * (j))
#define XCD_BAR_WORDS 5504
#ifndef XB_LOCAL
#define XB_LOCAL 1
#endif
#define XB_SPIN_CAP (1u << 18)
#ifndef XB_SLEEP
#define XB_SLEEP 0
#endif
#ifndef XB_FLAT_REL
#define XB_FLAT_REL 1
#endif
#ifndef XB_COUNT_REL
#define XB_COUNT_REL 0
#endif
#ifndef XB_EARLY_WB
#define XB_EARLY_WB 0
#endif

__device__ __forceinline__ unsigned xb_ld(unsigned* p)              { return __hip_atomic_load(p, __ATOMIC_RELAXED, __HIP_MEMORY_SCOPE_AGENT); }
__device__ __forceinline__ unsigned xb_add(unsigned* p, unsigned v) { return __hip_atomic_fetch_add(p, v, __ATOMIC_RELAXED, __HIP_MEMORY_SCOPE_AGENT); }
__device__ __forceinline__ unsigned xb_xcc_id() { return (unsigned)__builtin_amdgcn_s_getreg((3 << 11) | 20) & 0xFu; }
#define XB_SPIN(cond, bar) do { unsigned _sp = 0; while (cond) { __builtin_amdgcn_s_sleep(XB_SLEEP); \
    if ((++_sp & 255u) == 0u) { if (xb_ld(&(bar)[XB_TMO])) break; if (_sp > XB_SPIN_CAP) { atomicAdd(&(bar)[XB_TMO], 1u); break; } } } } while (0)

struct XcdBarrier {
    unsigned* bar; unsigned x;
    volatile LAS unsigned* st;
};

__device__ __forceinline__ XcdBarrier xcd_barrier_post(unsigned* bar, volatile LAS unsigned* st) {
    XcdBarrier b; b.bar = bar; b.x = xb_xcc_id(); b.st = st;
    if (threadIdx.x == 0) st[2] = xb_add(&bar[XB_XCNT(b.x)], 1u);
    return b;
}
__device__ __forceinline__ void xcd_barrier_complete(unsigned* bar, unsigned x, unsigned& nloc, unsigned& nx, unsigned& uniform) {
    const unsigned G = gridDim.x * gridDim.y * gridDim.z;
    unsigned sum, cnt, mine, uni, sp = 0u;
    for (;;) {
        sum = 0u; cnt = 0u; mine = 0u; uni = 1u;
#pragma unroll
        for (unsigned j = 0; j < 16; ++j) { const unsigned c = xb_ld(&bar[XB_XCNT(j)]); sum += c; cnt += (c > 0u) ? 1u : 0u; mine = (j == x) ? c : mine; uni = (c == (j < 8u ? 32u : 0u)) ? uni : 0u; }
        if (sum == G) break;
        __builtin_amdgcn_s_sleep(1);
        if ((++sp & 255u) == 0u) { if (xb_ld(&bar[XB_TMO])) break; if (sp > XB_SPIN_CAP) { atomicAdd(&bar[XB_TMO], 1u); break; } }
    }
    nloc = mine > 0u ? mine : 1u; nx = cnt > 0u ? cnt : 1u; uniform = (sum == G && G == 256u) ? uni : 0u;
}

__device__ __forceinline__ void xcd_barrier(const XcdBarrier& b) {
    asm volatile("s_waitcnt vmcnt(0)" ::: "memory");
    __syncthreads();
#if XB_EARLY_WB
    if (threadIdx.x == 64) {
        const unsigned nl = b.st[0];
        if (nl > 1u) { const unsigned c = xb_ld(&b.bar[XB_XSUB(b.x)]) % nl; if (c == (nl * XB_EARLY_WB) / 8u) asm volatile("buffer_wbl2 sc1" ::: "memory"); }
    }
#endif
    if (threadIdx.x == 0) {
        unsigned* bar = b.bar;
        __builtin_amdgcn_s_waitcnt(0);
        unsigned nloc = b.st[0], nx = b.st[1];
        if (nloc == 0u) { unsigned uni; xcd_barrier_complete(bar, b.x, nloc, nx, uni); b.st[0] = nloc; b.st[1] = nx;
            b.st[4] = uni; b.st[3] = uni ? b.st[2] * 8u + b.x : blockIdx.x; }
        const unsigned old = xb_add(&bar[XB_XSUB(b.x)], 1u);
        const unsigned gen = old / nloc;
#if XB_COUNT_REL
        if (old + 1u == (gen + 1u) * nloc) {
            __builtin_amdgcn_fence(__ATOMIC_RELEASE, "agent");
            asm volatile("s_waitcnt vmcnt(0)" ::: "memory");
            (void)xb_add(&bar[XB_TOP], 1u);
        }
        { const unsigned target = (gen + 1u) * nx; XB_SPIN(xb_ld(&bar[XB_TOP]) < target, bar); }
        __builtin_amdgcn_fence(__ATOMIC_ACQUIRE, "agent");
        asm volatile("s_waitcnt vmcnt(0)" ::: "memory");
#else
        if (old + 1u == (gen + 1u) * nloc) {
            __builtin_amdgcn_fence(__ATOMIC_RELEASE, "agent");
            asm volatile("s_waitcnt vmcnt(0)" ::: "memory");
            const unsigned og = xb_add(&bar[XB_TOP], 1u);
            const unsigned tg = og / nx;
            if (og + 1u == (tg + 1u) * nx) xb_add(&bar[XB_TOPGEN], 1u);
            else XB_SPIN(xb_ld(&bar[XB_TOPGEN]) == tg, bar);
            __builtin_amdgcn_fence(__ATOMIC_ACQUIRE, "agent");
#if !XB_FLAT_REL
            xb_add(&bar[XB_XGEN(b.x)], 1u);
#endif
            asm volatile("s_waitcnt vmcnt(0)" ::: "memory");
        } else {
#if XB_FLAT_REL
            XB_SPIN(xb_ld(&bar[XB_TOPGEN]) == gen, bar);
#else
            XB_SPIN(xb_ld(&bar[XB_XGEN(b.x)]) == gen, bar);
#endif
            __builtin_amdgcn_fence(__ATOMIC_ACQUIRE, "agent");
            asm volatile("s_waitcnt vmcnt(0)" ::: "memory");
        }
#endif
    }
    __syncthreads();
}

__device__ __forceinline__ void xcd_barrier_local(const XcdBarrier& b) {
#if XB_LOCAL
    if (b.st[4] == 0u) { xcd_barrier(b); return; }
    asm volatile("s_waitcnt vmcnt(0)" ::: "memory");
    __syncthreads();
    if (threadIdx.x == 0) {
        unsigned* bar = b.bar;
        __builtin_amdgcn_s_waitcnt(0);
        const unsigned nloc = b.st[0];
        const unsigned old = xb_add(&bar[XB_LSUB(b.x)], 1u);
        const unsigned gen = old / nloc;
#if XB_COUNT_REL
        { const unsigned target = (gen + 1u) * nloc; if (old + 1u != target) XB_SPIN(xb_ld(&bar[XB_LSUB(b.x)]) < target, bar); }
#else
        if (old + 1u == (gen + 1u) * nloc) xb_add(&bar[XB_LGEN(b.x)], 1u);
        else XB_SPIN(xb_ld(&bar[XB_LGEN(b.x)]) == gen, bar);
#endif
        __builtin_amdgcn_fence(__ATOMIC_ACQUIRE, "agent");
        asm volatile("s_waitcnt vmcnt(0)" ::: "memory");
    }
    __syncthreads();
#else
    xcd_barrier(b);
#endif
}

#ifndef Z_NT
#define Z_NT 0
#endif
#if Z_NT
#define Z_LD(p) __builtin_nontemporal_load(p)
#else
#define Z_LD(p) (*(p))
#endif
#ifndef CONV_Y_NT
#define CONV_Y_NT 0
#endif
#ifndef EP_NT
#define EP_NT 0
#endif
#if EP_NT
#define EP_LD(p) __builtin_nontemporal_load(p)
#else
#define EP_LD(p) (*(p))
#endif
#ifndef DUP_EPI
#define DUP_EPI 0
#endif
#ifndef CONV_ST16
#define CONV_ST16 1
#endif
#ifndef RSTAB_PAIR
#define RSTAB_PAIR 1
#endif
#ifndef Y_NT
#define Y_NT 0
#endif
#ifndef QKV_NT
#define QKV_NT 0
#endif
#ifndef OUT_NT
#define OUT_NT 1
#endif
namespace epi {
using pg8::Unit; using pg8::bf16_t;

__device__ __forceinline__ void rows_rs(const float* ssq, int row0  , int fq, float (&rs)[2][4]) {
    f32x4 pp[2][4];
#pragma unroll
    for (int ai = 0; ai < 2; ++ai)
#pragma unroll
        for (int m = 0; m < 4; ++m) pp[ai][m] = *(const f32x4*)(ssq + (size_t)(row0 + ai * 128 + m * 16) * 16 + 4 * fq);
#pragma unroll
    for (int ai = 0; ai < 2; ++ai)
#pragma unroll
        for (int m = 0; m < 4; ++m) { float t = (pp[ai][m][0] + pp[ai][m][1]) + (pp[ai][m][2] + pp[ai][m][3]); t = xsum_fq(t); rs[ai][m] = __builtin_amdgcn_rsqf(t * (1.0f / DM) + EPS); }
}
struct ConvIn {
    static constexpr bool PERM = false, AFTER_DRAIN = false, DUP = (DUP_EPI != 0);
    const float* ssq; bf16_t* V; bf16_t* G;
    template <class Sched> __device__ __forceinline__ void begin(LAS unsigned char*, const Sched&, int) const {}
    __device__ __forceinline__ void operator()(const f32x4 (&acc)[2][2][4][2], const Unit& u, int wr, int wc, int fr, int fq, int) const {
        const int ch0 = u.pn * 64 + wc * 16 + 4 * fq;
        float rsv[2][4]; rows_rs(ssq, u.pm * 256 + wr * 64 + fr, fq, rsv);
#pragma unroll
        for (int ai = 0; ai < 2; ++ai)
#pragma unroll
            for (int m = 0; m < 4; ++m) {
                const int row = u.pm * 256 + ai * 128 + wr * 64 + m * 16 + fr;
                const float rs = rsv[ai][m];
                const f32x4 b = acc[ai][0][m][0] * rs, c = acc[ai][0][m][1] * rs, uu = acc[ai][1][m][0] * rs, z = acc[ai][1][m][1] * rs;
                const f32x4 v = c * uu;
                f32x4 g;
#pragma unroll
                for (int i = 0; i < 4; ++i) g[i] = b[i] * z[i] * sigmoidf_(z[i]);
                v2u wv, wg; wv.x = pk2(v[0], v[1]); wv.y = pk2(v[2], v[3]); wg.x = pk2(g[0], g[1]); wg.y = pk2(g[2], g[3]);
                *(v2u*)(V + (size_t)row * CE + ch0) = wv;
                *(v2u*)(G + (size_t)row * CE + ch0) = wg;
            }
    }
};


constexpr int RSTAB_OFF = 152832, GTAB_OFF = 161024;
template <bool PAIR, class Sched> __device__ __forceinline__ void fill_rstab(LAS unsigned char* lds, const float* ssq, const Sched& S, int tid) {
    LAS float* tab = (LAS float*)(lds + RSTAB_OFF);
    if constexpr (PAIR && RSTAB_PAIR != 0) {
#pragma unroll
    for (int kk = 0; kk < 2; ++kk) {
        const int i0 = (tid >> 8) + 4 * kk, i1 = i0 + 2;
        Unit u0, u1; const bool ok0 = S.next(i0, u0), ok1 = S.next(i1, u1);
        if (!ok0) break;
        const f32x4* p0 = (const f32x4*)(ssq + (size_t)(u0.pm * 256 + (tid & 255)) * 16);
        const f32x4* p1 = (const f32x4*)(ssq + (size_t)((ok1 ? u1.pm : u0.pm) * 256 + (tid & 255)) * 16);
        const f32x4 a0 = p0[0], a1 = p0[1], a2 = p0[2], a3 = p0[3], b0 = p1[0], b1 = p1[1], b2 = p1[2], b3 = p1[3];
        const f32x4 sa = (a0 + a1) + (a2 + a3), sb = (b0 + b1) + (b2 + b3);
        tab[i0 * 256 + (tid & 255)] = __builtin_amdgcn_rsqf(((sa[0] + sa[1]) + (sa[2] + sa[3])) * (1.0f / DM) + EPS);
        if (ok1) tab[i1 * 256 + (tid & 255)] = __builtin_amdgcn_rsqf(((sb[0] + sb[1]) + (sb[2] + sb[3])) * (1.0f / DM) + EPS);
    }
    } else {
    Unit u;
    for (int i = tid >> 8; i < 8 && S.next(i, u); i += 2) {
        const f32x4* p = (const f32x4*)(ssq + (size_t)(u.pm * 256 + (tid & 255)) * 16);
        const f32x4 s = (p[0] + p[1]) + (p[2] + p[3]);
        tab[i * 256 + (tid & 255)] = __builtin_amdgcn_rsqf(((s[0] + s[1]) + (s[2] + s[3])) * (1.0f / DM) + EPS);
    }
    }
}
__device__ __forceinline__ void tab_rs(LAS unsigned char* lds, int ui, int wr, int fr, float (&rs)[2][4]) {
    const LAS float* tab = (const LAS float*)(lds + RSTAB_OFF) + ui * 256 + wr * 64 + fr;
#pragma unroll
    for (int ai = 0; ai < 2; ++ai)
#pragma unroll
        for (int m = 0; m < 4; ++m) rs[ai][m] = tab[ai * 128 + m * 16];
}
struct ConvFused {
    static constexpr bool PERM = false, AFTER_DRAIN = false, DUP = false;
    const float* ssq; bf16_t* Y; const float* cw; float* side; LAS unsigned char* xch;
    static __device__ __forceinline__ f32x4 unpk(v2u p) { return (f32x4){bflo(p.x), bfhi(p.x), bflo(p.y), bfhi(p.y)}; }
    template <class Sched> __device__ __forceinline__ void begin(LAS unsigned char* lds, const Sched& S, int tid) const { fill_rstab<true>(lds, ssq, S, tid); }
    __device__ __forceinline__ void operator()(const f32x4 (&acc)[2][2][4][2], const Unit& u, int wr, int wc, int fr, int fq, int ui) const {
        const int ch0 = u.pn * 64 + wc * 16 + 4 * fq;
        float rsv[2][4]; tab_rs(xch - 131072, ui, wr, fr, rsv);
        const f32x4 w0 = *(const f32x4*)(cw + ch0), w1 = *(const f32x4*)(cw + CE + ch0), w2 = *(const f32x4*)(cw + 2 * CE + ch0);
        v2u vq[2][4]; f32x4 gt[2][4];
#pragma unroll
        for (int ai = 0; ai < 2; ++ai)
#pragma unroll
            for (int m = 0; m < 4; ++m) {
                const float rs = rsv[ai][m];
                const f32x4 b = acc[ai][0][m][0] * rs, c = acc[ai][0][m][1] * rs, uu = acc[ai][1][m][0] * rs, z = acc[ai][1][m][1] * rs;
                const f32x4 v = c * uu;
                vq[ai][m].x = pk2(v[0], v[1]); vq[ai][m].y = pk2(v[2], v[3]);
                gt[ai][m] = (b * z) * sigmoid4(z);
            }
        LAS unsigned char* my = xch + (wr * 4 + wc) * 2720 + fq * 8;
        LAS unsigned char* other = xch + ((1 - wr) * 4 + wc) * 2720 + fq * 8;
        const bool seq_start = (u.pm & 15) == 0;
        if (fr >= 14) {
            const int hr = fr - 14;
            *(LAS v2u*)(other + ((wr == 0 ? 0 : 66) + hr) * 40) = vq[0][3];
            if (wr == 0) *(LAS v2u*)(other + (66 + hr) * 40) = vq[1][3];
            else *(f32x4*)(side + ((size_t)u.pm * 6 + 4 + hr) * CE + ch0) = unpk(vq[1][3]);
        }
        if (wr == 0 && fr < 2) *(LAS v2u*)(my + fr * 40) = (v2u){0u, 0u};
#pragma unroll
        for (int m = 0; m < 4; ++m) *(LAS v2u*)(my + (2 + 16 * m + fr) * 40) = vq[0][m];
        asm volatile("s_waitcnt lgkmcnt(0)\n\ts_barrier" ::: "memory");
        v2u q1[2][4], q2[2][4];
#pragma unroll
        for (int m = 0; m < 4; ++m) { const int k = 16 * m + fr; q1[0][m] = *(const LAS v2u*)(my + (k + 1) * 40); q2[0][m] = *(const LAS v2u*)(my + k * 40); }
        asm volatile("" ::: "memory");
#pragma unroll
        for (int m = 0; m < 4; ++m) *(LAS v2u*)(my + (2 + 16 * m + fr) * 40) = vq[1][m];
        asm volatile("s_waitcnt lgkmcnt(0)" ::: "memory");
#pragma unroll
        for (int m = 0; m < 4; ++m) { const int k = 16 * m + fr; int r1 = k + 1, r2 = k; if (k < 1) r1 = 67; if (k < 2) r2 = 66 + k;
            q1[1][m] = *(const LAS v2u*)(my + r1 * 40); q2[1][m] = *(const LAS v2u*)(my + r2 * 40); }
        v2u wyk[2]; (void)wyk;
#pragma unroll
        for (int ai = 0; ai < 2; ++ai)
#pragma unroll
            for (int m = 0; m < 4; ++m) {
                const int k = 16 * m + fr;
                const f32x4 p1 = unpk(q1[ai][m]), p2 = unpk(q2[ai][m]), v = unpk(vq[ai][m]);
                const f32x4 cv = w2 * v + w1 * p1 + w0 * p2;
                const f32x4 y = gt[ai][m] * cv;
                const int row = u.pm * 256 + ai * 128 + wr * 64 + k;
                v2u wy; wy.x = pk2(y[0], y[1]); wy.y = pk2(y[2], y[3]);
#if CONV_ST16
                wyk[m & 1] = wy;
                if (m & 1) {
                    auto sx = __builtin_amdgcn_permlane16_swap(wyk[0].x, wyk[1].x, false, false); auto sy = __builtin_amdgcn_permlane16_swap(wyk[0].y, wyk[1].y, false, false);
                    const v4u w16 = (v4u){sx[0], sy[0], sx[1], sy[1]};
                    const int rr = u.pm * 256 + ai * 128 + wr * 64 + 16 * (m - 1 + (fq & 1)) + fr;
#if CONV_Y_NT
                    __builtin_nontemporal_store(w16, (v4u*)(Y + (size_t)rr * CE + u.pn * 64 + wc * 16 + 8 * (fq >> 1)));
#else
                    st16(Y + (size_t)rr * CE + u.pn * 64 + wc * 16 + 8 * (fq >> 1), w16);
#endif
                }
#else
                *(v2u*)(Y + (size_t)row * CE + ch0) = wy;
#endif
                if (ai == 0 && m == 0 && wr == 0 && fr < 2 && !seq_start) {
                    *(f32x4*)(side + ((size_t)u.pm * 6 + fr) * CE + ch0) = gt[0][0];
                    *(f32x4*)(side + ((size_t)u.pm * 6 + 2 + fr) * CE + ch0) = cv;
                }
            }
    }
};
struct Resid {
    static constexpr bool PERM = false, AFTER_DRAIN = false, DUP = false;
    const float* xin; float* xout; bf16_t* xb; float* ssq;
    template <class Sched> __device__ __forceinline__ void begin(LAS unsigned char*, const Sched&, int) const {}
    __device__ __forceinline__ void operator()(const f32x4 (&acc)[2][2][4][2], const Unit& u, int wr, int wc, int fr, int fq, int) const {
        const int col0 = u.pn * 256 + wc * 32 + 4 * fq;
        const size_t off0 = (size_t)(u.pm * 256 + wr * 64 + fr) * DM + col0;
        f32x4 pre[4][2][2];
#pragma unroll
        for (int i = 0; i < 4; ++i)
#pragma unroll
            for (int bj = 0; bj < 2; ++bj)
#pragma unroll
                for (int n = 0; n < 2; ++n) pre[i][bj][n] = *(const f32x4*)(xin + off0 + (size_t)(16 * i) * DM + bj * 128 + n * 16);
#pragma unroll
        for (int i = 0; i < 8; ++i) {
            const int ai = i >> 2, m = i & 3;
            const size_t off = off0 + (size_t)(ai * 128 + m * 16) * DM;
            float ss = 0.f; f32x4 xn[2][2];
#pragma unroll
            for (int bj = 0; bj < 2; ++bj)
#pragma unroll
                for (int n = 0; n < 2; ++n) { xn[bj][n] = pre[i & 3][bj][n] + acc[ai][bj][m][n]; const f32x4 t = xn[bj][n]; ss += (t[0] * t[0] + t[1] * t[1]) + (t[2] * t[2] + t[3] * t[3]); }
            if (i < 4) {
#pragma unroll
                for (int bj = 0; bj < 2; ++bj)
#pragma unroll
                    for (int n = 0; n < 2; ++n) pre[i & 3][bj][n] = *(const f32x4*)(xin + off + (size_t)128 * DM + bj * 128 + n * 16);
            }
#pragma unroll
            for (int bj = 0; bj < 2; ++bj)
#pragma unroll
                for (int n = 0; n < 2; ++n) {
                    *(f32x4*)(xout + off + bj * 128 + n * 16) = xn[bj][n];
                    v2u w; w.x = pk2(xn[bj][n][0], xn[bj][n][1]); w.y = pk2(xn[bj][n][2], xn[bj][n][3]);
                    *(v2u*)(xb + off + bj * 128 + n * 16) = w;
                }
            ss = xsum_fq(ss);
            if (fq == 0) ssq[(size_t)(u.pm * 256 + ai * 128 + wr * 64 + m * 16 + fr) * 16 + u.pn * 4 + wc] = ss;
        }
    }
};
template <int MODE> struct ResidB {
    static constexpr bool PERM = false, AFTER_DRAIN = false, DUP = false;
    const float* xin; float* xout; bf16_t* xb; float* ssq; bf16_t* xbw;
    template <class Sched> __device__ __forceinline__ void begin(LAS unsigned char*, const Sched&, int) const {}
    __device__ __forceinline__ void operator()(const f32x4 (&acc)[2][2][4][2], const Unit& u, int wr, int wc, int fr, int fq, int) const {
        const int col0 = u.pn * 256 + wc * 32 + 4 * fq;
        const size_t off0 = (size_t)(u.pm * 256 + wr * 64 + fr) * DM + col0;
        if constexpr (MODE == 0) {
            f32x4 pre[4][2][2];
#pragma unroll
            for (int i = 0; i < 4; ++i)
#pragma unroll
                for (int bj = 0; bj < 2; ++bj)
#pragma unroll
                    for (int n = 0; n < 2; ++n) pre[i][bj][n] = *(const f32x4*)(xin + off0 + (size_t)(16 * i) * DM + bj * 128 + n * 16);
#pragma unroll
            for (int i = 0; i < 8; ++i) {
                const int ai = i >> 2, m = i & 3;
                const size_t off = off0 + (size_t)(ai * 128 + m * 16) * DM;
                float ss = 0.f; f32x4 xn[2][2];
#pragma unroll
                for (int bj = 0; bj < 2; ++bj)
#pragma unroll
                    for (int n = 0; n < 2; ++n) { xn[bj][n] = pre[i & 3][bj][n] + acc[ai][bj][m][n]; const f32x4 t = xn[bj][n]; ss += (t[0] * t[0] + t[1] * t[1]) + (t[2] * t[2] + t[3] * t[3]); }
                if (i < 4) {
#pragma unroll
                    for (int bj = 0; bj < 2; ++bj)
#pragma unroll
                        for (int n = 0; n < 2; ++n) pre[i & 3][bj][n] = *(const f32x4*)(xin + off + (size_t)128 * DM + bj * 128 + n * 16);
                }
#pragma unroll
                for (int bj = 0; bj < 2; ++bj)
#pragma unroll
                    for (int n = 0; n < 2; ++n) { v2u w; w.x = pk2(xn[bj][n][0], xn[bj][n][1]); w.y = pk2(xn[bj][n][2], xn[bj][n][3]); *(v2u*)(xbw + off + bj * 128 + n * 16) = w; }
                ss = xsum_fq(ss);
                if (fq == 0) ssq[(size_t)(u.pm * 256 + ai * 128 + wr * 64 + m * 16 + fr) * 16 + u.pn * 4 + wc] = ss;
            }
        } else {
            v2u pre[8][2][2];
#pragma unroll
            for (int i = 0; i < 8; ++i)
#pragma unroll
                for (int bj = 0; bj < 2; ++bj)
#pragma unroll
                    for (int n = 0; n < 2; ++n) pre[i][bj][n] = EP_LD((const v2u*)(xb + off0 + (size_t)((i >> 2) * 128 + (i & 3) * 16) * DM + bj * 128 + n * 16));
#pragma unroll
            for (int i = 0; i < 8; ++i) {
                const int ai = i >> 2, m = i & 3;
                const size_t off = off0 + (size_t)(ai * 128 + m * 16) * DM;
                f32x4 ssv = (f32x4){0.f, 0.f, 0.f, 0.f};
#pragma unroll
                for (int bj = 0; bj < 2; ++bj)
#pragma unroll
                    for (int n = 0; n < 2; ++n) {
                        const v2u p = pre[i][bj][n];
                        const f32x4 t = (f32x4){bflo(p.x), bfhi(p.x), bflo(p.y), bfhi(p.y)} + acc[ai][bj][m][n];
                        if constexpr (MODE == 2) { if constexpr (OUT_NT != 0) __builtin_nontemporal_store(t, (f32x4*)(xout + off + bj * 128 + n * 16)); else *(f32x4*)(xout + off + bj * 128 + n * 16) = t; }
                        else { ssv = __builtin_elementwise_fma(t, t, ssv); v2u w; w.x = pk2(t[0], t[1]); w.y = pk2(t[2], t[3]); *(v2u*)(xbw + off + bj * 128 + n * 16) = w; }
                    }
                if constexpr (MODE != 2) {
                    float ss = (ssv[0] + ssv[1]) + (ssv[2] + ssv[3]);
                    ss = xsum_fq(ss);
                    if (fq == 0) ssq[(size_t)(u.pm * 256 + ai * 128 + wr * 64 + m * 16 + fr) * 16 + u.pn * 4 + wc] = ss;
                }
            }
        }
    }
};
struct NullEpi {
    static constexpr bool PERM = false, AFTER_DRAIN = false, DUP = false;
    float* sink;
    template <class Sched> __device__ __forceinline__ void begin(LAS unsigned char*, const Sched&, int) const {}
    __device__ __forceinline__ void operator()(const f32x4 (&acc)[2][2][4][2], const Unit& u, int wr, int wc, int fr, int fq, int) const {
        f32x4 t = (f32x4){0.f, 0.f, 0.f, 0.f};
#pragma unroll
        for (int a = 0; a < 2; ++a)
#pragma unroll
            for (int b = 0; b < 2; ++b)
#pragma unroll
                for (int m = 0; m < 4; ++m)
#pragma unroll
                    for (int n = 0; n < 2; ++n) t += acc[a][b][m][n];
        const float q = (t[0] + t[1]) + (t[2] + t[3]);
        if (q == 123456.789f) sink[u.pm * 4 + u.pn] = q;
    }
};
struct QKV {
    static constexpr bool PERM = true, AFTER_DRAIN = false, DUP = (DUP_EPI != 0);
    const float* ssq; bf16_t* Q; bf16_t* K; bf16_t* Vv; const float* qg; const float* kg; LAS unsigned char* lds0; int sh; bf16_t* scratch = nullptr; bool probe = false;
    __device__ __forceinline__ void set_probe() { probe = true; }
    template <class Sched> __device__ __forceinline__ void begin(LAS unsigned char* lds, const Sched& S, int tid) const {
        fill_rstab<true>(lds, ssq, S, tid);
        if (tid < 64) ((LAS float*)(lds + GTAB_OFF))[tid] = qg[tid] * kg[tid] * QSCALE;
    }
    template <int W> __device__ __forceinline__ void emit(const f32x4 (&acc)[2][2][4][2], const Unit& u, int wr, int wc, int fr, int fq, int ui, bf16_t* base) const {
        const int h = (u.pn & 3) * 4 + wc;
        const LAS float* gp = (const LAS float*)(lds0 + GTAB_OFF);
        f32x4 g00, g01, g10, g11;
        if constexpr (W == 0) { g00 = *(const LAS f32x4*)(gp + 8 * fq); g01 = *(const LAS f32x4*)(gp + 8 * fq + 4); g10 = *(const LAS f32x4*)(gp + 32 + 8 * fq); g11 = *(const LAS f32x4*)(gp + 32 + 8 * fq + 4); }
        float rsv[2][4]; tab_rs(lds0, ui, wr, fr, rsv);
#pragma unroll
        for (int ai = 0; ai < 2; ++ai)
#pragma unroll
            for (int m = 0; m < 4; ++m) {
                const int row = u.pm * 256 + ai * 128 + wr * 64 + m * 16 + fr;
                const float rs = rsv[ai][m];
                float sc = rs;
                if constexpr (W < 2) {
                    f32x4 sq = acc[ai][0][m][0] * acc[ai][0][m][0];
                    sq = __builtin_elementwise_fma(acc[ai][0][m][1], acc[ai][0][m][1], sq); sq = __builtin_elementwise_fma(acc[ai][1][m][0], acc[ai][1][m][0], sq); sq = __builtin_elementwise_fma(acc[ai][1][m][1], acc[ai][1][m][1], sq);
                    float ss = (sq[0] + sq[1]) + (sq[2] + sq[3]);
                    ss = xsum_fq(ss);
                    sc = rs * __builtin_amdgcn_rsqf(ss * (rs * rs * (1.0f / HD)) + EPS);
                }
#pragma unroll
                for (int bj = 0; bj < 2; ++bj) {
                    f32x4 a = acc[ai][bj][m][0] * sc, b = acc[ai][bj][m][1] * sc;
                    if constexpr (W == 0) { a = a * (bj == 0 ? g00 : g10); b = b * (bj == 0 ? g01 : g11); }
                    v4u w; w.x = pk2(a[0], a[1]); w.y = pk2(a[2], a[3]); w.z = pk2(b[0], b[1]); w.w = pk2(b[2], b[3]);
#if QKV_NT
                    __builtin_nontemporal_store(w, (v4u*)(base + hm_row(row, h, sh) + 32 * bj + 8 * fq));
#else
                    st16(base + hm_row(row, h, sh) + 32 * bj + 8 * fq, w);
#endif
                }
            }
    }
    __device__ __forceinline__ void operator()(const f32x4 (&acc)[2][2][4][2], const Unit& u, int wr, int wc, int fr, int fq, int ui) const {
        const int which = __builtin_amdgcn_readfirstlane(u.pn >> 2);
        if (which == 0) emit<0>(acc, u, wr, wc, fr, fq, ui, Q); else if (which == 1) emit<1>(acc, u, wr, wc, fr, fq, ui, K); else emit<2>(acc, u, wr, wc, fr, fq, ui, Vv);
    }
};
struct ZMerge {
    static constexpr bool PERM = true, AFTER_DRAIN = false, DUP = false;
    const float* ssq; const bf16_t* O0; const bf16_t* O1; const bf16_t* O2; const float* lse; bf16_t* Y; LAS unsigned char* lds0;
    struct RowIn { v4u a[2], b[2], c[2]; float l0, l1, l2; };
    __device__ __forceinline__ void load_row(RowIn& r, int row, int h, int fq) const {
        const size_t off0 = hm_row(row, h, 0) + 8 * fq, off1 = hm_row(row, h, 2) + 8 * fq, off2 = hm_row(row, h, 4) + 8 * fq;
        r.l0 = lse[((size_t)0 * MROWS + row) * 16 + h]; r.l1 = lse[((size_t)1 * MROWS + row) * 16 + h]; r.l2 = lse[((size_t)2 * MROWS + row) * 16 + h];
#pragma unroll
        for (int bj = 0; bj < 2; ++bj) { r.a[bj] = Z_LD((const v4u*)(O0 + off0 + 32 * bj)); r.b[bj] = Z_LD((const v4u*)(O1 + off1 + 32 * bj)); r.c[bj] = Z_LD((const v4u*)(O2 + off2 + 32 * bj)); }
    }
    template <class Sched> __device__ __forceinline__ void begin(LAS unsigned char* lds, const Sched& S, int tid) const { fill_rstab<false>(lds, ssq, S, tid); }
    __device__ __forceinline__ void operator()(const f32x4 (&acc)[2][2][4][2], const Unit& u, int wr, int wc, int fr, int fq, int ui) const {
        const int h = u.pn * 4 + wc, row0 = u.pm * 256 + wr * 64 + fr;
        RowIn in[4];
        load_row(in[0], row0, h, fq); load_row(in[1], row0 + 16, h, fq);
        float rsv[2][4]; tab_rs(lds0, ui, wr, fr, rsv);
        v4u szp[2][4][2];
#pragma unroll
        for (int ai = 0; ai < 2; ++ai)
#pragma unroll
            for (int m = 0; m < 4; ++m)
#pragma unroll
                for (int bj = 0; bj < 2; ++bj) {
                    const f32x4 z0 = acc[ai][bj][m][0] * rsv[ai][m], z1 = acc[ai][bj][m][1] * rsv[ai][m];
                    const f32x4 s0 = z0 * sigmoid4(z0), s1 = z1 * sigmoid4(z1);
                    szp[ai][m][bj] = (v4u){pk2(s0[0], s0[1]), pk2(s0[2], s0[3]), pk2(s1[0], s1[1]), pk2(s1[2], s1[3])};
                }
        load_row(in[2], row0 + 32, h, fq); load_row(in[3], row0 + 48, h, fq);
#pragma unroll
        for (int i = 0; i < 8; ++i) {
            const int ai = i >> 2, m = i & 3, row = row0 + ai * 128 + m * 16;
            const RowIn& r = in[i & 3];
            const float mx = fmaxf(r.l0, fmaxf(r.l1, r.l2));
            float w0 = __builtin_amdgcn_exp2f(r.l0 - mx), w1 = __builtin_amdgcn_exp2f(r.l1 - mx), w2 = __builtin_amdgcn_exp2f(r.l2 - mx);
            const float inv = __builtin_amdgcn_rcpf(w0 + w1 + w2); w0 *= inv; w1 *= inv; w2 *= inv;
#pragma unroll
            for (int bj = 0; bj < 2; ++bj) {
                const v4u a = r.a[bj], b = r.b[bj], c = r.c[bj], sp = szp[ai][m][bj];
                v4u w;
#pragma unroll
                for (int k = 0; k < 4; ++k) {
                    const float ol = w0 * bflo(a[k]) + w1 * bflo(b[k]) + w2 * bflo(c[k]), oh = w0 * bfhi(a[k]) + w1 * bfhi(b[k]) + w2 * bfhi(c[k]);
                    w[k] = pk2(ol * bflo(sp[k]), oh * bfhi(sp[k]));
                }
#if Y_NT
                __builtin_nontemporal_store(w, (v4u*)(Y + (size_t)row * DM + h * HD + 32 * bj + 8 * fq));
#else
                st16(Y + (size_t)row * DM + h * HD + 32 * bj + 8 * fq, w);
#endif
            }
            if (i + 4 < 8) load_row(in[i & 3], row0 + 128 + m * 16, h, fq);
        }
    }
};
}

#ifndef P0_PIPE
#define P0_PIPE 1
#endif
#ifndef P0_ST_NT
#define P0_ST_NT 0
#endif
#ifndef P0_NT
#define P0_NT 1
#endif
#if P0_NT
#define P0_LD(p) __builtin_nontemporal_load(p)
#else
#define P0_LD(p) (*(p))
#endif
template <int MODE> __device__ __forceinline__ int wt_dest_row(int n) {
    if (MODE == 1) { const int type = n >> 11, e = n & 2047, pn = e >> 6, el = e & 63; return 256 * pn + 128 * (type >> 1) + 32 * (el >> 4) + 16 * (type & 1) + (el & 15); }
    if (MODE == 3) { const int blk = n >> 10, r = n & 1023, h = r >> 6, d = r & 63; return blk * 1024 + 256 * (h >> 2) + 128 * (d >> 5) + 32 * (h & 3) + (d & 31); }
    return n;
}
__device__ __forceinline__ void p0_item_load(const float* W, int N, int item, int lane, f32x4 (&v)[16], const float* scale, f32x4 (&sc)[2]) {
    const int nblk = N / 64, kb = item / nblk, nb = item % nblk, k0 = 64 * kb, n0 = 64 * nb;
    const int kr = lane >> 4, c4 = lane & 15;
#pragma unroll
    for (int i = 0; i < 16; ++i) v[i] = P0_LD((const GAS f32x4*)(W + (size_t)(k0 + 4 * i + kr) * N + n0 + 4 * c4));
    if (scale) { sc[0] = *(const f32x4*)(scale + k0 + 8 * (lane & 7)); sc[1] = *(const f32x4*)(scale + k0 + 8 * (lane & 7) + 4); }
    else { sc[0] = (f32x4){1.f, 1.f, 1.f, 1.f}; sc[1] = sc[0]; }
}
template <int MODE> __device__ __forceinline__ void p0_item_finish(int K, int N, bf16* WT, LAS float* scr, int item, int lane, const f32x4 (&v)[16], const f32x4 (&sc)[2]) {
    const int nblk = N / 64, kb = item / nblk, nb = item % nblk, k0 = 64 * kb, n0 = 64 * nb;
    const int kr = lane >> 4, c4 = lane & 15;
#pragma unroll
    for (int i = 0; i < 16; ++i) { LAS float* d = scr + (4 * i + kr) * 65 + 4 * c4; d[0] = v[i][0]; d[1] = v[i][1]; d[2] = v[i][2]; d[3] = v[i][3]; }
    LDS_WAIT(); asm volatile("" ::: "memory");
    const int c = lane & 7, nl = lane >> 3;
#pragma unroll
    for (int j = 0; j < 8; ++j) { const int n = nl + 8 * j; const LAS float* sp = scr + (8 * c) * 65 + n;
        v4u o; o.x = pk2(sp[0 * 65] * sc[0][0], sp[1 * 65] * sc[0][1]); o.y = pk2(sp[2 * 65] * sc[0][2], sp[3 * 65] * sc[0][3]); o.z = pk2(sp[4 * 65] * sc[1][0], sp[5 * 65] * sc[1][1]); o.w = pk2(sp[6 * 65] * sc[1][2], sp[7 * 65] * sc[1][3]);
#if P0_ST_NT
        __builtin_nontemporal_store(o, (GAS v4u*)(WT + (size_t)wt_dest_row<MODE>(n0 + n) * K + k0 + 8 * c)); }
#else
        *(GAS v4u*)(WT + (size_t)wt_dest_row<MODE>(n0 + n) * K + k0 + 8 * c) = o; }
#endif
    LDS_WAIT(); asm volatile("" ::: "memory");
}
template <int MODE> __device__ __forceinline__ void p0_transpose_item(const float* W, int K, int N, const float* scale, bf16* WT, LAS float* scr  , int item, int lane) {
    f32x4 v[16], sc[2];
    p0_item_load(W, N, item, lane, v, scale, sc);
    p0_item_finish<MODE>(K, N, WT, scr, item, lane, v, sc);
}
struct Ptrs {
    const float *x, *conv_norm, *conv_w_in, *conv_w, *conv_w_out, *attn_norm, *attn_w_in, *q_gain, *k_gain, *attn_w_out, *rel_bias;
    float* out; unsigned char* ws;
};
template <int PART> __device__ __forceinline__ void p0_weights(const Ptrs& P, int j, LAS unsigned char* lds, int vcu, int G, int wave, int lane) {
    LAS float* scr = (LAS float*)(lds + wave * 16640);
    const int gw = vcu * 8 + wave, NGW = G * 8;
    bf16* W1 = (bf16*)(P.ws + WS_W1); bf16* W2 = (bf16*)(P.ws + WS_W2); bf16* W3 = (bf16*)(P.ws + WS_W3); bf16* W4 = (bf16*)(P.ws + WS_W4);
    constexpr int I1 = (DM / 64) * (CN / 64), I2 = (CE / 64) * (DM / 64), I3 = (DM / 64) * (AN / 64), I4 = (DM / 64) * (DM / 64);
    if constexpr (PART == 0) {
        for (int it = gw; it < I1; it += NGW) p0_transpose_item<1>(P.conv_w_in + (size_t)j * DM * CN, DM, CN, P.conv_norm + j * DM, W1, scr, it, lane);
    } else {
#if P0_PIPE
        static_assert(I2 + I3 + I4 <= 2 * 256 * 8, "at most two items per wave");
        const int itA = gw, itB = gw + NGW; const bool hasA = itA < I2 + I3 + I4, hasB = itB < I2 + I3 + I4;
        const int mA = itA < I2 ? 0 : (itA < I2 + I3 ? 1 : 2), rA = itA - (mA == 0 ? 0 : (mA == 1 ? I2 : I2 + I3));
        const int mB = itB < I2 ? 0 : (itB < I2 + I3 ? 1 : 2), rB = itB - (mB == 0 ? 0 : (mB == 1 ? I2 : I2 + I3));
        const float* srcs[3] = {P.conv_w_out + (size_t)j * CE * DM, P.attn_w_in + (size_t)j * DM * AN, P.attn_w_out + (size_t)j * DM * DM};
        f32x4 vA[16], vB[16], sA[2], sB[2];
        if (hasA) p0_item_load(mA == 0 ? srcs[0] : (mA == 1 ? srcs[1] : srcs[2]), mA == 1 ? AN : DM, rA, lane, vA, mA == 1 ? P.attn_norm + j * DM : nullptr, sA);
        if (hasB) p0_item_load(mB == 0 ? srcs[0] : (mB == 1 ? srcs[1] : srcs[2]), mB == 1 ? AN : DM, rB, lane, vB, mB == 1 ? P.attn_norm + j * DM : nullptr, sB);
        if (hasA) { if (mA == 0) p0_item_finish<0>(CE, DM, W2, scr, rA, lane, vA, sA); else if (mA == 1) p0_item_finish<3>(DM, AN, W3, scr, rA, lane, vA, sA); else p0_item_finish<0>(DM, DM, W4, scr, rA, lane, vA, sA); }
        if (hasB) { if (mB == 0) p0_item_finish<0>(CE, DM, W2, scr, rB, lane, vB, sB); else if (mB == 1) p0_item_finish<3>(DM, AN, W3, scr, rB, lane, vB, sB); else p0_item_finish<0>(DM, DM, W4, scr, rB, lane, vB, sB); }
#else
        for (int it = gw; it < I2 + I3 + I4; it += NGW) {
            int r = it;
            if (r < I2) { p0_transpose_item<0>(P.conv_w_out + (size_t)j * CE * DM, CE, DM, nullptr, W2, scr, r, lane); continue; } r -= I2;
            if (r < I3) { p0_transpose_item<3>(P.attn_w_in + (size_t)j * DM * AN, DM, AN, P.attn_norm + j * DM, W3, scr, r, lane); continue; } r -= I3;
            p0_transpose_item<0>(P.attn_w_out + (size_t)j * DM * DM, DM, DM, nullptr, W4, scr, r, lane);
        }
#endif
    }
}
__device__ __forceinline__ void p0_rows_load(const float* x, int m, int lane, f32x4 (&v)[8]) {
    const GAS f32x4* xr = (const GAS f32x4*)(x + (size_t)m * DM) + lane;
#pragma unroll
    for (int jj = 0; jj < 8; ++jj) v[jj] = P0_LD(xr + 64 * jj);
}
__device__ __forceinline__ void p0_rows_finish(bf16* XB, float* SSQ, int m, int lane, const f32x4 (&v)[8]) {
    GAS v2u* o8 = (GAS v2u*)(XB + (size_t)m * DM) + lane;
    float s0 = 0.f, s1 = 0.f;
#pragma unroll
    for (int jj = 0; jj < 8; ++jj) { const f32x4 t = v[jj]; const float q = (t.x * t.x + t.y * t.y) + (t.z * t.z + t.w * t.w); if (jj < 4) s0 += q; else s1 += q;
        v2u w; w.x = pk2(t.x, t.y); w.y = pk2(t.z, t.w); o8[64 * jj] = w; }
    s0 = wave_sum(s0); s1 = wave_sum(s1);
    if (lane < 32) SSQ[(size_t)m * 16 + lane] = lane == 0 ? s0 : (lane == 16 ? s1 : 0.f);
}
__device__ __forceinline__ void p0_prologue(const Ptrs& P, LAS unsigned char* lds, int vcu, int G, int wave, int lane, int tid) {
    const int gw = vcu * 8 + wave, NGW = G * 8;
    bf16* XB = (bf16*)(P.ws + WS_XB); float* SSQ = (float*)(P.ws + WS_SSQ);
#if P0_PIPE
    constexpr int I1 = (DM / 64) * (CN / 64);
    LAS float* scr = (LAS float*)(lds + wave * 16640);
    f32x4 vw[16], sw[2], va[8], vb[8];
    const int step = 2 * NGW;
    int m = 2 * gw;
    if (gw < I1) p0_item_load(P.conv_w_in, CN, gw, lane, vw, P.conv_norm, sw);
    if (m < MROWS) p0_rows_load(P.x, m, lane, va);
    if (gw < I1) p0_item_finish<1>(DM, CN, (bf16*)(P.ws + WS_W1), scr, gw, lane, vw, sw);
    for (int it = gw + NGW; it < I1; it += NGW) p0_transpose_item<1>(P.conv_w_in, DM, CN, P.conv_norm, (bf16*)(P.ws + WS_W1), scr, it, lane);
    for (; m < MROWS; m += 2 * step) {
        const int m2 = m + step, m3 = m2 + step;
        if (m2 < MROWS) p0_rows_load(P.x, m2, lane, vb);
        p0_rows_finish(XB, SSQ, m, lane, va);
        if (m3 < MROWS) p0_rows_load(P.x, m3, lane, va);
        if (m2 < MROWS) p0_rows_finish(XB, SSQ, m2, lane, vb);
    }
#else
    p0_weights<0>(P, 0, lds, vcu, G, wave, lane);
    for (int m = 2 * gw; m < MROWS; m += 2 * NGW) {
        f32x4 v[8];
        p0_rows_load(P.x, m, lane, v);
        p0_rows_finish(XB, SSQ, m, lane, v);
    }
#endif
    float* BT = (float*)(P.ws + WS_BIAS);
    for (int i = vcu * 512 + tid; i < NG * NH * 132; i += G * 512) {
        const int g = i / (NH * 132), r = i % (NH * 132), h = r / 132, st = r % 132;
        const int dil = g == 0 ? 1 : (g == 1 ? 4 : 16);
        BT[i] = st <= 128 ? P.rel_bias[t5_bucket(st * dil) * (NG * NH) + g * NH + h] * LOG2E : 0.f;
    }
}
__device__ __forceinline__ void conv_fixup(bf16* Y, const float* side, const float* cw, int pm, int tid) {
    if ((pm & 15) == 0) return;
    const int ch = 4 * tid;
    const f32x4 g0 = *(const f32x4*)(side + ((size_t)pm * 6 + 0) * CE + ch), g1 = *(const f32x4*)(side + ((size_t)pm * 6 + 1) * CE + ch);
    const f32x4 c0 = *(const f32x4*)(side + ((size_t)pm * 6 + 2) * CE + ch), c1 = *(const f32x4*)(side + ((size_t)pm * 6 + 3) * CE + ch);
    const f32x4 va = *(const f32x4*)(side + ((size_t)(pm - 1) * 6 + 4) * CE + ch), vb = *(const f32x4*)(side + ((size_t)(pm - 1) * 6 + 5) * CE + ch);
    const f32x4 w0 = *(const f32x4*)(cw + ch), w1 = *(const f32x4*)(cw + CE + ch);
    const f32x4 y0 = g0 * (c0 + w1 * vb + w0 * va), y1 = g1 * (c1 + w0 * vb);
    v2u a, b; a.x = pk2(y0[0], y0[1]); a.y = pk2(y0[2], y0[3]); b.x = pk2(y1[0], y1[1]); b.y = pk2(y1[2], y1[3]);
    *(v2u*)(Y + (size_t)(pm * 256) * CE + ch) = a; *(v2u*)(Y + (size_t)(pm * 256 + 1) * CE + ch) = b;
}

namespace attn {
typedef float f32x16 __attribute__((ext_vector_type(16)));
typedef short s16x4 __attribute__((ext_vector_type(4)));
typedef short v4i16_t __attribute__((ext_vector_type(4)));
constexpr int L_K = 0, L_V = 49152, L_B = 98304, L_O = 118784, L_END = 151552, L_JUNK = 151552, L_WS = 161536 + 256;
__device__ __forceinline__ int rot3(int x) { return x >= 3 ? x - 3 : x; }
static_assert(L_O + 8 * 4096 == L_END && L_B + 5 * 4096 == L_O, "attention LDS map");
__device__ __forceinline__ int crow(int r, int hi) { return (r & 3) + 8 * (r >> 2) + 4 * hi; }
__device__ __forceinline__ s16x4 vtr(LAS const unsigned char* p) { return __builtin_bit_cast(s16x4, __builtin_amdgcn_ds_read_tr16_b64_v4i16((LAS v4i16_t*)p)); }
__device__ __forceinline__ float swapmax(float m) { auto rr = __builtin_amdgcn_permlane32_swap(__float_as_uint(m), __float_as_uint(m), false, false); return fmaxf(__uint_as_float(rr[0]), __uint_as_float(rr[1])); }
__device__ __forceinline__ float swapsum(float m) { auto rr = __builtin_amdgcn_permlane32_swap(__float_as_uint(m), __float_as_uint(m), false, false); return __uint_as_float(rr[0]) + __uint_as_float(rr[1]); }

#define ATT_BAR() asm volatile("s_waitcnt lgkmcnt(0)\n\ts_barrier" ::: "memory")
#ifndef ATT_O_NT
#define ATT_O_NT 0
#endif
#ifndef ATT_PRIO
#define ATT_PRIO 0
#endif
#ifndef ATT_KEEP_TAIL
#define ATT_KEEP_TAIL 0
#endif
#ifndef ATT_NT
#define ATT_NT " nt"
#endif
__device__ __forceinline__ void glds16_keep(const void* gsrc, unsigned lds_dst) { unsigned keep;
    asm volatile("s_mov_b32 %0, m0\n\ts_mov_b32 m0, %2\n\ts_nop 0\n\tglobal_load_lds_dwordx4 %1, off\n\ts_mov_b32 m0, %0" : "=&s"(keep) : "v"(gsrc), "s"(lds_dst) : "memory"); }
__device__ __forceinline__ void glds16(const void* gsrc, unsigned lds_dst) { unsigned keep;
    asm volatile("s_mov_b32 %0, m0\n\ts_mov_b32 m0, %2\n\ts_nop 0\n\tglobal_load_lds_dwordx4 %1, off" ATT_NT "\n\ts_mov_b32 m0, %0" : "=&s"(keep) : "v"(gsrc), "s"(lds_dst) : "memory"); }
template <int DIL> struct Job {
    int bh, c, n0, h; size_t rowb, base;
    __device__ __forceinline__ void decode(int id) { constexpr int CPC = (SEQ / DIL) / 256; bh = id >> 4; const int sub = id & 15; c = sub / CPC; n0 = (sub % CPC) * 256; h = bh & 15; rowb = (size_t)(bh >> 4) * SEQ;
        base = ((size_t)bh * SEQ + (size_t)c * (SEQ / DIL)) * HD; }
};
__device__ __forceinline__ void glds16s(unsigned voff, const void* sbase, unsigned lds_dst) { unsigned keep;
    asm volatile("s_mov_b32 %0, m0\n\ts_mov_b32 m0, %2\n\ts_nop 0\n\tglobal_load_lds_dwordx4 %1, %3 nt\n\ts_mov_b32 m0, %0" : "=&s"(keep) : "v"(voff), "s"(lds_dst), "s"(sbase) : "memory"); }
template <int DIL, bool ISV> __device__ __forceinline__ void issue_kv(LAS unsigned char* lds, const bf16* src, const Job<DIL>& J, int w, int lane, int rot, bool cont) {
    const int r8 = lane >> 3, pc = lane & 7;
    const bf16* sbase = src + J.base;
    const int pos0 = J.n0 - 128 + w * 48 + r8;
    const int swE = ISV ? ((((pc >> 2) ^ ((r8 >> 1) & 1)) * 64) + (pc & 3) * 16) : ((pc ^ (r8 >> 1)) * 16);
    const int swO = ISV ? swE : ((pc ^ (4 + (r8 >> 1))) * 16);
#pragma unroll
    for (int i = 0; i < 6; ++i) {
        const int kb = w * 6 + i, lb = kb >> 4;
        const bool junk = cont && lb == 0;
        int pos = pos0 + 8 * i; pos = (pos < 0 || junk) ? 0 : pos;
        const unsigned voff = (unsigned)(pos * 128 + ((i & 1) ? swO : swE));
        const int dst = junk ? L_JUNK : (ISV ? L_V : L_K) + rot3(lb + rot) * 16384 + (kb & 15) * 1024;
        glds16s(voff, sbase, (unsigned)__builtin_amdgcn_readfirstlane((int)((unsigned)(uintptr_t)lds + dst)));
    }
}
__device__ __forceinline__ void ld16_asm(bf16x8& dst, const bf16* p) { asm volatile("global_load_dwordx4 %0, %1, off" : "=v"(dst) : "v"(p) : "memory"); }

template <int DIL> __device__ __forceinline__ void phase(LAS unsigned char* lds, const bf16* QO, bf16* OUT, const bf16* Kg, const bf16* Vg, const float* biasT  , float* lse  , int vcu, int G, int jlo = 0, int jhi = 4) {
    const int tid = threadIdx.x, lane = tid & 63, r32 = lane & 31, hi = lane >> 5;
    const int w = __builtin_amdgcn_readfirstlane(tid >> 6);
    constexpr int NJS = BATCH * NH * 16;
    int id = vcu * 4 + jlo;
    if (id >= NJS || jlo >= jhi) return;
    Job<DIL> J; J.decode(id);
    bf16x8 q0, q1, q2, q3;
    int rot = 0;
    issue_kv<DIL, false>(lds, Kg, J, w, lane, 0, false);
    { const bf16* qp = QO + J.base + (size_t)(J.n0 + 32 * w + r32) * HD + hi * 8; ld16_asm(q0, qp); ld16_asm(q1, qp + 16); ld16_asm(q2, qp + 32); ld16_asm(q3, qp + 48); }
    issue_kv<DIL, true>(lds, Vg, J, w, lane, 0, false);
    int cur_bh = -1; bool first = true;
    for (;;) {
        const int nid = id + (((id & 3) == jhi - 1) ? (G * 4 - (jhi - 1 - jlo)) : 1);
        const bool has_next = nid < NJS;
        Job<DIL> JN; JN.decode(has_next ? nid : id);
        if (J.bh != cur_bh) {
            cur_bh = J.bh;
            float bv[10]; bool bok[10];
#pragma unroll
            for (int i = 0; i < 10; ++i) {
                const int e = tid + 512 * i, j = e >> 10, rem = e & 1023, rg = rem >> 8, ln = (rem & 255) >> 2, i4 = rem & 3;
                const int r = 4 * rg + i4, a = ln & 31, hh = ln >> 5, kk = 32 * j + crow(r, hh), step = 128 + a - kk;
                bv[i] = biasT[J.h * 132 + (step < 0 ? 0 : (step > 128 ? 128 : step))];
                bok[i] = step >= 0 && step <= 128;
            }
#pragma unroll
            for (int i = 0; i < 10; ++i) ((LAS float*)(lds + L_B))[tid + 512 * i] = bok[i] ? bv[i] : -INFINITY;
        }
        if (first) { first = false; asm volatile("s_waitcnt vmcnt(6)" : "+v"(q0), "+v"(q1), "+v"(q2), "+v"(q3) :: "memory"); }
        ATT_BAR();
        const int n0 = J.n0, h = J.h, c = J.c; const size_t rowb = J.rowb, jbase = J.base;
        const size_t qrow = rowb + (size_t)(n0 + 32 * w + r32) * DIL + c;
        const int jstart = (n0 == 0 && w < 4) ? 4 - w : 0;
        int toff[5];
#pragma unroll
        for (int j = 0; j < 5; ++j) { const int tb = w + j; toff[j] = rot3((tb >> 2) + rot) * 16384 + (tb & 3) * 4096; }
        const int rotn = rot3(rot + 2);
        const bool cont = (DIL != 16) && has_next && JN.bh == J.bh && JN.c == J.c && JN.n0 == J.n0 + 256;
        f32x16 S[5];
#if ATT_PRIO
        __builtin_amdgcn_s_setprio(1);
#endif
#pragma unroll
        for (int j = 0; j < 5; ++j) {
            if (j < jstart) {
#pragma unroll
                for (int r = 0; r < 16; ++r) S[j][r] = -INFINITY;
            } else {
                f32x16 cinit;
#pragma unroll
                for (int rg = 0; rg < 4; ++rg) { const f32x4 t = *(const LAS f32x4*)(lds + L_B + j * 4096 + rg * 1024 + lane * 16); cinit[4 * rg] = t[0]; cinit[4 * rg + 1] = t[1]; cinit[4 * rg + 2] = t[2]; cinit[4 * rg + 3] = t[3]; }
#pragma unroll
                for (int d0 = 0; d0 < 4; ++d0) {
                    const bf16x8 kf = *(const LAS bf16x8*)(lds + L_K + toff[j] + r32 * 128 + (((2 * d0 + hi) ^ ((r32 >> 1) & 7)) * 16));
                    cinit = __builtin_amdgcn_mfma_f32_32x32x16_bf16(kf, d0 == 0 ? q0 : (d0 == 1 ? q1 : (d0 == 2 ? q2 : q3)), cinit, 0, 0, 0);
                }
                S[j] = cinit;
            }
        }
#if ATT_PRIO
        __builtin_amdgcn_s_setprio(0);
#endif
        ATT_BAR();
        bf16x8 n0q, n1q, n2q, n3q;
        if (has_next) {
            issue_kv<DIL, false>(lds, Kg, JN, w, lane, rotn, cont);
            const bf16* qp = QO + JN.base + (size_t)(JN.n0 + 32 * w + r32) * HD + hi * 8; ld16_asm(n0q, qp); ld16_asm(n1q, qp + 16); ld16_asm(n2q, qp + 32); ld16_asm(n3q, qp + 48);
        }
        float m = -INFINITY;
#pragma unroll
        for (int j = 0; j < 5; ++j)
#pragma unroll
            for (int r = 0; r < 16; ++r) m = fmaxf(m, S[j][r]);
        m = swapmax(m);
        const f32x2_t nm2 = (f32x2_t){-m, -m};
        f32x16 lsv = (f32x16){0.f, 0.f, 0.f, 0.f, 0.f, 0.f, 0.f, 0.f, 0.f, 0.f, 0.f, 0.f, 0.f, 0.f, 0.f, 0.f};
#pragma unroll
        for (int j = 0; j < 5; ++j) {
            f32x16 d;
#pragma unroll
            for (int r = 0; r < 16; r += 2) { const f32x2_t t2 = (f32x2_t){S[j][r], S[j][r + 1]} + nm2; d[r] = t2[0]; d[r + 1] = t2[1]; }
            f32x16 pv;
#pragma unroll
            for (int r = 0; r < 16; ++r) pv[r] = __builtin_amdgcn_exp2f(d[r]);
            S[j] = pv; lsv += pv;
        }
        float lsum = ((lsv[0] + lsv[1]) + (lsv[2] + lsv[3])) + ((lsv[4] + lsv[5]) + (lsv[6] + lsv[7])) + (((lsv[8] + lsv[9]) + (lsv[10] + lsv[11])) + ((lsv[12] + lsv[13]) + (lsv[14] + lsv[15])));
        lsum = swapsum(lsum);
        if (has_next) asm volatile("s_waitcnt vmcnt(10)" ::: "memory"); else asm volatile("s_waitcnt vmcnt(0)" ::: "memory");
        ATT_BAR();
        f32x16 o[2];
        const int vq = (lane & 15) >> 2, vx = (vq >> 1) & 1;
        const LAS unsigned char* vrow = lds + L_V + (4 * hi + vq) * 128 + ((lane >> 4) & 1) * 32 + (lane & 3) * 8;
        const LAS unsigned char* vbh[2] = {vrow + vx * 64, vrow + (1 - vx) * 64};
#pragma unroll
        for (int j = 0; j < 5; ++j)
#pragma unroll
            for (int s = 0; s < 2; ++s) {
                v4u pw; pw.x = pk2(S[j][8 * s], S[j][8 * s + 1]); pw.y = pk2(S[j][8 * s + 2], S[j][8 * s + 3]); pw.z = pk2(S[j][8 * s + 4], S[j][8 * s + 5]); pw.w = pk2(S[j][8 * s + 6], S[j][8 * s + 7]);
                const bf16x8 pa = __builtin_bit_cast(bf16x8, pw);
#pragma unroll
                for (int d0 = 0; d0 < 2; ++d0) {
                    const s16x4 lo = vtr(vbh[d0] + toff[j] + (16 * s) * 128), hh = vtr(vbh[d0] + toff[j] + (16 * s + 8) * 128);
                    const bf16x8 vf = (bf16x8){lo[0], lo[1], lo[2], lo[3], hh[0], hh[1], hh[2], hh[3]};
                    o[d0] = __builtin_amdgcn_mfma_f32_32x32x16_bf16(vf, pa, (j == 0 && s == 0) ? (f32x16){0.f, 0.f, 0.f, 0.f, 0.f, 0.f, 0.f, 0.f, 0.f, 0.f, 0.f, 0.f, 0.f, 0.f, 0.f, 0.f} : o[d0], 0, 0, 0);
                }
            }
        ATT_BAR();
        if (has_next) issue_kv<DIL, true>(lds, Vg, JN, w, lane, rotn, cont);
        if (hi == 0) lse[qrow * 16 + h] = m + log2f(lsum);
        const float inv = __builtin_amdgcn_rcpf(lsum);
        LAS unsigned char* stg = lds + L_O + w * 4096;
#pragma unroll
        for (int d0 = 0; d0 < 2; ++d0)
#pragma unroll
            for (int g4 = 0; g4 < 4; ++g4) {
                v2u pk; pk.x = pk2(o[d0][4 * g4] * inv, o[d0][4 * g4 + 1] * inv); pk.y = pk2(o[d0][4 * g4 + 2] * inv, o[d0][4 * g4 + 3] * inv);
                *(LAS v2u*)(stg + r32 * 128 + (((4 * d0 + g4) ^ (r32 & 7)) * 16) + hi * 8) = pk;
            }
        asm volatile("s_waitcnt lgkmcnt(0)" ::: "memory");
#pragma unroll
        for (int i = 0; i < 4; ++i) { const int row = i * 8 + (lane >> 3), ch = lane & 7; const v4u v = *(const LAS v4u*)(stg + row * 128 + ((ch ^ (row & 7)) * 16));

#if ATT_O_NT
            __builtin_nontemporal_store(v, (v4u*)(OUT + jbase + (size_t)(n0 + 32 * w + row) * HD + ch * 8)); }
#else
            st16(OUT + jbase + (size_t)(n0 + 32 * w + row) * HD + ch * 8, v); }
#endif

        if (!has_next) break;
        asm volatile("s_waitcnt vmcnt(6)" : "+v"(n0q), "+v"(n1q), "+v"(n2q), "+v"(n3q) :: "memory");
        id = nid; J = JN; q0 = n0q; q1 = n1q; q2 = n2q; q3 = n3q; rot = rotn;
    }
    asm volatile("s_waitcnt vmcnt(0) lgkmcnt(0)\n\ts_barrier" ::: "memory");
}
#undef ATT_BAR
}

#ifndef PARITY_SPLIT
#define PARITY_SPLIT 1
#endif
#ifndef GEMM_SP2
#define GEMM_SP2 true
#endif
#ifndef GEMM_ALIGN
#define GEMM_ALIGN true
#endif
#ifndef DUP_RES
#define DUP_RES 0
#endif
#ifndef DUP_A2
#define DUP_A2 0
#endif
#ifndef DUP_A3
#define DUP_A3 0
#endif
#ifndef ATT_SPLIT
#define ATT_SPLIT 4
#endif
#ifndef DUP_EPI
#define DUP_EPI 0
#endif
#ifndef PARITY_EXPR
#define PARITY_EXPR ((bx & 1) != 0)
#endif
#ifndef CONV_PARITY_EXPR
#define CONV_PARITY_EXPR PARITY_EXPR
#endif
#ifndef ONE_ALIGN
#define ONE_ALIGN false
#endif
#ifndef DUP_BAR
#define DUP_BAR 0
#endif
#ifndef RESID0_BF16
#define RESID0_BF16 1
#endif
constexpr int LDS_BYTES = 163840;
constexpr int XCH_OFF = 131072;
constexpr int MISC_OFF = 161536;
struct Args { const float* in[11]; float* out; unsigned char* ws; int ph_lo, ph_hi; };

enum PhaseKind { PK_P0A, PK_P0B, PK_C1, PK_C3, PK_A1, PK_A1A2, PK_A2, PK_A3, PK_A4 };
struct PhaseDesc { int kind, j, g; };
__host__ __device__ constexpr PhaseDesc phase_desc(int ph) {
    if (ph == 0) return {PK_P0A, 0, 0};
    const int j = ph >= 9 ? 1 : 0, s = ph - (j ? 9 : 1);
    switch (s) {
        case 0: return {PK_C1, j, 0};
        case 1: return {PK_C3, j, 0};
        case 2: return {PK_A1, j, 0};
        case 3: return {PK_A1A2, j, 0};
        case 4: return {PK_A1A2, j, 1};
        case 5: return {PK_A2, j, 2};
        case 6: return {PK_A3, j, 0};
        default: return {PK_A4, j, 0};
    }
}
__device__ __forceinline__ size_t kbuf_off(int g) { return g == 1 ? WS_KB : WS_KA; }
__device__ __forceinline__ size_t vbuf_off(int g) { return g == 1 ? WS_VB : WS_VA; }

template <int J, int G1> __device__ __forceinline__ void run_qkv_gemm(const Args& args, LAS unsigned char* lds, int G, int bx) {
    unsigned char* ws = args.ws;
    bf16* XB = (bf16*)(ws + WS_XB); float* SSQ = (float*)(ws + WS_SSQ);
    bf16* QO = (bf16*)(ws + WS_QO) + (size_t)G1 * MROWS * DM;
    pg8::Gemm gm{XB, (const bf16*)(ws + WS_W3) + (size_t)G1 * 3072 * DM, MROWS, 3072, DM}; pg8::StaticOrder S; S.init(MROWS, 3072, G, bx);
    epi::QKV E{SSQ, QO, (bf16*)(ws + kbuf_off(G1)), (bf16*)(ws + vbuf_off(G1)), args.in[7] + (J * NG + G1) * HD, args.in[8] + (J * NG + G1) * HD, lds, 2 * G1, (DUP_EPI != 0 && G1 == 0) ? (bf16*)(ws + WS_QO) + (size_t)2 * MROWS * DM : nullptr};
    pg8::gemm_phase<epi::QKV, pg8::StaticOrder, GEMM_ALIGN, GEMM_SP2>(lds, gm, S, E);
}
template <int G0> __device__ __forceinline__ void run_attn(const Args& args, LAS unsigned char* lds, int vcu, int G, int jlo = 0, int jhi = 4) {
    unsigned char* ws = args.ws;
    constexpr int dil = G0 == 0 ? 1 : (G0 == 1 ? 4 : 16);
    bf16* QO = (bf16*)(ws + WS_QO) + (size_t)G0 * MROWS * DM;
    attn::phase<dil>(lds, QO, QO, (const bf16*)(ws + kbuf_off(G0)), (const bf16*)(ws + vbuf_off(G0)), (const float*)(ws + WS_BIAS) + G0 * NH * 132, (float*)(ws + WS_LSE) + (size_t)G0 * MROWS * 16, vcu, G, jlo, jhi);
}

template <int PH> __device__ __forceinline__ void run_phase(const Args& args, LAS unsigned char* lds) {
    constexpr PhaseDesc D = phase_desc(PH);
    constexpr int j = D.j;
    const int tid = threadIdx.x, lane = tid & 63, wave = __builtin_amdgcn_readfirstlane(tid >> 6);
    const int G = gridDim.x, bx = PH == 0 ? (int)blockIdx.x : __builtin_amdgcn_readfirstlane((int)((volatile LAS unsigned*)(lds + MISC_OFF))[8 + 3]), vcu = (G % 8 == 0) ? (bx % 8) * (G / 8) + bx / 8 : bx;
    unsigned char* ws = args.ws;
    float* SSQ = (float*)(ws + WS_SSQ); bf16* XB = (bf16*)(ws + WS_XB);
    (void)lane; (void)wave; (void)SSQ; (void)XB; (void)vcu;
    if constexpr (D.kind == PK_P0A || D.kind == PK_P0B) {
        Ptrs P;
        P.x = args.in[0]; P.conv_norm = args.in[1]; P.conv_w_in = args.in[2]; P.conv_w = args.in[3]; P.conv_w_out = args.in[4]; P.attn_norm = args.in[5];
        P.attn_w_in = args.in[6]; P.q_gain = args.in[7]; P.k_gain = args.in[8]; P.attn_w_out = args.in[9]; P.rel_bias = args.in[10]; P.out = args.out; P.ws = args.ws;
        if constexpr (D.kind == PK_P0A) p0_prologue(P, lds, vcu, G, wave, lane, tid);
        else p0_weights<0>(P, 1, lds, vcu, G, wave, lane);
    } else if constexpr (D.kind == PK_C1) {
        Ptrs P;
        P.x = args.in[0]; P.conv_norm = args.in[1]; P.conv_w_in = args.in[2]; P.conv_w = args.in[3]; P.conv_w_out = args.in[4]; P.attn_norm = args.in[5];
        P.attn_w_in = args.in[6]; P.q_gain = args.in[7]; P.k_gain = args.in[8]; P.attn_w_out = args.in[9]; P.rel_bias = args.in[10]; P.out = args.out; P.ws = args.ws;
        const bool conv_first = CONV_PARITY_EXPR;
        if (conv_first) { p0_weights<1>(P, j, lds, vcu, G, wave, lane); __syncthreads(); }
        pg8::Gemm g{XB, (const bf16*)(ws + WS_W1), MROWS, CN, DM}; pg8::StaticOrder S; S.init(MROWS, CN, G, bx);
        epi::ConvFused E{SSQ, (bf16*)(ws + WS_CG), args.in[3] + (size_t)j * 3 * CE, (float*)(ws + WS_SIDE), lds + XCH_OFF};
        pg8::gemm_phase<epi::ConvFused, pg8::StaticOrder, true, GEMM_SP2>(lds, g, S, E);
        if (!conv_first) p0_weights<1>(P, j, lds, vcu, G, wave, lane);
    } else if constexpr (D.kind == PK_C3 || D.kind == PK_A4) {
        constexpr bool C3 = D.kind == PK_C3; constexpr int K = C3 ? CE : DM;
        const bf16* A = (const bf16*)(ws + (C3 ? WS_CG : WS_Y));
        pg8::Gemm g{A, (const bf16*)(ws + (C3 ? WS_W2 : WS_W4)), MROWS, DM, K}; pg8::StaticOrder S; S.init(MROWS, DM, G, bx);
        if constexpr (C3) { pg8::Unit fu; for (int i = 0; S.next(i, fu); ++i) conv_fixup((bf16*)(ws + WS_CG), (const float*)(ws + WS_SIDE), args.in[3] + (size_t)j * 3 * CE, fu.pm, tid);
            asm volatile("s_waitcnt vmcnt(0)" ::: "memory"); __syncthreads(); }
        constexpr int RMODE = (j == 0 && C3 && !RESID0_BF16) ? 0 : ((j == 1 && !C3) ? 2 : 1);
#if DUP_RES
        if constexpr (RMODE == 1 && (DUP_RES == 1) == C3) { epi::ResidB<RMODE> E2{args.in[0], args.out, XB, SSQ, (bf16*)(ws + WS_VB)}; pg8::gemm_phase<epi::ResidB<RMODE>, pg8::StaticOrder, false, true>(lds, g, S, E2); }
#endif
#ifdef DUP_NULL
        if constexpr (!C3 && j == 0) { for (int rep = 0; rep < DUP_NULL; ++rep) { epi::NullEpi E0{(float*)(ws + WS_SIDE)}; pg8::gemm_phase<epi::NullEpi, pg8::StaticOrder, ONE_ALIGN, true>(lds, g, S, E0); } }
#endif
        epi::ResidB<RMODE> E{args.in[0], args.out, XB, SSQ, XB};
        pg8::gemm_phase<epi::ResidB<RMODE>, pg8::StaticOrder, ONE_ALIGN, true>(lds, g, S, E);
    } else if constexpr (D.kind == PK_A1) {
        if constexpr (j == 0) {
            Ptrs P;
            P.x = args.in[0]; P.conv_norm = args.in[1]; P.conv_w_in = args.in[2]; P.conv_w = args.in[3]; P.conv_w_out = args.in[4]; P.attn_norm = args.in[5];
            P.attn_w_in = args.in[6]; P.q_gain = args.in[7]; P.k_gain = args.in[8]; P.attn_w_out = args.in[9]; P.rel_bias = args.in[10]; P.out = args.out; P.ws = args.ws;
            const bool conv_first = CONV_PARITY_EXPR;
            if (conv_first) { p0_weights<0>(P, 1, lds, vcu, G, wave, lane); __syncthreads(); }
            run_qkv_gemm<j, 0>(args, lds, G, bx);
            if (!conv_first) p0_weights<0>(P, 1, lds, vcu, G, wave, lane);
        } else run_qkv_gemm<j, 0>(args, lds, G, bx);
    } else if constexpr (D.kind == PK_A1A2) {
#if PARITY_SPLIT
        const bool attn_first = PARITY_EXPR;
#else
        const bool attn_first = false;
#endif
        if (attn_first) { run_attn<D.g>(args, lds, vcu, G, 0, ATT_SPLIT); run_qkv_gemm<j, D.g + 1>(args, lds, G, bx); run_attn<D.g>(args, lds, vcu, G, ATT_SPLIT, 4); }
        else            { run_qkv_gemm<j, D.g + 1>(args, lds, G, bx); run_attn<D.g>(args, lds, vcu, G); }
    } else if constexpr (D.kind == PK_A2) {
#if DUP_A2
        { constexpr int dil = 16; bf16* QO = (bf16*)(ws + WS_QO) + (size_t)2 * MROWS * DM;
          attn::phase<dil>(lds, QO, (bf16*)(ws + WS_VB), (const bf16*)(ws + kbuf_off(2)), (const bf16*)(ws + vbuf_off(2)), (const float*)(ws + WS_BIAS) + 2 * NH * 132, (float*)(ws + WS_LSE) + (size_t)2 * MROWS * 16, vcu, G); }
#endif
        run_attn<D.g>(args, lds, vcu, G);
    } else if constexpr (D.kind == PK_A3) {
        const bf16* O0 = (const bf16*)(ws + WS_QO); const bf16* O1 = O0 + (size_t)MROWS * DM; const bf16* O2 = O1 + (size_t)MROWS * DM;
        pg8::Gemm g{XB, (const bf16*)(ws + WS_W3) + (size_t)QKVC * DM, MROWS, DM, DM}; pg8::StaticOrder S; S.init(MROWS, DM, G, bx);
        epi::ZMerge E{SSQ, O0, O1, O2, (const float*)(ws + WS_LSE), (bf16*)(ws + WS_Y), lds};
#if DUP_A3
        pg8::gemm_phase<epi::ZMerge, pg8::StaticOrder, false, true>(lds, g, S, E);
#endif
        pg8::gemm_phase<epi::ZMerge, pg8::StaticOrder, ONE_ALIGN, true>(lds, g, S, E);
    }
}

__global__ void __launch_bounds__(512, 2) mk_fwd(Args args) {
    extern __shared__ __attribute__((aligned(16))) unsigned char lds_raw[];
    LAS unsigned char* lds = (LAS unsigned char*)lds_raw;
    volatile LAS unsigned* MISC = (volatile LAS unsigned*)(lds + MISC_OFF);
    for (int u = threadIdx.x; u < (LDS_BYTES - MISC_OFF) / 4; u += 512) ((LAS unsigned*)(lds + MISC_OFF))[u] = 0u;
    __syncthreads();
    gu32* ctl = (gu32*)(args.ws + WS_CTL);
    XcdBarrier bar; bar.bar = (unsigned*)(ctl + CW_BAR); bar.x = 0; bar.st = nullptr;
    const int lo = args.ph_lo, hi = args.ph_hi;
    if (hi - lo > 1) bar = xcd_barrier_post((unsigned*)(ctl + CW_BAR), MISC + 8);
#if DUP_BAR
#define RUN(k) if (lo <= (k) && (k) < hi) { run_phase<(k)>(args, lds); if ((k) + 1 < hi) { xcd_barrier(bar); xcd_barrier(bar); } }
#else
#define RUN(k) if (lo <= (k) && (k) < hi) { run_phase<(k)>(args, lds); if ((k) + 1 < hi) { if constexpr (phase_desc(k).kind == PK_C3 || phase_desc(k).kind == PK_A3) xcd_barrier_local(bar); else xcd_barrier(bar); } }
#endif
    RUN(0) RUN(1) RUN(2) RUN(3) RUN(4) RUN(5) RUN(6) RUN(7) RUN(8) RUN(9) RUN(10) RUN(11) RUN(12) RUN(13) RUN(14) RUN(15) RUN(16)
#undef RUN
}

extern "C" void kernel_launch(void* const* d_in, const int* in_sizes, int n_in, void* d_out, int out_size, void* d_ws, size_t ws_size, hipStream_t stream) {
    static int grid = 0;
    if (grid == 0) {
        if (n_in != 11 || in_sizes[0] != MROWS * DM || out_size != MROWS * DM || ws_size < WS_END) { fprintf(stderr, "kernel_launch: unexpected shapes (n_in %d, ws %zu); nothing launched\n", n_in, ws_size); grid = -1; return; }
        int dev = 0, cus = 0, per_cu = 0;
        if (hipGetDevice(&dev) != hipSuccess || hipDeviceGetAttribute(&cus, hipDeviceAttributeMultiprocessorCount, dev) != hipSuccess) { grid = -1; return; }
        if (hipFuncSetAttribute((const void*)mk_fwd, hipFuncAttributeMaxDynamicSharedMemorySize, LDS_BYTES) != hipSuccess) { fprintf(stderr, "kernel_launch: hipFuncSetAttribute failed\n"); grid = -1; return; }
        if (hipOccupancyMaxActiveBlocksPerMultiprocessor(&per_cu, (const void*)mk_fwd, 512, LDS_BYTES) != hipSuccess || per_cu < 1) { fprintf(stderr, "kernel_launch: occupancy query says %d blocks per CU; nothing launched\n", per_cu); (void)hipGetLastError(); grid = -1; return; }
        if (cus < 256) { fprintf(stderr, "kernel_launch: built for >= 256 CUs (per-phase LDS tables hold 8 units per workgroup); %d found; nothing launched\n", cus); grid = -1; return; }
        grid = cus;
    }
    if (grid < 0) return;
    (void)hipMemsetAsync((char*)d_ws + WS_CTL, 0, CTL_ZERO_BYTES, stream);
    Args a{};
    for (int i = 0; i < 11; ++i) a.in[i] = (const float*)d_in[i];
    a.out = (float*)d_out; a.ws = (unsigned char*)d_ws;
    a.ph_lo = 0; a.ph_hi = NPHASE; hipLaunchKernelGGL(mk_fwd, dim3(grid), dim3(512), LDS_BYTES, stream, a);
}
```

```cpp
#include <hip/hip_runtime.h>
#include <cstdio>
#include <cstdint>
#include <cmath>
#define PARITY_EXPR ((bx&3)>0)
#define CONV_PARITY_EXPR ((bx&1)>0)
namespace pg8 {
#define PG8_LAS __attribute__((address_space(3)))
typedef unsigned short bf16_t;
typedef short bf16x8 __attribute__((ext_vector_type(8)));
typedef float f32x4 __attribute__((ext_vector_type(4)));
typedef unsigned u32x4 __attribute__((ext_vector_type(4)));
constexpr int BM = 256, BK = 64, HALF = 128, HTB = HALF * BK * 2  , STAGE_BYTES = 8 * HTB, NXCD = 8, WGM = 8;

__host__ __device__ __forceinline__ int lds_byte(int r, int c) { const int st = (r >> 4) * 2 + (c >> 5), rr = r & 15, cc = c & 31, ob = rr * 64 + cc * 2; return st * 1024 + (ob ^ (((ob >> 9) & 1) << 5)); }
__host__ __device__ __forceinline__ void stage_rc(int b, int& R, int& C) { const int st = b / 1024, sb = b % 1024, swz = sb ^ (((sb >> 9) & 1) << 5); R = (st >> 1) * 16 + swz / 64; C = (st & 1) * 32 + (swz % 64) / 2; }
__host__ __device__ __forceinline__ int perm32(int rho) { const int n = rho >> 4, i = rho & 15; return 8 * (i >> 2) + 4 * n + (i & 3); }

struct Unit { int pm, pn; };
struct Gemm { const bf16_t* A; const bf16_t* Bt; int M, N, K; };

struct StaticOrder {
    int nM, nN, nwg, G, c;
    __host__ __device__ void init(int M, int N, int G_, int c_) { nM = M / BM; nN = N / BM; nwg = nM * nN; G = G_; c = c_; }
    __host__ __device__ bool next(int i, Unit& u) const {
        const long L = (long)i * G + c; if (L >= nwg) return false;
        int wgid = (int)L; { const int q = nwg / NXCD, r = nwg % NXCD, xcd = wgid % NXCD, off = wgid / NXCD; wgid = (xcd < r ? xcd * (q + 1) : r * (q + 1) + (xcd - r) * q) + off; }
        const int nig = WGM * nN, gid = wgid / nig, fm = gid * WGM, gsz = (nM - fm) < WGM ? (nM - fm) : WGM;
        u.pm = fm + ((wgid % nig) % gsz); u.pn = (wgid % nig) / gsz; return true;
    }
    __device__ __forceinline__ void a_ready(const Unit&) const {}
    __device__ __forceinline__ void done(const Unit&) const {}
};

__device__ __forceinline__ unsigned cvt_pk_bf16(float lo, float hi) { unsigned r; asm volatile("v_cvt_pk_bf16_f32 %0, %1, %2" : "=v"(r) : "v"(lo), "v"(hi)); return r; }
typedef float f32x2 __attribute__((ext_vector_type(2)));

typedef float f32x2z __attribute__((ext_vector_type(2)));
template <class Epi, class Sched, bool ALIGN_EPI = false, bool SP2 = false>
__device__ __forceinline__ void gemm_phase(PG8_LAS unsigned char* lds, const Gemm g, const Sched& S, const Epi& E) {
    const int tid = threadIdx.x, wid = __builtin_amdgcn_readfirstlane(tid >> 6), lane = tid & 63, wr = wid >> 2, wc = wid & 3, fr = lane & 15, fq = lane >> 4;
    const int K = g.K, nt = K / BK;
    unsigned voffA[2], voffB[2];
#pragma unroll
    for (int i = 0; i < 2; ++i) { int R, C; stage_rc(tid * 16 + i * 8192, R, C); const int Rb = Epi::PERM ? ((R & ~31) + perm32(R & 31)) : R;
        voffA[i] = (unsigned)(R * K + C) * 2u; voffB[i] = (unsigned)(Rb * K + C) * 2u; }
    const size_t kstep = (size_t)(BK * 2);
    const size_t hstep = (size_t)HALF * K * 2;
    const size_t tstep = 2 * hstep;
    const unsigned ldsw = (unsigned)wid * 1024u;
    const int aoff = lds_byte(wr * 64 + fr, fq * 8), boff = lds_byte(wc * 32 + fr, fq * 8);
#define PG8_SA(b, h) (((b) * 2 + (h)) * HTB)
#define PG8_SB(b, h) ((4 + (b) * 2 + (h)) * HTB)
#define PG8_STAGE(bufoff, gbase, voff) do { _Pragma("unroll") for (int _i = 0; _i < 2; ++_i) \
        __builtin_amdgcn_global_load_lds((const unsigned*)((const char*)(gbase) + (voff)[_i]), (PG8_LAS unsigned*)(lds + (bufoff) + ldsw + _i * 8192), 16, 0, 0); } while (0)
#define PG8_LDA(dst, b, h) do { _Pragma("unroll") for (int m = 0; m < 4; ++m) _Pragma("unroll") for (int k = 0; k < 2; ++k) dst[m][k] = *(const PG8_LAS bf16x8*)(lds + PG8_SA(b, h) + aoff + m * 2048 + k * 1024); } while (0)
#define PG8_LDB(dst, b, h) do { _Pragma("unroll") for (int n = 0; n < 2; ++n) _Pragma("unroll") for (int k = 0; k < 2; ++k) dst[n][k] = *(const PG8_LAS bf16x8*)(lds + PG8_SB(b, h) + boff + n * 2048 + k * 1024); } while (0)
#define PG8_MMA(ai, bj, At, Bt) do { __builtin_amdgcn_s_setprio(1); _Pragma("unroll") for (int m = 0; m < 4; ++m) _Pragma("unroll") for (int n = 0; n < 2; ++n) _Pragma("unroll") for (int k = 0; k < 2; ++k) \
        acc[ai][bj][m][n] = __builtin_amdgcn_mfma_f32_16x16x32_bf16(Bt[n][k], At[m][k], acc[ai][bj][m][n], 0, 0, 0); __builtin_amdgcn_s_setprio(0); } while (0)
#define PG8_ZERO4(x) do { f32x2z _lo, _hi; asm volatile("v_pk_mov_b32 %0, 0, 0" : "=v"(_lo)); asm volatile("v_pk_mov_b32 %0, 0, 0" : "=v"(_hi)); (x) = (f32x4){_lo[0], _lo[1], _hi[0], _hi[1]}; } while (0)
#define PG8_WAIT_V(n) asm volatile("s_waitcnt vmcnt(" #n ")" ::: "memory")
#define PG8_WAIT_L(n) asm volatile("s_waitcnt lgkmcnt(" #n ")" ::: "memory")
#define PG8_BAR __builtin_amdgcn_s_barrier()
#define PG8_SCHED __builtin_amdgcn_sched_barrier(0)
    Unit cur, nxt; int ui = 0;
    if (!S.next(0, cur)) return;
    f32x4 acc[2][2][4][2];
    bf16x8 At[4][2], B0[2][2], B1[2][2];
    const char* cA = (const char*)g.A + (size_t)cur.pm * tstep; const char* cB = (const char*)g.Bt + (size_t)cur.pn * tstep;
    S.a_ready(cur);
    if constexpr (SP2) {
        PG8_STAGE(PG8_SB(0, 0), cB, voffB); PG8_STAGE(PG8_SB(0, 1), cB + hstep, voffB); PG8_STAGE(PG8_SA(0, 0), cA, voffA); PG8_STAGE(PG8_SA(0, 1), cA + hstep, voffA);
        E.begin(lds, S, tid);
        if (wr == 1) PG8_BAR;
        PG8_WAIT_V(2); PG8_BAR;
        PG8_STAGE(PG8_SB(1, 0), cB + kstep, voffB); PG8_STAGE(PG8_SA(1, 0), cA + kstep, voffA); PG8_STAGE(PG8_SB(1, 1), cB + hstep + kstep, voffB);
        PG8_WAIT_V(6); PG8_BAR;
    } else {
        PG8_STAGE(PG8_SB(0, 0), cB, voffB); PG8_STAGE(PG8_SA(0, 0), cA, voffA); PG8_STAGE(PG8_SB(0, 1), cB + hstep, voffB); PG8_STAGE(PG8_SA(0, 1), cA + hstep, voffA);
        E.begin(lds, S, tid);
        if (wr == 1) PG8_BAR;
        PG8_WAIT_V(4); PG8_BAR;
        PG8_STAGE(PG8_SB(1, 0), cB + kstep, voffB); PG8_STAGE(PG8_SA(1, 0), cA + kstep, voffA); PG8_STAGE(PG8_SB(1, 1), cB + hstep + kstep, voffB);
        PG8_WAIT_V(6); PG8_BAR;
    }
#pragma unroll
    for (int a = 0; a < 2; ++a)
#pragma unroll
        for (int b = 0; b < 2; ++b)
#pragma unroll
            for (int m = 0; m < 4; ++m)
#pragma unroll
                for (int n = 0; n < 2; ++n) PG8_ZERO4(acc[a][b][m][n]);
    for (;;) {
        const bool has_next = S.next(ui + 1, nxt);
        const char* nA = has_next ? (const char*)g.A + (size_t)nxt.pm * tstep : cA; const char* nB = has_next ? (const char*)g.Bt + (size_t)nxt.pn * tstep : cB;
        for (int t = 0; t < nt; t += 2) {
            const bool last = (t == nt - 2);
            const char* a1 = cA + (size_t)(t + 1) * kstep;
            const char* a2 = last ? nA : cA + (size_t)(t + 2) * kstep; const char* b2 = last ? nB : cB + (size_t)(t + 2) * kstep;
            const char* a3 = a2 + kstep; const char* b3 = b2 + kstep;
            if (last && has_next) S.a_ready(nxt);
            if constexpr (SP2) {
            PG8_LDB(B0, 0, 0); PG8_LDB(B1, 0, 1); PG8_SCHED; PG8_LDA(At, 0, 0); PG8_STAGE(PG8_SA(1, 1), a1 + hstep, voffA);
            PG8_WAIT_V(8); PG8_WAIT_L(0); PG8_BAR; PG8_MMA(0, 0, At, B0); PG8_MMA(0, 1, At, B1); PG8_BAR; PG8_SCHED;
            PG8_LDA(At, 0, 1); PG8_STAGE(PG8_SB(0, 0), b2, voffB); PG8_STAGE(PG8_SB(0, 1), b2 + hstep, voffB); PG8_STAGE(PG8_SA(0, 0), a2, voffA);
            PG8_WAIT_V(8); PG8_WAIT_L(0); PG8_BAR; PG8_MMA(1, 0, At, B0); PG8_MMA(1, 1, At, B1); PG8_BAR; PG8_SCHED;
            PG8_LDB(B0, 1, 0); PG8_LDB(B1, 1, 1); PG8_SCHED; PG8_LDA(At, 1, 0); PG8_STAGE(PG8_SA(0, 1), a2 + hstep, voffA);
            PG8_WAIT_V(8); PG8_WAIT_L(0); PG8_BAR; PG8_MMA(0, 0, At, B0); PG8_MMA(0, 1, At, B1); PG8_BAR; PG8_SCHED;
            PG8_LDA(At, 1, 1); PG8_STAGE(PG8_SB(1, 0), b3, voffB); PG8_STAGE(PG8_SB(1, 1), b3 + hstep, voffB); PG8_STAGE(PG8_SA(1, 0), a3, voffA);
            PG8_WAIT_V(8); PG8_WAIT_L(0); PG8_BAR; PG8_MMA(1, 0, At, B0); PG8_MMA(1, 1, At, B1); PG8_BAR; PG8_SCHED;
            } else {
            PG8_LDB(B0, 0, 0); PG8_SCHED; PG8_LDA(At, 0, 0); PG8_STAGE(PG8_SA(1, 1), a1 + hstep, voffA);
            PG8_WAIT_L(8); PG8_BAR; PG8_WAIT_L(0); PG8_MMA(0, 0, At, B0); PG8_BAR; PG8_SCHED;
            PG8_LDB(B1, 0, 1); PG8_STAGE(PG8_SB(0, 0), b2, voffB);
            PG8_BAR; PG8_WAIT_L(0); PG8_MMA(0, 1, At, B1); PG8_BAR;
            PG8_LDA(At, 0, 1); PG8_STAGE(PG8_SA(0, 0), a2, voffA);
            PG8_BAR; PG8_WAIT_L(0); PG8_MMA(1, 0, At, B0); PG8_BAR; PG8_SCHED;
            PG8_STAGE(PG8_SB(0, 1), b2 + hstep, voffB);
            PG8_WAIT_V(6); PG8_BAR; PG8_MMA(1, 1, At, B1); PG8_BAR;
            PG8_LDB(B0, 1, 0); PG8_SCHED; PG8_LDA(At, 1, 0); PG8_STAGE(PG8_SA(0, 1), a2 + hstep, voffA);
            PG8_WAIT_L(8); PG8_BAR; PG8_WAIT_L(0); PG8_MMA(0, 0, At, B0); PG8_BAR; PG8_SCHED;
            PG8_LDB(B1, 1, 1); PG8_STAGE(PG8_SB(1, 0), b3, voffB);
            PG8_BAR; PG8_WAIT_L(0); PG8_MMA(0, 1, At, B1); PG8_BAR;
            PG8_LDA(At, 1, 1); PG8_STAGE(PG8_SA(1, 0), a3, voffA);
            PG8_BAR; PG8_WAIT_L(0); PG8_MMA(1, 0, At, B0); PG8_BAR; PG8_SCHED;
            PG8_STAGE(PG8_SB(1, 1), b3 + hstep, voffB);
            PG8_WAIT_V(6); PG8_BAR; PG8_MMA(1, 1, At, B1); PG8_BAR;
            }
        }
        if constexpr (ALIGN_EPI) { if (wr == 0) PG8_BAR; }
        if constexpr (!Epi::AFTER_DRAIN) { E(acc, cur, wr, wc, fr, fq, ui); if constexpr (Epi::DUP) { asm volatile("" ::: "memory"); if (E.scratch) { Epi E2 = E; E2.set_probe(); E2(acc, cur, wr, wc, fr, fq, ui); } } S.done(cur); }
        if (!has_next) break;
#pragma unroll
        for (int a = 0; a < 2; ++a)
#pragma unroll
            for (int b = 0; b < 2; ++b)
#pragma unroll
                for (int m = 0; m < 4; ++m)
#pragma unroll
                    for (int n = 0; n < 2; ++n) PG8_ZERO4(acc[a][b][m][n]);
        cur = nxt; cA = nA; cB = nB; ++ui;
        if constexpr (ALIGN_EPI) { if (wr == 1) PG8_BAR; }
    }
    PG8_WAIT_V(0);
    if constexpr (!ALIGN_EPI) { if (wr == 0) PG8_BAR; }
    PG8_BAR;
    if constexpr (Epi::AFTER_DRAIN) { E.fused(acc, cur, wr, wc, fr, fq, lds, wid, lane); S.done(cur); }
#undef PG8_SA
#undef PG8_SB
#undef PG8_STAGE
#undef PG8_LDA
#undef PG8_LDB
#undef PG8_MMA
#undef PG8_ZERO4
#undef PG8_WAIT_V
#undef PG8_WAIT_L
#undef PG8_BAR
#undef PG8_SCHED
}
}

constexpr int BATCH = 4, SEQ = 4096, DM = 1024, MROWS = BATCH * SEQ;
constexpr int CE = 2048, CN = 4 * CE;
constexpr int NH = 16, HD = 64, NG = 3, QKVC = 9216, AN = 10240;
constexpr float EPS = 1e-6f, LOG2E = 1.4426950408889634f, QSCALE = 0.125f * LOG2E;
constexpr int NPHASE = 17;

constexpr size_t MiB = 1u << 20;
constexpr size_t WS_CTL = 0, CTL_ZERO_BYTES = 65536;
constexpr size_t WS_SSQ = 1 * MiB;
constexpr size_t WS_W1 = 2 * MiB, WS_W2 = 18 * MiB, WS_W3 = 22 * MiB, WS_W4 = 42 * MiB;
constexpr size_t WS_LSE = 44 * MiB;
constexpr size_t WS_BIAS = 47 * MiB;
constexpr size_t WS_XB = 48 * MiB;
constexpr size_t WS_QO = 80 * MiB;
constexpr size_t WS_CG = 112 * MiB;
constexpr size_t WS_KA = 176 * MiB, WS_VA = 208 * MiB, WS_KB = 240 * MiB, WS_VB = 272 * MiB;
constexpr size_t WS_Y = WS_KA;
constexpr size_t WS_SIDE = 304 * MiB;
constexpr size_t WS_END = 307 * MiB;
constexpr int CW_TMO = 0, CW_BAR = 4096;

#define GAS __attribute__((address_space(1)))
#define LAS __attribute__((address_space(3)))
typedef unsigned short bf16;
typedef unsigned v4u __attribute__((ext_vector_type(4)));
typedef unsigned v2u __attribute__((ext_vector_type(2)));
typedef float f32x4 __attribute__((ext_vector_type(4)));
typedef short bf16x8 __attribute__((ext_vector_type(8)));
typedef GAS unsigned gu32;
#define RLX_AGENT __ATOMIC_RELAXED, __HIP_MEMORY_SCOPE_AGENT
#define LDS_WAIT() asm volatile("s_waitcnt lgkmcnt(0)" ::: "memory")
#define VM_WAIT() asm volatile("s_waitcnt vmcnt(0)" ::: "memory")
__device__ __forceinline__ unsigned f2bf(float f) { unsigned u = __builtin_bit_cast(unsigned, f); return (u + 0x7fffu + ((u >> 16) & 1u)) >> 16; }
typedef float f32x2_t __attribute__((ext_vector_type(2))); typedef __bf16 bf16x2_t __attribute__((ext_vector_type(2)));
__device__ __forceinline__ unsigned pk2(float lo, float hi) { f32x2_t v = {lo, hi}; bf16x2_t b = __builtin_convertvector(v, bf16x2_t); return __builtin_bit_cast(unsigned, b); }
#ifndef ST_WT
#define ST_WT 0
#endif
#ifndef ST_NT
#define ST_NT 0
#endif
#ifndef XSUM_SWAP
#define XSUM_SWAP 1
#endif
__device__ __forceinline__ float xsum_fq(float t) {
#if XSUM_SWAP
    auto a = __builtin_amdgcn_permlane16_swap(__float_as_uint(t), __float_as_uint(t), false, false); t = __uint_as_float(a[0]) + __uint_as_float(a[1]);
    auto b = __builtin_amdgcn_permlane32_swap(__float_as_uint(t), __float_as_uint(t), false, false); return __uint_as_float(b[0]) + __uint_as_float(b[1]);
#else
    t += __shfl_xor(t, 16); t += __shfl_xor(t, 32); return t;
#endif
}
__device__ __forceinline__ void st16(void* p, v4u v) {
#if ST_WT
    asm volatile("global_store_dwordx4 %0, %1, off sc1\n\ts_nop 1" :: "v"(p), "v"(v) : "memory");
#elif ST_NT
    __builtin_nontemporal_store(v, (v4u*)p);
#else
    *(v4u*)p = v;
#endif
}
__device__ __forceinline__ size_t hm_row(int row  , int h, int sh) {
    const int b = row >> 12, t = row & 4095, p = ((t & ((1 << sh) - 1)) << (12 - sh)) | (t >> sh);
    return ((size_t)((b * 16 + h) * 4096 + p)) * 64;
}
__device__ __forceinline__ float bf2f(unsigned h) { return __builtin_bit_cast(float, h << 16); }
__device__ __forceinline__ float bflo(unsigned w) { return __builtin_bit_cast(float, w << 16); }
__device__ __forceinline__ float bfhi(unsigned w) { return __builtin_bit_cast(float, w & 0xffff0000u); }
__device__ __forceinline__ float sigmoidf_(float z) { return __builtin_amdgcn_rcpf(1.0f + __builtin_amdgcn_exp2f(-z * LOG2E)); }
typedef float f32x4_sig __attribute__((ext_vector_type(4)));
__device__ __forceinline__ f32x4_sig sigmoid4(f32x4_sig z) {
    const f32x4_sig a = z * (-LOG2E);
    f32x4_sig e; e[0] = __builtin_amdgcn_exp2f(a[0]); e[1] = __builtin_amdgcn_exp2f(a[1]); e[2] = __builtin_amdgcn_exp2f(a[2]); e[3] = __builtin_amdgcn_exp2f(a[3]);
    const f32x4_sig d = e + 1.0f;
    f32x4_sig r; r[0] = __builtin_amdgcn_rcpf(d[0]); r[1] = __builtin_amdgcn_rcpf(d[1]); r[2] = __builtin_amdgcn_rcpf(d[2]); r[3] = __builtin_amdgcn_rcpf(d[3]);
    return r;
}
__device__ __forceinline__ float row_rs(const float* ssq, int row) {
    const f32x4* p = (const f32x4*)(ssq + (size_t)row * 16);
    const f32x4 s = (p[0] + p[1]) + (p[2] + p[3]);
    return 1.0f / sqrtf(((s.x + s.y) + (s.z + s.w)) * (1.0f / DM) + EPS);
}
__device__ __forceinline__ float wave_sum(float v) {
#pragma unroll
    for (int o = 1; o < 64; o <<= 1) v += __shfl_xor(v, o);
    return v;
}
__device__ __forceinline__ int t5_bucket(int d) {
    if (d < 16) return d;
    int b = 15;
    b += (d >= 16); b += (d >= 22); b += (d >= 30); b += (d >= 40); b += (d >= 54); b += (d >= 73); b += (d >= 99); b += (d >= 134);
    b += (d >= 182); b += (d >= 246); b += (d >= 332); b += (d >= 450); b += (d >= 609); b += (d >= 825); b += (d >= 1117); b += (d >= 1513);
    return b;
}

#define XB_TMO      128
#define XB_XCNT(j)  (256  + 64 * (j))
#define XB_XSUB(j)  (1280 + 64 * (j))
#define XB_XGEN(j)  (2304 + 64 * (j))
#define XB_TOP      3328
#define XB_TOPGEN   3392
#define XB_LSUB(j)  (3456 + 64 * (j))
#define XB_LGEN(j)  (4480 + 64 * (j))
#define XCD_BAR_WORDS 5504
#ifndef XB_LOCAL
#define XB_LOCAL 1
#endif
#define XB_SPIN_CAP (1u << 18)
#ifndef XB_SLEEP
#define XB_SLEEP 0
#endif
#ifndef XB_FLAT_REL
#define XB_FLAT_REL 1
#endif
#ifndef XB_COUNT_REL
#define XB_COUNT_REL 0
#endif
#ifndef XB_EARLY_WB
#define XB_EARLY_WB 0
#endif

__device__ __forceinline__ unsigned xb_ld(unsigned* p)              { return __hip_atomic_load(p, __ATOMIC_RELAXED, __HIP_MEMORY_SCOPE_AGENT); }
__device__ __forceinline__ unsigned xb_add(unsigned* p, unsigned v) { return __hip_atomic_fetch_add(p, v, __ATOMIC_RELAXED, __HIP_MEMORY_SCOPE_AGENT); }
__device__ __forceinline__ unsigned xb_xcc_id() { return (unsigned)__builtin_amdgcn_s_getreg((3 << 11) | 20) & 0xFu; }
#define XB_SPIN(cond, bar) do { unsigned _sp = 0; while (cond) { __builtin_amdgcn_s_sleep(XB_SLEEP); \
    if ((++_sp & 255u) == 0u) { if (xb_ld(&(bar)[XB_TMO])) break; if (_sp > XB_SPIN_CAP) { atomicAdd(&(bar)[XB_TMO], 1u); break; } } } } while (0)

struct XcdBarrier {
    unsigned* bar; unsigned x;
    volatile LAS unsigned* st;
};

__device__ __forceinline__ XcdBarrier xcd_barrier_post(unsigned* bar, volatile LAS unsigned* st) {
    XcdBarrier b; b.bar = bar; b.x = xb_xcc_id(); b.st = st;
    if (threadIdx.x == 0) st[2] = xb_add(&bar[XB_XCNT(b.x)], 1u);
    return b;
}
__device__ __forceinline__ void xcd_barrier_complete(unsigned* bar, unsigned x, unsigned& nloc, unsigned& nx, unsigned& uniform) {
    const unsigned G = gridDim.x * gridDim.y * gridDim.z;
    unsigned sum, cnt, mine, uni, sp = 0u;
    for (;;) {
        sum = 0u; cnt = 0u; mine = 0u; uni = 1u;
#pragma unroll
        for (unsigned j = 0; j < 16; ++j) { const unsigned c = xb_ld(&bar[XB_XCNT(j)]); sum += c; cnt += (c > 0u) ? 1u : 0u; mine = (j == x) ? c : mine; uni = (c == (j < 8u ? 32u : 0u)) ? uni : 0u; }
        if (sum == G) break;
        __builtin_amdgcn_s_sleep(1);
        if ((++sp & 255u) == 0u) { if (xb_ld(&bar[XB_TMO])) break; if (sp > XB_SPIN_CAP) { atomicAdd(&bar[XB_TMO], 1u); break; } }
    }
    nloc = mine > 0u ? mine : 1u; nx = cnt > 0u ? cnt : 1u; uniform = (sum == G && G == 256u) ? uni : 0u;
}

__device__ __forceinline__ void xcd_barrier(const XcdBarrier& b) {
    asm volatile("s_waitcnt vmcnt(0)" ::: "memory");
    __syncthreads();
#if XB_EARLY_WB
    if (threadIdx.x == 64) {
        const unsigned nl = b.st[0];
        if (nl > 1u) { const unsigned c = xb_ld(&b.bar[XB_XSUB(b.x)]) % nl; if (c == (nl * XB_EARLY_WB) / 8u) asm volatile("buffer_wbl2 sc1" ::: "memory"); }
    }
#endif
    if (threadIdx.x == 0) {
        unsigned* bar = b.bar;
        __builtin_amdgcn_s_waitcnt(0);
        unsigned nloc = b.st[0], nx = b.st[1];
        if (nloc == 0u) { unsigned uni; xcd_barrier_complete(bar, b.x, nloc, nx, uni); b.st[0] = nloc; b.st[1] = nx;
            b.st[4] = uni; b.st[3] = uni ? b.st[2] * 8u + b.x : blockIdx.x; }
        const unsigned old = xb_add(&bar[XB_XSUB(b.x)], 1u);
        const unsigned gen = old / nloc;
#if XB_COUNT_REL
        if (old + 1u == (gen + 1u) * nloc) {
            __builtin_amdgcn_fence(__ATOMIC_RELEASE, "agent");
            asm volatile("s_waitcnt vmcnt(0)" ::: "memory");
            (void)xb_add(&bar[XB_TOP], 1u);
        }
        { const unsigned target = (gen + 1u) * nx; XB_SPIN(xb_ld(&bar[XB_TOP]) < target, bar); }
        __builtin_amdgcn_fence(__ATOMIC_ACQUIRE, "agent");
        asm volatile("s_waitcnt vmcnt(0)" ::: "memory");
#else
        if (old + 1u == (gen + 1u) * nloc) {
            __builtin_amdgcn_fence(__ATOMIC_RELEASE, "agent");
            asm volatile("s_waitcnt vmcnt(0)" ::: "memory");
            const unsigned og = xb_add(&bar[XB_TOP], 1u);
            const unsigned tg = og / nx;
            if (og + 1u == (tg + 1u) * nx) xb_add(&bar[XB_TOPGEN], 1u);
            else XB_SPIN(xb_ld(&bar[XB_TOPGEN]) == tg, bar);
            __builtin_amdgcn_fence(__ATOMIC_ACQUIRE, "agent");
#if !XB_FLAT_REL
            xb_add(&bar[XB_XGEN(b.x)], 1u);
#endif
            asm volatile("s_waitcnt vmcnt(0)" ::: "memory");
        } else {
#if XB_FLAT_REL
            XB_SPIN(xb_ld(&bar[XB_TOPGEN]) == gen, bar);
#else
            XB_SPIN(xb_ld(&bar[XB_XGEN(b.x)]) == gen, bar);
#endif
            __builtin_amdgcn_fence(__ATOMIC_ACQUIRE, "agent");
            asm volatile("s_waitcnt vmcnt(0)" ::: "memory");
        }
#endif
    }
    __syncthreads();
}

__device__ __forceinline__ void xcd_barrier_local(const XcdBarrier& b) {
#if XB_LOCAL
    if (b.st[4] == 0u) { xcd_barrier(b); return; }
    asm volatile("s_waitcnt vmcnt(0)" ::: "memory");
    __syncthreads();
    if (threadIdx.x == 0) {
        unsigned* bar = b.bar;
        __builtin_amdgcn_s_waitcnt(0);
        const unsigned nloc = b.st[0];
        const unsigned old = xb_add(&bar[XB_LSUB(b.x)], 1u);
        const unsigned gen = old / nloc;
#if XB_COUNT_REL
        { const unsigned target = (gen + 1u) * nloc; if (old + 1u != target) XB_SPIN(xb_ld(&bar[XB_LSUB(b.x)]) < target, bar); }
#else
        if (old + 1u == (gen + 1u) * nloc) xb_add(&bar[XB_LGEN(b.x)], 1u);
        else XB_SPIN(xb_ld(&bar[XB_LGEN(b.x)]) == gen, bar);
#endif
        __builtin_amdgcn_fence(__ATOMIC_ACQUIRE, "agent");
        asm volatile("s_waitcnt vmcnt(0)" ::: "memory");
    }
    __syncthreads();
#else
    xcd_barrier(b);
#endif
}

#ifndef Z_NT
#define Z_NT 0
#endif
#if Z_NT
#define Z_LD(p) __builtin_nontemporal_load(p)
#else
#define Z_LD(p) (*(p))
#endif
#ifndef CONV_Y_NT
#define CONV_Y_NT 0
#endif
#ifndef EP_NT
#define EP_NT 0
#endif
#if EP_NT
#define EP_LD(p) __builtin_nontemporal_load(p)
#else
#define EP_LD(p) (*(p))
#endif
#ifndef DUP_EPI
#define DUP_EPI 0
#endif
#ifndef CONV_ST16
#define CONV_ST16 1
#endif
#ifndef RSTAB_PAIR
#define RSTAB_PAIR 1
#endif
#ifndef Y_NT
#define Y_NT 0
#endif
#ifndef QKV_NT
#define QKV_NT 0
#endif
#ifndef OUT_NT
#define OUT_NT 1
#endif
namespace epi {
using pg8::Unit; using pg8::bf16_t;

__device__ __forceinline__ void rows_rs(const float* ssq, int row0  , int fq, float (&rs)[2][4]) {
    f32x4 pp[2][4];
#pragma unroll
    for (int ai = 0; ai < 2; ++ai)
#pragma unroll
        for (int m = 0; m < 4; ++m) pp[ai][m] = *(const f32x4*)(ssq + (size_t)(row0 + ai * 128 + m * 16) * 16 + 4 * fq);
#pragma unroll
    for (int ai = 0; ai < 2; ++ai)
#pragma unroll
        for (int m = 0; m < 4; ++m) { float t = (pp[ai][m][0] + pp[ai][m][1]) + (pp[ai][m][2] + pp[ai][m][3]); t = xsum_fq(t); rs[ai][m] = __builtin_amdgcn_rsqf(t * (1.0f / DM) + EPS); }
}
struct ConvIn {
    static constexpr bool PERM = false, AFTER_DRAIN = false, DUP = (DUP_EPI != 0);
    const float* ssq; bf16_t* V; bf16_t* G;
    template <class Sched> __device__ __forceinline__ void begin(LAS unsigned char*, const Sched&, int) const {}
    __device__ __forceinline__ void operator()(const f32x4 (&acc)[2][2][4][2], const Unit& u, int wr, int wc, int fr, int fq, int) const {
        const int ch0 = u.pn * 64 + wc * 16 + 4 * fq;
        float rsv[2][4]; rows_rs(ssq, u.pm * 256 + wr * 64 + fr, fq, rsv);
#pragma unroll
        for (int ai = 0; ai < 2; ++ai)
#pragma unroll
            for (int m = 0; m < 4; ++m) {
                const int row = u.pm * 256 + ai * 128 + wr * 64 + m * 16 + fr;
                const float rs = rsv[ai][m];
                const f32x4 b = acc[ai][0][m][0] * rs, c = acc[ai][0][m][1] * rs, uu = acc[ai][1][m][0] * rs, z = acc[ai][1][m][1] * rs;
                const f32x4 v = c * uu;
                f32x4 g;
#pragma unroll
                for (int i = 0; i < 4; ++i) g[i] = b[i] * z[i] * sigmoidf_(z[i]);
                v2u wv, wg; wv.x = pk2(v[0], v[1]); wv.y = pk2(v[2], v[3]); wg.x = pk2(g[0], g[1]); wg.y = pk2(g[2], g[3]);
                *(v2u*)(V + (size_t)row * CE + ch0) = wv;
                *(v2u*)(G + (size_t)row * CE + ch0) = wg;
            }
    }
};


constexpr int RSTAB_OFF = 152832, GTAB_OFF = 161024;
template <bool PAIR, class Sched> __device__ __forceinline__ void fill_rstab(LAS unsigned char* lds, const float* ssq, const Sched& S, int tid) {
    LAS float* tab = (LAS float*)(lds + RSTAB_OFF);
    if constexpr (PAIR && RSTAB_PAIR != 0) {
#pragma unroll
    for (int kk = 0; kk < 2; ++kk) {
        const int i0 = (tid >> 8) + 4 * kk, i1 = i0 + 2;
        Unit u0, u1; const bool ok0 = S.next(i0, u0), ok1 = S.next(i1, u1);
        if (!ok0) break;
        const f32x4* p0 = (const f32x4*)(ssq + (size_t)(u0.pm * 256 + (tid & 255)) * 16);
        const f32x4* p1 = (const f32x4*)(ssq + (size_t)((ok1 ? u1.pm : u0.pm) * 256 + (tid & 255)) * 16);
        const f32x4 a0 = p0[0], a1 = p0[1], a2 = p0[2], a3 = p0[3], b0 = p1[0], b1 = p1[1], b2 = p1[2], b3 = p1[3];
        const f32x4 sa = (a0 + a1) + (a2 + a3), sb = (b0 + b1) + (b2 + b3);
        tab[i0 * 256 + (tid & 255)] = __builtin_amdgcn_rsqf(((sa[0] + sa[1]) + (sa[2] + sa[3])) * (1.0f / DM) + EPS);
        if (ok1) tab[i1 * 256 + (tid & 255)] = __builtin_amdgcn_rsqf(((sb[0] + sb[1]) + (sb[2] + sb[3])) * (1.0f / DM) + EPS);
    }
    } else {
    Unit u;
    for (int i = tid >> 8; i < 8 && S.next(i, u); i += 2) {
        const f32x4* p = (const f32x4*)(ssq + (size_t)(u.pm * 256 + (tid & 255)) * 16);
        const f32x4 s = (p[0] + p[1]) + (p[2] + p[3]);
        tab[i * 256 + (tid & 255)] = __builtin_amdgcn_rsqf(((s[0] + s[1]) + (s[2] + s[3])) * (1.0f / DM) + EPS);
    }
    }
}
__device__ __forceinline__ void tab_rs(LAS unsigned char* lds, int ui, int wr, int fr, float (&rs)[2][4]) {
    const LAS float* tab = (const LAS float*)(lds + RSTAB_OFF) + ui * 256 + wr * 64 + fr;
#pragma unroll
    for (int ai = 0; ai < 2; ++ai)
#pragma unroll
        for (int m = 0; m < 4; ++m) rs[ai][m] = tab[ai * 128 + m * 16];
}
struct ConvFused {
    static constexpr bool PERM = false, AFTER_DRAIN = false, DUP = false;
    const float* ssq; bf16_t* Y; const float* cw; float* side; LAS unsigned char* xch;
    static __device__ __forceinline__ f32x4 unpk(v2u p) { return (f32x4){bflo(p.x), bfhi(p.x), bflo(p.y), bfhi(p.y)}; }
    template <class Sched> __device__ __forceinline__ void begin(LAS unsigned char* lds, const Sched& S, int tid) const { fill_rstab<true>(lds, ssq, S, tid); }
    __device__ __forceinline__ void operator()(const f32x4 (&acc)[2][2][4][2], const Unit& u, int wr, int wc, int fr, int fq, int ui) const {
        const int ch0 = u.pn * 64 + wc * 16 + 4 * fq;
        float rsv[2][4]; tab_rs(xch - 131072, ui, wr, fr, rsv);
        const f32x4 w0 = *(const f32x4*)(cw + ch0), w1 = *(const f32x4*)(cw + CE + ch0), w2 = *(const f32x4*)(cw + 2 * CE + ch0);
        v2u vq[2][4]; f32x4 gt[2][4];
#pragma unroll
        for (int ai = 0; ai < 2; ++ai)
#pragma unroll
            for (int m = 0; m < 4; ++m) {
                const float rs = rsv[ai][m];
                const f32x4 b = acc[ai][0][m][0] * rs, c = acc[ai][0][m][1] * rs, uu = acc[ai][1][m][0] * rs, z = acc[ai][1][m][1] * rs;
                const f32x4 v = c * uu;
                vq[ai][m].x = pk2(v[0], v[1]); vq[ai][m].y = pk2(v[2], v[3]);
                gt[ai][m] = (b * z) * sigmoid4(z);
            }
        LAS unsigned char* my = xch + (wr * 4 + wc) * 2720 + fq * 8;
        LAS unsigned char* other = xch + ((1 - wr) * 4 + wc) * 2720 + fq * 8;
        const bool seq_start = (u.pm & 15) == 0;
        if (fr >= 14) {
            const int hr = fr - 14;
            *(LAS v2u*)(other + ((wr == 0 ? 0 : 66) + hr) * 40) = vq[0][3];
            if (wr == 0) *(LAS v2u*)(other + (66 + hr) * 40) = vq[1][3];
            else *(f32x4*)(side + ((size_t)u.pm * 6 + 4 + hr) * CE + ch0) = unpk(vq[1][3]);
        }
        if (wr == 0 && fr < 2) *(LAS v2u*)(my + fr * 40) = (v2u){0u, 0u};
#pragma unroll
        for (int m = 0; m < 4; ++m) *(LAS v2u*)(my + (2 + 16 * m + fr) * 40) = vq[0][m];
        asm volatile("s_waitcnt lgkmcnt(0)\n\ts_barrier" ::: "memory");
        v2u q1[2][4], q2[2][4];
#pragma unroll
        for (int m = 0; m < 4; ++m) { const int k = 16 * m + fr; q1[0][m] = *(const LAS v2u*)(my + (k + 1) * 40); q2[0][m] = *(const LAS v2u*)(my + k * 40); }
        asm volatile("" ::: "memory");
#pragma unroll
        for (int m = 0; m < 4; ++m) *(LAS v2u*)(my + (2 + 16 * m + fr) * 40) = vq[1][m];
        asm volatile("s_waitcnt lgkmcnt(0)" ::: "memory");
#pragma unroll
        for (int m = 0; m < 4; ++m) { const int k = 16 * m + fr; int r1 = k + 1, r2 = k; if (k < 1) r1 = 67; if (k < 2) r2 = 66 + k;
            q1[1][m] = *(const LAS v2u*)(my + r1 * 40); q2[1][m] = *(const LAS v2u*)(my + r2 * 40); }
        v2u wyk[2]; (void)wyk;
#pragma unroll
        for (int ai = 0; ai < 2; ++ai)
#pragma unroll
            for (int m = 0; m < 4; ++m) {
                const int k = 16 * m + fr;
                const f32x4 p1 = unpk(q1[ai][m]), p2 = unpk(q2[ai][m]), v = unpk(vq[ai][m]);
                const f32x4 cv = w2 * v + w1 * p1 + w0 * p2;
                const f32x4 y = gt[ai][m] * cv;
                const int row = u.pm * 256 + ai * 128 + wr * 64 + k;
                v2u wy; wy.x = pk2(y[0], y[1]); wy.y = pk2(y[2], y[3]);
#if CONV_ST16
                wyk[m & 1] = wy;
                if (m & 1) {
                    auto sx = __builtin_amdgcn_permlane16_swap(wyk[0].x, wyk[1].x, false, false); auto sy = __builtin_amdgcn_permlane16_swap(wyk[0].y, wyk[1].y, false, false);
                    const v4u w16 = (v4u){sx[0], sy[0], sx[1], sy[1]};
                    const int rr = u.pm * 256 + ai * 128 + wr * 64 + 16 * (m - 1 + (fq & 1)) + fr;
#if CONV_Y_NT
                    __builtin_nontemporal_store(w16, (v4u*)(Y + (size_t)rr * CE + u.pn * 64 + wc * 16 + 8 * (fq >> 1)));
#else
                    st16(Y + (size_t)rr * CE + u.pn * 64 + wc * 16 + 8 * (fq >> 1), w16);
#endif
                }
#else
                *(v2u*)(Y + (size_t)row * CE + ch0) = wy;
#endif
                if (ai == 0 && m == 0 && wr == 0 && fr < 2 && !seq_start) {
                    *(f32x4*)(side + ((size_t)u.pm * 6 + fr) * CE + ch0) = gt[0][0];
                    *(f32x4*)(side + ((size_t)u.pm * 6 + 2 + fr) * CE + ch0) = cv;
                }
            }
    }
};
struct Resid {
    static constexpr bool PERM = false, AFTER_DRAIN = false, DUP = false;
    const float* xin; float* xout; bf16_t* xb; float* ssq;
    template <class Sched> __device__ __forceinline__ void begin(LAS unsigned char*, const Sched&, int) const {}
    __device__ __forceinline__ void operator()(const f32x4 (&acc)[2][2][4][2], const Unit& u, int wr, int wc, int fr, int fq, int) const {
        const int col0 = u.pn * 256 + wc * 32 + 4 * fq;
        const size_t off0 = (size_t)(u.pm * 256 + wr * 64 + fr) * DM + col0;
        f32x4 pre[4][2][2];
#pragma unroll
        for (int i = 0; i < 4; ++i)
#pragma unroll
            for (int bj = 0; bj < 2; ++bj)
#pragma unroll
                for (int n = 0; n < 2; ++n) pre[i][bj][n] = *(const f32x4*)(xin + off0 + (size_t)(16 * i) * DM + bj * 128 + n * 16);
#pragma unroll
        for (int i = 0; i < 8; ++i) {
            const int ai = i >> 2, m = i & 3;
            const size_t off = off0 + (size_t)(ai * 128 + m * 16) * DM;
            float ss = 0.f; f32x4 xn[2][2];
#pragma unroll
            for (int bj = 0; bj < 2; ++bj)
#pragma unroll
                for (int n = 0; n < 2; ++n) { xn[bj][n] = pre[i & 3][bj][n] + acc[ai][bj][m][n]; const f32x4 t = xn[bj][n]; ss += (t[0] * t[0] + t[1] * t[1]) + (t[2] * t[2] + t[3] * t[3]); }
            if (i < 4) {
#pragma unroll
                for (int bj = 0; bj < 2; ++bj)
#pragma unroll
                    for (int n = 0; n < 2; ++n) pre[i & 3][bj][n] = *(const f32x4*)(xin + off + (size_t)128 * DM + bj * 128 + n * 16);
            }
#pragma unroll
            for (int bj = 0; bj < 2; ++bj)
#pragma unroll
                for (int n = 0; n < 2; ++n) {
                    *(f32x4*)(xout + off + bj * 128 + n * 16) = xn[bj][n];
                    v2u w; w.x = pk2(xn[bj][n][0], xn[bj][n][1]); w.y = pk2(xn[bj][n][2], xn[bj][n][3]);
                    *(v2u*)(xb + off + bj * 128 + n * 16) = w;
                }
            ss = xsum_fq(ss);
            if (fq == 0) ssq[(size_t)(u.pm * 256 + ai * 128 + wr * 64 + m * 16 + fr) * 16 + u.pn * 4 + wc] = ss;
        }
    }
};
template <int MODE> struct ResidB {
    static constexpr bool PERM = false, AFTER_DRAIN = false, DUP = false;
    const float* xin; float* xout; bf16_t* xb; float* ssq; bf16_t* xbw;
    template <class Sched> __device__ __forceinline__ void begin(LAS unsigned char*, const Sched&, int) const {}
    __device__ __forceinline__ void operator()(const f32x4 (&acc)[2][2][4][2], const Unit& u, int wr, int wc, int fr, int fq, int) const {
        const int col0 = u.pn * 256 + wc * 32 + 4 * fq;
        const size_t off0 = (size_t)(u.pm * 256 + wr * 64 + fr) * DM + col0;
        if constexpr (MODE == 0) {
            f32x4 pre[4][2][2];
#pragma unroll
            for (int i = 0; i < 4; ++i)
#pragma unroll
                for (int bj = 0; bj < 2; ++bj)
#pragma unroll
                    for (int n = 0; n < 2; ++n) pre[i][bj][n] = *(const f32x4*)(xin + off0 + (size_t)(16 * i) * DM + bj * 128 + n * 16);
#pragma unroll
            for (int i = 0; i < 8; ++i) {
                const int ai = i >> 2, m = i & 3;
                const size_t off = off0 + (size_t)(ai * 128 + m * 16) * DM;
                float ss = 0.f; f32x4 xn[2][2];
#pragma unroll
                for (int bj = 0; bj < 2; ++bj)
#pragma unroll
                    for (int n = 0; n < 2; ++n) { xn[bj][n] = pre[i & 3][bj][n] + acc[ai][bj][m][n]; const f32x4 t = xn[bj][n]; ss += (t[0] * t[0] + t[1] * t[1]) + (t[2] * t[2] + t[3] * t[3]); }
                if (i < 4) {
#pragma unroll
                    for (int bj = 0; bj < 2; ++bj)
#pragma unroll
                        for (int n = 0; n < 2; ++n) pre[i & 3][bj][n] = *(const f32x4*)(xin + off + (size_t)128 * DM + bj * 128 + n * 16);
                }
#pragma unroll
                for (int bj = 0; bj < 2; ++bj)
#pragma unroll
                    for (int n = 0; n < 2; ++n) { v2u w; w.x = pk2(xn[bj][n][0], xn[bj][n][1]); w.y = pk2(xn[bj][n][2], xn[bj][n][3]); *(v2u*)(xbw + off + bj * 128 + n * 16) = w; }
                ss = xsum_fq(ss);
                if (fq == 0) ssq[(size_t)(u.pm * 256 + ai * 128 + wr * 64 + m * 16 + fr) * 16 + u.pn * 4 + wc] = ss;
            }
        } else {
            v2u pre[8][2][2];
#pragma unroll
            for (int i = 0; i < 8; ++i)
#pragma unroll
                for (int bj = 0; bj < 2; ++bj)
#pragma unroll
                    for (int n = 0; n < 2; ++n) pre[i][bj][n] = EP_LD((const v2u*)(xb + off0 + (size_t)((i >> 2) * 128 + (i & 3) * 16) * DM + bj * 128 + n * 16));
#pragma unroll
            for (int i = 0; i < 8; ++i) {
                const int ai = i >> 2, m = i & 3;
                const size_t off = off0 + (size_t)(ai * 128 + m * 16) * DM;
                f32x4 ssv = (f32x4){0.f, 0.f, 0.f, 0.f};
#pragma unroll
                for (int bj = 0; bj < 2; ++bj)
#pragma unroll
                    for (int n = 0; n < 2; ++n) {
                        const v2u p = pre[i][bj][n];
                        const f32x4 t = (f32x4){bflo(p.x), bfhi(p.x), bflo(p.y), bfhi(p.y)} + acc[ai][bj][m][n];
                        if constexpr (MODE == 2) { if constexpr (OUT_NT != 0) __builtin_nontemporal_store(t, (f32x4*)(xout + off + bj * 128 + n * 16)); else *(f32x4*)(xout + off + bj * 128 + n * 16) = t; }
                        else { ssv = __builtin_elementwise_fma(t, t, ssv); v2u w; w.x = pk2(t[0], t[1]); w.y = pk2(t[2], t[3]); *(v2u*)(xbw + off + bj * 128 + n * 16) = w; }
                    }
                if constexpr (MODE != 2) {
                    float ss = (ssv[0] + ssv[1]) + (ssv[2] + ssv[3]);
                    ss = xsum_fq(ss);
                    if (fq == 0) ssq[(size_t)(u.pm * 256 + ai * 128 + wr * 64 + m * 16 + fr) * 16 + u.pn * 4 + wc] = ss;
                }
            }
        }
    }
};
struct NullEpi {
    static constexpr bool PERM = false, AFTER_DRAIN = false, DUP = false;
    float* sink;
    template <class Sched> __device__ __forceinline__ void begin(LAS unsigned char*, const Sched&, int) const {}
    __device__ __forceinline__ void operator()(const f32x4 (&acc)[2][2][4][2], const Unit& u, int wr, int wc, int fr, int fq, int) const {
        f32x4 t = (f32x4){0.f, 0.f, 0.f, 0.f};
#pragma unroll
        for (int a = 0; a < 2; ++a)
#pragma unroll
            for (int b = 0; b < 2; ++b)
#pragma unroll
                for (int m = 0; m < 4; ++m)
#pragma unroll
                    for (int n = 0; n < 2; ++n) t += acc[a][b][m][n];
        const float q = (t[0] + t[1]) + (t[2] + t[3]);
        if (q == 123456.789f) sink[u.pm * 4 + u.pn] = q;
    }
};
struct QKV {
    static constexpr bool PERM = true, AFTER_DRAIN = false, DUP = (DUP_EPI != 0);
    const float* ssq; bf16_t* Q; bf16_t* K; bf16_t* Vv; const float* qg; const float* kg; LAS unsigned char* lds0; int sh; bf16_t* scratch = nullptr; bool probe = false;
    __device__ __forceinline__ void set_probe() { probe = true; }
    template <class Sched> __device__ __forceinline__ void begin(LAS unsigned char* lds, const Sched& S, int tid) const {
        fill_rstab<true>(lds, ssq, S, tid);
        if (tid < 64) ((LAS float*)(lds + GTAB_OFF))[tid] = qg[tid] * kg[tid] * QSCALE;
    }
    template <int W> __device__ __forceinline__ void emit(const f32x4 (&acc)[2][2][4][2], const Unit& u, int wr, int wc, int fr, int fq, int ui, bf16_t* base) const {
        const int h = (u.pn & 3) * 4 + wc;
        const LAS float* gp = (const LAS float*)(lds0 + GTAB_OFF);
        f32x4 g00, g01, g10, g11;
        if constexpr (W == 0) { g00 = *(const LAS f32x4*)(gp + 8 * fq); g01 = *(const LAS f32x4*)(gp + 8 * fq + 4); g10 = *(const LAS f32x4*)(gp + 32 + 8 * fq); g11 = *(const LAS f32x4*)(gp + 32 + 8 * fq + 4); }
        float rsv[2][4]; tab_rs(lds0, ui, wr, fr, rsv);
#pragma unroll
        for (int ai = 0; ai < 2; ++ai)
#pragma unroll
            for (int m = 0; m < 4; ++m) {
                const int row = u.pm * 256 + ai * 128 + wr * 64 + m * 16 + fr;
                const float rs = rsv[ai][m];
                float sc = rs;
                if constexpr (W < 2) {
                    f32x4 sq = acc[ai][0][m][0] * acc[ai][0][m][0];
                    sq = __builtin_elementwise_fma(acc[ai][0][m][1], acc[ai][0][m][1], sq); sq = __builtin_elementwise_fma(acc[ai][1][m][0], acc[ai][1][m][0], sq); sq = __builtin_elementwise_fma(acc[ai][1][m][1], acc[ai][1][m][1], sq);
                    float ss = (sq[0] + sq[1]) + (sq[2] + sq[3]);
                    ss = xsum_fq(ss);
                    sc = rs * __builtin_amdgcn_rsqf(ss * (rs * rs * (1.0f / HD)) + EPS);
                }
#pragma unroll
                for (int bj = 0; bj < 2; ++bj) {
                    f32x4 a = acc[ai][bj][m][0] * sc, b = acc[ai][bj][m][1] * sc;
                    if constexpr (W == 0) { a = a * (bj == 0 ? g00 : g10); b = b * (bj == 0 ? g01 : g11); }
                    v4u w; w.x = pk2(a[0], a[1]); w.y = pk2(a[2], a[3]); w.z = pk2(b[0], b[1]); w.w = pk2(b[2], b[3]);
#if QKV_NT
                    __builtin_nontemporal_store(w, (v4u*)(base + hm_row(row, h, sh) + 32 * bj + 8 * fq));
#else
                    st16(base + hm_row(row, h, sh) + 32 * bj + 8 * fq, w);
#endif
                }
            }
    }
    __device__ __forceinline__ void operator()(const f32x4 (&acc)[2][2][4][2], const Unit& u, int wr, int wc, int fr, int fq, int ui) const {
        const int which = __builtin_amdgcn_readfirstlane(u.pn >> 2);
        if (which == 0) emit<0>(acc, u, wr, wc, fr, fq, ui, Q); else if (which == 1) emit<1>(acc, u, wr, wc, fr, fq, ui, K); else emit<2>(acc, u, wr, wc, fr, fq, ui, Vv);
    }
};
struct ZMerge {
    static constexpr bool PERM = true, AFTER_DRAIN = false, DUP = false;
    const float* ssq; const bf16_t* O0; const bf16_t* O1; const bf16_t* O2; const float* lse; bf16_t* Y; LAS unsigned char* lds0;
    struct RowIn { v4u a[2], b[2], c[2]; float l0, l1, l2; };
    __device__ __forceinline__ void load_row(RowIn& r, int row, int h, int fq) const {
        const size_t off0 = hm_row(row, h, 0) + 8 * fq, off1 = hm_row(row, h, 2) + 8 * fq, off2 = hm_row(row, h, 4) + 8 * fq;
        r.l0 = lse[((size_t)0 * MROWS + row) * 16 + h]; r.l1 = lse[((size_t)1 * MROWS + row) * 16 + h]; r.l2 = lse[((size_t)2 * MROWS + row) * 16 + h];
#pragma unroll
        for (int bj = 0; bj < 2; ++bj) { r.a[bj] = Z_LD((const v4u*)(O0 + off0 + 32 * bj)); r.b[bj] = Z_LD((const v4u*)(O1 + off1 + 32 * bj)); r.c[bj] = Z_LD((const v4u*)(O2 + off2 + 32 * bj)); }
    }
    template <class Sched> __device__ __forceinline__ void begin(LAS unsigned char* lds, const Sched& S, int tid) const { fill_rstab<false>(lds, ssq, S, tid); }
    __device__ __forceinline__ void operator()(const f32x4 (&acc)[2][2][4][2], const Unit& u, int wr, int wc, int fr, int fq, int ui) const {
        const int h = u.pn * 4 + wc, row0 = u.pm * 256 + wr * 64 + fr;
        RowIn in[4];
        load_row(in[0], row0, h, fq); load_row(in[1], row0 + 16, h, fq);
        float rsv[2][4]; tab_rs(lds0, ui, wr, fr, rsv);
        v4u szp[2][4][2];
#pragma unroll
        for (int ai = 0; ai < 2; ++ai)
#pragma unroll
            for (int m = 0; m < 4; ++m)
#pragma unroll
                for (int bj = 0; bj < 2; ++bj) {
                    const f32x4 z0 = acc[ai][bj][m][0] * rsv[ai][m], z1 = acc[ai][bj][m][1] * rsv[ai][m];
                    const f32x4 s0 = z0 * sigmoid4(z0), s1 = z1 * sigmoid4(z1);
                    szp[ai][m][bj] = (v4u){pk2(s0[0], s0[1]), pk2(s0[2], s0[3]), pk2(s1[0], s1[1]), pk2(s1[2], s1[3])};
                }
        load_row(in[2], row0 + 32, h, fq); load_row(in[3], row0 + 48, h, fq);
#pragma unroll
        for (int i = 0; i < 8; ++i) {
            const int ai = i >> 2, m = i & 3, row = row0 + ai * 128 + m * 16;
            const RowIn& r = in[i & 3];
            const float mx = fmaxf(r.l0, fmaxf(r.l1, r.l2));
            float w0 = __builtin_amdgcn_exp2f(r.l0 - mx), w1 = __builtin_amdgcn_exp2f(r.l1 - mx), w2 = __builtin_amdgcn_exp2f(r.l2 - mx);
            const float inv = __builtin_amdgcn_rcpf(w0 + w1 + w2); w0 *= inv; w1 *= inv; w2 *= inv;
#pragma unroll
            for (int bj = 0; bj < 2; ++bj) {
                const v4u a = r.a[bj], b = r.b[bj], c = r.c[bj], sp = szp[ai][m][bj];
                v4u w;
#pragma unroll
                for (int k = 0; k < 4; ++k) {
                    const float ol = w0 * bflo(a[k]) + w1 * bflo(b[k]) + w2 * bflo(c[k]), oh = w0 * bfhi(a[k]) + w1 * bfhi(b[k]) + w2 * bfhi(c[k]);
                    w[k] = pk2(ol * bflo(sp[k]), oh * bfhi(sp[k]));
                }
#if Y_NT
                __builtin_nontemporal_store(w, (v4u*)(Y + (size_t)row * DM + h * HD + 32 * bj + 8 * fq));
#else
                st16(Y + (size_t)row * DM + h * HD + 32 * bj + 8 * fq, w);
#endif
            }
            if (i + 4 < 8) load_row(in[i & 3], row0 + 128 + m * 16, h, fq);
        }
    }
};
}

#ifndef P0_PIPE
#define P0_PIPE 1
#endif
#ifndef P0_ST_NT
#define P0_ST_NT 0
#endif
#ifndef P0_NT
#define P0_NT 1
#endif
#if P0_NT
#define P0_LD(p) __builtin_nontemporal_load(p)
#else
#define P0_LD(p) (*(p))
#endif
template <int MODE> __device__ __forceinline__ int wt_dest_row(int n) {
    if (MODE == 1) { const int type = n >> 11, e = n & 2047, pn = e >> 6, el = e & 63; return 256 * pn + 128 * (type >> 1) + 32 * (el >> 4) + 16 * (type & 1) + (el & 15); }
    if (MODE == 3) { const int blk = n >> 10, r = n & 1023, h = r >> 6, d = r & 63; return blk * 1024 + 256 * (h >> 2) + 128 * (d >> 5) + 32 * (h & 3) + (d & 31); }
    return n;
}
__device__ __forceinline__ void p0_item_load(const float* W, int N, int item, int lane, f32x4 (&v)[16], const float* scale, f32x4 (&sc)[2]) {
    const int nblk = N / 64, kb = item / nblk, nb = item % nblk, k0 = 64 * kb, n0 = 64 * nb;
    const int kr = lane >> 4, c4 = lane & 15;
#pragma unroll
    for (int i = 0; i < 16; ++i) v[i] = P0_LD((const GAS f32x4*)(W + (size_t)(k0 + 4 * i + kr) * N + n0 + 4 * c4));
    if (scale) { sc[0] = *(const f32x4*)(scale + k0 + 8 * (lane & 7)); sc[1] = *(const f32x4*)(scale + k0 + 8 * (lane & 7) + 4); }
    else { sc[0] = (f32x4){1.f, 1.f, 1.f, 1.f}; sc[1] = sc[0]; }
}
template <int MODE> __device__ __forceinline__ void p0_item_finish(int K, int N, bf16* WT, LAS float* scr, int item, int lane, const f32x4 (&v)[16], const f32x4 (&sc)[2]) {
    const int nblk = N / 64, kb = item / nblk, nb = item % nblk, k0 = 64 * kb, n0 = 64 * nb;
    const int kr = lane >> 4, c4 = lane & 15;
#pragma unroll
    for (int i = 0; i < 16; ++i) { LAS float* d = scr + (4 * i + kr) * 65 + 4 * c4; d[0] = v[i][0]; d[1] = v[i][1]; d[2] = v[i][2]; d[3] = v[i][3]; }
    LDS_WAIT(); asm volatile("" ::: "memory");
    const int c = lane & 7, nl = lane >> 3;
#pragma unroll
    for (int j = 0; j < 8; ++j) { const int n = nl + 8 * j; const LAS float* sp = scr + (8 * c) * 65 + n;
        v4u o; o.x = pk2(sp[0 * 65] * sc[0][0], sp[1 * 65] * sc[0][1]); o.y = pk2(sp[2 * 65] * sc[0][2], sp[3 * 65] * sc[0][3]); o.z = pk2(sp[4 * 65] * sc[1][0], sp[5 * 65] * sc[1][1]); o.w = pk2(sp[6 * 65] * sc[1][2], sp[7 * 65] * sc[1][3]);
#if P0_ST_NT
        __builtin_nontemporal_store(o, (GAS v4u*)(WT + (size_t)wt_dest_row<MODE>(n0 + n) * K + k0 + 8 * c)); }
#else
        *(GAS v4u*)(WT + (size_t)wt_dest_row<MODE>(n0 + n) * K + k0 + 8 * c) = o; }
#endif
    LDS_WAIT(); asm volatile("" ::: "memory");
}
template <int MODE> __device__ __forceinline__ void p0_transpose_item(const float* W, int K, int N, const float* scale, bf16* WT, LAS float* scr  , int item, int lane) {
    f32x4 v[16], sc[2];
    p0_item_load(W, N, item, lane, v, scale, sc);
    p0_item_finish<MODE>(K, N, WT, scr, item, lane, v, sc);
}
struct Ptrs {
    const float *x, *conv_norm, *conv_w_in, *conv_w, *conv_w_out, *attn_norm, *attn_w_in, *q_gain, *k_gain, *attn_w_out, *rel_bias;
    float* out; unsigned char* ws;
};
template <int PART> __device__ __forceinline__ void p0_weights(const Ptrs& P, int j, LAS unsigned char* lds, int vcu, int G, int wave, int lane) {
    LAS float* scr = (LAS float*)(lds + wave * 16640);
    const int gw = vcu * 8 + wave, NGW = G * 8;
    bf16* W1 = (bf16*)(P.ws + WS_W1); bf16* W2 = (bf16*)(P.ws + WS_W2); bf16* W3 = (bf16*)(P.ws + WS_W3); bf16* W4 = (bf16*)(P.ws + WS_W4);
    constexpr int I1 = (DM / 64) * (CN / 64), I2 = (CE / 64) * (DM / 64), I3 = (DM / 64) * (AN / 64), I4 = (DM / 64) * (DM / 64);
    if constexpr (PART == 0) {
        for (int it = gw; it < I1; it += NGW) p0_transpose_item<1>(P.conv_w_in + (size_t)j * DM * CN, DM, CN, P.conv_norm + j * DM, W1, scr, it, lane);
    } else {
#if P0_PIPE
        static_assert(I2 + I3 + I4 <= 2 * 256 * 8, "at most two items per wave");
        const int itA = gw, itB = gw + NGW; const bool hasA = itA < I2 + I3 + I4, hasB = itB < I2 + I3 + I4;
        const int mA = itA < I2 ? 0 : (itA < I2 + I3 ? 1 : 2), rA = itA - (mA == 0 ? 0 : (mA == 1 ? I2 : I2 + I3));
        const int mB = itB < I2 ? 0 : (itB < I2 + I3 ? 1 : 2), rB = itB - (mB == 0 ? 0 : (mB == 1 ? I2 : I2 + I3));
        const float* srcs[3] = {P.conv_w_out + (size_t)j * CE * DM, P.attn_w_in + (size_t)j * DM * AN, P.attn_w_out + (size_t)j * DM * DM};
        f32x4 vA[16], vB[16], sA[2], sB[2];
        if (hasA) p0_item_load(mA == 0 ? srcs[0] : (mA == 1 ? srcs[1] : srcs[2]), mA == 1 ? AN : DM, rA, lane, vA, mA == 1 ? P.attn_norm + j * DM : nullptr, sA);
        if (hasB) p0_item_load(mB == 0 ? srcs[0] : (mB == 1 ? srcs[1] : srcs[2]), mB == 1 ? AN : DM, rB, lane, vB, mB == 1 ? P.attn_norm + j * DM : nullptr, sB);
        if (hasA) { if (mA == 0) p0_item_finish<0>(CE, DM, W2, scr, rA, lane, vA, sA); else if (mA == 1) p0_item_finish<3>(DM, AN, W3, scr, rA, lane, vA, sA); else p0_item_finish<0>(DM, DM, W4, scr, rA, lane, vA, sA); }
        if (hasB) { if (mB == 0) p0_item_finish<0>(CE, DM, W2, scr, rB, lane, vB, sB); else if (mB == 1) p0_item_finish<3>(DM, AN, W3, scr, rB, lane, vB, sB); else p0_item_finish<0>(DM, DM, W4, scr, rB, lane, vB, sB); }
#else
        for (int it = gw; it < I2 + I3 + I4; it += NGW) {
            int r = it;
            if (r < I2) { p0_transpose_item<0>(P.conv_w_out + (size_t)j * CE * DM, CE, DM, nullptr, W2, scr, r, lane); continue; } r -= I2;
            if (r < I3) { p0_transpose_item<3>(P.attn_w_in + (size_t)j * DM * AN, DM, AN, P.attn_norm + j * DM, W3, scr, r, lane); continue; } r -= I3;
            p0_transpose_item<0>(P.attn_w_out + (size_t)j * DM * DM, DM, DM, nullptr, W4, scr, r, lane);
        }
#endif
    }
}
__device__ __forceinline__ void p0_rows_load(const float* x, int m, int lane, f32x4 (&v)[8]) {
    const GAS f32x4* xr = (const GAS f32x4*)(x + (size_t)m * DM) + lane;
#pragma unroll
    for (int jj = 0; jj < 8; ++jj) v[jj] = P0_LD(xr + 64 * jj);
}
__device__ __forceinline__ void p0_rows_finish(bf16* XB, float* SSQ, int m, int lane, const f32x4 (&v)[8]) {
    GAS v2u* o8 = (GAS v2u*)(XB + (size_t)m * DM) + lane;
    float s0 = 0.f, s1 = 0.f;
#pragma unroll
    for (int jj = 0; jj < 8; ++jj) { const f32x4 t = v[jj]; const float q = (t.x * t.x + t.y * t.y) + (t.z * t.z + t.w * t.w); if (jj < 4) s0 += q; else s1 += q;
        v2u w; w.x = pk2(t.x, t.y); w.y = pk2(t.z, t.w); o8[64 * jj] = w; }
    s0 = wave_sum(s0); s1 = wave_sum(s1);
    if (lane < 32) SSQ[(size_t)m * 16 + lane] = lane == 0 ? s0 : (lane == 16 ? s1 : 0.f);
}
__device__ __forceinline__ void p0_prologue(const Ptrs& P, LAS unsigned char* lds, int vcu, int G, int wave, int lane, int tid) {
    const int gw = vcu * 8 + wave, NGW = G * 8;
    bf16* XB = (bf16*)(P.ws + WS_XB); float* SSQ = (float*)(P.ws + WS_SSQ);
#if P0_PIPE
    constexpr int I1 = (DM / 64) * (CN / 64);
    LAS float* scr = (LAS float*)(lds + wave * 16640);
    f32x4 vw[16], sw[2], va[8], vb[8];
    const int step = 2 * NGW;
    int m = 2 * gw;
    if (gw < I1) p0_item_load(P.conv_w_in, CN, gw, lane, vw, P.conv_norm, sw);
    if (m < MROWS) p0_rows_load(P.x, m, lane, va);
    if (gw < I1) p0_item_finish<1>(DM, CN, (bf16*)(P.ws + WS_W1), scr, gw, lane, vw, sw);
    for (int it = gw + NGW; it < I1; it += NGW) p0_transpose_item<1>(P.conv_w_in, DM, CN, P.conv_norm, (bf16*)(P.ws + WS_W1), scr, it, lane);
    for (; m < MROWS; m += 2 * step) {
        const int m2 = m + step, m3 = m2 + step;
        if (m2 < MROWS) p0_rows_load(P.x, m2, lane, vb);
        p0_rows_finish(XB, SSQ, m, lane, va);
        if (m3 < MROWS) p0_rows_load(P.x, m3, lane, va);
        if (m2 < MROWS) p0_rows_finish(XB, SSQ, m2, lane, vb);
    }
#else
    p0_weights<0>(P, 0, lds, vcu, G, wave, lane);
    for (int m = 2 * gw; m < MROWS; m += 2 * NGW) {
        f32x4 v[8];
        p0_rows_load(P.x, m, lane, v);
        p0_rows_finish(XB, SSQ, m, lane, v);
    }
#endif
    float* BT = (float*)(P.ws + WS_BIAS);
    for (int i = vcu * 512 + tid; i < NG * NH * 132; i += G * 512) {
        const int g = i / (NH * 132), r = i % (NH * 132), h = r / 132, st = r % 132;
        const int dil = g == 0 ? 1 : (g == 1 ? 4 : 16);
        BT[i] = st <= 128 ? P.rel_bias[t5_bucket(st * dil) * (NG * NH) + g * NH + h] * LOG2E : 0.f;
    }
}
__device__ __forceinline__ void conv_fixup(bf16* Y, const float* side, const float* cw, int pm, int tid) {
    if ((pm & 15) == 0) return;
    const int ch = 4 * tid;
    const f32x4 g0 = *(const f32x4*)(side + ((size_t)pm * 6 + 0) * CE + ch), g1 = *(const f32x4*)(side + ((size_t)pm * 6 + 1) * CE + ch);
    const f32x4 c0 = *(const f32x4*)(side + ((size_t)pm * 6 + 2) * CE + ch), c1 = *(const f32x4*)(side + ((size_t)pm * 6 + 3) * CE + ch);
    const f32x4 va = *(const f32x4*)(side + ((size_t)(pm - 1) * 6 + 4) * CE + ch), vb = *(const f32x4*)(side + ((size_t)(pm - 1) * 6 + 5) * CE + ch);
    const f32x4 w0 = *(const f32x4*)(cw + ch), w1 = *(const f32x4*)(cw + CE + ch);
    const f32x4 y0 = g0 * (c0 + w1 * vb + w0 * va), y1 = g1 * (c1 + w0 * vb);
    v2u a, b; a.x = pk2(y0[0], y0[1]); a.y = pk2(y0[2], y0[3]); b.x = pk2(y1[0], y1[1]); b.y = pk2(y1[2], y1[3]);
    *(v2u*)(Y + (size_t)(pm * 256) * CE + ch) = a; *(v2u*)(Y + (size_t)(pm * 256 + 1) * CE + ch) = b;
}

namespace attn {
typedef float f32x16 __attribute__((ext_vector_type(16)));
typedef short s16x4 __attribute__((ext_vector_type(4)));
typedef short v4i16_t __attribute__((ext_vector_type(4)));
constexpr int L_K = 0, L_V = 49152, L_B = 98304, L_O = 118784, L_END = 151552, L_JUNK = 151552, L_WS = 161536 + 256;
__device__ __forceinline__ int rot3(int x) { return x >= 3 ? x - 3 : x; }
static_assert(L_O + 8 * 4096 == L_END && L_B + 5 * 4096 == L_O, "attention LDS map");
__device__ __forceinline__ int crow(int r, int hi) { return (r & 3) + 8 * (r >> 2) + 4 * hi; }
__device__ __forceinline__ s16x4 vtr(LAS const unsigned char* p) { return __builtin_bit_cast(s16x4, __builtin_amdgcn_ds_read_tr16_b64_v4i16((LAS v4i16_t*)p)); }
__device__ __forceinline__ float swapmax(float m) { auto rr = __builtin_amdgcn_permlane32_swap(__float_as_uint(m), __float_as_uint(m), false, false); return fmaxf(__uint_as_float(rr[0]), __uint_as_float(rr[1])); }
__device__ __forceinline__ float swapsum(float m) { auto rr = __builtin_amdgcn_permlane32_swap(__float_as_uint(m), __float_as_uint(m), false, false); return __uint_as_float(rr[0]) + __uint_as_float(rr[1]); }

#define ATT_BAR() asm volatile("s_waitcnt lgkmcnt(0)\n\ts_barrier" ::: "memory")
#ifndef ATT_O_NT
#define ATT_O_NT 0
#endif
#ifndef ATT_PRIO
#define ATT_PRIO 0
#endif
#ifndef ATT_KEEP_TAIL
#define ATT_KEEP_TAIL 0
#endif
#ifndef ATT_NT
#define ATT_NT " nt"
#endif
__device__ __forceinline__ void glds16_keep(const void* gsrc, unsigned lds_dst) { unsigned keep;
    asm volatile("s_mov_b32 %0, m0\n\ts_mov_b32 m0, %2\n\ts_nop 0\n\tglobal_load_lds_dwordx4 %1, off\n\ts_mov_b32 m0, %0" : "=&s"(keep) : "v"(gsrc), "s"(lds_dst) : "memory"); }
__device__ __forceinline__ void glds16(const void* gsrc, unsigned lds_dst) { unsigned keep;
    asm volatile("s_mov_b32 %0, m0\n\ts_mov_b32 m0, %2\n\ts_nop 0\n\tglobal_load_lds_dwordx4 %1, off" ATT_NT "\n\ts_mov_b32 m0, %0" : "=&s"(keep) : "v"(gsrc), "s"(lds_dst) : "memory"); }
template <int DIL> struct Job {
    int bh, c, n0, h; size_t rowb, base;
    __device__ __forceinline__ void decode(int id) { constexpr int CPC = (SEQ / DIL) / 256; bh = id >> 4; const int sub = id & 15; c = sub / CPC; n0 = (sub % CPC) * 256; h = bh & 15; rowb = (size_t)(bh >> 4) * SEQ;
        base = ((size_t)bh * SEQ + (size_t)c * (SEQ / DIL)) * HD; }
};
__device__ __forceinline__ void glds16s(unsigned voff, const void* sbase, unsigned lds_dst) { unsigned keep;
    asm volatile("s_mov_b32 %0, m0\n\ts_mov_b32 m0, %2\n\ts_nop 0\n\tglobal_load_lds_dwordx4 %1, %3 nt\n\ts_mov_b32 m0, %0" : "=&s"(keep) : "v"(voff), "s"(lds_dst), "s"(sbase) : "memory"); }
template <int DIL, bool ISV> __device__ __forceinline__ void issue_kv(LAS unsigned char* lds, const bf16* src, const Job<DIL>& J, int w, int lane, int rot, bool cont) {
    const int r8 = lane >> 3, pc = lane & 7;
    const bf16* sbase = src + J.base;
    const int pos0 = J.n0 - 128 + w * 48 + r8;
    const int swE = ISV ? ((((pc >> 2) ^ ((r8 >> 1) & 1)) * 64) + (pc & 3) * 16) : ((pc ^ (r8 >> 1)) * 16);
    const int swO = ISV ? swE : ((pc ^ (4 + (r8 >> 1))) * 16);
#pragma unroll
    for (int i = 0; i < 6; ++i) {
        const int kb = w * 6 + i, lb = kb >> 4;
        const bool junk = cont && lb == 0;
        int pos = pos0 + 8 * i; pos = (pos < 0 || junk) ? 0 : pos;
        const unsigned voff = (unsigned)(pos * 128 + ((i & 1) ? swO : swE));
        const int dst = junk ? L_JUNK : (ISV ? L_V : L_K) + rot3(lb + rot) * 16384 + (kb & 15) * 1024;
        glds16s(voff, sbase, (unsigned)__builtin_amdgcn_readfirstlane((int)((unsigned)(uintptr_t)lds + dst)));
    }
}
__device__ __forceinline__ void ld16_asm(bf16x8& dst, const bf16* p) { asm volatile("global_load_dwordx4 %0, %1, off" : "=v"(dst) : "v"(p) : "memory"); }

template <int DIL> __device__ __forceinline__ void phase(LAS unsigned char* lds, const bf16* QO, bf16* OUT, const bf16* Kg, const bf16* Vg, const float* biasT  , float* lse  , int vcu, int G, int jlo = 0, int jhi = 4) {
    const int tid = threadIdx.x, lane = tid & 63, r32 = lane & 31, hi = lane >> 5;
    const int w = __builtin_amdgcn_readfirstlane(tid >> 6);
    constexpr int NJS = BATCH * NH * 16;
    int id = vcu * 4 + jlo;
    if (id >= NJS || jlo >= jhi) return;
    Job<DIL> J; J.decode(id);
    bf16x8 q0, q1, q2, q3;
    int rot = 0;
    issue_kv<DIL, false>(lds, Kg, J, w, lane, 0, false);
    { const bf16* qp = QO + J.base + (size_t)(J.n0 + 32 * w + r32) * HD + hi * 8; ld16_asm(q0, qp); ld16_asm(q1, qp + 16); ld16_asm(q2, qp + 32); ld16_asm(q3, qp + 48); }
    issue_kv<DIL, true>(lds, Vg, J, w, lane, 0, false);
    int cur_bh = -1; bool first = true;
    for (;;) {
        const int nid = id + (((id & 3) == jhi - 1) ? (G * 4 - (jhi - 1 - jlo)) : 1);
        const bool has_next = nid < NJS;
        Job<DIL> JN; JN.decode(has_next ? nid : id);
        if (J.bh != cur_bh) {
            cur_bh = J.bh;
            float bv[10]; bool bok[10];
#pragma unroll
            for (int i = 0; i < 10; ++i) {
                const int e = tid + 512 * i, j = e >> 10, rem = e & 1023, rg = rem >> 8, ln = (rem & 255) >> 2, i4 = rem & 3;
                const int r = 4 * rg + i4, a = ln & 31, hh = ln >> 5, kk = 32 * j + crow(r, hh), step = 128 + a - kk;
                bv[i] = biasT[J.h * 132 + (step < 0 ? 0 : (step > 128 ? 128 : step))];
                bok[i] = step >= 0 && step <= 128;
            }
#pragma unroll
            for (int i = 0; i < 10; ++i) ((LAS float*)(lds + L_B))[tid + 512 * i] = bok[i] ? bv[i] : -INFINITY;
        }
        if (first) { first = false; asm volatile("s_waitcnt vmcnt(6)" : "+v"(q0), "+v"(q1), "+v"(q2), "+v"(q3) :: "memory"); }
        ATT_BAR();
        const int n0 = J.n0, h = J.h, c = J.c; const size_t rowb = J.rowb, jbase = J.base;
        const size_t qrow = rowb + (size_t)(n0 + 32 * w + r32) * DIL + c;
        const int jstart = (n0 == 0 && w < 4) ? 4 - w : 0;
        int toff[5];
#pragma unroll
        for (int j = 0; j < 5; ++j) { const int tb = w + j; toff[j] = rot3((tb >> 2) + rot) * 16384 + (tb & 3) * 4096; }
        const int rotn = rot3(rot + 2);
        const bool cont = (DIL != 16) && has_next && JN.bh == J.bh && JN.c == J.c && JN.n0 == J.n0 + 256;
        f32x16 S[5];
#if ATT_PRIO
        __builtin_amdgcn_s_setprio(1);
#endif
#pragma unroll
        for (int j = 0; j < 5; ++j) {
            if (j < jstart) {
#pragma unroll
                for (int r = 0; r < 16; ++r) S[j][r] = -INFINITY;
            } else {
                f32x16 cinit;
#pragma unroll
                for (int rg = 0; rg < 4; ++rg) { const f32x4 t = *(const LAS f32x4*)(lds + L_B + j * 4096 + rg * 1024 + lane * 16); cinit[4 * rg] = t[0]; cinit[4 * rg + 1] = t[1]; cinit[4 * rg + 2] = t[2]; cinit[4 * rg + 3] = t[3]; }
#pragma unroll
                for (int d0 = 0; d0 < 4; ++d0) {
                    const bf16x8 kf = *(const LAS bf16x8*)(lds + L_K + toff[j] + r32 * 128 + (((2 * d0 + hi) ^ ((r32 >> 1) & 7)) * 16));
                    cinit = __builtin_amdgcn_mfma_f32_32x32x16_bf16(kf, d0 == 0 ? q0 : (d0 == 1 ? q1 : (d0 == 2 ? q2 : q3)), cinit, 0, 0, 0);
                }
                S[j] = cinit;
            }
        }
#if ATT_PRIO
        __builtin_amdgcn_s_setprio(0);
#endif
        ATT_BAR();
        bf16x8 n0q, n1q, n2q, n3q;
        if (has_next) {
            issue_kv<DIL, false>(lds, Kg, JN, w, lane, rotn, cont);
            const bf16* qp = QO + JN.base + (size_t)(JN.n0 + 32 * w + r32) * HD + hi * 8; ld16_asm(n0q, qp); ld16_asm(n1q, qp + 16); ld16_asm(n2q, qp + 32); ld16_asm(n3q, qp + 48);
        }
        float m = -INFINITY;
#pragma unroll
        for (int j = 0; j < 5; ++j)
#pragma unroll
            for (int r = 0; r < 16; ++r) m = fmaxf(m, S[j][r]);
        m = swapmax(m);
        const f32x2_t nm2 = (f32x2_t){-m, -m};
        f32x16 lsv = (f32x16){0.f, 0.f, 0.f, 0.f, 0.f, 0.f, 0.f, 0.f, 0.f, 0.f, 0.f, 0.f, 0.f, 0.f, 0.f, 0.f};
#pragma unroll
        for (int j = 0; j < 5; ++j) {
            f32x16 d;
#pragma unroll
            for (int r = 0; r < 16; r += 2) { const f32x2_t t2 = (f32x2_t){S[j][r], S[j][r + 1]} + nm2; d[r] = t2[0]; d[r + 1] = t2[1]; }
            f32x16 pv;
#pragma unroll
            for (int r = 0; r < 16; ++r) pv[r] = __builtin_amdgcn_exp2f(d[r]);
            S[j] = pv; lsv += pv;
        }
        float lsum = ((lsv[0] + lsv[1]) + (lsv[2] + lsv[3])) + ((lsv[4] + lsv[5]) + (lsv[6] + lsv[7])) + (((lsv[8] + lsv[9]) + (lsv[10] + lsv[11])) + ((lsv[12] + lsv[13]) + (lsv[14] + lsv[15])));
        lsum = swapsum(lsum);
        if (has_next) asm volatile("s_waitcnt vmcnt(10)" ::: "memory"); else asm volatile("s_waitcnt vmcnt(0)" ::: "memory");
        ATT_BAR();
        f32x16 o[2];
        const int vq = (lane & 15) >> 2, vx = (vq >> 1) & 1;
        const LAS unsigned char* vrow = lds + L_V + (4 * hi + vq) * 128 + ((lane >> 4) & 1) * 32 + (lane & 3) * 8;
        const LAS unsigned char* vbh[2] = {vrow + vx * 64, vrow + (1 - vx) * 64};
#pragma unroll
        for (int j = 0; j < 5; ++j)
#pragma unroll
            for (int s = 0; s < 2; ++s) {
                v4u pw; pw.x = pk2(S[j][8 * s], S[j][8 * s + 1]); pw.y = pk2(S[j][8 * s + 2], S[j][8 * s + 3]); pw.z = pk2(S[j][8 * s + 4], S[j][8 * s + 5]); pw.w = pk2(S[j][8 * s + 6], S[j][8 * s + 7]);
                const bf16x8 pa = __builtin_bit_cast(bf16x8, pw);
#pragma unroll
                for (int d0 = 0; d0 < 2; ++d0) {
                    const s16x4 lo = vtr(vbh[d0] + toff[j] + (16 * s) * 128), hh = vtr(vbh[d0] + toff[j] + (16 * s + 8) * 128);
                    const bf16x8 vf = (bf16x8){lo[0], lo[1], lo[2], lo[3], hh[0], hh[1], hh[2], hh[3]};
                    o[d0] = __builtin_amdgcn_mfma_f32_32x32x16_bf16(vf, pa, (j == 0 && s == 0) ? (f32x16){0.f, 0.f, 0.f, 0.f, 0.f, 0.f, 0.f, 0.f, 0.f, 0.f, 0.f, 0.f, 0.f, 0.f, 0.f, 0.f} : o[d0], 0, 0, 0);
                }
            }
        ATT_BAR();
        if (has_next) issue_kv<DIL, true>(lds, Vg, JN, w, lane, rotn, cont);
        if (hi == 0) lse[qrow * 16 + h] = m + log2f(lsum);
        const float inv = __builtin_amdgcn_rcpf(lsum);
        LAS unsigned char* stg = lds + L_O + w * 4096;
#pragma unroll
        for (int d0 = 0; d0 < 2; ++d0)
#pragma unroll
            for (int g4 = 0; g4 < 4; ++g4) {
                v2u pk; pk.x = pk2(o[d0][4 * g4] * inv, o[d0][4 * g4 + 1] * inv); pk.y = pk2(o[d0][4 * g4 + 2] * inv, o[d0][4 * g4 + 3] * inv);
                *(LAS v2u*)(stg + r32 * 128 + (((4 * d0 + g4) ^ (r32 & 7)) * 16) + hi * 8) = pk;
            }
        asm volatile("s_waitcnt lgkmcnt(0)" ::: "memory");
#pragma unroll
        for (int i = 0; i < 4; ++i) { const int row = i * 8 + (lane >> 3), ch = lane & 7; const v4u v = *(const LAS v4u*)(stg + row * 128 + ((ch ^ (row & 7)) * 16));

#if ATT_O_NT
            __builtin_nontemporal_store(v, (v4u*)(OUT + jbase + (size_t)(n0 + 32 * w + row) * HD + ch * 8)); }
#else
            st16(OUT + jbase + (size_t)(n0 + 32 * w + row) * HD + ch * 8, v); }
#endif

        if (!has_next) break;
        asm volatile("s_waitcnt vmcnt(6)" : "+v"(n0q), "+v"(n1q), "+v"(n2q), "+v"(n3q) :: "memory");
        id = nid; J = JN; q0 = n0q; q1 = n1q; q2 = n2q; q3 = n3q; rot = rotn;
    }
    asm volatile("s_waitcnt vmcnt(0) lgkmcnt(0)\n\ts_barrier" ::: "memory");
}
#undef ATT_BAR
}

#ifndef PARITY_SPLIT
#define PARITY_SPLIT 1
#endif
#ifndef GEMM_SP2
#define GEMM_SP2 true
#endif
#ifndef GEMM_ALIGN
#define GEMM_ALIGN true
#endif
#ifndef DUP_RES
#define DUP_RES 0
#endif
#ifndef DUP_A2
#define DUP_A2 0
#endif
#ifndef DUP_A3
#define DUP_A3 0
#endif
#ifndef ATT_SPLIT
#define ATT_SPLIT 4
#endif
#ifndef DUP_EPI
#define DUP_EPI 0
#endif
#ifndef PARITY_EXPR
#define PARITY_EXPR ((bx & 1) != 0)
#endif
#ifndef CONV_PARITY_EXPR
#define CONV_PARITY_EXPR PARITY_EXPR
#endif
#ifndef ONE_ALIGN
#define ONE_ALIGN false
#endif
#ifndef DUP_BAR
#define DUP_BAR 0
#endif
#ifndef RESID0_BF16
#define RESID0_BF16 1
#endif
constexpr int LDS_BYTES = 163840;
constexpr int XCH_OFF = 131072;
constexpr int MISC_OFF = 161536;
struct Args { const float* in[11]; float* out; unsigned char* ws; int ph_lo, ph_hi; };

enum PhaseKind { PK_P0A, PK_P0B, PK_C1, PK_C3, PK_A1, PK_A1A2, PK_A2, PK_A3, PK_A4 };
struct PhaseDesc { int kind, j, g; };
__host__ __device__ constexpr PhaseDesc phase_desc(int ph) {
    if (ph == 0) return {PK_P0A, 0, 0};
    const int j = ph >= 9 ? 1 : 0, s = ph - (j ? 9 : 1);
    switch (s) {
        case 0: return {PK_C1, j, 0};
        case 1: return {PK_C3, j, 0};
        case 2: return {PK_A1, j, 0};
        case 3: return {PK_A1A2, j, 0};
        case 4: return {PK_A1A2, j, 1};
        case 5: return {PK_A2, j, 2};
        case 6: return {PK_A3, j, 0};
        default: return {PK_A4, j, 0};
    }
}
__device__ __forceinline__ size_t kbuf_off(int g) { return g == 1 ? WS_KB : WS_KA; }
__device__ __forceinline__ size_t vbuf_off(int g) { return g == 1 ? WS_VB : WS_VA; }

template <int J, int G1> __device__ __forceinline__ void run_qkv_gemm(const Args& args, LAS unsigned char* lds, int G, int bx) {
    unsigned char* ws = args.ws;
    bf16* XB = (bf16*)(ws + WS_XB); float* SSQ = (float*)(ws + WS_SSQ);
    bf16* QO = (bf16*)(ws + WS_QO) + (size_t)G1 * MROWS * DM;
    pg8::Gemm gm{XB, (const bf16*)(ws + WS_W3) + (size_t)G1 * 3072 * DM, MROWS, 3072, DM}; pg8::StaticOrder S; S.init(MROWS, 3072, G, bx);
    epi::QKV E{SSQ, QO, (bf16*)(ws + kbuf_off(G1)), (bf16*)(ws + vbuf_off(G1)), args.in[7] + (J * NG + G1) * HD, args.in[8] + (J * NG + G1) * HD, lds, 2 * G1, (DUP_EPI != 0 && G1 == 0) ? (bf16*)(ws + WS_QO) + (size_t)2 * MROWS * DM : nullptr};
    pg8::gemm_phase<epi::QKV, pg8::StaticOrder, GEMM_ALIGN, GEMM_SP2>(lds, gm, S, E);
}
template <int G0> __device__ __forceinline__ void run_attn(const Args& args, LAS unsigned char* lds, int vcu, int G, int jlo = 0, int jhi = 4) {
    unsigned char* ws = args.ws;
    constexpr int dil = G0 == 0 ? 1 : (G0 == 1 ? 4 : 16);
    bf16* QO = (bf16*)(ws + WS_QO) + (size_t)G0 * MROWS * DM;
    attn::phase<dil>(lds, QO, QO, (const bf16*)(ws + kbuf_off(G0)), (const bf16*)(ws + vbuf_off(G0)), (const float*)(ws + WS_BIAS) + G0 * NH * 132, (float*)(ws + WS_LSE) + (size_t)G0 * MROWS * 16, vcu, G, jlo, jhi);
}

template <int PH> __device__ __forceinline__ void run_phase(const Args& args, LAS unsigned char* lds) {
    constexpr PhaseDesc D = phase_desc(PH);
    constexpr int j = D.j;
    const int tid = threadIdx.x, lane = tid & 63, wave = __builtin_amdgcn_readfirstlane(tid >> 6);
    const int G = gridDim.x, bx = PH == 0 ? (int)blockIdx.x : __builtin_amdgcn_readfirstlane((int)((volatile LAS unsigned*)(lds + MISC_OFF))[8 + 3]), vcu = (G % 8 == 0) ? (bx % 8) * (G / 8) + bx / 8 : bx;
    unsigned char* ws = args.ws;
    float* SSQ = (float*)(ws + WS_SSQ); bf16* XB = (bf16*)(ws + WS_XB);
    (void)lane; (void)wave; (void)SSQ; (void)XB; (void)vcu;
    if constexpr (D.kind == PK_P0A || D.kind == PK_P0B) {
        Ptrs P;
        P.x = args.in[0]; P.conv_norm = args.in[1]; P.conv_w_in = args.in[2]; P.conv_w = args.in[3]; P.conv_w_out = args.in[4]; P.attn_norm = args.in[5];
        P.attn_w_in = args.in[6]; P.q_gain = args.in[7]; P.k_gain = args.in[8]; P.attn_w_out = args.in[9]; P.rel_bias = args.in[10]; P.out = args.out; P.ws = args.ws;
        if constexpr (D.kind == PK_P0A) p0_prologue(P, lds, vcu, G, wave, lane, tid);
        else p0_weights<0>(P, 1, lds, vcu, G, wave, lane);
    } else if constexpr (D.kind == PK_C1) {
        Ptrs P;
        P.x = args.in[0]; P.conv_norm = args.in[1]; P.conv_w_in = args.in[2]; P.conv_w = args.in[3]; P.conv_w_out = args.in[4]; P.attn_norm = args.in[5];
        P.attn_w_in = args.in[6]; P.q_gain = args.in[7]; P.k_gain = args.in[8]; P.attn_w_out = args.in[9]; P.rel_bias = args.in[10]; P.out = args.out; P.ws = args.ws;
        const bool conv_first = CONV_PARITY_EXPR;
        if (conv_first) { p0_weights<1>(P, j, lds, vcu, G, wave, lane); __syncthreads(); }
        pg8::Gemm g{XB, (const bf16*)(ws + WS_W1), MROWS, CN, DM}; pg8::StaticOrder S; S.init(MROWS, CN, G, bx);
        epi::ConvFused E{SSQ, (bf16*)(ws + WS_CG), args.in[3] + (size_t)j * 3 * CE, (float*)(ws + WS_SIDE), lds + XCH_OFF};
        pg8::gemm_phase<epi::ConvFused, pg8::StaticOrder, true, GEMM_SP2>(lds, g, S, E);
        if (!conv_first) p0_weights<1>(P, j, lds, vcu, G, wave, lane);
    } else if constexpr (D.kind == PK_C3 || D.kind == PK_A4) {
        constexpr bool C3 = D.kind == PK_C3; constexpr int K = C3 ? CE : DM;
        const bf16* A = (const bf16*)(ws + (C3 ? WS_CG : WS_Y));
        pg8::Gemm g{A, (const bf16*)(ws + (C3 ? WS_W2 : WS_W4)), MROWS, DM, K}; pg8::StaticOrder S; S.init(MROWS, DM, G, bx);
        if constexpr (C3) { pg8::Unit fu; for (int i = 0; S.next(i, fu); ++i) conv_fixup((bf16*)(ws + WS_CG), (const float*)(ws + WS_SIDE), args.in[3] + (size_t)j * 3 * CE, fu.pm, tid);
            asm volatile("s_waitcnt vmcnt(0)" ::: "memory"); __syncthreads(); }
        constexpr int RMODE = (j == 0 && C3 && !RESID0_BF16) ? 0 : ((j == 1 && !C3) ? 2 : 1);
#if DUP_RES
        if constexpr (RMODE == 1 && (DUP_RES == 1) == C3) { epi::ResidB<RMODE> E2{args.in[0], args.out, XB, SSQ, (bf16*)(ws + WS_VB)}; pg8::gemm_phase<epi::ResidB<RMODE>, pg8::StaticOrder, false, true>(lds, g, S, E2); }
#endif
#ifdef DUP_NULL
        if constexpr (!C3 && j == 0) { for (int rep = 0; rep < DUP_NULL; ++rep) { epi::NullEpi E0{(float*)(ws + WS_SIDE)}; pg8::gemm_phase<epi::NullEpi, pg8::StaticOrder, ONE_ALIGN, true>(lds, g, S, E0); } }
#endif
        epi::ResidB<RMODE> E{args.in[0], args.out, XB, SSQ, XB};
        pg8::gemm_phase<epi::ResidB<RMODE>, pg8::StaticOrder, ONE_ALIGN, true>(lds, g, S, E);
    } else if constexpr (D.kind == PK_A1) {
        if constexpr (j == 0) {
            Ptrs P;
            P.x = args.in[0]; P.conv_norm = args.in[1]; P.conv_w_in = args.in[2]; P.conv_w = args.in[3]; P.conv_w_out = args.in[4]; P.attn_norm = args.in[5];
            P.attn_w_in = args.in[6]; P.q_gain = args.in[7]; P.k_gain = args.in[8]; P.attn_w_out = args.in[9]; P.rel_bias = args.in[10]; P.out = args.out; P.ws = args.ws;
            const bool conv_first = CONV_PARITY_EXPR;
            if (conv_first) { p0_weights<0>(P, 1, lds, vcu, G, wave, lane); __syncthreads(); }
            run_qkv_gemm<j, 0>(args, lds, G, bx);
            if (!conv_first) p0_weights<0>(P, 1, lds, vcu, G, wave, lane);
        } else run_qkv_gemm<j, 0>(args, lds, G, bx);
    } else if constexpr (D.kind == PK_A1A2) {
#if PARITY_SPLIT
        const bool attn_first = PARITY_EXPR;
#else
        const bool attn_first = false;
#endif
        if (attn_first) { run_attn<D.g>(args, lds, vcu, G, 0, ATT_SPLIT); run_qkv_gemm<j, D.g + 1>(args, lds, G, bx); run_attn<D.g>(args, lds, vcu, G, ATT_SPLIT, 4); }
        else            { run_qkv_gemm<j, D.g + 1>(args, lds, G, bx); run_attn<D.g>(args, lds, vcu, G); }
    } else if constexpr (D.kind == PK_A2) {
#if DUP_A2
        { constexpr int dil = 16; bf16* QO = (bf16*)(ws + WS_QO) + (size_t)2 * MROWS * DM;
          attn::phase<dil>(lds, QO, (bf16*)(ws + WS_VB), (const bf16*)(ws + kbuf_off(2)), (const bf16*)(ws + vbuf_off(2)), (const float*)(ws + WS_BIAS) + 2 * NH * 132, (float*)(ws + WS_LSE) + (size_t)2 * MROWS * 16, vcu, G); }
#endif
        run_attn<D.g>(args, lds, vcu, G);
    } else if constexpr (D.kind == PK_A3) {
        const bf16* O0 = (const bf16*)(ws + WS_QO); const bf16* O1 = O0 + (size_t)MROWS * DM; const bf16* O2 = O1 + (size_t)MROWS * DM;
        pg8::Gemm g{XB, (const bf16*)(ws + WS_W3) + (size_t)QKVC * DM, MROWS, DM, DM}; pg8::StaticOrder S; S.init(MROWS, DM, G, bx);
        epi::ZMerge E{SSQ, O0, O1, O2, (const float*)(ws + WS_LSE), (bf16*)(ws + WS_Y), lds};
#if DUP_A3
        pg8::gemm_phase<epi::ZMerge, pg8::StaticOrder, false, true>(lds, g, S, E);
#endif
        pg8::gemm_phase<epi::ZMerge, pg8::StaticOrder, ONE_ALIGN, true>(lds, g, S, E);
    }
}

__global__ void __launch_bounds__(512, 2) mk_fwd(Args args) {
    extern __shared__ __attribute__((aligned(16))) unsigned char lds_raw[];
    LAS unsigned char* lds = (LAS unsigned char*)lds_raw;
    volatile LAS unsigned* MISC = (volatile LAS unsigned*)(lds + MISC_OFF);
    for (int u = threadIdx.x; u < (LDS_BYTES - MISC_OFF) / 4; u += 512) ((LAS unsigned*)(lds + MISC_OFF))[u] = 0u;
    __syncthreads();
    gu32* ctl = (gu32*)(args.ws + WS_CTL);
    XcdBarrier bar; bar.bar = (unsigned*)(ctl + CW_BAR); bar.x = 0; bar.st = nullptr;
    const int lo = args.ph_lo, hi = args.ph_hi;
    if (hi - lo > 1) bar = xcd_barrier_post((unsigned*)(ctl + CW_BAR), MISC + 8);
#if DUP_BAR
#define RUN(k) if (lo <= (k) && (k) < hi) { run_phase<(k)>(args, lds); if ((k) + 1 < hi) { xcd_barrier(bar); xcd_barrier(bar); } }
#else
#define RUN(k) if (lo <= (k) && (k) < hi) { run_phase<(k)>(args, lds); if ((k) + 1 < hi) { if constexpr (phase_desc(k).kind == PK_C3 || phase_desc(k).kind == PK_A3) xcd_barrier_local(bar); else xcd_barrier(bar); } }
#endif
    RUN(0) RUN(1) RUN(2) RUN(3) RUN(4) RUN(5) RUN(6) RUN(7) RUN(8) RUN(9) RUN(10) RUN(11) RUN(12) RUN(13) RUN(14) RUN(15) RUN(16)
#undef RUN
}

extern "C" void kernel_launch(void* const* d_in, const int* in_sizes, int n_in, void* d_out, int out_size, void* d_ws, size_t ws_size, hipStream_t stream) {
    static int grid = 0;
    if (grid == 0) {
        if (n_in != 11 || in_sizes[0] != MROWS * DM || out_size != MROWS * DM || ws_size < WS_END) { fprintf(stderr, "kernel_launch: unexpected shapes (n_in %d, ws %zu); nothing launched\n", n_in, ws_size); grid = -1; return; }
        int dev = 0, cus = 0, per_cu = 0;
        if (hipGetDevice(&dev) != hipSuccess || hipDeviceGetAttribute(&cus, hipDeviceAttributeMultiprocessorCount, dev) != hipSuccess) { grid = -1; return; }
        if (hipFuncSetAttribute((const void*)mk_fwd, hipFuncAttributeMaxDynamicSharedMemorySize, LDS_BYTES) != hipSuccess) { fprintf(stderr, "kernel_launch: hipFuncSetAttribute failed\n"); grid = -1; return; }
        if (hipOccupancyMaxActiveBlocksPerMultiprocessor(&per_cu, (const void*)mk_fwd, 512, LDS_BYTES) != hipSuccess || per_cu < 1) { fprintf(stderr, "kernel_launch: occupancy query says %d blocks per CU; nothing launched\n", per_cu); (void)hipGetLastError(); grid = -1; return; }
        if (cus < 256) { fprintf(stderr, "kernel_launch: built for >= 256 CUs (per-phase LDS tables hold 8 units per workgroup); %d found; nothing launched\n", cus); grid = -1; return; }
        grid = cus;
    }
    if (grid < 0) return;
    (void)hipMemsetAsync((char*)d_ws + WS_CTL, 0, CTL_ZERO_BYTES, stream);
    Args a{};
    for (int i = 0; i < 11; ++i) a.in[i] = (const float*)d_in[i];
    a.out = (float*)d_out; a.ws = (unsigned char*)d_ws;
    a.ph_lo = 0; a.ph_hi = NPHASE; hipLaunchKernelGGL(mk_fwd, dim3(grid), dim3(512), LDS_BYTES, stream, a);
}
```
